# Optimizing an MI355X kernel written in HIP

```python
import jax, jax.numpy as jnp
from jax import lax
import numpy as np

D_MODEL = 2048
BATCH = 4
SEQ = 2048
DEPTH = 4
DEC_BATCH = 8
DEC_SEQ = 4
PAST_LEN = 16384
PAGE_SIZE = 128

N_MIXERS = 2
N_LAYERS_A = (DEPTH + 1) // 2
N_LAYERS_B = DEPTH // 2
DIL_PATTERNS = ((128, 1), (512, 4), (2048, 16))
N_GROUPS_A = len(DIL_PATTERNS)
HEADS_A = 8
HEAD_DIM_A = 128
BLOCK_Q = 128
ROPE_THETA = 10000.0
HEADS_B = 8
DQK_B = D_MODEL // 2 // HEADS_B
DV_B = D_MODEL // HEADS_B
CHUNK_B = 64
GATE_CAP = 15.0
D_FF = 5632
CONV_W = 3
EPS = 1e-6

kernel_name = "dilated_attn_mlstm_convffn_step"


def rms_norm(x, g):
    xf = x.astype(jnp.float32)
    y = xf * lax.rsqrt(jnp.mean(xf * xf, axis=-1, keepdims=True) + EPS)
    return (y * g.astype(jnp.float32)).astype(x.dtype)


def rotary(x, pos):
    half = HEAD_DIM_A // 2
    inv_freq = ROPE_THETA ** (-jnp.arange(half, dtype=jnp.float32) / half)
    ang = pos.astype(jnp.float32)[:, None] * inv_freq[None, :]
    shape = (pos.shape[0],) + (1,) * (x.ndim - 3) + (half,)
    cos, sin = jnp.cos(ang).reshape(shape), jnp.sin(ang).reshape(shape)
    xf = x.astype(jnp.float32)
    x1, x2 = xf[..., :half], xf[..., half:]
    return jnp.concatenate([x1 * cos - x2 * sin, x2 * cos + x1 * sin], axis=-1).astype(x.dtype)


def attn_project(h, w_qkv, q_gain, k_gain, pos):
    B, S, _ = h.shape
    qkv = jnp.einsum('bsd,de->bse', h, w_qkv).reshape(B, S, N_GROUPS_A, 3, HEADS_A, HEAD_DIM_A)
    q = rotary(rms_norm(qkv[:, :, :, 0], q_gain), pos)
    k = rotary(rms_norm(qkv[:, :, :, 1], k_gain), pos)
    return q, k, qkv[:, :, :, 2]


def dilated_attn_prompt(q, k, v, dil, band):
    B, S, H, HD = q.shape
    L = S // dil
    n_blk = -(-L // BLOCK_Q)
    n_prev = -(-band // BLOCK_Q)
    Lp = n_blk * BLOCK_Q

    def classes(x):
        return x.reshape(B, L, dil, H, HD).transpose(0, 2, 1, 3, 4)

    qb = jnp.pad(classes(q), ((0, 0), (0, 0), (0, Lp - L), (0, 0), (0, 0))).reshape(B, dil, n_blk, BLOCK_Q, H, HD)

    def key_blocks(x):
        xp = jnp.pad(classes(x), ((0, 0), (0, 0), (n_prev * BLOCK_Q, Lp - L), (0, 0), (0, 0)))
        xp = xp.reshape(B, dil, n_blk + n_prev, BLOCK_Q, H, HD)
        return jnp.concatenate([xp[:, :, j:j + n_blk] for j in range(n_prev + 1)], axis=3)

    kb, vb = key_blocks(k), key_blocks(v)
    u_q = np.arange(Lp).reshape(n_blk, BLOCK_Q)
    u_k = (np.arange(n_blk)[:, None] - n_prev) * BLOCK_Q + np.arange((n_prev + 1) * BLOCK_Q)[None, :]
    delta = u_q[:, :, None] - u_k[:, None, :]
    mask = (delta >= 0) & (delta <= band) & (u_k[:, None, :] >= 0)
    s = jnp.einsum('brnqhd,brnkhd->brnhqk', qb, kb, preferred_element_type=jnp.float32) * (HEAD_DIM_A ** -0.5)
    s = jnp.where(mask[:, None], s, -jnp.inf)
    m = jnp.max(s, axis=-1, keepdims=True)
    p = jnp.exp(s - m)
    den = jnp.sum(p, axis=-1)
    o = jnp.einsum('brnhqk,brnkhd->brnqhd', p, vb.astype(jnp.float32)) / jnp.swapaxes(den, 3, 4)[..., None]
    lse = jnp.swapaxes(m[..., 0] + jnp.log(den), 3, 4)

    def positions(x):
        x = x.reshape((B, dil, Lp) + x.shape[4:])[:, :, :L]
        x = jnp.swapaxes(x, 1, 2)
        return x.reshape((B, S) + x.shape[3:])

    return positions(o), positions(lse)


def dilated_attn_sample(q, k_all, v_all, dil, band):
    T = q.shape[1]
    n_buf = k_all.shape[1] - T
    idx = n_buf + np.arange(T)[:, None] - dil * np.arange(band + 1)[None, :]
    valid = idx >= 0
    idx = np.maximum(idx, 0)
    kg, vg = k_all[:, idx], v_all[:, idx]
    s = jnp.einsum('bthd,btjhd->bthj', q, kg, preferred_element_type=jnp.float32) * (HEAD_DIM_A ** -0.5)
    s = jnp.where(valid[:, None, :], s, -jnp.inf)
    m = jnp.max(s, axis=-1, keepdims=True)
    p = jnp.exp(s - m)
    den = jnp.sum(p, axis=-1)
    o = jnp.einsum('bthj,btjhd->bthd', p, vg.astype(jnp.float32)) / den[..., None]
    return o, m[..., 0] + jnp.log(den)


def combine_groups(outs, lses, w_o, dtype):
    alpha = jax.nn.softmax(jnp.stack(lses, axis=-1), axis=-1)
    o = jnp.einsum('bshg,gbshd->bshd', alpha, jnp.stack(outs))
    B, S = o.shape[:2]
    return jnp.einsum('bse,ed->bsd', o.reshape(B, S, HEADS_A * HEAD_DIM_A).astype(dtype), w_o)


def attn_mixer_prompt(h, w_qkv, q_gain, k_gain, w_o):
    S = h.shape[1]
    q, k, v = attn_project(h, w_qkv, q_gain, k_gain, jnp.arange(S))
    outs, lses, bufs = [], [], []
    for g, (win, dil) in enumerate(DIL_PATTERNS):
        o_g, lse_g = dilated_attn_prompt(q[:, :, g], k[:, :, g], v[:, :, g], dil, win // dil)
        outs.append(o_g)
        lses.append(lse_g)
        n_keep = min(win, S)
        bufs.append(jnp.stack([k[:, S - n_keep:, g], v[:, S - n_keep:, g]], axis=2))
    return combine_groups(outs, lses, w_o, h.dtype), bufs


def attn_mixer_sample(h, bufs, w_qkv, q_gain, k_gain, w_o):
    T = h.shape[1]
    q, k, v = attn_project(h, w_qkv, q_gain, k_gain, PAST_LEN + jnp.arange(T))
    outs, lses, new_bufs = [], [], []
    for g, (win, dil) in enumerate(DIL_PATTERNS):
        n_buf = bufs[g].shape[1]
        kv_all = jnp.concatenate([bufs[g].astype(k.dtype), jnp.stack([k[:, :, g], v[:, :, g]], axis=2)], axis=1)
        o_g, lse_g = dilated_attn_sample(q[:, :, g], kv_all[:, :, 0], kv_all[:, :, 1], dil, win // dil)
        outs.append(o_g)
        lses.append(lse_g)
        new_bufs.append(kv_all[:, -n_buf:])
    return combine_groups(outs, lses, w_o, h.dtype), new_bufs


def mlstm_project(h, w_in, b_gates):
    B, S, _ = h.shape
    proj = jnp.einsum('bsd,de->bse', h, w_in)
    qk_w, v_w = HEADS_B * DQK_B, HEADS_B * DV_B
    q = proj[..., :qk_w].reshape(B, S, HEADS_B, DQK_B)
    k = proj[..., qk_w:2 * qk_w].reshape(B, S, HEADS_B, DQK_B) * (DQK_B ** -0.5)
    v = proj[..., 2 * qk_w:2 * qk_w + v_w].reshape(B, S, HEADS_B, DV_B)
    og = proj[..., 2 * qk_w + v_w:2 * qk_w + 2 * v_w]
    gates = proj[..., 2 * qk_w + 2 * v_w:].astype(jnp.float32) + b_gates.astype(jnp.float32)
    gates = GATE_CAP * jnp.tanh(gates / GATE_CAP)
    ig = jnp.swapaxes(gates[..., :HEADS_B], 1, 2)
    lf = jnp.swapaxes(jax.nn.log_sigmoid(gates[..., HEADS_B:]), 1, 2)

    def heads_first(x):
        return jnp.swapaxes(x, 1, 2).astype(jnp.float32)

    return heads_first(q), heads_first(k), heads_first(v), ig, lf, og


def mlstm_chunk(carry, inp):
    C, n, m = carry
    q, k, v, ig, lf = inp
    L = q.shape[2]
    b = jnp.cumsum(lf, axis=-1)
    causal = np.tril(np.ones((L, L), dtype=bool))
    Dm = jnp.where(causal, b[..., :, None] - b[..., None, :] + ig[..., None, :], -jnp.inf)
    inter = b + m[..., None]
    m_t = jnp.maximum(inter, jnp.max(Dm, axis=-1))
    w_inter = jnp.exp(inter - m_t)
    P = jnp.exp(Dm - m_t[..., None]) * jnp.einsum('bhtd,bhsd->bhts', q, k)
    num = w_inter[..., None] * jnp.einsum('bhed,bhtd->bhte', C, q) + jnp.einsum('bhts,bhse->bhte', P, v)
    den = w_inter * jnp.einsum('bhd,bhtd->bht', n, q) + jnp.sum(P, axis=-1)
    h = num / jnp.maximum(jnp.abs(den), jnp.exp(-m_t))[..., None]
    bL = b[..., -1]
    dec = bL[..., None] - b + ig
    m_new = jnp.maximum(bL + m, jnp.max(dec, axis=-1))
    wC = jnp.exp(bL + m - m_new)
    ws = jnp.exp(dec - m_new[..., None])
    C_new = wC[..., None, None] * C + jnp.einsum('bhs,bhse,bhsd->bhed', ws, v, k)
    n_new = wC[..., None] * n + jnp.einsum('bhs,bhsd->bhd', ws, k)
    return (C_new, n_new, m_new), h


def mlstm_output(hh, og, g_h, w_out, dtype):
    B, H, S, DV = hh.shape
    hh = jnp.swapaxes(hh, 1, 2)
    hn = hh * lax.rsqrt(jnp.mean(hh * hh, axis=-1, keepdims=True) + EPS)
    hn = hn.reshape(B, S, H * DV) * g_h.astype(jnp.float32) * jax.nn.sigmoid(og.astype(jnp.float32))
    return jnp.einsum('bse,ed->bsd', hn.astype(dtype), w_out)


def mlstm_mixer_prompt(h, w_in, b_gates, g_h, w_out):
    B, S, _ = h.shape
    q, k, v, ig, lf, og = mlstm_project(h, w_in, b_gates)
    n_chunks = S // CHUNK_B

    def chunks(x):
        return jnp.moveaxis(x.reshape(x.shape[:2] + (n_chunks, CHUNK_B) + x.shape[3:]), 2, 0)

    carry0 = (jnp.zeros((B, HEADS_B, DV_B, DQK_B), jnp.float32),
              jnp.zeros((B, HEADS_B, DQK_B), jnp.float32),
              jnp.zeros((B, HEADS_B), jnp.float32))
    (C, n, m), hs = lax.scan(mlstm_chunk, carry0, (chunks(q), chunks(k), chunks(v), chunks(ig), chunks(lf)))
    hh = jnp.moveaxis(hs, 0, 2).reshape(B, HEADS_B, S, DV_B)
    return mlstm_output(hh, og, g_h, w_out, h.dtype), C, n, m


def mlstm_mixer_sample(h, C0, n0, m0, w_in, b_gates, g_h, w_out):
    q, k, v, ig, lf, og = mlstm_project(h, w_in, b_gates)
    carry0 = (C0.astype(jnp.float32), n0.astype(jnp.float32), m0.astype(jnp.float32))
    (C, n, m), hh = mlstm_chunk(carry0, (q, k, v, ig, lf))
    return mlstm_output(hh, og, g_h, w_out, h.dtype), C, n, m


def conv_ffn(h, buf, w_up, conv_w, conv_b, w_down):
    T = h.shape[1]
    u = jnp.einsum('bsd,de->bse', h, w_up)
    ext = jnp.concatenate([buf.astype(u.dtype), u], axis=1)
    c = conv_b + conv_w[0] * ext[:, 0:T]
    for j in range(1, CONV_W):
        c = c + conv_w[j] * ext[:, j:j + T]
    a, b = jnp.split(c, 2, axis=-1)
    z = jax.nn.silu(a) * b
    return jnp.einsum('bsf,fd->bsd', z, w_down), ext[:, T:]


def setup_inputs(seed: int = 0) -> dict:
    key = jax.random.key(seed)
    ks = jax.random.split(key, 32)
    f32 = jnp.float32

    def normal(k, shape, scale=1.0):
        return scale * jax.random.normal(k, shape, f32)

    qkv_cols = N_GROUPS_A * 3 * HEADS_A * HEAD_DIM_A
    in_cols = 2 * HEADS_B * DQK_B + 2 * HEADS_B * DV_B + 2 * HEADS_B
    return {
        "x_prompt": normal(ks[0], (BATCH, SEQ, D_MODEL)),
        "x_sample": normal(ks[1], (DEC_BATCH, DEC_SEQ, D_MODEL)),
        "cache_kv_w128": normal(ks[2], (N_LAYERS_A, DEC_BATCH, min(DIL_PATTERNS[0][0], PAST_LEN), 2, HEADS_A, HEAD_DIM_A)),
        "cache_kv_w512": normal(ks[3], (N_LAYERS_A, DEC_BATCH, min(DIL_PATTERNS[1][0], PAST_LEN), 2, HEADS_A, HEAD_DIM_A)),
        "cache_kv_w2048": normal(ks[4], (N_LAYERS_A, DEC_BATCH, min(DIL_PATTERNS[2][0], PAST_LEN), 2, HEADS_A, HEAD_DIM_A)),
        "state_mlstm_C": normal(ks[5], (N_LAYERS_B, DEC_BATCH, HEADS_B, DV_B, DQK_B), 0.5),
        "state_mlstm_n": normal(ks[6], (N_LAYERS_B, DEC_BATCH, HEADS_B, DQK_B), 0.5),
        "state_mlstm_m": normal(ks[7], (N_LAYERS_B, DEC_BATCH, HEADS_B)),
        "state_ffn_conv": normal(ks[8], (DEPTH, DEC_BATCH, CONV_W - 1, 2 * D_FF)),
        "norm_mix": 1.0 + normal(ks[9], (DEPTH, D_MODEL), 0.02),
        "norm_ffn": 1.0 + normal(ks[10], (DEPTH, D_MODEL), 0.02),
        "attn_w_qkv": normal(ks[11], (N_LAYERS_A, D_MODEL, qkv_cols), D_MODEL ** -0.5),
        "attn_q_norm": 1.0 + normal(ks[12], (N_LAYERS_A, HEAD_DIM_A), 0.02),
        "attn_k_norm": 1.0 + normal(ks[13], (N_LAYERS_A, HEAD_DIM_A), 0.02),
        "attn_w_o": normal(ks[14], (N_LAYERS_A, HEADS_A * HEAD_DIM_A, D_MODEL), (HEADS_A * HEAD_DIM_A) ** -0.5),
        "mlstm_w_in": normal(ks[15], (N_LAYERS_B, D_MODEL, in_cols), D_MODEL ** -0.5),
        "mlstm_b_gates": jnp.concatenate([normal(ks[16], (N_LAYERS_B, HEADS_B), 0.1),
                                          3.0 + normal(ks[17], (N_LAYERS_B, HEADS_B), 0.5)], axis=-1),
        "mlstm_norm_h": 1.0 + normal(ks[18], (N_LAYERS_B, HEADS_B * DV_B), 0.02),
        "mlstm_w_out": normal(ks[19], (N_LAYERS_B, HEADS_B * DV_B, D_MODEL), (HEADS_B * DV_B) ** -0.5),
        "ffn_w_up": normal(ks[20], (DEPTH, D_MODEL, 2 * D_FF), D_MODEL ** -0.5),
        "ffn_conv_w": normal(ks[21], (DEPTH, CONV_W, 2 * D_FF), CONV_W ** -0.5),
        "ffn_conv_b": normal(ks[22], (DEPTH, 2 * D_FF), 0.02),
        "ffn_w_down": normal(ks[23], (DEPTH, D_FF, D_MODEL), D_FF ** -0.5),
    }


def reference(x_prompt, x_sample, cache_kv_w128, cache_kv_w512, cache_kv_w2048,
              state_mlstm_C, state_mlstm_n, state_mlstm_m, state_ffn_conv,
              norm_mix, norm_ffn, attn_w_qkv, attn_q_norm, attn_k_norm, attn_w_o,
              mlstm_w_in, mlstm_b_gates, mlstm_norm_h, mlstm_w_out,
              ffn_w_up, ffn_conv_w, ffn_conv_b, ffn_w_down):
    cache_kv = (cache_kv_w128, cache_kv_w512, cache_kv_w2048)
    xp, xs = x_prompt, x_sample
    kv_p = [[] for _ in DIL_PATTERNS]
    kv_s = [[] for _ in DIL_PATTERNS]
    C_p, n_p, m_p, C_s, n_s, m_s = [], [], [], [], [], []
    conv_p, conv_s = [], []
    for layer in range(DEPTH):
        hp = rms_norm(xp, norm_mix[layer])
        hs = rms_norm(xs, norm_mix[layer])
        if layer % N_MIXERS == 0:
            ia = layer // N_MIXERS
            yp, bufs_p = attn_mixer_prompt(hp, attn_w_qkv[ia], attn_q_norm[ia], attn_k_norm[ia], attn_w_o[ia])
            ys, bufs_s = attn_mixer_sample(hs, [c[ia] for c in cache_kv], attn_w_qkv[ia],
                                           attn_q_norm[ia], attn_k_norm[ia], attn_w_o[ia])
            for g in range(N_GROUPS_A):
                kv_p[g].append(bufs_p[g])
                kv_s[g].append(bufs_s[g])
        else:
            ib = layer // N_MIXERS
            yp, Cp, np_, mp = mlstm_mixer_prompt(hp, mlstm_w_in[ib], mlstm_b_gates[ib], mlstm_norm_h[ib], mlstm_w_out[ib])
            ys, Cs, ns, ms = mlstm_mixer_sample(hs, state_mlstm_C[ib], state_mlstm_n[ib], state_mlstm_m[ib],
                                                mlstm_w_in[ib], mlstm_b_gates[ib], mlstm_norm_h[ib], mlstm_w_out[ib])
            C_p.append(Cp); n_p.append(np_); m_p.append(mp)
            C_s.append(Cs); n_s.append(ns); m_s.append(ms)
        xp = xp + yp
        xs = xs + ys
        hp = rms_norm(xp, norm_ffn[layer])
        hs = rms_norm(xs, norm_ffn[layer])
        zero_buf = jnp.zeros((xp.shape[0], CONV_W - 1, 2 * D_FF), xp.dtype)
        yp, cp = conv_ffn(hp, zero_buf, ffn_w_up[layer], ffn_conv_w[layer], ffn_conv_b[layer], ffn_w_down[layer])
        ys, cs = conv_ffn(hs, state_ffn_conv[layer], ffn_w_up[layer], ffn_conv_w[layer], ffn_conv_b[layer], ffn_w_down[layer])
        conv_p.append(cp)
        conv_s.append(cs)
        xp = xp + yp
        xs = xs + ys
    dt = x_prompt.dtype
    kv_w128_prompt, kv_w512_prompt, kv_w2048_prompt = [jnp.stack(b) for b in kv_p]
    kv_w128_sample, kv_w512_sample, kv_w2048_sample = [jnp.stack(b) for b in kv_s]
    mlstm_C_prompt = jnp.stack(C_p).astype(dt)
    mlstm_n_prompt = jnp.stack(n_p).astype(dt)
    mlstm_m_prompt = jnp.stack(m_p).astype(dt)
    mlstm_C_sample = jnp.stack(C_s).astype(dt)
    mlstm_n_sample = jnp.stack(n_s).astype(dt)
    mlstm_m_sample = jnp.stack(m_s).astype(dt)
    ffn_conv_prompt = jnp.stack(conv_p)
    ffn_conv_sample = jnp.stack(conv_s)
    return (xp, xs, kv_w128_prompt, kv_w128_sample, kv_w512_prompt, kv_w512_sample,
            kv_w2048_prompt, kv_w2048_sample, mlstm_C_prompt, mlstm_C_sample,
            mlstm_n_prompt, mlstm_n_sample, mlstm_m_prompt, mlstm_m_sample,
            ffn_conv_prompt, ffn_conv_sample)
```

```cpp
#include <hip/hip_runtime.h>
#include <cstdio>
#include <cstdint>

#define LAS __attribute__((address_space(3)))
typedef unsigned short bf16_t;
typedef short bf16x8 __attribute__((ext_vector_type(8)));
typedef float f32x4 __attribute__((ext_vector_type(4)));
typedef float f32x2 __attribute__((ext_vector_type(2)));
typedef unsigned u32x4 __attribute__((ext_vector_type(4)));
typedef unsigned u32x2 __attribute__((ext_vector_type(2)));
typedef unsigned short u16x4 __attribute__((ext_vector_type(4)));

constexpr int DM = 2048, SEQ = 2048, NBP = 4, NBS = 8, TSAMP = 4, PAST = 16384;
constexpr int MP = NBP * SEQ, MSAMP = NBS * TSAMP, MR = MP + MSAMP, MT = 8448;
constexpr int NQKV = 9216, NIN = 6144, NIN_SRC = 6160, DFF = 5632, NUP = 2 * DFF, DO = 1024;
constexpr int DEPTH = 4;
constexpr float EPS = 1e-6f;
constexpr int NWAVES = 8, NTHR = 512;

constexpr size_t O_YP = 0;
constexpr size_t O_YS = O_YP + (size_t)MP * DM;
constexpr size_t O_KV128P = O_YS + (size_t)MSAMP * DM;
constexpr size_t O_KV128S = O_KV128P + (size_t)2 * NBP * 128 * 2048;
constexpr size_t O_KV512P = O_KV128S + (size_t)2 * NBS * 128 * 2048;
constexpr size_t O_KV512S = O_KV512P + (size_t)2 * NBP * 512 * 2048;
constexpr size_t O_KV2048P = O_KV512S + (size_t)2 * NBS * 512 * 2048;
constexpr size_t O_KV2048S = O_KV2048P + (size_t)2 * NBP * 2048 * 2048;
constexpr size_t O_CP = O_KV2048S + (size_t)2 * NBS * 2048 * 2048;
constexpr size_t O_CS = O_CP + (size_t)2 * NBP * 8 * 256 * 128;
constexpr size_t O_NP = O_CS + (size_t)2 * NBS * 8 * 256 * 128;
constexpr size_t O_NS = O_NP + (size_t)2 * NBP * 8 * 128;
constexpr size_t O_MP = O_NS + (size_t)2 * NBS * 8 * 128;
constexpr size_t O_MS = O_MP + (size_t)2 * NBP * 8;
constexpr size_t O_CONVP = O_MS + (size_t)2 * NBS * 8;
constexpr size_t O_CONVS = O_CONVP + (size_t)DEPTH * NBP * 2 * NUP;
constexpr size_t O_END = O_CONVS + (size_t)DEPTH * NBS * 2 * NUP;

constexpr size_t al1m(size_t x) { return (x + 1048575) & ~(size_t)1048575; }
constexpr size_t WS_CTL = 0, CTL_ZERO_BYTES = 1048576;
constexpr size_t SZ_WQKV = (size_t)NQKV * DM * 2, SZ_WO = (size_t)DM * DO * 2, SZ_WIN = (size_t)NIN * DM * 2, SZ_WOUT = (size_t)DM * DM * 2, SZ_WUP = (size_t)NUP * DM * 2, SZ_WDOWN = (size_t)DM * DFF * 2;
constexpr size_t WS_WQKV = al1m(WS_CTL + CTL_ZERO_BYTES);
constexpr size_t WS_WO = al1m(WS_WQKV + 2 * SZ_WQKV);
constexpr size_t WS_WIN = al1m(WS_WO + 2 * SZ_WO);
constexpr size_t WS_WOUT = al1m(WS_WIN + 2 * SZ_WIN);
constexpr size_t WS_WUP = al1m(WS_WOUT + 2 * SZ_WOUT);
constexpr size_t WS_WDOWN = al1m(WS_WUP + 4 * SZ_WUP);
constexpr size_t WS_X = al1m(WS_WDOWN + 4 * SZ_WDOWN);
constexpr size_t WS_H = al1m(WS_X + (size_t)MT * DM * 4);
constexpr size_t WS_QKV = al1m(WS_H + (size_t)MT * DM * 2);
constexpr size_t WS_OG = al1m(WS_QKV + (size_t)MT * NQKV * 2);
constexpr size_t WS_LSE = al1m(WS_OG + (size_t)MT * 3072 * 2);
constexpr size_t WS_OC = al1m(WS_LSE + (size_t)MT * 24 * 4);
constexpr size_t WS_GATES = al1m(WS_OC + (size_t)MT * DM * 2);
constexpr size_t WS_U = al1m(WS_GATES + (size_t)MT * 16 * 4);
constexpr size_t WS_Z = al1m(WS_U + (size_t)MT * NUP * 2);
constexpr size_t WS_END = al1m(WS_Z + (size_t)MT * DFF * 2);

constexpr int RING_BYTES = 131072;
constexpr int LDS_MISC_OFF = 150 * 1024;
constexpr int LDS_BYTES = 152 * 1024;

__device__ __forceinline__ unsigned f2bf(float f) { unsigned u = __builtin_bit_cast(unsigned, f); return (u + 0x7fffu + ((u >> 16) & 1u)) >> 16; }
__device__ __forceinline__ unsigned pk2(float lo, float hi) { return f2bf(lo) | (f2bf(hi) << 16); }
__device__ __forceinline__ float bflo(unsigned w) { return __builtin_bit_cast(float, w << 16); }
__device__ __forceinline__ float bfhi(unsigned w) { return __builtin_bit_cast(float, w & 0xffff0000u); }
__device__ __forceinline__ float bf1(bf16_t b) { return __builtin_bit_cast(float, (unsigned)b << 16); }
__device__ __forceinline__ float wave_sum(float v) {
#pragma unroll
    for (int o = 1; o < 64; o <<= 1) v += __shfl_xor(v, o);
    return v;
}
__device__ __forceinline__ float wave_max(float v) {
#pragma unroll
    for (int o = 1; o < 64; o <<= 1) v = fmaxf(v, __shfl_xor(v, o));
    return v;
}
__device__ __forceinline__ f32x4 mma16(bf16x8 a, bf16x8 b, f32x4 c) { return __builtin_amdgcn_mfma_f32_16x16x32_bf16(a, b, c, 0, 0, 0); }
__device__ __forceinline__ bf16x8 tr_read2(unsigned base, int off0, int off1) {
    u16x4 r0, r1;
    asm volatile("ds_read_b64_tr_b16 %0, %2 offset:%c3\n\tds_read_b64_tr_b16 %1, %2 offset:%c4\n\ts_waitcnt lgkmcnt(0)" : "=&v"(r0), "=&v"(r1) : "v"(base), "i"(off0), "i"(off1) : "memory");
    bf16x8 o; o[0] = (short)r0[0]; o[1] = (short)r0[1]; o[2] = (short)r0[2]; o[3] = (short)r0[3]; o[4] = (short)r1[0]; o[5] = (short)r1[1]; o[6] = (short)r1[2]; o[7] = (short)r1[3];
    return o;
}
__device__ __forceinline__ bf16x8 pack8(f32x4 a, f32x4 b) {
    u32x4 w; w.x = pk2(a[0], a[1]); w.y = pk2(a[2], a[3]); w.z = pk2(b[0], b[1]); w.w = pk2(b[2], b[3]);
    return __builtin_bit_cast(bf16x8, w);
}

namespace pg8 {
#define PG8_LAS __attribute__((address_space(3)))
typedef unsigned short bf16_t;
typedef short bf16x8 __attribute__((ext_vector_type(8)));
typedef float f32x4 __attribute__((ext_vector_type(4)));
typedef unsigned u32x4 __attribute__((ext_vector_type(4)));
constexpr int BM = 256, BK = 64, HALF = 128, HTB = HALF * BK * 2  , STAGE_BYTES = 8 * HTB, NXCD = 8, WGM = 8;

__host__ __device__ __forceinline__ int lds_byte(int r, int c) { const int st = (r >> 4) * 2 + (c >> 5), rr = r & 15, cc = c & 31, ob = rr * 64 + cc * 2; return st * 1024 + (ob ^ (((ob >> 9) & 1) << 5)); }
__host__ __device__ __forceinline__ void stage_rc(int b, int& R, int& C) { const int st = b / 1024, sb = b % 1024, swz = sb ^ (((sb >> 9) & 1) << 5); R = (st >> 1) * 16 + swz / 64; C = (st & 1) * 32 + (swz % 64) / 2; }
__host__ __device__ __forceinline__ int perm32(int rho) { const int n = rho >> 4, i = rho & 15; return 8 * (i >> 2) + 4 * n + (i & 3); }

struct Unit { int pm, pn; };
struct Gemm { const bf16_t* A; const bf16_t* Bt; int M, N, K; };

struct StaticOrder {
    int nM, nN, nwg, G, c;
    __host__ __device__ void init(int M, int N, int G_, int c_) { nM = M / BM; nN = N / BM; nwg = nM * nN; G = G_; c = c_; }
    __host__ __device__ bool next(int i, Unit& u) const {
        const long L = (long)i * G + c; if (L >= nwg) return false;
        int wgid = (int)L; { const int q = nwg / NXCD, r = nwg % NXCD, xcd = wgid % NXCD, off = wgid / NXCD; wgid = (xcd < r ? xcd * (q + 1) : r * (q + 1) + (xcd - r) * q) + off; }
        const int nig = WGM * nN, gid = wgid / nig, fm = gid * WGM, gsz = (nM - fm) < WGM ? (nM - fm) : WGM;
        u.pm = fm + ((wgid % nig) % gsz); u.pn = (wgid % nig) / gsz; return true;
    }
    __device__ __forceinline__ void a_ready(const Unit&) const {}
    __device__ __forceinline__ void done(const Unit&) const {}
};
__device__ __forceinline__ unsigned cvt_pk_bf16(float lo, float hi) { unsigned r; asm volatile("v_cvt_pk_bf16_f32 %0, %1, %2" : "=v"(r) : "v"(lo), "v"(hi)); return r; }

struct EpiStore {
    static constexpr bool PERM = true, AFTER_DRAIN = false;
    bf16_t* O; int ldc;
    __device__ __forceinline__ void operator()(const f32x4 (&acc)[2][2][4][2], const Unit& u, int wr, int wc, int fr, int fq) const {
        const int row0 = u.pm * BM + wr * 64 + fr, col0 = u.pn * BM + wc * 32 + 8 * fq;
#pragma unroll
        for (int ai = 0; ai < 2; ++ai)
#pragma unroll
            for (int m = 0; m < 4; ++m) { bf16_t* rowp = O + (size_t)(row0 + ai * HALF + m * 16) * ldc + col0;
#pragma unroll
                for (int bj = 0; bj < 2; ++bj) { const f32x4 v0 = acc[ai][bj][m][0], v1 = acc[ai][bj][m][1];
                    u32x4 w; w.x = cvt_pk_bf16(v0[0], v0[1]); w.y = cvt_pk_bf16(v0[2], v0[3]); w.z = cvt_pk_bf16(v1[0], v1[1]); w.w = cvt_pk_bf16(v1[2], v1[3]);
                    *(u32x4*)(rowp + bj * HALF) = w; } }
    }
};
struct EpiResid {
    static constexpr bool PERM = false, AFTER_DRAIN = false;
    const float* xin; float* out; int ldc; int mrows;
    __device__ __forceinline__ void operator()(const f32x4 (&acc)[2][2][4][2], const Unit& u, int wr, int wc, int fr, int fq) const {
        const int row0 = u.pm * BM + wr * 64 + fr, col0 = u.pn * BM + wc * 32 + 4 * fq;
#pragma unroll
        for (int ai = 0; ai < 2; ++ai)
#pragma unroll
            for (int m = 0; m < 4; ++m) { const int r = row0 + ai * HALF + m * 16;
                if (r < mrows) { const size_t off = (size_t)r * ldc + col0;
#pragma unroll
                    for (int bj = 0; bj < 2; ++bj)
#pragma unroll
                        for (int n = 0; n < 2; ++n) { const f32x4 bs = *(const f32x4*)(xin + off + bj * HALF + n * 16); *(f32x4*)(out + off + bj * HALF + n * 16) = bs + acc[ai][bj][m][n]; } }
                asm volatile("" ::: "memory"); }
    }
};

template <class Epi, class Sched, bool ALIGN_EPI = false, bool SP2 = false>
__device__ __forceinline__ void gemm_phase(PG8_LAS unsigned char* lds, const Gemm g, const Sched& S, const Epi& E) {
    int tid = threadIdx.x; asm volatile("" : "+v"(tid));
    const int wid = __builtin_amdgcn_readfirstlane(tid >> 6), lane = tid & 63, wr = wid >> 2, wc = wid & 3, fr = lane & 15, fq = lane >> 4;
    const int K = g.K, nt = K / BK;
    unsigned voffA[2], voffB[2];
#pragma unroll
    for (int i = 0; i < 2; ++i) { int R, C; stage_rc(tid * 16 + i * 8192, R, C); const int Rb = Epi::PERM ? ((R & ~31) + perm32(R & 31)) : R;
        voffA[i] = (unsigned)(R * K + C) * 2u; voffB[i] = (unsigned)(Rb * K + C) * 2u; }
    const size_t kstep = (size_t)(BK * 2);
    const size_t hstep = (size_t)HALF * K * 2;
    const size_t tstep = 2 * hstep;
    const unsigned ldsw = (unsigned)wid * 1024u;
    const int aoff = lds_byte(wr * 64 + fr, fq * 8), boff = lds_byte(wc * 32 + fr, fq * 8);
#define PG8_SA(b, h) (((b) * 2 + (h)) * HTB)
#define PG8_SB(b, h) ((4 + (b) * 2 + (h)) * HTB)
#define PG8_STAGE(bufoff, gbase, voff) do { _Pragma("unroll") for (int _i = 0; _i < 2; ++_i) \
        __builtin_amdgcn_global_load_lds((const unsigned*)((const char*)(gbase) + (voff)[_i]), (PG8_LAS unsigned*)(lds + (bufoff) + ldsw + _i * 8192), 16, 0, 0); } while (0)
#define PG8_LDA(dst, b, h) do { _Pragma("unroll") for (int m = 0; m < 4; ++m) _Pragma("unroll") for (int k = 0; k < 2; ++k) dst[m][k] = *(const PG8_LAS bf16x8*)(lds + PG8_SA(b, h) + aoff + m * 2048 + k * 1024); } while (0)
#define PG8_LDB(dst, b, h) do { _Pragma("unroll") for (int n = 0; n < 2; ++n) _Pragma("unroll") for (int k = 0; k < 2; ++k) dst[n][k] = *(const PG8_LAS bf16x8*)(lds + PG8_SB(b, h) + boff + n * 2048 + k * 1024); } while (0)
#define PG8_MMA(ai, bj, At, Bt) do { __builtin_amdgcn_s_setprio(1); _Pragma("unroll") for (int m = 0; m < 4; ++m) _Pragma("unroll") for (int n = 0; n < 2; ++n) _Pragma("unroll") for (int k = 0; k < 2; ++k) \
        acc[ai][bj][m][n] = __builtin_amdgcn_mfma_f32_16x16x32_bf16(Bt[n][k], At[m][k], acc[ai][bj][m][n], 0, 0, 0); __builtin_amdgcn_s_setprio(0); } while (0)
#define PG8_WAIT_V(n) asm volatile("s_waitcnt vmcnt(" #n ")" ::: "memory")
#define PG8_WAIT_L(n) asm volatile("s_waitcnt lgkmcnt(" #n ")" ::: "memory")
#define PG8_BAR __builtin_amdgcn_s_barrier()
#define PG8_SCHED __builtin_amdgcn_sched_barrier(0)
    Unit cur, nxt; int ui = 0;
    if (!S.next(0, cur)) return;
    f32x4 acc[2][2][4][2];
#pragma unroll
    for (int a = 0; a < 2; ++a)
#pragma unroll
        for (int b = 0; b < 2; ++b)
#pragma unroll
            for (int m = 0; m < 4; ++m)
#pragma unroll
                for (int n = 0; n < 2; ++n) acc[a][b][m][n] = (f32x4){0.f, 0.f, 0.f, 0.f};
    bf16x8 At[4][2], B0[2][2], B1[2][2];
    const char* cA = (const char*)g.A + (size_t)cur.pm * tstep; const char* cB = (const char*)g.Bt + (size_t)cur.pn * tstep;
    S.a_ready(cur);
    if constexpr (SP2) {
        PG8_STAGE(PG8_SB(0, 0), cB, voffB); PG8_STAGE(PG8_SB(0, 1), cB + hstep, voffB); PG8_STAGE(PG8_SA(0, 0), cA, voffA); PG8_STAGE(PG8_SA(0, 1), cA + hstep, voffA);
        if (wr == 1) PG8_BAR;
        PG8_WAIT_V(2); PG8_BAR;
        PG8_STAGE(PG8_SB(1, 0), cB + kstep, voffB); PG8_STAGE(PG8_SA(1, 0), cA + kstep, voffA); PG8_STAGE(PG8_SB(1, 1), cB + hstep + kstep, voffB);
        PG8_WAIT_V(6); PG8_BAR;
    } else {
        PG8_STAGE(PG8_SB(0, 0), cB, voffB); PG8_STAGE(PG8_SA(0, 0), cA, voffA); PG8_STAGE(PG8_SB(0, 1), cB + hstep, voffB); PG8_STAGE(PG8_SA(0, 1), cA + hstep, voffA);
        if (wr == 1) PG8_BAR;
        PG8_WAIT_V(4); PG8_BAR;
        PG8_STAGE(PG8_SB(1, 0), cB + kstep, voffB); PG8_STAGE(PG8_SA(1, 0), cA + kstep, voffA); PG8_STAGE(PG8_SB(1, 1), cB + hstep + kstep, voffB);
        PG8_WAIT_V(6); PG8_BAR;
    }
    for (;;) {
        const bool has_next = S.next(ui + 1, nxt);
        const char* nA = has_next ? (const char*)g.A + (size_t)nxt.pm * tstep : cA; const char* nB = has_next ? (const char*)g.Bt + (size_t)nxt.pn * tstep : cB;
        for (int t = 0; t < nt; t += 2) {
            const bool last = (t == nt - 2);
            const char* a1 = cA + (size_t)(t + 1) * kstep;
            const char* a2 = last ? nA : cA + (size_t)(t + 2) * kstep; const char* b2 = last ? nB : cB + (size_t)(t + 2) * kstep;
            const char* a3 = a2 + kstep; const char* b3 = b2 + kstep;
            if (last && has_next) S.a_ready(nxt);
            if constexpr (SP2) {
            PG8_LDB(B0, 0, 0); PG8_LDB(B1, 0, 1); PG8_SCHED; PG8_LDA(At, 0, 0); PG8_STAGE(PG8_SA(1, 1), a1 + hstep, voffA);
            PG8_WAIT_V(8); PG8_WAIT_L(0); PG8_BAR; PG8_MMA(0, 0, At, B0); PG8_MMA(0, 1, At, B1); PG8_BAR; PG8_SCHED;
            PG8_LDA(At, 0, 1); PG8_STAGE(PG8_SB(0, 0), b2, voffB); PG8_STAGE(PG8_SB(0, 1), b2 + hstep, voffB); PG8_STAGE(PG8_SA(0, 0), a2, voffA);
            PG8_WAIT_V(8); PG8_WAIT_L(0); PG8_BAR; PG8_MMA(1, 0, At, B0); PG8_MMA(1, 1, At, B1); PG8_BAR; PG8_SCHED;
            PG8_LDB(B0, 1, 0); PG8_LDB(B1, 1, 1); PG8_SCHED; PG8_LDA(At, 1, 0); PG8_STAGE(PG8_SA(0, 1), a2 + hstep, voffA);
            PG8_WAIT_V(8); PG8_WAIT_L(0); PG8_BAR; PG8_MMA(0, 0, At, B0); PG8_MMA(0, 1, At, B1); PG8_BAR; PG8_SCHED;
            PG8_LDA(At, 1, 1); PG8_STAGE(PG8_SB(1, 0), b3, voffB); PG8_STAGE(PG8_SB(1, 1), b3 + hstep, voffB); PG8_STAGE(PG8_SA(1, 0), a3, voffA);
            PG8_WAIT_V(8); PG8_WAIT_L(0); PG8_BAR; PG8_MMA(1, 0, At, B0); PG8_MMA(1, 1, At, B1); PG8_BAR; PG8_SCHED;
            } else {
            PG8_LDB(B0, 0, 0); PG8_SCHED; PG8_LDA(At, 0, 0); PG8_STAGE(PG8_SA(1, 1), a1 + hstep, voffA);
            PG8_WAIT_L(8); PG8_BAR; PG8_WAIT_L(0); PG8_MMA(0, 0, At, B0); PG8_BAR; PG8_SCHED;
            PG8_LDB(B1, 0, 1); PG8_STAGE(PG8_SB(0, 0), b2, voffB);
            PG8_BAR; PG8_WAIT_L(0); PG8_MMA(0, 1, At, B1); PG8_BAR;
            PG8_LDA(At, 0, 1); PG8_STAGE(PG8_SA(0, 0), a2, voffA);
            PG8_BAR; PG8_WAIT_L(0); PG8_MMA(1, 0, At, B0); PG8_BAR; PG8_SCHED;
            PG8_STAGE(PG8_SB(0, 1), b2 + hstep, voffB);
            PG8_WAIT_V(6); PG8_BAR; PG8_MMA(1, 1, At, B1); PG8_BAR;
            PG8_LDB(B0, 1, 0); PG8_SCHED; PG8_LDA(At, 1, 0); PG8_STAGE(PG8_SA(0, 1), a2 + hstep, voffA);
            PG8_WAIT_L(8); PG8_BAR; PG8_WAIT_L(0); PG8_MMA(0, 0, At, B0); PG8_BAR; PG8_SCHED;
            PG8_LDB(B1, 1, 1); PG8_STAGE(PG8_SB(1, 0), b3, voffB);
            PG8_BAR; PG8_WAIT_L(0); PG8_MMA(0, 1, At, B1); PG8_BAR;
            PG8_LDA(At, 1, 1); PG8_STAGE(PG8_SA(1, 0), a3, voffA);
            PG8_BAR; PG8_WAIT_L(0); PG8_MMA(1, 0, At, B0); PG8_BAR; PG8_SCHED;
            PG8_STAGE(PG8_SB(1, 1), b3 + hstep, voffB);
            PG8_WAIT_V(6); PG8_BAR; PG8_MMA(1, 1, At, B1); PG8_BAR;
            }
        }
        if constexpr (ALIGN_EPI) { if (wr == 0) PG8_BAR; }
        if constexpr (!Epi::AFTER_DRAIN) { E(acc, cur, wr, wc, fr, fq); S.done(cur); }
        if (!has_next) break;
#pragma unroll
        for (int a = 0; a < 2; ++a)
#pragma unroll
            for (int b = 0; b < 2; ++b)
#pragma unroll
                for (int m = 0; m < 4; ++m)
#pragma unroll
                    for (int n = 0; n < 2; ++n) acc[a][b][m][n] = (f32x4){0.f, 0.f, 0.f, 0.f};
        cur = nxt; cA = nA; cB = nB; ++ui;
        if constexpr (ALIGN_EPI) { if (wr == 1) PG8_BAR; }
    }
    PG8_WAIT_V(0);
    if constexpr (!ALIGN_EPI) { if (wr == 0) PG8_BAR; }
    PG8_BAR;
    if constexpr (Epi::AFTER_DRAIN) { E.fused(acc, cur, wr, wc, fr, fq, lds, wid, lane); S.done(cur); }
#undef PG8_SA
#undef PG8_SB
#undef PG8_STAGE
#undef PG8_LDA
#undef PG8_LDB
#undef PG8_MMA
#undef PG8_WAIT_V
#undef PG8_WAIT_L
#undef PG8_BAR
#undef PG8_SCHED
}
}
#define XB_TMO      128
#define XB_XCNT(j)  (256  + 64 * (j))
#define XB_XSUB(j)  (1280 + 64 * (j))
#define XB_XGEN(j)  (2304 + 64 * (j))
#define XB_TOP      3328
#define XB_TOPGEN   3392
#define XCD_BAR_WORDS 3456
#define XB_SPIN_CAP (1u << 18)

__device__ __forceinline__ unsigned xb_ld(unsigned* p)              { return __hip_atomic_load(p, __ATOMIC_RELAXED, __HIP_MEMORY_SCOPE_AGENT); }
__device__ __forceinline__ unsigned xb_add(unsigned* p, unsigned v) { return __hip_atomic_fetch_add(p, v, __ATOMIC_RELAXED, __HIP_MEMORY_SCOPE_AGENT); }
__device__ __forceinline__ unsigned xb_xcc_id() { return (unsigned)__builtin_amdgcn_s_getreg((3 << 11) | 20) & 0xFu; }
#define XB_SPIN(cond, bar) do { unsigned _sp = 0; while (cond) { __builtin_amdgcn_s_sleep(1); \
    if ((++_sp & 255u) == 0u) { if (xb_ld(&(bar)[XB_TMO])) break; if (_sp > XB_SPIN_CAP) { atomicAdd(&(bar)[XB_TMO], 1u); break; } } } } while (0)

struct XcdBarrier {
    unsigned* bar; unsigned x;
    volatile LAS unsigned* st;
};

__device__ __forceinline__ XcdBarrier xcd_barrier_post(unsigned* bar, volatile LAS unsigned* st) {
    XcdBarrier b; b.bar = bar; b.x = xb_xcc_id(); b.st = st;
    if (threadIdx.x == 0) (void)xb_add(&bar[XB_XCNT(b.x)], 1u);
    return b;
}
__device__ __forceinline__ void xcd_barrier_complete(unsigned* bar, unsigned x, unsigned& nloc, unsigned& nx) {
    const unsigned G = gridDim.x * gridDim.y * gridDim.z;
    unsigned sum, cnt, mine, sp = 0u;
    for (;;) {
        sum = 0u; cnt = 0u; mine = 0u;
#pragma unroll
        for (unsigned j = 0; j < 16; ++j) { const unsigned c = xb_ld(&bar[XB_XCNT(j)]); sum += c; cnt += (c > 0u) ? 1u : 0u; mine = (j == x) ? c : mine; }
        if (sum == G) break;
        __builtin_amdgcn_s_sleep(1);
        if ((++sp & 255u) == 0u) { if (xb_ld(&bar[XB_TMO])) break; if (sp > XB_SPIN_CAP) { atomicAdd(&bar[XB_TMO], 1u); break; } }
    }
    nloc = mine > 0u ? mine : 1u; nx = cnt > 0u ? cnt : 1u;
}

__device__ __forceinline__ void xcd_barrier(const XcdBarrier& b) {
    asm volatile("s_waitcnt vmcnt(0)" ::: "memory");
    __syncthreads();
    if (threadIdx.x == 0) {
        unsigned* bar = b.bar;
        __builtin_amdgcn_s_waitcnt(0);
        unsigned nloc = b.st[0], nx = b.st[1];
        if (nloc == 0u) { xcd_barrier_complete(bar, b.x, nloc, nx); b.st[0] = nloc; b.st[1] = nx; }
        const unsigned old = xb_add(&bar[XB_XSUB(b.x)], 1u);
        const unsigned gen = old / nloc;
        if (old + 1u == (gen + 1u) * nloc) {
            __builtin_amdgcn_fence(__ATOMIC_RELEASE, "agent");
            asm volatile("s_waitcnt vmcnt(0)" ::: "memory");
            const unsigned og = xb_add(&bar[XB_TOP], 1u);
            const unsigned tg = og / nx;
            if (og + 1u == (tg + 1u) * nx) xb_add(&bar[XB_TOPGEN], 1u);
            else XB_SPIN(xb_ld(&bar[XB_TOPGEN]) == tg, bar);
            __builtin_amdgcn_fence(__ATOMIC_ACQUIRE, "agent");
            xb_add(&bar[XB_XGEN(b.x)], 1u);
            asm volatile("s_waitcnt vmcnt(0)" ::: "memory");
        } else {
            XB_SPIN(xb_ld(&bar[XB_XGEN(b.x)]) == gen, bar);
            __builtin_amdgcn_fence(__ATOMIC_ACQUIRE, "agent");
            asm volatile("s_waitcnt vmcnt(0)" ::: "memory");
        }
    }
    __syncthreads();
}

struct Params { const float* in[23]; float* out; unsigned char* ws; };

__device__ __forceinline__ void p0_transpose_item(const float* W, int ldw, int K, int N, bf16_t* WT, LAS float* scr, int item, int lane, float scale) {
    const int nblk = N / 32, kb = item / nblk, nb = item % nblk, k0 = 64 * kb, n0 = 32 * nb;
#pragma unroll 8
    for (int i = 0; i < 32; ++i) { const int kk = 2 * i + (lane >> 5); scr[kk * 33 + (lane & 31)] = W[(size_t)(k0 + kk) * ldw + n0 + (lane & 31)] * scale; }
    asm volatile("s_waitcnt lgkmcnt(0)" ::: "memory");
    const int c = lane & 7;
#pragma unroll
    for (int j = 0; j < 4; ++j) { const int n = (lane >> 3) + 8 * j; const LAS float* s = scr + (8 * c) * 33 + n;
        u32x4 o; o.x = pk2(s[0 * 33], s[1 * 33]); o.y = pk2(s[2 * 33], s[3 * 33]); o.z = pk2(s[4 * 33], s[5 * 33]); o.w = pk2(s[6 * 33], s[7 * 33]);
        *(u32x4*)(WT + (size_t)(n0 + n) * K + k0 + 8 * c) = o; }
    asm volatile("s_waitcnt lgkmcnt(0)" ::: "memory");
}

__device__ __forceinline__ void phase_prologue(const Params& P, LAS unsigned char* lds, int gw, int NGW, int wave, int lane, int gtid, int NGT) {
    LAS float* scr = (LAS float*)(lds + wave * 16384);
    constexpr int I_QKV = (DM / 64) * (NQKV / 32), I_WO = (DO / 64) * (DM / 32), I_WIN = (DM / 64) * (NIN / 32), I_WOUT = (DM / 64) * (DM / 32), I_WUP = (DM / 64) * (NUP / 32), I_WDN = (DFF / 64) * (DM / 32);
    constexpr int T0 = 2 * I_QKV, T1 = T0 + 2 * I_WO, T2 = T1 + 2 * I_WIN, T3 = T2 + 2 * I_WOUT, T4 = T3 + 4 * I_WUP, T5 = T4 + 4 * I_WDN;
    unsigned char* ws = P.ws;
    for (int it = gw; it < T5; it += NGW) {
        if (it < T0) { const int l = it / I_QKV, r = it % I_QKV; p0_transpose_item(P.in[11] + (size_t)l * DM * NQKV, NQKV, DM, NQKV, (bf16_t*)(ws + WS_WQKV + l * SZ_WQKV), scr, r, lane, 1.f); }
        else if (it < T1) { const int q = it - T0, l = q / I_WO, r = q % I_WO; p0_transpose_item(P.in[14] + (size_t)l * DO * DM, DM, DO, DM, (bf16_t*)(ws + WS_WO + l * SZ_WO), scr, r, lane, 1.f); }
        else if (it < T2) { const int q = it - T1, l = q / I_WIN, r = q % I_WIN; const int nb = r % (NIN / 32);
            const float sc = (nb >= 32 && nb < 64) ? 0.08838834764831845f : 1.f;
            p0_transpose_item(P.in[15] + (size_t)l * DM * NIN_SRC, NIN_SRC, DM, NIN, (bf16_t*)(ws + WS_WIN + l * SZ_WIN), scr, r, lane, sc); }
        else if (it < T3) { const int q = it - T2, l = q / I_WOUT, r = q % I_WOUT; p0_transpose_item(P.in[18] + (size_t)l * DM * DM, DM, DM, DM, (bf16_t*)(ws + WS_WOUT + l * SZ_WOUT), scr, r, lane, 1.f); }
        else if (it < T4) { const int q = it - T3, l = q / I_WUP, r = q % I_WUP; p0_transpose_item(P.in[19] + (size_t)l * DM * NUP, NUP, DM, NUP, (bf16_t*)(ws + WS_WUP + l * SZ_WUP), scr, r, lane, 1.f); }
        else { const int q = it - T4, l = q / I_WDN, r = q % I_WDN; p0_transpose_item(P.in[22] + (size_t)l * DFF * DM, DM, DFF, DM, (bf16_t*)(ws + WS_WDOWN + l * SZ_WDOWN), scr, r, lane, 1.f); }
    }
    f32x4* X4 = (f32x4*)(ws + WS_X);
    const f32x4* xp = (const f32x4*)P.in[0]; const f32x4* xs = (const f32x4*)P.in[1];
    for (int i = gtid; i < MR * (DM / 4); i += NGT) X4[i] = (i < MP * (DM / 4)) ? xp[i] : xs[i - MP * (DM / 4)];
}

__device__ __forceinline__ void phase_rms(const float* X, const float* g, bf16_t* H, int gw, int NGW, int lane) {
    for (int r = gw; r < MR; r += NGW) {
        const f32x4* xr = (const f32x4*)(X + (size_t)r * DM) + lane;
        f32x4 v[8]; float s = 0.f;
#pragma unroll
        for (int j = 0; j < 8; ++j) { v[j] = xr[64 * j]; s += (v[j].x * v[j].x + v[j].y * v[j].y) + (v[j].z * v[j].z + v[j].w * v[j].w); }
        const float rstd = rsqrtf(wave_sum(s) * (1.f / DM) + EPS);
        u32x2* o = (u32x2*)(H + (size_t)r * DM) + lane;
#pragma unroll
        for (int j = 0; j < 8; ++j) { const f32x4 gv = ((const f32x4*)g)[lane + 64 * j]; u32x2 w; w.x = pk2(v[j].x * rstd * gv.x, v[j].y * rstd * gv.y); w.y = pk2(v[j].z * rstd * gv.z, v[j].w * rstd * gv.w); o[64 * j] = w; }
    }
}

__device__ __forceinline__ void gate_task(const float* X, const float* gnorm, const float* Win, const float* bg, float* GATES, int task, int lane) {
    const int r0 = task * 16, i16 = lane & 15, kq = lane >> 4;
    const float* xr = X + (size_t)(r0 + i16) * DM + 4 * kq;
    const float* wp = Win + (size_t)(4 * kq) * NIN_SRC + NIN + i16;
    f32x4 acc = {0.f, 0.f, 0.f, 0.f}; float ss = 0.f;
#pragma unroll 4
    for (int kb = 0; kb < 128; ++kb) {
        const f32x4 xv = *(const f32x4*)(xr + 16 * kb);
        const f32x4 gv = *(const f32x4*)(gnorm + 16 * kb + 4 * kq);
        ss += (xv.x * xv.x + xv.y * xv.y) + (xv.z * xv.z + xv.w * xv.w);
        const float* w = wp + (size_t)(16 * kb) * NIN_SRC;
        acc = __builtin_amdgcn_mfma_f32_16x16x4f32(xv.x, gv.x * w[0], acc, 0, 0, 0);
        acc = __builtin_amdgcn_mfma_f32_16x16x4f32(xv.y, gv.y * w[NIN_SRC], acc, 0, 0, 0);
        acc = __builtin_amdgcn_mfma_f32_16x16x4f32(xv.z, gv.z * w[2 * NIN_SRC], acc, 0, 0, 0);
        acc = __builtin_amdgcn_mfma_f32_16x16x4f32(xv.w, gv.w * w[3 * NIN_SRC], acc, 0, 0, 0);
    }
    ss += __shfl_xor(ss, 16); ss += __shfl_xor(ss, 32);
    const float rstd = rsqrtf(ss * (1.f / DM) + EPS);
    const float bias = bg[i16];
#pragma unroll
    for (int i = 0; i < 4; ++i) {
        const float rs = __shfl(rstd, 4 * kq + i);
        const float pre = acc[i] * rs + bias;
        const float gc = 15.f * tanhf(pre * (1.f / 15.f));
        const float val = (i16 < 8) ? gc : (fminf(gc, 0.f) - log1pf(expf(-fabsf(gc))));
        GATES[(size_t)(r0 + 4 * kq + i) * 16 + i16] = val;
    }
}

__device__ __forceinline__ void prep_row(bf16_t* QKV, const float* qg, const float* kg, float* out, int ia, int r, int lane) {
    const int hh = lane >> 3, sub = lane & 7;
    const bool samp = r >= MP;
    const int b = samp ? ((r - MP) >> 2) : (r >> 11), s = samp ? ((r - MP) & 3) : (r & 2047), pos = samp ? PAST + s : s;
    float cs[8], sn[8];
#pragma unroll
    for (int j = 0; j < 8; ++j) { const float invf = powf(10000.f, -(float)(8 * sub + j) * (1.f / 64.f)); const float ang = (float)pos * invf; sincosf(ang, &sn[j], &cs[j]); }
#pragma unroll 1
    for (int g = 0; g < 3; ++g) {
        const int win = 128 << (2 * g);
#pragma unroll
        for (int t = 0; t < 3; ++t) {
            bf16_t* p = QKV + (size_t)r * NQKV + ((g * 3 + t) * 8 + hh) * 128;
            const u32x4 w0 = *(const u32x4*)(p + 8 * sub), w1 = *(const u32x4*)(p + 64 + 8 * sub);
            float x1[8], x2[8];
            x1[0] = bflo(w0.x); x1[1] = bfhi(w0.x); x1[2] = bflo(w0.y); x1[3] = bfhi(w0.y); x1[4] = bflo(w0.z); x1[5] = bfhi(w0.z); x1[6] = bflo(w0.w); x1[7] = bfhi(w0.w);
            x2[0] = bflo(w1.x); x2[1] = bfhi(w1.x); x2[2] = bflo(w1.y); x2[3] = bfhi(w1.y); x2[4] = bflo(w1.z); x2[5] = bfhi(w1.z); x2[6] = bflo(w1.w); x2[7] = bfhi(w1.w);
            if (t < 2) {
                float ss = 0.f;
#pragma unroll
                for (int j = 0; j < 8; ++j) ss += x1[j] * x1[j] + x2[j] * x2[j];
                ss += __shfl_xor(ss, 1); ss += __shfl_xor(ss, 2); ss += __shfl_xor(ss, 4);
                const float rstd = rsqrtf(ss * (1.f / 128.f) + EPS);
                const float* gn = (t == 0) ? qg : kg;
#pragma unroll
                for (int j = 0; j < 8; ++j) { const float y1 = x1[j] * rstd * gn[8 * sub + j], y2 = x2[j] * rstd * gn[64 + 8 * sub + j];
                    x1[j] = y1 * cs[j] - y2 * sn[j]; x2[j] = y2 * cs[j] + y1 * sn[j]; }
                u32x4 o0, o1;
                o0.x = pk2(x1[0], x1[1]); o0.y = pk2(x1[2], x1[3]); o0.z = pk2(x1[4], x1[5]); o0.w = pk2(x1[6], x1[7]);
                o1.x = pk2(x2[0], x2[1]); o1.y = pk2(x2[2], x2[3]); o1.z = pk2(x2[4], x2[5]); o1.w = pk2(x2[6], x2[7]);
                *(u32x4*)(p + 8 * sub) = o0; *(u32x4*)(p + 64 + 8 * sub) = o1;
            }
            if (t >= 1) {
                const int kv = t - 1;
                const size_t obase = (g == 0) ? (samp ? O_KV128S : O_KV128P) : (g == 1) ? (samp ? O_KV512S : O_KV512P) : (samp ? O_KV2048S : O_KV2048P);
                const int j = samp ? (win - TSAMP + s) : (s - (SEQ - win));
                if (j >= 0) {
                    const int nb = samp ? NBS : NBP;
                    float* dst = out + obase + ((((size_t)(ia * nb + b) * win + j) * 2 + kv) * 8 + hh) * 128;
                    *(f32x4*)(dst + 8 * sub) = (f32x4){x1[0], x1[1], x1[2], x1[3]}; *(f32x4*)(dst + 8 * sub + 4) = (f32x4){x1[4], x1[5], x1[6], x1[7]};
                    *(f32x4*)(dst + 64 + 8 * sub) = (f32x4){x2[0], x2[1], x2[2], x2[3]}; *(f32x4*)(dst + 64 + 8 * sub + 4) = (f32x4){x2[4], x2[5], x2[6], x2[7]};
                }
            }
        }
    }
}

constexpr int AT_PITCH = 272, AT_KOFF = 0, AT_VOFF = 256 * AT_PITCH;
__device__ __forceinline__ void attn_item(LAS unsigned char* lds, unsigned lds_base, const bf16_t* QKV, bf16_t* OG, float* LSE, int item, int tid, int wave, int lane) {
    const int g = item >> 9, rem = item & 511, b = rem >> 7, h = (rem >> 4) & 7, idx = rem & 15;
    const int dil = (g == 0) ? 1 : (g == 1) ? 4 : 16;
    const int r = (g == 0) ? 0 : (g == 1) ? (idx >> 2) : idx;
    const int qb = (g == 0) ? idx : (g == 1) ? (idx & 3) : 0;
    const int cq = (g * 3 * 8 + h) * 128, ck = cq + 1024, cv = cq + 2048;
    const size_t rowbase = (size_t)b * SEQ + r;
    const int uk0 = 128 * (qb - 1);
    const int i16 = lane & 15, q4 = lane >> 4, qq = i16 >> 2, p = lane & 3;
#pragma unroll
    for (int i = 0; i < 8; ++i) {
        const int id = tid + 512 * i, kk = id >> 4, ch = id & 15, u = uk0 + kk;
        u32x4 kvv = {0u, 0u, 0u, 0u}, vvv = {0u, 0u, 0u, 0u};
        if (u >= 0) { const bf16_t* src = QKV + (rowbase + (size_t)u * dil) * NQKV + 8 * ch; kvv = *(const u32x4*)(src + ck); vvv = *(const u32x4*)(src + cv); }
        *(LAS u32x4*)(lds + AT_KOFF + kk * AT_PITCH + ch * 16) = kvv;
        *(LAS u32x4*)(lds + AT_VOFF + kk * AT_PITCH + ch * 16) = vvv;
    }
    const int tqa = 16 * wave + i16;
    const size_t grow = rowbase + (size_t)(128 * qb + tqa) * dil;
    bf16x8 Qf[4];
#pragma unroll
    for (int ks = 0; ks < 4; ++ks) Qf[ks] = *(const bf16x8*)(QKV + grow * NQKV + cq + 32 * ks + 8 * q4);
    __syncthreads();
    const int cb0 = wave & ~1;
    f32x4 S[10];
#pragma unroll
    for (int c = 0; c < 10; ++c) {
        f32x4 acc = {0.f, 0.f, 0.f, 0.f};
#pragma unroll
        for (int ks = 0; ks < 4; ++ks) { const bf16x8 kf = *(const LAS bf16x8*)(lds + AT_KOFF + (16 * (cb0 + c) + i16) * AT_PITCH + (32 * ks + 8 * q4) * 2); acc = mma16(kf, Qf[ks], acc); }
        S[c] = acc;
    }
    const float sc = 0.08838834764831845f * 1.4426950408889634f;
    float mx = -INFINITY;
#pragma unroll
    for (int c = 0; c < 10; ++c)
#pragma unroll
        for (int i = 0; i < 4; ++i) { const int kk = 16 * (cb0 + c) + 4 * q4 + i; const bool ok = (kk >= tqa) && (kk <= tqa + 128) && (qb > 0 || kk >= 128);
            const float s = ok ? S[c][i] * sc : -INFINITY; S[c][i] = s; mx = fmaxf(mx, s); }
    mx = fmaxf(mx, __shfl_xor(mx, 16)); mx = fmaxf(mx, __shfl_xor(mx, 32));
    float l = 0.f;
#pragma unroll
    for (int c = 0; c < 10; ++c)
#pragma unroll
        for (int i = 0; i < 4; ++i) { const float pv = exp2f(S[c][i] - mx); S[c][i] = pv; l += pv; }
    l += __shfl_xor(l, 16); l += __shfl_xor(l, 32);
    bf16x8 Pf[5];
#pragma unroll
    for (int kst = 0; kst < 5; ++kst) Pf[kst] = pack8(S[2 * kst], S[2 * kst + 1]);
    const float inv = 1.f / l;
    bf16_t* orow = OG + grow * 3072 + g * 1024 + h * 128 + 4 * q4;
    const unsigned vbase = lds_base + AT_VOFF + (16 * cb0 + 4 * q4 + qq) * AT_PITCH + 8 * p;
#pragma unroll
    for (int eb = 0; eb < 8; ++eb) {
        f32x4 acc = {0.f, 0.f, 0.f, 0.f};
#pragma unroll
        for (int kst = 0; kst < 5; ++kst) {
            const bf16x8 vf = tr_read2(vbase, 32 * kst * AT_PITCH + 32 * eb, (32 * kst + 16) * AT_PITCH + 32 * eb);
            acc = mma16(vf, Pf[kst], acc);
        }
        u32x2 w; w.x = pk2(acc[0] * inv, acc[1] * inv); w.y = pk2(acc[2] * inv, acc[3] * inv);
        *(u32x2*)(orow + 16 * eb) = w;
    }
    if (q4 == 0) LSE[grow * 24 + g * 8 + h] = (mx + log2f(l)) * 0.6931471805599453f;
    __syncthreads();
}

__device__ __forceinline__ void attn_sample_task(LAS unsigned char* wl  , const bf16_t* QKV, const float* c128, const float* c512, const float* c2048, bf16_t* OG, float* LSE, int ia, int wt, int lane) {
    const int bs = wt / 96, rem = wt % 96, g = rem >> 5, h = (rem >> 2) & 7, t = rem & 3;
    const int win = 128 << (2 * g), dil = 1 << (2 * g);
    const float* cache = ((g == 0) ? c128 : (g == 1) ? c512 : c2048) + (size_t)(ia * NBS + bs) * win * 2048;
    const int cq = (g * 3 * 8 + h) * 128, ck = cq + 1024, cv = cq + 2048;
    const size_t rq = (size_t)MP + bs * 4 + t;
    LAS float* qs = (LAS float*)wl; LAS float* ps = (LAS float*)(wl + 512);
    { const unsigned w = *(const unsigned*)(QKV + rq * NQKV + cq + 2 * lane); qs[2 * lane] = bflo(w); qs[2 * lane + 1] = bfhi(w); }
    asm volatile("s_waitcnt lgkmcnt(0)" ::: "memory");
    float sv[3];
#pragma unroll
    for (int pass = 0; pass < 3; ++pass) {
        const int j = pass * 64 + lane; float s = -INFINITY;
        if (j <= 128) {
            const int idx = win + t - dil * j; float acc = 0.f;
            if (idx >= win) { const bf16_t* kp = QKV + ((size_t)MP + bs * 4 + (idx - win)) * NQKV + ck;
                for (int d = 0; d < 128; d += 8) { const u32x4 w = *(const u32x4*)(kp + d); const LAS float* q = qs + d;
                    acc += q[0] * bflo(w.x) + q[1] * bfhi(w.x) + q[2] * bflo(w.y) + q[3] * bfhi(w.y) + q[4] * bflo(w.z) + q[5] * bfhi(w.z) + q[6] * bflo(w.w) + q[7] * bfhi(w.w); } }
            else { const float* kp = cache + ((size_t)idx * 2 + 0) * 1024 + h * 128;
                for (int d = 0; d < 128; d += 4) { const f32x4 kx = *(const f32x4*)(kp + d); const LAS float* q = qs + d; acc += q[0] * kx.x + q[1] * kx.y + q[2] * kx.z + q[3] * kx.w; } }
            s = acc * 0.08838834764831845f;
        }
        sv[pass] = s;
    }
    const float mx = wave_max(fmaxf(fmaxf(sv[0], sv[1]), sv[2]));
    float l = 0.f;
#pragma unroll
    for (int pass = 0; pass < 3; ++pass) { const float pv = expf(sv[pass] - mx); l += pv; ps[pass * 64 + lane] = pv; }
    l = wave_sum(l);
    asm volatile("s_waitcnt lgkmcnt(0)" ::: "memory");
    float o0 = 0.f, o1 = 0.f;
#pragma unroll 4
    for (int j = 0; j <= 128; ++j) {
        const int idx = win + t - dil * j; const float pj = ps[j]; float v0, v1;
        if (idx >= win) { const unsigned w = *(const unsigned*)(QKV + ((size_t)MP + bs * 4 + (idx - win)) * NQKV + cv + 2 * lane); v0 = bflo(w); v1 = bfhi(w); }
        else { const f32x2 vx = *(const f32x2*)(cache + ((size_t)idx * 2 + 1) * 1024 + h * 128 + 2 * lane); v0 = vx.x; v1 = vx.y; }
        o0 += pj * v0; o1 += pj * v1;
    }
    const float inv = 1.f / l;
    *(unsigned*)(OG + rq * 3072 + g * 1024 + h * 128 + 2 * lane) = pk2(o0 * inv, o1 * inv);
    if (lane == 0) LSE[rq * 24 + g * 8 + h] = mx + logf(l);
}

__device__ __forceinline__ void combine_row(const bf16_t* OG, const float* LSE, bf16_t* OC, int r, int lane) {
    const int hh = lane >> 3;
    const float l0 = LSE[(size_t)r * 24 + hh], l1 = LSE[(size_t)r * 24 + 8 + hh], l2 = LSE[(size_t)r * 24 + 16 + hh];
    const float mx = fmaxf(l0, fmaxf(l1, l2));
    float e0 = expf(l0 - mx), e1 = expf(l1 - mx), e2 = expf(l2 - mx);
    const float inv = 1.f / (e0 + e1 + e2); e0 *= inv; e1 *= inv; e2 *= inv;
    const bf16_t* src = OG + (size_t)r * 3072 + 16 * lane;
#pragma unroll
    for (int c = 0; c < 2; ++c) {
        const u32x4 a = *(const u32x4*)(src + 8 * c), bq = *(const u32x4*)(src + 1024 + 8 * c), cc = *(const u32x4*)(src + 2048 + 8 * c);
        u32x4 o;
        o.x = pk2(e0 * bflo(a.x) + e1 * bflo(bq.x) + e2 * bflo(cc.x), e0 * bfhi(a.x) + e1 * bfhi(bq.x) + e2 * bfhi(cc.x));
        o.y = pk2(e0 * bflo(a.y) + e1 * bflo(bq.y) + e2 * bflo(cc.y), e0 * bfhi(a.y) + e1 * bfhi(bq.y) + e2 * bfhi(cc.y));
        o.z = pk2(e0 * bflo(a.z) + e1 * bflo(bq.z) + e2 * bflo(cc.z), e0 * bfhi(a.z) + e1 * bfhi(bq.z) + e2 * bfhi(cc.z));
        o.w = pk2(e0 * bflo(a.w) + e1 * bflo(bq.w) + e2 * bflo(cc.w), e0 * bfhi(a.w) + e1 * bfhi(bq.w) + e2 * bfhi(cc.w));
        *(u32x4*)(OC + (size_t)r * DO + 16 * lane + 8 * c) = o;
    }
}

__device__ __forceinline__ float scan_sum(float v, int lane) {
#pragma unroll
    for (int o = 1; o < 64; o <<= 1) { const float t = __shfl_up(v, o); if (lane >= o) v += t; }
    return v;
}
__device__ __forceinline__ float scan_max(float v, int lane) {
#pragma unroll
    for (int o = 1; o < 64; o <<= 1) { const float t = __shfl_up(v, o); if (lane >= o) v = fmaxf(v, t); }
    return v;
}
constexpr int ML_QP = 272, ML_VP = 528, ML_PP = 144;
constexpr int ML_Q = 0, ML_K = ML_Q + 64 * ML_QP, ML_V = ML_K + 64 * ML_QP, ML_KW = ML_V + 64 * ML_VP, ML_P = ML_KW + 64 * ML_QP, ML_PART = ML_P + 64 * ML_PP, ML_N = ML_PART + 64 * 32, ML_DEN = ML_N + 512, ML_END = ML_DEN + 256;
__device__ __forceinline__ void mlstm_prompt(LAS unsigned char* lds, unsigned lds_base, const bf16_t* QKVO, const float* GATES, const float* gh, bf16_t* HN, float* out, int ib, int bh, int tid, int wave, int lane) {
    const int b = bh >> 3, h = bh & 7;
    const int i16 = lane & 15, q4 = lane >> 4, qq = i16 >> 2, p = lane & 3;
    f32x4 CT[2][8];
#pragma unroll
    for (int a = 0; a < 2; ++a)
#pragma unroll
        for (int d = 0; d < 8; ++d) CT[a][d] = (f32x4){0.f, 0.f, 0.f, 0.f};
    float m = 0.f;
    const unsigned vbase = lds_base + ML_V + (8 * q4 + qq) * ML_VP + (32 * wave + 4 * p) * 2, kwbase = lds_base + ML_KW + (8 * q4 + qq) * ML_QP + 8 * p;
    LAS float* nS = (LAS float*)(lds + ML_N); LAS float* denS = (LAS float*)(lds + ML_DEN);
    __syncthreads();
    if (tid < 128) nS[tid] = 0.f;
    const float ghv0 = gh[h * 256 + 32 * wave + i16], ghv1 = gh[h * 256 + 32 * wave + 16 + i16];
#pragma unroll 1
    for (int c = 0; c < 32; ++c) {
        const size_t r0 = (size_t)b * SEQ + 64 * c;
#pragma unroll
        for (int i = 0; i < 2; ++i) { const int id = tid + 512 * i, row = id >> 4, ch = id & 15; const bf16_t* src = QKVO + (r0 + row) * NIN + h * 128 + 8 * ch;
            *(LAS u32x4*)(lds + ML_Q + row * ML_QP + ch * 16) = *(const u32x4*)(src);
            *(LAS u32x4*)(lds + ML_K + row * ML_QP + ch * 16) = *(const u32x4*)(src + 1024); }
#pragma unroll
        for (int i = 0; i < 4; ++i) { const int id = tid + 512 * i, row = id >> 5, ch = id & 31;
            *(LAS u32x4*)(lds + ML_V + row * ML_VP + ch * 16) = *(const u32x4*)(QKVO + (r0 + row) * NIN + 2048 + h * 256 + 8 * ch); }
        const float ig = GATES[(r0 + lane) * 16 + h], lf = GATES[(r0 + lane) * 16 + 8 + h];
        const float bcum = scan_sum(lf, lane);
        const float av = ig - bcum;
        const float Av = fmaxf(m, scan_max(av, lane));
        const float bL = __shfl(bcum, 63), A63 = __shfl(Av, 63);
        const float wsv = expf(av - A63), wC = expf(m - A63);
        __syncthreads();
#pragma unroll
        for (int i = 0; i < 2; ++i) { const int id = lane + 64 * i, rr = 8 * wave + (id >> 4), ch = id & 15;
            const u32x4 kx = *(const LAS u32x4*)(lds + ML_K + rr * ML_QP + ch * 16); const float w = __shfl(wsv, rr);
            u32x4 o; o.x = pk2(bflo(kx.x) * w, bfhi(kx.x) * w); o.y = pk2(bflo(kx.y) * w, bfhi(kx.y) * w); o.z = pk2(bflo(kx.z) * w, bfhi(kx.z) * w); o.w = pk2(bflo(kx.w) * w, bfhi(kx.w) * w);
            *(LAS u32x4*)(lds + ML_KW + rr * ML_QP + ch * 16) = o; }
        { const int rb = wave >> 1;
#pragma unroll
          for (int cc = 0; cc < 2; ++cc) { const int cb = 2 * (wave & 1) + cc;
            f32x4 s = {0.f, 0.f, 0.f, 0.f};
            if (cb <= rb) {
#pragma unroll
                for (int ks = 0; ks < 4; ++ks) { const bf16x8 af = *(const LAS bf16x8*)(lds + ML_Q + (16 * rb + i16) * ML_QP + (32 * ks + 8 * q4) * 2);
                    const bf16x8 bf = *(const LAS bf16x8*)(lds + ML_K + (16 * cb + i16) * ML_QP + (32 * ks + 8 * q4) * 2); s = mma16(af, bf, s); } }
            const int sidx = 16 * cb + i16; const float as = __shfl(av, sidx);
#pragma unroll
            for (int i = 0; i < 4; ++i) { const int t = 16 * rb + 4 * q4 + i; const float At = __shfl(Av, t);
                const float pv = (sidx <= t && cb <= rb) ? s[i] * expf(as - At) : 0.f;
                *(LAS bf16_t*)(lds + ML_P + t * ML_PP + sidx * 2) = (bf16_t)f2bf(pv); } } }
        __syncthreads();
        { const int t = tid >> 3, part = tid & 7;
          const LAS unsigned char* qrow = lds + ML_Q + t * ML_QP + part * 32;
          const u32x4 qa = *(const LAS u32x4*)(qrow), qb = *(const LAS u32x4*)(qrow + 16);
          const LAS float* nn = nS + 16 * part;
          float a = nn[0] * bflo(qa.x) + nn[1] * bfhi(qa.x) + nn[2] * bflo(qa.y) + nn[3] * bfhi(qa.y) + nn[4] * bflo(qa.z) + nn[5] * bfhi(qa.z) + nn[6] * bflo(qa.w) + nn[7] * bfhi(qa.w)
                  + nn[8] * bflo(qb.x) + nn[9] * bfhi(qb.x) + nn[10] * bflo(qb.y) + nn[11] * bfhi(qb.y) + nn[12] * bflo(qb.z) + nn[13] * bfhi(qb.z) + nn[14] * bflo(qb.w) + nn[15] * bfhi(qb.w);
          const u32x4 pr = *(const LAS u32x4*)(lds + ML_P + t * ML_PP + part * 16);
          const float rsum = ((bflo(pr.x) + bfhi(pr.x)) + (bflo(pr.y) + bfhi(pr.y))) + ((bflo(pr.z) + bfhi(pr.z)) + (bflo(pr.w) + bfhi(pr.w)));
          const int tl = t & 63; const float At = __shfl(Av, tl), bt = __shfl(bcum, tl);
          float val = expf(m - At) * a + rsum;
          val += __shfl_xor(val, 1); val += __shfl_xor(val, 2); val += __shfl_xor(val, 4);
          if (part == 0) denS[t] = 1.f / fmaxf(fabsf(val), expf(-(bt + At))); }
        f32x4 num[2][4];
#pragma unroll
        for (int a = 0; a < 2; ++a)
#pragma unroll
            for (int rb2 = 0; rb2 < 4; ++rb2) num[a][rb2] = (f32x4){0.f, 0.f, 0.f, 0.f};
#pragma unroll
        for (int ks = 0; ks < 4; ++ks) {
            bf16x8 Af[4];
#pragma unroll
            for (int rb2 = 0; rb2 < 4; ++rb2) { const LAS unsigned char* qrow = lds + ML_Q + (16 * rb2 + i16) * ML_QP;
                const u32x2 lo = *(const LAS u32x2*)(qrow + (32 * ks + 4 * q4) * 2), hi = *(const LAS u32x2*)(qrow + (32 * ks + 16 + 4 * q4) * 2);
                u32x4 w; w.x = lo.x; w.y = lo.y; w.z = hi.x; w.w = hi.y; Af[rb2] = __builtin_bit_cast(bf16x8, w); }
#pragma unroll
            for (int a = 0; a < 2; ++a) { const bf16x8 Bf = pack8(CT[a][2 * ks], CT[a][2 * ks + 1]);
#pragma unroll
                for (int rb2 = 0; rb2 < 4; ++rb2) num[a][rb2] = mma16(Af[rb2], Bf, num[a][rb2]); }
        }
#pragma unroll
        for (int rb2 = 0; rb2 < 4; ++rb2)
#pragma unroll
            for (int i = 0; i < 4; ++i) { const float wi = expf(m - __shfl(Av, 16 * rb2 + 4 * q4 + i)); num[0][rb2][i] *= wi; num[1][rb2][i] *= wi; }
        bf16x8 Vf[2][2];
#pragma unroll
        for (int a = 0; a < 2; ++a)
#pragma unroll
            for (int ks = 0; ks < 2; ++ks) Vf[a][ks] = tr_read2(vbase, 32 * ks * ML_VP + 32 * a, (32 * ks + 4) * ML_VP + 32 * a);
#pragma unroll
        for (int ks = 0; ks < 2; ++ks)
#pragma unroll
            for (int rb2 = 0; rb2 < 4; ++rb2) { const bf16x8 pf = *(const LAS bf16x8*)(lds + ML_P + (16 * rb2 + i16) * ML_PP + (32 * ks + 8 * q4) * 2);
                num[0][rb2] = mma16(pf, Vf[0][ks], num[0][rb2]); num[1][rb2] = mma16(pf, Vf[1][ks], num[1][rb2]); }
#pragma unroll
        for (int rb2 = 0; rb2 < 4; ++rb2)
#pragma unroll
            for (int i = 0; i < 4; ++i) { const int t = 16 * rb2 + 4 * q4 + i;
                float sq = num[0][rb2][i] * num[0][rb2][i] + num[1][rb2][i] * num[1][rb2][i]; sq += __shfl_xor(sq, 1); sq += __shfl_xor(sq, 2); sq += __shfl_xor(sq, 4); sq += __shfl_xor(sq, 8);
                if (i16 == 0) *(LAS float*)(lds + ML_PART + t * 32 + wave * 4) = sq; }
#pragma unroll
        for (int a = 0; a < 2; ++a)
#pragma unroll
            for (int d = 0; d < 8; ++d) CT[a][d] = CT[a][d] * wC;
#pragma unroll
        for (int ks = 0; ks < 2; ++ks)
#pragma unroll
            for (int d = 0; d < 8; ++d) { const bf16x8 kf = tr_read2(kwbase, 32 * ks * ML_QP + 32 * d, (32 * ks + 4) * ML_QP + 32 * d);
                CT[0][d] = mma16(kf, Vf[0][ks], CT[0][d]); CT[1][d] = mma16(kf, Vf[1][ks], CT[1][d]); }
        __syncthreads();
        { const bf16_t* ogp = QKVO + (r0 + 4 * q4) * NIN + 4096 + h * 256 + 32 * wave + i16; bf16_t* hnp = HN + (r0 + 4 * q4) * DM + h * 256 + 32 * wave + i16;
#pragma unroll
          for (int rb2 = 0; rb2 < 4; ++rb2) {
#pragma unroll
            for (int i = 0; i < 4; ++i) { const int t = 16 * rb2 + 4 * q4 + i;
                const f32x4 s0 = *(const LAS f32x4*)(lds + ML_PART + t * 32), s1 = *(const LAS f32x4*)(lds + ML_PART + t * 32 + 16);
                const float idn = denS[t];
                const float tot = (((s0.x + s0.y) + (s0.z + s0.w)) + ((s1.x + s1.y) + (s1.z + s1.w))) * idn * idn;
                const float rs = rsqrtf(tot * (1.f / 256.f) + EPS) * idn;
                const int ro = 16 * rb2 + i;
                const float og0 = bf1(ogp[ro * NIN]), og1 = bf1(ogp[ro * NIN + 16]);
                hnp[ro * DM] = (bf16_t)f2bf(num[0][rb2][i] * rs * ghv0 / (1.f + expf(-og0)));
                hnp[ro * DM + 16] = (bf16_t)f2bf(num[1][rb2][i] * rs * ghv1 / (1.f + expf(-og1))); }
            asm volatile("" ::: "memory"); } }
        if (tid < 128) { float acc = wC * nS[tid];
#pragma unroll 8
            for (int s = 0; s < 64; ++s) acc += bf1(*(const LAS bf16_t*)(lds + ML_KW + s * ML_QP + tid * 2));
            nS[tid] = acc; }
        m = bL + A63;
    }
    const size_t sb = (size_t)(ib * NBP + b) * 8 + h;
#pragma unroll
    for (int a = 0; a < 2; ++a)
#pragma unroll
        for (int d = 0; d < 8; ++d) { const int e = 32 * wave + 16 * a + i16; *(f32x4*)(out + O_CP + (sb * 256 + e) * 128 + 16 * d + 4 * q4) = CT[a][d]; }
    if (tid < 128) out[O_NP + sb * 128 + tid] = nS[tid];
    if (tid == 0) out[O_MP + sb] = m;
}

__device__ __forceinline__ void mlstm_sample(LAS unsigned char* lds, const bf16_t* QKVO, const float* GATES, const float* gh, const float* C0all, const float* n0all, const float* m0all, bf16_t* HN, float* out, int ib, int bh, int tid, int wave, int lane) {
    const int bs = bh >> 3, h = bh & 7;
    const size_t sb = (size_t)(ib * NBS + bs) * 8 + h;
    LAS float* qs = (LAS float*)lds;
    LAS float* ks = qs + 512;
    LAS float* ns = ks + 512;
    LAS float* Ss = ns + 128;
    LAS float* nq = Ss + 16;
    LAS float* red = nq + 16;
    const size_t r0 = (size_t)MP + bs * 4;
    __syncthreads();
    { const int t = tid >> 7, d = tid & 127; qs[tid] = bf1(QKVO[(r0 + t) * NIN + h * 128 + d]); ks[tid] = bf1(QKVO[(r0 + t) * NIN + 1024 + h * 128 + d]); if (tid < 128) ns[tid] = n0all[sb * 128 + tid]; }
    __syncthreads();
    if (wave == 0) {
        if (lane < 16) { const int t = lane >> 2, s = lane & 3; float a = 0.f; for (int d = 0; d < 128; ++d) a += qs[t * 128 + d] * ks[s * 128 + d]; Ss[lane] = a; }
        else if (lane < 20) { const int t = lane - 16; float a = 0.f; for (int d = 0; d < 128; ++d) a += ns[d] * qs[t * 128 + d]; nq[t] = a; }
    }
    __syncthreads();
    const float m0 = m0all[sb];
    float bc[4], av[4], Av[4];
    { float run = 0.f, pm = -INFINITY;
#pragma unroll
      for (int t = 0; t < 4; ++t) { const float ig = GATES[(r0 + t) * 16 + h], lf = GATES[(r0 + t) * 16 + 8 + h]; run += lf; bc[t] = run; av[t] = ig - run; pm = fmaxf(pm, av[t]); Av[t] = fmaxf(m0, pm); } }
    const float A3 = Av[3], wC = expf(m0 - A3);
    float Pm[4][4], den[4];
#pragma unroll
    for (int t = 0; t < 4; ++t) { float rs = 0.f;
#pragma unroll
        for (int s = 0; s < 4; ++s) { Pm[t][s] = (s <= t) ? Ss[t * 4 + s] * expf(av[s] - Av[t]) : 0.f; rs += Pm[t][s]; }
        den[t] = expf(m0 - Av[t]) * nq[t] + rs; }
    const int e = tid >> 1, hf = tid & 1;
    const float* Crow = C0all + (sb * 256 + e) * 128 + 64 * hf;
    f32x4 Cv[16];
#pragma unroll
    for (int j = 0; j < 16; ++j) Cv[j] = *(const f32x4*)(Crow + 4 * j);
    float inter[4];
#pragma unroll
    for (int t = 0; t < 4; ++t) { float a = 0.f; const LAS float* q = qs + t * 128 + 64 * hf;
#pragma unroll
        for (int j = 0; j < 16; ++j) a += Cv[j].x * q[4 * j] + Cv[j].y * q[4 * j + 1] + Cv[j].z * q[4 * j + 2] + Cv[j].w * q[4 * j + 3];
        a += __shfl_xor(a, 1); inter[t] = a; }
    float vv[4];
#pragma unroll
    for (int s = 0; s < 4; ++s) vv[s] = bf1(QKVO[(r0 + s) * NIN + 2048 + h * 256 + e]);
    float hv[4];
#pragma unroll
    for (int t = 0; t < 4; ++t) { float nu = expf(m0 - Av[t]) * inter[t];
#pragma unroll
        for (int s = 0; s < 4; ++s) nu += Pm[t][s] * vv[s];
        hv[t] = nu / fmaxf(fabsf(den[t]), expf(-(bc[t] + Av[t])));
        float sq = (hf == 0) ? hv[t] * hv[t] : 0.f; sq = wave_sum(sq); if (lane == 0) red[t * 8 + wave] = sq; }
    __syncthreads();
    if (hf == 0) {
#pragma unroll
        for (int t = 0; t < 4; ++t) { float tot = 0.f;
#pragma unroll
            for (int w = 0; w < 8; ++w) tot += red[t * 8 + w];
            const float rs = rsqrtf(tot * (1.f / 256.f) + EPS);
            const float og = bf1(QKVO[(r0 + t) * NIN + 4096 + h * 256 + e]);
            HN[(r0 + t) * DM + h * 256 + e] = (bf16_t)f2bf(hv[t] * rs * gh[h * 256 + e] / (1.f + expf(-og))); } }
    float wv[4];
#pragma unroll
    for (int s = 0; s < 4; ++s) wv[s] = expf(av[s] - A3) * vv[s];
    float* Cout = out + O_CS + (sb * 256 + e) * 128 + 64 * hf;
#pragma unroll
    for (int j = 0; j < 16; ++j) { f32x4 o = Cv[j] * wC;
#pragma unroll
        for (int s = 0; s < 4; ++s) { const LAS float* k = ks + s * 128 + 64 * hf + 4 * j; o.x += wv[s] * k[0]; o.y += wv[s] * k[1]; o.z += wv[s] * k[2]; o.w += wv[s] * k[3]; }
        *(f32x4*)(Cout + 4 * j) = o; }
    if (tid < 128) { float o = wC * ns[tid];
#pragma unroll
        for (int s = 0; s < 4; ++s) o += expf(av[s] - A3) * ks[s * 128 + tid];
        out[O_NS + sb * 128 + tid] = o; }
    if (tid == 0) out[O_MS + sb] = bc[3] + A3;
}

__device__ __forceinline__ void cache_shift(const Params& P, float* outp, int ia, int w, int NW, int lane) {
    constexpr int N0 = NBS * 124, N1 = NBS * 508, N2 = NBS * 2044;
    for (int it = w; it < N0 + N1 + N2; it += NW) {
        int g, q; if (it < N0) { g = 0; q = it; } else if (it < N0 + N1) { g = 1; q = it - N0; } else { g = 2; q = it - N0 - N1; }
        const int win = 128 << (2 * g), per = win - 4, bs = q / per, j = q % per;
        const float* src = P.in[2 + g] + ((size_t)(ia * NBS + bs) * win + j + 4) * 2048;
        float* dst = outp + ((g == 0) ? O_KV128S : (g == 1) ? O_KV512S : O_KV2048S) + ((size_t)(ia * NBS + bs) * win + j) * 2048;
#pragma unroll
        for (int i = 0; i < 8; ++i) ((f32x4*)dst)[lane + 64 * i] = ((const f32x4*)src)[lane + 64 * i];
    }
}

__device__ __forceinline__ void unpack8(const u32x4 w, float (&x)[8]) { x[0] = bflo(w.x); x[1] = bfhi(w.x); x[2] = bflo(w.y); x[3] = bfhi(w.y); x[4] = bflo(w.z); x[5] = bfhi(w.z); x[6] = bflo(w.w); x[7] = bfhi(w.w); }
__device__ __forceinline__ void load8(const float* p, float (&x)[8]) { const f32x4 a = *(const f32x4*)p, b = *(const f32x4*)(p + 4); x[0] = a.x; x[1] = a.y; x[2] = a.z; x[3] = a.w; x[4] = b.x; x[5] = b.y; x[6] = b.z; x[7] = b.w; }
__device__ __forceinline__ void store8(float* p, const float (&x)[8]) { *(f32x4*)p = (f32x4){x[0], x[1], x[2], x[3]}; *(f32x4*)(p + 4) = (f32x4){x[4], x[5], x[6], x[7]}; }
__device__ __forceinline__ void phase_convgate(const Params& P, float* outp, const bf16_t* U, bf16_t* Z, int layer, int gtid, int NGT) {
    constexpr int NCG = DFF / 8, NRUN = MP / 64 + NBS;
    const float* cw = P.in[20] + (size_t)layer * 3 * NUP; const float* cbias = P.in[21] + (size_t)layer * NUP;
    for (int task = gtid; task < NCG * NRUN; task += NGT) {
        const int cg = task % NCG, run = task / NCG, j0 = 8 * cg;
        float wa[3][8], wb[3][8], ba[8], bb[8];
#pragma unroll
        for (int k = 0; k < 3; ++k) { load8(cw + (size_t)k * NUP + j0, wa[k]); load8(cw + (size_t)k * NUP + DFF + j0, wb[k]); }
        load8(cbias + j0, ba); load8(cbias + DFF + j0, bb);
        float a2[8], a1[8], b2[8], b1[8];
        size_t row0; int nrows; float* cout;
        if (run < MP / 64) { const int b = run >> 5, s0 = (run & 31) * 64; row0 = (size_t)b * SEQ + s0; nrows = 64;
            cout = (s0 == SEQ - 64) ? outp + O_CONVP + ((size_t)(layer * NBP + b) * 2) * NUP : nullptr;
            if (s0 == 0) {
#pragma unroll
                for (int j = 0; j < 8; ++j) { a2[j] = 0.f; a1[j] = 0.f; b2[j] = 0.f; b1[j] = 0.f; } }
            else { unpack8(*(const u32x4*)(U + (row0 - 2) * NUP + j0), a2); unpack8(*(const u32x4*)(U + (row0 - 1) * NUP + j0), a1);
                   unpack8(*(const u32x4*)(U + (row0 - 2) * NUP + DFF + j0), b2); unpack8(*(const u32x4*)(U + (row0 - 1) * NUP + DFF + j0), b1); } }
        else { const int bs = run - MP / 64; row0 = (size_t)MP + bs * 4; nrows = 4;
            cout = outp + O_CONVS + ((size_t)(layer * NBS + bs) * 2) * NUP;
            const float* st = P.in[8] + ((size_t)(layer * NBS + bs) * 2) * NUP;
            load8(st + j0, a2); load8(st + NUP + j0, a1); load8(st + DFF + j0, b2); load8(st + NUP + DFF + j0, b1); }
        for (int t = 0; t < nrows; ++t) {
            float a0[8], b0[8];
            unpack8(*(const u32x4*)(U + (row0 + t) * NUP + j0), a0); unpack8(*(const u32x4*)(U + (row0 + t) * NUP + DFF + j0), b0);
            float z[8];
#pragma unroll
            for (int j = 0; j < 8; ++j) { const float ca = ba[j] + wa[0][j] * a2[j] + wa[1][j] * a1[j] + wa[2][j] * a0[j]; const float cb = bb[j] + wb[0][j] * b2[j] + wb[1][j] * b1[j] + wb[2][j] * b0[j];
                z[j] = ca / (1.f + expf(-ca)) * cb; a2[j] = a1[j]; a1[j] = a0[j]; b2[j] = b1[j]; b1[j] = b0[j]; }
            u32x4 o; o.x = pk2(z[0], z[1]); o.y = pk2(z[2], z[3]); o.z = pk2(z[4], z[5]); o.w = pk2(z[6], z[7]);
            *(u32x4*)(Z + (row0 + t) * DFF + j0) = o;
        }
        if (cout) { store8(cout + j0, a2); store8(cout + NUP + j0, a1); store8(cout + DFF + j0, b2); store8(cout + NUP + DFF + j0, b1); }
    }
}

__global__ void __launch_bounds__(NTHR, 2) fwd_kernel(Params P) {
    extern __shared__ __attribute__((aligned(16))) unsigned char lds_raw[];
    LAS unsigned char* lds = (LAS unsigned char*)lds_raw;
    const unsigned lds_base = (unsigned)(size_t)lds;
    const int tid0 = threadIdx.x;
    const int G0 = gridDim.x, bx0 = blockIdx.x;
#define PHASE_IDS int tid = tid0; asm volatile("" : "+v"(tid)); int zz_ = 0; asm volatile("" : "+v"(zz_)); zz_ = __builtin_amdgcn_readfirstlane(zz_); const int bx = bx0 + zz_, G = G0 + zz_; unsigned char* ws = P.ws + zz_; float* outp = P.out + zz_; \
    const int lane = tid & 63, wave = __builtin_amdgcn_readfirstlane(tid >> 6); const int gw = bx * NWAVES + wave, gtid = bx * NTHR + tid, NGW = G * NWAVES, NGT = G * NTHR; (void)gw; (void)gtid; (void)lane; (void)NGW; (void)NGT; (void)outp; \
    float* X = (float*)(ws + WS_X); bf16_t* H = (bf16_t*)(ws + WS_H); bf16_t* QKV = (bf16_t*)(ws + WS_QKV); bf16_t* OG = (bf16_t*)(ws + WS_OG); float* LSE = (float*)(ws + WS_LSE); bf16_t* OC = (bf16_t*)(ws + WS_OC); \
    float* GATES = (float*)(ws + WS_GATES); bf16_t* U = (bf16_t*)(ws + WS_U); bf16_t* Z = (bf16_t*)(ws + WS_Z); (void)X; (void)H; (void)QKV; (void)OG; (void)LSE; (void)OC; (void)GATES; (void)U; (void)Z;
    volatile LAS unsigned* misc = (volatile LAS unsigned*)(lds + LDS_MISC_OFF);
    if (tid0 < 16) misc[tid0] = 0u;
    __syncthreads();
    { const XcdBarrier bar0 = xcd_barrier_post((unsigned*)(P.ws + WS_CTL) + 1024, misc + 8); if (tid0 == 0) misc[10] = bar0.x; }
    __syncthreads();
#define GRID_BAR() do { XcdBarrier bar_; bar_.bar = (unsigned*)(P.ws + WS_CTL) + 1024; bar_.x = (unsigned)__builtin_amdgcn_readfirstlane((int)misc[10]); bar_.st = misc + 8; xcd_barrier(bar_); } while (0)

    { PHASE_IDS; phase_prologue(P, lds, gw, NGW, wave, lane, gtid, NGT); }
    GRID_BAR();

#define LAYER_PAIR(lp) do { \
        { \
            const int L = 2 * lp, ia = lp; \
            { PHASE_IDS; phase_rms(X, P.in[9] + (size_t)L * DM, H, gw, NGW, lane); } \
            GRID_BAR(); \
            { PHASE_IDS; pg8::Gemm g{H, (const bf16_t*)(ws + WS_WQKV + ia * SZ_WQKV), MT, NQKV, DM}; pg8::StaticOrder S; S.init(MT, NQKV, G, bx); \
              pg8::EpiStore E{QKV, NQKV}; \
              pg8::gemm_phase<pg8::EpiStore, pg8::StaticOrder, true, true>(lds, g, S, E); } \
            GRID_BAR(); \
            { PHASE_IDS; for (int r = gw; r < MR; r += NGW) prep_row(QKV, P.in[12] + ia * 128, P.in[13] + ia * 128, outp, ia, r, lane); } \
            GRID_BAR(); \
            { PHASE_IDS; for (int it = bx; it < 1536; it += G) attn_item(lds, lds_base, QKV, OG, LSE, it, tid, wave, lane); } \
            { PHASE_IDS; if (gw < NBS * 96) attn_sample_task(lds + wave * 2048, QKV, P.in[2], P.in[3], P.in[4], OG, LSE, ia, gw, lane); } \
            GRID_BAR(); \
            { PHASE_IDS; for (int r = gw; r < MR; r += NGW) combine_row(OG, LSE, OC, r, lane); } \
            GRID_BAR(); \
            { PHASE_IDS; pg8::Gemm g{OC, (const bf16_t*)(ws + WS_WO + ia * SZ_WO), MT, DM, DO}; pg8::StaticOrder S; S.init(MT, DM, G, bx); \
              pg8::EpiResid E{X, X, DM, MT}; \
              pg8::gemm_phase<pg8::EpiResid, pg8::StaticOrder, true, true>(lds, g, S, E); } \
            GRID_BAR(); \
            { PHASE_IDS; phase_rms(X, P.in[10] + (size_t)L * DM, H, gw, NGW, lane); } \
            GRID_BAR(); \
            { PHASE_IDS; pg8::Gemm g{H, (const bf16_t*)(ws + WS_WUP + L * SZ_WUP), MT, NUP, DM}; pg8::StaticOrder S; S.init(MT, NUP, G, bx); \
              pg8::EpiStore E{U, NUP}; \
              pg8::gemm_phase<pg8::EpiStore, pg8::StaticOrder, true, true>(lds, g, S, E); } \
            GRID_BAR(); \
            { PHASE_IDS; phase_convgate(P, outp, U, Z, L, gtid, NGT); } \
            GRID_BAR(); \
            { PHASE_IDS; pg8::Gemm g{Z, (const bf16_t*)(ws + WS_WDOWN + L * SZ_WDOWN), MT, DM, DFF}; pg8::StaticOrder S; S.init(MT, DM, G, bx); \
              pg8::EpiResid E{X, X, DM, MT}; \
              pg8::gemm_phase<pg8::EpiResid, pg8::StaticOrder, true, true>(lds, g, S, E); } \
            GRID_BAR(); \
        } \
        { \
            const int L = 2 * lp + 1, ib = lp; \
            { PHASE_IDS; phase_rms(X, P.in[9] + (size_t)L * DM, H, gw, NGW, lane); } \
            { PHASE_IDS; for (int task = gw; task < MR / 16; task += NGW) gate_task(X, P.in[9] + (size_t)L * DM, P.in[15] + (size_t)ib * DM * NIN_SRC, P.in[16] + ib * 16, GATES, task, lane); } \
            GRID_BAR(); \
            { PHASE_IDS; pg8::Gemm g{H, (const bf16_t*)(ws + WS_WIN + ib * SZ_WIN), MT, NIN, DM}; pg8::StaticOrder S; S.init(MT, NIN, G, bx); \
              pg8::EpiStore E{QKV, NIN}; \
              pg8::gemm_phase<pg8::EpiStore, pg8::StaticOrder, true, true>(lds, g, S, E); } \
            GRID_BAR(); \
            { PHASE_IDS; \
            if (bx < 32) mlstm_prompt(lds, lds_base, QKV, GATES, P.in[17] + (size_t)ib * DM, OC, outp, ib, bx, tid, wave, lane); \
            else if (bx < 96) mlstm_sample(lds, QKV, GATES, P.in[17] + (size_t)ib * DM, P.in[5], P.in[6], P.in[7], OC, outp, ib, bx - 32, tid, wave, lane); \
            else cache_shift(P, outp, lp, (bx - 96) * NWAVES + wave, (G - 96) * NWAVES, lane); } \
            GRID_BAR(); \
            { PHASE_IDS; pg8::Gemm g{OC, (const bf16_t*)(ws + WS_WOUT + ib * SZ_WOUT), MT, DM, DM}; pg8::StaticOrder S; S.init(MT, DM, G, bx); \
              pg8::EpiResid E{X, X, DM, MT}; \
              pg8::gemm_phase<pg8::EpiResid, pg8::StaticOrder, true, true>(lds, g, S, E); } \
            GRID_BAR(); \
            { PHASE_IDS; phase_rms(X, P.in[10] + (size_t)L * DM, H, gw, NGW, lane); } \
            GRID_BAR(); \
            { PHASE_IDS; pg8::Gemm g{H, (const bf16_t*)(ws + WS_WUP + L * SZ_WUP), MT, NUP, DM}; pg8::StaticOrder S; S.init(MT, NUP, G, bx); \
              pg8::EpiStore E{U, NUP}; \
              pg8::gemm_phase<pg8::EpiStore, pg8::StaticOrder, true, true>(lds, g, S, E); } \
            GRID_BAR(); \
            { PHASE_IDS; phase_convgate(P, outp, U, Z, L, gtid, NGT); } \
            GRID_BAR(); \
            { PHASE_IDS; const bool fin = (L == DEPTH - 1); \
              pg8::Gemm g{Z, (const bf16_t*)(ws + WS_WDOWN + L * SZ_WDOWN), MT, DM, DFF}; pg8::StaticOrder S; S.init(MT, DM, G, bx); \
              pg8::EpiResid E{X, fin ? outp : X, DM, fin ? MR : MT}; \
              pg8::gemm_phase<pg8::EpiResid, pg8::StaticOrder, true, true>(lds, g, S, E); } \
            if (lp == 0) GRID_BAR(); \
        } \
    } while (0)
    LAYER_PAIR(0);
    LAYER_PAIR(1);
}

extern "C" void kernel_launch(void* const* d_in, const int* in_sizes, int n_in, void* d_out, int out_size, void* d_ws, size_t ws_size, hipStream_t stream) {
    static int grid = 0;
    if (grid == 0) {
        if (n_in != 23 || (size_t)out_size != O_END || ws_size < WS_END) {
            fprintf(stderr, "kernel_launch: built for 23 inputs, %zu outputs, >= %zu bytes of workspace; got n_in %d, out %d, ws %zu; nothing launched\n", (size_t)O_END, (size_t)WS_END, n_in, out_size, ws_size);
            grid = -1; return; }
        int dev = 0, cus = 0, per_cu = 0;
        if (hipGetDevice(&dev) != hipSuccess || hipDeviceGetAttribute(&cus, hipDeviceAttributeMultiprocessorCount, dev) != hipSuccess) { fprintf(stderr, "kernel_launch: device query failed\n"); grid = -1; return; }
        if (hipFuncSetAttribute((const void*)fwd_kernel, hipFuncAttributeMaxDynamicSharedMemorySize, LDS_BYTES) != hipSuccess) { fprintf(stderr, "kernel_launch: hipFuncSetAttribute failed\n"); grid = -1; return; }
        if (hipOccupancyMaxActiveBlocksPerMultiprocessor(&per_cu, (const void*)fwd_kernel, NTHR, LDS_BYTES) != hipSuccess || per_cu < 1)
            fprintf(stderr, "kernel_launch: occupancy query reports %d workgroups per CU\n", per_cu);
        (void)hipGetLastError();
        grid = cus;
    }
    if (grid < 0) return;
    (void)hipMemsetAsync((char*)d_ws + WS_CTL, 0, CTL_ZERO_BYTES, stream);
    Params p{};
    for (int i = 0; i < 23; ++i) p.in[i] = (const float*)d_in[i];
    p.out = (float*)d_out; p.ws = (unsigned char*)d_ws;
    hipLaunchKernelGGL(fwd_kernel, dim3(grid), dim3(NTHR), LDS_BYTES, stream, p);
    const hipError_t le = hipPeekAtLastError();
    if (le != hipSuccess) fprintf(stderr, "kernel_launch: launch failed: %s\n", hipGetErrorName(le));
}
```

```cpp
#include <hip/hip_runtime.h>
#include <cstdio>
#include <cstdint>

#define LAS __attribute__((address_space(3)))
typedef unsigned short bf16_t;
typedef short bf16x8 __attribute__((ext_vector_type(8)));
typedef float f32x4 __attribute__((ext_vector_type(4)));
typedef float f32x2 __attribute__((ext_vector_type(2)));
typedef unsigned u32x4 __attribute__((ext_vector_type(4)));
typedef unsigned u32x2 __attribute__((ext_vector_type(2)));
typedef unsigned short u16x4 __attribute__((ext_vector_type(4)));

constexpr int DM = 2048, SEQ = 2048, NBP = 4, NBS = 8, TSAMP = 4, PAST = 16384;
constexpr int MP = NBP * SEQ, MSAMP = NBS * TSAMP, MR = MP + MSAMP, MT = 8448;
constexpr int NQKV = 9216, NIN = 6144, NIN_SRC = 6160, DFF = 5632, NUP = 2 * DFF, DO = 1024;
constexpr int DEPTH = 4;
constexpr float EPS = 1e-6f;
constexpr int NWAVES = 8, NTHR = 512;

constexpr size_t O_YP = 0;
constexpr size_t O_YS = O_YP + (size_t)MP * DM;
constexpr size_t O_KV128P = O_YS + (size_t)MSAMP * DM;
constexpr size_t O_KV128S = O_KV128P + (size_t)2 * NBP * 128 * 2048;
constexpr size_t O_KV512P = O_KV128S + (size_t)2 * NBS * 128 * 2048;
constexpr size_t O_KV512S = O_KV512P + (size_t)2 * NBP * 512 * 2048;
constexpr size_t O_KV2048P = O_KV512S + (size_t)2 * NBS * 512 * 2048;
constexpr size_t O_KV2048S = O_KV2048P + (size_t)2 * NBP * 2048 * 2048;
constexpr size_t O_CP = O_KV2048S + (size_t)2 * NBS * 2048 * 2048;
constexpr size_t O_CS = O_CP + (size_t)2 * NBP * 8 * 256 * 128;
constexpr size_t O_NP = O_CS + (size_t)2 * NBS * 8 * 256 * 128;
constexpr size_t O_NS = O_NP + (size_t)2 * NBP * 8 * 128;
constexpr size_t O_MP = O_NS + (size_t)2 * NBS * 8 * 128;
constexpr size_t O_MS = O_MP + (size_t)2 * NBP * 8;
constexpr size_t O_CONVP = O_MS + (size_t)2 * NBS * 8;
constexpr size_t O_CONVS = O_CONVP + (size_t)DEPTH * NBP * 2 * NUP;
constexpr size_t O_END = O_CONVS + (size_t)DEPTH * NBS * 2 * NUP;

constexpr size_t al1m(size_t x) { return (x + 1048575) & ~(size_t)1048575; }
constexpr size_t WS_CTL = 0, CTL_ZERO_BYTES = 1048576;
constexpr size_t SZ_WQKV = (size_t)NQKV * DM * 2, SZ_WO = (size_t)DM * DO * 2, SZ_WIN = (size_t)NIN * DM * 2, SZ_WOUT = (size_t)DM * DM * 2, SZ_WUP = (size_t)NUP * DM * 2, SZ_WDOWN = (size_t)DM * DFF * 2;
constexpr size_t WS_WQKV = al1m(WS_CTL + CTL_ZERO_BYTES);
constexpr size_t WS_WO = al1m(WS_WQKV + 2 * SZ_WQKV);
constexpr size_t WS_WIN = al1m(WS_WO + 2 * SZ_WO);
constexpr size_t WS_WOUT = al1m(WS_WIN + 2 * SZ_WIN);
constexpr size_t WS_WUP = al1m(WS_WOUT + 2 * SZ_WOUT);
constexpr size_t WS_WDOWN = al1m(WS_WUP + 4 * SZ_WUP);
constexpr size_t WS_X = al1m(WS_WDOWN + 4 * SZ_WDOWN);
constexpr size_t WS_XB = al1m(WS_X + (size_t)MT * DM * 4);
constexpr size_t WS_SSQ = al1m(WS_XB + (size_t)MT * DM * 2);
constexpr size_t WS_SSQS = al1m(WS_SSQ + (size_t)MP * 32 * 4);
constexpr size_t WS_QKV = al1m(WS_SSQS + (size_t)MSAMP * 128 * 4);
constexpr size_t WS_OG = al1m(WS_QKV + (size_t)MT * NQKV * 2);
constexpr size_t WS_LSE = al1m(WS_OG + (size_t)MT * 3072 * 2);
constexpr size_t WS_OC = al1m(WS_LSE + (size_t)MT * 24 * 4);
constexpr size_t WS_GATES = al1m(WS_OC + (size_t)MT * DM * 2);
constexpr size_t WS_U = al1m(WS_GATES + (size_t)MT * 16 * 4);
constexpr size_t WS_Z = al1m(WS_U + (size_t)MT * NUP * 2);
constexpr size_t WS_SQ = al1m(WS_Z + (size_t)MT * DFF * 2);
constexpr size_t WS_END = al1m(WS_SQ + (size_t)MP * 128 * 4);

constexpr int RING_BYTES = 131072;
constexpr int LDS_MISC_OFF = 150 * 1024;
constexpr int LDS_BYTES = 152 * 1024;

__device__ __forceinline__ unsigned f2bf(float f) { unsigned u = __builtin_bit_cast(unsigned, f); return (u + 0x7fffu + ((u >> 16) & 1u)) >> 16; }
__device__ __forceinline__ unsigned pk2(float lo, float hi) { return f2bf(lo) | (f2bf(hi) << 16); }
__device__ __forceinline__ float bflo(unsigned w) { return __builtin_bit_cast(float, w << 16); }
__device__ __forceinline__ float bfhi(unsigned w) { return __builtin_bit_cast(float, w & 0xffff0000u); }
__device__ __forceinline__ float bf1(bf16_t b) { return __builtin_bit_cast(float, (unsigned)b << 16); }
__device__ __forceinline__ float fexp(float x) { return __builtin_amdgcn_exp2f(x * 1.4426950408889634f); }
__device__ __forceinline__ float wave_sum(float v) {
#pragma unroll
    for (int o = 1; o < 64; o <<= 1) v += __shfl_xor(v, o);
    return v;
}
__device__ __forceinline__ float wave_max(float v) {
#pragma unroll
    for (int o = 1; o < 64; o <<= 1) v = fmaxf(v, __shfl_xor(v, o));
    return v;
}
__device__ __forceinline__ f32x4 mma16(bf16x8 a, bf16x8 b, f32x4 c) { return __builtin_amdgcn_mfma_f32_16x16x32_bf16(a, b, c, 0, 0, 0); }
__device__ __forceinline__ bf16x8 tr_read2(unsigned base, int off0, int off1) {
    u16x4 r0, r1;
    asm volatile("ds_read_b64_tr_b16 %0, %2 offset:%c3\n\tds_read_b64_tr_b16 %1, %2 offset:%c4\n\ts_waitcnt lgkmcnt(0)" : "=&v"(r0), "=&v"(r1) : "v"(base), "i"(off0), "i"(off1) : "memory");
    bf16x8 o; o[0] = (short)r0[0]; o[1] = (short)r0[1]; o[2] = (short)r0[2]; o[3] = (short)r0[3]; o[4] = (short)r1[0]; o[5] = (short)r1[1]; o[6] = (short)r1[2]; o[7] = (short)r1[3];
    return o;
}
__device__ __forceinline__ bf16x8 pack8(f32x4 a, f32x4 b) {
    u32x4 w; w.x = pk2(a[0], a[1]); w.y = pk2(a[2], a[3]); w.z = pk2(b[0], b[1]); w.w = pk2(b[2], b[3]);
    return __builtin_bit_cast(bf16x8, w);
}

namespace pg8 {
#define PG8_LAS __attribute__((address_space(3)))
typedef unsigned short bf16_t;
typedef short bf16x8 __attribute__((ext_vector_type(8)));
typedef float f32x4 __attribute__((ext_vector_type(4)));
typedef unsigned u32x4 __attribute__((ext_vector_type(4)));
constexpr int BM = 256, BK = 64, HALF = 128, HTB = HALF * BK * 2  , STAGE_BYTES = 8 * HTB, NXCD = 8, WGM = 8;

__host__ __device__ __forceinline__ int lds_byte(int r, int c) { const int st = (r >> 4) * 2 + (c >> 5), rr = r & 15, cc = c & 31, ob = rr * 64 + cc * 2; return st * 1024 + (ob ^ (((ob >> 9) & 1) << 5)); }
__host__ __device__ __forceinline__ void stage_rc(int b, int& R, int& C) { const int st = b / 1024, sb = b % 1024, swz = sb ^ (((sb >> 9) & 1) << 5); R = (st >> 1) * 16 + swz / 64; C = (st & 1) * 32 + (swz % 64) / 2; }
__host__ __device__ __forceinline__ int perm32(int rho) { const int n = rho >> 4, i = rho & 15; return 8 * (i >> 2) + 4 * n + (i & 3); }

struct Unit { int pm, pn; };
struct Gemm { const bf16_t* A; const bf16_t* Bt; int M, N, K; };

struct StaticOrder {
    int nM, nN, nwg, G, c;
    __host__ __device__ void init(int M, int N, int G_, int c_) { nM = M / BM; nN = N / BM; nwg = nM * nN; G = G_; c = c_; }
    __host__ __device__ bool next(int i, Unit& u) const {
        const long L = (long)i * G + c; if (L >= nwg) return false;
        int wgid = (int)L; { const int q = nwg / NXCD, r = nwg % NXCD, xcd = wgid % NXCD, off = wgid / NXCD; wgid = (xcd < r ? xcd * (q + 1) : r * (q + 1) + (xcd - r) * q) + off; }
        const int nig = WGM * nN, gid = wgid / nig, fm = gid * WGM, gsz = (nM - fm) < WGM ? (nM - fm) : WGM;
        u.pm = fm + ((wgid % nig) % gsz); u.pn = (wgid % nig) / gsz; return true;
    }
    __device__ __forceinline__ void a_ready(const Unit&) const {}
    __device__ __forceinline__ void done(const Unit&) const {}
};
__device__ __forceinline__ unsigned cvt_pk_bf16(float lo, float hi) { unsigned r; asm volatile("v_cvt_pk_bf16_f32 %0, %1, %2" : "=v"(r) : "v"(lo), "v"(hi)); return r; }

struct EpiStore {
    static constexpr bool PERM = true, AFTER_DRAIN = false;
    bf16_t* O; int ldc;
    __device__ __forceinline__ void operator()(const f32x4 (&acc)[2][2][4][2], const Unit& u, int wr, int wc, int fr, int fq) const {
        const int row0 = u.pm * BM + wr * 64 + fr, col0 = u.pn * BM + wc * 32 + 8 * fq;
#pragma unroll
        for (int ai = 0; ai < 2; ++ai)
#pragma unroll
            for (int m = 0; m < 4; ++m) { bf16_t* rowp = O + (size_t)(row0 + ai * HALF + m * 16) * ldc + col0;
#pragma unroll
                for (int bj = 0; bj < 2; ++bj) { const f32x4 v0 = acc[ai][bj][m][0], v1 = acc[ai][bj][m][1];
                    u32x4 w; w.x = cvt_pk_bf16(v0[0], v0[1]); w.y = cvt_pk_bf16(v0[2], v0[3]); w.z = cvt_pk_bf16(v1[0], v1[1]); w.w = cvt_pk_bf16(v1[2], v1[3]);
                    *(u32x4*)(rowp + bj * HALF) = w; } }
    }
};
struct EpiResid {
    static constexpr bool PERM = false, AFTER_DRAIN = false;
    const float* xin; float* out; int ldc; int mrows;
    __device__ __forceinline__ void operator()(const f32x4 (&acc)[2][2][4][2], const Unit& u, int wr, int wc, int fr, int fq) const {
        const int row0 = u.pm * BM + wr * 64 + fr, col0 = u.pn * BM + wc * 32 + 4 * fq;
#pragma unroll
        for (int ai = 0; ai < 2; ++ai)
#pragma unroll
            for (int m = 0; m < 4; ++m) { const int r = row0 + ai * HALF + m * 16;
                if (r < mrows) { const size_t off = (size_t)r * ldc + col0;
#pragma unroll
                    for (int bj = 0; bj < 2; ++bj)
#pragma unroll
                        for (int n = 0; n < 2; ++n) { const f32x4 bs = *(const f32x4*)(xin + off + bj * HALF + n * 16); *(f32x4*)(out + off + bj * HALF + n * 16) = bs + acc[ai][bj][m][n]; } }
                asm volatile("" ::: "memory"); }
    }
};


struct EpiStoreN {
    static constexpr bool PERM = true, AFTER_DRAIN = false;
    bf16_t* O; int ldc; const float* ssq; float eps;
    __device__ __forceinline__ void operator()(const f32x4 (&acc)[2][2][4][2], const Unit& u, int wr, int wc, int fr, int fq) const {
        const int row0 = u.pm * BM + wr * 64 + fr, col0 = u.pn * BM + wc * 32 + 8 * fq;
#pragma unroll
        for (int ai = 0; ai < 2; ++ai)
#pragma unroll
            for (int m = 0; m < 4; ++m) { const int r = row0 + ai * HALF + m * 16;
                const f32x4 p0 = *(const f32x4*)(ssq + (size_t)r * 32 + 8 * fq), p1 = *(const f32x4*)(ssq + (size_t)r * 32 + 8 * fq + 4);
                float s = ((p0[0] + p0[1]) + (p0[2] + p0[3])) + ((p1[0] + p1[1]) + (p1[2] + p1[3]));
                s += __shfl_xor(s, 16); s += __shfl_xor(s, 32);
                const float rs = rsqrtf(s * (1.f / 2048.f) + eps);
                bf16_t* rowp = O + (size_t)r * ldc + col0;
#pragma unroll
                for (int bj = 0; bj < 2; ++bj) { const f32x4 v0 = acc[ai][bj][m][0] * rs, v1 = acc[ai][bj][m][1] * rs;
                    u32x4 w; w.x = cvt_pk_bf16(v0[0], v0[1]); w.y = cvt_pk_bf16(v0[2], v0[3]); w.z = cvt_pk_bf16(v1[0], v1[1]); w.w = cvt_pk_bf16(v1[2], v1[3]);
                    *(u32x4*)(rowp + bj * HALF) = w; } }
    }
};
struct EpiResidN {
    static constexpr bool PERM = false, AFTER_DRAIN = false;
    const float* xin; float* out; bf16_t* xb; float* ssq; int ldc;
    __device__ __forceinline__ void operator()(const f32x4 (&acc)[2][2][4][2], const Unit& u, int wr, int wc, int fr, int fq) const {
        const int row0 = u.pm * BM + wr * 64 + fr, col0 = u.pn * BM + wc * 32 + 4 * fq;
#pragma unroll
        for (int ai = 0; ai < 2; ++ai)
#pragma unroll
            for (int m = 0; m < 4; ++m) { const int r = row0 + ai * HALF + m * 16; const size_t off = (size_t)r * ldc + col0; float sq = 0.f;
#pragma unroll
                for (int bj = 0; bj < 2; ++bj)
#pragma unroll
                    for (int n = 0; n < 2; ++n) { const f32x4 v = *(const f32x4*)(xin + off + bj * HALF + n * 16) + acc[ai][bj][m][n]; *(f32x4*)(out + off + bj * HALF + n * 16) = v;
                        if (xb) { u32x2 w; w.x = cvt_pk_bf16(v[0], v[1]); w.y = cvt_pk_bf16(v[2], v[3]); *(u32x2*)(xb + off + bj * HALF + n * 16) = w; }
                        sq += (v[0] * v[0] + v[1] * v[1]) + (v[2] * v[2] + v[3] * v[3]); }
                if (ssq) { sq += __shfl_xor(sq, 16); sq += __shfl_xor(sq, 32); if (fq == 0) ssq[(size_t)r * 32 + u.pn * 4 + wc] = sq; }
                asm volatile("" ::: "memory"); }
    }
};
template <class Epi, class Sched, bool ALIGN_EPI = false, bool SP2 = false>
__device__ __forceinline__ void gemm_phase(PG8_LAS unsigned char* lds, const Gemm g, const Sched& S, const Epi& E) {
    int tid = threadIdx.x; asm volatile("" : "+v"(tid));
    const int wid = __builtin_amdgcn_readfirstlane(tid >> 6), lane = tid & 63, wr = wid >> 2, wc = wid & 3, fr = lane & 15, fq = lane >> 4;
    const int K = g.K, nt = K / BK;
    unsigned voffA[2], voffB[2];
#pragma unroll
    for (int i = 0; i < 2; ++i) { int R, C; stage_rc(tid * 16 + i * 8192, R, C); const int Rb = Epi::PERM ? ((R & ~31) + perm32(R & 31)) : R;
        voffA[i] = (unsigned)(R * K + C) * 2u; voffB[i] = (unsigned)(Rb * K + C) * 2u; }
    const size_t kstep = (size_t)(BK * 2);
    const size_t hstep = (size_t)HALF * K * 2;
    const size_t tstep = 2 * hstep;
    const unsigned ldsw = (unsigned)wid * 1024u;
    const int aoff = lds_byte(wr * 64 + fr, fq * 8), boff = lds_byte(wc * 32 + fr, fq * 8);
#define PG8_SA(b, h) (((b) * 2 + (h)) * HTB)
#define PG8_SB(b, h) ((4 + (b) * 2 + (h)) * HTB)
#define PG8_STAGE(bufoff, gbase, voff) do { _Pragma("unroll") for (int _i = 0; _i < 2; ++_i) \
        __builtin_amdgcn_global_load_lds((const unsigned*)((const char*)(gbase) + (voff)[_i]), (PG8_LAS unsigned*)(lds + (bufoff) + ldsw + _i * 8192), 16, 0, 0); } while (0)
#define PG8_LDA(dst, b, h) do { _Pragma("unroll") for (int m = 0; m < 4; ++m) _Pragma("unroll") for (int k = 0; k < 2; ++k) dst[m][k] = *(const PG8_LAS bf16x8*)(lds + PG8_SA(b, h) + aoff + m * 2048 + k * 1024); } while (0)
#define PG8_LDB(dst, b, h) do { _Pragma("unroll") for (int n = 0; n < 2; ++n) _Pragma("unroll") for (int k = 0; k < 2; ++k) dst[n][k] = *(const PG8_LAS bf16x8*)(lds + PG8_SB(b, h) + boff + n * 2048 + k * 1024); } while (0)
#define PG8_MMA(ai, bj, At, Bt) do { __builtin_amdgcn_s_setprio(1); _Pragma("unroll") for (int m = 0; m < 4; ++m) _Pragma("unroll") for (int n = 0; n < 2; ++n) _Pragma("unroll") for (int k = 0; k < 2; ++k) \
        acc[ai][bj][m][n] = __builtin_amdgcn_mfma_f32_16x16x32_bf16(Bt[n][k], At[m][k], acc[ai][bj][m][n], 0, 0, 0); __builtin_amdgcn_s_setprio(0); } while (0)
#define PG8_WAIT_V(n) asm volatile("s_waitcnt vmcnt(" #n ")" ::: "memory")
#define PG8_WAIT_L(n) asm volatile("s_waitcnt lgkmcnt(" #n ")" ::: "memory")
#define PG8_BAR __builtin_amdgcn_s_barrier()
#define PG8_SCHED __builtin_amdgcn_sched_barrier(0)
    Unit cur, nxt; int ui = 0;
    if (!S.next(0, cur)) return;
    f32x4 acc[2][2][4][2];
#pragma unroll
    for (int a = 0; a < 2; ++a)
#pragma unroll
        for (int b = 0; b < 2; ++b)
#pragma unroll
            for (int m = 0; m < 4; ++m)
#pragma unroll
                for (int n = 0; n < 2; ++n) acc[a][b][m][n] = (f32x4){0.f, 0.f, 0.f, 0.f};
    bf16x8 At[4][2], B0[2][2], B1[2][2];
    const char* cA = (const char*)g.A + (size_t)cur.pm * tstep; const char* cB = (const char*)g.Bt + (size_t)cur.pn * tstep;
    S.a_ready(cur);
    if constexpr (SP2) {
        PG8_STAGE(PG8_SB(0, 0), cB, voffB); PG8_STAGE(PG8_SB(0, 1), cB + hstep, voffB); PG8_STAGE(PG8_SA(0, 0), cA, voffA); PG8_STAGE(PG8_SA(0, 1), cA + hstep, voffA);
        if (wr == 1) PG8_BAR;
        PG8_WAIT_V(2); PG8_BAR;
        PG8_STAGE(PG8_SB(1, 0), cB + kstep, voffB); PG8_STAGE(PG8_SA(1, 0), cA + kstep, voffA); PG8_STAGE(PG8_SB(1, 1), cB + hstep + kstep, voffB);
        PG8_WAIT_V(6); PG8_BAR;
    } else {
        PG8_STAGE(PG8_SB(0, 0), cB, voffB); PG8_STAGE(PG8_SA(0, 0), cA, voffA); PG8_STAGE(PG8_SB(0, 1), cB + hstep, voffB); PG8_STAGE(PG8_SA(0, 1), cA + hstep, voffA);
        if (wr == 1) PG8_BAR;
        PG8_WAIT_V(4); PG8_BAR;
        PG8_STAGE(PG8_SB(1, 0), cB + kstep, voffB); PG8_STAGE(PG8_SA(1, 0), cA + kstep, voffA); PG8_STAGE(PG8_SB(1, 1), cB + hstep + kstep, voffB);
        PG8_WAIT_V(6); PG8_BAR;
    }
    for (;;) {
        const bool has_next = S.next(ui + 1, nxt);
        const char* nA = has_next ? (const char*)g.A + (size_t)nxt.pm * tstep : cA; const char* nB = has_next ? (const char*)g.Bt + (size_t)nxt.pn * tstep : cB;
        for (int t = 0; t < nt; t += 2) {
            const bool last = (t == nt - 2);
            const char* a1 = cA + (size_t)(t + 1) * kstep;
            const char* a2 = last ? nA : cA + (size_t)(t + 2) * kstep; const char* b2 = last ? nB : cB + (size_t)(t + 2) * kstep;
            const char* a3 = a2 + kstep; const char* b3 = b2 + kstep;
            if (last && has_next) S.a_ready(nxt);
            if constexpr (SP2) {
            PG8_LDB(B0, 0, 0); PG8_LDB(B1, 0, 1); PG8_SCHED; PG8_LDA(At, 0, 0); PG8_STAGE(PG8_SA(1, 1), a1 + hstep, voffA);
            PG8_WAIT_V(8); PG8_WAIT_L(0); PG8_BAR; PG8_MMA(0, 0, At, B0); PG8_MMA(0, 1, At, B1); PG8_BAR; PG8_SCHED;
            PG8_LDA(At, 0, 1); PG8_STAGE(PG8_SB(0, 0), b2, voffB); PG8_STAGE(PG8_SB(0, 1), b2 + hstep, voffB); PG8_STAGE(PG8_SA(0, 0), a2, voffA);
            PG8_WAIT_V(8); PG8_WAIT_L(0); PG8_BAR; PG8_MMA(1, 0, At, B0); PG8_MMA(1, 1, At, B1); PG8_BAR; PG8_SCHED;
            PG8_LDB(B0, 1, 0); PG8_LDB(B1, 1, 1); PG8_SCHED; PG8_LDA(At, 1, 0); PG8_STAGE(PG8_SA(0, 1), a2 + hstep, voffA);
            PG8_WAIT_V(8); PG8_WAIT_L(0); PG8_BAR; PG8_MMA(0, 0, At, B0); PG8_MMA(0, 1, At, B1); PG8_BAR; PG8_SCHED;
            PG8_LDA(At, 1, 1); PG8_STAGE(PG8_SB(1, 0), b3, voffB); PG8_STAGE(PG8_SB(1, 1), b3 + hstep, voffB); PG8_STAGE(PG8_SA(1, 0), a3, voffA);
            PG8_WAIT_V(8); PG8_WAIT_L(0); PG8_BAR; PG8_MMA(1, 0, At, B0); PG8_MMA(1, 1, At, B1); PG8_BAR; PG8_SCHED;
            } else {
            PG8_LDB(B0, 0, 0); PG8_SCHED; PG8_LDA(At, 0, 0); PG8_STAGE(PG8_SA(1, 1), a1 + hstep, voffA);
            PG8_WAIT_L(8); PG8_BAR; PG8_WAIT_L(0); PG8_MMA(0, 0, At, B0); PG8_BAR; PG8_SCHED;
            PG8_LDB(B1, 0, 1); PG8_STAGE(PG8_SB(0, 0), b2, voffB);
            PG8_BAR; PG8_WAIT_L(0); PG8_MMA(0, 1, At, B1); PG8_BAR;
            PG8_LDA(At, 0, 1); PG8_STAGE(PG8_SA(0, 0), a2, voffA);
            PG8_BAR; PG8_WAIT_L(0); PG8_MMA(1, 0, At, B0); PG8_BAR; PG8_SCHED;
            PG8_STAGE(PG8_SB(0, 1), b2 + hstep, voffB);
            PG8_WAIT_V(6); PG8_BAR; PG8_MMA(1, 1, At, B1); PG8_BAR;
            PG8_LDB(B0, 1, 0); PG8_SCHED; PG8_LDA(At, 1, 0); PG8_STAGE(PG8_SA(0, 1), a2 + hstep, voffA);
            PG8_WAIT_L(8); PG8_BAR; PG8_WAIT_L(0); PG8_MMA(0, 0, At, B0); PG8_BAR; PG8_SCHED;
            PG8_LDB(B1, 1, 1); PG8_STAGE(PG8_SB(1, 0), b3, voffB);
            PG8_BAR; PG8_WAIT_L(0); PG8_MMA(0, 1, At, B1); PG8_BAR;
            PG8_LDA(At, 1, 1); PG8_STAGE(PG8_SA(1, 0), a3, voffA);
            PG8_BAR; PG8_WAIT_L(0); PG8_MMA(1, 0, At, B0); PG8_BAR; PG8_SCHED;
            PG8_STAGE(PG8_SB(1, 1), b3 + hstep, voffB);
            PG8_WAIT_V(6); PG8_BAR; PG8_MMA(1, 1, At, B1); PG8_BAR;
            }
        }
        if constexpr (ALIGN_EPI) { if (wr == 0) PG8_BAR; }
        if constexpr (!Epi::AFTER_DRAIN) { E(acc, cur, wr, wc, fr, fq); S.done(cur); }
        if (!has_next) break;
#pragma unroll
        for (int a = 0; a < 2; ++a)
#pragma unroll
            for (int b = 0; b < 2; ++b)
#pragma unroll
                for (int m = 0; m < 4; ++m)
#pragma unroll
                    for (int n = 0; n < 2; ++n) acc[a][b][m][n] = (f32x4){0.f, 0.f, 0.f, 0.f};
        cur = nxt; cA = nA; cB = nB; ++ui;
        if constexpr (ALIGN_EPI) { if (wr == 1) PG8_BAR; }
    }
    PG8_WAIT_V(0);
    if constexpr (!ALIGN_EPI) { if (wr == 0) PG8_BAR; }
    PG8_BAR;
    if constexpr (Epi::AFTER_DRAIN) { E.fused(acc, cur, wr, wc, fr, fq, lds, wid, lane); S.done(cur); }
#undef PG8_SA
#undef PG8_SB
#undef PG8_STAGE
#undef PG8_LDA
#undef PG8_LDB
#undef PG8_MMA
#undef PG8_WAIT_V
#undef PG8_WAIT_L
#undef PG8_BAR
#undef PG8_SCHED
}
}
#define XB_TMO      128
#define XB_XCNT(j)  (256  + 64 * (j))
#define XB_XSUB(j)  (1280 + 64 * (j))
#define XB_XGEN(j)  (2304 + 64 * (j))
#define XB_TOP      3328
#define XB_TOPGEN   3392
#define XCD_BAR_WORDS 3456
#define XB_SPIN_CAP (1u << 18)

__device__ __forceinline__ unsigned xb_ld(unsigned* p)              { return __hip_atomic_load(p, __ATOMIC_RELAXED, __HIP_MEMORY_SCOPE_AGENT); }
__device__ __forceinline__ unsigned xb_add(unsigned* p, unsigned v) { return __hip_atomic_fetch_add(p, v, __ATOMIC_RELAXED, __HIP_MEMORY_SCOPE_AGENT); }
__device__ __forceinline__ unsigned xb_xcc_id() { return (unsigned)__builtin_amdgcn_s_getreg((3 << 11) | 20) & 0xFu; }
#define XB_SPIN(cond, bar) do { unsigned _sp = 0; while (cond) { __builtin_amdgcn_s_sleep(1); \
    if ((++_sp & 255u) == 0u) { if (xb_ld(&(bar)[XB_TMO])) break; if (_sp > XB_SPIN_CAP) { atomicAdd(&(bar)[XB_TMO], 1u); break; } } } } while (0)

struct XcdBarrier {
    unsigned* bar; unsigned x;
    volatile LAS unsigned* st;
};

__device__ __forceinline__ XcdBarrier xcd_barrier_post(unsigned* bar, volatile LAS unsigned* st) {
    XcdBarrier b; b.bar = bar; b.x = xb_xcc_id(); b.st = st;
    if (threadIdx.x == 0) (void)xb_add(&bar[XB_XCNT(b.x)], 1u);
    return b;
}
__device__ __forceinline__ void xcd_barrier_complete(unsigned* bar, unsigned x, unsigned& nloc, unsigned& nx) {
    const unsigned G = gridDim.x * gridDim.y * gridDim.z;
    unsigned sum, cnt, mine, sp = 0u;
    for (;;) {
        sum = 0u; cnt = 0u; mine = 0u;
#pragma unroll
        for (unsigned j = 0; j < 16; ++j) { const unsigned c = xb_ld(&bar[XB_XCNT(j)]); sum += c; cnt += (c > 0u) ? 1u : 0u; mine = (j == x) ? c : mine; }
        if (sum == G) break;
        __builtin_amdgcn_s_sleep(1);
        if ((++sp & 255u) == 0u) { if (xb_ld(&bar[XB_TMO])) break; if (sp > XB_SPIN_CAP) { atomicAdd(&bar[XB_TMO], 1u); break; } }
    }
    nloc = mine > 0u ? mine : 1u; nx = cnt > 0u ? cnt : 1u;
}

__device__ __forceinline__ void xcd_barrier(const XcdBarrier& b) {
    asm volatile("s_waitcnt vmcnt(0)" ::: "memory");
    __syncthreads();
    if (threadIdx.x == 0) {
        unsigned* bar = b.bar;
        __builtin_amdgcn_s_waitcnt(0);
        unsigned nloc = b.st[0], nx = b.st[1];
        if (nloc == 0u) { xcd_barrier_complete(bar, b.x, nloc, nx); b.st[0] = nloc; b.st[1] = nx; }
        const unsigned old = xb_add(&bar[XB_XSUB(b.x)], 1u);
        const unsigned gen = old / nloc;
        if (old + 1u == (gen + 1u) * nloc) {
            __builtin_amdgcn_fence(__ATOMIC_RELEASE, "agent");
            asm volatile("s_waitcnt vmcnt(0)" ::: "memory");
            const unsigned og = xb_add(&bar[XB_TOP], 1u);
            const unsigned tg = og / nx;
            if (og + 1u == (tg + 1u) * nx) xb_add(&bar[XB_TOPGEN], 1u);
            else XB_SPIN(xb_ld(&bar[XB_TOPGEN]) == tg, bar);
            __builtin_amdgcn_fence(__ATOMIC_ACQUIRE, "agent");
            xb_add(&bar[XB_XGEN(b.x)], 1u);
            asm volatile("s_waitcnt vmcnt(0)" ::: "memory");
        } else {
            XB_SPIN(xb_ld(&bar[XB_XGEN(b.x)]) == gen, bar);
            __builtin_amdgcn_fence(__ATOMIC_ACQUIRE, "agent");
            asm volatile("s_waitcnt vmcnt(0)" ::: "memory");
        }
    }
    __syncthreads();
}

struct Params { const float* in[23]; float* out; unsigned char* ws; };

__device__ __forceinline__ void p0_transpose_item(const float* W, int ldw, int K, int N, bf16_t* WT, LAS float* scr, int item, int lane, float scale, const float* gk) {
    const int nblk = N / 32, kb = item / nblk, nb = item % nblk, k0 = 64 * kb, n0 = 32 * nb;
#pragma unroll 8
    for (int i = 0; i < 32; ++i) { const int kk = 2 * i + (lane >> 5); scr[kk * 33 + (lane & 31)] = W[(size_t)(k0 + kk) * ldw + n0 + (lane & 31)] * (gk ? gk[k0 + kk] * scale : scale); }
    asm volatile("s_waitcnt lgkmcnt(0)" ::: "memory");
    const int c = lane & 7;
#pragma unroll
    for (int j = 0; j < 4; ++j) { const int n = (lane >> 3) + 8 * j; const LAS float* s = scr + (8 * c) * 33 + n;
        u32x4 o; o.x = pk2(s[0 * 33], s[1 * 33]); o.y = pk2(s[2 * 33], s[3 * 33]); o.z = pk2(s[4 * 33], s[5 * 33]); o.w = pk2(s[6 * 33], s[7 * 33]);
        *(u32x4*)(WT + (size_t)(n0 + n) * K + k0 + 8 * c) = o; }
    asm volatile("s_waitcnt lgkmcnt(0)" ::: "memory");
}

__device__ __forceinline__ void phase_prologue(const Params& P, LAS unsigned char* lds, int gw, int NGW, int wave, int lane) {
    LAS float* scr = (LAS float*)(lds + wave * 16384);
    constexpr int I_QKV = (DM / 64) * (NQKV / 32), I_WO = (DO / 64) * (DM / 32), I_WIN = (DM / 64) * (NIN / 32), I_WOUT = (DM / 64) * (DM / 32), I_WUP = (DM / 64) * (NUP / 32), I_WDN = (DFF / 64) * (DM / 32);
    constexpr int T0 = 2 * I_QKV, T1 = T0 + 2 * I_WO, T2 = T1 + 2 * I_WIN, T3 = T2 + 2 * I_WOUT, T4 = T3 + 4 * I_WUP, T5 = T4 + 4 * I_WDN;
    unsigned char* ws = P.ws;
    for (int it = gw; it < T5; it += NGW) {
        if (it < T0) { const int l = it / I_QKV, r = it % I_QKV; p0_transpose_item(P.in[11] + (size_t)l * DM * NQKV, NQKV, DM, NQKV, (bf16_t*)(ws + WS_WQKV + l * SZ_WQKV), scr, r, lane, 1.f, P.in[9] + (size_t)(2 * l) * DM); }
        else if (it < T1) { const int q = it - T0, l = q / I_WO, r = q % I_WO; p0_transpose_item(P.in[14] + (size_t)l * DO * DM, DM, DO, DM, (bf16_t*)(ws + WS_WO + l * SZ_WO), scr, r, lane, 1.f, nullptr); }
        else if (it < T2) { const int q = it - T1, l = q / I_WIN, r = q % I_WIN; const int nb = r % (NIN / 32);
            const float sc = (nb >= 32 && nb < 64) ? 0.08838834764831845f : 1.f;
            p0_transpose_item(P.in[15] + (size_t)l * DM * NIN_SRC, NIN_SRC, DM, NIN, (bf16_t*)(ws + WS_WIN + l * SZ_WIN), scr, r, lane, sc, P.in[9] + (size_t)(2 * l + 1) * DM); }
        else if (it < T3) { const int q = it - T2, l = q / I_WOUT, r = q % I_WOUT; p0_transpose_item(P.in[18] + (size_t)l * DM * DM, DM, DM, DM, (bf16_t*)(ws + WS_WOUT + l * SZ_WOUT), scr, r, lane, 1.f, nullptr); }
        else if (it < T4) { const int q = it - T3, l = q / I_WUP, r = q % I_WUP; p0_transpose_item(P.in[19] + (size_t)l * DM * NUP, NUP, DM, NUP, (bf16_t*)(ws + WS_WUP + l * SZ_WUP), scr, r, lane, 1.f, P.in[10] + (size_t)l * DM); }
        else { const int q = it - T4, l = q / I_WDN, r = q % I_WDN; p0_transpose_item(P.in[22] + (size_t)l * DFF * DM, DM, DFF, DM, (bf16_t*)(ws + WS_WDOWN + l * SZ_WDOWN), scr, r, lane, 1.f, nullptr); }
    }
    for (int r = gw; r < MR; r += NGW) {
        const f32x4* xr = (const f32x4*)((r < MP) ? P.in[0] + (size_t)r * DM : P.in[1] + (size_t)(r - MP) * DM) + lane;
        f32x4* xo = (f32x4*)(ws + WS_X) + (size_t)r * (DM / 4) + lane; u32x2* xb = (u32x2*)(ws + WS_XB) + (size_t)r * (DM / 4) + lane;
        float s = 0.f;
#pragma unroll
        for (int j = 0; j < 8; ++j) { const f32x4 v = xr[64 * j]; xo[64 * j] = v; u32x2 w; w.x = pk2(v.x, v.y); w.y = pk2(v.z, v.w); xb[64 * j] = w; s += (v.x * v.x + v.y * v.y) + (v.z * v.z + v.w * v.w); }
        s = wave_sum(s);
        if (r < MP) { if (lane < 32) ((float*)(ws + WS_SSQ))[(size_t)r * 32 + lane] = (lane == 0) ? s : 0.f; }
        else { float* q = (float*)(ws + WS_SSQS) + (size_t)(r - MP) * 128; q[lane] = (lane == 0) ? s : 0.f; q[64 + lane] = 0.f; }
    }
}

__device__ __forceinline__ void gate_task(const float* X, const float* gnorm, const float* Win, const float* bg, float* GATES, int task, int lane) {
    const int r0 = task * 16, i16 = lane & 15, kq = lane >> 4;
    const float* xr = X + (size_t)(r0 + i16) * DM + 4 * kq;
    const float* wp = Win + (size_t)(4 * kq) * NIN_SRC + NIN + i16;
    f32x4 acc = {0.f, 0.f, 0.f, 0.f}; float ss = 0.f;
#pragma unroll 4
    for (int kb = 0; kb < 128; ++kb) {
        const f32x4 xv = *(const f32x4*)(xr + 16 * kb);
        const f32x4 gv = *(const f32x4*)(gnorm + 16 * kb + 4 * kq);
        ss += (xv.x * xv.x + xv.y * xv.y) + (xv.z * xv.z + xv.w * xv.w);
        const float* w = wp + (size_t)(16 * kb) * NIN_SRC;
        acc = __builtin_amdgcn_mfma_f32_16x16x4f32(xv.x, gv.x * w[0], acc, 0, 0, 0);
        acc = __builtin_amdgcn_mfma_f32_16x16x4f32(xv.y, gv.y * w[NIN_SRC], acc, 0, 0, 0);
        acc = __builtin_amdgcn_mfma_f32_16x16x4f32(xv.z, gv.z * w[2 * NIN_SRC], acc, 0, 0, 0);
        acc = __builtin_amdgcn_mfma_f32_16x16x4f32(xv.w, gv.w * w[3 * NIN_SRC], acc, 0, 0, 0);
    }
    ss += __shfl_xor(ss, 16); ss += __shfl_xor(ss, 32);
    const float rstd = rsqrtf(ss * (1.f / DM) + EPS);
    const float bias = bg[i16];
#pragma unroll
    for (int i = 0; i < 4; ++i) {
        const float rs = __shfl(rstd, 4 * kq + i);
        const float pre = acc[i] * rs + bias;
        const float gc = 15.f * tanhf(pre * (1.f / 15.f));
        const float val = (i16 < 8) ? gc : (fminf(gc, 0.f) - log1pf(fexp(-fabsf(gc))));
        GATES[(size_t)(r0 + 4 * kq + i) * 16 + i16] = val;
    }
}

constexpr int SK_PART = 0, SK_RSTD = 16384;
template <int MODE>
__device__ __forceinline__ void skinny_phase(LAS unsigned char* lds, const bf16_t* A, int K, const bf16_t* Bt, int N, bf16_t* Ob, int ldo, float* Xs, bf16_t* XBs, float* SSQS, float* Os, int c, int G, int tid, int wave, int lane) {
    const int i16 = lane & 15, q4 = lane >> 4;
    LAS f32x4* part = (LAS f32x4*)(lds + SK_PART); LAS float* rstdS = (LAS float*)(lds + SK_RSTD);
    __syncthreads();
    if (MODE == 0) { const int row = tid >> 4, sub = tid & 15; const float* q = SSQS + row * 128 + 8 * sub;
        const f32x4 a = *(const f32x4*)q, b = *(const f32x4*)(q + 4); float s = ((a[0] + a[1]) + (a[2] + a[3])) + ((b[0] + b[1]) + (b[2] + b[3]));
        s += __shfl_xor(s, 1); s += __shfl_xor(s, 2); s += __shfl_xor(s, 4); s += __shfl_xor(s, 8);
        if (sub == 0) rstdS[row] = rsqrtf(s * (1.f / 2048.f) + EPS);
        __syncthreads(); }
    const int kper = K >> 3, nks = kper >> 5, k0 = wave * kper;
    for (int j = G - 1 - c; j < (N >> 4); j += G) {
        f32x4 acc0 = {0.f, 0.f, 0.f, 0.f}, acc1 = {0.f, 0.f, 0.f, 0.f};
        const bf16_t* bp = Bt + (size_t)(16 * j + i16) * K + k0 + 8 * q4; const bf16_t* ap = A + (size_t)i16 * K + k0 + 8 * q4;
#pragma unroll 4
        for (int ks = 0; ks < nks; ++ks) { const bf16x8 bf = *(const bf16x8*)(bp + 32 * ks), a0 = *(const bf16x8*)(ap + 32 * ks), a1 = *(const bf16x8*)(ap + (size_t)16 * K + 32 * ks);
            acc0 = mma16(a0, bf, acc0); acc1 = mma16(a1, bf, acc1); }
        part[(wave * 2 + 0) * 64 + lane] = acc0; part[(wave * 2 + 1) * 64 + lane] = acc1;
        __syncthreads();
        if (wave < 2) {
            f32x4 s = part[wave * 64 + lane];
#pragma unroll
            for (int w = 1; w < 8; ++w) s += part[(w * 2 + wave) * 64 + lane];
            const int col = 16 * j + i16;
#pragma unroll
            for (int i = 0; i < 4; ++i) { const int r = 16 * wave + 4 * q4 + i;
                if (MODE == 0) Ob[(size_t)r * ldo + col] = (bf16_t)f2bf(s[i] * rstdS[r]);
                else if (MODE == 1) { const float xo = Xs[(size_t)r * DM + col] + s[i]; Xs[(size_t)r * DM + col] = xo; XBs[(size_t)r * DM + col] = (bf16_t)f2bf(xo);
                    float sq = xo * xo; sq += __shfl_xor(sq, 1); sq += __shfl_xor(sq, 2); sq += __shfl_xor(sq, 4); sq += __shfl_xor(sq, 8);
                    if (i16 == 0) SSQS[r * 128 + j] = sq; }
                else Os[(size_t)r * DM + col] = Xs[(size_t)r * DM + col] + s[i]; }
        }
        __syncthreads();
    }
}

__device__ __forceinline__ void prep_row(bf16_t* QKV, const float* qg, const float* kg, float* out, int ia, int r, int lane) {
    const int hh = lane >> 3, sub = lane & 7;
    const bool samp = r >= MP;
    const int b = samp ? ((r - MP) >> 2) : (r >> 11), s = samp ? ((r - MP) & 3) : (r & 2047), pos = samp ? PAST + s : s;
    float cs[8], sn[8];
#pragma unroll
    for (int j = 0; j < 8; ++j) { const float invf = powf(10000.f, -(float)(8 * sub + j) * (1.f / 64.f)); const float ang = (float)pos * invf; sincosf(ang, &sn[j], &cs[j]); }
#pragma unroll 1
    for (int g = 0; g < 3; ++g) {
        const int win = 128 << (2 * g);
#pragma unroll
        for (int t = 0; t < 3; ++t) {
            bf16_t* p = QKV + (size_t)r * NQKV + ((g * 3 + t) * 8 + hh) * 128;
            const u32x4 w0 = *(const u32x4*)(p + 8 * sub), w1 = *(const u32x4*)(p + 64 + 8 * sub);
            float x1[8], x2[8];
            x1[0] = bflo(w0.x); x1[1] = bfhi(w0.x); x1[2] = bflo(w0.y); x1[3] = bfhi(w0.y); x1[4] = bflo(w0.z); x1[5] = bfhi(w0.z); x1[6] = bflo(w0.w); x1[7] = bfhi(w0.w);
            x2[0] = bflo(w1.x); x2[1] = bfhi(w1.x); x2[2] = bflo(w1.y); x2[3] = bfhi(w1.y); x2[4] = bflo(w1.z); x2[5] = bfhi(w1.z); x2[6] = bflo(w1.w); x2[7] = bfhi(w1.w);
            if (t < 2) {
                float ss = 0.f;
#pragma unroll
                for (int j = 0; j < 8; ++j) ss += x1[j] * x1[j] + x2[j] * x2[j];
                ss += __shfl_xor(ss, 1); ss += __shfl_xor(ss, 2); ss += __shfl_xor(ss, 4);
                const float rstd = rsqrtf(ss * (1.f / 128.f) + EPS);
                const float* gn = (t == 0) ? qg : kg;
#pragma unroll
                for (int j = 0; j < 8; ++j) { const float y1 = x1[j] * rstd * gn[8 * sub + j], y2 = x2[j] * rstd * gn[64 + 8 * sub + j];
                    x1[j] = y1 * cs[j] - y2 * sn[j]; x2[j] = y2 * cs[j] + y1 * sn[j]; }
                u32x4 o0, o1;
                o0.x = pk2(x1[0], x1[1]); o0.y = pk2(x1[2], x1[3]); o0.z = pk2(x1[4], x1[5]); o0.w = pk2(x1[6], x1[7]);
                o1.x = pk2(x2[0], x2[1]); o1.y = pk2(x2[2], x2[3]); o1.z = pk2(x2[4], x2[5]); o1.w = pk2(x2[6], x2[7]);
                *(u32x4*)(p + 8 * sub) = o0; *(u32x4*)(p + 64 + 8 * sub) = o1;
            }
            if (t >= 1) {
                const int kv = t - 1;
                const size_t obase = (g == 0) ? (samp ? O_KV128S : O_KV128P) : (g == 1) ? (samp ? O_KV512S : O_KV512P) : (samp ? O_KV2048S : O_KV2048P);
                const int j = samp ? (win - TSAMP + s) : (s - (SEQ - win));
                if (j >= 0) {
                    const int nb = samp ? NBS : NBP;
                    float* dst = out + obase + ((((size_t)(ia * nb + b) * win + j) * 2 + kv) * 8 + hh) * 128;
                    *(f32x4*)(dst + 8 * sub) = (f32x4){x1[0], x1[1], x1[2], x1[3]}; *(f32x4*)(dst + 8 * sub + 4) = (f32x4){x1[4], x1[5], x1[6], x1[7]};
                    *(f32x4*)(dst + 64 + 8 * sub) = (f32x4){x2[0], x2[1], x2[2], x2[3]}; *(f32x4*)(dst + 64 + 8 * sub + 4) = (f32x4){x2[4], x2[5], x2[6], x2[7]};
                }
            }
        }
    }
}

constexpr int AT_PITCH = 272, AT_KOFF = 0, AT_VOFF = 256 * AT_PITCH;
__device__ __forceinline__ void attn_item(LAS unsigned char* lds, unsigned lds_base, const bf16_t* QKV, bf16_t* OG, float* LSE, int item, int tid, int wave, int lane) {
    const int g = item >> 9, rem = item & 511, b = rem >> 7, h = (rem >> 4) & 7, idx = rem & 15;
    const int dil = (g == 0) ? 1 : (g == 1) ? 4 : 16;
    const int r = (g == 0) ? 0 : (g == 1) ? (idx >> 2) : idx;
    const int qb = (g == 0) ? idx : (g == 1) ? (idx & 3) : 0;
    const int cq = (g * 3 * 8 + h) * 128, ck = cq + 1024, cv = cq + 2048;
    const size_t rowbase = (size_t)b * SEQ + r;
    const int uk0 = 128 * (qb - 1);
    const int i16 = lane & 15, q4 = lane >> 4, qq = i16 >> 2, p = lane & 3;
#pragma unroll
    for (int i = 0; i < 8; ++i) {
        const int id = tid + 512 * i, kk = id >> 4, ch = id & 15, u = uk0 + kk;
        u32x4 kvv = {0u, 0u, 0u, 0u}, vvv = {0u, 0u, 0u, 0u};
        if (u >= 0) { const bf16_t* src = QKV + (rowbase + (size_t)u * dil) * NQKV + 8 * ch; kvv = *(const u32x4*)(src + ck); vvv = *(const u32x4*)(src + cv); }
        *(LAS u32x4*)(lds + AT_KOFF + kk * AT_PITCH + ch * 16) = kvv;
        *(LAS u32x4*)(lds + AT_VOFF + kk * AT_PITCH + ch * 16) = vvv;
    }
    const int tqa = 16 * wave + i16;
    const size_t grow = rowbase + (size_t)(128 * qb + tqa) * dil;
    bf16x8 Qf[4];
#pragma unroll
    for (int ks = 0; ks < 4; ++ks) Qf[ks] = *(const bf16x8*)(QKV + grow * NQKV + cq + 32 * ks + 8 * q4);
    __syncthreads();
    const int cb0 = wave & ~1;
    f32x4 S[10];
#pragma unroll
    for (int c = 0; c < 10; ++c) {
        f32x4 acc = {0.f, 0.f, 0.f, 0.f};
#pragma unroll
        for (int ks = 0; ks < 4; ++ks) { const bf16x8 kf = *(const LAS bf16x8*)(lds + AT_KOFF + (16 * (cb0 + c) + i16) * AT_PITCH + (32 * ks + 8 * q4) * 2); acc = mma16(kf, Qf[ks], acc); }
        S[c] = acc;
    }
    const float sc = 0.08838834764831845f * 1.4426950408889634f;
    float mx = -INFINITY;
#pragma unroll
    for (int c = 0; c < 10; ++c)
#pragma unroll
        for (int i = 0; i < 4; ++i) { const int kk = 16 * (cb0 + c) + 4 * q4 + i; const bool ok = (kk >= tqa) && (kk <= tqa + 128) && (qb > 0 || kk >= 128);
            const float s = ok ? S[c][i] * sc : -INFINITY; S[c][i] = s; mx = fmaxf(mx, s); }
    mx = fmaxf(mx, __shfl_xor(mx, 16)); mx = fmaxf(mx, __shfl_xor(mx, 32));
    float l = 0.f;
#pragma unroll
    for (int c = 0; c < 10; ++c)
#pragma unroll
        for (int i = 0; i < 4; ++i) { const float pv = exp2f(S[c][i] - mx); S[c][i] = pv; l += pv; }
    l += __shfl_xor(l, 16); l += __shfl_xor(l, 32);
    bf16x8 Pf[5];
#pragma unroll
    for (int kst = 0; kst < 5; ++kst) Pf[kst] = pack8(S[2 * kst], S[2 * kst + 1]);
    const float inv = 1.f / l;
    bf16_t* orow = OG + grow * 3072 + g * 1024 + h * 128 + 4 * q4;
    const unsigned vbase = lds_base + AT_VOFF + (16 * cb0 + 4 * q4 + qq) * AT_PITCH + 8 * p;
#pragma unroll
    for (int eb = 0; eb < 8; ++eb) {
        f32x4 acc = {0.f, 0.f, 0.f, 0.f};
#pragma unroll
        for (int kst = 0; kst < 5; ++kst) {
            const bf16x8 vf = tr_read2(vbase, 32 * kst * AT_PITCH + 32 * eb, (32 * kst + 16) * AT_PITCH + 32 * eb);
            acc = mma16(vf, Pf[kst], acc);
        }
        u32x2 w; w.x = pk2(acc[0] * inv, acc[1] * inv); w.y = pk2(acc[2] * inv, acc[3] * inv);
        *(u32x2*)(orow + 16 * eb) = w;
    }
    if (q4 == 0) LSE[grow * 24 + g * 8 + h] = (mx + log2f(l)) * 0.6931471805599453f;
    __syncthreads();
}

__device__ __forceinline__ void attn_sample_task(LAS unsigned char* wl  , const bf16_t* QKV, const float* c128, const float* c512, const float* c2048, bf16_t* OG, float* LSE, int ia, int wt, int lane) {
    const int bs = wt / 96, rem = wt % 96, g = rem >> 5, h = (rem >> 2) & 7, t = rem & 3;
    const int win = 128 << (2 * g), dil = 1 << (2 * g);
    const float* cache = ((g == 0) ? c128 : (g == 1) ? c512 : c2048) + (size_t)(ia * NBS + bs) * win * 2048;
    const int cq = (g * 3 * 8 + h) * 128, ck = cq + 1024, cv = cq + 2048;
    const size_t rq = (size_t)MP + bs * 4 + t;
    LAS float* qs = (LAS float*)wl; LAS float* ps = (LAS float*)(wl + 512);
    { const unsigned w = *(const unsigned*)(QKV + rq * NQKV + cq + 2 * lane); qs[2 * lane] = bflo(w); qs[2 * lane + 1] = bfhi(w); }
    asm volatile("s_waitcnt lgkmcnt(0)" ::: "memory");
    float sv[3];
#pragma unroll
    for (int pass = 0; pass < 3; ++pass) {
        const int j = pass * 64 + lane; float s = -INFINITY;
        if (j <= 128) {
            const int idx = win + t - dil * j; float acc = 0.f;
            if (idx >= win) { const bf16_t* kp = QKV + ((size_t)MP + bs * 4 + (idx - win)) * NQKV + ck;
                for (int d = 0; d < 128; d += 8) { const u32x4 w = *(const u32x4*)(kp + d); const LAS float* q = qs + d;
                    acc += q[0] * bflo(w.x) + q[1] * bfhi(w.x) + q[2] * bflo(w.y) + q[3] * bfhi(w.y) + q[4] * bflo(w.z) + q[5] * bfhi(w.z) + q[6] * bflo(w.w) + q[7] * bfhi(w.w); } }
            else { const float* kp = cache + ((size_t)idx * 2 + 0) * 1024 + h * 128;
                for (int d = 0; d < 128; d += 4) { const f32x4 kx = *(const f32x4*)(kp + d); const LAS float* q = qs + d; acc += q[0] * kx.x + q[1] * kx.y + q[2] * kx.z + q[3] * kx.w; } }
            s = acc * 0.08838834764831845f;
        }
        sv[pass] = s;
    }
    const float mx = wave_max(fmaxf(fmaxf(sv[0], sv[1]), sv[2]));
    float l = 0.f;
#pragma unroll
    for (int pass = 0; pass < 3; ++pass) { const float pv = fexp(sv[pass] - mx); l += pv; ps[pass * 64 + lane] = pv; }
    l = wave_sum(l);
    asm volatile("s_waitcnt lgkmcnt(0)" ::: "memory");
    float o0 = 0.f, o1 = 0.f;
#pragma unroll 4
    for (int j = 0; j <= 128; ++j) {
        const int idx = win + t - dil * j; const float pj = ps[j]; float v0, v1;
        if (idx >= win) { const unsigned w = *(const unsigned*)(QKV + ((size_t)MP + bs * 4 + (idx - win)) * NQKV + cv + 2 * lane); v0 = bflo(w); v1 = bfhi(w); }
        else { const f32x2 vx = *(const f32x2*)(cache + ((size_t)idx * 2 + 1) * 1024 + h * 128 + 2 * lane); v0 = vx.x; v1 = vx.y; }
        o0 += pj * v0; o1 += pj * v1;
    }
    const float inv = 1.f / l;
    *(unsigned*)(OG + rq * 3072 + g * 1024 + h * 128 + 2 * lane) = pk2(o0 * inv, o1 * inv);
    if (lane == 0) LSE[rq * 24 + g * 8 + h] = mx + logf(l);
}

__device__ __forceinline__ void combine_row(const bf16_t* OG, const float* LSE, bf16_t* OC, int r, int lane) {
    const int hh = lane >> 3;
    const float l0 = LSE[(size_t)r * 24 + hh], l1 = LSE[(size_t)r * 24 + 8 + hh], l2 = LSE[(size_t)r * 24 + 16 + hh];
    const float mx = fmaxf(l0, fmaxf(l1, l2));
    float e0 = fexp(l0 - mx), e1 = fexp(l1 - mx), e2 = fexp(l2 - mx);
    const float inv = 1.f / (e0 + e1 + e2); e0 *= inv; e1 *= inv; e2 *= inv;
    const bf16_t* src = OG + (size_t)r * 3072 + 16 * lane;
#pragma unroll
    for (int c = 0; c < 2; ++c) {
        const u32x4 a = *(const u32x4*)(src + 8 * c), bq = *(const u32x4*)(src + 1024 + 8 * c), cc = *(const u32x4*)(src + 2048 + 8 * c);
        u32x4 o;
        o.x = pk2(e0 * bflo(a.x) + e1 * bflo(bq.x) + e2 * bflo(cc.x), e0 * bfhi(a.x) + e1 * bfhi(bq.x) + e2 * bfhi(cc.x));
        o.y = pk2(e0 * bflo(a.y) + e1 * bflo(bq.y) + e2 * bflo(cc.y), e0 * bfhi(a.y) + e1 * bfhi(bq.y) + e2 * bfhi(cc.y));
        o.z = pk2(e0 * bflo(a.z) + e1 * bflo(bq.z) + e2 * bflo(cc.z), e0 * bfhi(a.z) + e1 * bfhi(bq.z) + e2 * bfhi(cc.z));
        o.w = pk2(e0 * bflo(a.w) + e1 * bflo(bq.w) + e2 * bflo(cc.w), e0 * bfhi(a.w) + e1 * bfhi(bq.w) + e2 * bfhi(cc.w));
        *(u32x4*)(OC + (size_t)r * DO + 16 * lane + 8 * c) = o;
    }
}

__device__ __forceinline__ float scan_sum(float v, int lane) {
#pragma unroll
    for (int o = 1; o < 64; o <<= 1) { const float t = __shfl_up(v, o); if (lane >= o) v += t; }
    return v;
}
__device__ __forceinline__ float scan_max(float v, int lane) {
#pragma unroll
    for (int o = 1; o < 64; o <<= 1) { const float t = __shfl_up(v, o); if (lane >= o) v = fmaxf(v, t); }
    return v;
}
constexpr int ML_QP = 272, ML_VP = 80, ML_PP = 144;
constexpr int ML_QSZ = 64 * ML_QP, ML_VSZ = 64 * ML_VP;
constexpr int ML_Q = 0, ML_K = ML_Q + 2 * ML_QSZ, ML_V = ML_K + 2 * ML_QSZ, ML_KW = ML_V + 2 * ML_VSZ, ML_P = ML_KW + ML_QSZ, ML_N = ML_P + 64 * ML_PP, ML_DEN = ML_N + 1024, ML_END = ML_DEN + 256;
__device__ __forceinline__ void mlstm_prompt(LAS unsigned char* lds, unsigned lds_base, const bf16_t* QKVO, const float* GATES, bf16_t* HRAW, float* SQ, float* out, int ib, int bh, int sl, int tid, int wave, int lane) {
    const int b = bh >> 3, h = bh & 7;
    const int i16 = lane & 15, q4 = lane >> 4, qq = i16 >> 2, p = lane & 3;
    const int rb = wave >> 1, ea = wave & 1, e0 = 32 * sl + 16 * ea;
    f32x4 CT[8];
#pragma unroll
    for (int d = 0; d < 8; ++d) CT[d] = (f32x4){0.f, 0.f, 0.f, 0.f};
    float m = 0.f;
    const unsigned vbase0 = lds_base + ML_V + (8 * q4 + qq) * ML_VP + (16 * ea + 4 * p) * 2, kwbase = lds_base + ML_KW + (8 * q4 + qq) * ML_QP + 8 * p;
    LAS float* nS = (LAS float*)(lds + ML_N); LAS float* denS = (LAS float*)(lds + ML_DEN);
    const size_t rbase = (size_t)b * SEQ;
    const int srow0 = tid >> 4, sch = tid & 15, vrow = (tid >> 2) & 63, vch = tid & 3;
    u32x4 pq0, pq1, pk0, pk1, pv; float pig, plf;
    { const bf16_t* s0 = QKVO + (rbase + srow0) * NIN + h * 128 + 8 * sch; const bf16_t* s1 = s0 + (size_t)32 * NIN;
      pq0 = *(const u32x4*)s0; pk0 = *(const u32x4*)(s0 + 1024); pq1 = *(const u32x4*)s1; pk1 = *(const u32x4*)(s1 + 1024);
      pv = *(const u32x4*)(QKVO + (rbase + vrow) * NIN + 2048 + h * 256 + 32 * sl + 8 * vch);
      pig = GATES[(rbase + lane) * 16 + h]; plf = GATES[(rbase + lane) * 16 + 8 + h]; }
    __syncthreads();
    if (tid < 128) nS[tid] = 0.f;
    *(LAS u32x4*)(lds + ML_Q + srow0 * ML_QP + sch * 16) = pq0; *(LAS u32x4*)(lds + ML_Q + (srow0 + 32) * ML_QP + sch * 16) = pq1;
    *(LAS u32x4*)(lds + ML_K + srow0 * ML_QP + sch * 16) = pk0; *(LAS u32x4*)(lds + ML_K + (srow0 + 32) * ML_QP + sch * 16) = pk1;
    if (tid < 256) *(LAS u32x4*)(lds + ML_V + vrow * ML_VP + vch * 16) = pv;
    __syncthreads();
#pragma unroll 1
    for (int c = 0; c < 32; ++c) {
        const int cur = c & 1, nxt = cur ^ 1;
        const size_t r0 = rbase + 64 * c;
        const LAS unsigned char* Qc = lds + ML_Q + cur * ML_QSZ; const LAS unsigned char* Kc = lds + ML_K + cur * ML_QSZ;
        const float ig = pig, lf = plf;
        { const size_t rn = rbase + 64 * ((c < 31) ? c + 1 : c);
          const bf16_t* s0 = QKVO + (rn + srow0) * NIN + h * 128 + 8 * sch; const bf16_t* s1 = s0 + (size_t)32 * NIN;
          pq0 = *(const u32x4*)s0; pk0 = *(const u32x4*)(s0 + 1024); pq1 = *(const u32x4*)s1; pk1 = *(const u32x4*)(s1 + 1024);
          pv = *(const u32x4*)(QKVO + (rn + vrow) * NIN + 2048 + h * 256 + 32 * sl + 8 * vch);
          pig = GATES[(rn + lane) * 16 + h]; plf = GATES[(rn + lane) * 16 + 8 + h]; }
        const float bcum = scan_sum(lf, lane);
        const float av = ig - bcum;
        const float Av = fmaxf(m, scan_max(av, lane));
        const float bL = __shfl(bcum, 63), A63 = __shfl(Av, 63);
        const float wsv = fexp(av - A63), wC = fexp(m - A63);
#pragma unroll
        for (int i = 0; i < 2; ++i) { const int id = lane + 64 * i, rr = 8 * wave + (id >> 4), ch = id & 15;
            const u32x4 kx = *(const LAS u32x4*)(Kc + rr * ML_QP + ch * 16); const float w = __shfl(wsv, rr);
            u32x4 o; o.x = pk2(bflo(kx.x) * w, bfhi(kx.x) * w); o.y = pk2(bflo(kx.y) * w, bfhi(kx.y) * w); o.z = pk2(bflo(kx.z) * w, bfhi(kx.z) * w); o.w = pk2(bflo(kx.w) * w, bfhi(kx.w) * w);
            *(LAS u32x4*)(lds + ML_KW + rr * ML_QP + ch * 16) = o; }
        {
#pragma unroll
          for (int cc = 0; cc < 2; ++cc) { const int cb = 2 * (wave & 1) + cc;
            f32x4 s = {0.f, 0.f, 0.f, 0.f};
            if (cb <= rb) {
#pragma unroll
                for (int ks = 0; ks < 4; ++ks) { const bf16x8 af = *(const LAS bf16x8*)(Qc + (16 * rb + i16) * ML_QP + (32 * ks + 8 * q4) * 2);
                    const bf16x8 bf = *(const LAS bf16x8*)(Kc + (16 * cb + i16) * ML_QP + (32 * ks + 8 * q4) * 2); s = mma16(af, bf, s); } }
            const int sidx = 16 * cb + i16; const float as = __shfl(av, sidx);
#pragma unroll
            for (int i = 0; i < 4; ++i) { const int t = 16 * rb + 4 * q4 + i; const float At = __shfl(Av, t);
                const float pv_ = (sidx <= t && cb <= rb) ? s[i] * fexp(as - At) : 0.f;
                *(LAS bf16_t*)(lds + ML_P + t * ML_PP + sidx * 2) = (bf16_t)f2bf(pv_); } } }
        __syncthreads();
        { const int t = tid >> 3, part = tid & 7;
          const LAS unsigned char* qrow = Qc + t * ML_QP + part * 32;
          const u32x4 qa = *(const LAS u32x4*)(qrow), qb = *(const LAS u32x4*)(qrow + 16);
          const LAS float* nn = nS + cur * 128 + 16 * part;
          float a = nn[0] * bflo(qa.x) + nn[1] * bfhi(qa.x) + nn[2] * bflo(qa.y) + nn[3] * bfhi(qa.y) + nn[4] * bflo(qa.z) + nn[5] * bfhi(qa.z) + nn[6] * bflo(qa.w) + nn[7] * bfhi(qa.w)
                  + nn[8] * bflo(qb.x) + nn[9] * bfhi(qb.x) + nn[10] * bflo(qb.y) + nn[11] * bfhi(qb.y) + nn[12] * bflo(qb.z) + nn[13] * bfhi(qb.z) + nn[14] * bflo(qb.w) + nn[15] * bfhi(qb.w);
          const u32x4 pr = *(const LAS u32x4*)(lds + ML_P + t * ML_PP + part * 16);
          const float rsum = ((bflo(pr.x) + bfhi(pr.x)) + (bflo(pr.y) + bfhi(pr.y))) + ((bflo(pr.z) + bfhi(pr.z)) + (bflo(pr.w) + bfhi(pr.w)));
          const float At = __shfl(Av, t), bt = __shfl(bcum, t);
          float val = fexp(m - At) * a + rsum;
          val += __shfl_xor(val, 1); val += __shfl_xor(val, 2); val += __shfl_xor(val, 4);
          if (part == 0) denS[t] = 1.f / fmaxf(fabsf(val), fexp(-(bt + At))); }
        if (tid < 128) { float acc = wC * nS[cur * 128 + tid];
#pragma unroll 8
            for (int s = 0; s < 64; ++s) acc += bf1(*(const LAS bf16_t*)(lds + ML_KW + s * ML_QP + tid * 2));
            nS[nxt * 128 + tid] = acc; }
        f32x4 num = {0.f, 0.f, 0.f, 0.f};
#pragma unroll
        for (int ks = 0; ks < 4; ++ks) { const LAS unsigned char* qrow = Qc + (16 * rb + i16) * ML_QP;
            const u32x2 lo = *(const LAS u32x2*)(qrow + (32 * ks + 4 * q4) * 2), hi = *(const LAS u32x2*)(qrow + (32 * ks + 16 + 4 * q4) * 2);
            u32x4 w; w.x = lo.x; w.y = lo.y; w.z = hi.x; w.w = hi.y;
            num = mma16(__builtin_bit_cast(bf16x8, w), pack8(CT[2 * ks], CT[2 * ks + 1]), num); }
#pragma unroll
        for (int i = 0; i < 4; ++i) num[i] *= fexp(m - __shfl(Av, 16 * rb + 4 * q4 + i));
        const unsigned vbase = vbase0 + cur * ML_VSZ;
        bf16x8 Vf[2];
#pragma unroll
        for (int ks = 0; ks < 2; ++ks) Vf[ks] = tr_read2(vbase, 32 * ks * ML_VP, (32 * ks + 4) * ML_VP);
#pragma unroll
        for (int ks = 0; ks < 2; ++ks) { const bf16x8 pf = *(const LAS bf16x8*)(lds + ML_P + (16 * rb + i16) * ML_PP + (32 * ks + 8 * q4) * 2); num = mma16(pf, Vf[ks], num); }
#pragma unroll
        for (int d = 0; d < 8; ++d) CT[d] = CT[d] * wC;
#pragma unroll
        for (int ks = 0; ks < 2; ++ks)
#pragma unroll
            for (int d = 0; d < 8; ++d) { const bf16x8 kf = tr_read2(kwbase, 32 * ks * ML_QP + 32 * d, (32 * ks + 4) * ML_QP + 32 * d); CT[d] = mma16(kf, Vf[ks], CT[d]); }
        { LAS unsigned char* Qn = lds + ML_Q + nxt * ML_QSZ; LAS unsigned char* Kn = lds + ML_K + nxt * ML_QSZ;
          *(LAS u32x4*)(Qn + srow0 * ML_QP + sch * 16) = pq0; *(LAS u32x4*)(Qn + (srow0 + 32) * ML_QP + sch * 16) = pq1;
          *(LAS u32x4*)(Kn + srow0 * ML_QP + sch * 16) = pk0; *(LAS u32x4*)(Kn + (srow0 + 32) * ML_QP + sch * 16) = pk1;
          if (tid < 256) *(LAS u32x4*)(lds + ML_V + nxt * ML_VSZ + vrow * ML_VP + vch * 16) = pv; }
        __syncthreads();
#pragma unroll
        for (int i = 0; i < 4; ++i) { const int t = 16 * rb + 4 * q4 + i; const float hv = num[i] * denS[t];
            HRAW[(r0 + t) * DM + h * 256 + e0 + i16] = (bf16_t)f2bf(hv);
            float sq = hv * hv; sq += __shfl_xor(sq, 1); sq += __shfl_xor(sq, 2); sq += __shfl_xor(sq, 4); sq += __shfl_xor(sq, 8);
            if (i16 == 0) SQ[(r0 + t) * 128 + h * 16 + 2 * sl + ea] = sq; }
        m = bL + A63;
    }
    const size_t sb = (size_t)(ib * NBP + b) * 8 + h;
    if (rb == 0) {
#pragma unroll
        for (int d = 0; d < 8; ++d) *(f32x4*)(out + O_CP + (sb * 256 + e0 + i16) * 128 + 16 * d + 4 * q4) = CT[d]; }
    if (sl == 0) { if (tid < 128) out[O_NP + sb * 128 + tid] = nS[tid]; if (tid == 0) out[O_MP + sb] = m; }
}

__device__ __forceinline__ void hn_row(const bf16_t* HRAW, const float* SQ, const bf16_t* QKVO, const float* gh, bf16_t* HN, int r, int lane) {
    const int hh = lane >> 3;
    const f32x4 s0 = *(const f32x4*)(SQ + (size_t)r * 128 + hh * 16), s1 = *(const f32x4*)(SQ + (size_t)r * 128 + hh * 16 + 4), s2 = *(const f32x4*)(SQ + (size_t)r * 128 + hh * 16 + 8), s3 = *(const f32x4*)(SQ + (size_t)r * 128 + hh * 16 + 12);
    const float tot = (((s0[0] + s0[1]) + (s0[2] + s0[3])) + ((s1[0] + s1[1]) + (s1[2] + s1[3]))) + (((s2[0] + s2[1]) + (s2[2] + s2[3])) + ((s3[0] + s3[1]) + (s3[2] + s3[3])));
    const float rs = rsqrtf(tot * (1.f / 256.f) + EPS);
#pragma unroll
    for (int c = 0; c < 4; ++c) { const int col = 32 * lane + 8 * c;
        const u32x4 hx = *(const u32x4*)(HRAW + (size_t)r * DM + col), ox = *(const u32x4*)(QKVO + (size_t)r * NIN + 4096 + col);
        const f32x4 g0 = *(const f32x4*)(gh + col), g1 = *(const f32x4*)(gh + col + 4);
        u32x4 o;
        o.x = pk2(bflo(hx.x) * rs * g0[0] / (1.f + fexp(-bflo(ox.x))), bfhi(hx.x) * rs * g0[1] / (1.f + fexp(-bfhi(ox.x))));
        o.y = pk2(bflo(hx.y) * rs * g0[2] / (1.f + fexp(-bflo(ox.y))), bfhi(hx.y) * rs * g0[3] / (1.f + fexp(-bfhi(ox.y))));
        o.z = pk2(bflo(hx.z) * rs * g1[0] / (1.f + fexp(-bflo(ox.z))), bfhi(hx.z) * rs * g1[1] / (1.f + fexp(-bfhi(ox.z))));
        o.w = pk2(bflo(hx.w) * rs * g1[2] / (1.f + fexp(-bflo(ox.w))), bfhi(hx.w) * rs * g1[3] / (1.f + fexp(-bfhi(ox.w))));
        *(u32x4*)(HN + (size_t)r * DM + col) = o; }
}

__device__ __forceinline__ void mlstm_sample(LAS unsigned char* lds, const bf16_t* QKVO, const float* GATES, const float* gh, const float* C0all, const float* n0all, const float* m0all, bf16_t* HN, float* out, int ib, int bh, int tid, int wave, int lane) {
    const int bs = bh >> 3, h = bh & 7;
    const size_t sb = (size_t)(ib * NBS + bs) * 8 + h;
    LAS float* qs = (LAS float*)lds;
    LAS float* ks = qs + 512;
    LAS float* ns = ks + 512;
    LAS float* Ss = ns + 128;
    LAS float* nq = Ss + 16;
    LAS float* red = nq + 16;
    const size_t r0 = (size_t)MP + bs * 4;
    __syncthreads();
    { const int t = tid >> 7, d = tid & 127; qs[tid] = bf1(QKVO[(r0 + t) * NIN + h * 128 + d]); ks[tid] = bf1(QKVO[(r0 + t) * NIN + 1024 + h * 128 + d]); if (tid < 128) ns[tid] = n0all[sb * 128 + tid]; }
    __syncthreads();
    if (wave == 0) {
        if (lane < 16) { const int t = lane >> 2, s = lane & 3; float a = 0.f; for (int d = 0; d < 128; ++d) a += qs[t * 128 + d] * ks[s * 128 + d]; Ss[lane] = a; }
        else if (lane < 20) { const int t = lane - 16; float a = 0.f; for (int d = 0; d < 128; ++d) a += ns[d] * qs[t * 128 + d]; nq[t] = a; }
    }
    __syncthreads();
    const float m0 = m0all[sb];
    float bc[4], av[4], Av[4];
    { float run = 0.f, pm = -INFINITY;
#pragma unroll
      for (int t = 0; t < 4; ++t) { const float ig = GATES[(r0 + t) * 16 + h], lf = GATES[(r0 + t) * 16 + 8 + h]; run += lf; bc[t] = run; av[t] = ig - run; pm = fmaxf(pm, av[t]); Av[t] = fmaxf(m0, pm); } }
    const float A3 = Av[3], wC = fexp(m0 - A3);
    float Pm[4][4], den[4];
#pragma unroll
    for (int t = 0; t < 4; ++t) { float rs = 0.f;
#pragma unroll
        for (int s = 0; s < 4; ++s) { Pm[t][s] = (s <= t) ? Ss[t * 4 + s] * fexp(av[s] - Av[t]) : 0.f; rs += Pm[t][s]; }
        den[t] = fexp(m0 - Av[t]) * nq[t] + rs; }
    const int e = tid >> 1, hf = tid & 1;
    const float* Crow = C0all + (sb * 256 + e) * 128 + 64 * hf;
    f32x4 Cv[16];
#pragma unroll
    for (int j = 0; j < 16; ++j) Cv[j] = *(const f32x4*)(Crow + 4 * j);
    float inter[4];
#pragma unroll
    for (int t = 0; t < 4; ++t) { float a = 0.f; const LAS float* q = qs + t * 128 + 64 * hf;
#pragma unroll
        for (int j = 0; j < 16; ++j) a += Cv[j].x * q[4 * j] + Cv[j].y * q[4 * j + 1] + Cv[j].z * q[4 * j + 2] + Cv[j].w * q[4 * j + 3];
        a += __shfl_xor(a, 1); inter[t] = a; }
    float vv[4];
#pragma unroll
    for (int s = 0; s < 4; ++s) vv[s] = bf1(QKVO[(r0 + s) * NIN + 2048 + h * 256 + e]);
    float hv[4];
#pragma unroll
    for (int t = 0; t < 4; ++t) { float nu = fexp(m0 - Av[t]) * inter[t];
#pragma unroll
        for (int s = 0; s < 4; ++s) nu += Pm[t][s] * vv[s];
        hv[t] = nu / fmaxf(fabsf(den[t]), fexp(-(bc[t] + Av[t])));
        float sq = (hf == 0) ? hv[t] * hv[t] : 0.f; sq = wave_sum(sq); if (lane == 0) red[t * 8 + wave] = sq; }
    __syncthreads();
    if (hf == 0) {
#pragma unroll
        for (int t = 0; t < 4; ++t) { float tot = 0.f;
#pragma unroll
            for (int w = 0; w < 8; ++w) tot += red[t * 8 + w];
            const float rs = rsqrtf(tot * (1.f / 256.f) + EPS);
            const float og = bf1(QKVO[(r0 + t) * NIN + 4096 + h * 256 + e]);
            HN[(r0 + t) * DM + h * 256 + e] = (bf16_t)f2bf(hv[t] * rs * gh[h * 256 + e] / (1.f + fexp(-og))); } }
    float wv[4];
#pragma unroll
    for (int s = 0; s < 4; ++s) wv[s] = fexp(av[s] - A3) * vv[s];
    float* Cout = out + O_CS + (sb * 256 + e) * 128 + 64 * hf;
#pragma unroll
    for (int j = 0; j < 16; ++j) { f32x4 o = Cv[j] * wC;
#pragma unroll
        for (int s = 0; s < 4; ++s) { const LAS float* k = ks + s * 128 + 64 * hf + 4 * j; o.x += wv[s] * k[0]; o.y += wv[s] * k[1]; o.z += wv[s] * k[2]; o.w += wv[s] * k[3]; }
        *(f32x4*)(Cout + 4 * j) = o; }
    if (tid < 128) { float o = wC * ns[tid];
#pragma unroll
        for (int s = 0; s < 4; ++s) o += fexp(av[s] - A3) * ks[s * 128 + tid];
        out[O_NS + sb * 128 + tid] = o; }
    if (tid == 0) out[O_MS + sb] = bc[3] + A3;
}

__device__ __forceinline__ void cache_shift(const Params& P, float* outp, int ia, int w, int NW, int lane) {
    constexpr int N0 = NBS * 124, N1 = NBS * 508, N2 = NBS * 2044;
    for (int it = w; it < N0 + N1 + N2; it += NW) {
        int g, q; if (it < N0) { g = 0; q = it; } else if (it < N0 + N1) { g = 1; q = it - N0; } else { g = 2; q = it - N0 - N1; }
        const int win = 128 << (2 * g), per = win - 4, bs = q / per, j = q % per;
        const float* src = P.in[2 + g] + ((size_t)(ia * NBS + bs) * win + j + 4) * 2048;
        float* dst = outp + ((g == 0) ? O_KV128S : (g == 1) ? O_KV512S : O_KV2048S) + ((size_t)(ia * NBS + bs) * win + j) * 2048;
#pragma unroll
        for (int i = 0; i < 8; ++i) ((f32x4*)dst)[lane + 64 * i] = ((const f32x4*)src)[lane + 64 * i];
    }
}

__device__ __forceinline__ void unpack8(const u32x4 w, float (&x)[8]) { x[0] = bflo(w.x); x[1] = bfhi(w.x); x[2] = bflo(w.y); x[3] = bfhi(w.y); x[4] = bflo(w.z); x[5] = bfhi(w.z); x[6] = bflo(w.w); x[7] = bfhi(w.w); }
__device__ __forceinline__ void load8(const float* p, float (&x)[8]) { const f32x4 a = *(const f32x4*)p, b = *(const f32x4*)(p + 4); x[0] = a.x; x[1] = a.y; x[2] = a.z; x[3] = a.w; x[4] = b.x; x[5] = b.y; x[6] = b.z; x[7] = b.w; }
__device__ __forceinline__ void store8(float* p, const float (&x)[8]) { *(f32x4*)p = (f32x4){x[0], x[1], x[2], x[3]}; *(f32x4*)(p + 4) = (f32x4){x[4], x[5], x[6], x[7]}; }
__device__ __forceinline__ void phase_convgate(const Params& P, float* outp, const bf16_t* U, bf16_t* Z, int layer, int gtid, int NGT) {
    constexpr int NCG = DFF / 8, NRUN = MP / 64 + NBS;
    const float* cw = P.in[20] + (size_t)layer * 3 * NUP; const float* cbias = P.in[21] + (size_t)layer * NUP;
    for (int task = gtid; task < NCG * NRUN; task += NGT) {
        const int cg = task % NCG, run = task / NCG, j0 = 8 * cg;
        float wa[3][8], wb[3][8], ba[8], bb[8];
#pragma unroll
        for (int k = 0; k < 3; ++k) { load8(cw + (size_t)k * NUP + j0, wa[k]); load8(cw + (size_t)k * NUP + DFF + j0, wb[k]); }
        load8(cbias + j0, ba); load8(cbias + DFF + j0, bb);
        float a2[8], a1[8], b2[8], b1[8];
        size_t row0; int nrows; float* cout;
        if (run < MP / 64) { const int b = run >> 5, s0 = (run & 31) * 64; row0 = (size_t)b * SEQ + s0; nrows = 64;
            cout = (s0 == SEQ - 64) ? outp + O_CONVP + ((size_t)(layer * NBP + b) * 2) * NUP : nullptr;
            if (s0 == 0) {
#pragma unroll
                for (int j = 0; j < 8; ++j) { a2[j] = 0.f; a1[j] = 0.f; b2[j] = 0.f; b1[j] = 0.f; } }
            else { unpack8(*(const u32x4*)(U + (row0 - 2) * NUP + j0), a2); unpack8(*(const u32x4*)(U + (row0 - 1) * NUP + j0), a1);
                   unpack8(*(const u32x4*)(U + (row0 - 2) * NUP + DFF + j0), b2); unpack8(*(const u32x4*)(U + (row0 - 1) * NUP + DFF + j0), b1); } }
        else { const int bs = run - MP / 64; row0 = (size_t)MP + bs * 4; nrows = 4;
            cout = outp + O_CONVS + ((size_t)(layer * NBS + bs) * 2) * NUP;
            const float* st = P.in[8] + ((size_t)(layer * NBS + bs) * 2) * NUP;
            load8(st + j0, a2); load8(st + NUP + j0, a1); load8(st + DFF + j0, b2); load8(st + NUP + DFF + j0, b1); }
        for (int t = 0; t < nrows; ++t) {
            float a0[8], b0[8];
            unpack8(*(const u32x4*)(U + (row0 + t) * NUP + j0), a0); unpack8(*(const u32x4*)(U + (row0 + t) * NUP + DFF + j0), b0);
            float z[8];
#pragma unroll
            for (int j = 0; j < 8; ++j) { const float ca = ba[j] + wa[0][j] * a2[j] + wa[1][j] * a1[j] + wa[2][j] * a0[j]; const float cb = bb[j] + wb[0][j] * b2[j] + wb[1][j] * b1[j] + wb[2][j] * b0[j];
                z[j] = ca / (1.f + fexp(-ca)) * cb; a2[j] = a1[j]; a1[j] = a0[j]; b2[j] = b1[j]; b1[j] = b0[j]; }
            u32x4 o; o.x = pk2(z[0], z[1]); o.y = pk2(z[2], z[3]); o.z = pk2(z[4], z[5]); o.w = pk2(z[6], z[7]);
            *(u32x4*)(Z + (row0 + t) * DFF + j0) = o;
        }
        if (cout) { store8(cout + j0, a2); store8(cout + NUP + j0, a1); store8(cout + DFF + j0, b2); store8(cout + NUP + DFF + j0, b1); }
    }
}

#ifndef REP_STORE
#define REP_STORE 1
#endif
#ifndef REP_CONV
#define REP_CONV 1
#endif
#ifndef REP_ML
#define REP_ML 1
#endif
#ifndef REP_ATT
#define REP_ATT 1
#endif
#ifndef REP_P0
#define REP_P0 1
#endif
#define REPEAT(n, body) do { body; if ((n) > 1) { body; } if ((n) > 2) { body; } } while (0)
__global__ void __launch_bounds__(NTHR, 2) fwd_kernel(Params P) {
    extern __shared__ __attribute__((aligned(16))) unsigned char lds_raw[];
    LAS unsigned char* lds = (LAS unsigned char*)lds_raw;
    const unsigned lds_base = (unsigned)(size_t)lds;
    const int tid0 = threadIdx.x;
    const int G0 = gridDim.x, bx0 = blockIdx.x;
#define PHASE_IDS int tid = tid0; asm volatile("" : "+v"(tid)); int zz_ = 0; asm volatile("" : "+v"(zz_)); zz_ = __builtin_amdgcn_readfirstlane(zz_); const int bx = bx0 + zz_, G = G0 + zz_; unsigned char* ws = P.ws + zz_; float* outp = P.out + zz_; \
    const int lane = tid & 63, wave = __builtin_amdgcn_readfirstlane(tid >> 6); const int gw = bx * NWAVES + wave, gtid = bx * NTHR + tid, NGW = G * NWAVES, NGT = G * NTHR; (void)gw; (void)gtid; (void)lane; (void)NGW; (void)NGT; (void)outp; \
    float* X = (float*)(ws + WS_X); bf16_t* XB = (bf16_t*)(ws + WS_XB); float* SSQ = (float*)(ws + WS_SSQ); float* SSQS = (float*)(ws + WS_SSQS); bf16_t* QKV = (bf16_t*)(ws + WS_QKV); bf16_t* OG = (bf16_t*)(ws + WS_OG); float* LSE = (float*)(ws + WS_LSE); bf16_t* OC = (bf16_t*)(ws + WS_OC); \
    float* GATES = (float*)(ws + WS_GATES); bf16_t* U = (bf16_t*)(ws + WS_U); bf16_t* Z = (bf16_t*)(ws + WS_Z); (void)X; (void)XB; (void)SSQ; (void)SSQS; (void)QKV; (void)OG; (void)LSE; (void)OC; (void)GATES; (void)U; (void)Z;
    volatile LAS unsigned* misc = (volatile LAS unsigned*)(lds + LDS_MISC_OFF);
    if (tid0 < 16) misc[tid0] = 0u;
    __syncthreads();
    { const XcdBarrier bar0 = xcd_barrier_post((unsigned*)(P.ws + WS_CTL) + 1024, misc + 8); if (tid0 == 0) misc[10] = bar0.x; }
    __syncthreads();
#define GRID_BAR() do { XcdBarrier bar_; bar_.bar = (unsigned*)(P.ws + WS_CTL) + 1024; bar_.x = (unsigned)__builtin_amdgcn_readfirstlane((int)misc[10]); bar_.st = misc + 8; xcd_barrier(bar_); } while (0)
#define GEMM_STORE(Abuf, Wt, NN, KK, Obuf) REPEAT(REP_STORE, GEMM_STORE1(Abuf, Wt, NN, KK, Obuf))
#define GEMM_STORE1(Abuf, Wt, NN, KK, Obuf) do { PHASE_IDS; \
        { pg8::Gemm g{Abuf, (const bf16_t*)(Wt), MP, NN, KK}; pg8::StaticOrder S; S.init(MP, NN, G, bx); pg8::EpiStoreN E{Obuf, NN, SSQ, EPS}; \
          pg8::gemm_phase<pg8::EpiStoreN, pg8::StaticOrder, true, true>(lds, g, S, E); } \
        skinny_phase<0>(lds, Abuf + (size_t)MP * KK, KK, (const bf16_t*)(Wt), NN, Obuf + (size_t)MP * NN, NN, nullptr, nullptr, SSQS, nullptr, bx, G, tid, wave, lane); } while (0)
#define GEMM_RESID(Abuf, Wt, KK, FIN) do { PHASE_IDS; \
        { pg8::Gemm g{Abuf, (const bf16_t*)(Wt), MP, DM, KK}; pg8::StaticOrder S; S.init(MP, DM, G, bx); pg8::EpiResidN E{X, (FIN) ? outp : X, (FIN) ? nullptr : XB, (FIN) ? nullptr : SSQ, DM}; \
          pg8::gemm_phase<pg8::EpiResidN, pg8::StaticOrder, true, true>(lds, g, S, E); } \
        if (FIN) skinny_phase<2>(lds, Abuf + (size_t)MP * KK, KK, (const bf16_t*)(Wt), DM, nullptr, 0, X + (size_t)MP * DM, nullptr, nullptr, outp + (size_t)MP * DM, bx, G, tid, wave, lane); \
        else skinny_phase<1>(lds, Abuf + (size_t)MP * KK, KK, (const bf16_t*)(Wt), DM, nullptr, 0, X + (size_t)MP * DM, XB + (size_t)MP * DM, SSQS, nullptr, bx, G, tid, wave, lane); } while (0)

    REPEAT(REP_P0, { PHASE_IDS; phase_prologue(P, lds, gw, NGW, wave, lane); });
    GRID_BAR();

#define FFN(L, FIN) do { \
        GEMM_STORE(XB, ws + WS_WUP + (L) * SZ_WUP, NUP, DM, U); \
        GRID_BAR(); \
        REPEAT(REP_CONV, { PHASE_IDS; phase_convgate(P, outp, U, Z, (L), gtid, NGT); }); \
        GRID_BAR(); \
        GEMM_RESID(Z, ws + WS_WDOWN + (L) * SZ_WDOWN, DFF, FIN); \
    } while (0)

#define LAYER_PAIR(lp) do { \
        { \
            const int ia = (lp); \
            GEMM_STORE(XB, ws + WS_WQKV + ia * SZ_WQKV, NQKV, DM, QKV); \
            GRID_BAR(); \
            { PHASE_IDS; for (int r = gw; r < MR; r += NGW) prep_row(QKV, P.in[12] + ia * 128, P.in[13] + ia * 128, outp, ia, r, lane); } \
            GRID_BAR(); \
            REPEAT(REP_ATT, { PHASE_IDS; for (int it = bx; it < 1536; it += G) attn_item(lds, lds_base, QKV, OG, LSE, it, tid, wave, lane); } \
            { PHASE_IDS; if (gw < NBS * 96) attn_sample_task(lds + wave * 2048, QKV, P.in[2], P.in[3], P.in[4], OG, LSE, ia, gw, lane); __syncthreads(); }); \
            GRID_BAR(); \
            REPEAT(REP_ATT, { PHASE_IDS; for (int r = gw; r < MR; r += NGW) combine_row(OG, LSE, OC, r, lane); }); \
            GRID_BAR(); \
            GEMM_RESID(OC, ws + WS_WO + ia * SZ_WO, DO, false); \
            GRID_BAR(); \
            FFN(2 * (lp), false); \
            GRID_BAR(); \
        } \
        { \
            const int L = 2 * (lp) + 1, ib = (lp); \
            GEMM_STORE(XB, ws + WS_WIN + ib * SZ_WIN, NIN, DM, QKV); \
            { PHASE_IDS; for (int task = gw; task < MR / 16; task += NGW) gate_task(X, P.in[9] + (size_t)L * DM, P.in[15] + (size_t)ib * DM * NIN_SRC, P.in[16] + ib * 16, GATES, task, lane); } \
            GRID_BAR(); \
            REPEAT(REP_ML, { PHASE_IDS; \
            for (int unit = bx; unit < 256; unit += G) mlstm_prompt(lds, lds_base, QKV, GATES, OG, (float*)(ws + WS_SQ), outp, ib, unit >> 3, unit & 7, tid, wave, lane); }); \
            GRID_BAR(); \
            REPEAT(REP_ML, { PHASE_IDS; \
            for (int unit = bx; unit < 64; unit += G) mlstm_sample(lds, QKV, GATES, P.in[17] + (size_t)ib * DM, P.in[5], P.in[6], P.in[7], OC, outp, ib, unit, tid, wave, lane); \
            for (int r = gw; r < MP; r += NGW) hn_row(OG, (const float*)(ws + WS_SQ), QKV, P.in[17] + (size_t)ib * DM, OC, r, lane); \
            cache_shift(P, outp, (lp), gw, NGW, lane); }); \
            GRID_BAR(); \
            GEMM_RESID(OC, ws + WS_WOUT + ib * SZ_WOUT, DM, false); \
            GRID_BAR(); \
            FFN(L, (L == DEPTH - 1)); \
            if ((lp) == 0) GRID_BAR(); \
        } \
    } while (0)
    LAYER_PAIR(0);
    LAYER_PAIR(1);
}

extern "C" void kernel_launch(void* const* d_in, const int* in_sizes, int n_in, void* d_out, int out_size, void* d_ws, size_t ws_size, hipStream_t stream) {
    static int grid = 0;
    if (grid == 0) {
        if (n_in != 23 || (size_t)out_size != O_END || ws_size < WS_END) {
            fprintf(stderr, "kernel_launch: built for 23 inputs, %zu outputs, >= %zu bytes of workspace; got n_in %d, out %d, ws %zu; nothing launched\n", (size_t)O_END, (size_t)WS_END, n_in, out_size, ws_size);
            grid = -1; return; }
        int dev = 0, cus = 0, per_cu = 0;
        if (hipGetDevice(&dev) != hipSuccess || hipDeviceGetAttribute(&cus, hipDeviceAttributeMultiprocessorCount, dev) != hipSuccess) { fprintf(stderr, "kernel_launch: device query failed\n"); grid = -1; return; }
        if (hipFuncSetAttribute((const void*)fwd_kernel, hipFuncAttributeMaxDynamicSharedMemorySize, LDS_BYTES) != hipSuccess) { fprintf(stderr, "kernel_launch: hipFuncSetAttribute failed\n"); grid = -1; return; }
        if (hipOccupancyMaxActiveBlocksPerMultiprocessor(&per_cu, (const void*)fwd_kernel, NTHR, LDS_BYTES) != hipSuccess || per_cu < 1)
            fprintf(stderr, "kernel_launch: occupancy query reports %d workgroups per CU\n", per_cu);
        (void)hipGetLastError();
        grid = cus;
    }
    if (grid < 0) return;
    (void)hipMemsetAsync((char*)d_ws + WS_CTL, 0, CTL_ZERO_BYTES, stream);
    Params p{};
    for (int i = 0; i < 23; ++i) p.in[i] = (const float*)d_in[i];
    p.out = (float*)d_out; p.ws = (unsigned char*)d_ws;
    hipLaunchKernelGGL(fwd_kernel, dim3(grid), dim3(NTHR), LDS_BYTES, stream, p);
    const hipError_t le = hipPeekAtLastError();
    if (le != hipSuccess) fprintf(stderr, "kernel_launch: launch failed: %s\n", hipGetErrorName(le));
}
```

```cpp
#include <hip/hip_runtime.h>
#include <cstdio>
#include <cstdint>

#define LAS __attribute__((address_space(3)))
typedef unsigned short bf16_t;
typedef short bf16x8 __attribute__((ext_vector_type(8)));
typedef float f32x4 __attribute__((ext_vector_type(4)));
typedef float f32x2 __attribute__((ext_vector_type(2)));
typedef unsigned u32x4 __attribute__((ext_vector_type(4)));
typedef unsigned u32x2 __attribute__((ext_vector_type(2)));
typedef unsigned short u16x4 __attribute__((ext_vector_type(4)));

constexpr int DM = 2048, SEQ = 2048, NBP = 4, NBS = 8, TSAMP = 4, PAST = 16384;
constexpr int MP = NBP * SEQ, MSAMP = NBS * TSAMP, MR = MP + MSAMP, MT = 8448;
constexpr int NQKV = 9216, NIN = 6144, NIN_SRC = 6160, DFF = 5632, NUP = 2 * DFF, DO = 1024;
constexpr int DEPTH = 4;
constexpr float EPS = 1e-6f;
constexpr int NWAVES = 8, NTHR = 512;

constexpr size_t O_YP = 0;
constexpr size_t O_YS = O_YP + (size_t)MP * DM;
constexpr size_t O_KV128P = O_YS + (size_t)MSAMP * DM;
constexpr size_t O_KV128S = O_KV128P + (size_t)2 * NBP * 128 * 2048;
constexpr size_t O_KV512P = O_KV128S + (size_t)2 * NBS * 128 * 2048;
constexpr size_t O_KV512S = O_KV512P + (size_t)2 * NBP * 512 * 2048;
constexpr size_t O_KV2048P = O_KV512S + (size_t)2 * NBS * 512 * 2048;
constexpr size_t O_KV2048S = O_KV2048P + (size_t)2 * NBP * 2048 * 2048;
constexpr size_t O_CP = O_KV2048S + (size_t)2 * NBS * 2048 * 2048;
constexpr size_t O_CS = O_CP + (size_t)2 * NBP * 8 * 256 * 128;
constexpr size_t O_NP = O_CS + (size_t)2 * NBS * 8 * 256 * 128;
constexpr size_t O_NS = O_NP + (size_t)2 * NBP * 8 * 128;
constexpr size_t O_MP = O_NS + (size_t)2 * NBS * 8 * 128;
constexpr size_t O_MS = O_MP + (size_t)2 * NBP * 8;
constexpr size_t O_CONVP = O_MS + (size_t)2 * NBS * 8;
constexpr size_t O_CONVS = O_CONVP + (size_t)DEPTH * NBP * 2 * NUP;
constexpr size_t O_END = O_CONVS + (size_t)DEPTH * NBS * 2 * NUP;

constexpr size_t al1m(size_t x) { return (x + 1048575) & ~(size_t)1048575; }
constexpr size_t WS_CTL = 0, CTL_ZERO_BYTES = 1048576;
constexpr size_t SZ_WQKV = (size_t)NQKV * DM * 2, SZ_WO = (size_t)DM * DO * 2, SZ_WIN = (size_t)NIN * DM * 2, SZ_WOUT = (size_t)DM * DM * 2, SZ_WUP = (size_t)NUP * DM * 2, SZ_WDOWN = (size_t)DM * DFF * 2;
constexpr size_t WS_WQKV = al1m(WS_CTL + CTL_ZERO_BYTES);
constexpr size_t WS_WO = al1m(WS_WQKV + 2 * SZ_WQKV);
constexpr size_t WS_WIN = al1m(WS_WO + 2 * SZ_WO);
constexpr size_t WS_WOUT = al1m(WS_WIN + 2 * SZ_WIN);
constexpr size_t WS_WUP = al1m(WS_WOUT + 2 * SZ_WOUT);
constexpr size_t WS_WDOWN = al1m(WS_WUP + 4 * SZ_WUP);
constexpr size_t WS_X = al1m(WS_WDOWN + 4 * SZ_WDOWN);
constexpr size_t WS_XB = al1m(WS_X + (size_t)MT * DM * 4);
constexpr size_t WS_SSQ = al1m(WS_XB + (size_t)MT * DM * 2);
constexpr size_t WS_SSQS = al1m(WS_SSQ + (size_t)MP * 32 * 4);
constexpr size_t WS_QKV = al1m(WS_SSQS + (size_t)MSAMP * 128 * 4);
constexpr size_t WS_OG = al1m(WS_QKV + (size_t)MT * NQKV * 2);
constexpr size_t WS_LSE = al1m(WS_OG + (size_t)MT * 3072 * 2);
constexpr size_t WS_OC = al1m(WS_LSE + (size_t)MT * 24 * 4);
constexpr size_t WS_GATES = al1m(WS_OC + (size_t)MT * DM * 2);
constexpr size_t WS_U = al1m(WS_GATES + (size_t)MT * 16 * 4);
constexpr size_t WS_Z = al1m(WS_U + (size_t)MT * NUP * 2);
constexpr size_t WS_SQ = al1m(WS_Z + (size_t)MT * DFF * 2);
constexpr size_t WS_ROPE = al1m(WS_SQ + (size_t)MP * 128 * 4);
constexpr size_t WS_WGP = al1m(WS_ROPE + (size_t)2052 * 128 * 4);
constexpr size_t WS_END = al1m(WS_WGP + (size_t)2 * 128 * 64 * 16);

constexpr int RING_BYTES = 131072;
constexpr int LDS_MISC_OFF = 150 * 1024;
constexpr int LDS_BYTES = 152 * 1024;

__device__ __forceinline__ unsigned f2bf(float f) { unsigned u = __builtin_bit_cast(unsigned, f); return (u + 0x7fffu + ((u >> 16) & 1u)) >> 16; }
__device__ __forceinline__ unsigned pk2(float lo, float hi) { return f2bf(lo) | (f2bf(hi) << 16); }
__device__ __forceinline__ float bflo(unsigned w) { return __builtin_bit_cast(float, w << 16); }
__device__ __forceinline__ float bfhi(unsigned w) { return __builtin_bit_cast(float, w & 0xffff0000u); }
__device__ __forceinline__ float bf1(bf16_t b) { return __builtin_bit_cast(float, (unsigned)b << 16); }
__device__ __forceinline__ float fexp(float x) { return __builtin_amdgcn_exp2f(x * 1.4426950408889634f); }
__device__ __forceinline__ float wave_sum(float v) {
#pragma unroll
    for (int o = 1; o < 64; o <<= 1) v += __shfl_xor(v, o);
    return v;
}
__device__ __forceinline__ float wave_max(float v) {
#pragma unroll
    for (int o = 1; o < 64; o <<= 1) v = fmaxf(v, __shfl_xor(v, o));
    return v;
}
__device__ __forceinline__ f32x4 mma16(bf16x8 a, bf16x8 b, f32x4 c) { return __builtin_amdgcn_mfma_f32_16x16x32_bf16(a, b, c, 0, 0, 0); }
__device__ __forceinline__ bf16x8 tr_read2(unsigned base, int off0, int off1) {
    u16x4 r0, r1;
    asm volatile("ds_read_b64_tr_b16 %0, %2 offset:%c3\n\tds_read_b64_tr_b16 %1, %2 offset:%c4\n\ts_waitcnt lgkmcnt(0)" : "=&v"(r0), "=&v"(r1) : "v"(base), "i"(off0), "i"(off1) : "memory");
    bf16x8 o; o[0] = (short)r0[0]; o[1] = (short)r0[1]; o[2] = (short)r0[2]; o[3] = (short)r0[3]; o[4] = (short)r1[0]; o[5] = (short)r1[1]; o[6] = (short)r1[2]; o[7] = (short)r1[3];
    return o;
}

__device__ __forceinline__ bf16x8 tr_join(u16x4 r0, u16x4 r1) { bf16x8 o; o[0] = (short)r0[0]; o[1] = (short)r0[1]; o[2] = (short)r0[2]; o[3] = (short)r0[3]; o[4] = (short)r1[0]; o[5] = (short)r1[1]; o[6] = (short)r1[2]; o[7] = (short)r1[3]; return o; }
#define TR_RD "ds_read_b64_tr_b16 "
#define TR_READ4(F0, F1, F2, F3, base, a0, a1, b0, b1, c0, c1, d0, d1) do { u16x4 t0_, t1_, t2_, t3_, t4_, t5_, t6_, t7_; \
    asm volatile(TR_RD "%0, %8 offset:%c9\n\t" TR_RD "%1, %8 offset:%c10\n\t" TR_RD "%2, %8 offset:%c11\n\t" TR_RD "%3, %8 offset:%c12\n\t" TR_RD "%4, %8 offset:%c13\n\t" TR_RD "%5, %8 offset:%c14\n\t" TR_RD "%6, %8 offset:%c15\n\t" TR_RD "%7, %8 offset:%c16\n\ts_waitcnt lgkmcnt(0)" \
        : "=&v"(t0_), "=&v"(t1_), "=&v"(t2_), "=&v"(t3_), "=&v"(t4_), "=&v"(t5_), "=&v"(t6_), "=&v"(t7_) : "v"(base), "i"(a0), "i"(a1), "i"(b0), "i"(b1), "i"(c0), "i"(c1), "i"(d0), "i"(d1) : "memory"); \
    F0 = tr_join(t0_, t1_); F1 = tr_join(t2_, t3_); F2 = tr_join(t4_, t5_); F3 = tr_join(t6_, t7_); } while (0)
#define TR_READ5(F0, F1, F2, F3, F4, base, a0, a1, b0, b1, c0, c1, d0, d1, e0, e1) do { u16x4 t0_, t1_, t2_, t3_, t4_, t5_, t6_, t7_, t8_, t9_; \
    asm volatile(TR_RD "%0, %10 offset:%c11\n\t" TR_RD "%1, %10 offset:%c12\n\t" TR_RD "%2, %10 offset:%c13\n\t" TR_RD "%3, %10 offset:%c14\n\t" TR_RD "%4, %10 offset:%c15\n\t" TR_RD "%5, %10 offset:%c16\n\t" TR_RD "%6, %10 offset:%c17\n\t" TR_RD "%7, %10 offset:%c18\n\t" TR_RD "%8, %10 offset:%c19\n\t" TR_RD "%9, %10 offset:%c20\n\ts_waitcnt lgkmcnt(0)" \
        : "=&v"(t0_), "=&v"(t1_), "=&v"(t2_), "=&v"(t3_), "=&v"(t4_), "=&v"(t5_), "=&v"(t6_), "=&v"(t7_), "=&v"(t8_), "=&v"(t9_) : "v"(base), "i"(a0), "i"(a1), "i"(b0), "i"(b1), "i"(c0), "i"(c1), "i"(d0), "i"(d1), "i"(e0), "i"(e1) : "memory"); \
    F0 = tr_join(t0_, t1_); F1 = tr_join(t2_, t3_); F2 = tr_join(t4_, t5_); F3 = tr_join(t6_, t7_); F4 = tr_join(t8_, t9_); } while (0)
__device__ __forceinline__ bf16x8 pack8(f32x4 a, f32x4 b) {
    u32x4 w; w.x = pk2(a[0], a[1]); w.y = pk2(a[2], a[3]); w.z = pk2(b[0], b[1]); w.w = pk2(b[2], b[3]);
    return __builtin_bit_cast(bf16x8, w);
}

namespace pg8 {
#define PG8_LAS __attribute__((address_space(3)))
typedef unsigned short bf16_t;
typedef short bf16x8 __attribute__((ext_vector_type(8)));
typedef float f32x4 __attribute__((ext_vector_type(4)));
typedef unsigned u32x4 __attribute__((ext_vector_type(4)));
constexpr int BM = 256, BK = 64, HALF = 128, HTB = HALF * BK * 2  , STAGE_BYTES = 8 * HTB, NXCD = 8, WGM = 8;

__host__ __device__ __forceinline__ int lds_byte(int r, int c) { const int st = (r >> 4) * 2 + (c >> 5), rr = r & 15, cc = c & 31, ob = rr * 64 + cc * 2; return st * 1024 + (ob ^ (((ob >> 9) & 1) << 5)); }
__host__ __device__ __forceinline__ void stage_rc(int b, int& R, int& C) { const int st = b / 1024, sb = b % 1024, swz = sb ^ (((sb >> 9) & 1) << 5); R = (st >> 1) * 16 + swz / 64; C = (st & 1) * 32 + (swz % 64) / 2; }
__host__ __device__ __forceinline__ int perm32(int rho) { const int n = rho >> 4, i = rho & 15; return 8 * (i >> 2) + 4 * n + (i & 3); }

struct Unit { int pm, pn; };
struct Gemm { const bf16_t* A; const bf16_t* Bt; int M, N, K; };

struct StaticOrder {
    int nM, nN, nwg, G, c;
    __host__ __device__ void init(int M, int N, int G_, int c_) { nM = M / BM; nN = N / BM; nwg = nM * nN; G = G_; c = c_; }
    __host__ __device__ bool next(int i, Unit& u) const {
        const long L = (long)i * G + c; if (L >= nwg) return false;
        int wgid = (int)L; { const int q = nwg / NXCD, r = nwg % NXCD, xcd = wgid % NXCD, off = wgid / NXCD; wgid = (xcd < r ? xcd * (q + 1) : r * (q + 1) + (xcd - r) * q) + off; }
        const int nig = WGM * nN, gid = wgid / nig, fm = gid * WGM, gsz = (nM - fm) < WGM ? (nM - fm) : WGM;
        u.pm = fm + ((wgid % nig) % gsz); u.pn = (wgid % nig) / gsz; return true;
    }
    __device__ __forceinline__ void a_ready(const Unit&) const {}
    __device__ __forceinline__ void done(const Unit&) const {}
};
__device__ __forceinline__ unsigned cvt_pk_bf16(float lo, float hi) { unsigned r; asm volatile("v_cvt_pk_bf16_f32 %0, %1, %2" : "=v"(r) : "v"(lo), "v"(hi)); return r; }

struct EpiStore {
    static constexpr bool PERM = true, AFTER_DRAIN = false;
    bf16_t* O; int ldc;
    __device__ __forceinline__ void operator()(const f32x4 (&acc)[2][2][4][2], const Unit& u, int wr, int wc, int fr, int fq) const {
        const int row0 = u.pm * BM + wr * 64 + fr, col0 = u.pn * BM + wc * 32 + 8 * fq;
#pragma unroll
        for (int ai = 0; ai < 2; ++ai)
#pragma unroll
            for (int m = 0; m < 4; ++m) { bf16_t* rowp = O + (size_t)(row0 + ai * HALF + m * 16) * ldc + col0;
#pragma unroll
                for (int bj = 0; bj < 2; ++bj) { const f32x4 v0 = acc[ai][bj][m][0], v1 = acc[ai][bj][m][1];
                    u32x4 w; w.x = cvt_pk_bf16(v0[0], v0[1]); w.y = cvt_pk_bf16(v0[2], v0[3]); w.z = cvt_pk_bf16(v1[0], v1[1]); w.w = cvt_pk_bf16(v1[2], v1[3]);
                    *(u32x4*)(rowp + bj * HALF) = w; } }
    }
};
struct EpiResid {
    static constexpr bool PERM = false, AFTER_DRAIN = false;
    const float* xin; float* out; int ldc; int mrows;
    __device__ __forceinline__ void operator()(const f32x4 (&acc)[2][2][4][2], const Unit& u, int wr, int wc, int fr, int fq) const {
        const int row0 = u.pm * BM + wr * 64 + fr, col0 = u.pn * BM + wc * 32 + 4 * fq;
#pragma unroll
        for (int ai = 0; ai < 2; ++ai)
#pragma unroll
            for (int m = 0; m < 4; ++m) { const int r = row0 + ai * HALF + m * 16;
                if (r < mrows) { const size_t off = (size_t)r * ldc + col0;
#pragma unroll
                    for (int bj = 0; bj < 2; ++bj)
#pragma unroll
                        for (int n = 0; n < 2; ++n) { const f32x4 bs = *(const f32x4*)(xin + off + bj * HALF + n * 16); *(f32x4*)(out + off + bj * HALF + n * 16) = bs + acc[ai][bj][m][n]; } }
                asm volatile("" ::: "memory"); }
    }
};


struct EpiStoreN {
    static constexpr bool PERM = true, AFTER_DRAIN = false;
    bf16_t* O; int ldc; const float* ssq; float eps;
    __device__ __forceinline__ void operator()(const f32x4 (&acc)[2][2][4][2], const Unit& u, int wr, int wc, int fr, int fq) const {
        const int row0 = u.pm * BM + wr * 64 + fr, col0 = u.pn * BM + wc * 32 + 8 * fq;
#pragma unroll
        for (int ai = 0; ai < 2; ++ai)
#pragma unroll
            for (int m = 0; m < 4; ++m) { const int r = row0 + ai * HALF + m * 16;
                const f32x4 p0 = *(const f32x4*)(ssq + (size_t)r * 32 + 8 * fq), p1 = *(const f32x4*)(ssq + (size_t)r * 32 + 8 * fq + 4);
                float s = ((p0[0] + p0[1]) + (p0[2] + p0[3])) + ((p1[0] + p1[1]) + (p1[2] + p1[3]));
                s += __shfl_xor(s, 16); s += __shfl_xor(s, 32);
                const float rs = rsqrtf(s * (1.f / 2048.f) + eps);
                bf16_t* rowp = O + (size_t)r * ldc + col0;
#pragma unroll
                for (int bj = 0; bj < 2; ++bj) { const f32x4 v0 = acc[ai][bj][m][0] * rs, v1 = acc[ai][bj][m][1] * rs;
                    u32x4 w; w.x = cvt_pk_bf16(v0[0], v0[1]); w.y = cvt_pk_bf16(v0[2], v0[3]); w.z = cvt_pk_bf16(v1[0], v1[1]); w.w = cvt_pk_bf16(v1[2], v1[3]);
                    *(u32x4*)(rowp + bj * HALF) = w; } }
    }
};
struct EpiResidN {
    static constexpr bool PERM = false, AFTER_DRAIN = false;
    const float* xin; float* out; bf16_t* xb; float* ssq; int ldc;
    __device__ __forceinline__ void operator()(const f32x4 (&acc)[2][2][4][2], const Unit& u, int wr, int wc, int fr, int fq) const {
        const int row0 = u.pm * BM + wr * 64 + fr, col0 = u.pn * BM + wc * 32 + 4 * fq;
#pragma unroll
        for (int ai = 0; ai < 2; ++ai)
#pragma unroll
            for (int m = 0; m < 4; ++m) { const int r = row0 + ai * HALF + m * 16; const size_t off = (size_t)r * ldc + col0; float sq = 0.f;
#pragma unroll
                for (int bj = 0; bj < 2; ++bj)
#pragma unroll
                    for (int n = 0; n < 2; ++n) { const f32x4 v = *(const f32x4*)(xin + off + bj * HALF + n * 16) + acc[ai][bj][m][n]; *(f32x4*)(out + off + bj * HALF + n * 16) = v;
                        if (xb) { u32x2 w; w.x = cvt_pk_bf16(v[0], v[1]); w.y = cvt_pk_bf16(v[2], v[3]); *(u32x2*)(xb + off + bj * HALF + n * 16) = w; }
                        sq += (v[0] * v[0] + v[1] * v[1]) + (v[2] * v[2] + v[3] * v[3]); }
                if (ssq) { sq += __shfl_xor(sq, 16); sq += __shfl_xor(sq, 32); if (fq == 0) ssq[(size_t)r * 32 + u.pn * 4 + wc] = sq; }
                asm volatile("" ::: "memory"); }
    }
};
template <class Epi, class Sched, bool ALIGN_EPI = false, bool SP2 = false>
__device__ __forceinline__ void gemm_phase(PG8_LAS unsigned char* lds, const Gemm g, const Sched& S, const Epi& E) {
    int tid = threadIdx.x; asm volatile("" : "+v"(tid));
    const int wid = __builtin_amdgcn_readfirstlane(tid >> 6), lane = tid & 63, wr = wid >> 2, wc = wid & 3, fr = lane & 15, fq = lane >> 4;
    const int K = g.K, nt = K / BK;
    unsigned voffA[2], voffB[2];
#pragma unroll
    for (int i = 0; i < 2; ++i) { int R, C; stage_rc(tid * 16 + i * 8192, R, C); const int Rb = Epi::PERM ? ((R & ~31) + perm32(R & 31)) : R;
        voffA[i] = (unsigned)(R * K + C) * 2u; voffB[i] = (unsigned)(Rb * K + C) * 2u; }
    const size_t kstep = (size_t)(BK * 2);
    const size_t hstep = (size_t)HALF * K * 2;
    const size_t tstep = 2 * hstep;
    const unsigned ldsw = (unsigned)wid * 1024u;
    const int aoff = lds_byte(wr * 64 + fr, fq * 8), boff = lds_byte(wc * 32 + fr, fq * 8);
#define PG8_SA(b, h) (((b) * 2 + (h)) * HTB)
#define PG8_SB(b, h) ((4 + (b) * 2 + (h)) * HTB)
#define PG8_STAGE(bufoff, gbase, voff) do { _Pragma("unroll") for (int _i = 0; _i < 2; ++_i) \
        __builtin_amdgcn_global_load_lds((const unsigned*)((const char*)(gbase) + (voff)[_i]), (PG8_LAS unsigned*)(lds + (bufoff) + ldsw + _i * 8192), 16, 0, 0); } while (0)
#define PG8_LDA(dst, b, h) do { _Pragma("unroll") for (int m = 0; m < 4; ++m) _Pragma("unroll") for (int k = 0; k < 2; ++k) dst[m][k] = *(const PG8_LAS bf16x8*)(lds + PG8_SA(b, h) + aoff + m * 2048 + k * 1024); } while (0)
#define PG8_LDB(dst, b, h) do { _Pragma("unroll") for (int n = 0; n < 2; ++n) _Pragma("unroll") for (int k = 0; k < 2; ++k) dst[n][k] = *(const PG8_LAS bf16x8*)(lds + PG8_SB(b, h) + boff + n * 2048 + k * 1024); } while (0)
#define PG8_MMA(ai, bj, At, Bt) do { __builtin_amdgcn_s_setprio(1); _Pragma("unroll") for (int m = 0; m < 4; ++m) _Pragma("unroll") for (int n = 0; n < 2; ++n) _Pragma("unroll") for (int k = 0; k < 2; ++k) \
        acc[ai][bj][m][n] = __builtin_amdgcn_mfma_f32_16x16x32_bf16(Bt[n][k], At[m][k], acc[ai][bj][m][n], 0, 0, 0); __builtin_amdgcn_s_setprio(0); } while (0)
#define PG8_WAIT_V(n) asm volatile("s_waitcnt vmcnt(" #n ")" ::: "memory")
#define PG8_WAIT_L(n) asm volatile("s_waitcnt lgkmcnt(" #n ")" ::: "memory")
#define PG8_BAR __builtin_amdgcn_s_barrier()
#define PG8_SCHED __builtin_amdgcn_sched_barrier(0)
    Unit cur, nxt; int ui = 0;
    if (!S.next(0, cur)) return;
    f32x4 acc[2][2][4][2];
#pragma unroll
    for (int a = 0; a < 2; ++a)
#pragma unroll
        for (int b = 0; b < 2; ++b)
#pragma unroll
            for (int m = 0; m < 4; ++m)
#pragma unroll
                for (int n = 0; n < 2; ++n) acc[a][b][m][n] = (f32x4){0.f, 0.f, 0.f, 0.f};
    bf16x8 At[4][2], B0[2][2], B1[2][2];
    const char* cA = (const char*)g.A + (size_t)cur.pm * tstep; const char* cB = (const char*)g.Bt + (size_t)cur.pn * tstep;
    S.a_ready(cur);
    if constexpr (SP2) {
        PG8_STAGE(PG8_SB(0, 0), cB, voffB); PG8_STAGE(PG8_SB(0, 1), cB + hstep, voffB); PG8_STAGE(PG8_SA(0, 0), cA, voffA); PG8_STAGE(PG8_SA(0, 1), cA + hstep, voffA);
        if (wr == 1) PG8_BAR;
        PG8_WAIT_V(2); PG8_BAR;
        PG8_STAGE(PG8_SB(1, 0), cB + kstep, voffB); PG8_STAGE(PG8_SA(1, 0), cA + kstep, voffA); PG8_STAGE(PG8_SB(1, 1), cB + hstep + kstep, voffB);
        PG8_WAIT_V(6); PG8_BAR;
    } else {
        PG8_STAGE(PG8_SB(0, 0), cB, voffB); PG8_STAGE(PG8_SA(0, 0), cA, voffA); PG8_STAGE(PG8_SB(0, 1), cB + hstep, voffB); PG8_STAGE(PG8_SA(0, 1), cA + hstep, voffA);
        if (wr == 1) PG8_BAR;
        PG8_WAIT_V(4); PG8_BAR;
        PG8_STAGE(PG8_SB(1, 0), cB + kstep, voffB); PG8_STAGE(PG8_SA(1, 0), cA + kstep, voffA); PG8_STAGE(PG8_SB(1, 1), cB + hstep + kstep, voffB);
        PG8_WAIT_V(6); PG8_BAR;
    }
    for (;;) {
        const bool has_next = S.next(ui + 1, nxt);
        const char* nA = has_next ? (const char*)g.A + (size_t)nxt.pm * tstep : cA; const char* nB = has_next ? (const char*)g.Bt + (size_t)nxt.pn * tstep : cB;
        for (int t = 0; t < nt; t += 2) {
            const bool last = (t == nt - 2);
            const char* a1 = cA + (size_t)(t + 1) * kstep;
            const char* a2 = last ? nA : cA + (size_t)(t + 2) * kstep; const char* b2 = last ? nB : cB + (size_t)(t + 2) * kstep;
            const char* a3 = a2 + kstep; const char* b3 = b2 + kstep;
            if (last && has_next) S.a_ready(nxt);
            if constexpr (SP2) {
            PG8_LDB(B0, 0, 0); PG8_LDB(B1, 0, 1); PG8_SCHED; PG8_LDA(At, 0, 0); PG8_STAGE(PG8_SA(1, 1), a1 + hstep, voffA);
            PG8_WAIT_V(8); PG8_WAIT_L(0); PG8_BAR; PG8_MMA(0, 0, At, B0); PG8_MMA(0, 1, At, B1); PG8_BAR; PG8_SCHED;
            PG8_LDA(At, 0, 1); PG8_STAGE(PG8_SB(0, 0), b2, voffB); PG8_STAGE(PG8_SB(0, 1), b2 + hstep, voffB); PG8_STAGE(PG8_SA(0, 0), a2, voffA);
            PG8_WAIT_V(8); PG8_WAIT_L(0); PG8_BAR; PG8_MMA(1, 0, At, B0); PG8_MMA(1, 1, At, B1); PG8_BAR; PG8_SCHED;
            PG8_LDB(B0, 1, 0); PG8_LDB(B1, 1, 1); PG8_SCHED; PG8_LDA(At, 1, 0); PG8_STAGE(PG8_SA(0, 1), a2 + hstep, voffA);
            PG8_WAIT_V(8); PG8_WAIT_L(0); PG8_BAR; PG8_MMA(0, 0, At, B0); PG8_MMA(0, 1, At, B1); PG8_BAR; PG8_SCHED;
            PG8_LDA(At, 1, 1); PG8_STAGE(PG8_SB(1, 0), b3, voffB); PG8_STAGE(PG8_SB(1, 1), b3 + hstep, voffB); PG8_STAGE(PG8_SA(1, 0), a3, voffA);
            PG8_WAIT_V(8); PG8_WAIT_L(0); PG8_BAR; PG8_MMA(1, 0, At, B0); PG8_MMA(1, 1, At, B1); PG8_BAR; PG8_SCHED;
            } else {
            PG8_LDB(B0, 0, 0); PG8_SCHED; PG8_LDA(At, 0, 0); PG8_STAGE(PG8_SA(1, 1), a1 + hstep, voffA);
            PG8_WAIT_L(8); PG8_BAR; PG8_WAIT_L(0); PG8_MMA(0, 0, At, B0); PG8_BAR; PG8_SCHED;
            PG8_LDB(B1, 0, 1); PG8_STAGE(PG8_SB(0, 0), b2, voffB);
            PG8_BAR; PG8_WAIT_L(0); PG8_MMA(0, 1, At, B1); PG8_BAR;
            PG8_LDA(At, 0, 1); PG8_STAGE(PG8_SA(0, 0), a2, voffA);
            PG8_BAR; PG8_WAIT_L(0); PG8_MMA(1, 0, At, B0); PG8_BAR; PG8_SCHED;
            PG8_STAGE(PG8_SB(0, 1), b2 + hstep, voffB);
            PG8_WAIT_V(6); PG8_BAR; PG8_MMA(1, 1, At, B1); PG8_BAR;
            PG8_LDB(B0, 1, 0); PG8_SCHED; PG8_LDA(At, 1, 0); PG8_STAGE(PG8_SA(0, 1), a2 + hstep, voffA);
            PG8_WAIT_L(8); PG8_BAR; PG8_WAIT_L(0); PG8_MMA(0, 0, At, B0); PG8_BAR; PG8_SCHED;
            PG8_LDB(B1, 1, 1); PG8_STAGE(PG8_SB(1, 0), b3, voffB);
            PG8_BAR; PG8_WAIT_L(0); PG8_MMA(0, 1, At, B1); PG8_BAR;
            PG8_LDA(At, 1, 1); PG8_STAGE(PG8_SA(1, 0), a3, voffA);
            PG8_BAR; PG8_WAIT_L(0); PG8_MMA(1, 0, At, B0); PG8_BAR; PG8_SCHED;
            PG8_STAGE(PG8_SB(1, 1), b3 + hstep, voffB);
            PG8_WAIT_V(6); PG8_BAR; PG8_MMA(1, 1, At, B1); PG8_BAR;
            }
        }
        if constexpr (ALIGN_EPI) { if (wr == 0) PG8_BAR; }
        if constexpr (!Epi::AFTER_DRAIN) { E(acc, cur, wr, wc, fr, fq); S.done(cur); }
        if (!has_next) break;
#pragma unroll
        for (int a = 0; a < 2; ++a)
#pragma unroll
            for (int b = 0; b < 2; ++b)
#pragma unroll
                for (int m = 0; m < 4; ++m)
#pragma unroll
                    for (int n = 0; n < 2; ++n) acc[a][b][m][n] = (f32x4){0.f, 0.f, 0.f, 0.f};
        cur = nxt; cA = nA; cB = nB; ++ui;
        if constexpr (ALIGN_EPI) { if (wr == 1) PG8_BAR; }
    }
    PG8_WAIT_V(0);
    if constexpr (!ALIGN_EPI) { if (wr == 0) PG8_BAR; }
    PG8_BAR;
    if constexpr (Epi::AFTER_DRAIN) { E.fused(acc, cur, wr, wc, fr, fq, lds, wid, lane); S.done(cur); }
#undef PG8_SA
#undef PG8_SB
#undef PG8_STAGE
#undef PG8_LDA
#undef PG8_LDB
#undef PG8_MMA
#undef PG8_WAIT_V
#undef PG8_WAIT_L
#undef PG8_BAR
#undef PG8_SCHED
}
}
#define XB_TMO      128
#define XB_XCNT(j)  (256  + 64 * (j))
#define XB_XSUB(j)  (1280 + 64 * (j))
#define XB_XGEN(j)  (2304 + 64 * (j))
#define XB_TOP      3328
#define XB_TOPGEN   3392
#define XCD_BAR_WORDS 3456
#define XB_SPIN_CAP (1u << 18)

__device__ __forceinline__ unsigned xb_ld(unsigned* p)              { return __hip_atomic_load(p, __ATOMIC_RELAXED, __HIP_MEMORY_SCOPE_AGENT); }
__device__ __forceinline__ unsigned xb_add(unsigned* p, unsigned v) { return __hip_atomic_fetch_add(p, v, __ATOMIC_RELAXED, __HIP_MEMORY_SCOPE_AGENT); }
__device__ __forceinline__ unsigned xb_xcc_id() { return (unsigned)__builtin_amdgcn_s_getreg((3 << 11) | 20) & 0xFu; }
#define XB_SPIN(cond, bar) do { unsigned _sp = 0; while (cond) { __builtin_amdgcn_s_sleep(1); \
    if ((++_sp & 255u) == 0u) { if (xb_ld(&(bar)[XB_TMO])) break; if (_sp > XB_SPIN_CAP) { atomicAdd(&(bar)[XB_TMO], 1u); break; } } } } while (0)

struct XcdBarrier {
    unsigned* bar; unsigned x;
    volatile LAS unsigned* st;
};

__device__ __forceinline__ XcdBarrier xcd_barrier_post(unsigned* bar, volatile LAS unsigned* st) {
    XcdBarrier b; b.bar = bar; b.x = xb_xcc_id(); b.st = st;
    if (threadIdx.x == 0) (void)xb_add(&bar[XB_XCNT(b.x)], 1u);
    return b;
}
__device__ __forceinline__ void xcd_barrier_complete(unsigned* bar, unsigned x, unsigned& nloc, unsigned& nx) {
    const unsigned G = gridDim.x * gridDim.y * gridDim.z;
    unsigned sum, cnt, mine, sp = 0u;
    for (;;) {
        sum = 0u; cnt = 0u; mine = 0u;
#pragma unroll
        for (unsigned j = 0; j < 16; ++j) { const unsigned c = xb_ld(&bar[XB_XCNT(j)]); sum += c; cnt += (c > 0u) ? 1u : 0u; mine = (j == x) ? c : mine; }
        if (sum == G) break;
        __builtin_amdgcn_s_sleep(1);
        if ((++sp & 255u) == 0u) { if (xb_ld(&bar[XB_TMO])) break; if (sp > XB_SPIN_CAP) { atomicAdd(&bar[XB_TMO], 1u); break; } }
    }
    nloc = mine > 0u ? mine : 1u; nx = cnt > 0u ? cnt : 1u;
}

__device__ __forceinline__ void xcd_barrier(const XcdBarrier& b) {
    asm volatile("s_waitcnt vmcnt(0)" ::: "memory");
    __syncthreads();
    if (threadIdx.x == 0) {
        unsigned* bar = b.bar;
        __builtin_amdgcn_s_waitcnt(0);
        unsigned nloc = b.st[0], nx = b.st[1];
        if (nloc == 0u) { xcd_barrier_complete(bar, b.x, nloc, nx); b.st[0] = nloc; b.st[1] = nx; }
        const unsigned old = xb_add(&bar[XB_XSUB(b.x)], 1u);
        const unsigned gen = old / nloc;
        if (old + 1u == (gen + 1u) * nloc) {
            __builtin_amdgcn_fence(__ATOMIC_RELEASE, "agent");
            asm volatile("s_waitcnt vmcnt(0)" ::: "memory");
            const unsigned og = xb_add(&bar[XB_TOP], 1u);
            const unsigned tg = og / nx;
            if (og + 1u == (tg + 1u) * nx) xb_add(&bar[XB_TOPGEN], 1u);
            else XB_SPIN(xb_ld(&bar[XB_TOPGEN]) == tg, bar);
            __builtin_amdgcn_fence(__ATOMIC_ACQUIRE, "agent");
            xb_add(&bar[XB_XGEN(b.x)], 1u);
            asm volatile("s_waitcnt vmcnt(0)" ::: "memory");
        } else {
            XB_SPIN(xb_ld(&bar[XB_XGEN(b.x)]) == gen, bar);
            __builtin_amdgcn_fence(__ATOMIC_ACQUIRE, "agent");
            asm volatile("s_waitcnt vmcnt(0)" ::: "memory");
        }
    }
    __syncthreads();
}

struct Params { const float* in[23]; float* out; unsigned char* ws; };

__device__ __forceinline__ void p0_transpose_item(const float* W, int ldw, int K, int N, bf16_t* WT, int item, int lane, float scale, const float* gk) {
    const int nblk = N / 64, kb = item / nblk, nb = item % nblk, i16 = lane & 15, q4 = lane >> 4;
    const int n0 = 64 * nb + 4 * i16;
#pragma unroll
    for (int pass = 0; pass < 2; ++pass) {
        const int kk0 = 64 * kb + 32 * pass + 8 * q4;
        const float* src = W + (size_t)kk0 * ldw + n0;
        f32x4 v[8];
#pragma unroll
        for (int i = 0; i < 8; ++i) v[i] = *(const f32x4*)(src + (size_t)i * ldw);
        f32x4 g0 = {scale, scale, scale, scale}, g1 = g0;
        if (gk) { g0 = *(const f32x4*)(gk + kk0) * scale; g1 = *(const f32x4*)(gk + kk0 + 4) * scale; }
#pragma unroll
        for (int j = 0; j < 4; ++j) { u32x4 o;
            o.x = pk2(v[0][j] * g0[0], v[1][j] * g0[1]); o.y = pk2(v[2][j] * g0[2], v[3][j] * g0[3]); o.z = pk2(v[4][j] * g1[0], v[5][j] * g1[1]); o.w = pk2(v[6][j] * g1[2], v[7][j] * g1[3]);
            *(u32x4*)(WT + (size_t)(n0 + j) * K + kk0) = o; }
    }
}

__device__ __forceinline__ void phase_prologue(const Params& P, LAS unsigned char* lds, int gw, int NGW, int wave, int lane) {
    constexpr int I_QKV = (DM / 64) * (NQKV / 64), I_WO = (DO / 64) * (DM / 64), I_WIN = (DM / 64) * (NIN / 64), I_WOUT = (DM / 64) * (DM / 64), I_WUP = (DM / 64) * (NUP / 64), I_WDN = (DFF / 64) * (DM / 64);
    constexpr int T0 = 2 * I_QKV, T1 = T0 + 2 * I_WO, T2 = T1 + 2 * I_WIN, T3 = T2 + 2 * I_WOUT, T4 = T3 + 4 * I_WUP, T5 = T4 + 4 * I_WDN;
    unsigned char* ws = P.ws;
    for (int it = gw; it < T5; it += NGW) {
        if (it < T0) { const int l = it / I_QKV, r = it % I_QKV; p0_transpose_item(P.in[11] + (size_t)l * DM * NQKV, NQKV, DM, NQKV, (bf16_t*)(ws + WS_WQKV + l * SZ_WQKV), r, lane, 1.f, P.in[9] + (size_t)(2 * l) * DM); }
        else if (it < T1) { const int q = it - T0, l = q / I_WO, r = q % I_WO; p0_transpose_item(P.in[14] + (size_t)l * DO * DM, DM, DO, DM, (bf16_t*)(ws + WS_WO + l * SZ_WO), r, lane, 1.f, nullptr); }
        else if (it < T2) { const int q = it - T1, l = q / I_WIN, r = q % I_WIN; const int nb = r % (NIN / 64);
            const float sc = (nb >= 16 && nb < 32) ? 0.08838834764831845f : 1.f;
            p0_transpose_item(P.in[15] + (size_t)l * DM * NIN_SRC, NIN_SRC, DM, NIN, (bf16_t*)(ws + WS_WIN + l * SZ_WIN), r, lane, sc, P.in[9] + (size_t)(2 * l + 1) * DM); }
        else if (it < T3) { const int q = it - T2, l = q / I_WOUT, r = q % I_WOUT; p0_transpose_item(P.in[18] + (size_t)l * DM * DM, DM, DM, DM, (bf16_t*)(ws + WS_WOUT + l * SZ_WOUT), r, lane, 1.f, nullptr); }
        else if (it < T4) { const int q = it - T3, l = q / I_WUP, r = q % I_WUP; p0_transpose_item(P.in[19] + (size_t)l * DM * NUP, NUP, DM, NUP, (bf16_t*)(ws + WS_WUP + l * SZ_WUP), r, lane, 1.f, P.in[10] + (size_t)l * DM); }
        else { const int q = it - T4, l = q / I_WDN, r = q % I_WDN; p0_transpose_item(P.in[22] + (size_t)l * DFF * DM, DM, DFF, DM, (bf16_t*)(ws + WS_WDOWN + l * SZ_WDOWN), r, lane, 1.f, nullptr); }
    }
    { const int gt = gw * 64 + lane, NT = NGW * 64;
      float* rope = (float*)(ws + WS_ROPE);
      for (int i = gt; i < 2052 * 64; i += NT) { const int pi = i >> 6, f = i & 63; const int pos = (pi < SEQ) ? pi : PAST + (pi - SEQ);
          const float invf = powf(10000.f, -(float)f * (1.f / 64.f)); const float ang = (float)pos * invf; float sn, cs; sincosf(ang, &sn, &cs); rope[2 * i] = cs; rope[2 * i + 1] = sn; }
      f32x4* wgp = (f32x4*)(ws + WS_WGP);
      for (int i = gt; i < 2 * 128 * 64; i += NT) { const int l = i >> 13, kb = (i >> 6) & 127, ln = i & 63, col = ln & 15, kq = ln >> 4, k = 16 * kb + 4 * kq;
          const float* w = P.in[15] + (size_t)l * DM * NIN_SRC + (size_t)k * NIN_SRC + NIN + col; const float* g = P.in[9] + (size_t)(2 * l + 1) * DM + k;
          wgp[i] = (f32x4){g[0] * w[0], g[1] * w[NIN_SRC], g[2] * w[2 * NIN_SRC], g[3] * w[3 * NIN_SRC]}; } }
    for (int r = gw; r < MR; r += NGW) {
        const f32x4* xr = (const f32x4*)((r < MP) ? P.in[0] + (size_t)r * DM : P.in[1] + (size_t)(r - MP) * DM) + lane;
        f32x4* xo = (f32x4*)(ws + WS_X) + (size_t)r * (DM / 4) + lane; u32x2* xb = (u32x2*)(ws + WS_XB) + (size_t)r * (DM / 4) + lane;
        float s = 0.f;
#pragma unroll
        for (int j = 0; j < 8; ++j) { const f32x4 v = xr[64 * j]; xo[64 * j] = v; u32x2 w; w.x = pk2(v.x, v.y); w.y = pk2(v.z, v.w); xb[64 * j] = w; s += (v.x * v.x + v.y * v.y) + (v.z * v.z + v.w * v.w); }
        s = wave_sum(s);
        if (r < MP) { if (lane < 32) ((float*)(ws + WS_SSQ))[(size_t)r * 32 + lane] = (lane == 0) ? s : 0.f; }
        else { float* q = (float*)(ws + WS_SSQS) + (size_t)(r - MP) * 128; q[lane] = (lane == 0) ? s : 0.f; q[64 + lane] = 0.f; }
    }
}

__device__ __forceinline__ void gate_block(LAS unsigned char* lds, const float* X, const f32x4* WGP, const float* bg, float* GATES, int task, int wave, int lane) {
    const int r0 = task * 16, i16 = lane & 15, kq = lane >> 4;
    const float* xr = X + (size_t)(r0 + i16) * DM + 256 * wave + 4 * kq;
    const f32x4* wp = WGP + (size_t)(16 * wave) * 64 + lane;
    f32x4 acc = {0.f, 0.f, 0.f, 0.f}; float ss = 0.f;
#pragma unroll
    for (int j = 0; j < 16; ++j) {
        const f32x4 xv = *(const f32x4*)(xr + 16 * j), wv = wp[64 * j];
        ss += (xv.x * xv.x + xv.y * xv.y) + (xv.z * xv.z + xv.w * xv.w);
        acc = __builtin_amdgcn_mfma_f32_16x16x4f32(xv.x, wv.x, acc, 0, 0, 0);
        acc = __builtin_amdgcn_mfma_f32_16x16x4f32(xv.y, wv.y, acc, 0, 0, 0);
        acc = __builtin_amdgcn_mfma_f32_16x16x4f32(xv.z, wv.z, acc, 0, 0, 0);
        acc = __builtin_amdgcn_mfma_f32_16x16x4f32(xv.w, wv.w, acc, 0, 0, 0);
    }
    LAS f32x4* gp = (LAS f32x4*)lds; LAS float* sp = (LAS float*)(lds + 8192);
    __syncthreads();
    gp[wave * 64 + lane] = acc; sp[wave * 64 + lane] = ss;
    __syncthreads();
    if (wave == 0) {
        f32x4 a = gp[lane]; float s = sp[lane];
#pragma unroll
        for (int w = 1; w < 8; ++w) { a += gp[w * 64 + lane]; s += sp[w * 64 + lane]; }
        s += __shfl_xor(s, 16); s += __shfl_xor(s, 32);
        const float rstd = rsqrtf(s * (1.f / DM) + EPS);
        const float bias = bg[i16];
#pragma unroll
        for (int i = 0; i < 4; ++i) {
            const float rs = __shfl(rstd, 4 * kq + i);
            const float pre = a[i] * rs + bias;
            const float gc = 15.f * tanhf(pre * (1.f / 15.f));
            const float val = (i16 < 8) ? gc : (fminf(gc, 0.f) - log1pf(fexp(-fabsf(gc))));
            GATES[(size_t)(r0 + 4 * kq + i) * 16 + i16] = val;
        }
    }
}

constexpr int SK_PART = 0, SK_RSTD = 16384;
template <int MODE>
__device__ __forceinline__ void skinny_phase(LAS unsigned char* lds, const bf16_t* A, int K, const bf16_t* Bt, int N, bf16_t* Ob, int ldo, float* Xs, bf16_t* XBs, float* SSQS, float* Os, int c, int G, int nIdle, int tid, int wave, int lane) {
    const int i16 = lane & 15, q4 = lane >> 4;
    if (c < G - nIdle) return;
    LAS f32x4* part = (LAS f32x4*)(lds + SK_PART); LAS float* rstdS = (LAS float*)(lds + SK_RSTD);
    __syncthreads();
    if (MODE == 0) { const int row = tid >> 4, sub = tid & 15; const float* q = SSQS + row * 128 + 8 * sub;
        const f32x4 a = *(const f32x4*)q, b = *(const f32x4*)(q + 4); float s = ((a[0] + a[1]) + (a[2] + a[3])) + ((b[0] + b[1]) + (b[2] + b[3]));
        s += __shfl_xor(s, 1); s += __shfl_xor(s, 2); s += __shfl_xor(s, 4); s += __shfl_xor(s, 8);
        if (sub == 0) rstdS[row] = rsqrtf(s * (1.f / 2048.f) + EPS);
        __syncthreads(); }
    const int kper = K >> 3, nks = kper >> 5, k0 = wave * kper;
    for (int j = G - 1 - c; j < (N >> 4); j += nIdle) {
        f32x4 acc0 = {0.f, 0.f, 0.f, 0.f}, acc1 = {0.f, 0.f, 0.f, 0.f};
        const bf16_t* bp = Bt + (size_t)(16 * j + i16) * K + k0 + 8 * q4; const bf16_t* ap = A + (size_t)i16 * K + k0 + 8 * q4;
#pragma unroll 4
        for (int ks = 0; ks < nks; ++ks) { const bf16x8 bf = *(const bf16x8*)(bp + 32 * ks), a0 = *(const bf16x8*)(ap + 32 * ks), a1 = *(const bf16x8*)(ap + (size_t)16 * K + 32 * ks);
            acc0 = mma16(a0, bf, acc0); acc1 = mma16(a1, bf, acc1); }
        part[(wave * 2 + 0) * 64 + lane] = acc0; part[(wave * 2 + 1) * 64 + lane] = acc1;
        __syncthreads();
        if (wave < 2) {
            f32x4 s = part[wave * 64 + lane];
#pragma unroll
            for (int w = 1; w < 8; ++w) s += part[(w * 2 + wave) * 64 + lane];
            const int col = 16 * j + i16;
#pragma unroll
            for (int i = 0; i < 4; ++i) { const int r = 16 * wave + 4 * q4 + i;
                if (MODE == 0) Ob[(size_t)r * ldo + col] = (bf16_t)f2bf(s[i] * rstdS[r]);
                else if (MODE == 1) { const float xo = Xs[(size_t)r * DM + col] + s[i]; Xs[(size_t)r * DM + col] = xo; XBs[(size_t)r * DM + col] = (bf16_t)f2bf(xo);
                    float sq = xo * xo; sq += __shfl_xor(sq, 1); sq += __shfl_xor(sq, 2); sq += __shfl_xor(sq, 4); sq += __shfl_xor(sq, 8);
                    if (i16 == 0) SSQS[r * 128 + j] = sq; }
                else Os[(size_t)r * DM + col] = Xs[(size_t)r * DM + col] + s[i]; }
        }
        __syncthreads();
    }
}

__device__ __forceinline__ void prep_row(bf16_t* QKV, const float* rope, const float* qg, const float* kg, float* out, int ia, int r, int lane) {
    const int hh = lane >> 3, sub = lane & 7;
    const bool samp = r >= MP;
    const int b = samp ? ((r - MP) >> 2) : (r >> 11), s = samp ? ((r - MP) & 3) : (r & 2047);
    float cs[8], sn[8];
    { const f32x4* rp = (const f32x4*)(rope + ((size_t)(samp ? SEQ + s : s) * 64 + 8 * sub) * 2);
      const f32x4 t0 = rp[0], t1 = rp[1], t2 = rp[2], t3 = rp[3];
      cs[0] = t0[0]; sn[0] = t0[1]; cs[1] = t0[2]; sn[1] = t0[3]; cs[2] = t1[0]; sn[2] = t1[1]; cs[3] = t1[2]; sn[3] = t1[3];
      cs[4] = t2[0]; sn[4] = t2[1]; cs[5] = t2[2]; sn[5] = t2[3]; cs[6] = t3[0]; sn[6] = t3[1]; cs[7] = t3[2]; sn[7] = t3[3]; }
#pragma unroll 1
    for (int g = 0; g < 3; ++g) {
        const int win = 128 << (2 * g);
#pragma unroll
        for (int t = 0; t < 3; ++t) {
            bf16_t* p = QKV + (size_t)r * NQKV + ((g * 3 + t) * 8 + hh) * 128;
            const u32x4 w0 = *(const u32x4*)(p + 8 * sub), w1 = *(const u32x4*)(p + 64 + 8 * sub);
            float x1[8], x2[8];
            x1[0] = bflo(w0.x); x1[1] = bfhi(w0.x); x1[2] = bflo(w0.y); x1[3] = bfhi(w0.y); x1[4] = bflo(w0.z); x1[5] = bfhi(w0.z); x1[6] = bflo(w0.w); x1[7] = bfhi(w0.w);
            x2[0] = bflo(w1.x); x2[1] = bfhi(w1.x); x2[2] = bflo(w1.y); x2[3] = bfhi(w1.y); x2[4] = bflo(w1.z); x2[5] = bfhi(w1.z); x2[6] = bflo(w1.w); x2[7] = bfhi(w1.w);
            if (t < 2) {
                float ss = 0.f;
#pragma unroll
                for (int j = 0; j < 8; ++j) ss += x1[j] * x1[j] + x2[j] * x2[j];
                ss += __shfl_xor(ss, 1); ss += __shfl_xor(ss, 2); ss += __shfl_xor(ss, 4);
                const float rstd = rsqrtf(ss * (1.f / 128.f) + EPS);
                const float* gn = (t == 0) ? qg : kg;
#pragma unroll
                for (int j = 0; j < 8; ++j) { const float y1 = x1[j] * rstd * gn[8 * sub + j], y2 = x2[j] * rstd * gn[64 + 8 * sub + j];
                    x1[j] = y1 * cs[j] - y2 * sn[j]; x2[j] = y2 * cs[j] + y1 * sn[j]; }
                u32x4 o0, o1;
                o0.x = pk2(x1[0], x1[1]); o0.y = pk2(x1[2], x1[3]); o0.z = pk2(x1[4], x1[5]); o0.w = pk2(x1[6], x1[7]);
                o1.x = pk2(x2[0], x2[1]); o1.y = pk2(x2[2], x2[3]); o1.z = pk2(x2[4], x2[5]); o1.w = pk2(x2[6], x2[7]);
                *(u32x4*)(p + 8 * sub) = o0; *(u32x4*)(p + 64 + 8 * sub) = o1;
            }
            if (t >= 1) {
                const int kv = t - 1;
                const size_t obase = (g == 0) ? (samp ? O_KV128S : O_KV128P) : (g == 1) ? (samp ? O_KV512S : O_KV512P) : (samp ? O_KV2048S : O_KV2048P);
                const int j = samp ? (win - TSAMP + s) : (s - (SEQ - win));
                if (j >= 0) {
                    const int nb = samp ? NBS : NBP;
                    float* dst = out + obase + ((((size_t)(ia * nb + b) * win + j) * 2 + kv) * 8 + hh) * 128;
                    *(f32x4*)(dst + 8 * sub) = (f32x4){x1[0], x1[1], x1[2], x1[3]}; *(f32x4*)(dst + 8 * sub + 4) = (f32x4){x1[4], x1[5], x1[6], x1[7]};
                    *(f32x4*)(dst + 64 + 8 * sub) = (f32x4){x2[0], x2[1], x2[2], x2[3]}; *(f32x4*)(dst + 64 + 8 * sub + 4) = (f32x4){x2[4], x2[5], x2[6], x2[7]};
                }
            }
        }
    }
}

constexpr int AT_PITCH = 272, AT_KOFF = 0, AT_VOFF = 256 * AT_PITCH;
struct AttnItem { int g, b, h, dil, r, qb; };
__device__ __forceinline__ AttnItem attn_decode(int item) {
    AttnItem a; a.g = item >> 9; const int rem = item & 511, idx = rem & 15; a.b = rem >> 7; a.h = (rem >> 4) & 7;
    a.dil = (a.g == 0) ? 1 : (a.g == 1) ? 4 : 16; a.r = (a.g == 0) ? 0 : (a.g == 1) ? (idx >> 2) : idx; a.qb = (a.g == 0) ? idx : (a.g == 1) ? (idx & 3) : 0; return a;
}
__device__ __forceinline__ void attn_fetch(const bf16_t* QKV, const AttnItem& a, int tid, u32x4 (&kr)[8], u32x4 (&vr)[8]) {
    const int ck = (a.g * 3 * 8 + a.h) * 128 + 1024, uk0 = 128 * (a.qb - 1); const size_t rowbase = (size_t)a.b * SEQ + a.r;
#pragma unroll
    for (int i = 0; i < 8; ++i) { const int id = tid + 512 * i, kk = id >> 4, ch = id & 15, u = uk0 + kk;
        kr[i] = (u32x4){0u, 0u, 0u, 0u}; vr[i] = (u32x4){0u, 0u, 0u, 0u};
        if (u >= 0) { const bf16_t* src = QKV + (rowbase + (size_t)u * a.dil) * NQKV + ck + 8 * ch; kr[i] = *(const u32x4*)src; vr[i] = *(const u32x4*)(src + 1024); } }
}
__device__ __forceinline__ void attn_phase(LAS unsigned char* lds, unsigned lds_base, const bf16_t* QKV, bf16_t* OG, float* LSE, int first, int stride, int nitems, int tid, int wave, int lane) {
    const int i16 = lane & 15, q4 = lane >> 4, qq = i16 >> 2, p = lane & 3;
    u32x4 kr[8], vr[8];
    if (first < nitems) { const AttnItem a0 = attn_decode(first); attn_fetch(QKV, a0, tid, kr, vr); }
    __syncthreads();
#pragma unroll 1
    for (int item = first; item < nitems; item += stride) {
        const AttnItem a = attn_decode(item);
        const int g = a.g, h = a.h, qb = a.qb;
        const int cq = (g * 3 * 8 + h) * 128;
        const size_t rowbase = (size_t)a.b * SEQ + a.r;
#pragma unroll
        for (int i = 0; i < 8; ++i) { const int id = tid + 512 * i, kk = id >> 4, ch = id & 15;
            *(LAS u32x4*)(lds + AT_KOFF + kk * AT_PITCH + ch * 16) = kr[i]; *(LAS u32x4*)(lds + AT_VOFF + kk * AT_PITCH + ch * 16) = vr[i]; }
        const int tqa = 16 * wave + i16;
        const size_t grow = rowbase + (size_t)(128 * qb + tqa) * a.dil;
        bf16x8 Qf[4];
#pragma unroll
        for (int ks = 0; ks < 4; ++ks) Qf[ks] = *(const bf16x8*)(QKV + grow * NQKV + cq + 32 * ks + 8 * q4);
        __syncthreads();
        if (item + stride < nitems) { const AttnItem an = attn_decode(item + stride); attn_fetch(QKV, an, tid, kr, vr); }
        const int cb0 = wave & ~1;
        f32x4 S[10];
#pragma unroll
        for (int c = 0; c < 10; ++c) {
            f32x4 acc = {0.f, 0.f, 0.f, 0.f};
#pragma unroll
            for (int ks = 0; ks < 4; ++ks) { const bf16x8 kf = *(const LAS bf16x8*)(lds + AT_KOFF + (16 * (cb0 + c) + i16) * AT_PITCH + (32 * ks + 8 * q4) * 2); acc = mma16(kf, Qf[ks], acc); }
            S[c] = acc;
        }
        const float sc = 0.08838834764831845f * 1.4426950408889634f;
        float mx = -INFINITY;
#pragma unroll
        for (int c = 0; c < 10; ++c)
#pragma unroll
            for (int i = 0; i < 4; ++i) { const int kk = 16 * (cb0 + c) + 4 * q4 + i; const bool ok = (kk >= tqa) && (kk <= tqa + 128) && (qb > 0 || kk >= 128);
                const float s = ok ? S[c][i] * sc : -INFINITY; S[c][i] = s; mx = fmaxf(mx, s); }
        mx = fmaxf(mx, __shfl_xor(mx, 16)); mx = fmaxf(mx, __shfl_xor(mx, 32));
        float l = 0.f;
#pragma unroll
        for (int c = 0; c < 10; ++c)
#pragma unroll
            for (int i = 0; i < 4; ++i) { const float pv = __builtin_amdgcn_exp2f(S[c][i] - mx); S[c][i] = pv; l += pv; }
        l += __shfl_xor(l, 16); l += __shfl_xor(l, 32);
        bf16x8 Pf[5];
#pragma unroll
        for (int kst = 0; kst < 5; ++kst) Pf[kst] = pack8(S[2 * kst], S[2 * kst + 1]);
        const float inv = 1.f / l;
        bf16_t* orow = OG + grow * 3072 + g * 1024 + h * 128 + 4 * q4;
        const unsigned vbase = lds_base + AT_VOFF + (16 * cb0 + 4 * q4 + qq) * AT_PITCH + 8 * p;
#pragma unroll
        for (int eb = 0; eb < 8; ++eb) {
            f32x4 acc = {0.f, 0.f, 0.f, 0.f};
            bf16x8 v0, v1, v2, v3, v4;
            TR_READ5(v0, v1, v2, v3, v4, vbase, 0 * AT_PITCH + 32 * eb, 16 * AT_PITCH + 32 * eb, 32 * AT_PITCH + 32 * eb, 48 * AT_PITCH + 32 * eb, 64 * AT_PITCH + 32 * eb, 80 * AT_PITCH + 32 * eb,
                     96 * AT_PITCH + 32 * eb, 112 * AT_PITCH + 32 * eb, 128 * AT_PITCH + 32 * eb, 144 * AT_PITCH + 32 * eb);
            acc = mma16(v0, Pf[0], acc); acc = mma16(v1, Pf[1], acc); acc = mma16(v2, Pf[2], acc); acc = mma16(v3, Pf[3], acc); acc = mma16(v4, Pf[4], acc);
            u32x2 w; w.x = pk2(acc[0] * inv, acc[1] * inv); w.y = pk2(acc[2] * inv, acc[3] * inv);
            *(u32x2*)(orow + 16 * eb) = w;
        }
        if (q4 == 0) LSE[grow * 24 + g * 8 + h] = (mx + log2f(l)) * 0.6931471805599453f;
        __syncthreads();
    }
}

__device__ __forceinline__ void unpack8(const u32x4 w, float (&x)[8]) { x[0] = bflo(w.x); x[1] = bfhi(w.x); x[2] = bflo(w.y); x[3] = bfhi(w.y); x[4] = bflo(w.z); x[5] = bfhi(w.z); x[6] = bflo(w.w); x[7] = bfhi(w.w); }
__device__ __forceinline__ void load8(const float* p, float (&x)[8]) { const f32x4 a = *(const f32x4*)p, b = *(const f32x4*)(p + 4); x[0] = a.x; x[1] = a.y; x[2] = a.z; x[3] = a.w; x[4] = b.x; x[5] = b.y; x[6] = b.z; x[7] = b.w; }
__device__ __forceinline__ void store8(float* p, const float (&x)[8]) { *(f32x4*)p = (f32x4){x[0], x[1], x[2], x[3]}; *(f32x4*)(p + 4) = (f32x4){x[4], x[5], x[6], x[7]}; }
__device__ __forceinline__ void attn_sample_task(LAS unsigned char* wl  , const bf16_t* QKV, const float* c128, const float* c512, const float* c2048, bf16_t* OG, float* LSE, int ia, int wt, int lane) {
    const int bs = wt / 96, rem = wt % 96, g = rem >> 5, h = (rem >> 2) & 7, t = rem & 3;
    const int win = 128 << (2 * g), dil = 1 << (2 * g);
    const float* cache = ((g == 0) ? c128 : (g == 1) ? c512 : c2048) + (size_t)(ia * NBS + bs) * win * 2048;
    const int cq = (g * 3 * 8 + h) * 128, ck = cq + 1024, cv = cq + 2048;
    const size_t rq = (size_t)MP + bs * 4 + t;
    LAS float* qs = (LAS float*)wl; LAS float* ps = (LAS float*)(wl + 512);
    { const unsigned w = *(const unsigned*)(QKV + rq * NQKV + cq + 2 * lane); qs[2 * lane] = bflo(w); qs[2 * lane + 1] = bfhi(w); }
    asm volatile("s_waitcnt lgkmcnt(0)" ::: "memory");
    float sv[3];
#pragma unroll
    for (int pass = 0; pass < 3; ++pass) {
        const int j = pass * 64 + lane; float s = -INFINITY;
        if (j <= 128) {
            const int idx = win + t - dil * j; float acc = 0.f;
            if (idx >= win) { const bf16_t* kp = QKV + ((size_t)MP + bs * 4 + (idx - win)) * NQKV + ck;
                for (int d = 0; d < 128; d += 8) { const u32x4 w = *(const u32x4*)(kp + d); const LAS float* q = qs + d;
                    acc += q[0] * bflo(w.x) + q[1] * bfhi(w.x) + q[2] * bflo(w.y) + q[3] * bfhi(w.y) + q[4] * bflo(w.z) + q[5] * bfhi(w.z) + q[6] * bflo(w.w) + q[7] * bfhi(w.w); } }
            else { const float* kp = cache + ((size_t)idx * 2 + 0) * 1024 + h * 128;
                for (int d = 0; d < 128; d += 4) { const f32x4 kx = *(const f32x4*)(kp + d); const LAS float* q = qs + d; acc += q[0] * kx.x + q[1] * kx.y + q[2] * kx.z + q[3] * kx.w; } }
            s = acc * 0.08838834764831845f;
        }
        sv[pass] = s;
    }
    const float mx = wave_max(fmaxf(fmaxf(sv[0], sv[1]), sv[2]));
    float l = 0.f;
#pragma unroll
    for (int pass = 0; pass < 3; ++pass) { const float pv = fexp(sv[pass] - mx); l += pv; ps[pass * 64 + lane] = pv; }
    l = wave_sum(l);
    asm volatile("s_waitcnt lgkmcnt(0)" ::: "memory");
    { const int jg = lane >> 4, dd = lane & 15;
      float o[8];
#pragma unroll
      for (int q = 0; q < 8; ++q) o[q] = 0.f;
#pragma unroll 4
      for (int j = jg; j <= 128; j += 4) {
          const int idx = win + t - dil * j; const float pj = ps[j]; float v[8];
          if (idx >= win) { unpack8(*(const u32x4*)(QKV + ((size_t)MP + bs * 4 + (idx - win)) * NQKV + cv + 8 * dd), v); }
          else { load8(cache + ((size_t)idx * 2 + 1) * 1024 + h * 128 + 8 * dd, v); }
#pragma unroll
          for (int q = 0; q < 8; ++q) o[q] += pj * v[q];
      }
      const float inv = 1.f / l;
#pragma unroll
      for (int q = 0; q < 8; ++q) { o[q] += __shfl_xor(o[q], 16); o[q] += __shfl_xor(o[q], 32); o[q] *= inv; }
      if (jg == 0) { u32x4 w; w.x = pk2(o[0], o[1]); w.y = pk2(o[2], o[3]); w.z = pk2(o[4], o[5]); w.w = pk2(o[6], o[7]); *(u32x4*)(OG + rq * 3072 + g * 1024 + h * 128 + 8 * dd) = w; } }
    if (lane == 0) LSE[rq * 24 + g * 8 + h] = mx + logf(l);
}

__device__ __forceinline__ void combine_row(const bf16_t* OG, const float* LSE, bf16_t* OC, int r, int lane) {
    const int hh = lane >> 3;
    const float l0 = LSE[(size_t)r * 24 + hh], l1 = LSE[(size_t)r * 24 + 8 + hh], l2 = LSE[(size_t)r * 24 + 16 + hh];
    const float mx = fmaxf(l0, fmaxf(l1, l2));
    float e0 = fexp(l0 - mx), e1 = fexp(l1 - mx), e2 = fexp(l2 - mx);
    const float inv = 1.f / (e0 + e1 + e2); e0 *= inv; e1 *= inv; e2 *= inv;
    const bf16_t* src = OG + (size_t)r * 3072 + 16 * lane;
#pragma unroll
    for (int c = 0; c < 2; ++c) {
        const u32x4 a = *(const u32x4*)(src + 8 * c), bq = *(const u32x4*)(src + 1024 + 8 * c), cc = *(const u32x4*)(src + 2048 + 8 * c);
        u32x4 o;
        o.x = pk2(e0 * bflo(a.x) + e1 * bflo(bq.x) + e2 * bflo(cc.x), e0 * bfhi(a.x) + e1 * bfhi(bq.x) + e2 * bfhi(cc.x));
        o.y = pk2(e0 * bflo(a.y) + e1 * bflo(bq.y) + e2 * bflo(cc.y), e0 * bfhi(a.y) + e1 * bfhi(bq.y) + e2 * bfhi(cc.y));
        o.z = pk2(e0 * bflo(a.z) + e1 * bflo(bq.z) + e2 * bflo(cc.z), e0 * bfhi(a.z) + e1 * bfhi(bq.z) + e2 * bfhi(cc.z));
        o.w = pk2(e0 * bflo(a.w) + e1 * bflo(bq.w) + e2 * bflo(cc.w), e0 * bfhi(a.w) + e1 * bfhi(bq.w) + e2 * bfhi(cc.w));
        *(u32x4*)(OC + (size_t)r * DO + 16 * lane + 8 * c) = o;
    }
}

__device__ __forceinline__ float scan_sum(float v, int lane) {
#pragma unroll
    for (int o = 1; o < 64; o <<= 1) { const float t = __shfl_up(v, o); if (lane >= o) v += t; }
    return v;
}
__device__ __forceinline__ float scan_max(float v, int lane) {
#pragma unroll
    for (int o = 1; o < 64; o <<= 1) { const float t = __shfl_up(v, o); if (lane >= o) v = fmaxf(v, t); }
    return v;
}
constexpr int ML_QP = 272, ML_VP = 80, ML_PP = 144;
constexpr int ML_QSZ = 64 * ML_QP, ML_VSZ = 64 * ML_VP;
constexpr int ML_Q = 0, ML_K = ML_Q + 2 * ML_QSZ, ML_V = ML_K + 2 * ML_QSZ, ML_KW = ML_V + 2 * ML_VSZ, ML_P = ML_KW + ML_QSZ, ML_N = ML_P + 64 * ML_PP, ML_DEN = ML_N + 1024, ML_END = ML_DEN + 256;
__device__ __forceinline__ void mlstm_prompt(LAS unsigned char* lds, unsigned lds_base, const bf16_t* QKVO, const float* GATES, bf16_t* HRAW, float* SQ, float* out, int ib, int bh, int sl, int tid, int wave, int lane) {
    const int b = bh >> 3, h = bh & 7;
    const int i16 = lane & 15, q4 = lane >> 4, qq = i16 >> 2, p = lane & 3;
    const int rb = wave >> 1, ea = wave & 1, e0 = 32 * sl + 16 * ea;
    f32x4 CT[8];
#pragma unroll
    for (int d = 0; d < 8; ++d) CT[d] = (f32x4){0.f, 0.f, 0.f, 0.f};
    float m = 0.f;
    const unsigned vbase0 = lds_base + ML_V + (8 * q4 + qq) * ML_VP + (16 * ea + 4 * p) * 2, kwbase = lds_base + ML_KW + (8 * q4 + qq) * ML_QP + 8 * p;
    LAS float* nS = (LAS float*)(lds + ML_N); LAS float* denS = (LAS float*)(lds + ML_DEN);
    const size_t rbase = (size_t)b * SEQ;
    const int srow0 = tid >> 4, sch = tid & 15, vrow = (tid >> 2) & 63, vch = tid & 3;
    u32x4 pq0, pq1, pk0, pk1, pv; float pig, plf;
    { const bf16_t* s0 = QKVO + (rbase + srow0) * NIN + h * 128 + 8 * sch; const bf16_t* s1 = s0 + (size_t)32 * NIN;
      pq0 = *(const u32x4*)s0; pk0 = *(const u32x4*)(s0 + 1024); pq1 = *(const u32x4*)s1; pk1 = *(const u32x4*)(s1 + 1024);
      pv = *(const u32x4*)(QKVO + (rbase + vrow) * NIN + 2048 + h * 256 + 32 * sl + 8 * vch);
      pig = GATES[(rbase + lane) * 16 + h]; plf = GATES[(rbase + lane) * 16 + 8 + h]; }
    __syncthreads();
    if (tid < 128) nS[tid] = 0.f;
    *(LAS u32x4*)(lds + ML_Q + srow0 * ML_QP + sch * 16) = pq0; *(LAS u32x4*)(lds + ML_Q + (srow0 + 32) * ML_QP + sch * 16) = pq1;
    *(LAS u32x4*)(lds + ML_K + srow0 * ML_QP + sch * 16) = pk0; *(LAS u32x4*)(lds + ML_K + (srow0 + 32) * ML_QP + sch * 16) = pk1;
    if (tid < 256) *(LAS u32x4*)(lds + ML_V + vrow * ML_VP + vch * 16) = pv;
    __syncthreads();
#pragma unroll 1
    for (int c = 0; c < 32; ++c) {
        const int cur = c & 1, nxt = cur ^ 1;
        const size_t r0 = rbase + 64 * c;
        const LAS unsigned char* Qc = lds + ML_Q + cur * ML_QSZ; const LAS unsigned char* Kc = lds + ML_K + cur * ML_QSZ;
        const float ig = pig, lf = plf;
        { const size_t rn = rbase + 64 * ((c < 31) ? c + 1 : c);
          const bf16_t* s0 = QKVO + (rn + srow0) * NIN + h * 128 + 8 * sch; const bf16_t* s1 = s0 + (size_t)32 * NIN;
          pq0 = *(const u32x4*)s0; pk0 = *(const u32x4*)(s0 + 1024); pq1 = *(const u32x4*)s1; pk1 = *(const u32x4*)(s1 + 1024);
          pv = *(const u32x4*)(QKVO + (rn + vrow) * NIN + 2048 + h * 256 + 32 * sl + 8 * vch);
          pig = GATES[(rn + lane) * 16 + h]; plf = GATES[(rn + lane) * 16 + 8 + h]; }
        const float bcum = scan_sum(lf, lane);
        const float av = ig - bcum;
        const float Av = fmaxf(m, scan_max(av, lane));
        const float bL = __shfl(bcum, 63), A63 = __shfl(Av, 63);
        const float wsv = fexp(av - A63), wC = fexp(m - A63);
#pragma unroll
        for (int i = 0; i < 2; ++i) { const int id = lane + 64 * i, rr = 8 * wave + (id >> 4), ch = id & 15;
            const u32x4 kx = *(const LAS u32x4*)(Kc + rr * ML_QP + ch * 16); const float w = __shfl(wsv, rr);
            u32x4 o; o.x = pk2(bflo(kx.x) * w, bfhi(kx.x) * w); o.y = pk2(bflo(kx.y) * w, bfhi(kx.y) * w); o.z = pk2(bflo(kx.z) * w, bfhi(kx.z) * w); o.w = pk2(bflo(kx.w) * w, bfhi(kx.w) * w);
            *(LAS u32x4*)(lds + ML_KW + rr * ML_QP + ch * 16) = o; }
        {
#pragma unroll
          for (int cc = 0; cc < 2; ++cc) { const int cb = 2 * (wave & 1) + cc;
            f32x4 s = {0.f, 0.f, 0.f, 0.f};
            if (cb <= rb) {
#pragma unroll
                for (int ks = 0; ks < 4; ++ks) { const bf16x8 af = *(const LAS bf16x8*)(Qc + (16 * rb + i16) * ML_QP + (32 * ks + 8 * q4) * 2);
                    const bf16x8 bf = *(const LAS bf16x8*)(Kc + (16 * cb + i16) * ML_QP + (32 * ks + 8 * q4) * 2); s = mma16(af, bf, s); } }
            const int sidx = 16 * cb + i16; const float as = __shfl(av, sidx);
#pragma unroll
            for (int i = 0; i < 4; ++i) { const int t = 16 * rb + 4 * q4 + i; const float At = __shfl(Av, t);
                const float pv_ = (sidx <= t && cb <= rb) ? s[i] * fexp(as - At) : 0.f;
                *(LAS bf16_t*)(lds + ML_P + t * ML_PP + sidx * 2) = (bf16_t)f2bf(pv_); } } }
        __syncthreads();
        { const int t = tid >> 3, part = tid & 7;
          const LAS unsigned char* qrow = Qc + t * ML_QP + part * 32;
          const u32x4 qa = *(const LAS u32x4*)(qrow), qb = *(const LAS u32x4*)(qrow + 16);
          const LAS float* nn = nS + cur * 128 + 16 * part;
          float a = nn[0] * bflo(qa.x) + nn[1] * bfhi(qa.x) + nn[2] * bflo(qa.y) + nn[3] * bfhi(qa.y) + nn[4] * bflo(qa.z) + nn[5] * bfhi(qa.z) + nn[6] * bflo(qa.w) + nn[7] * bfhi(qa.w)
                  + nn[8] * bflo(qb.x) + nn[9] * bfhi(qb.x) + nn[10] * bflo(qb.y) + nn[11] * bfhi(qb.y) + nn[12] * bflo(qb.z) + nn[13] * bfhi(qb.z) + nn[14] * bflo(qb.w) + nn[15] * bfhi(qb.w);
          const u32x4 pr = *(const LAS u32x4*)(lds + ML_P + t * ML_PP + part * 16);
          const float rsum = ((bflo(pr.x) + bfhi(pr.x)) + (bflo(pr.y) + bfhi(pr.y))) + ((bflo(pr.z) + bfhi(pr.z)) + (bflo(pr.w) + bfhi(pr.w)));
          const float At = __shfl(Av, t), bt = __shfl(bcum, t);
          float val = fexp(m - At) * a + rsum;
          val += __shfl_xor(val, 1); val += __shfl_xor(val, 2); val += __shfl_xor(val, 4);
          if (part == 0) denS[t] = 1.f / fmaxf(fabsf(val), fexp(-(bt + At))); }
        if (tid < 128) { float acc = wC * nS[cur * 128 + tid];
#pragma unroll 8
            for (int s = 0; s < 64; ++s) acc += bf1(*(const LAS bf16_t*)(lds + ML_KW + s * ML_QP + tid * 2));
            nS[nxt * 128 + tid] = acc; }
        f32x4 num = {0.f, 0.f, 0.f, 0.f};
#pragma unroll
        for (int ks = 0; ks < 4; ++ks) { const LAS unsigned char* qrow = Qc + (16 * rb + i16) * ML_QP;
            const u32x2 lo = *(const LAS u32x2*)(qrow + (32 * ks + 4 * q4) * 2), hi = *(const LAS u32x2*)(qrow + (32 * ks + 16 + 4 * q4) * 2);
            u32x4 w; w.x = lo.x; w.y = lo.y; w.z = hi.x; w.w = hi.y;
            num = mma16(__builtin_bit_cast(bf16x8, w), pack8(CT[2 * ks], CT[2 * ks + 1]), num); }
#pragma unroll
        for (int i = 0; i < 4; ++i) num[i] *= fexp(m - __shfl(Av, 16 * rb + 4 * q4 + i));
        const unsigned vbase = vbase0 + cur * ML_VSZ;
        bf16x8 Vf[2];
#pragma unroll
        for (int ks = 0; ks < 2; ++ks) Vf[ks] = tr_read2(vbase, 32 * ks * ML_VP, (32 * ks + 4) * ML_VP);
#pragma unroll
        for (int ks = 0; ks < 2; ++ks) { const bf16x8 pf = *(const LAS bf16x8*)(lds + ML_P + (16 * rb + i16) * ML_PP + (32 * ks + 8 * q4) * 2); num = mma16(pf, Vf[ks], num); }
#pragma unroll
        for (int d = 0; d < 8; ++d) CT[d] = CT[d] * wC;
#pragma unroll
        for (int ks = 0; ks < 2; ++ks)
#pragma unroll
            for (int dg = 0; dg < 2; ++dg) { bf16x8 k0, k1, k2, k3;
                TR_READ4(k0, k1, k2, k3, kwbase, 32 * ks * ML_QP + 32 * (4 * dg), (32 * ks + 4) * ML_QP + 32 * (4 * dg), 32 * ks * ML_QP + 32 * (4 * dg + 1), (32 * ks + 4) * ML_QP + 32 * (4 * dg + 1),
                         32 * ks * ML_QP + 32 * (4 * dg + 2), (32 * ks + 4) * ML_QP + 32 * (4 * dg + 2), 32 * ks * ML_QP + 32 * (4 * dg + 3), (32 * ks + 4) * ML_QP + 32 * (4 * dg + 3));
                CT[4 * dg] = mma16(k0, Vf[ks], CT[4 * dg]); CT[4 * dg + 1] = mma16(k1, Vf[ks], CT[4 * dg + 1]); CT[4 * dg + 2] = mma16(k2, Vf[ks], CT[4 * dg + 2]); CT[4 * dg + 3] = mma16(k3, Vf[ks], CT[4 * dg + 3]); }
        { LAS unsigned char* Qn = lds + ML_Q + nxt * ML_QSZ; LAS unsigned char* Kn = lds + ML_K + nxt * ML_QSZ;
          *(LAS u32x4*)(Qn + srow0 * ML_QP + sch * 16) = pq0; *(LAS u32x4*)(Qn + (srow0 + 32) * ML_QP + sch * 16) = pq1;
          *(LAS u32x4*)(Kn + srow0 * ML_QP + sch * 16) = pk0; *(LAS u32x4*)(Kn + (srow0 + 32) * ML_QP + sch * 16) = pk1;
          if (tid < 256) *(LAS u32x4*)(lds + ML_V + nxt * ML_VSZ + vrow * ML_VP + vch * 16) = pv; }
        __syncthreads();
#pragma unroll
        for (int i = 0; i < 4; ++i) { const int t = 16 * rb + 4 * q4 + i; const float hv = num[i] * denS[t];
            HRAW[(r0 + t) * DM + h * 256 + e0 + i16] = (bf16_t)f2bf(hv);
            float sq = hv * hv; sq += __shfl_xor(sq, 1); sq += __shfl_xor(sq, 2); sq += __shfl_xor(sq, 4); sq += __shfl_xor(sq, 8);
            if (i16 == 0) SQ[(r0 + t) * 128 + h * 16 + 2 * sl + ea] = sq; }
        m = bL + A63;
    }
    const size_t sb = (size_t)(ib * NBP + b) * 8 + h;
    if (rb == 0) {
#pragma unroll
        for (int d = 0; d < 8; ++d) *(f32x4*)(out + O_CP + (sb * 256 + e0 + i16) * 128 + 16 * d + 4 * q4) = CT[d]; }
    if (sl == 0) { if (tid < 128) out[O_NP + sb * 128 + tid] = nS[tid]; if (tid == 0) out[O_MP + sb] = m; }
}

__device__ __forceinline__ void hn_row(const bf16_t* HRAW, const float* SQ, const bf16_t* QKVO, const float* gh, bf16_t* HN, int r, int lane) {
    const int hh = lane >> 3;
    const f32x4 s0 = *(const f32x4*)(SQ + (size_t)r * 128 + hh * 16), s1 = *(const f32x4*)(SQ + (size_t)r * 128 + hh * 16 + 4), s2 = *(const f32x4*)(SQ + (size_t)r * 128 + hh * 16 + 8), s3 = *(const f32x4*)(SQ + (size_t)r * 128 + hh * 16 + 12);
    const float tot = (((s0[0] + s0[1]) + (s0[2] + s0[3])) + ((s1[0] + s1[1]) + (s1[2] + s1[3]))) + (((s2[0] + s2[1]) + (s2[2] + s2[3])) + ((s3[0] + s3[1]) + (s3[2] + s3[3])));
    const float rs = rsqrtf(tot * (1.f / 256.f) + EPS);
#pragma unroll
    for (int c = 0; c < 4; ++c) { const int col = 32 * lane + 8 * c;
        const u32x4 hx = *(const u32x4*)(HRAW + (size_t)r * DM + col), ox = *(const u32x4*)(QKVO + (size_t)r * NIN + 4096 + col);
        const f32x4 g0 = *(const f32x4*)(gh + col), g1 = *(const f32x4*)(gh + col + 4);
        u32x4 o;
        o.x = pk2(bflo(hx.x) * rs * g0[0] / (1.f + fexp(-bflo(ox.x))), bfhi(hx.x) * rs * g0[1] / (1.f + fexp(-bfhi(ox.x))));
        o.y = pk2(bflo(hx.y) * rs * g0[2] / (1.f + fexp(-bflo(ox.y))), bfhi(hx.y) * rs * g0[3] / (1.f + fexp(-bfhi(ox.y))));
        o.z = pk2(bflo(hx.z) * rs * g1[0] / (1.f + fexp(-bflo(ox.z))), bfhi(hx.z) * rs * g1[1] / (1.f + fexp(-bfhi(ox.z))));
        o.w = pk2(bflo(hx.w) * rs * g1[2] / (1.f + fexp(-bflo(ox.w))), bfhi(hx.w) * rs * g1[3] / (1.f + fexp(-bfhi(ox.w))));
        *(u32x4*)(HN + (size_t)r * DM + col) = o; }
}

__device__ __forceinline__ void mlstm_sample(LAS unsigned char* lds, const bf16_t* QKVO, const float* GATES, const float* gh, const float* C0all, const float* n0all, const float* m0all, bf16_t* HN, float* out, int ib, int bh, int tid, int wave, int lane) {
    const int bs = bh >> 3, h = bh & 7;
    const size_t sb = (size_t)(ib * NBS + bs) * 8 + h;
    LAS float* qs = (LAS float*)lds;
    LAS float* ks = qs + 512;
    LAS float* ns = ks + 512;
    LAS float* Ss = ns + 128;
    LAS float* nq = Ss + 16;
    LAS float* red = nq + 16;
    const size_t r0 = (size_t)MP + bs * 4;
    __syncthreads();
    { const int t = tid >> 7, d = tid & 127; qs[tid] = bf1(QKVO[(r0 + t) * NIN + h * 128 + d]); ks[tid] = bf1(QKVO[(r0 + t) * NIN + 1024 + h * 128 + d]); if (tid < 128) ns[tid] = n0all[sb * 128 + tid]; }
    __syncthreads();
    if (wave == 0) {
        if (lane < 16) { const int t = lane >> 2, s = lane & 3; float a = 0.f; for (int d = 0; d < 128; ++d) a += qs[t * 128 + d] * ks[s * 128 + d]; Ss[lane] = a; }
        else if (lane < 20) { const int t = lane - 16; float a = 0.f; for (int d = 0; d < 128; ++d) a += ns[d] * qs[t * 128 + d]; nq[t] = a; }
    }
    __syncthreads();
    const float m0 = m0all[sb];
    float bc[4], av[4], Av[4];
    { float run = 0.f, pm = -INFINITY;
#pragma unroll
      for (int t = 0; t < 4; ++t) { const float ig = GATES[(r0 + t) * 16 + h], lf = GATES[(r0 + t) * 16 + 8 + h]; run += lf; bc[t] = run; av[t] = ig - run; pm = fmaxf(pm, av[t]); Av[t] = fmaxf(m0, pm); } }
    const float A3 = Av[3], wC = fexp(m0 - A3);
    float Pm[4][4], den[4];
#pragma unroll
    for (int t = 0; t < 4; ++t) { float rs = 0.f;
#pragma unroll
        for (int s = 0; s < 4; ++s) { Pm[t][s] = (s <= t) ? Ss[t * 4 + s] * fexp(av[s] - Av[t]) : 0.f; rs += Pm[t][s]; }
        den[t] = fexp(m0 - Av[t]) * nq[t] + rs; }
    const int e = tid >> 1, hf = tid & 1;
    const float* Crow = C0all + (sb * 256 + e) * 128 + 64 * hf;
    f32x4 Cv[16];
#pragma unroll
    for (int j = 0; j < 16; ++j) Cv[j] = *(const f32x4*)(Crow + 4 * j);
    float inter[4];
#pragma unroll
    for (int t = 0; t < 4; ++t) { float a = 0.f; const LAS float* q = qs + t * 128 + 64 * hf;
#pragma unroll
        for (int j = 0; j < 16; ++j) a += Cv[j].x * q[4 * j] + Cv[j].y * q[4 * j + 1] + Cv[j].z * q[4 * j + 2] + Cv[j].w * q[4 * j + 3];
        a += __shfl_xor(a, 1); inter[t] = a; }
    float vv[4];
#pragma unroll
    for (int s = 0; s < 4; ++s) vv[s] = bf1(QKVO[(r0 + s) * NIN + 2048 + h * 256 + e]);
    float hv[4];
#pragma unroll
    for (int t = 0; t < 4; ++t) { float nu = fexp(m0 - Av[t]) * inter[t];
#pragma unroll
        for (int s = 0; s < 4; ++s) nu += Pm[t][s] * vv[s];
        hv[t] = nu / fmaxf(fabsf(den[t]), fexp(-(bc[t] + Av[t])));
        float sq = (hf == 0) ? hv[t] * hv[t] : 0.f; sq = wave_sum(sq); if (lane == 0) red[t * 8 + wave] = sq; }
    __syncthreads();
    if (hf == 0) {
#pragma unroll
        for (int t = 0; t < 4; ++t) { float tot = 0.f;
#pragma unroll
            for (int w = 0; w < 8; ++w) tot += red[t * 8 + w];
            const float rs = rsqrtf(tot * (1.f / 256.f) + EPS);
            const float og = bf1(QKVO[(r0 + t) * NIN + 4096 + h * 256 + e]);
            HN[(r0 + t) * DM + h * 256 + e] = (bf16_t)f2bf(hv[t] * rs * gh[h * 256 + e] / (1.f + fexp(-og))); } }
    float wv[4];
#pragma unroll
    for (int s = 0; s < 4; ++s) wv[s] = fexp(av[s] - A3) * vv[s];
    float* Cout = out + O_CS + (sb * 256 + e) * 128 + 64 * hf;
#pragma unroll
    for (int j = 0; j < 16; ++j) { f32x4 o = Cv[j] * wC;
#pragma unroll
        for (int s = 0; s < 4; ++s) { const LAS float* k = ks + s * 128 + 64 * hf + 4 * j; o.x += wv[s] * k[0]; o.y += wv[s] * k[1]; o.z += wv[s] * k[2]; o.w += wv[s] * k[3]; }
        *(f32x4*)(Cout + 4 * j) = o; }
    if (tid < 128) { float o = wC * ns[tid];
#pragma unroll
        for (int s = 0; s < 4; ++s) o += fexp(av[s] - A3) * ks[s * 128 + tid];
        out[O_NS + sb * 128 + tid] = o; }
    if (tid == 0) out[O_MS + sb] = bc[3] + A3;
}

__device__ __forceinline__ void cache_shift(const Params& P, float* outp, int ia, int w, int NW, int lane) {
    constexpr int N0 = NBS * 124, N1 = NBS * 508, N2 = NBS * 2044;
    for (int it = w; it < N0 + N1 + N2; it += NW) {
        int g, q; if (it < N0) { g = 0; q = it; } else if (it < N0 + N1) { g = 1; q = it - N0; } else { g = 2; q = it - N0 - N1; }
        const int win = 128 << (2 * g), per = win - 4, bs = q / per, j = q % per;
        const float* src = P.in[2 + g] + ((size_t)(ia * NBS + bs) * win + j + 4) * 2048;
        float* dst = outp + ((g == 0) ? O_KV128S : (g == 1) ? O_KV512S : O_KV2048S) + ((size_t)(ia * NBS + bs) * win + j) * 2048;
#pragma unroll
        for (int i = 0; i < 8; ++i) ((f32x4*)dst)[lane + 64 * i] = ((const f32x4*)src)[lane + 64 * i];
    }
}

__device__ __forceinline__ void phase_convgate(const Params& P, float* outp, const bf16_t* U, bf16_t* Z, int layer, int gtid, int NGT) {
    constexpr int NCG = DFF / 8, NRUN = MP / 64 + NBS;
    const float* cw = P.in[20] + (size_t)layer * 3 * NUP; const float* cbias = P.in[21] + (size_t)layer * NUP;
    for (int task = gtid; task < NCG * NRUN; task += NGT) {
        const int cg = task % NCG, run = task / NCG, j0 = 8 * cg;
        float wa[3][8], wb[3][8], ba[8], bb[8];
#pragma unroll
        for (int k = 0; k < 3; ++k) { load8(cw + (size_t)k * NUP + j0, wa[k]); load8(cw + (size_t)k * NUP + DFF + j0, wb[k]); }
        load8(cbias + j0, ba); load8(cbias + DFF + j0, bb);
        float a2[8], a1[8], b2[8], b1[8];
        size_t row0; int nrows; float* cout;
        if (run < MP / 64) { const int b = run >> 5, s0 = (run & 31) * 64; row0 = (size_t)b * SEQ + s0; nrows = 64;
            cout = (s0 == SEQ - 64) ? outp + O_CONVP + ((size_t)(layer * NBP + b) * 2) * NUP : nullptr;
            if (s0 == 0) {
#pragma unroll
                for (int j = 0; j < 8; ++j) { a2[j] = 0.f; a1[j] = 0.f; b2[j] = 0.f; b1[j] = 0.f; } }
            else { unpack8(*(const u32x4*)(U + (row0 - 2) * NUP + j0), a2); unpack8(*(const u32x4*)(U + (row0 - 1) * NUP + j0), a1);
                   unpack8(*(const u32x4*)(U + (row0 - 2) * NUP + DFF + j0), b2); unpack8(*(const u32x4*)(U + (row0 - 1) * NUP + DFF + j0), b1); } }
        else { const int bs = run - MP / 64; row0 = (size_t)MP + bs * 4; nrows = 4;
            cout = outp + O_CONVS + ((size_t)(layer * NBS + bs) * 2) * NUP;
            const float* st = P.in[8] + ((size_t)(layer * NBS + bs) * 2) * NUP;
            load8(st + j0, a2); load8(st + NUP + j0, a1); load8(st + DFF + j0, b2); load8(st + NUP + DFF + j0, b1); }
        for (int t = 0; t < nrows; t += 4) {
            u32x4 ua[4], ub[4];
#pragma unroll
            for (int q = 0; q < 4; ++q) { ua[q] = *(const u32x4*)(U + (row0 + t + q) * NUP + j0); ub[q] = *(const u32x4*)(U + (row0 + t + q) * NUP + DFF + j0); }
#pragma unroll
            for (int q = 0; q < 4; ++q) {
                float a0[8], b0[8];
                unpack8(ua[q], a0); unpack8(ub[q], b0);
                float z[8];
#pragma unroll
                for (int j = 0; j < 8; ++j) { const float ca = ba[j] + wa[0][j] * a2[j] + wa[1][j] * a1[j] + wa[2][j] * a0[j]; const float cb = bb[j] + wb[0][j] * b2[j] + wb[1][j] * b1[j] + wb[2][j] * b0[j];
                    z[j] = ca / (1.f + fexp(-ca)) * cb; a2[j] = a1[j]; a1[j] = a0[j]; b2[j] = b1[j]; b1[j] = b0[j]; }
                u32x4 o; o.x = pk2(z[0], z[1]); o.y = pk2(z[2], z[3]); o.z = pk2(z[4], z[5]); o.w = pk2(z[6], z[7]);
                *(u32x4*)(Z + (row0 + t + q) * DFF + j0) = o;
            }
        }
        if (cout) { store8(cout + j0, a2); store8(cout + NUP + j0, a1); store8(cout + DFF + j0, b2); store8(cout + NUP + DFF + j0, b1); }
    }
}

#ifndef REP_STORE
#define REP_STORE 1
#endif
#ifndef REP_CONV
#define REP_CONV 1
#endif
#ifndef REP_ML
#define REP_ML 1
#endif
#ifndef REP_ATT
#define REP_ATT 1
#endif
#ifndef REP_RESID
#define REP_RESID 1
#endif
#ifndef REP_P0
#define REP_P0 1
#endif
#define REPEAT(n, body) do { body; if ((n) > 1) { body; } if ((n) > 2) { body; } } while (0)
__global__ void __launch_bounds__(NTHR, 2) fwd_kernel(Params P) {
    extern __shared__ __attribute__((aligned(16))) unsigned char lds_raw[];
    LAS unsigned char* lds = (LAS unsigned char*)lds_raw;
    const unsigned lds_base = (unsigned)(size_t)lds;
    const int tid0 = threadIdx.x;
    const int G0 = gridDim.x, bx0 = blockIdx.x;
#define PHASE_IDS int tid = tid0; asm volatile("" : "+v"(tid)); int zz_ = 0; asm volatile("" : "+v"(zz_)); zz_ = __builtin_amdgcn_readfirstlane(zz_); const int bx = bx0 + zz_, G = G0 + zz_; unsigned char* ws = P.ws + zz_; float* outp = P.out + zz_; \
    const int lane = tid & 63, wave = __builtin_amdgcn_readfirstlane(tid >> 6); const int gw = bx * NWAVES + wave, gtid = bx * NTHR + tid, NGW = G * NWAVES, NGT = G * NTHR; (void)gw; (void)gtid; (void)lane; (void)NGW; (void)NGT; (void)outp; \
    float* X = (float*)(ws + WS_X); bf16_t* XB = (bf16_t*)(ws + WS_XB); float* SSQ = (float*)(ws + WS_SSQ); float* SSQS = (float*)(ws + WS_SSQS); bf16_t* QKV = (bf16_t*)(ws + WS_QKV); bf16_t* OG = (bf16_t*)(ws + WS_OG); float* LSE = (float*)(ws + WS_LSE); bf16_t* OC = (bf16_t*)(ws + WS_OC); \
    float* GATES = (float*)(ws + WS_GATES); bf16_t* U = (bf16_t*)(ws + WS_U); bf16_t* Z = (bf16_t*)(ws + WS_Z); (void)X; (void)XB; (void)SSQ; (void)SSQS; (void)QKV; (void)OG; (void)LSE; (void)OC; (void)GATES; (void)U; (void)Z;
    volatile LAS unsigned* misc = (volatile LAS unsigned*)(lds + LDS_MISC_OFF);
    if (tid0 < 16) misc[tid0] = 0u;
    __syncthreads();
    { const XcdBarrier bar0 = xcd_barrier_post((unsigned*)(P.ws + WS_CTL) + 1024, misc + 8); if (tid0 == 0) misc[10] = bar0.x; }
    __syncthreads();
#define GRID_BAR() do { XcdBarrier bar_; bar_.bar = (unsigned*)(P.ws + WS_CTL) + 1024; bar_.x = (unsigned)__builtin_amdgcn_readfirstlane((int)misc[10]); bar_.st = misc + 8; xcd_barrier(bar_); } while (0)
#define GEMM_STORE(Abuf, Wt, NN, KK, Obuf) REPEAT(REP_STORE, GEMM_STORE1(Abuf, Wt, NN, KK, Obuf))
#define GEMM_STORE1(Abuf, Wt, NN, KK, Obuf) do { PHASE_IDS; \
        { pg8::Gemm g{Abuf, (const bf16_t*)(Wt), MP, NN, KK}; pg8::StaticOrder S; S.init(MP, NN, G, bx); pg8::EpiStoreN E{Obuf, NN, SSQ, EPS}; \
          pg8::gemm_phase<pg8::EpiStoreN, pg8::StaticOrder, true, true>(lds, g, S, E); } \
        skinny_phase<0>(lds, Abuf + (size_t)MP * KK, KK, (const bf16_t*)(Wt), NN, Obuf + (size_t)MP * NN, NN, nullptr, nullptr, SSQS, nullptr, bx, G, (((MP / 256) * ((NN) / 256)) % G) ? G - (((MP / 256) * ((NN) / 256)) % G) : G, tid, wave, lane); } while (0)
#define GEMM_RESID(Abuf, Wt, KK, FIN) do { GEMM_RESID1(Abuf, Wt, KK, FIN); if (REP_RESID > 1) { PHASE_IDS; float* scr_ = (float*)(ws + WS_U); \
        { pg8::Gemm g{Abuf, (const bf16_t*)(Wt), MP, DM, KK}; pg8::StaticOrder S; S.init(MP, DM, G, bx); pg8::EpiResidN E{X, scr_, nullptr, nullptr, DM}; \
          pg8::gemm_phase<pg8::EpiResidN, pg8::StaticOrder, true, true>(lds, g, S, E); } \
        skinny_phase<2>(lds, Abuf + (size_t)MP * KK, KK, (const bf16_t*)(Wt), DM, nullptr, 0, X + (size_t)MP * DM, nullptr, nullptr, scr_ + (size_t)MP * DM, bx, G, G, tid, wave, lane); } } while (0)
#define GEMM_RESID1(Abuf, Wt, KK, FIN) do { PHASE_IDS; \
        { pg8::Gemm g{Abuf, (const bf16_t*)(Wt), MP, DM, KK}; pg8::StaticOrder S; S.init(MP, DM, G, bx); pg8::EpiResidN E{X, (FIN) ? outp : X, (FIN) ? nullptr : XB, (FIN) ? nullptr : SSQ, DM}; \
          pg8::gemm_phase<pg8::EpiResidN, pg8::StaticOrder, true, true>(lds, g, S, E); } \
        if (FIN) skinny_phase<2>(lds, Abuf + (size_t)MP * KK, KK, (const bf16_t*)(Wt), DM, nullptr, 0, X + (size_t)MP * DM, nullptr, nullptr, outp + (size_t)MP * DM, bx, G, G, tid, wave, lane); \
        else skinny_phase<1>(lds, Abuf + (size_t)MP * KK, KK, (const bf16_t*)(Wt), DM, nullptr, 0, X + (size_t)MP * DM, XB + (size_t)MP * DM, SSQS, nullptr, bx, G, G, tid, wave, lane); } while (0)

    REPEAT(REP_P0, { PHASE_IDS; phase_prologue(P, lds, gw, NGW, wave, lane); });
    GRID_BAR();

#define FFN(L, FIN) do { \
        GEMM_STORE(XB, ws + WS_WUP + (L) * SZ_WUP, NUP, DM, U); \
        GRID_BAR(); \
        REPEAT(REP_CONV, { PHASE_IDS; phase_convgate(P, outp, U, Z, (L), gtid, NGT); }); \
        GRID_BAR(); \
        GEMM_RESID(Z, ws + WS_WDOWN + (L) * SZ_WDOWN, DFF, FIN); \
    } while (0)

#define LAYER_PAIR(lp) do { \
        { \
            const int ia = (lp); \
            GEMM_STORE(XB, ws + WS_WQKV + ia * SZ_WQKV, NQKV, DM, QKV); \
            GRID_BAR(); \
            { PHASE_IDS; for (int r = gw; r < MR; r += NGW) prep_row(QKV, (const float*)(ws + WS_ROPE), P.in[12] + ia * 128, P.in[13] + ia * 128, outp, ia, r, lane); } \
            GRID_BAR(); \
            REPEAT(REP_ATT, { PHASE_IDS; attn_phase(lds, lds_base, QKV, OG, LSE, bx, G, 1536, tid, wave, lane); } \
            { PHASE_IDS; for (int wt = bx + G * wave; wt < NBS * 96; wt += G * NWAVES) attn_sample_task(lds + wave * 2048, QKV, P.in[2], P.in[3], P.in[4], OG, LSE, ia, wt, lane); __syncthreads(); }); \
            GRID_BAR(); \
            REPEAT(REP_ATT, { PHASE_IDS; for (int r = gw; r < MR; r += NGW) combine_row(OG, LSE, OC, r, lane); }); \
            GRID_BAR(); \
            GEMM_RESID(OC, ws + WS_WO + ia * SZ_WO, DO, false); \
            GRID_BAR(); \
            FFN(2 * (lp), false); \
            GRID_BAR(); \
        } \
        { \
            const int L = 2 * (lp) + 1, ib = (lp); \
            GEMM_STORE(XB, ws + WS_WIN + ib * SZ_WIN, NIN, DM, QKV); \
            { PHASE_IDS; for (int task = G - 1 - bx; task < MR / 16; task += G) gate_block(lds, X, (const f32x4*)(ws + WS_WGP) + (size_t)ib * 128 * 64, P.in[16] + ib * 16, GATES, task, wave, lane); } \
            GRID_BAR(); \
            REPEAT(REP_ML, { PHASE_IDS; \
            for (int unit = bx; unit < 256; unit += G) mlstm_prompt(lds, lds_base, QKV, GATES, OG, (float*)(ws + WS_SQ), outp, ib, unit >> 3, unit & 7, tid, wave, lane); }); \
            GRID_BAR(); \
            REPEAT(REP_ML, { PHASE_IDS; \
            for (int unit = bx; unit < 64; unit += G) mlstm_sample(lds, QKV, GATES, P.in[17] + (size_t)ib * DM, P.in[5], P.in[6], P.in[7], OC, outp, ib, unit, tid, wave, lane); \
            for (int r = gw; r < MP; r += NGW) hn_row(OG, (const float*)(ws + WS_SQ), QKV, P.in[17] + (size_t)ib * DM, OC, r, lane); \
            cache_shift(P, outp, (lp), gw, NGW, lane); }); \
            GRID_BAR(); \
            GEMM_RESID(OC, ws + WS_WOUT + ib * SZ_WOUT, DM, false); \
            GRID_BAR(); \
            FFN(L, (L == DEPTH - 1)); \
            if ((lp) == 0) GRID_BAR(); \
        } \
    } while (0)
    LAYER_PAIR(0);
    LAYER_PAIR(1);
}

extern "C" void kernel_launch(void* const* d_in, const int* in_sizes, int n_in, void* d_out, int out_size, void* d_ws, size_t ws_size, hipStream_t stream) {
    static int grid = 0;
    if (grid == 0) {
        if (n_in != 23 || (size_t)out_size != O_END || ws_size < WS_END) {
            fprintf(stderr, "kernel_launch: built for 23 inputs, %zu outputs, >= %zu bytes of workspace; got n_in %d, out %d, ws %zu; nothing launched\n", (size_t)O_END, (size_t)WS_END, n_in, out_size, ws_size);
            grid = -1; return; }
        int dev = 0, cus = 0, per_cu = 0;
        if (hipGetDevice(&dev) != hipSuccess || hipDeviceGetAttribute(&cus, hipDeviceAttributeMultiprocessorCount, dev) != hipSuccess) { fprintf(stderr, "kernel_launch: device query failed\n"); grid = -1; return; }
        if (hipFuncSetAttribute((const void*)fwd_kernel, hipFuncAttributeMaxDynamicSharedMemorySize, LDS_BYTES) != hipSuccess) { fprintf(stderr, "kernel_launch: hipFuncSetAttribute failed\n"); grid = -1; return; }
        if (hipOccupancyMaxActiveBlocksPerMultiprocessor(&per_cu, (const void*)fwd_kernel, NTHR, LDS_BYTES) != hipSuccess || per_cu < 1)
            fprintf(stderr, "kernel_launch: occupancy query reports %d workgroups per CU\n", per_cu);
        (void)hipGetLastError();
        grid = cus;
    }
    if (grid < 0) return;
    (void)hipMemsetAsync((char*)d_ws + WS_CTL, 0, CTL_ZERO_BYTES, stream);
    Params p{};
    for (int i = 0; i < 23; ++i) p.in[i] = (const float*)d_in[i];
    p.out = (float*)d_out; p.ws = (unsigned char*)d_ws;
    hipLaunchKernelGGL(fwd_kernel, dim3(grid), dim3(NTHR), LDS_BYTES, stream, p);
    const hipError_t le = hipPeekAtLastError();
    if (le != hipSuccess) fprintf(stderr, "kernel_launch: launch failed: %s\n", hipGetErrorName(le));
}
```

```cpp
#include <hip/hip_runtime.h>
#include <cstdio>
#include <cstdint>

#define LAS __attribute__((address_space(3)))
typedef unsigned short bf16_t;
typedef short bf16x8 __attribute__((ext_vector_type(8)));
typedef float f32x4 __attribute__((ext_vector_type(4)));
typedef float f32x2 __attribute__((ext_vector_type(2)));
typedef unsigned u32x4 __attribute__((ext_vector_type(4)));
typedef unsigned u32x2 __attribute__((ext_vector_type(2)));
typedef unsigned short u16x4 __attribute__((ext_vector_type(4)));

constexpr int DM = 2048, SEQ = 2048, NBP = 4, NBS = 8, TSAMP = 4, PAST = 16384;
constexpr int MP = NBP * SEQ, MSAMP = NBS * TSAMP, MR = MP + MSAMP, MT = 8448;
constexpr int NQKV = 9216, NIN = 6144, NIN_SRC = 6160, DFF = 5632, NUP = 2 * DFF, DO = 1024;
constexpr int DEPTH = 4;
constexpr float EPS = 1e-6f;
constexpr int NWAVES = 8, NTHR = 512;

constexpr size_t O_YP = 0;
constexpr size_t O_YS = O_YP + (size_t)MP * DM;
constexpr size_t O_KV128P = O_YS + (size_t)MSAMP * DM;
constexpr size_t O_KV128S = O_KV128P + (size_t)2 * NBP * 128 * 2048;
constexpr size_t O_KV512P = O_KV128S + (size_t)2 * NBS * 128 * 2048;
constexpr size_t O_KV512S = O_KV512P + (size_t)2 * NBP * 512 * 2048;
constexpr size_t O_KV2048P = O_KV512S + (size_t)2 * NBS * 512 * 2048;
constexpr size_t O_KV2048S = O_KV2048P + (size_t)2 * NBP * 2048 * 2048;
constexpr size_t O_CP = O_KV2048S + (size_t)2 * NBS * 2048 * 2048;
constexpr size_t O_CS = O_CP + (size_t)2 * NBP * 8 * 256 * 128;
constexpr size_t O_NP = O_CS + (size_t)2 * NBS * 8 * 256 * 128;
constexpr size_t O_NS = O_NP + (size_t)2 * NBP * 8 * 128;
constexpr size_t O_MP = O_NS + (size_t)2 * NBS * 8 * 128;
constexpr size_t O_MS = O_MP + (size_t)2 * NBP * 8;
constexpr size_t O_CONVP = O_MS + (size_t)2 * NBS * 8;
constexpr size_t O_CONVS = O_CONVP + (size_t)DEPTH * NBP * 2 * NUP;
constexpr size_t O_END = O_CONVS + (size_t)DEPTH * NBS * 2 * NUP;

constexpr size_t al1m(size_t x) { return (x + 1048575) & ~(size_t)1048575; }
constexpr size_t WS_CTL = 0, CTL_ZERO_BYTES = 1048576;
constexpr size_t SZ_WQKV = (size_t)NQKV * DM * 2, SZ_WO = (size_t)DM * DO * 2, SZ_WIN = (size_t)NIN * DM * 2, SZ_WOUT = (size_t)DM * DM * 2, SZ_WUP = (size_t)NUP * DM * 2, SZ_WDOWN = (size_t)DM * DFF * 2;
constexpr size_t WS_WQKV = al1m(WS_CTL + CTL_ZERO_BYTES);
constexpr size_t WS_WO = al1m(WS_WQKV + 2 * SZ_WQKV);
constexpr size_t WS_WIN = al1m(WS_WO + 2 * SZ_WO);
constexpr size_t WS_WOUT = al1m(WS_WIN + 2 * SZ_WIN);
constexpr size_t WS_WUP = al1m(WS_WOUT + 2 * SZ_WOUT);
constexpr size_t WS_WDOWN = al1m(WS_WUP + 4 * SZ_WUP);
constexpr size_t WS_X = al1m(WS_WDOWN + 4 * SZ_WDOWN);
constexpr size_t WS_XB = al1m(WS_X + (size_t)MT * DM * 4);
constexpr size_t WS_SSQ = al1m(WS_XB + (size_t)MT * DM * 2);
constexpr size_t WS_SSQS = al1m(WS_SSQ + (size_t)MP * 32 * 4);
constexpr size_t WS_QKV = al1m(WS_SSQS + (size_t)MSAMP * 128 * 4);
constexpr size_t WS_OG = al1m(WS_QKV + (size_t)MT * NQKV * 2);
constexpr size_t WS_LSE = al1m(WS_OG + (size_t)MT * 3072 * 2);
constexpr size_t WS_OC = al1m(WS_LSE + (size_t)MT * 24 * 4);
constexpr size_t WS_GATES = al1m(WS_OC + (size_t)MT * DM * 2);
constexpr size_t WS_U = al1m(WS_GATES + (size_t)MT * 16 * 4);
constexpr size_t WS_Z = al1m(WS_U + (size_t)MT * NUP * 2);
constexpr size_t WS_SQ = al1m(WS_Z + (size_t)MT * DFF * 2);
constexpr size_t WS_ROPE = al1m(WS_SQ + (size_t)MP * 128 * 4);
constexpr size_t WS_WGP = al1m(WS_ROPE + (size_t)2052 * 128 * 4);
constexpr size_t WS_END = al1m(WS_WGP + (size_t)2 * 128 * 64 * 16);

constexpr int RING_BYTES = 131072;
constexpr int LDS_MISC_OFF = 150 * 1024;
constexpr int LDS_BYTES = 152 * 1024;

__device__ __forceinline__ unsigned pk2(float lo, float hi) { unsigned r; asm("v_cvt_pk_bf16_f32 %0, %1, %2" : "=v"(r) : "v"(lo), "v"(hi)); return r; }
__device__ __forceinline__ unsigned f2bf(float f) { return pk2(f, 0.f) & 0xffffu; }
__device__ __forceinline__ float bflo(unsigned w) { return __builtin_bit_cast(float, w << 16); }
__device__ __forceinline__ float bfhi(unsigned w) { return __builtin_bit_cast(float, w & 0xffff0000u); }
__device__ __forceinline__ float bf1(bf16_t b) { return __builtin_bit_cast(float, (unsigned)b << 16); }
__device__ __forceinline__ float fexp(float x) { return __builtin_amdgcn_exp2f(x * 1.4426950408889634f); }
#define LDS_BARRIER() do { asm volatile("s_waitcnt lgkmcnt(0)" ::: "memory"); __builtin_amdgcn_s_barrier(); asm volatile("" ::: "memory"); } while (0)
__device__ __forceinline__ float wave_sum(float v) {
#pragma unroll
    for (int o = 1; o < 64; o <<= 1) v += __shfl_xor(v, o);
    return v;
}
__device__ __forceinline__ float wave_max(float v) {
#pragma unroll
    for (int o = 1; o < 64; o <<= 1) v = fmaxf(v, __shfl_xor(v, o));
    return v;
}
__device__ __forceinline__ f32x4 mma16(bf16x8 a, bf16x8 b, f32x4 c) { return __builtin_amdgcn_mfma_f32_16x16x32_bf16(a, b, c, 0, 0, 0); }
__device__ __forceinline__ bf16x8 tr_read2(unsigned base, int off0, int off1) {
    u16x4 r0, r1;
    asm volatile("ds_read_b64_tr_b16 %0, %2 offset:%c3\n\tds_read_b64_tr_b16 %1, %2 offset:%c4\n\ts_waitcnt lgkmcnt(0)" : "=&v"(r0), "=&v"(r1) : "v"(base), "i"(off0), "i"(off1) : "memory");
    bf16x8 o; o[0] = (short)r0[0]; o[1] = (short)r0[1]; o[2] = (short)r0[2]; o[3] = (short)r0[3]; o[4] = (short)r1[0]; o[5] = (short)r1[1]; o[6] = (short)r1[2]; o[7] = (short)r1[3];
    return o;
}

__device__ __forceinline__ bf16x8 tr_join(u16x4 r0, u16x4 r1) { bf16x8 o; o[0] = (short)r0[0]; o[1] = (short)r0[1]; o[2] = (short)r0[2]; o[3] = (short)r0[3]; o[4] = (short)r1[0]; o[5] = (short)r1[1]; o[6] = (short)r1[2]; o[7] = (short)r1[3]; return o; }
#define TR_RD "ds_read_b64_tr_b16 "
#define TR_READ4(F0, F1, F2, F3, base, a0, a1, b0, b1, c0, c1, d0, d1) do { u16x4 t0_, t1_, t2_, t3_, t4_, t5_, t6_, t7_; \
    asm volatile(TR_RD "%0, %8 offset:%c9\n\t" TR_RD "%1, %8 offset:%c10\n\t" TR_RD "%2, %8 offset:%c11\n\t" TR_RD "%3, %8 offset:%c12\n\t" TR_RD "%4, %8 offset:%c13\n\t" TR_RD "%5, %8 offset:%c14\n\t" TR_RD "%6, %8 offset:%c15\n\t" TR_RD "%7, %8 offset:%c16\n\ts_waitcnt lgkmcnt(0)" \
        : "=&v"(t0_), "=&v"(t1_), "=&v"(t2_), "=&v"(t3_), "=&v"(t4_), "=&v"(t5_), "=&v"(t6_), "=&v"(t7_) : "v"(base), "i"(a0), "i"(a1), "i"(b0), "i"(b1), "i"(c0), "i"(c1), "i"(d0), "i"(d1) : "memory"); \
    F0 = tr_join(t0_, t1_); F1 = tr_join(t2_, t3_); F2 = tr_join(t4_, t5_); F3 = tr_join(t6_, t7_); } while (0)
#define TR_READ5(F0, F1, F2, F3, F4, base, a0, a1, b0, b1, c0, c1, d0, d1, e0, e1) do { u16x4 t0_, t1_, t2_, t3_, t4_, t5_, t6_, t7_, t8_, t9_; \
    asm volatile(TR_RD "%0, %10 offset:%c11\n\t" TR_RD "%1, %10 offset:%c12\n\t" TR_RD "%2, %10 offset:%c13\n\t" TR_RD "%3, %10 offset:%c14\n\t" TR_RD "%4, %10 offset:%c15\n\t" TR_RD "%5, %10 offset:%c16\n\t" TR_RD "%6, %10 offset:%c17\n\t" TR_RD "%7, %10 offset:%c18\n\t" TR_RD "%8, %10 offset:%c19\n\t" TR_RD "%9, %10 offset:%c20\n\ts_waitcnt lgkmcnt(0)" \
        : "=&v"(t0_), "=&v"(t1_), "=&v"(t2_), "=&v"(t3_), "=&v"(t4_), "=&v"(t5_), "=&v"(t6_), "=&v"(t7_), "=&v"(t8_), "=&v"(t9_) : "v"(base), "i"(a0), "i"(a1), "i"(b0), "i"(b1), "i"(c0), "i"(c1), "i"(d0), "i"(d1), "i"(e0), "i"(e1) : "memory"); \
    F0 = tr_join(t0_, t1_); F1 = tr_join(t2_, t3_); F2 = tr_join(t4_, t5_); F3 = tr_join(t6_, t7_); F4 = tr_join(t8_, t9_); } while (0)
__device__ __forceinline__ bf16x8 pack8(f32x4 a, f32x4 b) {
    u32x4 w; w.x = pk2(a[0], a[1]); w.y = pk2(a[2], a[3]); w.z = pk2(b[0], b[1]); w.w = pk2(b[2], b[3]);
    return __builtin_bit_cast(bf16x8, w);
}

namespace pg8 {
#define PG8_LAS __attribute__((address_space(3)))
typedef unsigned short bf16_t;
typedef short bf16x8 __attribute__((ext_vector_type(8)));
typedef float f32x4 __attribute__((ext_vector_type(4)));
typedef unsigned u32x4 __attribute__((ext_vector_type(4)));
constexpr int BM = 256, BK = 64, HALF = 128, HTB = HALF * BK * 2  , STAGE_BYTES = 8 * HTB, NXCD = 8, WGM = 8;

__host__ __device__ __forceinline__ int lds_byte(int r, int c) { const int st = (r >> 4) * 2 + (c >> 5), rr = r & 15, cc = c & 31, ob = rr * 64 + cc * 2; return st * 1024 + (ob ^ (((ob >> 9) & 1) << 5)); }
__host__ __device__ __forceinline__ void stage_rc(int b, int& R, int& C) { const int st = b / 1024, sb = b % 1024, swz = sb ^ (((sb >> 9) & 1) << 5); R = (st >> 1) * 16 + swz / 64; C = (st & 1) * 32 + (swz % 64) / 2; }
__host__ __device__ __forceinline__ int perm32(int rho) { const int n = rho >> 4, i = rho & 15; return 8 * (i >> 2) + 4 * n + (i & 3); }

struct Unit { int pm, pn; };
struct Gemm { const bf16_t* A; const bf16_t* Bt; int M, N, K; };

struct StaticOrder {
    int nM, nN, nwg, G, c;
    __host__ __device__ void init(int M, int N, int G_, int c_) { nM = M / BM; nN = N / BM; nwg = nM * nN; G = G_; c = c_; }
    __host__ __device__ bool next(int i, Unit& u) const {
        const long L = (long)i * G + c; if (L >= nwg) return false;
        int wgid = (int)L; { const int q = nwg / NXCD, r = nwg % NXCD, xcd = wgid % NXCD, off = wgid / NXCD; wgid = (xcd < r ? xcd * (q + 1) : r * (q + 1) + (xcd - r) * q) + off; }
        const int nig = WGM * nN, gid = wgid / nig, fm = gid * WGM, gsz = (nM - fm) < WGM ? (nM - fm) : WGM;
        u.pm = fm + ((wgid % nig) % gsz); u.pn = (wgid % nig) / gsz; return true;
    }
    __device__ __forceinline__ void a_ready(const Unit&) const {}
    __device__ __forceinline__ void done(const Unit&) const {}
};
__device__ __forceinline__ unsigned cvt_pk_bf16(float lo, float hi) { unsigned r; asm volatile("v_cvt_pk_bf16_f32 %0, %1, %2" : "=v"(r) : "v"(lo), "v"(hi)); return r; }

struct EpiStore {
    static constexpr bool PERM = true, AFTER_DRAIN = false;
    bf16_t* O; int ldc;
    __device__ __forceinline__ void operator()(const f32x4 (&acc)[2][2][4][2], const Unit& u, int wr, int wc, int fr, int fq) const {
        const int row0 = u.pm * BM + wr * 64 + fr, col0 = u.pn * BM + wc * 32 + 8 * fq;
#pragma unroll
        for (int ai = 0; ai < 2; ++ai)
#pragma unroll
            for (int m = 0; m < 4; ++m) { bf16_t* rowp = O + (size_t)(row0 + ai * HALF + m * 16) * ldc + col0;
#pragma unroll
                for (int bj = 0; bj < 2; ++bj) { const f32x4 v0 = acc[ai][bj][m][0], v1 = acc[ai][bj][m][1];
                    u32x4 w; w.x = cvt_pk_bf16(v0[0], v0[1]); w.y = cvt_pk_bf16(v0[2], v0[3]); w.z = cvt_pk_bf16(v1[0], v1[1]); w.w = cvt_pk_bf16(v1[2], v1[3]);
                    *(u32x4*)(rowp + bj * HALF) = w; } }
    }
};
struct EpiResid {
    static constexpr bool PERM = false, AFTER_DRAIN = false;
    const float* xin; float* out; int ldc; int mrows;
    __device__ __forceinline__ void operator()(const f32x4 (&acc)[2][2][4][2], const Unit& u, int wr, int wc, int fr, int fq) const {
        const int row0 = u.pm * BM + wr * 64 + fr, col0 = u.pn * BM + wc * 32 + 4 * fq;
#pragma unroll
        for (int ai = 0; ai < 2; ++ai)
#pragma unroll
            for (int m = 0; m < 4; ++m) { const int r = row0 + ai * HALF + m * 16;
                if (r < mrows) { const size_t off = (size_t)r * ldc + col0;
#pragma unroll
                    for (int bj = 0; bj < 2; ++bj)
#pragma unroll
                        for (int n = 0; n < 2; ++n) { const f32x4 bs = *(const f32x4*)(xin + off + bj * HALF + n * 16); *(f32x4*)(out + off + bj * HALF + n * 16) = bs + acc[ai][bj][m][n]; } }
                asm volatile("" ::: "memory"); }
    }
};


struct EpiStoreN {
    static constexpr bool PERM = true, AFTER_DRAIN = false;
    bf16_t* O; int ldc; const float* ssq; float eps;
    __device__ __forceinline__ void operator()(const f32x4 (&acc)[2][2][4][2], const Unit& u, int wr, int wc, int fr, int fq) const {
        const int row0 = u.pm * BM + wr * 64 + fr, col0 = u.pn * BM + wc * 32 + 8 * fq;
#pragma unroll
        for (int ai = 0; ai < 2; ++ai)
#pragma unroll
            for (int m = 0; m < 4; ++m) { const int r = row0 + ai * HALF + m * 16;
                const f32x4 p0 = *(const f32x4*)(ssq + (size_t)r * 32 + 8 * fq), p1 = *(const f32x4*)(ssq + (size_t)r * 32 + 8 * fq + 4);
                float s = ((p0[0] + p0[1]) + (p0[2] + p0[3])) + ((p1[0] + p1[1]) + (p1[2] + p1[3]));
                s += __shfl_xor(s, 16); s += __shfl_xor(s, 32);
                const float rs = rsqrtf(s * (1.f / 2048.f) + eps);
                bf16_t* rowp = O + (size_t)r * ldc + col0;
#pragma unroll
                for (int bj = 0; bj < 2; ++bj) { const f32x4 v0 = acc[ai][bj][m][0] * rs, v1 = acc[ai][bj][m][1] * rs;
                    u32x4 w; w.x = cvt_pk_bf16(v0[0], v0[1]); w.y = cvt_pk_bf16(v0[2], v0[3]); w.z = cvt_pk_bf16(v1[0], v1[1]); w.w = cvt_pk_bf16(v1[2], v1[3]);
                    *(u32x4*)(rowp + bj * HALF) = w; } }
    }
};
struct EpiResidN {
    static constexpr bool PERM = false, AFTER_DRAIN = false;
    bf16_t* xb; float* fin; float* ssq; int ldc;
    __device__ __forceinline__ void operator()(const f32x4 (&acc)[2][2][4][2], const Unit& u, int wr, int wc, int fr, int fq) const {
        const int row0 = u.pm * BM + wr * 64 + fr, col0 = u.pn * BM + wc * 32 + 4 * fq;
#pragma unroll
        for (int ai = 0; ai < 2; ++ai)
#pragma unroll
            for (int m = 0; m < 4; ++m) { const int r = row0 + ai * HALF + m * 16; const size_t off = (size_t)r * ldc + col0; float sq = 0.f;
#pragma unroll
                for (int bj = 0; bj < 2; ++bj)
#pragma unroll
                    for (int n = 0; n < 2; ++n) { const u32x2 xw = *(const u32x2*)(xb + off + bj * HALF + n * 16);
                        f32x4 v = acc[ai][bj][m][n];
                        v[0] += __builtin_bit_cast(float, xw.x << 16); v[1] += __builtin_bit_cast(float, xw.x & 0xffff0000u); v[2] += __builtin_bit_cast(float, xw.y << 16); v[3] += __builtin_bit_cast(float, xw.y & 0xffff0000u);
                        if (fin) *(f32x4*)(fin + off + bj * HALF + n * 16) = v;
                        else { u32x2 w; w.x = cvt_pk_bf16(v[0], v[1]); w.y = cvt_pk_bf16(v[2], v[3]); *(u32x2*)(xb + off + bj * HALF + n * 16) = w; }
                        sq += (v[0] * v[0] + v[1] * v[1]) + (v[2] * v[2] + v[3] * v[3]); }
                if (ssq) { sq += __shfl_xor(sq, 16); sq += __shfl_xor(sq, 32); if (fq == 0) ssq[(size_t)r * 32 + u.pn * 4 + wc] = sq; }
                if (m == 3) asm volatile("" ::: "memory"); }
    }
};
template <class Epi, class Sched, bool ALIGN_EPI = false, bool SP2 = false>
__device__ __forceinline__ void gemm_phase(PG8_LAS unsigned char* lds, const Gemm g, const Sched& S, const Epi& E) {
    int tid = threadIdx.x; asm volatile("" : "+v"(tid));
    const int wid = __builtin_amdgcn_readfirstlane(tid >> 6), lane = tid & 63, wr = wid >> 2, wc = wid & 3, fr = lane & 15, fq = lane >> 4;
    const int K = g.K, nt = K / BK;
    unsigned voffA[2], voffB[2];
#pragma unroll
    for (int i = 0; i < 2; ++i) { int R, C; stage_rc(tid * 16 + i * 8192, R, C); const int Rb = Epi::PERM ? ((R & ~31) + perm32(R & 31)) : R;
        voffA[i] = (unsigned)(R * K + C) * 2u; voffB[i] = (unsigned)(Rb * K + C) * 2u; }
    const size_t kstep = (size_t)(BK * 2);
    const size_t hstep = (size_t)HALF * K * 2;
    const size_t tstep = 2 * hstep;
    const unsigned ldsw = (unsigned)wid * 1024u;
    const int aoff = lds_byte(wr * 64 + fr, fq * 8), boff = lds_byte(wc * 32 + fr, fq * 8);
#define PG8_SA(b, h) (((b) * 2 + (h)) * HTB)
#define PG8_SB(b, h) ((4 + (b) * 2 + (h)) * HTB)
#define PG8_STAGE(bufoff, gbase, voff) do { _Pragma("unroll") for (int _i = 0; _i < 2; ++_i) \
        __builtin_amdgcn_global_load_lds((const unsigned*)((const char*)(gbase) + (voff)[_i]), (PG8_LAS unsigned*)(lds + (bufoff) + ldsw + _i * 8192), 16, 0, 0); } while (0)
#define PG8_LDA(dst, b, h) do { _Pragma("unroll") for (int m = 0; m < 4; ++m) _Pragma("unroll") for (int k = 0; k < 2; ++k) dst[m][k] = *(const PG8_LAS bf16x8*)(lds + PG8_SA(b, h) + aoff + m * 2048 + k * 1024); } while (0)
#define PG8_LDB(dst, b, h) do { _Pragma("unroll") for (int n = 0; n < 2; ++n) _Pragma("unroll") for (int k = 0; k < 2; ++k) dst[n][k] = *(const PG8_LAS bf16x8*)(lds + PG8_SB(b, h) + boff + n * 2048 + k * 1024); } while (0)
#define PG8_MMA(ai, bj, At, Bt) do { __builtin_amdgcn_s_setprio(1); _Pragma("unroll") for (int m = 0; m < 4; ++m) _Pragma("unroll") for (int n = 0; n < 2; ++n) _Pragma("unroll") for (int k = 0; k < 2; ++k) \
        acc[ai][bj][m][n] = __builtin_amdgcn_mfma_f32_16x16x32_bf16(Bt[n][k], At[m][k], acc[ai][bj][m][n], 0, 0, 0); __builtin_amdgcn_s_setprio(0); } while (0)
#define PG8_WAIT_V(n) asm volatile("s_waitcnt vmcnt(" #n ")" ::: "memory")
#define PG8_WAIT_L(n) asm volatile("s_waitcnt lgkmcnt(" #n ")" ::: "memory")
#define PG8_BAR __builtin_amdgcn_s_barrier()
#define PG8_SCHED __builtin_amdgcn_sched_barrier(0)
    Unit cur, nxt; int ui = 0;
    if (!S.next(0, cur)) return;
    f32x4 acc[2][2][4][2];
#pragma unroll
    for (int a = 0; a < 2; ++a)
#pragma unroll
        for (int b = 0; b < 2; ++b)
#pragma unroll
            for (int m = 0; m < 4; ++m)
#pragma unroll
                for (int n = 0; n < 2; ++n) acc[a][b][m][n] = (f32x4){0.f, 0.f, 0.f, 0.f};
    bf16x8 At[4][2], B0[2][2], B1[2][2];
    const char* cA = (const char*)g.A + (size_t)cur.pm * tstep; const char* cB = (const char*)g.Bt + (size_t)cur.pn * tstep;
    S.a_ready(cur);
    if constexpr (SP2) {
        PG8_STAGE(PG8_SB(0, 0), cB, voffB); PG8_STAGE(PG8_SB(0, 1), cB + hstep, voffB); PG8_STAGE(PG8_SA(0, 0), cA, voffA); PG8_STAGE(PG8_SA(0, 1), cA + hstep, voffA);
        if (wr == 1) PG8_BAR;
        PG8_WAIT_V(2); PG8_BAR;
        PG8_STAGE(PG8_SB(1, 0), cB + kstep, voffB); PG8_STAGE(PG8_SA(1, 0), cA + kstep, voffA); PG8_STAGE(PG8_SB(1, 1), cB + hstep + kstep, voffB);
        PG8_WAIT_V(6); PG8_BAR;
    } else {
        PG8_STAGE(PG8_SB(0, 0), cB, voffB); PG8_STAGE(PG8_SA(0, 0), cA, voffA); PG8_STAGE(PG8_SB(0, 1), cB + hstep, voffB); PG8_STAGE(PG8_SA(0, 1), cA + hstep, voffA);
        if (wr == 1) PG8_BAR;
        PG8_WAIT_V(4); PG8_BAR;
        PG8_STAGE(PG8_SB(1, 0), cB + kstep, voffB); PG8_STAGE(PG8_SA(1, 0), cA + kstep, voffA); PG8_STAGE(PG8_SB(1, 1), cB + hstep + kstep, voffB);
        PG8_WAIT_V(6); PG8_BAR;
    }
    for (;;) {
        const bool has_next = S.next(ui + 1, nxt);
        const char* nA = has_next ? (const char*)g.A + (size_t)nxt.pm * tstep : cA; const char* nB = has_next ? (const char*)g.Bt + (size_t)nxt.pn * tstep : cB;
        for (int t = 0; t < nt; t += 2) {
            const bool last = (t == nt - 2);
            const char* a1 = cA + (size_t)(t + 1) * kstep;
            const char* a2 = last ? nA : cA + (size_t)(t + 2) * kstep; const char* b2 = last ? nB : cB + (size_t)(t + 2) * kstep;
            const char* a3 = a2 + kstep; const char* b3 = b2 + kstep;
            if (last && has_next) S.a_ready(nxt);
            if constexpr (SP2) {
            PG8_LDB(B0, 0, 0); PG8_LDB(B1, 0, 1); PG8_SCHED; PG8_LDA(At, 0, 0); PG8_STAGE(PG8_SA(1, 1), a1 + hstep, voffA);
            PG8_WAIT_V(8); PG8_WAIT_L(0); PG8_BAR; PG8_MMA(0, 0, At, B0); PG8_MMA(0, 1, At, B1); PG8_BAR; PG8_SCHED;
            PG8_LDA(At, 0, 1); PG8_STAGE(PG8_SB(0, 0), b2, voffB); PG8_STAGE(PG8_SB(0, 1), b2 + hstep, voffB); PG8_STAGE(PG8_SA(0, 0), a2, voffA);
            PG8_WAIT_V(8); PG8_WAIT_L(0); PG8_BAR; PG8_MMA(1, 0, At, B0); PG8_MMA(1, 1, At, B1); PG8_BAR; PG8_SCHED;
            PG8_LDB(B0, 1, 0); PG8_LDB(B1, 1, 1); PG8_SCHED; PG8_LDA(At, 1, 0); PG8_STAGE(PG8_SA(0, 1), a2 + hstep, voffA);
            PG8_WAIT_V(8); PG8_WAIT_L(0); PG8_BAR; PG8_MMA(0, 0, At, B0); PG8_MMA(0, 1, At, B1); PG8_BAR; PG8_SCHED;
            PG8_LDA(At, 1, 1); PG8_STAGE(PG8_SB(1, 0), b3, voffB); PG8_STAGE(PG8_SB(1, 1), b3 + hstep, voffB); PG8_STAGE(PG8_SA(1, 0), a3, voffA);
            PG8_WAIT_V(8); PG8_WAIT_L(0); PG8_BAR; PG8_MMA(1, 0, At, B0); PG8_MMA(1, 1, At, B1); PG8_BAR; PG8_SCHED;
            } else {
            PG8_LDB(B0, 0, 0); PG8_SCHED; PG8_LDA(At, 0, 0); PG8_STAGE(PG8_SA(1, 1), a1 + hstep, voffA);
            PG8_WAIT_L(8); PG8_BAR; PG8_WAIT_L(0); PG8_MMA(0, 0, At, B0); PG8_BAR; PG8_SCHED;
            PG8_LDB(B1, 0, 1); PG8_STAGE(PG8_SB(0, 0), b2, voffB);
            PG8_BAR; PG8_WAIT_L(0); PG8_MMA(0, 1, At, B1); PG8_BAR;
            PG8_LDA(At, 0, 1); PG8_STAGE(PG8_SA(0, 0), a2, voffA);
            PG8_BAR; PG8_WAIT_L(0); PG8_MMA(1, 0, At, B0); PG8_BAR; PG8_SCHED;
            PG8_STAGE(PG8_SB(0, 1), b2 + hstep, voffB);
            PG8_WAIT_V(6); PG8_BAR; PG8_MMA(1, 1, At, B1); PG8_BAR;
            PG8_LDB(B0, 1, 0); PG8_SCHED; PG8_LDA(At, 1, 0); PG8_STAGE(PG8_SA(0, 1), a2 + hstep, voffA);
            PG8_WAIT_L(8); PG8_BAR; PG8_WAIT_L(0); PG8_MMA(0, 0, At, B0); PG8_BAR; PG8_SCHED;
            PG8_LDB(B1, 1, 1); PG8_STAGE(PG8_SB(1, 0), b3, voffB);
            PG8_BAR; PG8_WAIT_L(0); PG8_MMA(0, 1, At, B1); PG8_BAR;
            PG8_LDA(At, 1, 1); PG8_STAGE(PG8_SA(1, 0), a3, voffA);
            PG8_BAR; PG8_WAIT_L(0); PG8_MMA(1, 0, At, B0); PG8_BAR; PG8_SCHED;
            PG8_STAGE(PG8_SB(1, 1), b3 + hstep, voffB);
            PG8_WAIT_V(6); PG8_BAR; PG8_MMA(1, 1, At, B1); PG8_BAR;
            }
        }
        if constexpr (ALIGN_EPI) { if (wr == 0) PG8_BAR; }
        if constexpr (!Epi::AFTER_DRAIN) { E(acc, cur, wr, wc, fr, fq); S.done(cur); }
        if (!has_next) break;
#pragma unroll
        for (int a = 0; a < 2; ++a)
#pragma unroll
            for (int b = 0; b < 2; ++b)
#pragma unroll
                for (int m = 0; m < 4; ++m)
#pragma unroll
                    for (int n = 0; n < 2; ++n) acc[a][b][m][n] = (f32x4){0.f, 0.f, 0.f, 0.f};
        cur = nxt; cA = nA; cB = nB; ++ui;
        if constexpr (ALIGN_EPI) { if (wr == 1) PG8_BAR; }
    }
    PG8_WAIT_V(0);
    if constexpr (!ALIGN_EPI) { if (wr == 0) PG8_BAR; }
    PG8_BAR;
    if constexpr (Epi::AFTER_DRAIN) { E.fused(acc, cur, wr, wc, fr, fq, lds, wid, lane); S.done(cur); }
#undef PG8_SA
#undef PG8_SB
#undef PG8_STAGE
#undef PG8_LDA
#undef PG8_LDB
#undef PG8_MMA
#undef PG8_WAIT_V
#undef PG8_WAIT_L
#undef PG8_BAR
#undef PG8_SCHED
}
}
#define XB_TMO      128
#define XB_XCNT(j)  (256  + 64 * (j))
#define XB_XSUB(j)  (1280 + 64 * (j))
#define XB_XGEN(j)  (2304 + 64 * (j))
#define XB_TOP      3328
#define XB_TOPGEN   3392
#define XCD_BAR_WORDS 3456
#define XB_SPIN_CAP (1u << 18)

__device__ __forceinline__ unsigned xb_ld(unsigned* p)              { return __hip_atomic_load(p, __ATOMIC_RELAXED, __HIP_MEMORY_SCOPE_AGENT); }
__device__ __forceinline__ unsigned xb_add(unsigned* p, unsigned v) { return __hip_atomic_fetch_add(p, v, __ATOMIC_RELAXED, __HIP_MEMORY_SCOPE_AGENT); }
__device__ __forceinline__ unsigned xb_xcc_id() { return (unsigned)__builtin_amdgcn_s_getreg((3 << 11) | 20) & 0xFu; }
#define XB_SPIN(cond, bar) do { unsigned _sp = 0; while (cond) { __builtin_amdgcn_s_sleep(1); \
    if ((++_sp & 255u) == 0u) { if (xb_ld(&(bar)[XB_TMO])) break; if (_sp > XB_SPIN_CAP) { atomicAdd(&(bar)[XB_TMO], 1u); break; } } } } while (0)

struct XcdBarrier {
    unsigned* bar; unsigned x;
    volatile LAS unsigned* st;
};

__device__ __forceinline__ XcdBarrier xcd_barrier_post(unsigned* bar, volatile LAS unsigned* st) {
    XcdBarrier b; b.bar = bar; b.x = xb_xcc_id(); b.st = st;
    if (threadIdx.x == 0) (void)xb_add(&bar[XB_XCNT(b.x)], 1u);
    return b;
}
__device__ __forceinline__ void xcd_barrier_complete(unsigned* bar, unsigned x, unsigned& nloc, unsigned& nx) {
    const unsigned G = gridDim.x * gridDim.y * gridDim.z;
    unsigned sum, cnt, mine, sp = 0u;
    for (;;) {
        sum = 0u; cnt = 0u; mine = 0u;
#pragma unroll
        for (unsigned j = 0; j < 16; ++j) { const unsigned c = xb_ld(&bar[XB_XCNT(j)]); sum += c; cnt += (c > 0u) ? 1u : 0u; mine = (j == x) ? c : mine; }
        if (sum == G) break;
        __builtin_amdgcn_s_sleep(1);
        if ((++sp & 255u) == 0u) { if (xb_ld(&bar[XB_TMO])) break; if (sp > XB_SPIN_CAP) { atomicAdd(&bar[XB_TMO], 1u); break; } }
    }
    nloc = mine > 0u ? mine : 1u; nx = cnt > 0u ? cnt : 1u;
}

__device__ __forceinline__ void xcd_barrier(const XcdBarrier& b) {
    asm volatile("s_waitcnt vmcnt(0)" ::: "memory");
    __syncthreads();
    if (threadIdx.x == 0) {
        unsigned* bar = b.bar;
        __builtin_amdgcn_s_waitcnt(0);
        unsigned nloc = b.st[0], nx = b.st[1];
        if (nloc == 0u) { xcd_barrier_complete(bar, b.x, nloc, nx); b.st[0] = nloc; b.st[1] = nx; }
        const unsigned old = xb_add(&bar[XB_XSUB(b.x)], 1u);
        const unsigned gen = old / nloc;
        if (old + 1u == (gen + 1u) * nloc) {
            __builtin_amdgcn_fence(__ATOMIC_RELEASE, "agent");
            asm volatile("s_waitcnt vmcnt(0)" ::: "memory");
            const unsigned og = xb_add(&bar[XB_TOP], 1u);
            const unsigned tg = og / nx;
            if (og + 1u == (tg + 1u) * nx) xb_add(&bar[XB_TOPGEN], 1u);
            else XB_SPIN(xb_ld(&bar[XB_TOPGEN]) == tg, bar);
            __builtin_amdgcn_fence(__ATOMIC_ACQUIRE, "agent");
            xb_add(&bar[XB_XGEN(b.x)], 1u);
            asm volatile("s_waitcnt vmcnt(0)" ::: "memory");
        } else {
            XB_SPIN(xb_ld(&bar[XB_XGEN(b.x)]) == gen, bar);
            __builtin_amdgcn_fence(__ATOMIC_ACQUIRE, "agent");
            asm volatile("s_waitcnt vmcnt(0)" ::: "memory");
        }
    }
    __syncthreads();
}

struct Params { const float* in[23]; float* out; unsigned char* ws; };

__device__ __forceinline__ void p0_transpose_item(const float* W, int ldw, int K, int N, bf16_t* WT, int item, int lane, float scale, const float* gk) {
    const int nblk = N / 64, kb = item / nblk, nb = item % nblk, i16 = lane & 15, q4 = lane >> 4;
    const int n0 = 64 * nb + 4 * i16;
#pragma unroll
    for (int pass = 0; pass < 2; ++pass) {
        const int kk0 = 64 * kb + 32 * pass + 8 * q4;
        const float* src = W + (size_t)kk0 * ldw + n0;
        f32x4 v[8];
#pragma unroll
        for (int i = 0; i < 8; ++i) v[i] = *(const f32x4*)(src + (size_t)i * ldw);
        f32x4 g0 = {scale, scale, scale, scale}, g1 = g0;
        if (gk) { g0 = *(const f32x4*)(gk + kk0) * scale; g1 = *(const f32x4*)(gk + kk0 + 4) * scale; }
#pragma unroll
        for (int j = 0; j < 4; ++j) { u32x4 o;
            o.x = pk2(v[0][j] * g0[0], v[1][j] * g0[1]); o.y = pk2(v[2][j] * g0[2], v[3][j] * g0[3]); o.z = pk2(v[4][j] * g1[0], v[5][j] * g1[1]); o.w = pk2(v[6][j] * g1[2], v[7][j] * g1[3]);
            *(u32x4*)(WT + (size_t)(n0 + j) * K + kk0) = o; }
    }
}

__device__ __forceinline__ void phase_prologue(const Params& P, LAS unsigned char* lds, int gw, int NGW, int wave, int lane) {
    constexpr int I_QKV = (DM / 64) * (NQKV / 64), I_WO = (DO / 64) * (DM / 64), I_WIN = (DM / 64) * (NIN / 64), I_WOUT = (DM / 64) * (DM / 64), I_WUP = (DM / 64) * (NUP / 64), I_WDN = (DFF / 64) * (DM / 64);
    constexpr int T0 = 2 * I_QKV, T1 = T0 + 2 * I_WO, T2 = T1 + 2 * I_WIN, T3 = T2 + 2 * I_WOUT, T4 = T3 + 4 * I_WUP, T5 = T4 + 4 * I_WDN;
    unsigned char* ws = P.ws;
    for (int it = gw; it < T5; it += NGW) {
        if (it < T0) { const int l = it / I_QKV, r = it % I_QKV; p0_transpose_item(P.in[11] + (size_t)l * DM * NQKV, NQKV, DM, NQKV, (bf16_t*)(ws + WS_WQKV + l * SZ_WQKV), r, lane, 1.f, P.in[9] + (size_t)(2 * l) * DM); }
        else if (it < T1) { const int q = it - T0, l = q / I_WO, r = q % I_WO; p0_transpose_item(P.in[14] + (size_t)l * DO * DM, DM, DO, DM, (bf16_t*)(ws + WS_WO + l * SZ_WO), r, lane, 1.f, nullptr); }
        else if (it < T2) { const int q = it - T1, l = q / I_WIN, r = q % I_WIN; const int nb = r % (NIN / 64);
            const float sc = (nb >= 16 && nb < 32) ? 0.08838834764831845f : 1.f;
            p0_transpose_item(P.in[15] + (size_t)l * DM * NIN_SRC, NIN_SRC, DM, NIN, (bf16_t*)(ws + WS_WIN + l * SZ_WIN), r, lane, sc, P.in[9] + (size_t)(2 * l + 1) * DM); }
        else if (it < T3) { const int q = it - T2, l = q / I_WOUT, r = q % I_WOUT; p0_transpose_item(P.in[18] + (size_t)l * DM * DM, DM, DM, DM, (bf16_t*)(ws + WS_WOUT + l * SZ_WOUT), r, lane, 1.f, nullptr); }
        else if (it < T4) { const int q = it - T3, l = q / I_WUP, r = q % I_WUP; p0_transpose_item(P.in[19] + (size_t)l * DM * NUP, NUP, DM, NUP, (bf16_t*)(ws + WS_WUP + l * SZ_WUP), r, lane, 1.f, P.in[10] + (size_t)l * DM); }
        else { const int q = it - T4, l = q / I_WDN, r = q % I_WDN; p0_transpose_item(P.in[22] + (size_t)l * DFF * DM, DM, DFF, DM, (bf16_t*)(ws + WS_WDOWN + l * SZ_WDOWN), r, lane, 1.f, nullptr); }
    }
    { const int gt = gw * 64 + lane, NT = NGW * 64;
      float* rope = (float*)(ws + WS_ROPE);
      for (int i = gt; i < 2052 * 64; i += NT) { const int pi = i >> 6, f = i & 63; const int pos = (pi < SEQ) ? pi : PAST + (pi - SEQ);
          const float invf = powf(10000.f, -(float)f * (1.f / 64.f)); const float ang = (float)pos * invf; float sn, cs; sincosf(ang, &sn, &cs); rope[2 * i] = cs; rope[2 * i + 1] = sn; }
      f32x4* wgp = (f32x4*)(ws + WS_WGP);
      for (int i = gt; i < 2 * 128 * 64; i += NT) { const int l = i >> 13, kb = (i >> 6) & 127, ln = i & 63, col = ln & 15, kq = ln >> 4, k = 16 * kb + 4 * kq;
          const float* w = P.in[15] + (size_t)l * DM * NIN_SRC + (size_t)k * NIN_SRC + NIN + col; const float* g = P.in[9] + (size_t)(2 * l + 1) * DM + k;
          wgp[i] = (f32x4){g[0] * w[0], g[1] * w[NIN_SRC], g[2] * w[2 * NIN_SRC], g[3] * w[3 * NIN_SRC]}; } }
    for (int r = gw; r < MR; r += NGW) {
        const f32x4* xr = (const f32x4*)((r < MP) ? P.in[0] + (size_t)r * DM : P.in[1] + (size_t)(r - MP) * DM) + lane;
        u32x2* xb = (u32x2*)(ws + WS_XB) + (size_t)r * (DM / 4) + lane;
        float s = 0.f;
#pragma unroll
        for (int j = 0; j < 8; ++j) { const f32x4 v = xr[64 * j]; u32x2 w; w.x = pk2(v.x, v.y); w.y = pk2(v.z, v.w); xb[64 * j] = w; s += (v.x * v.x + v.y * v.y) + (v.z * v.z + v.w * v.w); }
        s = wave_sum(s);
        if (r < MP) { if (lane < 32) ((float*)(ws + WS_SSQ))[(size_t)r * 32 + lane] = (lane == 0) ? s : 0.f; }
        else { float* q = (float*)(ws + WS_SSQS) + (size_t)(r - MP) * 128; q[lane] = (lane == 0) ? s : 0.f; q[64 + lane] = 0.f; }
    }
}

__device__ __forceinline__ void gate_block(LAS unsigned char* lds, const bf16_t* X, const f32x4* WGP, const float* bg, float* GATES, int task, int wave, int lane) {
    const int r0 = task * 16, i16 = lane & 15, kq = lane >> 4;
    const bf16_t* xr = X + (size_t)(r0 + i16) * DM + 256 * wave + 4 * kq;
    const f32x4* wp = WGP + (size_t)(16 * wave) * 64 + lane;
    f32x4 acc = {0.f, 0.f, 0.f, 0.f}; float ss = 0.f;
#pragma unroll
    for (int j = 0; j < 16; ++j) {
        const u32x2 xw = *(const u32x2*)(xr + 16 * j); const f32x4 xv = {bflo(xw.x), bfhi(xw.x), bflo(xw.y), bfhi(xw.y)}, wv = wp[64 * j];
        ss += (xv.x * xv.x + xv.y * xv.y) + (xv.z * xv.z + xv.w * xv.w);
        acc = __builtin_amdgcn_mfma_f32_16x16x4f32(xv.x, wv.x, acc, 0, 0, 0);
        acc = __builtin_amdgcn_mfma_f32_16x16x4f32(xv.y, wv.y, acc, 0, 0, 0);
        acc = __builtin_amdgcn_mfma_f32_16x16x4f32(xv.z, wv.z, acc, 0, 0, 0);
        acc = __builtin_amdgcn_mfma_f32_16x16x4f32(xv.w, wv.w, acc, 0, 0, 0);
    }
    LAS f32x4* gp = (LAS f32x4*)lds; LAS float* sp = (LAS float*)(lds + 8192);
    __syncthreads();
    gp[wave * 64 + lane] = acc; sp[wave * 64 + lane] = ss;
    __syncthreads();
    if (wave == 0) {
        f32x4 a = gp[lane]; float s = sp[lane];
#pragma unroll
        for (int w = 1; w < 8; ++w) { a += gp[w * 64 + lane]; s += sp[w * 64 + lane]; }
        s += __shfl_xor(s, 16); s += __shfl_xor(s, 32);
        const float rstd = rsqrtf(s * (1.f / DM) + EPS);
        const float bias = bg[i16];
#pragma unroll
        for (int i = 0; i < 4; ++i) {
            const float rs = __shfl(rstd, 4 * kq + i);
            const float pre = a[i] * rs + bias;
            const float gc = 15.f * tanhf(pre * (1.f / 15.f));
            const float val = (i16 < 8) ? gc : (fminf(gc, 0.f) - log1pf(fexp(-fabsf(gc))));
            GATES[(size_t)(r0 + 4 * kq + i) * 16 + i16] = val;
        }
    }
}

constexpr int SK_PART = 0, SK_RSTD = 16384;
template <int MODE>
__device__ __forceinline__ void skinny_phase(LAS unsigned char* lds, const bf16_t* A, int K, const bf16_t* Bt, int N, bf16_t* Ob, int ldo, bf16_t* XBs, float* SSQS, float* Os, int c, int G, int nIdle, int tid, int wave, int lane) {
    const int i16 = lane & 15, q4 = lane >> 4;
    if (c < G - nIdle) return;
    LAS f32x4* part = (LAS f32x4*)(lds + SK_PART); LAS float* rstdS = (LAS float*)(lds + SK_RSTD);
    __syncthreads();
    if (MODE == 0) { const int row = tid >> 4, sub = tid & 15; const float* q = SSQS + row * 128 + 8 * sub;
        const f32x4 a = *(const f32x4*)q, b = *(const f32x4*)(q + 4); float s = ((a[0] + a[1]) + (a[2] + a[3])) + ((b[0] + b[1]) + (b[2] + b[3]));
        s += __shfl_xor(s, 1); s += __shfl_xor(s, 2); s += __shfl_xor(s, 4); s += __shfl_xor(s, 8);
        if (sub == 0) rstdS[row] = rsqrtf(s * (1.f / 2048.f) + EPS);
        __syncthreads(); }
    const int kper = K >> 3, nks = kper >> 5, k0 = wave * kper;
    for (int j = G - 1 - c; j < (N >> 4); j += nIdle) {
        f32x4 acc0 = {0.f, 0.f, 0.f, 0.f}, acc1 = {0.f, 0.f, 0.f, 0.f};
        const bf16_t* bp = Bt + (size_t)(16 * j + i16) * K + k0 + 8 * q4; const bf16_t* ap = A + (size_t)i16 * K + k0 + 8 * q4;
#pragma unroll 4
        for (int ks = 0; ks < nks; ++ks) { const bf16x8 bf = *(const bf16x8*)(bp + 32 * ks), a0 = *(const bf16x8*)(ap + 32 * ks), a1 = *(const bf16x8*)(ap + (size_t)16 * K + 32 * ks);
            acc0 = mma16(a0, bf, acc0); acc1 = mma16(a1, bf, acc1); }
        part[(wave * 2 + 0) * 64 + lane] = acc0; part[(wave * 2 + 1) * 64 + lane] = acc1;
        __syncthreads();
        if (wave < 2) {
            f32x4 s = part[wave * 64 + lane];
#pragma unroll
            for (int w = 1; w < 8; ++w) s += part[(w * 2 + wave) * 64 + lane];
            const int col = 16 * j + i16;
#pragma unroll
            for (int i = 0; i < 4; ++i) { const int r = 16 * wave + 4 * q4 + i;
                if (MODE == 0) Ob[(size_t)r * ldo + col] = (bf16_t)f2bf(s[i] * rstdS[r]);
                else if (MODE == 1) { const float xo = bf1(XBs[(size_t)r * DM + col]) + s[i]; XBs[(size_t)r * DM + col] = (bf16_t)f2bf(xo);
                    float sq = xo * xo; sq += __shfl_xor(sq, 1); sq += __shfl_xor(sq, 2); sq += __shfl_xor(sq, 4); sq += __shfl_xor(sq, 8);
                    if (i16 == 0) SSQS[r * 128 + j] = sq; }
                else Os[(size_t)r * DM + col] = bf1(XBs[(size_t)r * DM + col]) + s[i]; }
        }
        __syncthreads();
    }
}

__device__ __forceinline__ void prep_row(bf16_t* QKV, const float* rope, const float* qg, const float* kg, float* out, int ia, int r, int lane) {
    const int hh = lane >> 3, sub = lane & 7;
    const bool samp = r >= MP;
    const int b = samp ? ((r - MP) >> 2) : (r >> 11), s = samp ? ((r - MP) & 3) : (r & 2047);
    float cs[8], sn[8];
    { const f32x4* rp = (const f32x4*)(rope + ((size_t)(samp ? SEQ + s : s) * 64 + 8 * sub) * 2);
      const f32x4 t0 = rp[0], t1 = rp[1], t2 = rp[2], t3 = rp[3];
      cs[0] = t0[0]; sn[0] = t0[1]; cs[1] = t0[2]; sn[1] = t0[3]; cs[2] = t1[0]; sn[2] = t1[1]; cs[3] = t1[2]; sn[3] = t1[3];
      cs[4] = t2[0]; sn[4] = t2[1]; cs[5] = t2[2]; sn[5] = t2[3]; cs[6] = t3[0]; sn[6] = t3[1]; cs[7] = t3[2]; sn[7] = t3[3]; }
#pragma unroll 1
    for (int g = 0; g < 3; ++g) {
        const int win = 128 << (2 * g);
#pragma unroll
        for (int t = 0; t < 3; ++t) {
            bf16_t* p = QKV + (size_t)r * NQKV + ((g * 3 + t) * 8 + hh) * 128;
            const u32x4 w0 = *(const u32x4*)(p + 8 * sub), w1 = *(const u32x4*)(p + 64 + 8 * sub);
            float x1[8], x2[8];
            x1[0] = bflo(w0.x); x1[1] = bfhi(w0.x); x1[2] = bflo(w0.y); x1[3] = bfhi(w0.y); x1[4] = bflo(w0.z); x1[5] = bfhi(w0.z); x1[6] = bflo(w0.w); x1[7] = bfhi(w0.w);
            x2[0] = bflo(w1.x); x2[1] = bfhi(w1.x); x2[2] = bflo(w1.y); x2[3] = bfhi(w1.y); x2[4] = bflo(w1.z); x2[5] = bfhi(w1.z); x2[6] = bflo(w1.w); x2[7] = bfhi(w1.w);
            if (t < 2) {
                float ss = 0.f;
#pragma unroll
                for (int j = 0; j < 8; ++j) ss += x1[j] * x1[j] + x2[j] * x2[j];
                ss += __shfl_xor(ss, 1); ss += __shfl_xor(ss, 2); ss += __shfl_xor(ss, 4);
                const float rstd = rsqrtf(ss * (1.f / 128.f) + EPS);
                const float* gn = (t == 0) ? qg : kg;
#pragma unroll
                for (int j = 0; j < 8; ++j) { const float y1 = x1[j] * rstd * gn[8 * sub + j], y2 = x2[j] * rstd * gn[64 + 8 * sub + j];
                    x1[j] = y1 * cs[j] - y2 * sn[j]; x2[j] = y2 * cs[j] + y1 * sn[j]; }
                u32x4 o0, o1;
                o0.x = pk2(x1[0], x1[1]); o0.y = pk2(x1[2], x1[3]); o0.z = pk2(x1[4], x1[5]); o0.w = pk2(x1[6], x1[7]);
                o1.x = pk2(x2[0], x2[1]); o1.y = pk2(x2[2], x2[3]); o1.z = pk2(x2[4], x2[5]); o1.w = pk2(x2[6], x2[7]);
                *(u32x4*)(p + 8 * sub) = o0; *(u32x4*)(p + 64 + 8 * sub) = o1;
            }
            if (t >= 1) {
                const int kv = t - 1;
                const size_t obase = (g == 0) ? (samp ? O_KV128S : O_KV128P) : (g == 1) ? (samp ? O_KV512S : O_KV512P) : (samp ? O_KV2048S : O_KV2048P);
                const int j = samp ? (win - TSAMP + s) : (s - (SEQ - win));
                if (j >= 0) {
                    const int nb = samp ? NBS : NBP;
                    float* dst = out + obase + ((((size_t)(ia * nb + b) * win + j) * 2 + kv) * 8 + hh) * 128;
                    *(f32x4*)(dst + 8 * sub) = (f32x4){x1[0], x1[1], x1[2], x1[3]}; *(f32x4*)(dst + 8 * sub + 4) = (f32x4){x1[4], x1[5], x1[6], x1[7]};
                    *(f32x4*)(dst + 64 + 8 * sub) = (f32x4){x2[0], x2[1], x2[2], x2[3]}; *(f32x4*)(dst + 64 + 8 * sub + 4) = (f32x4){x2[4], x2[5], x2[6], x2[7]};
                }
            }
        }
    }
}

constexpr int AT_PITCH = 272, AT_KOFF = 0, AT_VOFF = 256 * AT_PITCH;
struct AttnItem { int g, b, h, dil, r, qb; };
__device__ __forceinline__ AttnItem attn_decode(int item) {
    AttnItem a; a.g = item >> 9; const int rem = item & 511, idx = rem & 15; a.b = rem >> 7; a.h = (rem >> 4) & 7;
    a.dil = (a.g == 0) ? 1 : (a.g == 1) ? 4 : 16; a.r = (a.g == 0) ? 0 : (a.g == 1) ? (idx >> 2) : idx; a.qb = (a.g == 0) ? idx : (a.g == 1) ? (idx & 3) : 0; return a;
}
__device__ __forceinline__ void attn_fetch(const bf16_t* QKV, const AttnItem& a, int tid, u32x4 (&kr)[8], u32x4 (&vr)[8]) {
    const int ck = (a.g * 3 * 8 + a.h) * 128 + 1024, uk0 = 128 * (a.qb - 1); const size_t rowbase = (size_t)a.b * SEQ + a.r;
#pragma unroll
    for (int i = 0; i < 8; ++i) { const int id = tid + 512 * i, kk = id >> 4, ch = id & 15, u = uk0 + kk;
        kr[i] = (u32x4){0u, 0u, 0u, 0u}; vr[i] = (u32x4){0u, 0u, 0u, 0u};
        if (u >= 0) { const bf16_t* src = QKV + (rowbase + (size_t)u * a.dil) * NQKV + ck + 8 * ch; kr[i] = *(const u32x4*)src; vr[i] = *(const u32x4*)(src + 1024); } }
}
__device__ __forceinline__ void attn_phase(LAS unsigned char* lds, unsigned lds_base, const bf16_t* QKV, bf16_t* OG, float* LSE, int first, int stride, int nitems, int tid, int wave, int lane) {
    const int i16 = lane & 15, q4 = lane >> 4, qq = i16 >> 2, p = lane & 3;
    u32x4 kr[8], vr[8];
    if (first < nitems) { const AttnItem a0 = attn_decode(first); attn_fetch(QKV, a0, tid, kr, vr); }
    __syncthreads();
#pragma unroll 1
    for (int item = first; item < nitems; item += stride) {
        const AttnItem a = attn_decode(item);
        const int g = a.g, h = a.h, qb = a.qb;
        const int cq = (g * 3 * 8 + h) * 128;
        const size_t rowbase = (size_t)a.b * SEQ + a.r;
#pragma unroll
        for (int i = 0; i < 8; ++i) { const int id = tid + 512 * i, kk = id >> 4, ch = id & 15;
            *(LAS u32x4*)(lds + AT_KOFF + kk * AT_PITCH + ch * 16) = kr[i]; *(LAS u32x4*)(lds + AT_VOFF + kk * AT_PITCH + ch * 16) = vr[i]; }
        const int tqa = 16 * wave + i16;
        const size_t grow = rowbase + (size_t)(128 * qb + tqa) * a.dil;
        bf16x8 Qf[4];
#pragma unroll
        for (int ks = 0; ks < 4; ++ks) Qf[ks] = *(const bf16x8*)(QKV + grow * NQKV + cq + 32 * ks + 8 * q4);
        __syncthreads();
        if (item + stride < nitems) { const AttnItem an = attn_decode(item + stride); attn_fetch(QKV, an, tid, kr, vr); }
        const int cb0 = wave & ~1;
        f32x4 S[10];
#pragma unroll
        for (int c = 0; c < 10; ++c) {
            f32x4 acc = {0.f, 0.f, 0.f, 0.f};
#pragma unroll
            for (int ks = 0; ks < 4; ++ks) { const bf16x8 kf = *(const LAS bf16x8*)(lds + AT_KOFF + (16 * (cb0 + c) + i16) * AT_PITCH + (32 * ks + 8 * q4) * 2); acc = mma16(kf, Qf[ks], acc); }
            S[c] = acc;
        }
        const float sc = 0.08838834764831845f * 1.4426950408889634f;
        float mx = -INFINITY;
#pragma unroll
        for (int c = 0; c < 10; ++c)
#pragma unroll
            for (int i = 0; i < 4; ++i) { const int kk = 16 * (cb0 + c) + 4 * q4 + i; const bool ok = (kk >= tqa) && (kk <= tqa + 128) && (qb > 0 || kk >= 128);
                const float s = ok ? S[c][i] * sc : -INFINITY; S[c][i] = s; mx = fmaxf(mx, s); }
        mx = fmaxf(mx, __shfl_xor(mx, 16)); mx = fmaxf(mx, __shfl_xor(mx, 32));
        float l = 0.f;
#pragma unroll
        for (int c = 0; c < 10; ++c)
#pragma unroll
            for (int i = 0; i < 4; ++i) { const float pv = __builtin_amdgcn_exp2f(S[c][i] - mx); S[c][i] = pv; l += pv; }
        l += __shfl_xor(l, 16); l += __shfl_xor(l, 32);
        bf16x8 Pf[5];
#pragma unroll
        for (int kst = 0; kst < 5; ++kst) Pf[kst] = pack8(S[2 * kst], S[2 * kst + 1]);
        const float inv = 1.f / l;
        bf16_t* orow = OG + grow * 3072 + g * 1024 + h * 128 + 4 * q4;
        const unsigned vbase = lds_base + AT_VOFF + (16 * cb0 + 4 * q4 + qq) * AT_PITCH + 8 * p;
#pragma unroll
        for (int eb = 0; eb < 8; ++eb) {
            f32x4 acc = {0.f, 0.f, 0.f, 0.f};
            bf16x8 v0, v1, v2, v3, v4;
            TR_READ5(v0, v1, v2, v3, v4, vbase, 0 * AT_PITCH + 32 * eb, 16 * AT_PITCH + 32 * eb, 32 * AT_PITCH + 32 * eb, 48 * AT_PITCH + 32 * eb, 64 * AT_PITCH + 32 * eb, 80 * AT_PITCH + 32 * eb,
                     96 * AT_PITCH + 32 * eb, 112 * AT_PITCH + 32 * eb, 128 * AT_PITCH + 32 * eb, 144 * AT_PITCH + 32 * eb);
            acc = mma16(v0, Pf[0], acc); acc = mma16(v1, Pf[1], acc); acc = mma16(v2, Pf[2], acc); acc = mma16(v3, Pf[3], acc); acc = mma16(v4, Pf[4], acc);
            u32x2 w; w.x = pk2(acc[0] * inv, acc[1] * inv); w.y = pk2(acc[2] * inv, acc[3] * inv);
            *(u32x2*)(orow + 16 * eb) = w;
        }
        if (q4 == 0) LSE[grow * 24 + g * 8 + h] = (mx + log2f(l)) * 0.6931471805599453f;
        __syncthreads();
    }
}

__device__ __forceinline__ void unpack8(const u32x4 w, float (&x)[8]) { x[0] = bflo(w.x); x[1] = bfhi(w.x); x[2] = bflo(w.y); x[3] = bfhi(w.y); x[4] = bflo(w.z); x[5] = bfhi(w.z); x[6] = bflo(w.w); x[7] = bfhi(w.w); }
__device__ __forceinline__ void load8(const float* p, float (&x)[8]) { const f32x4 a = *(const f32x4*)p, b = *(const f32x4*)(p + 4); x[0] = a.x; x[1] = a.y; x[2] = a.z; x[3] = a.w; x[4] = b.x; x[5] = b.y; x[6] = b.z; x[7] = b.w; }
__device__ __forceinline__ void store8(float* p, const float (&x)[8]) { *(f32x4*)p = (f32x4){x[0], x[1], x[2], x[3]}; *(f32x4*)(p + 4) = (f32x4){x[4], x[5], x[6], x[7]}; }
__device__ __forceinline__ void attn_sample_task(LAS unsigned char* wl  , const bf16_t* QKV, const float* c128, const float* c512, const float* c2048, bf16_t* OG, float* LSE, int ia, int wt, int lane) {
    const int bs = wt / 96, rem = wt % 96, g = rem >> 5, h = (rem >> 2) & 7, t = rem & 3;
    const int win = 128 << (2 * g), dil = 1 << (2 * g);
    const float* cache = ((g == 0) ? c128 : (g == 1) ? c512 : c2048) + (size_t)(ia * NBS + bs) * win * 2048;
    const int cq = (g * 3 * 8 + h) * 128, ck = cq + 1024, cv = cq + 2048;
    const size_t rq = (size_t)MP + bs * 4 + t;
    LAS float* qs = (LAS float*)wl; LAS float* ps = (LAS float*)(wl + 512);
    { const unsigned w = *(const unsigned*)(QKV + rq * NQKV + cq + 2 * lane); qs[2 * lane] = bflo(w); qs[2 * lane + 1] = bfhi(w); }
    asm volatile("s_waitcnt lgkmcnt(0)" ::: "memory");
    float sv[3];
#pragma unroll
    for (int pass = 0; pass < 3; ++pass) {
        const int j = pass * 64 + lane; float s = -INFINITY;
        if (j <= 128) {
            const int idx = win + t - dil * j; float acc = 0.f;
            if (idx >= win) { const bf16_t* kp = QKV + ((size_t)MP + bs * 4 + (idx - win)) * NQKV + ck;
                for (int d = 0; d < 128; d += 8) { const u32x4 w = *(const u32x4*)(kp + d); const LAS float* q = qs + d;
                    acc += q[0] * bflo(w.x) + q[1] * bfhi(w.x) + q[2] * bflo(w.y) + q[3] * bfhi(w.y) + q[4] * bflo(w.z) + q[5] * bfhi(w.z) + q[6] * bflo(w.w) + q[7] * bfhi(w.w); } }
            else { const float* kp = cache + ((size_t)idx * 2 + 0) * 1024 + h * 128;
                for (int d = 0; d < 128; d += 4) { const f32x4 kx = *(const f32x4*)(kp + d); const LAS float* q = qs + d; acc += q[0] * kx.x + q[1] * kx.y + q[2] * kx.z + q[3] * kx.w; } }
            s = acc * 0.08838834764831845f;
        }
        sv[pass] = s;
    }
    const float mx = wave_max(fmaxf(fmaxf(sv[0], sv[1]), sv[2]));
    float l = 0.f;
#pragma unroll
    for (int pass = 0; pass < 3; ++pass) { const float pv = fexp(sv[pass] - mx); l += pv; ps[pass * 64 + lane] = pv; }
    l = wave_sum(l);
    asm volatile("s_waitcnt lgkmcnt(0)" ::: "memory");
    { const int jg = lane >> 4, dd = lane & 15;
      float o[8];
#pragma unroll
      for (int q = 0; q < 8; ++q) o[q] = 0.f;
#pragma unroll 4
      for (int j = jg; j <= 128; j += 4) {
          const int idx = win + t - dil * j; const float pj = ps[j]; float v[8];
          if (idx >= win) { unpack8(*(const u32x4*)(QKV + ((size_t)MP + bs * 4 + (idx - win)) * NQKV + cv + 8 * dd), v); }
          else { load8(cache + ((size_t)idx * 2 + 1) * 1024 + h * 128 + 8 * dd, v); }
#pragma unroll
          for (int q = 0; q < 8; ++q) o[q] += pj * v[q];
      }
      const float inv = 1.f / l;
#pragma unroll
      for (int q = 0; q < 8; ++q) { o[q] += __shfl_xor(o[q], 16); o[q] += __shfl_xor(o[q], 32); o[q] *= inv; }
      if (jg == 0) { u32x4 w; w.x = pk2(o[0], o[1]); w.y = pk2(o[2], o[3]); w.z = pk2(o[4], o[5]); w.w = pk2(o[6], o[7]); *(u32x4*)(OG + rq * 3072 + g * 1024 + h * 128 + 8 * dd) = w; } }
    if (lane == 0) LSE[rq * 24 + g * 8 + h] = mx + logf(l);
}

__device__ __forceinline__ void combine_row(const bf16_t* OG, const float* LSE, bf16_t* OC, int r, int lane) {
    const int hh = lane >> 3;
    const float l0 = LSE[(size_t)r * 24 + hh], l1 = LSE[(size_t)r * 24 + 8 + hh], l2 = LSE[(size_t)r * 24 + 16 + hh];
    const float mx = fmaxf(l0, fmaxf(l1, l2));
    float e0 = fexp(l0 - mx), e1 = fexp(l1 - mx), e2 = fexp(l2 - mx);
    const float inv = 1.f / (e0 + e1 + e2); e0 *= inv; e1 *= inv; e2 *= inv;
    const bf16_t* src = OG + (size_t)r * 3072 + 16 * lane;
#pragma unroll
    for (int c = 0; c < 2; ++c) {
        const u32x4 a = *(const u32x4*)(src + 8 * c), bq = *(const u32x4*)(src + 1024 + 8 * c), cc = *(const u32x4*)(src + 2048 + 8 * c);
        u32x4 o;
        o.x = pk2(e0 * bflo(a.x) + e1 * bflo(bq.x) + e2 * bflo(cc.x), e0 * bfhi(a.x) + e1 * bfhi(bq.x) + e2 * bfhi(cc.x));
        o.y = pk2(e0 * bflo(a.y) + e1 * bflo(bq.y) + e2 * bflo(cc.y), e0 * bfhi(a.y) + e1 * bfhi(bq.y) + e2 * bfhi(cc.y));
        o.z = pk2(e0 * bflo(a.z) + e1 * bflo(bq.z) + e2 * bflo(cc.z), e0 * bfhi(a.z) + e1 * bfhi(bq.z) + e2 * bfhi(cc.z));
        o.w = pk2(e0 * bflo(a.w) + e1 * bflo(bq.w) + e2 * bflo(cc.w), e0 * bfhi(a.w) + e1 * bfhi(bq.w) + e2 * bfhi(cc.w));
        *(u32x4*)(OC + (size_t)r * DO + 16 * lane + 8 * c) = o;
    }
}

template <int CTRL, int RMASK> __device__ __forceinline__ float dpp_f(float oldv, float src) {
    return __builtin_bit_cast(float, __builtin_amdgcn_update_dpp(__builtin_bit_cast(int, oldv), __builtin_bit_cast(int, src), CTRL, RMASK, 0xf, false)); }
__device__ __forceinline__ float scan_sum(float v, int lane) {
    (void)lane;
    v += dpp_f<0x111, 0xf>(0.f, v); v += dpp_f<0x112, 0xf>(0.f, v); v += dpp_f<0x114, 0xf>(0.f, v); v += dpp_f<0x118, 0xf>(0.f, v);
    v += dpp_f<0x142, 0xa>(0.f, v); v += dpp_f<0x143, 0xc>(0.f, v);
    return v;
}
__device__ __forceinline__ float scan_max(float v, int lane) {
    (void)lane; const float ninf = -INFINITY;
    v = fmaxf(v, dpp_f<0x111, 0xf>(ninf, v)); v = fmaxf(v, dpp_f<0x112, 0xf>(ninf, v)); v = fmaxf(v, dpp_f<0x114, 0xf>(ninf, v)); v = fmaxf(v, dpp_f<0x118, 0xf>(ninf, v));
    v = fmaxf(v, dpp_f<0x142, 0xa>(ninf, v)); v = fmaxf(v, dpp_f<0x143, 0xc>(ninf, v));
    return v;
}
#ifndef ML_COPY
#define ML_COPY 0
#endif
constexpr int ML_QP = 272, ML_VP = 144, ML_PP = 144;
constexpr int ML_QSZ = 64 * ML_QP, ML_VSZ = 64 * ML_VP;
constexpr int ML_Q = 0, ML_K = ML_Q + 2 * ML_QSZ, ML_V = ML_K + 2 * ML_QSZ, ML_KW = ML_V + 2 * ML_VSZ, ML_P = ML_KW + ML_QSZ, ML_N = ML_P + 64 * ML_PP, ML_DEN = ML_N + 1024, ML_END = ML_DEN + 256;
__device__ __forceinline__ void mlstm_prompt(LAS unsigned char* lds, unsigned lds_base, const bf16_t* QKVO, const float* GATES, bf16_t* HRAW, float* SQ, float* out, int ib, int unit, int tid, int wave, int lane) {
    const int bh = unit >> 2, sl = unit & 3;
    const int b = bh >> 3, h = bh & 7;
    const int i16 = lane & 15, q4 = lane >> 4, qq = i16 >> 2, p = lane & 3;
    const int rb = wave >> 1, ea = wave & 1, e0 = 64 * sl + 32 * ea;
    f32x4 CT[2][8];
#pragma unroll
    for (int a = 0; a < 2; ++a)
#pragma unroll
        for (int d = 0; d < 8; ++d) CT[a][d] = (f32x4){0.f, 0.f, 0.f, 0.f};
    float m = 0.f;
    const unsigned vbase0 = lds_base + ML_V + (8 * q4 + qq) * ML_VP + (32 * ea + 4 * p) * 2, kwbase = lds_base + ML_KW + (8 * q4 + qq) * ML_QP + 8 * p;
    LAS float* nS = (LAS float*)(lds + ML_N); LAS float* denS = (LAS float*)(lds + ML_DEN);
    const size_t rbase = (size_t)b * SEQ;
    const int srow0 = tid >> 4, sch = tid & 15, vrow = tid >> 3, vch = tid & 7;
    u32x4 pq0, pq1, pk0, pk1, pv; float pig, plf;
    { const bf16_t* s0 = QKVO + (rbase + srow0) * NIN + h * 128 + 8 * sch; const bf16_t* s1 = s0 + (size_t)32 * NIN;
      pq0 = *(const u32x4*)s0; pk0 = *(const u32x4*)(s0 + 1024); pq1 = *(const u32x4*)s1; pk1 = *(const u32x4*)(s1 + 1024);
      pv = *(const u32x4*)(QKVO + (rbase + vrow) * NIN + 2048 + h * 256 + 64 * sl + 8 * vch);
      pig = GATES[(rbase + lane) * 16 + h]; plf = GATES[(rbase + lane) * 16 + 8 + h]; }
    __syncthreads();
    if (tid < 128) nS[tid] = 0.f;
    *(LAS u32x4*)(lds + ML_Q + srow0 * ML_QP + sch * 16) = pq0; *(LAS u32x4*)(lds + ML_Q + (srow0 + 32) * ML_QP + sch * 16) = pq1;
    *(LAS u32x4*)(lds + ML_K + srow0 * ML_QP + sch * 16) = pk0; *(LAS u32x4*)(lds + ML_K + (srow0 + 32) * ML_QP + sch * 16) = pk1;
    *(LAS u32x4*)(lds + ML_V + vrow * ML_VP + vch * 16) = pv;
    __syncthreads();
    float hv0[4] = {0.f, 0.f, 0.f, 0.f}, hv1[4] = {0.f, 0.f, 0.f, 0.f}, sv0[4] = {0.f, 0.f, 0.f, 0.f}, sv1[4] = {0.f, 0.f, 0.f, 0.f};
#define ML_FLUSH(rprev) do { _Pragma("unroll") for (int i = 0; i < 4; ++i) { const int t = 16 * rb + 4 * q4 + i; \
        bf16_t* hp = HRAW + ((rprev) + t) * DM + h * 256 + e0 + i16; hp[0] = (bf16_t)f2bf(hv0[i]); hp[16] = (bf16_t)f2bf(hv1[i]); \
        if (i16 == 0) { float* sp = SQ + ((rprev) + t) * 128 + h * 16 + 4 * sl + 2 * ea; sp[0] = sv0[i]; sp[1] = sv1[i]; } } } while (0)
#pragma unroll 1
    for (int c = 0; c < 32; ++c) {
        const int cur = c & 1, nxt = cur ^ 1;
        const size_t r0 = rbase + 64 * c;
        const LAS unsigned char* Qc = lds + ML_Q + cur * ML_QSZ; const LAS unsigned char* Kc = lds + ML_K + cur * ML_QSZ;
        const float ig = pig, lf = plf;
        asm volatile("" :: "v"(ig), "v"(lf));
        if (c > 0) ML_FLUSH(r0 - 64);
        { const size_t rn = rbase + 64 * ((c < 31) ? c + 1 : c);
          const bf16_t* s0 = QKVO + (rn + srow0) * NIN + h * 128 + 8 * sch; const bf16_t* s1 = s0 + (size_t)32 * NIN;
          pq0 = *(const u32x4*)s0; pk0 = *(const u32x4*)(s0 + 1024); pq1 = *(const u32x4*)s1; pk1 = *(const u32x4*)(s1 + 1024);
          pv = *(const u32x4*)(QKVO + (rn + vrow) * NIN + 2048 + h * 256 + 64 * sl + 8 * vch);
          pig = GATES[(rn + lane) * 16 + h]; plf = GATES[(rn + lane) * 16 + 8 + h]; }
        const float bcum = scan_sum(lf, lane);
        const float av = ig - bcum;
        const float Av = fmaxf(m, scan_max(av, lane));
        const float bL = __shfl(bcum, 63), A63 = __shfl(Av, 63);
        const float wsv = fexp(av - A63), wC = fexp(m - A63);
#pragma unroll
        for (int i = 0; i < 2; ++i) { const int id = lane + 64 * i, rr = 8 * wave + (id >> 4), ch = id & 15;
            const u32x4 kx = *(const LAS u32x4*)(Kc + rr * ML_QP + ch * 16); const float w = __shfl(wsv, rr);
            u32x4 o; o.x = pk2(bflo(kx.x) * w, bfhi(kx.x) * w); o.y = pk2(bflo(kx.y) * w, bfhi(kx.y) * w); o.z = pk2(bflo(kx.z) * w, bfhi(kx.z) * w); o.w = pk2(bflo(kx.w) * w, bfhi(kx.w) * w);
            *(LAS u32x4*)(lds + ML_KW + rr * ML_QP + ch * 16) = o; }
        {
#pragma unroll
          for (int cc = 0; cc < 2; ++cc) { const int cb = 2 * (wave & 1) + cc;
            f32x4 s = {0.f, 0.f, 0.f, 0.f};
            if (cb <= rb) {
#pragma unroll
                for (int ks = 0; ks < 4; ++ks) { const bf16x8 af = *(const LAS bf16x8*)(Qc + (16 * rb + i16) * ML_QP + (32 * ks + 8 * q4) * 2);
                    const bf16x8 bf = *(const LAS bf16x8*)(Kc + (16 * cb + i16) * ML_QP + (32 * ks + 8 * q4) * 2); s = mma16(af, bf, s); } }
            const int sidx = 16 * cb + i16; const float as = __shfl(av, sidx);
#pragma unroll
            for (int i = 0; i < 4; ++i) { const int t = 16 * rb + 4 * q4 + i; const float At = __shfl(Av, t);
                const float pv_ = (sidx <= t && cb <= rb) ? s[i] * fexp(as - At) : 0.f;
                *(LAS bf16_t*)(lds + ML_P + t * ML_PP + sidx * 2) = (bf16_t)f2bf(pv_); } } }
        LDS_BARRIER();
        { const int t = tid >> 3, part = tid & 7;
          const LAS unsigned char* qrow = Qc + t * ML_QP + part * 32;
          const u32x4 qa = *(const LAS u32x4*)(qrow), qb = *(const LAS u32x4*)(qrow + 16);
          const LAS float* nn = nS + cur * 128 + 16 * part;
          float a = nn[0] * bflo(qa.x) + nn[1] * bfhi(qa.x) + nn[2] * bflo(qa.y) + nn[3] * bfhi(qa.y) + nn[4] * bflo(qa.z) + nn[5] * bfhi(qa.z) + nn[6] * bflo(qa.w) + nn[7] * bfhi(qa.w)
                  + nn[8] * bflo(qb.x) + nn[9] * bfhi(qb.x) + nn[10] * bflo(qb.y) + nn[11] * bfhi(qb.y) + nn[12] * bflo(qb.z) + nn[13] * bfhi(qb.z) + nn[14] * bflo(qb.w) + nn[15] * bfhi(qb.w);
          const u32x4 pr = *(const LAS u32x4*)(lds + ML_P + t * ML_PP + part * 16);
          const float rsum = ((bflo(pr.x) + bfhi(pr.x)) + (bflo(pr.y) + bfhi(pr.y))) + ((bflo(pr.z) + bfhi(pr.z)) + (bflo(pr.w) + bfhi(pr.w)));
          const float At = __shfl(Av, t), bt = __shfl(bcum, t);
          float val = fexp(m - At) * a + rsum;
          val += __shfl_xor(val, 1); val += __shfl_xor(val, 2); val += __shfl_xor(val, 4);
          if (part == 0) denS[t] = 1.f / fmaxf(fabsf(val), fexp(-(bt + At))); }
        if (tid < 128) { float acc = wC * nS[cur * 128 + tid];
#pragma unroll 8
            for (int s = 0; s < 64; ++s) acc += bf1(*(const LAS bf16_t*)(lds + ML_KW + s * ML_QP + tid * 2));
            nS[nxt * 128 + tid] = acc; }
        f32x4 num0 = {0.f, 0.f, 0.f, 0.f}, num1 = {0.f, 0.f, 0.f, 0.f};
#pragma unroll
        for (int ks = 0; ks < 4; ++ks) { const LAS unsigned char* qrow = Qc + (16 * rb + i16) * ML_QP;
            const u32x2 lo = *(const LAS u32x2*)(qrow + (32 * ks + 4 * q4) * 2), hi = *(const LAS u32x2*)(qrow + (32 * ks + 16 + 4 * q4) * 2);
            u32x4 w; w.x = lo.x; w.y = lo.y; w.z = hi.x; w.w = hi.y; const bf16x8 af = __builtin_bit_cast(bf16x8, w);
            num0 = mma16(af, pack8(CT[0][2 * ks], CT[0][2 * ks + 1]), num0); num1 = mma16(af, pack8(CT[1][2 * ks], CT[1][2 * ks + 1]), num1); }
#pragma unroll
        for (int i = 0; i < 4; ++i) { const float wi = fexp(m - __shfl(Av, 16 * rb + 4 * q4 + i)); num0[i] *= wi; num1[i] *= wi; }
        const unsigned vbase = vbase0 + cur * ML_VSZ;
        bf16x8 V00, V01, V10, V11;
        TR_READ4(V00, V01, V10, V11, vbase, 0, 4 * ML_VP, 32 * ML_VP, 36 * ML_VP, 32, 4 * ML_VP + 32, 32 * ML_VP + 32, 36 * ML_VP + 32);
        { const bf16x8 pf0 = *(const LAS bf16x8*)(lds + ML_P + (16 * rb + i16) * ML_PP + (8 * q4) * 2), pf1 = *(const LAS bf16x8*)(lds + ML_P + (16 * rb + i16) * ML_PP + (32 + 8 * q4) * 2);
          num0 = mma16(pf0, V00, num0); num0 = mma16(pf1, V01, num0); num1 = mma16(pf0, V10, num1); num1 = mma16(pf1, V11, num1); }
#pragma unroll
        for (int a = 0; a < 2; ++a)
#pragma unroll
            for (int d = 0; d < 8; ++d) CT[a][d] = CT[a][d] * wC;
#pragma unroll
        for (int ks = 0; ks < 2; ++ks)
#pragma unroll
            for (int dg = 0; dg < 2; ++dg) { bf16x8 k0, k1, k2, k3;
                TR_READ4(k0, k1, k2, k3, kwbase, 32 * ks * ML_QP + 32 * (4 * dg), (32 * ks + 4) * ML_QP + 32 * (4 * dg), 32 * ks * ML_QP + 32 * (4 * dg + 1), (32 * ks + 4) * ML_QP + 32 * (4 * dg + 1),
                         32 * ks * ML_QP + 32 * (4 * dg + 2), (32 * ks + 4) * ML_QP + 32 * (4 * dg + 2), 32 * ks * ML_QP + 32 * (4 * dg + 3), (32 * ks + 4) * ML_QP + 32 * (4 * dg + 3));
                const bf16x8 va = ks ? V01 : V00, vb = ks ? V11 : V10;
                CT[0][4 * dg] = mma16(k0, va, CT[0][4 * dg]); CT[0][4 * dg + 1] = mma16(k1, va, CT[0][4 * dg + 1]); CT[0][4 * dg + 2] = mma16(k2, va, CT[0][4 * dg + 2]); CT[0][4 * dg + 3] = mma16(k3, va, CT[0][4 * dg + 3]);
                CT[1][4 * dg] = mma16(k0, vb, CT[1][4 * dg]); CT[1][4 * dg + 1] = mma16(k1, vb, CT[1][4 * dg + 1]); CT[1][4 * dg + 2] = mma16(k2, vb, CT[1][4 * dg + 2]); CT[1][4 * dg + 3] = mma16(k3, vb, CT[1][4 * dg + 3]); }
        { LAS unsigned char* Qn = lds + ML_Q + nxt * ML_QSZ; LAS unsigned char* Kn = lds + ML_K + nxt * ML_QSZ;
          *(LAS u32x4*)(Qn + srow0 * ML_QP + sch * 16) = pq0; *(LAS u32x4*)(Qn + (srow0 + 32) * ML_QP + sch * 16) = pq1;
          *(LAS u32x4*)(Kn + srow0 * ML_QP + sch * 16) = pk0; *(LAS u32x4*)(Kn + (srow0 + 32) * ML_QP + sch * 16) = pk1;
          *(LAS u32x4*)(lds + ML_V + nxt * ML_VSZ + vrow * ML_VP + vch * 16) = pv; }
        LDS_BARRIER();
#pragma unroll
        for (int i = 0; i < 4; ++i) { const int t = 16 * rb + 4 * q4 + i; const float dinv = denS[t]; const float h0 = num0[i] * dinv, h1 = num1[i] * dinv;
            hv0[i] = h0; hv1[i] = h1;
            float s0 = h0 * h0, s1 = h1 * h1;
            s0 += __shfl_xor(s0, 1); s0 += __shfl_xor(s0, 2); s0 += __shfl_xor(s0, 4); s0 += __shfl_xor(s0, 8);
            s1 += __shfl_xor(s1, 1); s1 += __shfl_xor(s1, 2); s1 += __shfl_xor(s1, 4); s1 += __shfl_xor(s1, 8);
            sv0[i] = s0; sv1[i] = s1; }
        m = bL + A63;
    }
    ML_FLUSH(rbase + 64 * 31);
#undef ML_FLUSH
    const size_t sb = (size_t)(ib * NBP + b) * 8 + h;
    if (rb == 0) {
#pragma unroll
        for (int a = 0; a < 2; ++a)
#pragma unroll
            for (int d = 0; d < 8; ++d) *(f32x4*)(out + O_CP + (sb * 256 + e0 + 16 * a + i16) * 128 + 16 * d + 4 * q4) = CT[a][d]; }
    if (sl == 0) { if (tid < 128) out[O_NP + sb * 128 + tid] = nS[tid]; if (tid == 0) out[O_MP + sb] = m; }
}

__device__ __forceinline__ void hn_row(const bf16_t* HRAW, const float* SQ, const bf16_t* QKVO, const float* gh, bf16_t* HN, int r, int lane) {
    const int hh = lane >> 3;
    const f32x4 s0 = *(const f32x4*)(SQ + (size_t)r * 128 + hh * 16), s1 = *(const f32x4*)(SQ + (size_t)r * 128 + hh * 16 + 4), s2 = *(const f32x4*)(SQ + (size_t)r * 128 + hh * 16 + 8), s3 = *(const f32x4*)(SQ + (size_t)r * 128 + hh * 16 + 12);
    const float tot = (((s0[0] + s0[1]) + (s0[2] + s0[3])) + ((s1[0] + s1[1]) + (s1[2] + s1[3]))) + (((s2[0] + s2[1]) + (s2[2] + s2[3])) + ((s3[0] + s3[1]) + (s3[2] + s3[3])));
    const float rs = rsqrtf(tot * (1.f / 256.f) + EPS);
#pragma unroll
    for (int c = 0; c < 4; ++c) { const int col = 32 * lane + 8 * c;
        const u32x4 hx = *(const u32x4*)(HRAW + (size_t)r * DM + col), ox = *(const u32x4*)(QKVO + (size_t)r * NIN + 4096 + col);
        const f32x4 g0 = *(const f32x4*)(gh + col), g1 = *(const f32x4*)(gh + col + 4);
        u32x4 o;
        o.x = pk2(bflo(hx.x) * rs * g0[0] / (1.f + fexp(-bflo(ox.x))), bfhi(hx.x) * rs * g0[1] / (1.f + fexp(-bfhi(ox.x))));
        o.y = pk2(bflo(hx.y) * rs * g0[2] / (1.f + fexp(-bflo(ox.y))), bfhi(hx.y) * rs * g0[3] / (1.f + fexp(-bfhi(ox.y))));
        o.z = pk2(bflo(hx.z) * rs * g1[0] / (1.f + fexp(-bflo(ox.z))), bfhi(hx.z) * rs * g1[1] / (1.f + fexp(-bfhi(ox.z))));
        o.w = pk2(bflo(hx.w) * rs * g1[2] / (1.f + fexp(-bflo(ox.w))), bfhi(hx.w) * rs * g1[3] / (1.f + fexp(-bfhi(ox.w))));
        *(u32x4*)(HN + (size_t)r * DM + col) = o; }
}

__device__ __forceinline__ void mlstm_sample(LAS unsigned char* lds, const bf16_t* QKVO, const float* GATES, const float* gh, const float* C0all, const float* n0all, const float* m0all, bf16_t* HN, float* out, int ib, int bh, int tid, int wave, int lane) {
    const int bs = bh >> 3, h = bh & 7;
    const size_t sb = (size_t)(ib * NBS + bs) * 8 + h;
    LAS float* qs = (LAS float*)lds;
    LAS float* ks = qs + 512;
    LAS float* ns = ks + 512;
    LAS float* Ss = ns + 128;
    LAS float* nq = Ss + 16;
    LAS float* red = nq + 16;
    const size_t r0 = (size_t)MP + bs * 4;
    __syncthreads();
    { const int t = tid >> 7, d = tid & 127; qs[tid] = bf1(QKVO[(r0 + t) * NIN + h * 128 + d]); ks[tid] = bf1(QKVO[(r0 + t) * NIN + 1024 + h * 128 + d]); if (tid < 128) ns[tid] = n0all[sb * 128 + tid]; }
    __syncthreads();
    if (wave == 0) {
        if (lane < 16) { const int t = lane >> 2, s = lane & 3; float a = 0.f; for (int d = 0; d < 128; ++d) a += qs[t * 128 + d] * ks[s * 128 + d]; Ss[lane] = a; }
        else if (lane < 20) { const int t = lane - 16; float a = 0.f; for (int d = 0; d < 128; ++d) a += ns[d] * qs[t * 128 + d]; nq[t] = a; }
    }
    __syncthreads();
    const float m0 = m0all[sb];
    float bc[4], av[4], Av[4];
    { float run = 0.f, pm = -INFINITY;
#pragma unroll
      for (int t = 0; t < 4; ++t) { const float ig = GATES[(r0 + t) * 16 + h], lf = GATES[(r0 + t) * 16 + 8 + h]; run += lf; bc[t] = run; av[t] = ig - run; pm = fmaxf(pm, av[t]); Av[t] = fmaxf(m0, pm); } }
    const float A3 = Av[3], wC = fexp(m0 - A3);
    float Pm[4][4], den[4];
#pragma unroll
    for (int t = 0; t < 4; ++t) { float rs = 0.f;
#pragma unroll
        for (int s = 0; s < 4; ++s) { Pm[t][s] = (s <= t) ? Ss[t * 4 + s] * fexp(av[s] - Av[t]) : 0.f; rs += Pm[t][s]; }
        den[t] = fexp(m0 - Av[t]) * nq[t] + rs; }
    const int e = tid >> 1, hf = tid & 1;
    const float* Crow = C0all + (sb * 256 + e) * 128 + 64 * hf;
    f32x4 Cv[16];
#pragma unroll
    for (int j = 0; j < 16; ++j) Cv[j] = *(const f32x4*)(Crow + 4 * j);
    float inter[4];
#pragma unroll
    for (int t = 0; t < 4; ++t) { float a = 0.f; const LAS float* q = qs + t * 128 + 64 * hf;
#pragma unroll
        for (int j = 0; j < 16; ++j) a += Cv[j].x * q[4 * j] + Cv[j].y * q[4 * j + 1] + Cv[j].z * q[4 * j + 2] + Cv[j].w * q[4 * j + 3];
        a += __shfl_xor(a, 1); inter[t] = a; }
    float vv[4];
#pragma unroll
    for (int s = 0; s < 4; ++s) vv[s] = bf1(QKVO[(r0 + s) * NIN + 2048 + h * 256 + e]);
    float hv[4];
#pragma unroll
    for (int t = 0; t < 4; ++t) { float nu = fexp(m0 - Av[t]) * inter[t];
#pragma unroll
        for (int s = 0; s < 4; ++s) nu += Pm[t][s] * vv[s];
        hv[t] = nu / fmaxf(fabsf(den[t]), fexp(-(bc[t] + Av[t])));
        float sq = (hf == 0) ? hv[t] * hv[t] : 0.f; sq = wave_sum(sq); if (lane == 0) red[t * 8 + wave] = sq; }
    __syncthreads();
    if (hf == 0) {
#pragma unroll
        for (int t = 0; t < 4; ++t) { float tot = 0.f;
#pragma unroll
            for (int w = 0; w < 8; ++w) tot += red[t * 8 + w];
            const float rs = rsqrtf(tot * (1.f / 256.f) + EPS);
            const float og = bf1(QKVO[(r0 + t) * NIN + 4096 + h * 256 + e]);
            HN[(r0 + t) * DM + h * 256 + e] = (bf16_t)f2bf(hv[t] * rs * gh[h * 256 + e] / (1.f + fexp(-og))); } }
    float wv[4];
#pragma unroll
    for (int s = 0; s < 4; ++s) wv[s] = fexp(av[s] - A3) * vv[s];
    float* Cout = out + O_CS + (sb * 256 + e) * 128 + 64 * hf;
#pragma unroll
    for (int j = 0; j < 16; ++j) { f32x4 o = Cv[j] * wC;
#pragma unroll
        for (int s = 0; s < 4; ++s) { const LAS float* k = ks + s * 128 + 64 * hf + 4 * j; o.x += wv[s] * k[0]; o.y += wv[s] * k[1]; o.z += wv[s] * k[2]; o.w += wv[s] * k[3]; }
        *(f32x4*)(Cout + 4 * j) = o; }
    if (tid < 128) { float o = wC * ns[tid];
#pragma unroll
        for (int s = 0; s < 4; ++s) o += fexp(av[s] - A3) * ks[s * 128 + tid];
        out[O_NS + sb * 128 + tid] = o; }
    if (tid == 0) out[O_MS + sb] = bc[3] + A3;
}

__device__ __forceinline__ void cache_shift(const Params& P, float* outp, int ia, int w, int NW, int lane) {
    constexpr int N0 = NBS * 124, N1 = NBS * 508, N2 = NBS * 2044;
    for (int it = w; it < N0 + N1 + N2; it += NW) {
        int g, q; if (it < N0) { g = 0; q = it; } else if (it < N0 + N1) { g = 1; q = it - N0; } else { g = 2; q = it - N0 - N1; }
        const int win = 128 << (2 * g), per = win - 4, bs = q / per, j = q % per;
        const float* src = P.in[2 + g] + ((size_t)(ia * NBS + bs) * win + j + 4) * 2048;
        float* dst = outp + ((g == 0) ? O_KV128S : (g == 1) ? O_KV512S : O_KV2048S) + ((size_t)(ia * NBS + bs) * win + j) * 2048;
#pragma unroll
        for (int i = 0; i < 8; ++i) ((f32x4*)dst)[lane + 64 * i] = ((const f32x4*)src)[lane + 64 * i];
    }
}

__device__ __forceinline__ void phase_convgate(const Params& P, float* outp, const bf16_t* U, bf16_t* Z, int layer, int gtid, int NGT) {
    constexpr int NCG = DFF / 8, NRUN = MP / 64 + NBS;
    const float* cw = P.in[20] + (size_t)layer * 3 * NUP; const float* cbias = P.in[21] + (size_t)layer * NUP;
    for (int task = gtid; task < NCG * NRUN; task += NGT) {
        const int cg = task % NCG, run = task / NCG, j0 = 8 * cg;
        float wa[3][8], wb[3][8], ba[8], bb[8];
#pragma unroll
        for (int k = 0; k < 3; ++k) { load8(cw + (size_t)k * NUP + j0, wa[k]); load8(cw + (size_t)k * NUP + DFF + j0, wb[k]); }
        load8(cbias + j0, ba); load8(cbias + DFF + j0, bb);
        float a2[8], a1[8], b2[8], b1[8];
        size_t row0; int nrows; float* cout;
        if (run < MP / 64) { const int b = run >> 5, s0 = (run & 31) * 64; row0 = (size_t)b * SEQ + s0; nrows = 64;
            cout = (s0 == SEQ - 64) ? outp + O_CONVP + ((size_t)(layer * NBP + b) * 2) * NUP : nullptr;
            if (s0 == 0) {
#pragma unroll
                for (int j = 0; j < 8; ++j) { a2[j] = 0.f; a1[j] = 0.f; b2[j] = 0.f; b1[j] = 0.f; } }
            else { unpack8(*(const u32x4*)(U + (row0 - 2) * NUP + j0), a2); unpack8(*(const u32x4*)(U + (row0 - 1) * NUP + j0), a1);
                   unpack8(*(const u32x4*)(U + (row0 - 2) * NUP + DFF + j0), b2); unpack8(*(const u32x4*)(U + (row0 - 1) * NUP + DFF + j0), b1); } }
        else { const int bs = run - MP / 64; row0 = (size_t)MP + bs * 4; nrows = 4;
            cout = outp + O_CONVS + ((size_t)(layer * NBS + bs) * 2) * NUP;
            const float* st = P.in[8] + ((size_t)(layer * NBS + bs) * 2) * NUP;
            load8(st + j0, a2); load8(st + NUP + j0, a1); load8(st + DFF + j0, b2); load8(st + NUP + DFF + j0, b1); }
        for (int t = 0; t < nrows; t += 4) {
            u32x4 ua[4], ub[4];
#pragma unroll
            for (int q = 0; q < 4; ++q) { ua[q] = *(const u32x4*)(U + (row0 + t + q) * NUP + j0); ub[q] = *(const u32x4*)(U + (row0 + t + q) * NUP + DFF + j0); }
#pragma unroll
            for (int q = 0; q < 4; ++q) {
                float a0[8], b0[8];
                unpack8(ua[q], a0); unpack8(ub[q], b0);
                float z[8];
#pragma unroll
                for (int j = 0; j < 8; ++j) { const float ca = ba[j] + wa[0][j] * a2[j] + wa[1][j] * a1[j] + wa[2][j] * a0[j]; const float cb = bb[j] + wb[0][j] * b2[j] + wb[1][j] * b1[j] + wb[2][j] * b0[j];
                    z[j] = ca / (1.f + fexp(-ca)) * cb; a2[j] = a1[j]; a1[j] = a0[j]; b2[j] = b1[j]; b1[j] = b0[j]; }
                u32x4 o; o.x = pk2(z[0], z[1]); o.y = pk2(z[2], z[3]); o.z = pk2(z[4], z[5]); o.w = pk2(z[6], z[7]);
                *(u32x4*)(Z + (row0 + t + q) * DFF + j0) = o;
            }
        }
        if (cout) { store8(cout + j0, a2); store8(cout + NUP + j0, a1); store8(cout + DFF + j0, b2); store8(cout + NUP + DFF + j0, b1); }
    }
}

#ifndef REP_STORE
#define REP_STORE 1
#endif
#ifndef REP_CONV
#define REP_CONV 1
#endif
#ifndef REP_ML
#define REP_ML 1
#endif
#ifndef REP_ATT
#define REP_ATT 1
#endif
#ifndef REP_RESID
#define REP_RESID 1
#endif
#ifndef REP_FIN
#define REP_FIN 1
#endif
#ifndef REP_P0
#define REP_P0 1
#endif
#define REPEAT(n, body) do { body; if ((n) > 1) { body; } if ((n) > 2) { body; } } while (0)
__global__ void __launch_bounds__(NTHR, 2) fwd_kernel(Params P) {
    extern __shared__ __attribute__((aligned(16))) unsigned char lds_raw[];
    LAS unsigned char* lds = (LAS unsigned char*)lds_raw;
    const unsigned lds_base = (unsigned)(size_t)lds;
    const int tid0 = threadIdx.x;
    const int G0 = gridDim.x, bx0 = blockIdx.x;
#define PHASE_IDS int tid = tid0; asm volatile("" : "+v"(tid)); int zz_ = 0; asm volatile("" : "+v"(zz_)); zz_ = __builtin_amdgcn_readfirstlane(zz_); const int bx = bx0 + zz_, G = G0 + zz_; unsigned char* ws = P.ws + zz_; float* outp = P.out + zz_; \
    const int lane = tid & 63, wave = __builtin_amdgcn_readfirstlane(tid >> 6); const int gw = bx * NWAVES + wave, gtid = bx * NTHR + tid, NGW = G * NWAVES, NGT = G * NTHR; (void)gw; (void)gtid; (void)lane; (void)NGW; (void)NGT; (void)outp; \
    bf16_t* XB = (bf16_t*)(ws + WS_XB); float* SSQ = (float*)(ws + WS_SSQ); float* SSQS = (float*)(ws + WS_SSQS); bf16_t* QKV = (bf16_t*)(ws + WS_QKV); bf16_t* OG = (bf16_t*)(ws + WS_OG); float* LSE = (float*)(ws + WS_LSE); bf16_t* OC = (bf16_t*)(ws + WS_OC); \
    float* GATES = (float*)(ws + WS_GATES); bf16_t* U = (bf16_t*)(ws + WS_U); bf16_t* Z = (bf16_t*)(ws + WS_Z); (void)XB; (void)SSQ; (void)SSQS; (void)QKV; (void)OG; (void)LSE; (void)OC; (void)GATES; (void)U; (void)Z;
    volatile LAS unsigned* misc = (volatile LAS unsigned*)(lds + LDS_MISC_OFF);
    if (tid0 < 16) misc[tid0] = 0u;
    __syncthreads();
    { const XcdBarrier bar0 = xcd_barrier_post((unsigned*)(P.ws + WS_CTL) + 1024, misc + 8); if (tid0 == 0) misc[10] = bar0.x; }
    __syncthreads();
#define GRID_BAR() do { XcdBarrier bar_; bar_.bar = (unsigned*)(P.ws + WS_CTL) + 1024; bar_.x = (unsigned)__builtin_amdgcn_readfirstlane((int)misc[10]); bar_.st = misc + 8; xcd_barrier(bar_); } while (0)
#define GEMM_STORE(Abuf, Wt, NN, KK, Obuf) REPEAT(REP_STORE, GEMM_STORE1(Abuf, Wt, NN, KK, Obuf))
#define GEMM_STORE1(Abuf, Wt, NN, KK, Obuf) do { PHASE_IDS; \
        { pg8::Gemm g{Abuf, (const bf16_t*)(Wt), MP, NN, KK}; pg8::StaticOrder S; S.init(MP, NN, G, bx); pg8::EpiStoreN E{Obuf, NN, SSQ, EPS}; \
          pg8::gemm_phase<pg8::EpiStoreN, pg8::StaticOrder, true, true>(lds, g, S, E); } \
        skinny_phase<0>(lds, Abuf + (size_t)MP * KK, KK, (const bf16_t*)(Wt), NN, Obuf + (size_t)MP * NN, NN, nullptr, SSQS, nullptr, bx, G, (((MP / 256) * ((NN) / 256)) % G) ? G - (((MP / 256) * ((NN) / 256)) % G) : G, tid, wave, lane); } while (0)
#define GEMM_RESID(Abuf, Wt, KK, FIN) do { PHASE_IDS; \
        { pg8::Gemm g{Abuf, (const bf16_t*)(Wt), MP, DM, KK}; pg8::StaticOrder S; S.init(MP, DM, G, bx); pg8::EpiResidN E{XB, (FIN) ? outp : nullptr, (FIN) ? nullptr : SSQ, DM}; \
          pg8::gemm_phase<pg8::EpiResidN, pg8::StaticOrder, true, true>(lds, g, S, E); } \
        if (FIN) skinny_phase<2>(lds, Abuf + (size_t)MP * KK, KK, (const bf16_t*)(Wt), DM, nullptr, 0, XB + (size_t)MP * DM, nullptr, outp + (size_t)MP * DM, bx, G, G, tid, wave, lane); \
        else skinny_phase<1>(lds, Abuf + (size_t)MP * KK, KK, (const bf16_t*)(Wt), DM, nullptr, 0, XB + (size_t)MP * DM, SSQS, nullptr, bx, G, G, tid, wave, lane); } while (0)

    REPEAT(REP_P0, { PHASE_IDS; phase_prologue(P, lds, gw, NGW, wave, lane); });
    GRID_BAR();

#define FFN(L, FIN) do { \
        GEMM_STORE(XB, ws + WS_WUP + (L) * SZ_WUP, NUP, DM, U); \
        GRID_BAR(); \
        REPEAT(REP_CONV, { PHASE_IDS; phase_convgate(P, outp, U, Z, (L), gtid, NGT); }); \
        GRID_BAR(); \
        GEMM_RESID(Z, ws + WS_WDOWN + (L) * SZ_WDOWN, DFF, FIN); \
    } while (0)

#define LAYER_PAIR(lp) do { \
        { \
            const int ia = (lp); \
            GEMM_STORE(XB, ws + WS_WQKV + ia * SZ_WQKV, NQKV, DM, QKV); \
            GRID_BAR(); \
            { PHASE_IDS; for (int r = gw; r < MR; r += NGW) prep_row(QKV, (const float*)(ws + WS_ROPE), P.in[12] + ia * 128, P.in[13] + ia * 128, outp, ia, r, lane); } \
            GRID_BAR(); \
            REPEAT(REP_ATT, { PHASE_IDS; attn_phase(lds, lds_base, QKV, OG, LSE, bx, G, 1536, tid, wave, lane); } \
            { PHASE_IDS; for (int wt = bx + G * wave; wt < NBS * 96; wt += G * NWAVES) attn_sample_task(lds + wave * 2048, QKV, P.in[2], P.in[3], P.in[4], OG, LSE, ia, wt, lane); __syncthreads(); }); \
            GRID_BAR(); \
            REPEAT(REP_ATT, { PHASE_IDS; for (int r = gw; r < MR; r += NGW) combine_row(OG, LSE, OC, r, lane); }); \
            GRID_BAR(); \
            GEMM_RESID(OC, ws + WS_WO + ia * SZ_WO, DO, false); \
            GRID_BAR(); \
            FFN(2 * (lp), false); \
            GRID_BAR(); \
        } \
        { \
            const int L = 2 * (lp) + 1, ib = (lp); \
            GEMM_STORE(XB, ws + WS_WIN + ib * SZ_WIN, NIN, DM, QKV); \
            { PHASE_IDS; for (int task = G - 1 - bx; task < MR / 16; task += G) gate_block(lds, XB, (const f32x4*)(ws + WS_WGP) + (size_t)ib * 128 * 64, P.in[16] + ib * 16, GATES, task, wave, lane); } \
            GRID_BAR(); \
            REPEAT(REP_ML, { PHASE_IDS; \
            if (bx < 128) mlstm_prompt(lds, lds_base, QKV, GATES, OG, (float*)(ws + WS_SQ), outp, ib, bx, tid, wave, lane); \
            else { if (bx < 192) mlstm_sample(lds, QKV, GATES, P.in[17] + (size_t)ib * DM, P.in[5], P.in[6], P.in[7], OC, outp, ib, bx - 128, tid, wave, lane); \
                   cache_shift(P, outp, (lp), (bx - 128) * NWAVES + wave, (G - 128) * NWAVES, lane); } }); \
            GRID_BAR(); \
            REPEAT(REP_FIN, { PHASE_IDS; for (int r = gw; r < MP; r += NGW) hn_row(OG, (const float*)(ws + WS_SQ), QKV, P.in[17] + (size_t)ib * DM, OC, r, lane); }); \
            GRID_BAR(); \
            GEMM_RESID(OC, ws + WS_WOUT + ib * SZ_WOUT, DM, false); \
            GRID_BAR(); \
            FFN(L, (L == DEPTH - 1)); \
            if ((lp) == 0) GRID_BAR(); \
        } \
    } while (0)
    LAYER_PAIR(0);
    LAYER_PAIR(1);
}

extern "C" void kernel_launch(void* const* d_in, const int* in_sizes, int n_in, void* d_out, int out_size, void* d_ws, size_t ws_size, hipStream_t stream) {
    static int grid = 0;
    if (grid == 0) {
        if (n_in != 23 || (size_t)out_size != O_END || ws_size < WS_END) {
            fprintf(stderr, "kernel_launch: built for 23 inputs, %zu outputs, >= %zu bytes of workspace; got n_in %d, out %d, ws %zu; nothing launched\n", (size_t)O_END, (size_t)WS_END, n_in, out_size, ws_size);
            grid = -1; return; }
        int dev = 0, cus = 0, per_cu = 0;
        if (hipGetDevice(&dev) != hipSuccess || hipDeviceGetAttribute(&cus, hipDeviceAttributeMultiprocessorCount, dev) != hipSuccess) { fprintf(stderr, "kernel_launch: device query failed\n"); grid = -1; return; }
        if (hipFuncSetAttribute((const void*)fwd_kernel, hipFuncAttributeMaxDynamicSharedMemorySize, LDS_BYTES) != hipSuccess) { fprintf(stderr, "kernel_launch: hipFuncSetAttribute failed\n"); grid = -1; return; }
        if (hipOccupancyMaxActiveBlocksPerMultiprocessor(&per_cu, (const void*)fwd_kernel, NTHR, LDS_BYTES) != hipSuccess || per_cu < 1)
            fprintf(stderr, "kernel_launch: occupancy query reports %d workgroups per CU\n", per_cu);
        (void)hipGetLastError();
        grid = cus;
    }
    if (grid < 0) return;
    (void)hipMemsetAsync((char*)d_ws + WS_CTL, 0, CTL_ZERO_BYTES, stream);
    Params p{};
    for (int i = 0; i < 23; ++i) p.in[i] = (const float*)d_in[i];
    p.out = (float*)d_out; p.ws = (unsigned char*)d_ws;
    hipLaunchKernelGGL(fwd_kernel, dim3(grid), dim3(NTHR), LDS_BYTES, stream, p);
    const hipError_t le = hipPeekAtLastError();
    if (le != hipSuccess) fprintf(stderr, "kernel_launch: launch failed: %s\n", hipGetErrorName(le));
}
```

```cpp
#include <hip/hip_runtime.h>
#include <cstdio>
#include <cstdint>

#define LAS __attribute__((address_space(3)))
typedef unsigned short bf16_t;
typedef short bf16x8 __attribute__((ext_vector_type(8)));
typedef float f32x4 __attribute__((ext_vector_type(4)));
typedef float f32x2 __attribute__((ext_vector_type(2)));
typedef unsigned u32x4 __attribute__((ext_vector_type(4)));
typedef unsigned u32x2 __attribute__((ext_vector_type(2)));
typedef unsigned short u16x4 __attribute__((ext_vector_type(4)));

constexpr int DM = 2048, SEQ = 2048, NBP = 4, NBS = 8, TSAMP = 4, PAST = 16384;
constexpr int MP = NBP * SEQ, MSAMP = NBS * TSAMP, MR = MP + MSAMP, MT = 8448;
constexpr int NQKV = 9216, NIN = 6144, NIN_SRC = 6160, DFF = 5632, NUP = 2 * DFF, DO = 1024;
constexpr int DEPTH = 4;
constexpr float EPS = 1e-6f;
constexpr int NWAVES = 8, NTHR = 512;

constexpr size_t O_YP = 0;
constexpr size_t O_YS = O_YP + (size_t)MP * DM;
constexpr size_t O_KV128P = O_YS + (size_t)MSAMP * DM;
constexpr size_t O_KV128S = O_KV128P + (size_t)2 * NBP * 128 * 2048;
constexpr size_t O_KV512P = O_KV128S + (size_t)2 * NBS * 128 * 2048;
constexpr size_t O_KV512S = O_KV512P + (size_t)2 * NBP * 512 * 2048;
constexpr size_t O_KV2048P = O_KV512S + (size_t)2 * NBS * 512 * 2048;
constexpr size_t O_KV2048S = O_KV2048P + (size_t)2 * NBP * 2048 * 2048;
constexpr size_t O_CP = O_KV2048S + (size_t)2 * NBS * 2048 * 2048;
constexpr size_t O_CS = O_CP + (size_t)2 * NBP * 8 * 256 * 128;
constexpr size_t O_NP = O_CS + (size_t)2 * NBS * 8 * 256 * 128;
constexpr size_t O_NS = O_NP + (size_t)2 * NBP * 8 * 128;
constexpr size_t O_MP = O_NS + (size_t)2 * NBS * 8 * 128;
constexpr size_t O_MS = O_MP + (size_t)2 * NBP * 8;
constexpr size_t O_CONVP = O_MS + (size_t)2 * NBS * 8;
constexpr size_t O_CONVS = O_CONVP + (size_t)DEPTH * NBP * 2 * NUP;
constexpr size_t O_END = O_CONVS + (size_t)DEPTH * NBS * 2 * NUP;

constexpr size_t al1m(size_t x) { return (x + 1048575) & ~(size_t)1048575; }
constexpr size_t WS_CTL = 0, CTL_ZERO_BYTES = 1048576;
constexpr size_t SZ_WQKV = (size_t)NQKV * DM * 2, SZ_WO = (size_t)DM * DO * 2, SZ_WIN = (size_t)NIN * DM * 2, SZ_WOUT = (size_t)DM * DM * 2, SZ_WUP = (size_t)NUP * DM * 2, SZ_WDOWN = (size_t)DM * DFF * 2;
constexpr size_t WS_WQKV = al1m(WS_CTL + CTL_ZERO_BYTES);
constexpr size_t WS_WO = al1m(WS_WQKV + 2 * SZ_WQKV);
constexpr size_t WS_WIN = al1m(WS_WO + 2 * SZ_WO);
constexpr size_t WS_WOUT = al1m(WS_WIN + 2 * SZ_WIN);
constexpr size_t WS_WUP = al1m(WS_WOUT + 2 * SZ_WOUT);
constexpr size_t WS_WDOWN = al1m(WS_WUP + 4 * SZ_WUP);
constexpr size_t WS_X = al1m(WS_WDOWN + 4 * SZ_WDOWN);
constexpr size_t WS_XB = al1m(WS_X + (size_t)MT * DM * 4);
constexpr size_t WS_SSQ = al1m(WS_XB + (size_t)MT * DM * 2);
constexpr size_t WS_SSQS = al1m(WS_SSQ + (size_t)MP * 32 * 4);
constexpr size_t WS_QKV = al1m(WS_SSQS + (size_t)MSAMP * 128 * 4);
constexpr size_t WS_OG = al1m(WS_QKV + (size_t)MT * NQKV * 2);
constexpr size_t WS_LSE = al1m(WS_OG + (size_t)MT * 3072 * 2);
constexpr size_t WS_OC = al1m(WS_LSE + (size_t)MT * 24 * 4);
constexpr size_t WS_GATES = al1m(WS_OC + (size_t)MT * DM * 2);
constexpr size_t WS_U = al1m(WS_GATES + (size_t)MT * 16 * 4);
constexpr size_t WS_Z = al1m(WS_U + (size_t)MT * NUP * 2);
constexpr size_t WS_SQ = al1m(WS_Z + (size_t)MT * DFF * 2);
constexpr size_t WS_ROPE = al1m(WS_SQ + (size_t)MP * 128 * 4);
constexpr size_t WS_WGP = al1m(WS_ROPE + (size_t)2052 * 128 * 4);
constexpr size_t WS_END = al1m(WS_WGP + (size_t)2 * 128 * 64 * 16);

constexpr int RING_BYTES = 131072;
constexpr int LDS_MISC_OFF = 150 * 1024;
constexpr int LDS_BYTES = 152 * 1024;

__device__ __forceinline__ unsigned pk2(float lo, float hi) { unsigned r; asm("v_cvt_pk_bf16_f32 %0, %1, %2" : "=v"(r) : "v"(lo), "v"(hi)); return r; }
__device__ __forceinline__ unsigned f2bf(float f) { return pk2(f, 0.f) & 0xffffu; }
__device__ __forceinline__ float bflo(unsigned w) { return __builtin_bit_cast(float, w << 16); }
__device__ __forceinline__ float bfhi(unsigned w) { return __builtin_bit_cast(float, w & 0xffff0000u); }
__device__ __forceinline__ float bf1(bf16_t b) { return __builtin_bit_cast(float, (unsigned)b << 16); }
__device__ __forceinline__ float fexp(float x) { return __builtin_amdgcn_exp2f(x * 1.4426950408889634f); }
#define LDS_BARRIER() do { asm volatile("s_waitcnt lgkmcnt(0)" ::: "memory"); __builtin_amdgcn_s_barrier(); asm volatile("" ::: "memory"); } while (0)
__device__ __forceinline__ float wave_sum(float v) {
#pragma unroll
    for (int o = 1; o < 64; o <<= 1) v += __shfl_xor(v, o);
    return v;
}
__device__ __forceinline__ float wave_max(float v) {
#pragma unroll
    for (int o = 1; o < 64; o <<= 1) v = fmaxf(v, __shfl_xor(v, o));
    return v;
}
__device__ __forceinline__ f32x4 mma16(bf16x8 a, bf16x8 b, f32x4 c) { return __builtin_amdgcn_mfma_f32_16x16x32_bf16(a, b, c, 0, 0, 0); }
__device__ __forceinline__ bf16x8 tr_read2(unsigned base, int off0, int off1) {
    u16x4 r0, r1;
    asm volatile("ds_read_b64_tr_b16 %0, %2 offset:%c3\n\tds_read_b64_tr_b16 %1, %2 offset:%c4\n\ts_waitcnt lgkmcnt(0)" : "=&v"(r0), "=&v"(r1) : "v"(base), "i"(off0), "i"(off1) : "memory");
    bf16x8 o; o[0] = (short)r0[0]; o[1] = (short)r0[1]; o[2] = (short)r0[2]; o[3] = (short)r0[3]; o[4] = (short)r1[0]; o[5] = (short)r1[1]; o[6] = (short)r1[2]; o[7] = (short)r1[3];
    return o;
}

__device__ __forceinline__ bf16x8 tr_join(u16x4 r0, u16x4 r1) { bf16x8 o; o[0] = (short)r0[0]; o[1] = (short)r0[1]; o[2] = (short)r0[2]; o[3] = (short)r0[3]; o[4] = (short)r1[0]; o[5] = (short)r1[1]; o[6] = (short)r1[2]; o[7] = (short)r1[3]; return o; }
#define TR_RD "ds_read_b64_tr_b16 "
#define TR_READ4(F0, F1, F2, F3, base, a0, a1, b0, b1, c0, c1, d0, d1) do { u16x4 t0_, t1_, t2_, t3_, t4_, t5_, t6_, t7_; \
    asm volatile(TR_RD "%0, %8 offset:%c9\n\t" TR_RD "%1, %8 offset:%c10\n\t" TR_RD "%2, %8 offset:%c11\n\t" TR_RD "%3, %8 offset:%c12\n\t" TR_RD "%4, %8 offset:%c13\n\t" TR_RD "%5, %8 offset:%c14\n\t" TR_RD "%6, %8 offset:%c15\n\t" TR_RD "%7, %8 offset:%c16\n\ts_waitcnt lgkmcnt(0)" \
        : "=&v"(t0_), "=&v"(t1_), "=&v"(t2_), "=&v"(t3_), "=&v"(t4_), "=&v"(t5_), "=&v"(t6_), "=&v"(t7_) : "v"(base), "i"(a0), "i"(a1), "i"(b0), "i"(b1), "i"(c0), "i"(c1), "i"(d0), "i"(d1) : "memory"); \
    F0 = tr_join(t0_, t1_); F1 = tr_join(t2_, t3_); F2 = tr_join(t4_, t5_); F3 = tr_join(t6_, t7_); } while (0)
#define TR_READ5(F0, F1, F2, F3, F4, base, a0, a1, b0, b1, c0, c1, d0, d1, e0, e1) do { u16x4 t0_, t1_, t2_, t3_, t4_, t5_, t6_, t7_, t8_, t9_; \
    asm volatile(TR_RD "%0, %10 offset:%c11\n\t" TR_RD "%1, %10 offset:%c12\n\t" TR_RD "%2, %10 offset:%c13\n\t" TR_RD "%3, %10 offset:%c14\n\t" TR_RD "%4, %10 offset:%c15\n\t" TR_RD "%5, %10 offset:%c16\n\t" TR_RD "%6, %10 offset:%c17\n\t" TR_RD "%7, %10 offset:%c18\n\t" TR_RD "%8, %10 offset:%c19\n\t" TR_RD "%9, %10 offset:%c20\n\ts_waitcnt lgkmcnt(0)" \
        : "=&v"(t0_), "=&v"(t1_), "=&v"(t2_), "=&v"(t3_), "=&v"(t4_), "=&v"(t5_), "=&v"(t6_), "=&v"(t7_), "=&v"(t8_), "=&v"(t9_) : "v"(base), "i"(a0), "i"(a1), "i"(b0), "i"(b1), "i"(c0), "i"(c1), "i"(d0), "i"(d1), "i"(e0), "i"(e1) : "memory"); \
    F0 = tr_join(t0_, t1_); F1 = tr_join(t2_, t3_); F2 = tr_join(t4_, t5_); F3 = tr_join(t6_, t7_); F4 = tr_join(t8_, t9_); } while (0)
__device__ __forceinline__ bf16x8 pack8(f32x4 a, f32x4 b) {
    u32x4 w; w.x = pk2(a[0], a[1]); w.y = pk2(a[2], a[3]); w.z = pk2(b[0], b[1]); w.w = pk2(b[2], b[3]);
    return __builtin_bit_cast(bf16x8, w);
}

namespace pg8 {
#define PG8_LAS __attribute__((address_space(3)))
typedef unsigned short bf16_t;
typedef short bf16x8 __attribute__((ext_vector_type(8)));
typedef float f32x4 __attribute__((ext_vector_type(4)));
typedef unsigned u32x4 __attribute__((ext_vector_type(4)));
constexpr int BM = 256, BK = 64, HALF = 128, HTB = HALF * BK * 2  , STAGE_BYTES = 8 * HTB, NXCD = 8, WGM = 8;

__host__ __device__ __forceinline__ int lds_byte(int r, int c) { const int st = (r >> 4) * 2 + (c >> 5), rr = r & 15, cc = c & 31, ob = rr * 64 + cc * 2; return st * 1024 + (ob ^ (((ob >> 9) & 1) << 5)); }
__host__ __device__ __forceinline__ void stage_rc(int b, int& R, int& C) { const int st = b / 1024, sb = b % 1024, swz = sb ^ (((sb >> 9) & 1) << 5); R = (st >> 1) * 16 + swz / 64; C = (st & 1) * 32 + (swz % 64) / 2; }
__host__ __device__ __forceinline__ int perm32(int rho) { const int n = rho >> 4, i = rho & 15; return 8 * (i >> 2) + 4 * n + (i & 3); }

struct Unit { int pm, pn; };
struct Gemm { const bf16_t* A; const bf16_t* Bt; int M, N, K; };

struct StaticOrder {
    int nM, nN, nwg, G, c;
    __host__ __device__ void init(int M, int N, int G_, int c_) { nM = M / BM; nN = N / BM; nwg = nM * nN; G = G_; c = c_; }
    __host__ __device__ bool next(int i, Unit& u) const {
        const long L = (long)i * G + c; if (L >= nwg) return false;
        int wgid = (int)L; { const int q = nwg / NXCD, r = nwg % NXCD, xcd = wgid % NXCD, off = wgid / NXCD; wgid = (xcd < r ? xcd * (q + 1) : r * (q + 1) + (xcd - r) * q) + off; }
        const int nig = WGM * nN, gid = wgid / nig, fm = gid * WGM, gsz = (nM - fm) < WGM ? (nM - fm) : WGM;
        u.pm = fm + ((wgid % nig) % gsz); u.pn = (wgid % nig) / gsz; return true;
    }
    __device__ __forceinline__ void a_ready(const Unit&) const {}
    __device__ __forceinline__ void done(const Unit&) const {}
};
__device__ __forceinline__ unsigned cvt_pk_bf16(float lo, float hi) { unsigned r; asm volatile("v_cvt_pk_bf16_f32 %0, %1, %2" : "=v"(r) : "v"(lo), "v"(hi)); return r; }

struct EpiStore {
    static constexpr bool PERM = true, AFTER_DRAIN = false;
    bf16_t* O; int ldc;
    __device__ __forceinline__ void operator()(const f32x4 (&acc)[2][2][4][2], const Unit& u, int wr, int wc, int fr, int fq) const {
        const int row0 = u.pm * BM + wr * 64 + fr, col0 = u.pn * BM + wc * 32 + 8 * fq;
#pragma unroll
        for (int ai = 0; ai < 2; ++ai)
#pragma unroll
            for (int m = 0; m < 4; ++m) { bf16_t* rowp = O + (size_t)(row0 + ai * HALF + m * 16) * ldc + col0;
#pragma unroll
                for (int bj = 0; bj < 2; ++bj) { const f32x4 v0 = acc[ai][bj][m][0], v1 = acc[ai][bj][m][1];
                    u32x4 w; w.x = cvt_pk_bf16(v0[0], v0[1]); w.y = cvt_pk_bf16(v0[2], v0[3]); w.z = cvt_pk_bf16(v1[0], v1[1]); w.w = cvt_pk_bf16(v1[2], v1[3]);
                    *(u32x4*)(rowp + bj * HALF) = w; } }
    }
};
struct EpiResid {
    static constexpr bool PERM = false, AFTER_DRAIN = false;
    const float* xin; float* out; int ldc; int mrows;
    __device__ __forceinline__ void operator()(const f32x4 (&acc)[2][2][4][2], const Unit& u, int wr, int wc, int fr, int fq) const {
        const int row0 = u.pm * BM + wr * 64 + fr, col0 = u.pn * BM + wc * 32 + 4 * fq;
#pragma unroll
        for (int ai = 0; ai < 2; ++ai)
#pragma unroll
            for (int m = 0; m < 4; ++m) { const int r = row0 + ai * HALF + m * 16;
                if (r < mrows) { const size_t off = (size_t)r * ldc + col0;
#pragma unroll
                    for (int bj = 0; bj < 2; ++bj)
#pragma unroll
                        for (int n = 0; n < 2; ++n) { const f32x4 bs = *(const f32x4*)(xin + off + bj * HALF + n * 16); *(f32x4*)(out + off + bj * HALF + n * 16) = bs + acc[ai][bj][m][n]; } }
                asm volatile("" ::: "memory"); }
    }
};


struct EpiStoreN {
    static constexpr bool PERM = true, AFTER_DRAIN = false;
    bf16_t* O; int ldc; const float* ssq; float eps; const PG8_LAS float* rs_tab; int rs_pm;
    __device__ __forceinline__ void operator()(const f32x4 (&acc)[2][2][4][2], const Unit& u, int wr, int wc, int fr, int fq) const {
        const int row0 = u.pm * BM + wr * 64 + fr, col0 = u.pn * BM + wc * 32 + 8 * fq;
        const bool cached = (u.pm == rs_pm);
#pragma unroll
        for (int ai = 0; ai < 2; ++ai)
#pragma unroll
            for (int m = 0; m < 4; ++m) { const int r = row0 + ai * HALF + m * 16;
                float rs;
                if (cached) rs = rs_tab[wr * 64 + fr + ai * HALF + m * 16];
                else { const f32x4 p0 = *(const f32x4*)(ssq + (size_t)r * 32 + 8 * fq), p1 = *(const f32x4*)(ssq + (size_t)r * 32 + 8 * fq + 4);
                    float s = ((p0[0] + p0[1]) + (p0[2] + p0[3])) + ((p1[0] + p1[1]) + (p1[2] + p1[3]));
                    s += __shfl_xor(s, 16); s += __shfl_xor(s, 32);
                    rs = rsqrtf(s * (1.f / 2048.f) + eps); }
                bf16_t* rowp = O + (size_t)r * ldc + col0;
#pragma unroll
                for (int bj = 0; bj < 2; ++bj) { const f32x4 v0 = acc[ai][bj][m][0] * rs, v1 = acc[ai][bj][m][1] * rs;
                    u32x4 w; w.x = cvt_pk_bf16(v0[0], v0[1]); w.y = cvt_pk_bf16(v0[2], v0[3]); w.z = cvt_pk_bf16(v1[0], v1[1]); w.w = cvt_pk_bf16(v1[2], v1[3]);
                    *(u32x4*)(rowp + bj * HALF) = w; } }
    }
};
__device__ __forceinline__ int first_pm(const StaticOrder& S) { const int wg0 = S.c; const int q = S.nwg / NXCD, r = S.nwg % NXCD, xcd = wg0 % NXCD, off = wg0 / NXCD; const int wgid = (xcd < r ? xcd * (q + 1) : r * (q + 1) + (xcd - r) * q) + off;
    const int nig = WGM * S.nN, gid = wgid / nig, fm = gid * WGM, gsz = (S.nM - fm) < WGM ? (S.nM - fm) : WGM; return fm + ((wgid % nig) % gsz); }
__device__ __forceinline__ void rstd_panel(PG8_LAS float* tab, const float* ssq, int pm, float eps, int tid) {
    const int row = tid >> 1, hf = tid & 1; const float* q = ssq + (size_t)(pm * BM + row) * 32 + 16 * hf;
    const f32x4 a = *(const f32x4*)q, b = *(const f32x4*)(q + 4), c = *(const f32x4*)(q + 8), d = *(const f32x4*)(q + 12);
    float s = (((a[0] + a[1]) + (a[2] + a[3])) + ((b[0] + b[1]) + (b[2] + b[3]))) + (((c[0] + c[1]) + (c[2] + c[3])) + ((d[0] + d[1]) + (d[2] + d[3])));
    s += __shfl_xor(s, 1);
    if (hf == 0) tab[row] = rsqrtf(s * (1.f / 2048.f) + eps);
    __syncthreads();
}
struct EpiResidN {
    static constexpr bool PERM = false, AFTER_DRAIN = false;
    bf16_t* xb; float* fin; float* ssq; int ldc;
    __device__ __forceinline__ void operator()(const f32x4 (&acc)[2][2][4][2], const Unit& u, int wr, int wc, int fr, int fq) const {
        const int row0 = u.pm * BM + wr * 64 + fr, col0 = u.pn * BM + wc * 32 + 4 * fq;
#pragma unroll
        for (int ai = 0; ai < 2; ++ai)
#pragma unroll
            for (int m = 0; m < 4; ++m) { const int r = row0 + ai * HALF + m * 16; const size_t off = (size_t)r * ldc + col0; float sq = 0.f;
#pragma unroll
                for (int bj = 0; bj < 2; ++bj)
#pragma unroll
                    for (int n = 0; n < 2; ++n) { const u32x2 xw = *(const u32x2*)(xb + off + bj * HALF + n * 16);
                        f32x4 v = acc[ai][bj][m][n];
                        v[0] += __builtin_bit_cast(float, xw.x << 16); v[1] += __builtin_bit_cast(float, xw.x & 0xffff0000u); v[2] += __builtin_bit_cast(float, xw.y << 16); v[3] += __builtin_bit_cast(float, xw.y & 0xffff0000u);
                        if (fin) *(f32x4*)(fin + off + bj * HALF + n * 16) = v;
                        else { u32x2 w; w.x = cvt_pk_bf16(v[0], v[1]); w.y = cvt_pk_bf16(v[2], v[3]); *(u32x2*)(xb + off + bj * HALF + n * 16) = w; }
                        sq += (v[0] * v[0] + v[1] * v[1]) + (v[2] * v[2] + v[3] * v[3]); }
                if (ssq) { sq += __shfl_xor(sq, 16); sq += __shfl_xor(sq, 32); if (fq == 0) ssq[(size_t)r * 32 + u.pn * 4 + wc] = sq; }
                if (m == 3) asm volatile("" ::: "memory"); }
    }
};
template <class Epi, class Sched, bool ALIGN_EPI = false, bool SP2 = false>
__device__ __forceinline__ void gemm_phase(PG8_LAS unsigned char* lds, const Gemm g, const Sched& S, const Epi& E) {
    int tid = threadIdx.x; asm volatile("" : "+v"(tid));
    const int wid = __builtin_amdgcn_readfirstlane(tid >> 6), lane = tid & 63, wr = wid >> 2, wc = wid & 3, fr = lane & 15, fq = lane >> 4;
    const int K = g.K, nt = K / BK;
    unsigned voffA[2], voffB[2];
#pragma unroll
    for (int i = 0; i < 2; ++i) { int R, C; stage_rc(tid * 16 + i * 8192, R, C); const int Rb = Epi::PERM ? ((R & ~31) + perm32(R & 31)) : R;
        voffA[i] = (unsigned)(R * K + C) * 2u; voffB[i] = (unsigned)(Rb * K + C) * 2u; }
    const size_t kstep = (size_t)(BK * 2);
    const size_t hstep = (size_t)HALF * K * 2;
    const size_t tstep = 2 * hstep;
    const unsigned ldsw = (unsigned)wid * 1024u;
    const int aoff = lds_byte(wr * 64 + fr, fq * 8), boff = lds_byte(wc * 32 + fr, fq * 8);
#define PG8_SA(b, h) (((b) * 2 + (h)) * HTB)
#define PG8_SB(b, h) ((4 + (b) * 2 + (h)) * HTB)
#define PG8_STAGE(bufoff, gbase, voff) do { _Pragma("unroll") for (int _i = 0; _i < 2; ++_i) \
        __builtin_amdgcn_global_load_lds((const unsigned*)((const char*)(gbase) + (voff)[_i]), (PG8_LAS unsigned*)(lds + (bufoff) + ldsw + _i * 8192), 16, 0, 0); } while (0)
#define PG8_LDA(dst, b, h) do { _Pragma("unroll") for (int m = 0; m < 4; ++m) _Pragma("unroll") for (int k = 0; k < 2; ++k) dst[m][k] = *(const PG8_LAS bf16x8*)(lds + PG8_SA(b, h) + aoff + m * 2048 + k * 1024); } while (0)
#define PG8_LDB(dst, b, h) do { _Pragma("unroll") for (int n = 0; n < 2; ++n) _Pragma("unroll") for (int k = 0; k < 2; ++k) dst[n][k] = *(const PG8_LAS bf16x8*)(lds + PG8_SB(b, h) + boff + n * 2048 + k * 1024); } while (0)
#define PG8_MMA(ai, bj, At, Bt) do { __builtin_amdgcn_s_setprio(1); _Pragma("unroll") for (int m = 0; m < 4; ++m) _Pragma("unroll") for (int n = 0; n < 2; ++n) _Pragma("unroll") for (int k = 0; k < 2; ++k) \
        acc[ai][bj][m][n] = __builtin_amdgcn_mfma_f32_16x16x32_bf16(Bt[n][k], At[m][k], acc[ai][bj][m][n], 0, 0, 0); __builtin_amdgcn_s_setprio(0); } while (0)
#define PG8_WAIT_V(n) asm volatile("s_waitcnt vmcnt(" #n ")" ::: "memory")
#define PG8_WAIT_L(n) asm volatile("s_waitcnt lgkmcnt(" #n ")" ::: "memory")
#define PG8_BAR __builtin_amdgcn_s_barrier()
#define PG8_SCHED __builtin_amdgcn_sched_barrier(0)
    Unit cur, nxt; int ui = 0;
    if (!S.next(0, cur)) return;
    f32x4 acc[2][2][4][2];
#pragma unroll
    for (int a = 0; a < 2; ++a)
#pragma unroll
        for (int b = 0; b < 2; ++b)
#pragma unroll
            for (int m = 0; m < 4; ++m)
#pragma unroll
                for (int n = 0; n < 2; ++n) acc[a][b][m][n] = (f32x4){0.f, 0.f, 0.f, 0.f};
    bf16x8 At[4][2], B0[2][2], B1[2][2];
    const char* cA = (const char*)g.A + (size_t)cur.pm * tstep; const char* cB = (const char*)g.Bt + (size_t)cur.pn * tstep;
    S.a_ready(cur);
    if constexpr (SP2) {
        PG8_STAGE(PG8_SB(0, 0), cB, voffB); PG8_STAGE(PG8_SB(0, 1), cB + hstep, voffB); PG8_STAGE(PG8_SA(0, 0), cA, voffA); PG8_STAGE(PG8_SA(0, 1), cA + hstep, voffA);
        if (wr == 1) PG8_BAR;
        PG8_WAIT_V(2); PG8_BAR;
        PG8_STAGE(PG8_SB(1, 0), cB + kstep, voffB); PG8_STAGE(PG8_SA(1, 0), cA + kstep, voffA); PG8_STAGE(PG8_SB(1, 1), cB + hstep + kstep, voffB);
        PG8_WAIT_V(6); PG8_BAR;
    } else {
        PG8_STAGE(PG8_SB(0, 0), cB, voffB); PG8_STAGE(PG8_SA(0, 0), cA, voffA); PG8_STAGE(PG8_SB(0, 1), cB + hstep, voffB); PG8_STAGE(PG8_SA(0, 1), cA + hstep, voffA);
        if (wr == 1) PG8_BAR;
        PG8_WAIT_V(4); PG8_BAR;
        PG8_STAGE(PG8_SB(1, 0), cB + kstep, voffB); PG8_STAGE(PG8_SA(1, 0), cA + kstep, voffA); PG8_STAGE(PG8_SB(1, 1), cB + hstep + kstep, voffB);
        PG8_WAIT_V(6); PG8_BAR;
    }
    for (;;) {
        const bool has_next = S.next(ui + 1, nxt);
        const char* nA = has_next ? (const char*)g.A + (size_t)nxt.pm * tstep : cA; const char* nB = has_next ? (const char*)g.Bt + (size_t)nxt.pn * tstep : cB;
        for (int t = 0; t < nt; t += 2) {
            const bool last = (t == nt - 2);
            const char* a1 = cA + (size_t)(t + 1) * kstep;
            const char* a2 = last ? nA : cA + (size_t)(t + 2) * kstep; const char* b2 = last ? nB : cB + (size_t)(t + 2) * kstep;
            const char* a3 = a2 + kstep; const char* b3 = b2 + kstep;
            if (last && has_next) S.a_ready(nxt);
            if constexpr (SP2) {
            PG8_LDB(B0, 0, 0); PG8_LDB(B1, 0, 1); PG8_SCHED; PG8_LDA(At, 0, 0); PG8_STAGE(PG8_SA(1, 1), a1 + hstep, voffA);
            PG8_WAIT_V(8); PG8_WAIT_L(0); PG8_BAR; PG8_MMA(0, 0, At, B0); PG8_MMA(0, 1, At, B1); PG8_BAR; PG8_SCHED;
            PG8_LDA(At, 0, 1); PG8_STAGE(PG8_SB(0, 0), b2, voffB); PG8_STAGE(PG8_SB(0, 1), b2 + hstep, voffB); PG8_STAGE(PG8_SA(0, 0), a2, voffA);
            PG8_WAIT_V(8); PG8_WAIT_L(0); PG8_BAR; PG8_MMA(1, 0, At, B0); PG8_MMA(1, 1, At, B1); PG8_BAR; PG8_SCHED;
            PG8_LDB(B0, 1, 0); PG8_LDB(B1, 1, 1); PG8_SCHED; PG8_LDA(At, 1, 0); PG8_STAGE(PG8_SA(0, 1), a2 + hstep, voffA);
            PG8_WAIT_V(8); PG8_WAIT_L(0); PG8_BAR; PG8_MMA(0, 0, At, B0); PG8_MMA(0, 1, At, B1); PG8_BAR; PG8_SCHED;
            PG8_LDA(At, 1, 1); PG8_STAGE(PG8_SB(1, 0), b3, voffB); PG8_STAGE(PG8_SB(1, 1), b3 + hstep, voffB); PG8_STAGE(PG8_SA(1, 0), a3, voffA);
            PG8_WAIT_V(8); PG8_WAIT_L(0); PG8_BAR; PG8_MMA(1, 0, At, B0); PG8_MMA(1, 1, At, B1); PG8_BAR; PG8_SCHED;
            } else {
            PG8_LDB(B0, 0, 0); PG8_SCHED; PG8_LDA(At, 0, 0); PG8_STAGE(PG8_SA(1, 1), a1 + hstep, voffA);
            PG8_WAIT_L(8); PG8_BAR; PG8_WAIT_L(0); PG8_MMA(0, 0, At, B0); PG8_BAR; PG8_SCHED;
            PG8_LDB(B1, 0, 1); PG8_STAGE(PG8_SB(0, 0), b2, voffB);
            PG8_BAR; PG8_WAIT_L(0); PG8_MMA(0, 1, At, B1); PG8_BAR;
            PG8_LDA(At, 0, 1); PG8_STAGE(PG8_SA(0, 0), a2, voffA);
            PG8_BAR; PG8_WAIT_L(0); PG8_MMA(1, 0, At, B0); PG8_BAR; PG8_SCHED;
            PG8_STAGE(PG8_SB(0, 1), b2 + hstep, voffB);
            PG8_WAIT_V(6); PG8_BAR; PG8_MMA(1, 1, At, B1); PG8_BAR;
            PG8_LDB(B0, 1, 0); PG8_SCHED; PG8_LDA(At, 1, 0); PG8_STAGE(PG8_SA(0, 1), a2 + hstep, voffA);
            PG8_WAIT_L(8); PG8_BAR; PG8_WAIT_L(0); PG8_MMA(0, 0, At, B0); PG8_BAR; PG8_SCHED;
            PG8_LDB(B1, 1, 1); PG8_STAGE(PG8_SB(1, 0), b3, voffB);
            PG8_BAR; PG8_WAIT_L(0); PG8_MMA(0, 1, At, B1); PG8_BAR;
            PG8_LDA(At, 1, 1); PG8_STAGE(PG8_SA(1, 0), a3, voffA);
            PG8_BAR; PG8_WAIT_L(0); PG8_MMA(1, 0, At, B0); PG8_BAR; PG8_SCHED;
            PG8_STAGE(PG8_SB(1, 1), b3 + hstep, voffB);
            PG8_WAIT_V(6); PG8_BAR; PG8_MMA(1, 1, At, B1); PG8_BAR;
            }
        }
        if constexpr (ALIGN_EPI) { if (wr == 0) PG8_BAR; }
        if constexpr (!Epi::AFTER_DRAIN) { E(acc, cur, wr, wc, fr, fq); S.done(cur); }
        if (!has_next) break;
#pragma unroll
        for (int a = 0; a < 2; ++a)
#pragma unroll
            for (int b = 0; b < 2; ++b)
#pragma unroll
                for (int m = 0; m < 4; ++m)
#pragma unroll
                    for (int n = 0; n < 2; ++n) acc[a][b][m][n] = (f32x4){0.f, 0.f, 0.f, 0.f};
        cur = nxt; cA = nA; cB = nB; ++ui;
        if constexpr (ALIGN_EPI) { if (wr == 1) PG8_BAR; }
    }
    PG8_WAIT_V(0);
    if constexpr (!ALIGN_EPI) { if (wr == 0) PG8_BAR; }
    PG8_BAR;
    if constexpr (Epi::AFTER_DRAIN) { E.fused(acc, cur, wr, wc, fr, fq, lds, wid, lane); S.done(cur); }
#undef PG8_SA
#undef PG8_SB
#undef PG8_STAGE
#undef PG8_LDA
#undef PG8_LDB
#undef PG8_MMA
#undef PG8_WAIT_V
#undef PG8_WAIT_L
#undef PG8_BAR
#undef PG8_SCHED
}
}
#define XB_TMO      128
#define XB_XCNT(j)  (256  + 64 * (j))
#define XB_XSUB(j)  (1280 + 64 * (j))
#define XB_XGEN(j)  (2304 + 64 * (j))
#define XB_TOP      3328
#define XB_TOPGEN   3392
#define XCD_BAR_WORDS 3456
#define XB_SPIN_CAP (1u << 18)

__device__ __forceinline__ unsigned xb_ld(unsigned* p)              { return __hip_atomic_load(p, __ATOMIC_RELAXED, __HIP_MEMORY_SCOPE_AGENT); }
__device__ __forceinline__ unsigned xb_add(unsigned* p, unsigned v) { return __hip_atomic_fetch_add(p, v, __ATOMIC_RELAXED, __HIP_MEMORY_SCOPE_AGENT); }
__device__ __forceinline__ unsigned xb_xcc_id() { return (unsigned)__builtin_amdgcn_s_getreg((3 << 11) | 20) & 0xFu; }
#define XB_SPIN(cond, bar) do { unsigned _sp = 0; while (cond) { __builtin_amdgcn_s_sleep(1); \
    if ((++_sp & 255u) == 0u) { if (xb_ld(&(bar)[XB_TMO])) break; if (_sp > XB_SPIN_CAP) { atomicAdd(&(bar)[XB_TMO], 1u); break; } } } } while (0)

struct XcdBarrier {
    unsigned* bar; unsigned x;
    volatile LAS unsigned* st;
};

__device__ __forceinline__ XcdBarrier xcd_barrier_post(unsigned* bar, volatile LAS unsigned* st) {
    XcdBarrier b; b.bar = bar; b.x = xb_xcc_id(); b.st = st;
    if (threadIdx.x == 0) (void)xb_add(&bar[XB_XCNT(b.x)], 1u);
    return b;
}
__device__ __forceinline__ void xcd_barrier_complete(unsigned* bar, unsigned x, unsigned& nloc, unsigned& nx) {
    const unsigned G = gridDim.x * gridDim.y * gridDim.z;
    unsigned sum, cnt, mine, sp = 0u;
    for (;;) {
        sum = 0u; cnt = 0u; mine = 0u;
#pragma unroll
        for (unsigned j = 0; j < 16; ++j) { const unsigned c = xb_ld(&bar[XB_XCNT(j)]); sum += c; cnt += (c > 0u) ? 1u : 0u; mine = (j == x) ? c : mine; }
        if (sum == G) break;
        __builtin_amdgcn_s_sleep(1);
        if ((++sp & 255u) == 0u) { if (xb_ld(&bar[XB_TMO])) break; if (sp > XB_SPIN_CAP) { atomicAdd(&bar[XB_TMO], 1u); break; } }
    }
    nloc = mine > 0u ? mine : 1u; nx = cnt > 0u ? cnt : 1u;
}

__device__ __forceinline__ void xcd_barrier(const XcdBarrier& b) {
    asm volatile("s_waitcnt vmcnt(0)" ::: "memory");
    __syncthreads();
    if (threadIdx.x == 0) {
        unsigned* bar = b.bar;
        __builtin_amdgcn_s_waitcnt(0);
        unsigned nloc = b.st[0], nx = b.st[1];
        if (nloc == 0u) { xcd_barrier_complete(bar, b.x, nloc, nx); b.st[0] = nloc; b.st[1] = nx; }
        const unsigned old = xb_add(&bar[XB_XSUB(b.x)], 1u);
        const unsigned gen = old / nloc;
        if (old + 1u == (gen + 1u) * nloc) {
            __builtin_amdgcn_fence(__ATOMIC_RELEASE, "agent");
            asm volatile("s_waitcnt vmcnt(0)" ::: "memory");
            const unsigned og = xb_add(&bar[XB_TOP], 1u);
            const unsigned tg = og / nx;
            if (og + 1u == (tg + 1u) * nx) xb_add(&bar[XB_TOPGEN], 1u);
            else XB_SPIN(xb_ld(&bar[XB_TOPGEN]) == tg, bar);
            __builtin_amdgcn_fence(__ATOMIC_ACQUIRE, "agent");
            xb_add(&bar[XB_XGEN(b.x)], 1u);
            asm volatile("s_waitcnt vmcnt(0)" ::: "memory");
        } else {
            XB_SPIN(xb_ld(&bar[XB_XGEN(b.x)]) == gen, bar);
            __builtin_amdgcn_fence(__ATOMIC_ACQUIRE, "agent");
            asm volatile("s_waitcnt vmcnt(0)" ::: "memory");
        }
    }
    __syncthreads();
}

struct Params { const float* in[23]; float* out; unsigned char* ws; };

__device__ __forceinline__ void p0_transpose_item(const float* W, int ldw, int K, int N, bf16_t* WT, int item, int lane, float scale, const float* gk, bool pair_perm = false) {
    const int nblk = N / 64, kb = item / nblk, nb = item % nblk, i16 = lane & 15, q4 = lane >> 4;
    const int n0 = 64 * nb + 4 * i16;
    const int ns0 = (pair_perm ? ((nb >> 1) & 1) * DFF + 128 * (nb >> 2) + 64 * (nb & 1) : 64 * nb) + 4 * i16;
#pragma unroll
    for (int pass = 0; pass < 2; ++pass) {
        const int kk0 = 64 * kb + 32 * pass + 8 * q4;
        const float* src = W + (size_t)kk0 * ldw + ns0;
        f32x4 v[8];
#pragma unroll
        for (int i = 0; i < 8; ++i) v[i] = *(const f32x4*)(src + (size_t)i * ldw);
        f32x4 g0 = {scale, scale, scale, scale}, g1 = g0;
        if (gk) { g0 = *(const f32x4*)(gk + kk0) * scale; g1 = *(const f32x4*)(gk + kk0 + 4) * scale; }
#pragma unroll
        for (int j = 0; j < 4; ++j) { u32x4 o;
            o.x = pk2(v[0][j] * g0[0], v[1][j] * g0[1]); o.y = pk2(v[2][j] * g0[2], v[3][j] * g0[3]); o.z = pk2(v[4][j] * g1[0], v[5][j] * g1[1]); o.w = pk2(v[6][j] * g1[2], v[7][j] * g1[3]);
            *(u32x4*)(WT + (size_t)(n0 + j) * K + kk0) = o; }
    }
}

__device__ __forceinline__ void phase_prologue(const Params& P, LAS unsigned char* lds, int gw, int NGW, int wave, int lane) {
    constexpr int I_QKV = (DM / 64) * (NQKV / 64), I_WO = (DO / 64) * (DM / 64), I_WIN = (DM / 64) * (NIN / 64), I_WOUT = (DM / 64) * (DM / 64), I_WUP = (DM / 64) * (NUP / 64), I_WDN = (DFF / 64) * (DM / 64);
    constexpr int T0 = 2 * I_QKV, T1 = T0 + 2 * I_WO, T2 = T1 + 2 * I_WIN, T3 = T2 + 2 * I_WOUT, T4 = T3 + 4 * I_WUP, T5 = T4 + 4 * I_WDN;
    unsigned char* ws = P.ws;
    for (int it = gw; it < T5; it += NGW) {
        if (it < T0) { const int l = it / I_QKV, r = it % I_QKV; p0_transpose_item(P.in[11] + (size_t)l * DM * NQKV, NQKV, DM, NQKV, (bf16_t*)(ws + WS_WQKV + l * SZ_WQKV), r, lane, 1.f, P.in[9] + (size_t)(2 * l) * DM); }
        else if (it < T1) { const int q = it - T0, l = q / I_WO, r = q % I_WO; p0_transpose_item(P.in[14] + (size_t)l * DO * DM, DM, DO, DM, (bf16_t*)(ws + WS_WO + l * SZ_WO), r, lane, 1.f, nullptr); }
        else if (it < T2) { const int q = it - T1, l = q / I_WIN, r = q % I_WIN; const int nb = r % (NIN / 64);
            const float sc = (nb >= 16 && nb < 32) ? 0.08838834764831845f : 1.f;
            p0_transpose_item(P.in[15] + (size_t)l * DM * NIN_SRC, NIN_SRC, DM, NIN, (bf16_t*)(ws + WS_WIN + l * SZ_WIN), r, lane, sc, P.in[9] + (size_t)(2 * l + 1) * DM); }
        else if (it < T3) { const int q = it - T2, l = q / I_WOUT, r = q % I_WOUT; p0_transpose_item(P.in[18] + (size_t)l * DM * DM, DM, DM, DM, (bf16_t*)(ws + WS_WOUT + l * SZ_WOUT), r, lane, 1.f, nullptr); }
        else if (it < T4) { const int q = it - T3, l = q / I_WUP, r = q % I_WUP; p0_transpose_item(P.in[19] + (size_t)l * DM * NUP, NUP, DM, NUP, (bf16_t*)(ws + WS_WUP + l * SZ_WUP), r, lane, 1.f, P.in[10] + (size_t)l * DM, true); }
        else { const int q = it - T4, l = q / I_WDN, r = q % I_WDN; p0_transpose_item(P.in[22] + (size_t)l * DFF * DM, DM, DFF, DM, (bf16_t*)(ws + WS_WDOWN + l * SZ_WDOWN), r, lane, 1.f, nullptr); }
    }
    { const int gt = gw * 64 + lane, NT = NGW * 64;
      float* rope = (float*)(ws + WS_ROPE);
      for (int i = gt; i < 2052 * 64; i += NT) { const int pi = i >> 6, f = i & 63; const int pos = (pi < SEQ) ? pi : PAST + (pi - SEQ);
          const float invf = powf(10000.f, -(float)f * (1.f / 64.f)); const float ang = (float)pos * invf; float sn, cs; sincosf(ang, &sn, &cs); rope[2 * i] = cs; rope[2 * i + 1] = sn; }
      f32x4* wgp = (f32x4*)(ws + WS_WGP);
      for (int i = gt; i < 2 * 128 * 64; i += NT) { const int l = i >> 13, kb = (i >> 6) & 127, ln = i & 63, col = ln & 15, kq = ln >> 4, k = 16 * kb + 4 * kq;
          const float* w = P.in[15] + (size_t)l * DM * NIN_SRC + (size_t)k * NIN_SRC + NIN + col; const float* g = P.in[9] + (size_t)(2 * l + 1) * DM + k;
          wgp[i] = (f32x4){g[0] * w[0], g[1] * w[NIN_SRC], g[2] * w[2 * NIN_SRC], g[3] * w[3 * NIN_SRC]}; } }
    for (int r = gw; r < MR; r += NGW) {
        const f32x4* xr = (const f32x4*)((r < MP) ? P.in[0] + (size_t)r * DM : P.in[1] + (size_t)(r - MP) * DM) + lane;
        u32x2* xb = (u32x2*)(ws + WS_XB) + (size_t)r * (DM / 4) + lane;
        float s = 0.f;
#pragma unroll
        for (int j = 0; j < 8; ++j) { const f32x4 v = xr[64 * j]; u32x2 w; w.x = pk2(v.x, v.y); w.y = pk2(v.z, v.w); xb[64 * j] = w; s += (v.x * v.x + v.y * v.y) + (v.z * v.z + v.w * v.w); }
        s = wave_sum(s);
        if (r < MP) { if (lane < 32) ((float*)(ws + WS_SSQ))[(size_t)r * 32 + lane] = (lane == 0) ? s : 0.f; }
        else { float* q = (float*)(ws + WS_SSQS) + (size_t)(r - MP) * 128; q[lane] = (lane == 0) ? s : 0.f; q[64 + lane] = 0.f; }
    }
}

__device__ __forceinline__ void gate_block(LAS unsigned char* lds, const bf16_t* X, const f32x4* WGP, const float* bg, float* GATES, int task, int wave, int lane) {
    const int r0 = task * 16, i16 = lane & 15, kq = lane >> 4;
    const bf16_t* xr = X + (size_t)(r0 + i16) * DM + 256 * wave + 4 * kq;
    const f32x4* wp = WGP + (size_t)(16 * wave) * 64 + lane;
    f32x4 acc = {0.f, 0.f, 0.f, 0.f}; float ss = 0.f;
#pragma unroll
    for (int j = 0; j < 16; ++j) {
        const u32x2 xw = *(const u32x2*)(xr + 16 * j); const f32x4 xv = {bflo(xw.x), bfhi(xw.x), bflo(xw.y), bfhi(xw.y)}, wv = wp[64 * j];
        ss += (xv.x * xv.x + xv.y * xv.y) + (xv.z * xv.z + xv.w * xv.w);
        acc = __builtin_amdgcn_mfma_f32_16x16x4f32(xv.x, wv.x, acc, 0, 0, 0);
        acc = __builtin_amdgcn_mfma_f32_16x16x4f32(xv.y, wv.y, acc, 0, 0, 0);
        acc = __builtin_amdgcn_mfma_f32_16x16x4f32(xv.z, wv.z, acc, 0, 0, 0);
        acc = __builtin_amdgcn_mfma_f32_16x16x4f32(xv.w, wv.w, acc, 0, 0, 0);
    }
    LAS f32x4* gp = (LAS f32x4*)lds; LAS float* sp = (LAS float*)(lds + 8192);
    __syncthreads();
    gp[wave * 64 + lane] = acc; sp[wave * 64 + lane] = ss;
    __syncthreads();
    if (wave == 0) {
        f32x4 a = gp[lane]; float s = sp[lane];
#pragma unroll
        for (int w = 1; w < 8; ++w) { a += gp[w * 64 + lane]; s += sp[w * 64 + lane]; }
        s += __shfl_xor(s, 16); s += __shfl_xor(s, 32);
        const float rstd = rsqrtf(s * (1.f / DM) + EPS);
        const float bias = bg[i16];
#pragma unroll
        for (int i = 0; i < 4; ++i) {
            const float rs = __shfl(rstd, 4 * kq + i);
            const float pre = a[i] * rs + bias;
            const float gc = 15.f * tanhf(pre * (1.f / 15.f));
            const float val = (i16 < 8) ? gc : (fminf(gc, 0.f) - log1pf(fexp(-fabsf(gc))));
            GATES[(size_t)(r0 + 4 * kq + i) * 16 + i16] = val;
        }
    }
}

constexpr int SK_PART = 0, SK_RSTD = 16384;
template <int MODE>
__device__ __forceinline__ void skinny_phase(LAS unsigned char* lds, const bf16_t* A, int K, const bf16_t* Bt, int N, bf16_t* Ob, int ldo, bf16_t* XBs, float* SSQS, float* Os, int c, int G, int nIdle, int tid, int wave, int lane) {
    const int i16 = lane & 15, q4 = lane >> 4;
    if (c < G - nIdle) return;
    LAS f32x4* part = (LAS f32x4*)(lds + SK_PART); LAS float* rstdS = (LAS float*)(lds + SK_RSTD);
    __syncthreads();
    if (MODE == 0) { const int row = tid >> 4, sub = tid & 15; const float* q = SSQS + row * 128 + 8 * sub;
        const f32x4 a = *(const f32x4*)q, b = *(const f32x4*)(q + 4); float s = ((a[0] + a[1]) + (a[2] + a[3])) + ((b[0] + b[1]) + (b[2] + b[3]));
        s += __shfl_xor(s, 1); s += __shfl_xor(s, 2); s += __shfl_xor(s, 4); s += __shfl_xor(s, 8);
        if (sub == 0) rstdS[row] = rsqrtf(s * (1.f / 2048.f) + EPS);
        __syncthreads(); }
    const int kper = K >> 3, nks = kper >> 5, k0 = wave * kper;
    for (int j = G - 1 - c; j < (N >> 4); j += nIdle) {
        f32x4 acc0 = {0.f, 0.f, 0.f, 0.f}, acc1 = {0.f, 0.f, 0.f, 0.f};
        const bf16_t* bp = Bt + (size_t)(16 * j + i16) * K + k0 + 8 * q4; const bf16_t* ap = A + (size_t)i16 * K + k0 + 8 * q4;
#pragma unroll 4
        for (int ks = 0; ks < nks; ++ks) { const bf16x8 bf = *(const bf16x8*)(bp + 32 * ks), a0 = *(const bf16x8*)(ap + 32 * ks), a1 = *(const bf16x8*)(ap + (size_t)16 * K + 32 * ks);
            acc0 = mma16(a0, bf, acc0); acc1 = mma16(a1, bf, acc1); }
        part[(wave * 2 + 0) * 64 + lane] = acc0; part[(wave * 2 + 1) * 64 + lane] = acc1;
        __syncthreads();
        if (wave < 2) {
            f32x4 s = part[wave * 64 + lane];
#pragma unroll
            for (int w = 1; w < 8; ++w) s += part[(w * 2 + wave) * 64 + lane];
            const int col = 16 * j + i16;
#pragma unroll
            for (int i = 0; i < 4; ++i) { const int r = 16 * wave + 4 * q4 + i;
                if (MODE == 0) Ob[(size_t)r * ldo + col] = (bf16_t)f2bf(s[i] * rstdS[r]);
                else if (MODE == 1) { const float xo = bf1(XBs[(size_t)r * DM + col]) + s[i]; XBs[(size_t)r * DM + col] = (bf16_t)f2bf(xo);
                    float sq = xo * xo; sq += __shfl_xor(sq, 1); sq += __shfl_xor(sq, 2); sq += __shfl_xor(sq, 4); sq += __shfl_xor(sq, 8);
                    if (i16 == 0) SSQS[r * 128 + j] = sq; }
                else Os[(size_t)r * DM + col] = bf1(XBs[(size_t)r * DM + col]) + s[i]; }
        }
        __syncthreads();
    }
}

__device__ __forceinline__ void prep_row(bf16_t* QKV, const float* rope, const float* qg, const float* kg, float* out, int ia, int r, int lane) {
    const int hh = lane >> 3, sub = lane & 7;
    const bool samp = r >= MP;
    const int b = samp ? ((r - MP) >> 2) : (r >> 11), s = samp ? ((r - MP) & 3) : (r & 2047);
    float cs[8], sn[8];
    { const f32x4* rp = (const f32x4*)(rope + ((size_t)(samp ? SEQ + s : s) * 64 + 8 * sub) * 2);
      const f32x4 t0 = rp[0], t1 = rp[1], t2 = rp[2], t3 = rp[3];
      cs[0] = t0[0]; sn[0] = t0[1]; cs[1] = t0[2]; sn[1] = t0[3]; cs[2] = t1[0]; sn[2] = t1[1]; cs[3] = t1[2]; sn[3] = t1[3];
      cs[4] = t2[0]; sn[4] = t2[1]; cs[5] = t2[2]; sn[5] = t2[3]; cs[6] = t3[0]; sn[6] = t3[1]; cs[7] = t3[2]; sn[7] = t3[3]; }
#pragma unroll 1
    for (int g = 0; g < 3; ++g) {
        const int win = 128 << (2 * g);
#pragma unroll
        for (int t = 0; t < 3; ++t) {
            bf16_t* p = QKV + (size_t)r * NQKV + ((g * 3 + t) * 8 + hh) * 128;
            const u32x4 w0 = *(const u32x4*)(p + 8 * sub), w1 = *(const u32x4*)(p + 64 + 8 * sub);
            float x1[8], x2[8];
            x1[0] = bflo(w0.x); x1[1] = bfhi(w0.x); x1[2] = bflo(w0.y); x1[3] = bfhi(w0.y); x1[4] = bflo(w0.z); x1[5] = bfhi(w0.z); x1[6] = bflo(w0.w); x1[7] = bfhi(w0.w);
            x2[0] = bflo(w1.x); x2[1] = bfhi(w1.x); x2[2] = bflo(w1.y); x2[3] = bfhi(w1.y); x2[4] = bflo(w1.z); x2[5] = bfhi(w1.z); x2[6] = bflo(w1.w); x2[7] = bfhi(w1.w);
            if (t < 2) {
                float ss = 0.f;
#pragma unroll
                for (int j = 0; j < 8; ++j) ss += x1[j] * x1[j] + x2[j] * x2[j];
                ss += __shfl_xor(ss, 1); ss += __shfl_xor(ss, 2); ss += __shfl_xor(ss, 4);
                const float rstd = rsqrtf(ss * (1.f / 128.f) + EPS);
                const float* gn = (t == 0) ? qg : kg;
#pragma unroll
                for (int j = 0; j < 8; ++j) { const float y1 = x1[j] * rstd * gn[8 * sub + j], y2 = x2[j] * rstd * gn[64 + 8 * sub + j];
                    x1[j] = y1 * cs[j] - y2 * sn[j]; x2[j] = y2 * cs[j] + y1 * sn[j]; }
                u32x4 o0, o1;
                o0.x = pk2(x1[0], x1[1]); o0.y = pk2(x1[2], x1[3]); o0.z = pk2(x1[4], x1[5]); o0.w = pk2(x1[6], x1[7]);
                o1.x = pk2(x2[0], x2[1]); o1.y = pk2(x2[2], x2[3]); o1.z = pk2(x2[4], x2[5]); o1.w = pk2(x2[6], x2[7]);
                *(u32x4*)(p + 8 * sub) = o0; *(u32x4*)(p + 64 + 8 * sub) = o1;
            }
            if (t >= 1) {
                const int kv = t - 1;
                const size_t obase = (g == 0) ? (samp ? O_KV128S : O_KV128P) : (g == 1) ? (samp ? O_KV512S : O_KV512P) : (samp ? O_KV2048S : O_KV2048P);
                const int j = samp ? (win - TSAMP + s) : (s - (SEQ - win));
                if (j >= 0) {
                    const int nb = samp ? NBS : NBP;
                    float* dst = out + obase + ((((size_t)(ia * nb + b) * win + j) * 2 + kv) * 8 + hh) * 128;
                    *(f32x4*)(dst + 8 * sub) = (f32x4){x1[0], x1[1], x1[2], x1[3]}; *(f32x4*)(dst + 8 * sub + 4) = (f32x4){x1[4], x1[5], x1[6], x1[7]};
                    *(f32x4*)(dst + 64 + 8 * sub) = (f32x4){x2[0], x2[1], x2[2], x2[3]}; *(f32x4*)(dst + 64 + 8 * sub + 4) = (f32x4){x2[4], x2[5], x2[6], x2[7]};
                }
            }
        }
    }
}

constexpr int AT_PITCH = 272, AT_KOFF = 0, AT_VOFF = 256 * AT_PITCH;
struct AttnItem { int g, b, h, dil, r, qb; };
__device__ __forceinline__ AttnItem attn_decode(int item) {
    AttnItem a; a.g = item >> 9; const int rem = item & 511, idx = rem & 15; a.b = rem >> 7; a.h = (rem >> 4) & 7;
    a.dil = (a.g == 0) ? 1 : (a.g == 1) ? 4 : 16; a.r = (a.g == 0) ? 0 : (a.g == 1) ? (idx >> 2) : idx; a.qb = (a.g == 0) ? idx : (a.g == 1) ? (idx & 3) : 0; return a;
}
__device__ __forceinline__ void attn_fetch(const bf16_t* QKV, const AttnItem& a, int tid, u32x4 (&kr)[8], u32x4 (&vr)[8]) {
    const int ck = (a.g * 3 * 8 + a.h) * 128 + 1024, uk0 = 128 * (a.qb - 1); const size_t rowbase = (size_t)a.b * SEQ + a.r;
#pragma unroll
    for (int i = 0; i < 8; ++i) { const int id = tid + 512 * i, kk = id >> 4, ch = id & 15, u = uk0 + kk;
        kr[i] = (u32x4){0u, 0u, 0u, 0u}; vr[i] = (u32x4){0u, 0u, 0u, 0u};
        if (u >= 0) { const bf16_t* src = QKV + (rowbase + (size_t)u * a.dil) * NQKV + ck + 8 * ch; kr[i] = *(const u32x4*)src; vr[i] = *(const u32x4*)(src + 1024); } }
}
__device__ __forceinline__ void attn_phase(LAS unsigned char* lds, unsigned lds_base, const bf16_t* QKV, bf16_t* OG, float* LSE, int first, int stride, int nitems, int tid, int wave, int lane) {
    const int i16 = lane & 15, q4 = lane >> 4, qq = i16 >> 2, p = lane & 3;
    u32x4 kr[8], vr[8];
    if (first < nitems) { const AttnItem a0 = attn_decode(first); attn_fetch(QKV, a0, tid, kr, vr); }
    __syncthreads();
#pragma unroll 1
    for (int item = first; item < nitems; item += stride) {
        const AttnItem a = attn_decode(item);
        const int g = a.g, h = a.h, qb = a.qb;
        const int cq = (g * 3 * 8 + h) * 128;
        const size_t rowbase = (size_t)a.b * SEQ + a.r;
#pragma unroll
        for (int i = 0; i < 8; ++i) { const int id = tid + 512 * i, kk = id >> 4, ch = id & 15;
            *(LAS u32x4*)(lds + AT_KOFF + kk * AT_PITCH + ch * 16) = kr[i]; *(LAS u32x4*)(lds + AT_VOFF + kk * AT_PITCH + ch * 16) = vr[i]; }
        const int tqa = 16 * wave + i16;
        const size_t grow = rowbase + (size_t)(128 * qb + tqa) * a.dil;
        bf16x8 Qf[4];
#pragma unroll
        for (int ks = 0; ks < 4; ++ks) Qf[ks] = *(const bf16x8*)(QKV + grow * NQKV + cq + 32 * ks + 8 * q4);
        __syncthreads();
        if (item + stride < nitems) { const AttnItem an = attn_decode(item + stride); attn_fetch(QKV, an, tid, kr, vr); }
        const int cb0 = wave & ~1;
        f32x4 S[10];
#pragma unroll
        for (int c = 0; c < 10; ++c) {
            f32x4 acc = {0.f, 0.f, 0.f, 0.f};
#pragma unroll
            for (int ks = 0; ks < 4; ++ks) { const bf16x8 kf = *(const LAS bf16x8*)(lds + AT_KOFF + (16 * (cb0 + c) + i16) * AT_PITCH + (32 * ks + 8 * q4) * 2); acc = mma16(kf, Qf[ks], acc); }
            S[c] = acc;
        }
        const float sc = 0.08838834764831845f * 1.4426950408889634f;
        float mx = -INFINITY;
#pragma unroll
        for (int c = 0; c < 10; ++c)
#pragma unroll
            for (int i = 0; i < 4; ++i) { const int kk = 16 * (cb0 + c) + 4 * q4 + i; const bool ok = (kk >= tqa) && (kk <= tqa + 128) && (qb > 0 || kk >= 128);
                const float s = ok ? S[c][i] * sc : -INFINITY; S[c][i] = s; mx = fmaxf(mx, s); }
        mx = fmaxf(mx, __shfl_xor(mx, 16)); mx = fmaxf(mx, __shfl_xor(mx, 32));
        float l = 0.f;
#pragma unroll
        for (int c = 0; c < 10; ++c)
#pragma unroll
            for (int i = 0; i < 4; ++i) { const float pv = __builtin_amdgcn_exp2f(S[c][i] - mx); S[c][i] = pv; l += pv; }
        l += __shfl_xor(l, 16); l += __shfl_xor(l, 32);
        bf16x8 Pf[5];
#pragma unroll
        for (int kst = 0; kst < 5; ++kst) Pf[kst] = pack8(S[2 * kst], S[2 * kst + 1]);
        const float inv = 1.f / l;
        bf16_t* orow = OG + grow * 3072 + g * 1024 + h * 128 + 4 * q4;
        const unsigned vbase = lds_base + AT_VOFF + (16 * cb0 + 4 * q4 + qq) * AT_PITCH + 8 * p;
#pragma unroll
        for (int eb = 0; eb < 8; ++eb) {
            f32x4 acc = {0.f, 0.f, 0.f, 0.f};
            bf16x8 v0, v1, v2, v3, v4;
            TR_READ5(v0, v1, v2, v3, v4, vbase, 0 * AT_PITCH + 32 * eb, 16 * AT_PITCH + 32 * eb, 32 * AT_PITCH + 32 * eb, 48 * AT_PITCH + 32 * eb, 64 * AT_PITCH + 32 * eb, 80 * AT_PITCH + 32 * eb,
                     96 * AT_PITCH + 32 * eb, 112 * AT_PITCH + 32 * eb, 128 * AT_PITCH + 32 * eb, 144 * AT_PITCH + 32 * eb);
            acc = mma16(v0, Pf[0], acc); acc = mma16(v1, Pf[1], acc); acc = mma16(v2, Pf[2], acc); acc = mma16(v3, Pf[3], acc); acc = mma16(v4, Pf[4], acc);
            u32x2 w; w.x = pk2(acc[0] * inv, acc[1] * inv); w.y = pk2(acc[2] * inv, acc[3] * inv);
            *(u32x2*)(orow + 16 * eb) = w;
        }
        if (q4 == 0) LSE[grow * 24 + g * 8 + h] = (mx + log2f(l)) * 0.6931471805599453f;
        __syncthreads();
    }
}

__device__ __forceinline__ void unpack8(const u32x4 w, float (&x)[8]) { x[0] = bflo(w.x); x[1] = bfhi(w.x); x[2] = bflo(w.y); x[3] = bfhi(w.y); x[4] = bflo(w.z); x[5] = bfhi(w.z); x[6] = bflo(w.w); x[7] = bfhi(w.w); }
__device__ __forceinline__ void load8(const float* p, float (&x)[8]) { const f32x4 a = *(const f32x4*)p, b = *(const f32x4*)(p + 4); x[0] = a.x; x[1] = a.y; x[2] = a.z; x[3] = a.w; x[4] = b.x; x[5] = b.y; x[6] = b.z; x[7] = b.w; }
__device__ __forceinline__ void store8(float* p, const float (&x)[8]) { *(f32x4*)p = (f32x4){x[0], x[1], x[2], x[3]}; *(f32x4*)(p + 4) = (f32x4){x[4], x[5], x[6], x[7]}; }
__device__ __forceinline__ void attn_sample_task(LAS unsigned char* wl  , const bf16_t* QKV, const float* c128, const float* c512, const float* c2048, bf16_t* OG, float* LSE, int ia, int wt, int lane) {
    const int bs = wt / 96, rem = wt % 96, g = rem >> 5, h = (rem >> 2) & 7, t = rem & 3;
    const int win = 128 << (2 * g), dil = 1 << (2 * g);
    const float* cache = ((g == 0) ? c128 : (g == 1) ? c512 : c2048) + (size_t)(ia * NBS + bs) * win * 2048;
    const int cq = (g * 3 * 8 + h) * 128, ck = cq + 1024, cv = cq + 2048;
    const size_t rq = (size_t)MP + bs * 4 + t;
    LAS float* qs = (LAS float*)wl; LAS float* ps = (LAS float*)(wl + 512);
    { const unsigned w = *(const unsigned*)(QKV + rq * NQKV + cq + 2 * lane); qs[2 * lane] = bflo(w); qs[2 * lane + 1] = bfhi(w); }
    asm volatile("s_waitcnt lgkmcnt(0)" ::: "memory");
    float sv[3];
#pragma unroll
    for (int pass = 0; pass < 3; ++pass) {
        const int j = pass * 64 + lane; float s = -INFINITY;
        if (j <= 128) {
            const int idx = win + t - dil * j; float acc = 0.f;
            if (idx >= win) { const bf16_t* kp = QKV + ((size_t)MP + bs * 4 + (idx - win)) * NQKV + ck;
                for (int d = 0; d < 128; d += 8) { const u32x4 w = *(const u32x4*)(kp + d); const LAS float* q = qs + d;
                    acc += q[0] * bflo(w.x) + q[1] * bfhi(w.x) + q[2] * bflo(w.y) + q[3] * bfhi(w.y) + q[4] * bflo(w.z) + q[5] * bfhi(w.z) + q[6] * bflo(w.w) + q[7] * bfhi(w.w); } }
            else { const float* kp = cache + ((size_t)idx * 2 + 0) * 1024 + h * 128;
                for (int d = 0; d < 128; d += 4) { const f32x4 kx = *(const f32x4*)(kp + d); const LAS float* q = qs + d; acc += q[0] * kx.x + q[1] * kx.y + q[2] * kx.z + q[3] * kx.w; } }
            s = acc * 0.08838834764831845f;
        }
        sv[pass] = s;
    }
    const float mx = wave_max(fmaxf(fmaxf(sv[0], sv[1]), sv[2]));
    float l = 0.f;
#pragma unroll
    for (int pass = 0; pass < 3; ++pass) { const float pv = fexp(sv[pass] - mx); l += pv; ps[pass * 64 + lane] = pv; }
    l = wave_sum(l);
    asm volatile("s_waitcnt lgkmcnt(0)" ::: "memory");
    { const int jg = lane >> 4, dd = lane & 15;
      float o[8];
#pragma unroll
      for (int q = 0; q < 8; ++q) o[q] = 0.f;
#pragma unroll 4
      for (int j = jg; j <= 128; j += 4) {
          const int idx = win + t - dil * j; const float pj = ps[j]; float v[8];
          if (idx >= win) { unpack8(*(const u32x4*)(QKV + ((size_t)MP + bs * 4 + (idx - win)) * NQKV + cv + 8 * dd), v); }
          else { load8(cache + ((size_t)idx * 2 + 1) * 1024 + h * 128 + 8 * dd, v); }
#pragma unroll
          for (int q = 0; q < 8; ++q) o[q] += pj * v[q];
      }
      const float inv = 1.f / l;
#pragma unroll
      for (int q = 0; q < 8; ++q) { o[q] += __shfl_xor(o[q], 16); o[q] += __shfl_xor(o[q], 32); o[q] *= inv; }
      if (jg == 0) { u32x4 w; w.x = pk2(o[0], o[1]); w.y = pk2(o[2], o[3]); w.z = pk2(o[4], o[5]); w.w = pk2(o[6], o[7]); *(u32x4*)(OG + rq * 3072 + g * 1024 + h * 128 + 8 * dd) = w; } }
    if (lane == 0) LSE[rq * 24 + g * 8 + h] = mx + logf(l);
}

__device__ __forceinline__ void combine_row(const bf16_t* OG, const float* LSE, bf16_t* OC, int r, int lane) {
    const int hh = lane >> 3;
    const float l0 = LSE[(size_t)r * 24 + hh], l1 = LSE[(size_t)r * 24 + 8 + hh], l2 = LSE[(size_t)r * 24 + 16 + hh];
    const float mx = fmaxf(l0, fmaxf(l1, l2));
    float e0 = fexp(l0 - mx), e1 = fexp(l1 - mx), e2 = fexp(l2 - mx);
    const float inv = 1.f / (e0 + e1 + e2); e0 *= inv; e1 *= inv; e2 *= inv;
    const bf16_t* src = OG + (size_t)r * 3072 + 16 * lane;
#pragma unroll
    for (int c = 0; c < 2; ++c) {
        const u32x4 a = *(const u32x4*)(src + 8 * c), bq = *(const u32x4*)(src + 1024 + 8 * c), cc = *(const u32x4*)(src + 2048 + 8 * c);
        u32x4 o;
        o.x = pk2(e0 * bflo(a.x) + e1 * bflo(bq.x) + e2 * bflo(cc.x), e0 * bfhi(a.x) + e1 * bfhi(bq.x) + e2 * bfhi(cc.x));
        o.y = pk2(e0 * bflo(a.y) + e1 * bflo(bq.y) + e2 * bflo(cc.y), e0 * bfhi(a.y) + e1 * bfhi(bq.y) + e2 * bfhi(cc.y));
        o.z = pk2(e0 * bflo(a.z) + e1 * bflo(bq.z) + e2 * bflo(cc.z), e0 * bfhi(a.z) + e1 * bfhi(bq.z) + e2 * bfhi(cc.z));
        o.w = pk2(e0 * bflo(a.w) + e1 * bflo(bq.w) + e2 * bflo(cc.w), e0 * bfhi(a.w) + e1 * bfhi(bq.w) + e2 * bfhi(cc.w));
        *(u32x4*)(OC + (size_t)r * DO + 16 * lane + 8 * c) = o;
    }
}

template <int CTRL, int RMASK> __device__ __forceinline__ float dpp_f(float oldv, float src) {
    return __builtin_bit_cast(float, __builtin_amdgcn_update_dpp(__builtin_bit_cast(int, oldv), __builtin_bit_cast(int, src), CTRL, RMASK, 0xf, false)); }
__device__ __forceinline__ float scan_sum(float v, int lane) {
    (void)lane;
    v += dpp_f<0x111, 0xf>(0.f, v); v += dpp_f<0x112, 0xf>(0.f, v); v += dpp_f<0x114, 0xf>(0.f, v); v += dpp_f<0x118, 0xf>(0.f, v);
    v += dpp_f<0x142, 0xa>(0.f, v); v += dpp_f<0x143, 0xc>(0.f, v);
    return v;
}
__device__ __forceinline__ float scan_max(float v, int lane) {
    (void)lane; const float ninf = -INFINITY;
    v = fmaxf(v, dpp_f<0x111, 0xf>(ninf, v)); v = fmaxf(v, dpp_f<0x112, 0xf>(ninf, v)); v = fmaxf(v, dpp_f<0x114, 0xf>(ninf, v)); v = fmaxf(v, dpp_f<0x118, 0xf>(ninf, v));
    v = fmaxf(v, dpp_f<0x142, 0xa>(ninf, v)); v = fmaxf(v, dpp_f<0x143, 0xc>(ninf, v));
    return v;
}
#ifndef ML_COPY
#define ML_COPY 0
#endif
constexpr int ML_QP = 272, ML_VP = 144, ML_PP = 144;
constexpr int ML_QSZ = 64 * ML_QP, ML_VSZ = 64 * ML_VP;
constexpr int ML_Q = 0, ML_K = ML_Q + 2 * ML_QSZ, ML_V = ML_K + 2 * ML_QSZ, ML_KW = ML_V + 2 * ML_VSZ, ML_P = ML_KW + ML_QSZ, ML_N = ML_P + 64 * ML_PP, ML_DEN = ML_N + 1024, ML_END = ML_DEN + 256;
__device__ __forceinline__ void mlstm_prompt(LAS unsigned char* lds, unsigned lds_base, const bf16_t* QKVO, const float* GATES, bf16_t* HRAW, float* SQ, float* out, int ib, int unit, int tid, int wave, int lane) {
    const int bh = unit >> 2, sl = unit & 3;
    const int b = bh >> 3, h = bh & 7;
    const int i16 = lane & 15, q4 = lane >> 4, qq = i16 >> 2, p = lane & 3;
    const int rb = wave >> 1, ea = wave & 1, e0 = 64 * sl + 32 * ea;
    f32x4 CT[2][8];
#pragma unroll
    for (int a = 0; a < 2; ++a)
#pragma unroll
        for (int d = 0; d < 8; ++d) CT[a][d] = (f32x4){0.f, 0.f, 0.f, 0.f};
    float m = 0.f;
    const unsigned vbase0 = lds_base + ML_V + (8 * q4 + qq) * ML_VP + (32 * ea + 4 * p) * 2, kwbase = lds_base + ML_KW + (8 * q4 + qq) * ML_QP + 8 * p;
    LAS float* nS = (LAS float*)(lds + ML_N); LAS float* denS = (LAS float*)(lds + ML_DEN);
    const size_t rbase = (size_t)b * SEQ;
    const int srow0 = tid >> 4, sch = tid & 15, vrow = tid >> 3, vch = tid & 7;
    u32x4 pq0, pq1, pk0, pk1, pv; float pig, plf;
    { const bf16_t* s0 = QKVO + (rbase + srow0) * NIN + h * 128 + 8 * sch; const bf16_t* s1 = s0 + (size_t)32 * NIN;
      pq0 = *(const u32x4*)s0; pk0 = *(const u32x4*)(s0 + 1024); pq1 = *(const u32x4*)s1; pk1 = *(const u32x4*)(s1 + 1024);
      pv = *(const u32x4*)(QKVO + (rbase + vrow) * NIN + 2048 + h * 256 + 64 * sl + 8 * vch);
      pig = GATES[(rbase + lane) * 16 + h]; plf = GATES[(rbase + lane) * 16 + 8 + h]; }
    __syncthreads();
    if (tid < 128) nS[tid] = 0.f;
    *(LAS u32x4*)(lds + ML_Q + srow0 * ML_QP + sch * 16) = pq0; *(LAS u32x4*)(lds + ML_Q + (srow0 + 32) * ML_QP + sch * 16) = pq1;
    *(LAS u32x4*)(lds + ML_K + srow0 * ML_QP + sch * 16) = pk0; *(LAS u32x4*)(lds + ML_K + (srow0 + 32) * ML_QP + sch * 16) = pk1;
    *(LAS u32x4*)(lds + ML_V + vrow * ML_VP + vch * 16) = pv;
    __syncthreads();
    float hv0[4] = {0.f, 0.f, 0.f, 0.f}, hv1[4] = {0.f, 0.f, 0.f, 0.f}, sv0[4] = {0.f, 0.f, 0.f, 0.f}, sv1[4] = {0.f, 0.f, 0.f, 0.f};
#define ML_FLUSH(rprev) do { _Pragma("unroll") for (int i = 0; i < 4; ++i) { const int t = 16 * rb + 4 * q4 + i; \
        bf16_t* hp = HRAW + ((rprev) + t) * DM + h * 256 + e0 + i16; hp[0] = (bf16_t)f2bf(hv0[i]); hp[16] = (bf16_t)f2bf(hv1[i]); \
        if (i16 == 0) { float* sp = SQ + ((rprev) + t) * 128 + h * 16 + 4 * sl + 2 * ea; sp[0] = sv0[i]; sp[1] = sv1[i]; } } } while (0)
#pragma unroll 1
    for (int c = 0; c < 32; ++c) {
        const int cur = c & 1, nxt = cur ^ 1;
        const size_t r0 = rbase + 64 * c;
        const LAS unsigned char* Qc = lds + ML_Q + cur * ML_QSZ; const LAS unsigned char* Kc = lds + ML_K + cur * ML_QSZ;
        const float ig = pig, lf = plf;
        asm volatile("" :: "v"(ig), "v"(lf));
        if (c > 0) ML_FLUSH(r0 - 64);
        { const size_t rn = rbase + 64 * ((c < 31) ? c + 1 : c);
          const bf16_t* s0 = QKVO + (rn + srow0) * NIN + h * 128 + 8 * sch; const bf16_t* s1 = s0 + (size_t)32 * NIN;
          pq0 = *(const u32x4*)s0; pk0 = *(const u32x4*)(s0 + 1024); pq1 = *(const u32x4*)s1; pk1 = *(const u32x4*)(s1 + 1024);
          pv = *(const u32x4*)(QKVO + (rn + vrow) * NIN + 2048 + h * 256 + 64 * sl + 8 * vch);
          pig = GATES[(rn + lane) * 16 + h]; plf = GATES[(rn + lane) * 16 + 8 + h]; }
        const float bcum = scan_sum(lf, lane);
        const float av = ig - bcum;
        const float Av = fmaxf(m, scan_max(av, lane));
        const float bL = __shfl(bcum, 63), A63 = __shfl(Av, 63);
        const float wsv = fexp(av - A63), wC = fexp(m - A63);
#pragma unroll
        for (int i = 0; i < 2; ++i) { const int id = lane + 64 * i, rr = 8 * wave + (id >> 4), ch = id & 15;
            const u32x4 kx = *(const LAS u32x4*)(Kc + rr * ML_QP + ch * 16); const float w = __shfl(wsv, rr);
            u32x4 o; o.x = pk2(bflo(kx.x) * w, bfhi(kx.x) * w); o.y = pk2(bflo(kx.y) * w, bfhi(kx.y) * w); o.z = pk2(bflo(kx.z) * w, bfhi(kx.z) * w); o.w = pk2(bflo(kx.w) * w, bfhi(kx.w) * w);
            *(LAS u32x4*)(lds + ML_KW + rr * ML_QP + ch * 16) = o; }
        {
#pragma unroll
          for (int cc = 0; cc < 2; ++cc) { const int cb = 2 * (wave & 1) + cc;
            f32x4 s = {0.f, 0.f, 0.f, 0.f};
            if (cb <= rb) {
#pragma unroll
                for (int ks = 0; ks < 4; ++ks) { const bf16x8 af = *(const LAS bf16x8*)(Qc + (16 * rb + i16) * ML_QP + (32 * ks + 8 * q4) * 2);
                    const bf16x8 bf = *(const LAS bf16x8*)(Kc + (16 * cb + i16) * ML_QP + (32 * ks + 8 * q4) * 2); s = mma16(af, bf, s); } }
            const int sidx = 16 * cb + i16; const float as = __shfl(av, sidx);
#pragma unroll
            for (int i = 0; i < 4; ++i) { const int t = 16 * rb + 4 * q4 + i; const float At = __shfl(Av, t);
                const float pv_ = (sidx <= t && cb <= rb) ? s[i] * fexp(as - At) : 0.f;
                *(LAS bf16_t*)(lds + ML_P + t * ML_PP + sidx * 2) = (bf16_t)f2bf(pv_); } } }
        LDS_BARRIER();
        { const int t = tid >> 3, part = tid & 7;
          const LAS unsigned char* qrow = Qc + t * ML_QP + part * 32;
          const u32x4 qa = *(const LAS u32x4*)(qrow), qb = *(const LAS u32x4*)(qrow + 16);
          const LAS float* nn = nS + cur * 128 + 16 * part;
          float a = nn[0] * bflo(qa.x) + nn[1] * bfhi(qa.x) + nn[2] * bflo(qa.y) + nn[3] * bfhi(qa.y) + nn[4] * bflo(qa.z) + nn[5] * bfhi(qa.z) + nn[6] * bflo(qa.w) + nn[7] * bfhi(qa.w)
                  + nn[8] * bflo(qb.x) + nn[9] * bfhi(qb.x) + nn[10] * bflo(qb.y) + nn[11] * bfhi(qb.y) + nn[12] * bflo(qb.z) + nn[13] * bfhi(qb.z) + nn[14] * bflo(qb.w) + nn[15] * bfhi(qb.w);
          const u32x4 pr = *(const LAS u32x4*)(lds + ML_P + t * ML_PP + part * 16);
          const float rsum = ((bflo(pr.x) + bfhi(pr.x)) + (bflo(pr.y) + bfhi(pr.y))) + ((bflo(pr.z) + bfhi(pr.z)) + (bflo(pr.w) + bfhi(pr.w)));
          const float At = __shfl(Av, t), bt = __shfl(bcum, t);
          float val = fexp(m - At) * a + rsum;
          val += __shfl_xor(val, 1); val += __shfl_xor(val, 2); val += __shfl_xor(val, 4);
          if (part == 0) denS[t] = 1.f / fmaxf(fabsf(val), fexp(-(bt + At))); }
        if (tid < 128) { float acc = wC * nS[cur * 128 + tid];
#pragma unroll 8
            for (int s = 0; s < 64; ++s) acc += bf1(*(const LAS bf16_t*)(lds + ML_KW + s * ML_QP + tid * 2));
            nS[nxt * 128 + tid] = acc; }
        f32x4 num0 = {0.f, 0.f, 0.f, 0.f}, num1 = {0.f, 0.f, 0.f, 0.f};
#pragma unroll
        for (int ks = 0; ks < 4; ++ks) { const LAS unsigned char* qrow = Qc + (16 * rb + i16) * ML_QP;
            const u32x2 lo = *(const LAS u32x2*)(qrow + (32 * ks + 4 * q4) * 2), hi = *(const LAS u32x2*)(qrow + (32 * ks + 16 + 4 * q4) * 2);
            u32x4 w; w.x = lo.x; w.y = lo.y; w.z = hi.x; w.w = hi.y; const bf16x8 af = __builtin_bit_cast(bf16x8, w);
            num0 = mma16(af, pack8(CT[0][2 * ks], CT[0][2 * ks + 1]), num0); num1 = mma16(af, pack8(CT[1][2 * ks], CT[1][2 * ks + 1]), num1); }
#pragma unroll
        for (int i = 0; i < 4; ++i) { const float wi = fexp(m - __shfl(Av, 16 * rb + 4 * q4 + i)); num0[i] *= wi; num1[i] *= wi; }
        const unsigned vbase = vbase0 + cur * ML_VSZ;
        bf16x8 V00, V01, V10, V11;
        TR_READ4(V00, V01, V10, V11, vbase, 0, 4 * ML_VP, 32 * ML_VP, 36 * ML_VP, 32, 4 * ML_VP + 32, 32 * ML_VP + 32, 36 * ML_VP + 32);
        { const bf16x8 pf0 = *(const LAS bf16x8*)(lds + ML_P + (16 * rb + i16) * ML_PP + (8 * q4) * 2), pf1 = *(const LAS bf16x8*)(lds + ML_P + (16 * rb + i16) * ML_PP + (32 + 8 * q4) * 2);
          num0 = mma16(pf0, V00, num0); num0 = mma16(pf1, V01, num0); num1 = mma16(pf0, V10, num1); num1 = mma16(pf1, V11, num1); }
#pragma unroll
        for (int a = 0; a < 2; ++a)
#pragma unroll
            for (int d = 0; d < 8; ++d) CT[a][d] = CT[a][d] * wC;
#pragma unroll
        for (int ks = 0; ks < 2; ++ks)
#pragma unroll
            for (int dg = 0; dg < 2; ++dg) { bf16x8 k0, k1, k2, k3;
                TR_READ4(k0, k1, k2, k3, kwbase, 32 * ks * ML_QP + 32 * (4 * dg), (32 * ks + 4) * ML_QP + 32 * (4 * dg), 32 * ks * ML_QP + 32 * (4 * dg + 1), (32 * ks + 4) * ML_QP + 32 * (4 * dg + 1),
                         32 * ks * ML_QP + 32 * (4 * dg + 2), (32 * ks + 4) * ML_QP + 32 * (4 * dg + 2), 32 * ks * ML_QP + 32 * (4 * dg + 3), (32 * ks + 4) * ML_QP + 32 * (4 * dg + 3));
                const bf16x8 va = ks ? V01 : V00, vb = ks ? V11 : V10;
                CT[0][4 * dg] = mma16(k0, va, CT[0][4 * dg]); CT[0][4 * dg + 1] = mma16(k1, va, CT[0][4 * dg + 1]); CT[0][4 * dg + 2] = mma16(k2, va, CT[0][4 * dg + 2]); CT[0][4 * dg + 3] = mma16(k3, va, CT[0][4 * dg + 3]);
                CT[1][4 * dg] = mma16(k0, vb, CT[1][4 * dg]); CT[1][4 * dg + 1] = mma16(k1, vb, CT[1][4 * dg + 1]); CT[1][4 * dg + 2] = mma16(k2, vb, CT[1][4 * dg + 2]); CT[1][4 * dg + 3] = mma16(k3, vb, CT[1][4 * dg + 3]); }
        { LAS unsigned char* Qn = lds + ML_Q + nxt * ML_QSZ; LAS unsigned char* Kn = lds + ML_K + nxt * ML_QSZ;
          *(LAS u32x4*)(Qn + srow0 * ML_QP + sch * 16) = pq0; *(LAS u32x4*)(Qn + (srow0 + 32) * ML_QP + sch * 16) = pq1;
          *(LAS u32x4*)(Kn + srow0 * ML_QP + sch * 16) = pk0; *(LAS u32x4*)(Kn + (srow0 + 32) * ML_QP + sch * 16) = pk1;
          *(LAS u32x4*)(lds + ML_V + nxt * ML_VSZ + vrow * ML_VP + vch * 16) = pv; }
        LDS_BARRIER();
#pragma unroll
        for (int i = 0; i < 4; ++i) { const int t = 16 * rb + 4 * q4 + i; const float dinv = denS[t]; const float h0 = num0[i] * dinv, h1 = num1[i] * dinv;
            hv0[i] = h0; hv1[i] = h1;
            float s0 = h0 * h0, s1 = h1 * h1;
            s0 += __shfl_xor(s0, 1); s0 += __shfl_xor(s0, 2); s0 += __shfl_xor(s0, 4); s0 += __shfl_xor(s0, 8);
            s1 += __shfl_xor(s1, 1); s1 += __shfl_xor(s1, 2); s1 += __shfl_xor(s1, 4); s1 += __shfl_xor(s1, 8);
            sv0[i] = s0; sv1[i] = s1; }
        m = bL + A63;
    }
    ML_FLUSH(rbase + 64 * 31);
#undef ML_FLUSH
    const size_t sb = (size_t)(ib * NBP + b) * 8 + h;
    if (rb == 0) {
#pragma unroll
        for (int a = 0; a < 2; ++a)
#pragma unroll
            for (int d = 0; d < 8; ++d) *(f32x4*)(out + O_CP + (sb * 256 + e0 + 16 * a + i16) * 128 + 16 * d + 4 * q4) = CT[a][d]; }
    if (sl == 0) { if (tid < 128) out[O_NP + sb * 128 + tid] = nS[tid]; if (tid == 0) out[O_MP + sb] = m; }
}

__device__ __forceinline__ void hn_row(const bf16_t* HRAW, const float* SQ, const bf16_t* QKVO, const float* gh, bf16_t* HN, int r, int lane) {
    const int hh = lane >> 3;
    const f32x4 s0 = *(const f32x4*)(SQ + (size_t)r * 128 + hh * 16), s1 = *(const f32x4*)(SQ + (size_t)r * 128 + hh * 16 + 4), s2 = *(const f32x4*)(SQ + (size_t)r * 128 + hh * 16 + 8), s3 = *(const f32x4*)(SQ + (size_t)r * 128 + hh * 16 + 12);
    const float tot = (((s0[0] + s0[1]) + (s0[2] + s0[3])) + ((s1[0] + s1[1]) + (s1[2] + s1[3]))) + (((s2[0] + s2[1]) + (s2[2] + s2[3])) + ((s3[0] + s3[1]) + (s3[2] + s3[3])));
    const float rs = rsqrtf(tot * (1.f / 256.f) + EPS);
#pragma unroll
    for (int c = 0; c < 4; ++c) { const int col = 32 * lane + 8 * c;
        const u32x4 hx = *(const u32x4*)(HRAW + (size_t)r * DM + col), ox = *(const u32x4*)(QKVO + (size_t)r * NIN + 4096 + col);
        const f32x4 g0 = *(const f32x4*)(gh + col), g1 = *(const f32x4*)(gh + col + 4);
        u32x4 o;
        o.x = pk2(bflo(hx.x) * rs * g0[0] / (1.f + fexp(-bflo(ox.x))), bfhi(hx.x) * rs * g0[1] / (1.f + fexp(-bfhi(ox.x))));
        o.y = pk2(bflo(hx.y) * rs * g0[2] / (1.f + fexp(-bflo(ox.y))), bfhi(hx.y) * rs * g0[3] / (1.f + fexp(-bfhi(ox.y))));
        o.z = pk2(bflo(hx.z) * rs * g1[0] / (1.f + fexp(-bflo(ox.z))), bfhi(hx.z) * rs * g1[1] / (1.f + fexp(-bfhi(ox.z))));
        o.w = pk2(bflo(hx.w) * rs * g1[2] / (1.f + fexp(-bflo(ox.w))), bfhi(hx.w) * rs * g1[3] / (1.f + fexp(-bfhi(ox.w))));
        *(u32x4*)(HN + (size_t)r * DM + col) = o; }
}

__device__ __forceinline__ void mlstm_sample(LAS unsigned char* lds, const bf16_t* QKVO, const float* GATES, const float* gh, const float* C0all, const float* n0all, const float* m0all, bf16_t* HN, float* out, int ib, int bh, int tid, int wave, int lane) {
    const int bs = bh >> 3, h = bh & 7;
    const size_t sb = (size_t)(ib * NBS + bs) * 8 + h;
    LAS float* qs = (LAS float*)lds;
    LAS float* ks = qs + 512;
    LAS float* ns = ks + 512;
    LAS float* Ss = ns + 128;
    LAS float* nq = Ss + 16;
    LAS float* red = nq + 16;
    const size_t r0 = (size_t)MP + bs * 4;
    __syncthreads();
    { const int t = tid >> 7, d = tid & 127; qs[tid] = bf1(QKVO[(r0 + t) * NIN + h * 128 + d]); ks[tid] = bf1(QKVO[(r0 + t) * NIN + 1024 + h * 128 + d]); if (tid < 128) ns[tid] = n0all[sb * 128 + tid]; }
    __syncthreads();
    if (wave == 0) {
        if (lane < 16) { const int t = lane >> 2, s = lane & 3; float a = 0.f; for (int d = 0; d < 128; ++d) a += qs[t * 128 + d] * ks[s * 128 + d]; Ss[lane] = a; }
        else if (lane < 20) { const int t = lane - 16; float a = 0.f; for (int d = 0; d < 128; ++d) a += ns[d] * qs[t * 128 + d]; nq[t] = a; }
    }
    __syncthreads();
    const float m0 = m0all[sb];
    float bc[4], av[4], Av[4];
    { float run = 0.f, pm = -INFINITY;
#pragma unroll
      for (int t = 0; t < 4; ++t) { const float ig = GATES[(r0 + t) * 16 + h], lf = GATES[(r0 + t) * 16 + 8 + h]; run += lf; bc[t] = run; av[t] = ig - run; pm = fmaxf(pm, av[t]); Av[t] = fmaxf(m0, pm); } }
    const float A3 = Av[3], wC = fexp(m0 - A3);
    float Pm[4][4], den[4];
#pragma unroll
    for (int t = 0; t < 4; ++t) { float rs = 0.f;
#pragma unroll
        for (int s = 0; s < 4; ++s) { Pm[t][s] = (s <= t) ? Ss[t * 4 + s] * fexp(av[s] - Av[t]) : 0.f; rs += Pm[t][s]; }
        den[t] = fexp(m0 - Av[t]) * nq[t] + rs; }
    const int e = tid >> 1, hf = tid & 1;
    const float* Crow = C0all + (sb * 256 + e) * 128 + 64 * hf;
    f32x4 Cv[16];
#pragma unroll
    for (int j = 0; j < 16; ++j) Cv[j] = *(const f32x4*)(Crow + 4 * j);
    float inter[4];
#pragma unroll
    for (int t = 0; t < 4; ++t) { float a = 0.f; const LAS float* q = qs + t * 128 + 64 * hf;
#pragma unroll
        for (int j = 0; j < 16; ++j) a += Cv[j].x * q[4 * j] + Cv[j].y * q[4 * j + 1] + Cv[j].z * q[4 * j + 2] + Cv[j].w * q[4 * j + 3];
        a += __shfl_xor(a, 1); inter[t] = a; }
    float vv[4];
#pragma unroll
    for (int s = 0; s < 4; ++s) vv[s] = bf1(QKVO[(r0 + s) * NIN + 2048 + h * 256 + e]);
    float hv[4];
#pragma unroll
    for (int t = 0; t < 4; ++t) { float nu = fexp(m0 - Av[t]) * inter[t];
#pragma unroll
        for (int s = 0; s < 4; ++s) nu += Pm[t][s] * vv[s];
        hv[t] = nu / fmaxf(fabsf(den[t]), fexp(-(bc[t] + Av[t])));
        float sq = (hf == 0) ? hv[t] * hv[t] : 0.f; sq = wave_sum(sq); if (lane == 0) red[t * 8 + wave] = sq; }
    __syncthreads();
    if (hf == 0) {
#pragma unroll
        for (int t = 0; t < 4; ++t) { float tot = 0.f;
#pragma unroll
            for (int w = 0; w < 8; ++w) tot += red[t * 8 + w];
            const float rs = rsqrtf(tot * (1.f / 256.f) + EPS);
            const float og = bf1(QKVO[(r0 + t) * NIN + 4096 + h * 256 + e]);
            HN[(r0 + t) * DM + h * 256 + e] = (bf16_t)f2bf(hv[t] * rs * gh[h * 256 + e] / (1.f + fexp(-og))); } }
    float wv[4];
#pragma unroll
    for (int s = 0; s < 4; ++s) wv[s] = fexp(av[s] - A3) * vv[s];
    float* Cout = out + O_CS + (sb * 256 + e) * 128 + 64 * hf;
#pragma unroll
    for (int j = 0; j < 16; ++j) { f32x4 o = Cv[j] * wC;
#pragma unroll
        for (int s = 0; s < 4; ++s) { const LAS float* k = ks + s * 128 + 64 * hf + 4 * j; o.x += wv[s] * k[0]; o.y += wv[s] * k[1]; o.z += wv[s] * k[2]; o.w += wv[s] * k[3]; }
        *(f32x4*)(Cout + 4 * j) = o; }
    if (tid < 128) { float o = wC * ns[tid];
#pragma unroll
        for (int s = 0; s < 4; ++s) o += fexp(av[s] - A3) * ks[s * 128 + tid];
        out[O_NS + sb * 128 + tid] = o; }
    if (tid == 0) out[O_MS + sb] = bc[3] + A3;
}

__device__ __forceinline__ void cache_shift(const Params& P, float* outp, int ia, int w, int NW, int lane) {
    constexpr int N0 = NBS * 124, N1 = NBS * 508, N2 = NBS * 2044;
    for (int it = w; it < N0 + N1 + N2; it += NW) {
        int g, q; if (it < N0) { g = 0; q = it; } else if (it < N0 + N1) { g = 1; q = it - N0; } else { g = 2; q = it - N0 - N1; }
        const int win = 128 << (2 * g), per = win - 4, bs = q / per, j = q % per;
        const float* src = P.in[2 + g] + ((size_t)(ia * NBS + bs) * win + j + 4) * 2048;
        float* dst = outp + ((g == 0) ? O_KV128S : (g == 1) ? O_KV512S : O_KV2048S) + ((size_t)(ia * NBS + bs) * win + j) * 2048;
#pragma unroll
        for (int i = 0; i < 8; ++i) ((f32x4*)dst)[lane + 64 * i] = ((const f32x4*)src)[lane + 64 * i];
    }
}

__device__ __forceinline__ void phase_convgate(const Params& P, float* outp, const bf16_t* U, bf16_t* Z, int layer, int gtid, int NGT) {
    constexpr int NCG = DFF / 8, NRUN = MP / 64 + NBS;
    const float* cw = P.in[20] + (size_t)layer * 3 * NUP; const float* cbias = P.in[21] + (size_t)layer * NUP;
    for (int task = gtid; task < NCG * NRUN; task += NGT) {
        const int cg = task % NCG, run = task / NCG, j0 = 8 * cg;
        const int ua0 = 256 * (j0 >> 7) + (j0 & 127), ub0 = ua0 + 128;
        float wa[3][8], wb[3][8], ba[8], bb[8];
#pragma unroll
        for (int k = 0; k < 3; ++k) { load8(cw + (size_t)k * NUP + j0, wa[k]); load8(cw + (size_t)k * NUP + DFF + j0, wb[k]); }
        load8(cbias + j0, ba); load8(cbias + DFF + j0, bb);
        float a2[8], a1[8], b2[8], b1[8];
        size_t row0; int nrows; float* cout;
        if (run < MP / 64) { const int b = run >> 5, s0 = (run & 31) * 64; row0 = (size_t)b * SEQ + s0; nrows = 64;
            cout = (s0 == SEQ - 64) ? outp + O_CONVP + ((size_t)(layer * NBP + b) * 2) * NUP : nullptr;
            if (s0 == 0) {
#pragma unroll
                for (int j = 0; j < 8; ++j) { a2[j] = 0.f; a1[j] = 0.f; b2[j] = 0.f; b1[j] = 0.f; } }
            else { unpack8(*(const u32x4*)(U + (row0 - 2) * NUP + ua0), a2); unpack8(*(const u32x4*)(U + (row0 - 1) * NUP + ua0), a1);
                   unpack8(*(const u32x4*)(U + (row0 - 2) * NUP + ub0), b2); unpack8(*(const u32x4*)(U + (row0 - 1) * NUP + ub0), b1); } }
        else { const int bs = run - MP / 64; row0 = (size_t)MP + bs * 4; nrows = 4;
            cout = outp + O_CONVS + ((size_t)(layer * NBS + bs) * 2) * NUP;
            const float* st = P.in[8] + ((size_t)(layer * NBS + bs) * 2) * NUP;
            load8(st + j0, a2); load8(st + NUP + j0, a1); load8(st + DFF + j0, b2); load8(st + NUP + DFF + j0, b1); }
        for (int t = 0; t < nrows; t += 4) {
            u32x4 ua[4], ub[4];
#pragma unroll
            for (int q = 0; q < 4; ++q) { ua[q] = *(const u32x4*)(U + (row0 + t + q) * NUP + ua0); ub[q] = *(const u32x4*)(U + (row0 + t + q) * NUP + ub0); }
#pragma unroll
            for (int q = 0; q < 4; ++q) {
                float a0[8], b0[8];
                unpack8(ua[q], a0); unpack8(ub[q], b0);
                float z[8];
#pragma unroll
                for (int j = 0; j < 8; ++j) { const float ca = ba[j] + wa[0][j] * a2[j] + wa[1][j] * a1[j] + wa[2][j] * a0[j]; const float cb = bb[j] + wb[0][j] * b2[j] + wb[1][j] * b1[j] + wb[2][j] * b0[j];
                    z[j] = ca / (1.f + fexp(-ca)) * cb; a2[j] = a1[j]; a1[j] = a0[j]; b2[j] = b1[j]; b1[j] = b0[j]; }
                u32x4 o; o.x = pk2(z[0], z[1]); o.y = pk2(z[2], z[3]); o.z = pk2(z[4], z[5]); o.w = pk2(z[6], z[7]);
                *(u32x4*)(Z + (row0 + t + q) * DFF + j0) = o;
            }
        }
        if (cout) { store8(cout + j0, a2); store8(cout + NUP + j0, a1); store8(cout + DFF + j0, b2); store8(cout + NUP + DFF + j0, b1); }
    }
}

#ifndef REP_STORE
#define REP_STORE 1
#endif
#ifndef REP_CONV
#define REP_CONV 1
#endif
#ifndef REP_ML
#define REP_ML 1
#endif
#ifndef REP_ATT
#define REP_ATT 1
#endif
#ifndef REP_RESID
#define REP_RESID 1
#endif
#ifndef REP_FIN
#define REP_FIN 1
#endif
#ifndef REP_P0
#define REP_P0 1
#endif
#define REPEAT(n, body) do { body; if ((n) > 1) { body; } if ((n) > 2) { body; } } while (0)
__global__ void __launch_bounds__(NTHR, 2) fwd_kernel(Params P) {
    extern __shared__ __attribute__((aligned(16))) unsigned char lds_raw[];
    LAS unsigned char* lds = (LAS unsigned char*)lds_raw;
    const unsigned lds_base = (unsigned)(size_t)lds;
    const int tid0 = threadIdx.x;
    const int G0 = gridDim.x, bx0 = blockIdx.x;
#define PHASE_IDS int tid = tid0; asm volatile("" : "+v"(tid)); int zz_ = 0; asm volatile("" : "+v"(zz_)); zz_ = __builtin_amdgcn_readfirstlane(zz_); const int bx = bx0 + zz_, G = G0 + zz_; unsigned char* ws = P.ws + zz_; float* outp = P.out + zz_; \
    const int lane = tid & 63, wave = __builtin_amdgcn_readfirstlane(tid >> 6); const int gw = bx * NWAVES + wave, gtid = bx * NTHR + tid, NGW = G * NWAVES, NGT = G * NTHR; (void)gw; (void)gtid; (void)lane; (void)NGW; (void)NGT; (void)outp; \
    bf16_t* XB = (bf16_t*)(ws + WS_XB); float* SSQ = (float*)(ws + WS_SSQ); float* SSQS = (float*)(ws + WS_SSQS); bf16_t* QKV = (bf16_t*)(ws + WS_QKV); bf16_t* OG = (bf16_t*)(ws + WS_OG); float* LSE = (float*)(ws + WS_LSE); bf16_t* OC = (bf16_t*)(ws + WS_OC); \
    float* GATES = (float*)(ws + WS_GATES); bf16_t* U = (bf16_t*)(ws + WS_U); bf16_t* Z = (bf16_t*)(ws + WS_Z); (void)XB; (void)SSQ; (void)SSQS; (void)QKV; (void)OG; (void)LSE; (void)OC; (void)GATES; (void)U; (void)Z;
    volatile LAS unsigned* misc = (volatile LAS unsigned*)(lds + LDS_MISC_OFF);
    if (tid0 < 16) misc[tid0] = 0u;
    __syncthreads();
    { const XcdBarrier bar0 = xcd_barrier_post((unsigned*)(P.ws + WS_CTL) + 1024, misc + 8); if (tid0 == 0) misc[10] = bar0.x; }
    __syncthreads();
#define GRID_BAR() do { XcdBarrier bar_; bar_.bar = (unsigned*)(P.ws + WS_CTL) + 1024; bar_.x = (unsigned)__builtin_amdgcn_readfirstlane((int)misc[10]); bar_.st = misc + 8; xcd_barrier(bar_); } while (0)
#define GEMM_STORE(Abuf, Wt, NN, KK, Obuf) REPEAT(REP_STORE, GEMM_STORE1(Abuf, Wt, NN, KK, Obuf))
#define GEMM_STORE1(Abuf, Wt, NN, KK, Obuf) do { PHASE_IDS; \
        { pg8::Gemm g{Abuf, (const bf16_t*)(Wt), MP, NN, KK}; pg8::StaticOrder S; S.init(MP, NN, G, bx); const int pm0_ = pg8::first_pm(S); LAS float* rtab_ = (LAS float*)(lds + RING_BYTES); pg8::rstd_panel(rtab_, SSQ, pm0_, EPS, tid); pg8::EpiStoreN E{Obuf, NN, SSQ, EPS, rtab_, pm0_}; \
          pg8::gemm_phase<pg8::EpiStoreN, pg8::StaticOrder, true, true>(lds, g, S, E); } \
        skinny_phase<0>(lds, Abuf + (size_t)MP * KK, KK, (const bf16_t*)(Wt), NN, Obuf + (size_t)MP * NN, NN, nullptr, SSQS, nullptr, bx, G, (((MP / 256) * ((NN) / 256)) % G) ? G - (((MP / 256) * ((NN) / 256)) % G) : G, tid, wave, lane); } while (0)
#define GEMM_RESID(Abuf, Wt, KK, FIN) do { PHASE_IDS; \
        { pg8::Gemm g{Abuf, (const bf16_t*)(Wt), MP, DM, KK}; pg8::StaticOrder S; S.init(MP, DM, G, bx); pg8::EpiResidN E{XB, (FIN) ? outp : nullptr, (FIN) ? nullptr : SSQ, DM}; \
          pg8::gemm_phase<pg8::EpiResidN, pg8::StaticOrder, true, true>(lds, g, S, E); } \
        if (FIN) skinny_phase<2>(lds, Abuf + (size_t)MP * KK, KK, (const bf16_t*)(Wt), DM, nullptr, 0, XB + (size_t)MP * DM, nullptr, outp + (size_t)MP * DM, bx, G, G, tid, wave, lane); \
        else skinny_phase<1>(lds, Abuf + (size_t)MP * KK, KK, (const bf16_t*)(Wt), DM, nullptr, 0, XB + (size_t)MP * DM, SSQS, nullptr, bx, G, G, tid, wave, lane); } while (0)

    REPEAT(REP_P0, { PHASE_IDS; phase_prologue(P, lds, gw, NGW, wave, lane); });
    GRID_BAR();

#define FFN(L, FIN) do { \
        GEMM_STORE(XB, ws + WS_WUP + (L) * SZ_WUP, NUP, DM, U); \
        GRID_BAR(); \
        REPEAT(REP_CONV, { PHASE_IDS; phase_convgate(P, outp, U, Z, (L), gtid, NGT); }); \
        GRID_BAR(); \
        GEMM_RESID(Z, ws + WS_WDOWN + (L) * SZ_WDOWN, DFF, FIN); \
    } while (0)

#define LAYER_PAIR(lp) do { \
        { \
            const int ia = (lp); \
            GEMM_STORE(XB, ws + WS_WQKV + ia * SZ_WQKV, NQKV, DM, QKV); \
            GRID_BAR(); \
            { PHASE_IDS; for (int r = gw; r < MR; r += NGW) prep_row(QKV, (const float*)(ws + WS_ROPE), P.in[12] + ia * 128, P.in[13] + ia * 128, outp, ia, r, lane); } \
            GRID_BAR(); \
            REPEAT(REP_ATT, { PHASE_IDS; attn_phase(lds, lds_base, QKV, OG, LSE, bx, G, 1536, tid, wave, lane); } \
            { PHASE_IDS; for (int wt = bx + G * wave; wt < NBS * 96; wt += G * NWAVES) attn_sample_task(lds + wave * 2048, QKV, P.in[2], P.in[3], P.in[4], OG, LSE, ia, wt, lane); __syncthreads(); }); \
            GRID_BAR(); \
            REPEAT(REP_ATT, { PHASE_IDS; for (int r = gw; r < MR; r += NGW) combine_row(OG, LSE, OC, r, lane); }); \
            GRID_BAR(); \
            GEMM_RESID(OC, ws + WS_WO + ia * SZ_WO, DO, false); \
            GRID_BAR(); \
            FFN(2 * (lp), false); \
            GRID_BAR(); \
        } \
        { \
            const int L = 2 * (lp) + 1, ib = (lp); \
            GEMM_STORE(XB, ws + WS_WIN + ib * SZ_WIN, NIN, DM, QKV); \
            { PHASE_IDS; for (int task = G - 1 - bx; task < MR / 16; task += G) gate_block(lds, XB, (const f32x4*)(ws + WS_WGP) + (size_t)ib * 128 * 64, P.in[16] + ib * 16, GATES, task, wave, lane); } \
            GRID_BAR(); \
            REPEAT(REP_ML, { PHASE_IDS; \
            if (bx < 128) mlstm_prompt(lds, lds_base, QKV, GATES, OG, (float*)(ws + WS_SQ), outp, ib, bx, tid, wave, lane); \
            else { if (bx < 192) mlstm_sample(lds, QKV, GATES, P.in[17] + (size_t)ib * DM, P.in[5], P.in[6], P.in[7], OC, outp, ib, bx - 128, tid, wave, lane); \
                   cache_shift(P, outp, (lp), (bx - 128) * NWAVES + wave, (G - 128) * NWAVES, lane); } }); \
            GRID_BAR(); \
            REPEAT(REP_FIN, { PHASE_IDS; for (int r = gw; r < MP; r += NGW) hn_row(OG, (const float*)(ws + WS_SQ), QKV, P.in[17] + (size_t)ib * DM, OC, r, lane); }); \
            GRID_BAR(); \
            GEMM_RESID(OC, ws + WS_WOUT + ib * SZ_WOUT, DM, false); \
            GRID_BAR(); \
            FFN(L, (L == DEPTH - 1)); \
            if ((lp) == 0) GRID_BAR(); \
        } \
    } while (0)
    LAYER_PAIR(0);
    LAYER_PAIR(1);
}

extern "C" void kernel_launch(void* const* d_in, const int* in_sizes, int n_in, void* d_out, int out_size, void* d_ws, size_t ws_size, hipStream_t stream) {
    static int grid = 0;
    if (grid == 0) {
        if (n_in != 23 || (size_t)out_size != O_END || ws_size < WS_END) {
            fprintf(stderr, "kernel_launch: built for 23 inputs, %zu outputs, >= %zu bytes of workspace; got n_in %d, out %d, ws %zu; nothing launched\n", (size_t)O_END, (size_t)WS_END, n_in, out_size, ws_size);
            grid = -1; return; }
        int dev = 0, cus = 0, per_cu = 0;
        if (hipGetDevice(&dev) != hipSuccess || hipDeviceGetAttribute(&cus, hipDeviceAttributeMultiprocessorCount, dev) != hipSuccess) { fprintf(stderr, "kernel_launch: device query failed\n"); grid = -1; return; }
        if (hipFuncSetAttribute((const void*)fwd_kernel, hipFuncAttributeMaxDynamicSharedMemorySize, LDS_BYTES) != hipSuccess) { fprintf(stderr, "kernel_launch: hipFuncSetAttribute failed\n"); grid = -1; return; }
        if (hipOccupancyMaxActiveBlocksPerMultiprocessor(&per_cu, (const void*)fwd_kernel, NTHR, LDS_BYTES) != hipSuccess || per_cu < 1)
            fprintf(stderr, "kernel_launch: occupancy query reports %d workgroups per CU\n", per_cu);
        (void)hipGetLastError();
        grid = cus;
    }
    if (grid < 0) return;
    (void)hipMemsetAsync((char*)d_ws + WS_CTL, 0, CTL_ZERO_BYTES, stream);
    Params p{};
    for (int i = 0; i < 23; ++i) p.in[i] = (const float*)d_in[i];
    p.out = (float*)d_out; p.ws = (unsigned char*)d_ws;
    hipLaunchKernelGGL(fwd_kernel, dim3(grid), dim3(NTHR), LDS_BYTES, stream, p);
    const hipError_t le = hipPeekAtLastError();
    if (le != hipSuccess) fprintf(stderr, "kernel_launch: launch failed: %s\n", hipGetErrorName(le));
}
```

```cpp
#include <hip/hip_runtime.h>
#include <cstdio>
#include <cstdint>

#define LAS __attribute__((address_space(3)))
typedef unsigned short bf16_t;
typedef short bf16x8 __attribute__((ext_vector_type(8)));
typedef float f32x4 __attribute__((ext_vector_type(4)));
typedef float f32x2 __attribute__((ext_vector_type(2)));
typedef unsigned u32x4 __attribute__((ext_vector_type(4)));
typedef unsigned u32x2 __attribute__((ext_vector_type(2)));
typedef unsigned short u16x4 __attribute__((ext_vector_type(4)));

constexpr int DM = 2048, SEQ = 2048, NBP = 4, NBS = 8, TSAMP = 4, PAST = 16384;
constexpr int MP = NBP * SEQ, MSAMP = NBS * TSAMP, MR = MP + MSAMP, MT = 8448;
constexpr int NQKV = 9216, NIN = 6144, NIN_SRC = 6160, DFF = 5632, NUP = 2 * DFF, DO = 1024;
constexpr int DEPTH = 4;
constexpr float EPS = 1e-6f;
constexpr int NWAVES = 8, NTHR = 512;

constexpr size_t O_YP = 0;
constexpr size_t O_YS = O_YP + (size_t)MP * DM;
constexpr size_t O_KV128P = O_YS + (size_t)MSAMP * DM;
constexpr size_t O_KV128S = O_KV128P + (size_t)2 * NBP * 128 * 2048;
constexpr size_t O_KV512P = O_KV128S + (size_t)2 * NBS * 128 * 2048;
constexpr size_t O_KV512S = O_KV512P + (size_t)2 * NBP * 512 * 2048;
constexpr size_t O_KV2048P = O_KV512S + (size_t)2 * NBS * 512 * 2048;
constexpr size_t O_KV2048S = O_KV2048P + (size_t)2 * NBP * 2048 * 2048;
constexpr size_t O_CP = O_KV2048S + (size_t)2 * NBS * 2048 * 2048;
constexpr size_t O_CS = O_CP + (size_t)2 * NBP * 8 * 256 * 128;
constexpr size_t O_NP = O_CS + (size_t)2 * NBS * 8 * 256 * 128;
constexpr size_t O_NS = O_NP + (size_t)2 * NBP * 8 * 128;
constexpr size_t O_MP = O_NS + (size_t)2 * NBS * 8 * 128;
constexpr size_t O_MS = O_MP + (size_t)2 * NBP * 8;
constexpr size_t O_CONVP = O_MS + (size_t)2 * NBS * 8;
constexpr size_t O_CONVS = O_CONVP + (size_t)DEPTH * NBP * 2 * NUP;
constexpr size_t O_END = O_CONVS + (size_t)DEPTH * NBS * 2 * NUP;

constexpr size_t al1m(size_t x) { return (x + 1048575) & ~(size_t)1048575; }
constexpr size_t WS_CTL = 0, CTL_ZERO_BYTES = 1048576;
constexpr size_t SZ_WQKV = (size_t)NQKV * DM * 2, SZ_WO = (size_t)DM * DO * 2, SZ_WIN = (size_t)NIN * DM * 2, SZ_WOUT = (size_t)DM * DM * 2, SZ_WUP = (size_t)NUP * DM * 2, SZ_WDOWN = (size_t)DM * DFF * 2;
constexpr size_t WS_WQKV = al1m(WS_CTL + CTL_ZERO_BYTES);
constexpr size_t WS_WO = al1m(WS_WQKV + 2 * SZ_WQKV);
constexpr size_t WS_WIN = al1m(WS_WO + 2 * SZ_WO);
constexpr size_t WS_WOUT = al1m(WS_WIN + 2 * SZ_WIN);
constexpr size_t WS_WUP = al1m(WS_WOUT + 2 * SZ_WOUT);
constexpr size_t WS_WDOWN = al1m(WS_WUP + 4 * SZ_WUP);
constexpr size_t WS_X = al1m(WS_WDOWN + 4 * SZ_WDOWN);
constexpr size_t WS_XB = al1m(WS_X + (size_t)MT * DM * 4);
constexpr size_t WS_SSQ = al1m(WS_XB + (size_t)MT * DM * 2);
constexpr size_t WS_SSQS = al1m(WS_SSQ + (size_t)MP * 32 * 4);
constexpr size_t WS_QKV = al1m(WS_SSQS + (size_t)MSAMP * 128 * 4);
constexpr size_t WS_OG = al1m(WS_QKV + (size_t)MT * NQKV * 2);
constexpr size_t WS_LSE = al1m(WS_OG + (size_t)MT * 3072 * 2);
constexpr size_t WS_OC = al1m(WS_LSE + (size_t)MT * 24 * 4);
constexpr size_t WS_GATES = al1m(WS_OC + (size_t)MT * DM * 2);
constexpr size_t WS_U = al1m(WS_GATES + (size_t)MT * 16 * 4);
constexpr size_t WS_Z = al1m(WS_U + (size_t)MT * NUP * 2);
constexpr size_t WS_SQ = al1m(WS_Z + (size_t)MT * DFF * 2);
constexpr size_t WS_ROPE = al1m(WS_SQ + (size_t)MP * 128 * 4);
constexpr size_t WS_WGP = al1m(WS_ROPE + (size_t)2052 * 128 * 4);
constexpr size_t WS_HALO = al1m(WS_WGP + (size_t)2 * 128 * 64 * 16);
constexpr size_t WS_END = al1m(WS_HALO + (size_t)64 * NUP * 4);
constexpr int CW_HCNT = 65536, CW_TMO = 65600, CW_CSQ = 65664;

constexpr int RING_BYTES = 131072;
constexpr int LDS_MISC_OFF = 150 * 1024;
constexpr int LDS_BYTES = 152 * 1024;

__device__ __forceinline__ unsigned pk2(float lo, float hi) { unsigned r; asm("v_cvt_pk_bf16_f32 %0, %1, %2" : "=v"(r) : "v"(lo), "v"(hi)); return r; }
__device__ __forceinline__ unsigned f2bf(float f) { return pk2(f, 0.f) & 0xffffu; }
__device__ __forceinline__ float bflo(unsigned w) { return __builtin_bit_cast(float, w << 16); }
__device__ __forceinline__ float bfhi(unsigned w) { return __builtin_bit_cast(float, w & 0xffff0000u); }
__device__ __forceinline__ float bf1(bf16_t b) { return __builtin_bit_cast(float, (unsigned)b << 16); }
__device__ __forceinline__ float fexp(float x) { return __builtin_amdgcn_exp2f(x * 1.4426950408889634f); }
template <int CTRL> __device__ __forceinline__ float dpp_mov(float src) { return __builtin_bit_cast(float, __builtin_amdgcn_mov_dpp(__builtin_bit_cast(int, src), CTRL, 0xf, 0xf, false)); }
__device__ __forceinline__ float row4_sum(float v) { v += dpp_mov<0xB1>(v); v += dpp_mov<0x4E>(v); return v; }
__device__ __forceinline__ float row8_sum(float v) { v = row4_sum(v); v += dpp_mov<0x141>(v); return v; }
__device__ __forceinline__ float row16_sum(float v) { v = row8_sum(v); v += dpp_mov<0x140>(v); return v; }
#define LDS_BARRIER() do { asm volatile("s_waitcnt lgkmcnt(0)" ::: "memory"); __builtin_amdgcn_s_barrier(); asm volatile("" ::: "memory"); } while (0)
__device__ __forceinline__ float wave_sum(float v) {
#pragma unroll
    for (int o = 1; o < 64; o <<= 1) v += __shfl_xor(v, o);
    return v;
}
__device__ __forceinline__ float wave_max(float v) {
#pragma unroll
    for (int o = 1; o < 64; o <<= 1) v = fmaxf(v, __shfl_xor(v, o));
    return v;
}
__device__ __forceinline__ f32x4 mma16(bf16x8 a, bf16x8 b, f32x4 c) { return __builtin_amdgcn_mfma_f32_16x16x32_bf16(a, b, c, 0, 0, 0); }
__device__ __forceinline__ bf16x8 tr_read2(unsigned base, int off0, int off1) {
    u16x4 r0, r1;
    asm volatile("ds_read_b64_tr_b16 %0, %2 offset:%c3\n\tds_read_b64_tr_b16 %1, %2 offset:%c4\n\ts_waitcnt lgkmcnt(0)" : "=&v"(r0), "=&v"(r1) : "v"(base), "i"(off0), "i"(off1) : "memory");
    bf16x8 o; o[0] = (short)r0[0]; o[1] = (short)r0[1]; o[2] = (short)r0[2]; o[3] = (short)r0[3]; o[4] = (short)r1[0]; o[5] = (short)r1[1]; o[6] = (short)r1[2]; o[7] = (short)r1[3];
    return o;
}

__device__ __forceinline__ bf16x8 tr_join(u16x4 r0, u16x4 r1) { bf16x8 o; o[0] = (short)r0[0]; o[1] = (short)r0[1]; o[2] = (short)r0[2]; o[3] = (short)r0[3]; o[4] = (short)r1[0]; o[5] = (short)r1[1]; o[6] = (short)r1[2]; o[7] = (short)r1[3]; return o; }
#define TR_RD "ds_read_b64_tr_b16 "
#define TR_READ4(F0, F1, F2, F3, base, a0, a1, b0, b1, c0, c1, d0, d1) do { u16x4 t0_, t1_, t2_, t3_, t4_, t5_, t6_, t7_; \
    asm volatile(TR_RD "%0, %8 offset:%c9\n\t" TR_RD "%1, %8 offset:%c10\n\t" TR_RD "%2, %8 offset:%c11\n\t" TR_RD "%3, %8 offset:%c12\n\t" TR_RD "%4, %8 offset:%c13\n\t" TR_RD "%5, %8 offset:%c14\n\t" TR_RD "%6, %8 offset:%c15\n\t" TR_RD "%7, %8 offset:%c16\n\ts_waitcnt lgkmcnt(0)" \
        : "=&v"(t0_), "=&v"(t1_), "=&v"(t2_), "=&v"(t3_), "=&v"(t4_), "=&v"(t5_), "=&v"(t6_), "=&v"(t7_) : "v"(base), "i"(a0), "i"(a1), "i"(b0), "i"(b1), "i"(c0), "i"(c1), "i"(d0), "i"(d1) : "memory"); \
    F0 = tr_join(t0_, t1_); F1 = tr_join(t2_, t3_); F2 = tr_join(t4_, t5_); F3 = tr_join(t6_, t7_); } while (0)
#define TR_READ5(F0, F1, F2, F3, F4, base, a0, a1, b0, b1, c0, c1, d0, d1, e0, e1) do { u16x4 t0_, t1_, t2_, t3_, t4_, t5_, t6_, t7_, t8_, t9_; \
    asm volatile(TR_RD "%0, %10 offset:%c11\n\t" TR_RD "%1, %10 offset:%c12\n\t" TR_RD "%2, %10 offset:%c13\n\t" TR_RD "%3, %10 offset:%c14\n\t" TR_RD "%4, %10 offset:%c15\n\t" TR_RD "%5, %10 offset:%c16\n\t" TR_RD "%6, %10 offset:%c17\n\t" TR_RD "%7, %10 offset:%c18\n\t" TR_RD "%8, %10 offset:%c19\n\t" TR_RD "%9, %10 offset:%c20\n\ts_waitcnt lgkmcnt(0)" \
        : "=&v"(t0_), "=&v"(t1_), "=&v"(t2_), "=&v"(t3_), "=&v"(t4_), "=&v"(t5_), "=&v"(t6_), "=&v"(t7_), "=&v"(t8_), "=&v"(t9_) : "v"(base), "i"(a0), "i"(a1), "i"(b0), "i"(b1), "i"(c0), "i"(c1), "i"(d0), "i"(d1), "i"(e0), "i"(e1) : "memory"); \
    F0 = tr_join(t0_, t1_); F1 = tr_join(t2_, t3_); F2 = tr_join(t4_, t5_); F3 = tr_join(t6_, t7_); F4 = tr_join(t8_, t9_); } while (0)
__device__ __forceinline__ bf16x8 pack8(f32x4 a, f32x4 b) {
    u32x4 w; w.x = pk2(a[0], a[1]); w.y = pk2(a[2], a[3]); w.z = pk2(b[0], b[1]); w.w = pk2(b[2], b[3]);
    return __builtin_bit_cast(bf16x8, w);
}

namespace pg8 {
#define PG8_LAS __attribute__((address_space(3)))
typedef unsigned short bf16_t;
typedef short bf16x8 __attribute__((ext_vector_type(8)));
typedef float f32x4 __attribute__((ext_vector_type(4)));
typedef unsigned u32x4 __attribute__((ext_vector_type(4)));
constexpr int BM = 256, BK = 64, HALF = 128, HTB = HALF * BK * 2  , STAGE_BYTES = 8 * HTB, NXCD = 8, WGM = 8;

__host__ __device__ __forceinline__ int lds_byte(int r, int c) { const int st = (r >> 4) * 2 + (c >> 5), rr = r & 15, cc = c & 31, ob = rr * 64 + cc * 2; return st * 1024 + (ob ^ (((ob >> 9) & 1) << 5)); }
__host__ __device__ __forceinline__ void stage_rc(int b, int& R, int& C) { const int st = b / 1024, sb = b % 1024, swz = sb ^ (((sb >> 9) & 1) << 5); R = (st >> 1) * 16 + swz / 64; C = (st & 1) * 32 + (swz % 64) / 2; }
__host__ __device__ __forceinline__ int perm32(int rho) { const int n = rho >> 4, i = rho & 15; return 8 * (i >> 2) + 4 * n + (i & 3); }

struct Unit { int pm, pn; };
struct Gemm { const bf16_t* A; const bf16_t* Bt; int M, N, K; };

struct StaticOrder {
    int nM, nN, nwg, G, c;
    __host__ __device__ void init(int M, int N, int G_, int c_) { nM = M / BM; nN = N / BM; nwg = nM * nN; G = G_; c = c_; }
    __host__ __device__ bool next(int i, Unit& u) const {
        const long L = (long)i * G + c; if (L >= nwg) return false;
        int wgid = (int)L; { const int q = nwg / NXCD, r = nwg % NXCD, xcd = wgid % NXCD, off = wgid / NXCD; wgid = (xcd < r ? xcd * (q + 1) : r * (q + 1) + (xcd - r) * q) + off; }
        const int nig = WGM * nN, gid = wgid / nig, fm = gid * WGM, gsz = (nM - fm) < WGM ? (nM - fm) : WGM;
        u.pm = fm + ((wgid % nig) % gsz); u.pn = (wgid % nig) / gsz; return true;
    }
    __device__ __forceinline__ void a_ready(const Unit&) const {}
    __device__ __forceinline__ void done(const Unit&) const {}
};
__device__ __forceinline__ unsigned cvt_pk_bf16(float lo, float hi) { unsigned r; asm volatile("v_cvt_pk_bf16_f32 %0, %1, %2" : "=v"(r) : "v"(lo), "v"(hi)); return r; }

struct EpiStore {
    static constexpr bool PERM = true, AFTER_DRAIN = false;
    bf16_t* O; int ldc;
    __device__ __forceinline__ void operator()(const f32x4 (&acc)[2][2][4][2], const Unit& u, int wr, int wc, int fr, int fq) const {
        const int row0 = u.pm * BM + wr * 64 + fr, col0 = u.pn * BM + wc * 32 + 8 * fq;
#pragma unroll
        for (int ai = 0; ai < 2; ++ai)
#pragma unroll
            for (int m = 0; m < 4; ++m) { bf16_t* rowp = O + (size_t)(row0 + ai * HALF + m * 16) * ldc + col0;
#pragma unroll
                for (int bj = 0; bj < 2; ++bj) { const f32x4 v0 = acc[ai][bj][m][0], v1 = acc[ai][bj][m][1];
                    u32x4 w; w.x = cvt_pk_bf16(v0[0], v0[1]); w.y = cvt_pk_bf16(v0[2], v0[3]); w.z = cvt_pk_bf16(v1[0], v1[1]); w.w = cvt_pk_bf16(v1[2], v1[3]);
                    *(u32x4*)(rowp + bj * HALF) = w; } }
    }
};
struct EpiResid {
    static constexpr bool PERM = false, AFTER_DRAIN = false;
    const float* xin; float* out; int ldc; int mrows;
    __device__ __forceinline__ void operator()(const f32x4 (&acc)[2][2][4][2], const Unit& u, int wr, int wc, int fr, int fq) const {
        const int row0 = u.pm * BM + wr * 64 + fr, col0 = u.pn * BM + wc * 32 + 4 * fq;
#pragma unroll
        for (int ai = 0; ai < 2; ++ai)
#pragma unroll
            for (int m = 0; m < 4; ++m) { const int r = row0 + ai * HALF + m * 16;
                if (r < mrows) { const size_t off = (size_t)r * ldc + col0;
#pragma unroll
                    for (int bj = 0; bj < 2; ++bj)
#pragma unroll
                        for (int n = 0; n < 2; ++n) { const f32x4 bs = *(const f32x4*)(xin + off + bj * HALF + n * 16); *(f32x4*)(out + off + bj * HALF + n * 16) = bs + acc[ai][bj][m][n]; } }
                asm volatile("" ::: "memory"); }
    }
};


struct EpiStoreN {
    static constexpr bool PERM = true, AFTER_DRAIN = false;
    bf16_t* O; int ldc; const float* ssq; float eps; const PG8_LAS float* rs_tab; int rs_pm;
    __device__ __forceinline__ void operator()(const f32x4 (&acc)[2][2][4][2], const Unit& u, int wr, int wc, int fr, int fq) const {
        const int row0 = u.pm * BM + wr * 64 + fr, col0 = u.pn * BM + wc * 32 + 8 * fq;
        const bool cached = (u.pm == rs_pm);
#pragma unroll
        for (int ai = 0; ai < 2; ++ai)
#pragma unroll
            for (int m = 0; m < 4; ++m) { const int r = row0 + ai * HALF + m * 16;
                float rs;
                if (cached) rs = rs_tab[wr * 64 + fr + ai * HALF + m * 16];
                else { const f32x4 p0 = *(const f32x4*)(ssq + (size_t)r * 32 + 8 * fq), p1 = *(const f32x4*)(ssq + (size_t)r * 32 + 8 * fq + 4);
                    float s = ((p0[0] + p0[1]) + (p0[2] + p0[3])) + ((p1[0] + p1[1]) + (p1[2] + p1[3]));
                    s += __shfl_xor(s, 16); s += __shfl_xor(s, 32);
                    rs = rsqrtf(s * (1.f / 2048.f) + eps); }
                bf16_t* rowp = O + (size_t)r * ldc + col0;
#pragma unroll
                for (int bj = 0; bj < 2; ++bj) { const f32x4 v0 = acc[ai][bj][m][0] * rs, v1 = acc[ai][bj][m][1] * rs;
                    u32x4 w; w.x = cvt_pk_bf16(v0[0], v0[1]); w.y = cvt_pk_bf16(v0[2], v0[3]); w.z = cvt_pk_bf16(v1[0], v1[1]); w.w = cvt_pk_bf16(v1[2], v1[3]);
                    *(u32x4*)(rowp + bj * HALF) = w; } }
    }
};
__device__ __forceinline__ int first_pm(const StaticOrder& S) { const int wg0 = S.c; const int q = S.nwg / NXCD, r = S.nwg % NXCD, xcd = wg0 % NXCD, off = wg0 / NXCD; const int wgid = (xcd < r ? xcd * (q + 1) : r * (q + 1) + (xcd - r) * q) + off;
    const int nig = WGM * S.nN, gid = wgid / nig, fm = gid * WGM, gsz = (S.nM - fm) < WGM ? (S.nM - fm) : WGM; return fm + ((wgid % nig) % gsz); }
__device__ __forceinline__ void rstd_panel(PG8_LAS float* tab, const float* ssq, int pm, float eps, int tid) {
    const int row = tid >> 1, hf = tid & 1; const float* q = ssq + (size_t)(pm * BM + row) * 32 + 16 * hf;
    const f32x4 a = *(const f32x4*)q, b = *(const f32x4*)(q + 4), c = *(const f32x4*)(q + 8), d = *(const f32x4*)(q + 12);
    float s = (((a[0] + a[1]) + (a[2] + a[3])) + ((b[0] + b[1]) + (b[2] + b[3]))) + (((c[0] + c[1]) + (c[2] + c[3])) + ((d[0] + d[1]) + (d[2] + d[3])));
    s += __shfl_xor(s, 1);
    if (hf == 0) tab[row] = rsqrtf(s * (1.f / 2048.f) + eps);
    __syncthreads();
}
struct EpiResidN {
    static constexpr bool PERM = true, AFTER_DRAIN = false;
    bf16_t* xb; float* fin; float* ssq; int ldc;
    __device__ __forceinline__ void operator()(const f32x4 (&acc)[2][2][4][2], const Unit& u, int wr, int wc, int fr, int fq) const {
        const int row0 = u.pm * BM + wr * 64 + fr, col0 = u.pn * BM + wc * 32 + 8 * fq;
#pragma unroll
        for (int ai = 0; ai < 2; ++ai)
#pragma unroll
            for (int m = 0; m < 4; ++m) { const int r = row0 + ai * HALF + m * 16; const size_t off = (size_t)r * ldc + col0; float sq = 0.f;
#pragma unroll
                for (int bj = 0; bj < 2; ++bj) { const u32x4 xw = *(const u32x4*)(xb + off + bj * HALF);
                    f32x4 v0 = acc[ai][bj][m][0], v1 = acc[ai][bj][m][1];
                    v0[0] += __builtin_bit_cast(float, xw.x << 16); v0[1] += __builtin_bit_cast(float, xw.x & 0xffff0000u); v0[2] += __builtin_bit_cast(float, xw.y << 16); v0[3] += __builtin_bit_cast(float, xw.y & 0xffff0000u);
                    v1[0] += __builtin_bit_cast(float, xw.z << 16); v1[1] += __builtin_bit_cast(float, xw.z & 0xffff0000u); v1[2] += __builtin_bit_cast(float, xw.w << 16); v1[3] += __builtin_bit_cast(float, xw.w & 0xffff0000u);
                    if (fin) { *(f32x4*)(fin + off + bj * HALF) = v0; *(f32x4*)(fin + off + bj * HALF + 4) = v1; }
                    else { u32x4 w; w.x = cvt_pk_bf16(v0[0], v0[1]); w.y = cvt_pk_bf16(v0[2], v0[3]); w.z = cvt_pk_bf16(v1[0], v1[1]); w.w = cvt_pk_bf16(v1[2], v1[3]); *(u32x4*)(xb + off + bj * HALF) = w; }
                    sq += ((v0[0] * v0[0] + v0[1] * v0[1]) + (v0[2] * v0[2] + v0[3] * v0[3])) + ((v1[0] * v1[0] + v1[1] * v1[1]) + (v1[2] * v1[2] + v1[3] * v1[3])); }
                if (ssq) { sq += __shfl_xor(sq, 16); sq += __shfl_xor(sq, 32); if (fq == 0) ssq[(size_t)r * 32 + u.pn * 4 + wc] = sq; }
                if (m == 3) asm volatile("" ::: "memory"); }
    }
};
template <int CTRL> __device__ __forceinline__ float dppf(float oldv, float src) {
    return __builtin_bit_cast(float, __builtin_amdgcn_update_dpp(__builtin_bit_cast(int, oldv), __builtin_bit_cast(int, src), CTRL, 0xf, 0xf, false)); }
template <int CTRL> __device__ __forceinline__ float dppr(float src) {
    return __builtin_bit_cast(float, __builtin_amdgcn_mov_dpp(__builtin_bit_cast(int, src), CTRL, 0xf, 0xf, false)); }
struct EpiConv {
    static constexpr bool PERM = true, AFTER_DRAIN = false;
    static constexpr size_t WS_Z_ = ::WS_Z, WS_SSQ_ = ::WS_SSQ, WS_HALO_ = ::WS_HALO; static constexpr int CW_HCNT_ = ::CW_HCNT, CW_TMO_ = ::CW_TMO;
    unsigned char* wsb; const float* cw; const float* cb; PG8_LAS unsigned char* ldsx; unsigned target; int rs_pm;
    __device__ __forceinline__ void operator()(f32x4 (&acc)[2][2][4][2], const Unit& u, int wr, int wc, int fr_in, int fq_in) const {
        int fr = fr_in, fq = fq_in; asm volatile("" : "+v"(fr), "+v"(fq));
        bf16_t* Z = (bf16_t*)(wsb + WS_Z_); const float* ssq = (const float*)(wsb + WS_SSQ_); const float* halo = (const float*)(wsb + WS_HALO_); const float eps = 1e-6f;
        unsigned* hcnt = (unsigned*)wsb + CW_HCNT_; unsigned* tmo = (unsigned*)wsb + CW_TMO_;
        const PG8_LAS float* rs_tab = (const PG8_LAS float*)ldsx; PG8_LAS f32x4* xch = (PG8_LAS f32x4*)(ldsx + 1024); volatile PG8_LAS unsigned* ready = (volatile PG8_LAS unsigned*)(ldsx + 1024 + 8192);
        const int row0 = u.pm * BM + wr * 64 + fr;
        const bool cached = (u.pm == rs_pm);
#pragma unroll
        for (int ai = 0; ai < 2; ++ai)
#pragma unroll
            for (int m = 0; m < 4; ++m) { const int r = row0 + ai * HALF + m * 16; float rs;
                if (cached) rs = rs_tab[wr * 64 + fr + ai * HALF + m * 16];
                else { const f32x4 p0 = *(const f32x4*)(ssq + (size_t)r * 32 + 8 * fq), p1 = *(const f32x4*)(ssq + (size_t)r * 32 + 8 * fq + 4);
                    float s = ((p0[0] + p0[1]) + (p0[2] + p0[3])) + ((p1[0] + p1[1]) + (p1[2] + p1[3]));
                    s += __shfl_xor(s, 16); s += __shfl_xor(s, 32); rs = rsqrtf(s * (1.f / 2048.f) + eps); }
#pragma unroll
                for (int bj = 0; bj < 2; ++bj) { acc[ai][bj][m][0] *= rs; acc[ai][bj][m][1] *= rs; } }
        f32x4 hal[2][2];
#pragma unroll
        for (int bj = 0; bj < 2; ++bj) { hal[bj][0] = (f32x4){0.f, 0.f, 0.f, 0.f}; hal[bj][1] = (f32x4){0.f, 0.f, 0.f, 0.f}; }
        if (wr == 0 && (u.pm & 7) != 0) {
            if (ready[0] == 0u) { unsigned spins = 0;
                while (__hip_atomic_load(hcnt, __ATOMIC_RELAXED, __HIP_MEMORY_SCOPE_AGENT) < target) { __builtin_amdgcn_s_sleep(2);
                    if (++spins > (1u << 20)) { __hip_atomic_store(tmo, 1u, __ATOMIC_RELAXED, __HIP_MEMORY_SCOPE_AGENT); break; } }
                ready[0] = 1u; }
            if (fr >= 14) { const unsigned long long* hp = (const unsigned long long*)(halo + (size_t)(2 * (u.pm - 1) + (fr - 14)) * 11264 + u.pn * 256 + wc * 32 + 8 * fq);
#pragma unroll
                for (int bj = 0; bj < 2; ++bj)
#pragma unroll
                    for (int n = 0; n < 2; ++n) { const unsigned long long lo = __hip_atomic_load(hp + bj * 64 + 2 * n, __ATOMIC_RELAXED, __HIP_MEMORY_SCOPE_AGENT), hi = __hip_atomic_load(hp + bj * 64 + 2 * n + 1, __ATOMIC_RELAXED, __HIP_MEMORY_SCOPE_AGENT);
                        hal[bj][n] = (f32x4){__builtin_bit_cast(float, (unsigned)lo), __builtin_bit_cast(float, (unsigned)(lo >> 32)), __builtin_bit_cast(float, (unsigned)hi), __builtin_bit_cast(float, (unsigned)(hi >> 32))}; } } }
        if (fr >= 14) {
#pragma unroll
            for (int ai = 0; ai < 2; ++ai)
#pragma unroll
                for (int bj = 0; bj < 2; ++bj)
#pragma unroll
                    for (int n = 0; n < 2; ++n) xch[(((((ai * 2 + wr) * 4 + wc) * 2 + (fr & 1)) * 4 + fq) * 4) + bj * 2 + n] = acc[ai][bj][3][n]; }
        asm volatile("s_waitcnt lgkmcnt(0)" ::: "memory"); __builtin_amdgcn_s_barrier(); asm volatile("" ::: "memory");
        const int jn0 = u.pn * 128 + wc * 32 + 8 * fq;
        u32x2 zk[2][4];
#pragma unroll
        for (int n = 0; n < 2; ++n) {
            const float* wp = cw + jn0 + 4 * n; const float* bp = cb + jn0 + 4 * n;
            const f32x4 wa0 = *(const f32x4*)wp, wa1 = *(const f32x4*)(wp + 11264), wa2 = *(const f32x4*)(wp + 2 * 11264), ba = *(const f32x4*)bp;
            const f32x4 wb0 = *(const f32x4*)(wp + 5632), wb1 = *(const f32x4*)(wp + 11264 + 5632), wb2 = *(const f32x4*)(wp + 2 * 11264 + 5632), bb = *(const f32x4*)(bp + 5632);
#pragma unroll
            for (int ai = 0; ai < 2; ++ai) {
                f32x4 pa, pb;
                if (ai == 0 && wr == 0) { pa = hal[0][n]; pb = hal[1][n]; }
                else { const int sai = wr ? ai : ai - 1, swr = wr ^ 1; const int xi = (((((sai * 2 + swr) * 4 + wc) * 2 + (fr & 1)) * 4 + fq) * 4) + n; pa = xch[xi]; pb = xch[xi + 2]; }
#pragma unroll
                for (int m = 0; m < 4; ++m) {
                    const f32x4 ca4 = acc[ai][0][m][n], cb4 = acc[ai][1][m][n]; float z[4];
#pragma unroll
                    for (int i = 0; i < 4; ++i) {
                        const float a1 = dppf<0x111>(dppr<0x121>(pa[i]), ca4[i]), a2 = dppf<0x112>(dppr<0x122>(pa[i]), ca4[i]);
                        const float b1 = dppf<0x111>(dppr<0x121>(pb[i]), cb4[i]), b2 = dppf<0x112>(dppr<0x122>(pb[i]), cb4[i]);
                        const float ca = ba[i] + wa0[i] * a2 + wa1[i] * a1 + wa2[i] * ca4[i];
                        const float cbv = bb[i] + wb0[i] * b2 + wb1[i] * b1 + wb2[i] * cb4[i];
                        z[i] = ca * __builtin_amdgcn_rcpf(1.f + __builtin_amdgcn_exp2f(ca * -1.4426950408889634f)) * cbv; }
                    u32x2 w; w.x = cvt_pk_bf16(z[0], z[1]); w.y = cvt_pk_bf16(z[2], z[3]);
                    if (n == 0) zk[ai][m] = w;
                    else { u32x4 w4; w4.x = zk[ai][m].x; w4.y = zk[ai][m].y; w4.z = w.x; w4.w = w.y; *(u32x4*)(Z + (size_t)(row0 + ai * HALF + m * 16) * 5632 + jn0) = w4; }
                    pa = ca4; pb = cb4; }
            }
        }
    }
};
template <class Epi, class Sched, bool ALIGN_EPI = false, bool SP2 = false>
__device__ __forceinline__ void gemm_phase(PG8_LAS unsigned char* lds, const Gemm g, const Sched& S, const Epi& E) {
    int tid = threadIdx.x; asm volatile("" : "+v"(tid));
    const int wid = __builtin_amdgcn_readfirstlane(tid >> 6), lane = tid & 63, wr = wid >> 2, wc = wid & 3, fr = lane & 15, fq = lane >> 4;
    const int K = g.K, nt = K / BK;
    unsigned voffA[2], voffB[2];
#pragma unroll
    for (int i = 0; i < 2; ++i) { int R, C; stage_rc(tid * 16 + i * 8192, R, C); const int Rb = Epi::PERM ? ((R & ~31) + perm32(R & 31)) : R;
        voffA[i] = (unsigned)(R * K + C) * 2u; voffB[i] = (unsigned)(Rb * K + C) * 2u; }
    const size_t kstep = (size_t)(BK * 2);
    const size_t hstep = (size_t)HALF * K * 2;
    const size_t tstep = 2 * hstep;
    const unsigned ldsw = (unsigned)wid * 1024u;
    const int aoff = lds_byte(wr * 64 + fr, fq * 8), boff = lds_byte(wc * 32 + fr, fq * 8);
#define PG8_SA(b, h) (((b) * 2 + (h)) * HTB)
#define PG8_SB(b, h) ((4 + (b) * 2 + (h)) * HTB)
#define PG8_STAGE(bufoff, gbase, voff) do { _Pragma("unroll") for (int _i = 0; _i < 2; ++_i) \
        __builtin_amdgcn_global_load_lds((const unsigned*)((const char*)(gbase) + (voff)[_i]), (PG8_LAS unsigned*)(lds + (bufoff) + ldsw + _i * 8192), 16, 0, 0); } while (0)
#define PG8_LDA(dst, b, h) do { _Pragma("unroll") for (int m = 0; m < 4; ++m) _Pragma("unroll") for (int k = 0; k < 2; ++k) dst[m][k] = *(const PG8_LAS bf16x8*)(lds + PG8_SA(b, h) + aoff + m * 2048 + k * 1024); } while (0)
#define PG8_LDB(dst, b, h) do { _Pragma("unroll") for (int n = 0; n < 2; ++n) _Pragma("unroll") for (int k = 0; k < 2; ++k) dst[n][k] = *(const PG8_LAS bf16x8*)(lds + PG8_SB(b, h) + boff + n * 2048 + k * 1024); } while (0)
#define PG8_MMA(ai, bj, At, Bt) do { __builtin_amdgcn_s_setprio(1); _Pragma("unroll") for (int m = 0; m < 4; ++m) _Pragma("unroll") for (int n = 0; n < 2; ++n) _Pragma("unroll") for (int k = 0; k < 2; ++k) \
        acc[ai][bj][m][n] = __builtin_amdgcn_mfma_f32_16x16x32_bf16(Bt[n][k], At[m][k], acc[ai][bj][m][n], 0, 0, 0); __builtin_amdgcn_s_setprio(0); } while (0)
#define PG8_WAIT_V(n) asm volatile("s_waitcnt vmcnt(" #n ")" ::: "memory")
#define PG8_WAIT_L(n) asm volatile("s_waitcnt lgkmcnt(" #n ")" ::: "memory")
#define PG8_BAR __builtin_amdgcn_s_barrier()
#define PG8_SCHED __builtin_amdgcn_sched_barrier(0)
    Unit cur, nxt; int ui = 0;
    if (!S.next(0, cur)) return;
    f32x4 acc[2][2][4][2];
#pragma unroll
    for (int a = 0; a < 2; ++a)
#pragma unroll
        for (int b = 0; b < 2; ++b)
#pragma unroll
            for (int m = 0; m < 4; ++m)
#pragma unroll
                for (int n = 0; n < 2; ++n) acc[a][b][m][n] = (f32x4){0.f, 0.f, 0.f, 0.f};
    bf16x8 At[4][2], B0[2][2], B1[2][2];
    const char* cA = (const char*)g.A + (size_t)cur.pm * tstep; const char* cB = (const char*)g.Bt + (size_t)cur.pn * tstep;
    S.a_ready(cur);
    if constexpr (SP2) {
        PG8_STAGE(PG8_SB(0, 0), cB, voffB); PG8_STAGE(PG8_SB(0, 1), cB + hstep, voffB); PG8_STAGE(PG8_SA(0, 0), cA, voffA); PG8_STAGE(PG8_SA(0, 1), cA + hstep, voffA);
        if (wr == 1) PG8_BAR;
        PG8_WAIT_V(2); PG8_BAR;
        PG8_STAGE(PG8_SB(1, 0), cB + kstep, voffB); PG8_STAGE(PG8_SA(1, 0), cA + kstep, voffA); PG8_STAGE(PG8_SB(1, 1), cB + hstep + kstep, voffB);
        PG8_WAIT_V(6); PG8_BAR;
    } else {
        PG8_STAGE(PG8_SB(0, 0), cB, voffB); PG8_STAGE(PG8_SA(0, 0), cA, voffA); PG8_STAGE(PG8_SB(0, 1), cB + hstep, voffB); PG8_STAGE(PG8_SA(0, 1), cA + hstep, voffA);
        if (wr == 1) PG8_BAR;
        PG8_WAIT_V(4); PG8_BAR;
        PG8_STAGE(PG8_SB(1, 0), cB + kstep, voffB); PG8_STAGE(PG8_SA(1, 0), cA + kstep, voffA); PG8_STAGE(PG8_SB(1, 1), cB + hstep + kstep, voffB);
        PG8_WAIT_V(6); PG8_BAR;
    }
    for (;;) {
        const bool has_next = S.next(ui + 1, nxt);
        const char* nA = has_next ? (const char*)g.A + (size_t)nxt.pm * tstep : cA; const char* nB = has_next ? (const char*)g.Bt + (size_t)nxt.pn * tstep : cB;
        for (int t = 0; t < nt; t += 2) {
            const bool last = (t == nt - 2);
            const char* a1 = cA + (size_t)(t + 1) * kstep;
            const char* a2 = last ? nA : cA + (size_t)(t + 2) * kstep; const char* b2 = last ? nB : cB + (size_t)(t + 2) * kstep;
            const char* a3 = a2 + kstep; const char* b3 = b2 + kstep;
            if (last && has_next) S.a_ready(nxt);
            if constexpr (SP2) {
            PG8_LDB(B0, 0, 0); PG8_LDB(B1, 0, 1); PG8_SCHED; PG8_LDA(At, 0, 0); PG8_STAGE(PG8_SA(1, 1), a1 + hstep, voffA);
            PG8_WAIT_V(8); PG8_WAIT_L(0); PG8_BAR; PG8_MMA(0, 0, At, B0); PG8_MMA(0, 1, At, B1); PG8_BAR; PG8_SCHED;
            PG8_LDA(At, 0, 1); PG8_STAGE(PG8_SB(0, 0), b2, voffB); PG8_STAGE(PG8_SB(0, 1), b2 + hstep, voffB); PG8_STAGE(PG8_SA(0, 0), a2, voffA);
            PG8_WAIT_V(8); PG8_WAIT_L(0); PG8_BAR; PG8_MMA(1, 0, At, B0); PG8_MMA(1, 1, At, B1); PG8_BAR; PG8_SCHED;
            PG8_LDB(B0, 1, 0); PG8_LDB(B1, 1, 1); PG8_SCHED; PG8_LDA(At, 1, 0); PG8_STAGE(PG8_SA(0, 1), a2 + hstep, voffA);
            PG8_WAIT_V(8); PG8_WAIT_L(0); PG8_BAR; PG8_MMA(0, 0, At, B0); PG8_MMA(0, 1, At, B1); PG8_BAR; PG8_SCHED;
            PG8_LDA(At, 1, 1); PG8_STAGE(PG8_SB(1, 0), b3, voffB); PG8_STAGE(PG8_SB(1, 1), b3 + hstep, voffB); PG8_STAGE(PG8_SA(1, 0), a3, voffA);
            PG8_WAIT_V(8); PG8_WAIT_L(0); PG8_BAR; PG8_MMA(1, 0, At, B0); PG8_MMA(1, 1, At, B1); PG8_BAR; PG8_SCHED;
            } else {
            PG8_LDB(B0, 0, 0); PG8_SCHED; PG8_LDA(At, 0, 0); PG8_STAGE(PG8_SA(1, 1), a1 + hstep, voffA);
            PG8_WAIT_L(8); PG8_BAR; PG8_WAIT_L(0); PG8_MMA(0, 0, At, B0); PG8_BAR; PG8_SCHED;
            PG8_LDB(B1, 0, 1); PG8_STAGE(PG8_SB(0, 0), b2, voffB);
            PG8_BAR; PG8_WAIT_L(0); PG8_MMA(0, 1, At, B1); PG8_BAR;
            PG8_LDA(At, 0, 1); PG8_STAGE(PG8_SA(0, 0), a2, voffA);
            PG8_BAR; PG8_WAIT_L(0); PG8_MMA(1, 0, At, B0); PG8_BAR; PG8_SCHED;
            PG8_STAGE(PG8_SB(0, 1), b2 + hstep, voffB);
            PG8_WAIT_V(6); PG8_BAR; PG8_MMA(1, 1, At, B1); PG8_BAR;
            PG8_LDB(B0, 1, 0); PG8_SCHED; PG8_LDA(At, 1, 0); PG8_STAGE(PG8_SA(0, 1), a2 + hstep, voffA);
            PG8_WAIT_L(8); PG8_BAR; PG8_WAIT_L(0); PG8_MMA(0, 0, At, B0); PG8_BAR; PG8_SCHED;
            PG8_LDB(B1, 1, 1); PG8_STAGE(PG8_SB(1, 0), b3, voffB);
            PG8_BAR; PG8_WAIT_L(0); PG8_MMA(0, 1, At, B1); PG8_BAR;
            PG8_LDA(At, 1, 1); PG8_STAGE(PG8_SA(1, 0), a3, voffA);
            PG8_BAR; PG8_WAIT_L(0); PG8_MMA(1, 0, At, B0); PG8_BAR; PG8_SCHED;
            PG8_STAGE(PG8_SB(1, 1), b3 + hstep, voffB);
            PG8_WAIT_V(6); PG8_BAR; PG8_MMA(1, 1, At, B1); PG8_BAR;
            }
        }
        if constexpr (ALIGN_EPI) { if (wr == 0) PG8_BAR; }
        if constexpr (!Epi::AFTER_DRAIN) { E(acc, cur, wr, wc, fr, fq); S.done(cur); }
        if (!has_next) break;
#pragma unroll
        for (int a = 0; a < 2; ++a)
#pragma unroll
            for (int b = 0; b < 2; ++b)
#pragma unroll
                for (int m = 0; m < 4; ++m)
#pragma unroll
                    for (int n = 0; n < 2; ++n) acc[a][b][m][n] = (f32x4){0.f, 0.f, 0.f, 0.f};
        cur = nxt; cA = nA; cB = nB; ++ui;
        if constexpr (ALIGN_EPI) { if (wr == 1) PG8_BAR; }
    }
    PG8_WAIT_V(0);
    if constexpr (!ALIGN_EPI) { if (wr == 0) PG8_BAR; }
    PG8_BAR;
    if constexpr (Epi::AFTER_DRAIN) { E.fused(acc, cur, wr, wc, fr, fq, lds, wid, lane); S.done(cur); }
#undef PG8_SA
#undef PG8_SB
#undef PG8_STAGE
#undef PG8_LDA
#undef PG8_LDB
#undef PG8_MMA
#undef PG8_WAIT_V
#undef PG8_WAIT_L
#undef PG8_BAR
#undef PG8_SCHED
}
}
#define XB_TMO      128
#define XB_XCNT(j)  (256  + 64 * (j))
#define XB_XSUB(j)  (1280 + 64 * (j))
#define XB_XGEN(j)  (2304 + 64 * (j))
#define XB_TOP      3328
#define XB_TOPGEN   3392
#define XCD_BAR_WORDS 3456
#define XB_SPIN_CAP (1u << 18)

__device__ __forceinline__ unsigned xb_ld(unsigned* p)              { return __hip_atomic_load(p, __ATOMIC_RELAXED, __HIP_MEMORY_SCOPE_AGENT); }
__device__ __forceinline__ unsigned xb_add(unsigned* p, unsigned v) { return __hip_atomic_fetch_add(p, v, __ATOMIC_RELAXED, __HIP_MEMORY_SCOPE_AGENT); }
__device__ __forceinline__ unsigned xb_xcc_id() { return (unsigned)__builtin_amdgcn_s_getreg((3 << 11) | 20) & 0xFu; }
#define XB_SPIN(cond, bar) do { unsigned _sp = 0; while (cond) { __builtin_amdgcn_s_sleep(1); \
    if ((++_sp & 255u) == 0u) { if (xb_ld(&(bar)[XB_TMO])) break; if (_sp > XB_SPIN_CAP) { atomicAdd(&(bar)[XB_TMO], 1u); break; } } } } while (0)

struct XcdBarrier {
    unsigned* bar; unsigned x;
    volatile LAS unsigned* st;
};

__device__ __forceinline__ XcdBarrier xcd_barrier_post(unsigned* bar, volatile LAS unsigned* st) {
    XcdBarrier b; b.bar = bar; b.x = xb_xcc_id(); b.st = st;
    if (threadIdx.x == 0) (void)xb_add(&bar[XB_XCNT(b.x)], 1u);
    return b;
}
__device__ __forceinline__ void xcd_barrier_complete(unsigned* bar, unsigned x, unsigned& nloc, unsigned& nx) {
    const unsigned G = gridDim.x * gridDim.y * gridDim.z;
    unsigned sum, cnt, mine, sp = 0u;
    for (;;) {
        sum = 0u; cnt = 0u; mine = 0u;
#pragma unroll
        for (unsigned j = 0; j < 16; ++j) { const unsigned c = xb_ld(&bar[XB_XCNT(j)]); sum += c; cnt += (c > 0u) ? 1u : 0u; mine = (j == x) ? c : mine; }
        if (sum == G) break;
        __builtin_amdgcn_s_sleep(1);
        if ((++sp & 255u) == 0u) { if (xb_ld(&bar[XB_TMO])) break; if (sp > XB_SPIN_CAP) { atomicAdd(&bar[XB_TMO], 1u); break; } }
    }
    nloc = mine > 0u ? mine : 1u; nx = cnt > 0u ? cnt : 1u;
}

__device__ __forceinline__ void xcd_barrier(const XcdBarrier& b) {
    asm volatile("s_waitcnt vmcnt(0)" ::: "memory");
    __syncthreads();
    if (threadIdx.x == 0) {
        unsigned* bar = b.bar;
        __builtin_amdgcn_s_waitcnt(0);
        unsigned nloc = b.st[0], nx = b.st[1];
        if (nloc == 0u) { xcd_barrier_complete(bar, b.x, nloc, nx); b.st[0] = nloc; b.st[1] = nx; }
        const unsigned old = xb_add(&bar[XB_XSUB(b.x)], 1u);
        const unsigned gen = old / nloc;
        if (old + 1u == (gen + 1u) * nloc) {
            __builtin_amdgcn_fence(__ATOMIC_RELEASE, "agent");
            asm volatile("s_waitcnt vmcnt(0)" ::: "memory");
            const unsigned og = xb_add(&bar[XB_TOP], 1u);
            const unsigned tg = og / nx;
            if (og + 1u == (tg + 1u) * nx) xb_add(&bar[XB_TOPGEN], 1u);
            else XB_SPIN(xb_ld(&bar[XB_TOPGEN]) == tg, bar);
            __builtin_amdgcn_fence(__ATOMIC_ACQUIRE, "agent");
            xb_add(&bar[XB_XGEN(b.x)], 1u);
            asm volatile("s_waitcnt vmcnt(0)" ::: "memory");
        } else {
            XB_SPIN(xb_ld(&bar[XB_XGEN(b.x)]) == gen, bar);
            __builtin_amdgcn_fence(__ATOMIC_ACQUIRE, "agent");
            asm volatile("s_waitcnt vmcnt(0)" ::: "memory");
        }
    }
    __syncthreads();
}

struct Params { const float* in[23]; float* out; unsigned char* ws; };

__device__ __forceinline__ void p0_transpose_item(const float* W, int ldw, int K, int N, bf16_t* WT, int item, int lane, float scale, const float* gk, bool pair_perm = false) {
    const int nblk = N / 64, kb = item / nblk, nb = item % nblk, i16 = lane & 15, q4 = lane >> 4;
    const int n0 = 64 * nb + 4 * i16;
    const int ns0 = (pair_perm ? ((nb >> 1) & 1) * DFF + 128 * (nb >> 2) + 64 * (nb & 1) : 64 * nb) + 4 * i16;
#pragma unroll
    for (int pass = 0; pass < 2; ++pass) {
        const int kk0 = 64 * kb + 32 * pass + 8 * q4;
        const float* src = W + (size_t)kk0 * ldw + ns0;
        f32x4 v[8];
#pragma unroll
        for (int i = 0; i < 8; ++i) v[i] = *(const f32x4*)(src + (size_t)i * ldw);
        f32x4 g0 = {scale, scale, scale, scale}, g1 = g0;
        if (gk) { g0 = *(const f32x4*)(gk + kk0) * scale; g1 = *(const f32x4*)(gk + kk0 + 4) * scale; }
#pragma unroll
        for (int j = 0; j < 4; ++j) { u32x4 o;
            o.x = pk2(v[0][j] * g0[0], v[1][j] * g0[1]); o.y = pk2(v[2][j] * g0[2], v[3][j] * g0[3]); o.z = pk2(v[4][j] * g1[0], v[5][j] * g1[1]); o.w = pk2(v[6][j] * g1[2], v[7][j] * g1[3]);
            *(u32x4*)(WT + (size_t)(n0 + j) * K + kk0) = o; }
    }
}

__device__ __forceinline__ void phase_prologue(const Params& P, LAS unsigned char* lds, int gw, int NGW, int wave, int lane) {
    constexpr int I_QKV = (DM / 64) * (NQKV / 64), I_WO = (DO / 64) * (DM / 64), I_WIN = (DM / 64) * (NIN / 64), I_WOUT = (DM / 64) * (DM / 64), I_WUP = (DM / 64) * (NUP / 64), I_WDN = (DFF / 64) * (DM / 64);
    constexpr int T0 = 2 * I_QKV, T1 = T0 + 2 * I_WO, T2 = T1 + 2 * I_WIN, T3 = T2 + 2 * I_WOUT, T4 = T3 + 4 * I_WUP, T5 = T4 + 4 * I_WDN;
    unsigned char* ws = P.ws;
    for (int it = gw; it < T5; it += NGW) {
        if (it < T0) { const int l = it / I_QKV, r = it % I_QKV; p0_transpose_item(P.in[11] + (size_t)l * DM * NQKV, NQKV, DM, NQKV, (bf16_t*)(ws + WS_WQKV + l * SZ_WQKV), r, lane, 1.f, P.in[9] + (size_t)(2 * l) * DM); }
        else if (it < T1) { const int q = it - T0, l = q / I_WO, r = q % I_WO; p0_transpose_item(P.in[14] + (size_t)l * DO * DM, DM, DO, DM, (bf16_t*)(ws + WS_WO + l * SZ_WO), r, lane, 1.f, nullptr); }
        else if (it < T2) { const int q = it - T1, l = q / I_WIN, r = q % I_WIN; const int nb = r % (NIN / 64);
            const float sc = (nb >= 16 && nb < 32) ? 0.08838834764831845f : 1.f;
            p0_transpose_item(P.in[15] + (size_t)l * DM * NIN_SRC, NIN_SRC, DM, NIN, (bf16_t*)(ws + WS_WIN + l * SZ_WIN), r, lane, sc, P.in[9] + (size_t)(2 * l + 1) * DM); }
        else if (it < T3) { const int q = it - T2, l = q / I_WOUT, r = q % I_WOUT; p0_transpose_item(P.in[18] + (size_t)l * DM * DM, DM, DM, DM, (bf16_t*)(ws + WS_WOUT + l * SZ_WOUT), r, lane, 1.f, nullptr); }
        else if (it < T4) { const int q = it - T3, l = q / I_WUP, r = q % I_WUP; p0_transpose_item(P.in[19] + (size_t)l * DM * NUP, NUP, DM, NUP, (bf16_t*)(ws + WS_WUP + l * SZ_WUP), r, lane, 1.f, P.in[10] + (size_t)l * DM, true); }
        else { const int q = it - T4, l = q / I_WDN, r = q % I_WDN; p0_transpose_item(P.in[22] + (size_t)l * DFF * DM, DM, DFF, DM, (bf16_t*)(ws + WS_WDOWN + l * SZ_WDOWN), r, lane, 1.f, nullptr); }
    }
    { const int gt = gw * 64 + lane, NT = NGW * 64;
      float* rope = (float*)(ws + WS_ROPE);
      for (int i = gt; i < 2052 * 64; i += NT) { const int pi = i >> 6, f = i & 63; const int pos = (pi < SEQ) ? pi : PAST + (pi - SEQ);
          const float invf = powf(10000.f, -(float)f * (1.f / 64.f)); const float ang = (float)pos * invf; float sn, cs; sincosf(ang, &sn, &cs); rope[2 * i] = cs; rope[2 * i + 1] = sn; }
      f32x4* wgp = (f32x4*)(ws + WS_WGP);
      for (int i = gt; i < 2 * 128 * 64; i += NT) { const int l = i >> 13, kb = (i >> 6) & 127, ln = i & 63, col = ln & 15, kq = ln >> 4, k = 16 * kb + 4 * kq;
          const float* w = P.in[15] + (size_t)l * DM * NIN_SRC + (size_t)k * NIN_SRC + NIN + col; const float* g = P.in[9] + (size_t)(2 * l + 1) * DM + k;
          wgp[i] = (f32x4){g[0] * w[0], g[1] * w[NIN_SRC], g[2] * w[2 * NIN_SRC], g[3] * w[3 * NIN_SRC]}; } }
    for (int r = gw; r < MR; r += NGW) {
        const f32x4* xr = (const f32x4*)((r < MP) ? P.in[0] + (size_t)r * DM : P.in[1] + (size_t)(r - MP) * DM) + lane;
        u32x2* xb = (u32x2*)(ws + WS_XB) + (size_t)r * (DM / 4) + lane;
        float s = 0.f;
#pragma unroll
        for (int j = 0; j < 8; ++j) { const f32x4 v = xr[64 * j]; u32x2 w; w.x = pk2(v.x, v.y); w.y = pk2(v.z, v.w); xb[64 * j] = w; s += (v.x * v.x + v.y * v.y) + (v.z * v.z + v.w * v.w); }
        s = wave_sum(s);
        if (r < MP) { if (lane < 32) ((float*)(ws + WS_SSQ))[(size_t)r * 32 + lane] = (lane == 0) ? s : 0.f; }
        else { float* q = (float*)(ws + WS_SSQS) + (size_t)(r - MP) * 128; q[lane] = (lane == 0) ? s : 0.f; q[64 + lane] = 0.f; }
    }
}

__device__ __forceinline__ void gate_block(LAS unsigned char* lds, const bf16_t* X, const f32x4* WGP, const float* bg, float* GATES, int task, int wave, int lane) {
    const int r0 = task * 16, i16 = lane & 15, kq = lane >> 4;
    const bf16_t* xr = X + (size_t)(r0 + i16) * DM + 256 * wave + 4 * kq;
    const f32x4* wp = WGP + (size_t)(16 * wave) * 64 + lane;
    f32x4 acc = {0.f, 0.f, 0.f, 0.f}; float ss = 0.f;
#pragma unroll
    for (int j = 0; j < 16; ++j) {
        const u32x2 xw = *(const u32x2*)(xr + 16 * j); const f32x4 xv = {bflo(xw.x), bfhi(xw.x), bflo(xw.y), bfhi(xw.y)}, wv = wp[64 * j];
        ss += (xv.x * xv.x + xv.y * xv.y) + (xv.z * xv.z + xv.w * xv.w);
        acc = __builtin_amdgcn_mfma_f32_16x16x4f32(xv.x, wv.x, acc, 0, 0, 0);
        acc = __builtin_amdgcn_mfma_f32_16x16x4f32(xv.y, wv.y, acc, 0, 0, 0);
        acc = __builtin_amdgcn_mfma_f32_16x16x4f32(xv.z, wv.z, acc, 0, 0, 0);
        acc = __builtin_amdgcn_mfma_f32_16x16x4f32(xv.w, wv.w, acc, 0, 0, 0);
    }
    LAS f32x4* gp = (LAS f32x4*)lds; LAS float* sp = (LAS float*)(lds + 8192);
    __syncthreads();
    gp[wave * 64 + lane] = acc; sp[wave * 64 + lane] = ss;
    __syncthreads();
    if (wave == 0) {
        f32x4 a = gp[lane]; float s = sp[lane];
#pragma unroll
        for (int w = 1; w < 8; ++w) { a += gp[w * 64 + lane]; s += sp[w * 64 + lane]; }
        s += __shfl_xor(s, 16); s += __shfl_xor(s, 32);
        const float rstd = rsqrtf(s * (1.f / DM) + EPS);
        const float bias = bg[i16];
#pragma unroll
        for (int i = 0; i < 4; ++i) {
            const float rs = __shfl(rstd, 4 * kq + i);
            const float pre = a[i] * rs + bias;
            const float gc = 15.f * tanhf(pre * (1.f / 15.f));
            const float val = (i16 < 8) ? gc : (fminf(gc, 0.f) - log1pf(fexp(-fabsf(gc))));
            GATES[(size_t)(r0 + 4 * kq + i) * 16 + i16] = val;
        }
    }
}

constexpr int SK_PART = 0, SK_RSTD = 16384;
template <int MODE>
__device__ __forceinline__ void skinny_phase(LAS unsigned char* lds, const bf16_t* A, int K, const bf16_t* Bt, int N, bf16_t* Ob, int ldo, bf16_t* XBs, float* SSQS, float* Os, int c, int G, int nIdle, int tid, int wave, int lane) {
    const int i16 = lane & 15, q4 = lane >> 4;
    if (c < G - nIdle) return;
    LAS f32x4* part = (LAS f32x4*)(lds + SK_PART); LAS float* rstdS = (LAS float*)(lds + SK_RSTD);
    __syncthreads();
    if (MODE == 0) { const int row = tid >> 4, sub = tid & 15; const float* q = SSQS + row * 128 + 8 * sub;
        const f32x4 a = *(const f32x4*)q, b = *(const f32x4*)(q + 4); float s = ((a[0] + a[1]) + (a[2] + a[3])) + ((b[0] + b[1]) + (b[2] + b[3]));
        s = row16_sum(s);
        if (sub == 0) rstdS[row] = rsqrtf(s * (1.f / 2048.f) + EPS);
        __syncthreads(); }
    const int kper = K >> 3, nks = kper >> 5, k0 = wave * kper;
    for (int j = G - 1 - c; j < (N >> 4); j += nIdle) {
        f32x4 acc0 = {0.f, 0.f, 0.f, 0.f}, acc1 = {0.f, 0.f, 0.f, 0.f};
        const bf16_t* bp = Bt + (size_t)(16 * j + i16) * K + k0 + 8 * q4; const bf16_t* ap = A + (size_t)i16 * K + k0 + 8 * q4;
#pragma unroll 8
        for (int ks = 0; ks < nks; ++ks) { const bf16x8 bf = *(const bf16x8*)(bp + 32 * ks), a0 = *(const bf16x8*)(ap + 32 * ks), a1 = *(const bf16x8*)(ap + (size_t)16 * K + 32 * ks);
            acc0 = mma16(a0, bf, acc0); acc1 = mma16(a1, bf, acc1); }
        part[(wave * 2 + 0) * 64 + lane] = acc0; part[(wave * 2 + 1) * 64 + lane] = acc1;
        __syncthreads();
        if (wave < 2) {
            f32x4 s = part[wave * 64 + lane];
#pragma unroll
            for (int w = 1; w < 8; ++w) s += part[(w * 2 + wave) * 64 + lane];
            const int col = 16 * j + i16;
#pragma unroll
            for (int i = 0; i < 4; ++i) { const int r = 16 * wave + 4 * q4 + i;
                if (MODE == 0) Ob[(size_t)r * ldo + col] = (bf16_t)f2bf(s[i] * rstdS[r]);
                else if (MODE == 1) { const float xo = bf1(XBs[(size_t)r * DM + col]) + s[i]; XBs[(size_t)r * DM + col] = (bf16_t)f2bf(xo);
                    float sq = xo * xo; sq = row16_sum(sq);
                    if (i16 == 0) SSQS[r * 128 + j] = sq; }
                else Os[(size_t)r * DM + col] = bf1(XBs[(size_t)r * DM + col]) + s[i]; }
        }
        __syncthreads();
    }
}

constexpr int SU_PART = 0, SU_RSTD = 98304, SU_NITEMS = 352;
__device__ __forceinline__ void skinny_up(LAS unsigned char* lds, const float* st_in, const float* cw, const float* cb, const bf16_t* XB, const bf16_t* Bt, const float* SSQ, const float* SSQS, float* HALO, unsigned* hcnt,
                                          bf16_t* Z, float* outp, int layer, int c, int G, int nIdle, int tid, int wave, int lane) {
    if (c < G - nIdle) return;
    const int i16 = lane & 15, q4 = lane >> 4;
    LAS f32x4* part = (LAS f32x4*)(lds + SU_PART); LAS float* rstdS = (LAS float*)(lds + SU_RSTD);
    __syncthreads();
    { const int row = tid >> 2, pt = tid & 3; float s = 0.f;
      if (row < 32) { const float* q = SSQS + row * 128 + 32 * pt;
#pragma unroll
          for (int v = 0; v < 8; ++v) { const f32x4 a = *(const f32x4*)(q + 4 * v); s += (a[0] + a[1]) + (a[2] + a[3]); } }
      else if (row < 96) { const int hr = row - 32; const float* q = SSQ + (size_t)(256 * (hr >> 1) + 254 + (hr & 1)) * 32 + 8 * pt;
          const f32x4 a = *(const f32x4*)q, b = *(const f32x4*)(q + 4); s = ((a[0] + a[1]) + (a[2] + a[3])) + ((b[0] + b[1]) + (b[2] + b[3])); }
      s = row4_sum(s);
      if (pt == 0 && row < 96) rstdS[row] = rsqrtf(s * (1.f / 2048.f) + EPS); }
    __syncthreads();
    const int k0 = wave * 256;
    const bf16_t* ap[6];
#pragma unroll
    for (int rb = 0; rb < 6; ++rb) { const int grow = (rb < 2) ? MP + 16 * rb + i16 : 256 * ((16 * (rb - 2) + i16) >> 1) + 254 + (i16 & 1); ap[rb] = XB + (size_t)grow * DM + k0 + 8 * q4; }
    for (int j = G - 1 - c; j < SU_NITEMS; j += nIdle) {
        const int pn = j >> 3, sb = j & 7, na = 256 * pn + 16 * sb + i16;
        f32x4 acc[6][2];
#pragma unroll
        for (int rb = 0; rb < 6; ++rb) { acc[rb][0] = (f32x4){0.f, 0.f, 0.f, 0.f}; acc[rb][1] = (f32x4){0.f, 0.f, 0.f, 0.f}; }
        const bf16_t* bpa = Bt + (size_t)na * DM + k0 + 8 * q4; const bf16_t* bpb = bpa + (size_t)128 * DM;
#pragma unroll 2
        for (int ks = 0; ks < 8; ++ks) { const bf16x8 fa = *(const bf16x8*)(bpa + 32 * ks), fb = *(const bf16x8*)(bpb + 32 * ks);
#pragma unroll
            for (int rb = 0; rb < 6; ++rb) { const bf16x8 a = *(const bf16x8*)(ap[rb] + 32 * ks); acc[rb][0] = mma16(a, fa, acc[rb][0]); acc[rb][1] = mma16(a, fb, acc[rb][1]); } }
#pragma unroll
        for (int rb = 0; rb < 6; ++rb) { part[((wave * 6 + rb) * 2 + 0) * 64 + lane] = acc[rb][0]; part[((wave * 6 + rb) * 2 + 1) * 64 + lane] = acc[rb][1]; }
        __syncthreads();
        if (wave < 6) {
            const int rb = wave;
            f32x4 sa = part[((0 * 6 + rb) * 2 + 0) * 64 + lane], sbv = part[((0 * 6 + rb) * 2 + 1) * 64 + lane];
#pragma unroll
            for (int w = 1; w < 8; ++w) { sa += part[((w * 6 + rb) * 2 + 0) * 64 + lane]; sbv += part[((w * 6 + rb) * 2 + 1) * 64 + lane]; }
            const int jn = 128 * pn + 16 * sb + i16;
            if (rb < 2) {
                const int bs = 4 * rb + q4;
                float ua[4], ub[4];
#pragma unroll
                for (int i = 0; i < 4; ++i) { const float rs = rstdS[16 * rb + 4 * q4 + i]; ua[i] = sa[i] * rs; ub[i] = sbv[i] * rs; }
                const float wa0 = cw[jn], wa1 = cw[NUP + jn], wa2 = cw[2 * NUP + jn], ba = cb[jn], wb0 = cw[DFF + jn], wb1 = cw[NUP + DFF + jn], wb2 = cw[2 * NUP + DFF + jn], bb = cb[DFF + jn];
                const float* st = st_in + ((size_t)(layer * NBS + bs) * 2) * NUP;
                float a2 = st[jn], a1 = st[NUP + jn], b2 = st[DFF + jn], b1 = st[NUP + DFF + jn];
#pragma unroll
                for (int t = 0; t < 4; ++t) { const float ca = ba + wa0 * a2 + wa1 * a1 + wa2 * ua[t], cbv = bb + wb0 * b2 + wb1 * b1 + wb2 * ub[t];
                    Z[(size_t)(MP + bs * 4 + t) * DFF + jn] = (bf16_t)f2bf(ca / (1.f + fexp(-ca)) * cbv); a2 = a1; a1 = ua[t]; b2 = b1; b1 = ub[t]; }
                float* co = outp + O_CONVS + ((size_t)(layer * NBS + bs) * 2) * NUP;
                co[jn] = ua[2]; co[NUP + jn] = ua[3]; co[DFF + jn] = ub[2]; co[NUP + DFF + jn] = ub[3];
            } else {
#pragma unroll
                for (int i = 0; i < 4; ++i) { const int hr = 16 * (rb - 2) + 4 * q4 + i; const float rs = rstdS[32 + hr]; const float va = sa[i] * rs, vb = sbv[i] * rs;
                    __hip_atomic_store(HALO + (size_t)hr * NUP + na, va, __ATOMIC_RELAXED, __HIP_MEMORY_SCOPE_AGENT); __hip_atomic_store(HALO + (size_t)hr * NUP + na + 128, vb, __ATOMIC_RELAXED, __HIP_MEMORY_SCOPE_AGENT);
                    const int pmg = hr >> 1;
                    if ((pmg & 7) == 7) { float* co = outp + O_CONVP + ((size_t)(layer * NBP + (pmg >> 3)) * 2 + (hr & 1)) * NUP; co[jn] = va; co[DFF + jn] = vb; } }
                asm volatile("s_waitcnt vmcnt(0)" ::: "memory");
                if (lane == 0) __hip_atomic_fetch_add(hcnt, 1u, __ATOMIC_RELAXED, __HIP_MEMORY_SCOPE_AGENT);
            }
        }
        __syncthreads();
    }
}

__device__ __forceinline__ void prep_row(bf16_t* QKV, const float* rope, const float* qg, const float* kg, float* out, int ia, int r, int lane) {
    const int hh = lane >> 3, sub = lane & 7;
    const bool samp = r >= MP;
    const int b = samp ? ((r - MP) >> 2) : (r >> 11), s = samp ? ((r - MP) & 3) : (r & 2047);
    float cs[8], sn[8];
    { const f32x4* rp = (const f32x4*)(rope + ((size_t)(samp ? SEQ + s : s) * 64 + 8 * sub) * 2);
      const f32x4 t0 = rp[0], t1 = rp[1], t2 = rp[2], t3 = rp[3];
      cs[0] = t0[0]; sn[0] = t0[1]; cs[1] = t0[2]; sn[1] = t0[3]; cs[2] = t1[0]; sn[2] = t1[1]; cs[3] = t1[2]; sn[3] = t1[3];
      cs[4] = t2[0]; sn[4] = t2[1]; cs[5] = t2[2]; sn[5] = t2[3]; cs[6] = t3[0]; sn[6] = t3[1]; cs[7] = t3[2]; sn[7] = t3[3]; }
#pragma unroll 1
    for (int g = 0; g < 3; ++g) {
        const int win = 128 << (2 * g);
#pragma unroll
        for (int t = 0; t < 3; ++t) {
            bf16_t* p = QKV + (size_t)r * NQKV + ((g * 3 + t) * 8 + hh) * 128;
            const u32x4 w0 = *(const u32x4*)(p + 8 * sub), w1 = *(const u32x4*)(p + 64 + 8 * sub);
            float x1[8], x2[8];
            x1[0] = bflo(w0.x); x1[1] = bfhi(w0.x); x1[2] = bflo(w0.y); x1[3] = bfhi(w0.y); x1[4] = bflo(w0.z); x1[5] = bfhi(w0.z); x1[6] = bflo(w0.w); x1[7] = bfhi(w0.w);
            x2[0] = bflo(w1.x); x2[1] = bfhi(w1.x); x2[2] = bflo(w1.y); x2[3] = bfhi(w1.y); x2[4] = bflo(w1.z); x2[5] = bfhi(w1.z); x2[6] = bflo(w1.w); x2[7] = bfhi(w1.w);
            if (t < 2) {
                float ss = 0.f;
#pragma unroll
                for (int j = 0; j < 8; ++j) ss += x1[j] * x1[j] + x2[j] * x2[j];
                ss = row8_sum(ss);
                const float rstd = rsqrtf(ss * (1.f / 128.f) + EPS);
                const float* gn = (t == 0) ? qg : kg;
#pragma unroll
                for (int j = 0; j < 8; ++j) { const float y1 = x1[j] * rstd * gn[8 * sub + j], y2 = x2[j] * rstd * gn[64 + 8 * sub + j];
                    x1[j] = y1 * cs[j] - y2 * sn[j]; x2[j] = y2 * cs[j] + y1 * sn[j]; }
                u32x4 o0, o1;
                o0.x = pk2(x1[0], x1[1]); o0.y = pk2(x1[2], x1[3]); o0.z = pk2(x1[4], x1[5]); o0.w = pk2(x1[6], x1[7]);
                o1.x = pk2(x2[0], x2[1]); o1.y = pk2(x2[2], x2[3]); o1.z = pk2(x2[4], x2[5]); o1.w = pk2(x2[6], x2[7]);
                *(u32x4*)(p + 8 * sub) = o0; *(u32x4*)(p + 64 + 8 * sub) = o1;
            }
            if (t >= 1) {
                const int kv = t - 1;
                const size_t obase = (g == 0) ? (samp ? O_KV128S : O_KV128P) : (g == 1) ? (samp ? O_KV512S : O_KV512P) : (samp ? O_KV2048S : O_KV2048P);
                const int j = samp ? (win - TSAMP + s) : (s - (SEQ - win));
                if (j >= 0) {
                    const int nb = samp ? NBS : NBP;
                    float* dst = out + obase + ((((size_t)(ia * nb + b) * win + j) * 2 + kv) * 8 + hh) * 128;
                    *(f32x4*)(dst + 8 * sub) = (f32x4){x1[0], x1[1], x1[2], x1[3]}; *(f32x4*)(dst + 8 * sub + 4) = (f32x4){x1[4], x1[5], x1[6], x1[7]};
                    *(f32x4*)(dst + 64 + 8 * sub) = (f32x4){x2[0], x2[1], x2[2], x2[3]}; *(f32x4*)(dst + 64 + 8 * sub + 4) = (f32x4){x2[4], x2[5], x2[6], x2[7]};
                }
            }
        }
    }
}

constexpr int AT_PITCH = 272, AT_KOFF = 0, AT_VOFF = 256 * AT_PITCH;
struct AttnItem { int g, b, h, dil, r, qb; };
__device__ __forceinline__ AttnItem attn_decode(int item) {
    AttnItem a; a.g = item >> 9; const int rem = item & 511, idx = rem & 15; a.b = rem >> 7; a.h = (rem >> 4) & 7;
    a.dil = (a.g == 0) ? 1 : (a.g == 1) ? 4 : 16; a.r = (a.g == 0) ? 0 : (a.g == 1) ? (idx >> 2) : idx; a.qb = (a.g == 0) ? idx : (a.g == 1) ? (idx & 3) : 0; return a;
}
__device__ __forceinline__ void attn_fetch(const bf16_t* QKV, const AttnItem& a, int tid, u32x4 (&kr)[8], u32x4 (&vr)[8]) {
    const int ck = (a.g * 3 * 8 + a.h) * 128 + 1024, uk0 = 128 * (a.qb - 1); const size_t rowbase = (size_t)a.b * SEQ + a.r;
#pragma unroll
    for (int i = 0; i < 8; ++i) { const int id = tid + 512 * i, kk = id >> 4, ch = id & 15, u = uk0 + kk;
        kr[i] = (u32x4){0u, 0u, 0u, 0u}; vr[i] = (u32x4){0u, 0u, 0u, 0u};
        if (u >= 0) { const bf16_t* src = QKV + (rowbase + (size_t)u * a.dil) * NQKV + ck + 8 * ch; kr[i] = *(const u32x4*)src; vr[i] = *(const u32x4*)(src + 1024); } }
}
__device__ __forceinline__ void attn_phase(LAS unsigned char* lds, unsigned lds_base, const bf16_t* QKV, bf16_t* OG, float* LSE, int first, int stride, int nitems, int tid, int wave, int lane) {
    const int i16 = lane & 15, q4 = lane >> 4, qq = i16 >> 2, p = lane & 3;
    u32x4 kr[8], vr[8];
    if (first < nitems) { const AttnItem a0 = attn_decode(first); attn_fetch(QKV, a0, tid, kr, vr); }
    __syncthreads();
#pragma unroll 1
    for (int item = first; item < nitems; item += stride) {
        const AttnItem a = attn_decode(item);
        const int g = a.g, h = a.h, qb = a.qb;
        const int cq = (g * 3 * 8 + h) * 128;
        const size_t rowbase = (size_t)a.b * SEQ + a.r;
#pragma unroll
        for (int i = 0; i < 8; ++i) { const int id = tid + 512 * i, kk = id >> 4, ch = id & 15;
            *(LAS u32x4*)(lds + AT_KOFF + kk * AT_PITCH + ch * 16) = kr[i]; *(LAS u32x4*)(lds + AT_VOFF + kk * AT_PITCH + ch * 16) = vr[i]; }
        const int tqa = 16 * wave + i16;
        const size_t grow = rowbase + (size_t)(128 * qb + tqa) * a.dil;
        bf16x8 Qf[4];
#pragma unroll
        for (int ks = 0; ks < 4; ++ks) Qf[ks] = *(const bf16x8*)(QKV + grow * NQKV + cq + 32 * ks + 8 * q4);
        __syncthreads();
        if (item + stride < nitems) { const AttnItem an = attn_decode(item + stride); attn_fetch(QKV, an, tid, kr, vr); }
        const int cb0 = wave & ~1;
        f32x4 S[10];
#pragma unroll
        for (int c = 0; c < 10; ++c) {
            f32x4 acc = {0.f, 0.f, 0.f, 0.f};
#pragma unroll
            for (int ks = 0; ks < 4; ++ks) { const bf16x8 kf = *(const LAS bf16x8*)(lds + AT_KOFF + (16 * (cb0 + c) + i16) * AT_PITCH + (32 * ks + 8 * q4) * 2); acc = mma16(kf, Qf[ks], acc); }
            S[c] = acc;
        }
        const float sc = 0.08838834764831845f * 1.4426950408889634f;
        float mx = -INFINITY;
#pragma unroll
        for (int c = 0; c < 10; ++c)
#pragma unroll
            for (int i = 0; i < 4; ++i) { const int kk = 16 * (cb0 + c) + 4 * q4 + i; const bool ok = (kk >= tqa) && (kk <= tqa + 128) && (qb > 0 || kk >= 128);
                const float s = ok ? S[c][i] * sc : -INFINITY; S[c][i] = s; mx = fmaxf(mx, s); }
        mx = fmaxf(mx, __shfl_xor(mx, 16)); mx = fmaxf(mx, __shfl_xor(mx, 32));
        float l = 0.f;
#pragma unroll
        for (int c = 0; c < 10; ++c)
#pragma unroll
            for (int i = 0; i < 4; ++i) { const float pv = __builtin_amdgcn_exp2f(S[c][i] - mx); S[c][i] = pv; l += pv; }
        l += __shfl_xor(l, 16); l += __shfl_xor(l, 32);
        bf16x8 Pf[5];
#pragma unroll
        for (int kst = 0; kst < 5; ++kst) Pf[kst] = pack8(S[2 * kst], S[2 * kst + 1]);
        const float inv = 1.f / l;
        bf16_t* orow = OG + grow * 3072 + g * 1024 + h * 128 + 4 * q4;
        const unsigned vbase = lds_base + AT_VOFF + (16 * cb0 + 4 * q4 + qq) * AT_PITCH + 8 * p;
#pragma unroll
        for (int eb = 0; eb < 8; ++eb) {
            f32x4 acc = {0.f, 0.f, 0.f, 0.f};
            bf16x8 v0, v1, v2, v3, v4;
            TR_READ5(v0, v1, v2, v3, v4, vbase, 0 * AT_PITCH + 32 * eb, 16 * AT_PITCH + 32 * eb, 32 * AT_PITCH + 32 * eb, 48 * AT_PITCH + 32 * eb, 64 * AT_PITCH + 32 * eb, 80 * AT_PITCH + 32 * eb,
                     96 * AT_PITCH + 32 * eb, 112 * AT_PITCH + 32 * eb, 128 * AT_PITCH + 32 * eb, 144 * AT_PITCH + 32 * eb);
            acc = mma16(v0, Pf[0], acc); acc = mma16(v1, Pf[1], acc); acc = mma16(v2, Pf[2], acc); acc = mma16(v3, Pf[3], acc); acc = mma16(v4, Pf[4], acc);
            u32x2 w; w.x = pk2(acc[0] * inv, acc[1] * inv); w.y = pk2(acc[2] * inv, acc[3] * inv);
            *(u32x2*)(orow + 16 * eb) = w;
        }
        if (q4 == 0) LSE[grow * 24 + g * 8 + h] = (mx + log2f(l)) * 0.6931471805599453f;
        __syncthreads();
    }
}

__device__ __forceinline__ void unpack8(const u32x4 w, float (&x)[8]) { x[0] = bflo(w.x); x[1] = bfhi(w.x); x[2] = bflo(w.y); x[3] = bfhi(w.y); x[4] = bflo(w.z); x[5] = bfhi(w.z); x[6] = bflo(w.w); x[7] = bfhi(w.w); }
__device__ __forceinline__ void load8(const float* p, float (&x)[8]) { const f32x4 a = *(const f32x4*)p, b = *(const f32x4*)(p + 4); x[0] = a.x; x[1] = a.y; x[2] = a.z; x[3] = a.w; x[4] = b.x; x[5] = b.y; x[6] = b.z; x[7] = b.w; }
__device__ __forceinline__ void store8(float* p, const float (&x)[8]) { *(f32x4*)p = (f32x4){x[0], x[1], x[2], x[3]}; *(f32x4*)(p + 4) = (f32x4){x[4], x[5], x[6], x[7]}; }
__device__ __forceinline__ void attn_sample_task(LAS unsigned char* wl  , const bf16_t* QKV, const float* c128, const float* c512, const float* c2048, bf16_t* OG, float* LSE, int ia, int wt, int lane) {
    const int bs = wt / 96, rem = wt % 96, g = rem >> 5, h = (rem >> 2) & 7, t = rem & 3;
    const int win = 128 << (2 * g), dil = 1 << (2 * g);
    const float* cache = ((g == 0) ? c128 : (g == 1) ? c512 : c2048) + (size_t)(ia * NBS + bs) * win * 2048;
    const int cq = (g * 3 * 8 + h) * 128, ck = cq + 1024, cv = cq + 2048;
    const size_t rq = (size_t)MP + bs * 4 + t;
    LAS float* qs = (LAS float*)wl; LAS float* ps = (LAS float*)(wl + 512);
    { const unsigned w = *(const unsigned*)(QKV + rq * NQKV + cq + 2 * lane); qs[2 * lane] = bflo(w); qs[2 * lane + 1] = bfhi(w); }
    asm volatile("s_waitcnt lgkmcnt(0)" ::: "memory");
    float sv[3];
#pragma unroll
    for (int pass = 0; pass < 3; ++pass) {
        const int j = pass * 64 + lane; float s = -INFINITY;
        if (j <= 128) {
            const int idx = win + t - dil * j; float acc = 0.f;
            if (idx >= win) { const bf16_t* kp = QKV + ((size_t)MP + bs * 4 + (idx - win)) * NQKV + ck;
                for (int d = 0; d < 128; d += 8) { const u32x4 w = *(const u32x4*)(kp + d); const LAS float* q = qs + d;
                    acc += q[0] * bflo(w.x) + q[1] * bfhi(w.x) + q[2] * bflo(w.y) + q[3] * bfhi(w.y) + q[4] * bflo(w.z) + q[5] * bfhi(w.z) + q[6] * bflo(w.w) + q[7] * bfhi(w.w); } }
            else { const float* kp = cache + ((size_t)idx * 2 + 0) * 1024 + h * 128;
                for (int d = 0; d < 128; d += 4) { const f32x4 kx = *(const f32x4*)(kp + d); const LAS float* q = qs + d; acc += q[0] * kx.x + q[1] * kx.y + q[2] * kx.z + q[3] * kx.w; } }
            s = acc * 0.08838834764831845f;
        }
        sv[pass] = s;
    }
    const float mx = wave_max(fmaxf(fmaxf(sv[0], sv[1]), sv[2]));
    float l = 0.f;
#pragma unroll
    for (int pass = 0; pass < 3; ++pass) { const float pv = fexp(sv[pass] - mx); l += pv; ps[pass * 64 + lane] = pv; }
    l = wave_sum(l);
    asm volatile("s_waitcnt lgkmcnt(0)" ::: "memory");
    { const int jg = lane >> 4, dd = lane & 15;
      float o[8];
#pragma unroll
      for (int q = 0; q < 8; ++q) o[q] = 0.f;
#pragma unroll 4
      for (int j = jg; j <= 128; j += 4) {
          const int idx = win + t - dil * j; const float pj = ps[j]; float v[8];
          if (idx >= win) { unpack8(*(const u32x4*)(QKV + ((size_t)MP + bs * 4 + (idx - win)) * NQKV + cv + 8 * dd), v); }
          else { load8(cache + ((size_t)idx * 2 + 1) * 1024 + h * 128 + 8 * dd, v); }
#pragma unroll
          for (int q = 0; q < 8; ++q) o[q] += pj * v[q];
      }
      const float inv = 1.f / l;
#pragma unroll
      for (int q = 0; q < 8; ++q) { o[q] += __shfl_xor(o[q], 16); o[q] += __shfl_xor(o[q], 32); o[q] *= inv; }
      if (jg == 0) { u32x4 w; w.x = pk2(o[0], o[1]); w.y = pk2(o[2], o[3]); w.z = pk2(o[4], o[5]); w.w = pk2(o[6], o[7]); *(u32x4*)(OG + rq * 3072 + g * 1024 + h * 128 + 8 * dd) = w; } }
    if (lane == 0) LSE[rq * 24 + g * 8 + h] = mx + logf(l);
}

__device__ __forceinline__ void combine_row(const bf16_t* OG, const float* LSE, bf16_t* OC, int r, int lane) {
    const int hh = lane >> 3;
    const float l0 = LSE[(size_t)r * 24 + hh], l1 = LSE[(size_t)r * 24 + 8 + hh], l2 = LSE[(size_t)r * 24 + 16 + hh];
    const float mx = fmaxf(l0, fmaxf(l1, l2));
    float e0 = fexp(l0 - mx), e1 = fexp(l1 - mx), e2 = fexp(l2 - mx);
    const float inv = 1.f / (e0 + e1 + e2); e0 *= inv; e1 *= inv; e2 *= inv;
    const bf16_t* src = OG + (size_t)r * 3072 + 16 * lane;
#pragma unroll
    for (int c = 0; c < 2; ++c) {
        const u32x4 a = *(const u32x4*)(src + 8 * c), bq = *(const u32x4*)(src + 1024 + 8 * c), cc = *(const u32x4*)(src + 2048 + 8 * c);
        u32x4 o;
        o.x = pk2(e0 * bflo(a.x) + e1 * bflo(bq.x) + e2 * bflo(cc.x), e0 * bfhi(a.x) + e1 * bfhi(bq.x) + e2 * bfhi(cc.x));
        o.y = pk2(e0 * bflo(a.y) + e1 * bflo(bq.y) + e2 * bflo(cc.y), e0 * bfhi(a.y) + e1 * bfhi(bq.y) + e2 * bfhi(cc.y));
        o.z = pk2(e0 * bflo(a.z) + e1 * bflo(bq.z) + e2 * bflo(cc.z), e0 * bfhi(a.z) + e1 * bfhi(bq.z) + e2 * bfhi(cc.z));
        o.w = pk2(e0 * bflo(a.w) + e1 * bflo(bq.w) + e2 * bflo(cc.w), e0 * bfhi(a.w) + e1 * bfhi(bq.w) + e2 * bfhi(cc.w));
        *(u32x4*)(OC + (size_t)r * DO + 16 * lane + 8 * c) = o;
    }
}

template <int CTRL, int RMASK> __device__ __forceinline__ float dpp_f(float oldv, float src) {
    return __builtin_bit_cast(float, __builtin_amdgcn_update_dpp(__builtin_bit_cast(int, oldv), __builtin_bit_cast(int, src), CTRL, RMASK, 0xf, false)); }
__device__ __forceinline__ float scan_sum(float v, int lane) {
    (void)lane;
    v += dpp_f<0x111, 0xf>(0.f, v); v += dpp_f<0x112, 0xf>(0.f, v); v += dpp_f<0x114, 0xf>(0.f, v); v += dpp_f<0x118, 0xf>(0.f, v);
    v += dpp_f<0x142, 0xa>(0.f, v); v += dpp_f<0x143, 0xc>(0.f, v);
    return v;
}
__device__ __forceinline__ float scan_max(float v, int lane) {
    (void)lane; const float ninf = -INFINITY;
    v = fmaxf(v, dpp_f<0x111, 0xf>(ninf, v)); v = fmaxf(v, dpp_f<0x112, 0xf>(ninf, v)); v = fmaxf(v, dpp_f<0x114, 0xf>(ninf, v)); v = fmaxf(v, dpp_f<0x118, 0xf>(ninf, v));
    v = fmaxf(v, dpp_f<0x142, 0xa>(ninf, v)); v = fmaxf(v, dpp_f<0x143, 0xc>(ninf, v));
    return v;
}
#ifndef ML_COPY
#define ML_COPY 0
#endif
constexpr int ML_QP = 272, ML_VP = 144, ML_PP = 144;
constexpr int ML_QSZ = 64 * ML_QP, ML_VSZ = 64 * ML_VP;
constexpr int ML_Q = 0, ML_K = ML_Q + 2 * ML_QSZ, ML_V = ML_K + 2 * ML_QSZ, ML_KW = ML_V + 2 * ML_VSZ, ML_P = ML_KW + ML_QSZ, ML_N = ML_P + 64 * ML_PP, ML_DEN = ML_N + 1024, ML_END = ML_DEN + 256;
__device__ __forceinline__ void mlstm_prompt(LAS unsigned char* lds, unsigned lds_base, const bf16_t* QKVO, const float* GATES, bf16_t* HRAW, float* SQ, float* out, int ib, int unit, int tid, int wave, int lane) {
    const int bh = unit >> 2, sl = unit & 3;
    const int b = bh >> 3, h = bh & 7;
    const int i16 = lane & 15, q4 = lane >> 4, qq = i16 >> 2, p = lane & 3;
    const int rb = wave >> 1, ea = wave & 1, e0 = 64 * sl + 32 * ea;
    f32x4 CT[2][8];
#pragma unroll
    for (int a = 0; a < 2; ++a)
#pragma unroll
        for (int d = 0; d < 8; ++d) CT[a][d] = (f32x4){0.f, 0.f, 0.f, 0.f};
    float m = 0.f;
    const unsigned vbase0 = lds_base + ML_V + (8 * q4 + qq) * ML_VP + (32 * ea + 4 * p) * 2, kwbase = lds_base + ML_KW + (8 * q4 + qq) * ML_QP + 8 * p;
    LAS float* nS = (LAS float*)(lds + ML_N); LAS float* denS = (LAS float*)(lds + ML_DEN);
    const size_t rbase = (size_t)b * SEQ;
    const int srow0 = tid >> 4, sch = tid & 15, vrow = tid >> 3, vch = tid & 7;
    u32x4 pq0, pq1, pk0, pk1, pv; float pig, plf;
    { const bf16_t* s0 = QKVO + (rbase + srow0) * NIN + h * 128 + 8 * sch; const bf16_t* s1 = s0 + (size_t)32 * NIN;
      pq0 = *(const u32x4*)s0; pk0 = *(const u32x4*)(s0 + 1024); pq1 = *(const u32x4*)s1; pk1 = *(const u32x4*)(s1 + 1024);
      pv = *(const u32x4*)(QKVO + (rbase + vrow) * NIN + 2048 + h * 256 + 64 * sl + 8 * vch);
      pig = GATES[(rbase + lane) * 16 + h]; plf = GATES[(rbase + lane) * 16 + 8 + h]; }
    __syncthreads();
    if (tid < 128) nS[tid] = 0.f;
    *(LAS u32x4*)(lds + ML_Q + srow0 * ML_QP + sch * 16) = pq0; *(LAS u32x4*)(lds + ML_Q + (srow0 + 32) * ML_QP + sch * 16) = pq1;
    *(LAS u32x4*)(lds + ML_K + srow0 * ML_QP + sch * 16) = pk0; *(LAS u32x4*)(lds + ML_K + (srow0 + 32) * ML_QP + sch * 16) = pk1;
    *(LAS u32x4*)(lds + ML_V + vrow * ML_VP + vch * 16) = pv;
    __syncthreads();
    float hv0[4] = {0.f, 0.f, 0.f, 0.f}, hv1[4] = {0.f, 0.f, 0.f, 0.f}, sv0[4] = {0.f, 0.f, 0.f, 0.f}, sv1[4] = {0.f, 0.f, 0.f, 0.f};
#define ML_FLUSH(rprev) do { _Pragma("unroll") for (int i = 0; i < 4; ++i) { const int t = 16 * rb + 4 * q4 + i; \
        bf16_t* hp = HRAW + ((rprev) + t) * DM + h * 256 + e0 + i16; hp[0] = (bf16_t)f2bf(hv0[i]); hp[16] = (bf16_t)f2bf(hv1[i]); \
        if (i16 == 0) { float* sp = SQ + ((rprev) + t) * 128 + h * 16 + 4 * sl + 2 * ea; sp[0] = sv0[i]; sp[1] = sv1[i]; } } } while (0)
#pragma unroll 1
    for (int c = 0; c < 32; ++c) {
        const int cur = c & 1, nxt = cur ^ 1;
        const size_t r0 = rbase + 64 * c;
        const LAS unsigned char* Qc = lds + ML_Q + cur * ML_QSZ; const LAS unsigned char* Kc = lds + ML_K + cur * ML_QSZ;
        const float ig = pig, lf = plf;
        asm volatile("" :: "v"(ig), "v"(lf));
        if (c > 0) ML_FLUSH(r0 - 64);
        { const size_t rn = rbase + 64 * ((c < 31) ? c + 1 : c);
          const bf16_t* s0 = QKVO + (rn + srow0) * NIN + h * 128 + 8 * sch; const bf16_t* s1 = s0 + (size_t)32 * NIN;
          pq0 = *(const u32x4*)s0; pk0 = *(const u32x4*)(s0 + 1024); pq1 = *(const u32x4*)s1; pk1 = *(const u32x4*)(s1 + 1024);
          pv = *(const u32x4*)(QKVO + (rn + vrow) * NIN + 2048 + h * 256 + 64 * sl + 8 * vch);
          pig = GATES[(rn + lane) * 16 + h]; plf = GATES[(rn + lane) * 16 + 8 + h]; }
        const float bcum = scan_sum(lf, lane);
        const float av = ig - bcum;
        const float Av = fmaxf(m, scan_max(av, lane));
        const float bL = __shfl(bcum, 63), A63 = __shfl(Av, 63);
        const float wsv = fexp(av - A63), wC = fexp(m - A63);
#pragma unroll
        for (int i = 0; i < 2; ++i) { const int id = lane + 64 * i, rr = 8 * wave + (id >> 4), ch = id & 15;
            const u32x4 kx = *(const LAS u32x4*)(Kc + rr * ML_QP + ch * 16); const float w = __shfl(wsv, rr);
            u32x4 o; o.x = pk2(bflo(kx.x) * w, bfhi(kx.x) * w); o.y = pk2(bflo(kx.y) * w, bfhi(kx.y) * w); o.z = pk2(bflo(kx.z) * w, bfhi(kx.z) * w); o.w = pk2(bflo(kx.w) * w, bfhi(kx.w) * w);
            *(LAS u32x4*)(lds + ML_KW + rr * ML_QP + ch * 16) = o; }
        {
#pragma unroll
          for (int cc = 0; cc < 2; ++cc) { const int cb = 2 * (wave & 1) + cc;
            f32x4 s = {0.f, 0.f, 0.f, 0.f};
            if (cb <= rb) {
#pragma unroll
                for (int ks = 0; ks < 4; ++ks) { const bf16x8 af = *(const LAS bf16x8*)(Qc + (16 * rb + i16) * ML_QP + (32 * ks + 8 * q4) * 2);
                    const bf16x8 bf = *(const LAS bf16x8*)(Kc + (16 * cb + i16) * ML_QP + (32 * ks + 8 * q4) * 2); s = mma16(af, bf, s); } }
            const int sidx = 16 * cb + i16; const float as = __shfl(av, sidx);
#pragma unroll
            for (int i = 0; i < 4; ++i) { const int t = 16 * rb + 4 * q4 + i; const float At = __shfl(Av, t);
                const float pv_ = (sidx <= t && cb <= rb) ? s[i] * fexp(as - At) : 0.f;
                *(LAS bf16_t*)(lds + ML_P + t * ML_PP + sidx * 2) = (bf16_t)f2bf(pv_); } } }
        LDS_BARRIER();
        { const int t = tid >> 3, part = tid & 7;
          const LAS unsigned char* qrow = Qc + t * ML_QP + part * 32;
          const u32x4 qa = *(const LAS u32x4*)(qrow), qb = *(const LAS u32x4*)(qrow + 16);
          const LAS float* nn = nS + cur * 128 + 16 * part;
          float a = nn[0] * bflo(qa.x) + nn[1] * bfhi(qa.x) + nn[2] * bflo(qa.y) + nn[3] * bfhi(qa.y) + nn[4] * bflo(qa.z) + nn[5] * bfhi(qa.z) + nn[6] * bflo(qa.w) + nn[7] * bfhi(qa.w)
                  + nn[8] * bflo(qb.x) + nn[9] * bfhi(qb.x) + nn[10] * bflo(qb.y) + nn[11] * bfhi(qb.y) + nn[12] * bflo(qb.z) + nn[13] * bfhi(qb.z) + nn[14] * bflo(qb.w) + nn[15] * bfhi(qb.w);
          const u32x4 pr = *(const LAS u32x4*)(lds + ML_P + t * ML_PP + part * 16);
          const float rsum = ((bflo(pr.x) + bfhi(pr.x)) + (bflo(pr.y) + bfhi(pr.y))) + ((bflo(pr.z) + bfhi(pr.z)) + (bflo(pr.w) + bfhi(pr.w)));
          const float At = __shfl(Av, t), bt = __shfl(bcum, t);
          float val = fexp(m - At) * a + rsum;
          val = row8_sum(val);
          if (part == 0) denS[t] = 1.f / fmaxf(fabsf(val), fexp(-(bt + At))); }
        if (tid < 128) { float acc = wC * nS[cur * 128 + tid];
#pragma unroll 8
            for (int s = 0; s < 64; ++s) acc += bf1(*(const LAS bf16_t*)(lds + ML_KW + s * ML_QP + tid * 2));
            nS[nxt * 128 + tid] = acc; }
        f32x4 num0 = {0.f, 0.f, 0.f, 0.f}, num1 = {0.f, 0.f, 0.f, 0.f};
#pragma unroll
        for (int ks = 0; ks < 4; ++ks) { const LAS unsigned char* qrow = Qc + (16 * rb + i16) * ML_QP;
            const u32x2 lo = *(const LAS u32x2*)(qrow + (32 * ks + 4 * q4) * 2), hi = *(const LAS u32x2*)(qrow + (32 * ks + 16 + 4 * q4) * 2);
            u32x4 w; w.x = lo.x; w.y = lo.y; w.z = hi.x; w.w = hi.y; const bf16x8 af = __builtin_bit_cast(bf16x8, w);
            num0 = mma16(af, pack8(CT[0][2 * ks], CT[0][2 * ks + 1]), num0); num1 = mma16(af, pack8(CT[1][2 * ks], CT[1][2 * ks + 1]), num1); }
#pragma unroll
        for (int i = 0; i < 4; ++i) { const float wi = fexp(m - __shfl(Av, 16 * rb + 4 * q4 + i)); num0[i] *= wi; num1[i] *= wi; }
        const unsigned vbase = vbase0 + cur * ML_VSZ;
        bf16x8 V00, V01, V10, V11;
        TR_READ4(V00, V01, V10, V11, vbase, 0, 4 * ML_VP, 32 * ML_VP, 36 * ML_VP, 32, 4 * ML_VP + 32, 32 * ML_VP + 32, 36 * ML_VP + 32);
        { const bf16x8 pf0 = *(const LAS bf16x8*)(lds + ML_P + (16 * rb + i16) * ML_PP + (8 * q4) * 2), pf1 = *(const LAS bf16x8*)(lds + ML_P + (16 * rb + i16) * ML_PP + (32 + 8 * q4) * 2);
          num0 = mma16(pf0, V00, num0); num0 = mma16(pf1, V01, num0); num1 = mma16(pf0, V10, num1); num1 = mma16(pf1, V11, num1); }
#pragma unroll
        for (int a = 0; a < 2; ++a)
#pragma unroll
            for (int d = 0; d < 8; ++d) CT[a][d] = CT[a][d] * wC;
#pragma unroll
        for (int ks = 0; ks < 2; ++ks)
#pragma unroll
            for (int dg = 0; dg < 2; ++dg) { bf16x8 k0, k1, k2, k3;
                TR_READ4(k0, k1, k2, k3, kwbase, 32 * ks * ML_QP + 32 * (4 * dg), (32 * ks + 4) * ML_QP + 32 * (4 * dg), 32 * ks * ML_QP + 32 * (4 * dg + 1), (32 * ks + 4) * ML_QP + 32 * (4 * dg + 1),
                         32 * ks * ML_QP + 32 * (4 * dg + 2), (32 * ks + 4) * ML_QP + 32 * (4 * dg + 2), 32 * ks * ML_QP + 32 * (4 * dg + 3), (32 * ks + 4) * ML_QP + 32 * (4 * dg + 3));
                const bf16x8 va = ks ? V01 : V00, vb = ks ? V11 : V10;
                CT[0][4 * dg] = mma16(k0, va, CT[0][4 * dg]); CT[0][4 * dg + 1] = mma16(k1, va, CT[0][4 * dg + 1]); CT[0][4 * dg + 2] = mma16(k2, va, CT[0][4 * dg + 2]); CT[0][4 * dg + 3] = mma16(k3, va, CT[0][4 * dg + 3]);
                CT[1][4 * dg] = mma16(k0, vb, CT[1][4 * dg]); CT[1][4 * dg + 1] = mma16(k1, vb, CT[1][4 * dg + 1]); CT[1][4 * dg + 2] = mma16(k2, vb, CT[1][4 * dg + 2]); CT[1][4 * dg + 3] = mma16(k3, vb, CT[1][4 * dg + 3]); }
        { LAS unsigned char* Qn = lds + ML_Q + nxt * ML_QSZ; LAS unsigned char* Kn = lds + ML_K + nxt * ML_QSZ;
          *(LAS u32x4*)(Qn + srow0 * ML_QP + sch * 16) = pq0; *(LAS u32x4*)(Qn + (srow0 + 32) * ML_QP + sch * 16) = pq1;
          *(LAS u32x4*)(Kn + srow0 * ML_QP + sch * 16) = pk0; *(LAS u32x4*)(Kn + (srow0 + 32) * ML_QP + sch * 16) = pk1;
          *(LAS u32x4*)(lds + ML_V + nxt * ML_VSZ + vrow * ML_VP + vch * 16) = pv; }
        LDS_BARRIER();
#pragma unroll
        for (int i = 0; i < 4; ++i) { const int t = 16 * rb + 4 * q4 + i; const float dinv = denS[t]; const float h0 = num0[i] * dinv, h1 = num1[i] * dinv;
            hv0[i] = h0; hv1[i] = h1;
            float s0 = h0 * h0, s1 = h1 * h1;
            s0 = row16_sum(s0);
            s1 = row16_sum(s1);
            sv0[i] = s0; sv1[i] = s1; }
        m = bL + A63;
    }
    ML_FLUSH(rbase + 64 * 31);
#undef ML_FLUSH
    const size_t sb = (size_t)(ib * NBP + b) * 8 + h;
    if (rb == 0) {
#pragma unroll
        for (int a = 0; a < 2; ++a)
#pragma unroll
            for (int d = 0; d < 8; ++d) *(f32x4*)(out + O_CP + (sb * 256 + e0 + 16 * a + i16) * 128 + 16 * d + 4 * q4) = CT[a][d]; }
    if (sl == 0) { if (tid < 128) out[O_NP + sb * 128 + tid] = nS[tid]; if (tid == 0) out[O_MP + sb] = m; }
}

__device__ __forceinline__ void hn_row(const bf16_t* HRAW, const float* SQ, const bf16_t* QKVO, const float* gh, bf16_t* HN, int r, int lane) {
    const int hh = lane >> 3;
    const f32x4 s0 = *(const f32x4*)(SQ + (size_t)r * 128 + hh * 16), s1 = *(const f32x4*)(SQ + (size_t)r * 128 + hh * 16 + 4), s2 = *(const f32x4*)(SQ + (size_t)r * 128 + hh * 16 + 8), s3 = *(const f32x4*)(SQ + (size_t)r * 128 + hh * 16 + 12);
    const float tot = (((s0[0] + s0[1]) + (s0[2] + s0[3])) + ((s1[0] + s1[1]) + (s1[2] + s1[3]))) + (((s2[0] + s2[1]) + (s2[2] + s2[3])) + ((s3[0] + s3[1]) + (s3[2] + s3[3])));
    const float rs = rsqrtf(tot * (1.f / 256.f) + EPS);
#pragma unroll
    for (int c = 0; c < 4; ++c) { const int col = 32 * lane + 8 * c;
        const u32x4 hx = *(const u32x4*)(HRAW + (size_t)r * DM + col), ox = *(const u32x4*)(QKVO + (size_t)r * NIN + 4096 + col);
        const f32x4 g0 = *(const f32x4*)(gh + col), g1 = *(const f32x4*)(gh + col + 4);
        u32x4 o;
        o.x = pk2(bflo(hx.x) * rs * g0[0] / (1.f + fexp(-bflo(ox.x))), bfhi(hx.x) * rs * g0[1] / (1.f + fexp(-bfhi(ox.x))));
        o.y = pk2(bflo(hx.y) * rs * g0[2] / (1.f + fexp(-bflo(ox.y))), bfhi(hx.y) * rs * g0[3] / (1.f + fexp(-bfhi(ox.y))));
        o.z = pk2(bflo(hx.z) * rs * g1[0] / (1.f + fexp(-bflo(ox.z))), bfhi(hx.z) * rs * g1[1] / (1.f + fexp(-bfhi(ox.z))));
        o.w = pk2(bflo(hx.w) * rs * g1[2] / (1.f + fexp(-bflo(ox.w))), bfhi(hx.w) * rs * g1[3] / (1.f + fexp(-bfhi(ox.w))));
        *(u32x4*)(HN + (size_t)r * DM + col) = o; }
}

__device__ __forceinline__ void mlstm_sample(LAS unsigned char* lds, const bf16_t* QKVO, const float* GATES, const float* gh, const float* C0all, const float* n0all, const float* m0all, bf16_t* HN, float* out, int ib, int bh, int tid, int wave, int lane) {
    const int bs = bh >> 3, h = bh & 7;
    const size_t sb = (size_t)(ib * NBS + bs) * 8 + h;
    LAS float* qs = (LAS float*)lds;
    LAS float* ks = qs + 512;
    LAS float* ns = ks + 512;
    LAS float* Ss = ns + 128;
    LAS float* nq = Ss + 16;
    LAS float* red = nq + 16;
    const size_t r0 = (size_t)MP + bs * 4;
    __syncthreads();
    { const int t = tid >> 7, d = tid & 127; qs[tid] = bf1(QKVO[(r0 + t) * NIN + h * 128 + d]); ks[tid] = bf1(QKVO[(r0 + t) * NIN + 1024 + h * 128 + d]); if (tid < 128) ns[tid] = n0all[sb * 128 + tid]; }
    __syncthreads();
    if (wave == 0) {
        if (lane < 16) { const int t = lane >> 2, s = lane & 3; float a = 0.f; for (int d = 0; d < 128; ++d) a += qs[t * 128 + d] * ks[s * 128 + d]; Ss[lane] = a; }
        else if (lane < 20) { const int t = lane - 16; float a = 0.f; for (int d = 0; d < 128; ++d) a += ns[d] * qs[t * 128 + d]; nq[t] = a; }
    }
    __syncthreads();
    const float m0 = m0all[sb];
    float bc[4], av[4], Av[4];
    { float run = 0.f, pm = -INFINITY;
#pragma unroll
      for (int t = 0; t < 4; ++t) { const float ig = GATES[(r0 + t) * 16 + h], lf = GATES[(r0 + t) * 16 + 8 + h]; run += lf; bc[t] = run; av[t] = ig - run; pm = fmaxf(pm, av[t]); Av[t] = fmaxf(m0, pm); } }
    const float A3 = Av[3], wC = fexp(m0 - A3);
    float Pm[4][4], den[4];
#pragma unroll
    for (int t = 0; t < 4; ++t) { float rs = 0.f;
#pragma unroll
        for (int s = 0; s < 4; ++s) { Pm[t][s] = (s <= t) ? Ss[t * 4 + s] * fexp(av[s] - Av[t]) : 0.f; rs += Pm[t][s]; }
        den[t] = fexp(m0 - Av[t]) * nq[t] + rs; }
    const int e = tid >> 1, hf = tid & 1;
    const float* Crow = C0all + (sb * 256 + e) * 128 + 64 * hf;
    f32x4 Cv[16];
#pragma unroll
    for (int j = 0; j < 16; ++j) Cv[j] = *(const f32x4*)(Crow + 4 * j);
    float inter[4];
#pragma unroll
    for (int t = 0; t < 4; ++t) { float a = 0.f; const LAS float* q = qs + t * 128 + 64 * hf;
#pragma unroll
        for (int j = 0; j < 16; ++j) a += Cv[j].x * q[4 * j] + Cv[j].y * q[4 * j + 1] + Cv[j].z * q[4 * j + 2] + Cv[j].w * q[4 * j + 3];
        a += __shfl_xor(a, 1); inter[t] = a; }
    float vv[4];
#pragma unroll
    for (int s = 0; s < 4; ++s) vv[s] = bf1(QKVO[(r0 + s) * NIN + 2048 + h * 256 + e]);
    float hv[4];
#pragma unroll
    for (int t = 0; t < 4; ++t) { float nu = fexp(m0 - Av[t]) * inter[t];
#pragma unroll
        for (int s = 0; s < 4; ++s) nu += Pm[t][s] * vv[s];
        hv[t] = nu / fmaxf(fabsf(den[t]), fexp(-(bc[t] + Av[t])));
        float sq = (hf == 0) ? hv[t] * hv[t] : 0.f; sq = wave_sum(sq); if (lane == 0) red[t * 8 + wave] = sq; }
    __syncthreads();
    if (hf == 0) {
#pragma unroll
        for (int t = 0; t < 4; ++t) { float tot = 0.f;
#pragma unroll
            for (int w = 0; w < 8; ++w) tot += red[t * 8 + w];
            const float rs = rsqrtf(tot * (1.f / 256.f) + EPS);
            const float og = bf1(QKVO[(r0 + t) * NIN + 4096 + h * 256 + e]);
            HN[(r0 + t) * DM + h * 256 + e] = (bf16_t)f2bf(hv[t] * rs * gh[h * 256 + e] / (1.f + fexp(-og))); } }
    float wv[4];
#pragma unroll
    for (int s = 0; s < 4; ++s) wv[s] = fexp(av[s] - A3) * vv[s];
    float* Cout = out + O_CS + (sb * 256 + e) * 128 + 64 * hf;
#pragma unroll
    for (int j = 0; j < 16; ++j) { f32x4 o = Cv[j] * wC;
#pragma unroll
        for (int s = 0; s < 4; ++s) { const LAS float* k = ks + s * 128 + 64 * hf + 4 * j; o.x += wv[s] * k[0]; o.y += wv[s] * k[1]; o.z += wv[s] * k[2]; o.w += wv[s] * k[3]; }
        *(f32x4*)(Cout + 4 * j) = o; }
    if (tid < 128) { float o = wC * ns[tid];
#pragma unroll
        for (int s = 0; s < 4; ++s) o += fexp(av[s] - A3) * ks[s * 128 + tid];
        out[O_NS + sb * 128 + tid] = o; }
    if (tid == 0) out[O_MS + sb] = bc[3] + A3;
}

__device__ __forceinline__ void cache_shift(const Params& P, float* outp, int ia, int w, int NW, int lane) {
    constexpr int N0 = NBS * 124, N1 = NBS * 508, N2 = NBS * 2044;
    for (int it = w; it < N0 + N1 + N2; it += NW) {
        int g, q; if (it < N0) { g = 0; q = it; } else if (it < N0 + N1) { g = 1; q = it - N0; } else { g = 2; q = it - N0 - N1; }
        const int win = 128 << (2 * g), per = win - 4, bs = q / per, j = q % per;
        const float* src = P.in[2 + g] + ((size_t)(ia * NBS + bs) * win + j + 4) * 2048;
        float* dst = outp + ((g == 0) ? O_KV128S : (g == 1) ? O_KV512S : O_KV2048S) + ((size_t)(ia * NBS + bs) * win + j) * 2048;
#pragma unroll
        for (int i = 0; i < 8; ++i) ((f32x4*)dst)[lane + 64 * i] = ((const f32x4*)src)[lane + 64 * i];
    }
}

__device__ __forceinline__ void phase_convgate(const Params& P, float* outp, const bf16_t* U, bf16_t* Z, int layer, int gtid, int NGT) {
    constexpr int NCG = DFF / 8, NRUN = MP / 64 + NBS;
    const float* cw = P.in[20] + (size_t)layer * 3 * NUP; const float* cbias = P.in[21] + (size_t)layer * NUP;
    for (int task = gtid; task < NCG * NRUN; task += NGT) {
        const int cg = task % NCG, run = task / NCG, j0 = 8 * cg;
        const int ua0 = 256 * (j0 >> 7) + (j0 & 127), ub0 = ua0 + 128;
        float wa[3][8], wb[3][8], ba[8], bb[8];
#pragma unroll
        for (int k = 0; k < 3; ++k) { load8(cw + (size_t)k * NUP + j0, wa[k]); load8(cw + (size_t)k * NUP + DFF + j0, wb[k]); }
        load8(cbias + j0, ba); load8(cbias + DFF + j0, bb);
        float a2[8], a1[8], b2[8], b1[8];
        size_t row0; int nrows; float* cout;
        if (run < MP / 64) { const int b = run >> 5, s0 = (run & 31) * 64; row0 = (size_t)b * SEQ + s0; nrows = 64;
            cout = (s0 == SEQ - 64) ? outp + O_CONVP + ((size_t)(layer * NBP + b) * 2) * NUP : nullptr;
            if (s0 == 0) {
#pragma unroll
                for (int j = 0; j < 8; ++j) { a2[j] = 0.f; a1[j] = 0.f; b2[j] = 0.f; b1[j] = 0.f; } }
            else { unpack8(*(const u32x4*)(U + (row0 - 2) * NUP + ua0), a2); unpack8(*(const u32x4*)(U + (row0 - 1) * NUP + ua0), a1);
                   unpack8(*(const u32x4*)(U + (row0 - 2) * NUP + ub0), b2); unpack8(*(const u32x4*)(U + (row0 - 1) * NUP + ub0), b1); } }
        else { const int bs = run - MP / 64; row0 = (size_t)MP + bs * 4; nrows = 4;
            cout = outp + O_CONVS + ((size_t)(layer * NBS + bs) * 2) * NUP;
            const float* st = P.in[8] + ((size_t)(layer * NBS + bs) * 2) * NUP;
            load8(st + j0, a2); load8(st + NUP + j0, a1); load8(st + DFF + j0, b2); load8(st + NUP + DFF + j0, b1); }
        for (int t = 0; t < nrows; t += 4) {
            u32x4 ua[4], ub[4];
#pragma unroll
            for (int q = 0; q < 4; ++q) { ua[q] = *(const u32x4*)(U + (row0 + t + q) * NUP + ua0); ub[q] = *(const u32x4*)(U + (row0 + t + q) * NUP + ub0); }
#pragma unroll
            for (int q = 0; q < 4; ++q) {
                float a0[8], b0[8];
                unpack8(ua[q], a0); unpack8(ub[q], b0);
                float z[8];
#pragma unroll
                for (int j = 0; j < 8; ++j) { const float ca = ba[j] + wa[0][j] * a2[j] + wa[1][j] * a1[j] + wa[2][j] * a0[j]; const float cb = bb[j] + wb[0][j] * b2[j] + wb[1][j] * b1[j] + wb[2][j] * b0[j];
                    z[j] = ca / (1.f + fexp(-ca)) * cb; a2[j] = a1[j]; a1[j] = a0[j]; b2[j] = b1[j]; b1[j] = b0[j]; }
                u32x4 o; o.x = pk2(z[0], z[1]); o.y = pk2(z[2], z[3]); o.z = pk2(z[4], z[5]); o.w = pk2(z[6], z[7]);
                *(u32x4*)(Z + (row0 + t + q) * DFF + j0) = o;
            }
        }
        if (cout) { store8(cout + j0, a2); store8(cout + NUP + j0, a1); store8(cout + DFF + j0, b2); store8(cout + NUP + DFF + j0, b1); }
    }
}

#ifndef REP_STORE
#define REP_STORE 1
#endif
#ifndef REP_CONV
#define REP_CONV 1
#endif
#ifndef REP_ML
#define REP_ML 1
#endif
#ifndef REP_ATT
#define REP_ATT 1
#endif
#ifndef REP_RESID
#define REP_RESID 1
#endif
#ifndef REP_FIN
#define REP_FIN 1
#endif
#ifndef REP_CS
#define REP_CS 1
#endif
#ifndef REP_MR
#define REP_MR 1
#endif
#ifndef REP_P0
#define REP_P0 1
#endif
#define REPEAT(n, body) do { body; if ((n) > 1) { body; } if ((n) > 2) { body; } } while (0)
__global__ void __launch_bounds__(NTHR, 2) fwd_kernel(Params P) {
    extern __shared__ __attribute__((aligned(16))) unsigned char lds_raw[];
    LAS unsigned char* lds = (LAS unsigned char*)lds_raw;
    const unsigned lds_base = (unsigned)(size_t)lds;
    const int tid0 = threadIdx.x;
    const int G0 = gridDim.x, bx0 = blockIdx.x;
#define PHASE_IDS int tid = tid0; asm volatile("" : "+v"(tid)); int zz_ = 0; asm volatile("" : "+v"(zz_)); zz_ = __builtin_amdgcn_readfirstlane(zz_); const int bx = bx0 + zz_, G = G0 + zz_; unsigned char* ws = P.ws + zz_; float* outp = P.out + zz_; \
    const int lane = tid & 63, wave = __builtin_amdgcn_readfirstlane(tid >> 6); const int gw = bx * NWAVES + wave, gtid = bx * NTHR + tid, NGW = G * NWAVES, NGT = G * NTHR; (void)gw; (void)gtid; (void)lane; (void)NGW; (void)NGT; (void)outp; \
    bf16_t* XB = (bf16_t*)(ws + WS_XB); float* SSQ = (float*)(ws + WS_SSQ); float* SSQS = (float*)(ws + WS_SSQS); bf16_t* QKV = (bf16_t*)(ws + WS_QKV); bf16_t* OG = (bf16_t*)(ws + WS_OG); float* LSE = (float*)(ws + WS_LSE); bf16_t* OC = (bf16_t*)(ws + WS_OC); \
    float* GATES = (float*)(ws + WS_GATES); bf16_t* U = (bf16_t*)(ws + WS_U); bf16_t* Z = (bf16_t*)(ws + WS_Z); (void)XB; (void)SSQ; (void)SSQS; (void)QKV; (void)OG; (void)LSE; (void)OC; (void)GATES; (void)U; (void)Z;
    volatile LAS unsigned* misc = (volatile LAS unsigned*)(lds + LDS_MISC_OFF);
    if (tid0 < 16) misc[tid0] = 0u;
    __syncthreads();
    { const XcdBarrier bar0 = xcd_barrier_post((unsigned*)(P.ws + WS_CTL) + 1024, misc + 8); if (tid0 == 0) misc[10] = bar0.x; }
    __syncthreads();
#define GRID_BAR() do { XcdBarrier bar_; bar_.bar = (unsigned*)(P.ws + WS_CTL) + 1024; bar_.x = (unsigned)__builtin_amdgcn_readfirstlane((int)misc[10]); bar_.st = misc + 8; xcd_barrier(bar_); } while (0)
#define GEMM_STORE(Abuf, Wt, NN, KK, Obuf) REPEAT(REP_STORE, GEMM_STORE1(Abuf, Wt, NN, KK, Obuf))
#define GEMM_STORE1(Abuf, Wt, NN, KK, Obuf) do { PHASE_IDS; \
        { pg8::Gemm g{Abuf, (const bf16_t*)(Wt), MP, NN, KK}; pg8::StaticOrder S; S.init(MP, NN, G, bx); const int pm0_ = pg8::first_pm(S); LAS float* rtab_ = (LAS float*)(lds + RING_BYTES); pg8::rstd_panel(rtab_, SSQ, pm0_, EPS, tid); pg8::EpiStoreN E{Obuf, NN, SSQ, EPS, rtab_, pm0_}; \
          pg8::gemm_phase<pg8::EpiStoreN, pg8::StaticOrder, true, true>(lds, g, S, E); } \
        skinny_phase<0>(lds, Abuf + (size_t)MP * KK, KK, (const bf16_t*)(Wt), NN, Obuf + (size_t)MP * NN, NN, nullptr, SSQS, nullptr, bx, G, (((MP / 256) * ((NN) / 256)) % G) ? G - (((MP / 256) * ((NN) / 256)) % G) : G, tid, wave, lane); } while (0)
#define GEMM_RESID(Abuf, Wt, KK, FIN) do { PHASE_IDS; \
        { pg8::Gemm g{Abuf, (const bf16_t*)(Wt), MP, DM, KK}; pg8::StaticOrder S; S.init(MP, DM, G, bx); pg8::EpiResidN E{XB, (FIN) ? outp : nullptr, (FIN) ? nullptr : SSQ, DM}; \
          pg8::gemm_phase<pg8::EpiResidN, pg8::StaticOrder, true, true>(lds, g, S, E); } \
        if (FIN) skinny_phase<2>(lds, Abuf + (size_t)MP * KK, KK, (const bf16_t*)(Wt), DM, nullptr, 0, XB + (size_t)MP * DM, nullptr, outp + (size_t)MP * DM, bx, G, G, tid, wave, lane); \
        else skinny_phase<1>(lds, Abuf + (size_t)MP * KK, KK, (const bf16_t*)(Wt), DM, nullptr, 0, XB + (size_t)MP * DM, SSQS, nullptr, bx, G, G, tid, wave, lane); } while (0)

    REPEAT(REP_P0, { PHASE_IDS; phase_prologue(P, lds, gw, NGW, wave, lane); });
    GRID_BAR();

#define FFN(L, FIN) do { \
        { PHASE_IDS; unsigned* ctl_ = (unsigned*)(ws + WS_CTL); \
          skinny_up(lds, P.in[8], P.in[20] + (size_t)(L) * 3 * NUP, P.in[21] + (size_t)(L) * NUP, XB, (const bf16_t*)(ws + WS_WUP + (L) * SZ_WUP), SSQ, SSQS, (float*)(ws + WS_HALO), ctl_ + CW_HCNT, Z, outp, (L), bx, G, 128, tid, wave, lane); \
          { pg8::Gemm g{XB, (const bf16_t*)(ws + WS_WUP + (L) * SZ_WUP), MP, NUP, DM}; pg8::StaticOrder S; S.init(MP, NUP, G, bx); const int pm0_ = pg8::first_pm(S); \
            LAS float* rtab_ = (LAS float*)(lds + RING_BYTES); volatile LAS unsigned* rdy_ = (volatile LAS unsigned*)(lds + RING_BYTES + 1024 + 8192); if (tid == 0) rdy_[0] = 0u; pg8::rstd_panel(rtab_, SSQ, pm0_, EPS, tid); \
            pg8::EpiConv E{ws, P.in[20] + (size_t)(L) * 3 * NUP, P.in[21] + (size_t)(L) * NUP, lds + RING_BYTES, (unsigned)((L) + 1) * (unsigned)(SU_NITEMS * 4), pm0_}; \
            pg8::gemm_phase<pg8::EpiConv, pg8::StaticOrder, true, true>(lds, g, S, E); } } \
        GRID_BAR(); \
        GEMM_RESID(Z, ws + WS_WDOWN + (L) * SZ_WDOWN, DFF, FIN); \
    } while (0)

#define LAYER_PAIR(lp) do { \
        { \
            const int ia = (lp); \
            GEMM_STORE(XB, ws + WS_WQKV + ia * SZ_WQKV, NQKV, DM, QKV); \
            GRID_BAR(); \
            { PHASE_IDS; for (int r = gw; r < MR; r += NGW) prep_row(QKV, (const float*)(ws + WS_ROPE), P.in[12] + ia * 128, P.in[13] + ia * 128, outp, ia, r, lane); } \
            GRID_BAR(); \
            REPEAT(REP_ATT, { PHASE_IDS; attn_phase(lds, lds_base, QKV, OG, LSE, bx, G, 1536, tid, wave, lane); } \
            { PHASE_IDS; for (int wt = bx + G * wave; wt < NBS * 96; wt += G * NWAVES) attn_sample_task(lds + wave * 2048, QKV, P.in[2], P.in[3], P.in[4], OG, LSE, ia, wt, lane); __syncthreads(); }); \
            GRID_BAR(); \
            REPEAT(REP_ATT, { PHASE_IDS; for (int r = gw; r < MR; r += NGW) combine_row(OG, LSE, OC, r, lane); }); \
            GRID_BAR(); \
            GEMM_RESID(OC, ws + WS_WO + ia * SZ_WO, DO, false); \
            GRID_BAR(); \
            FFN(2 * (lp), false); \
            GRID_BAR(); \
        } \
        { \
            const int L = 2 * (lp) + 1, ib = (lp); \
            GEMM_STORE(XB, ws + WS_WIN + ib * SZ_WIN, NIN, DM, QKV); \
            { PHASE_IDS; for (int task = G - 1 - bx; task < MR / 16; task += G) gate_block(lds, XB, (const f32x4*)(ws + WS_WGP) + (size_t)ib * 128 * 64, P.in[16] + ib * 16, GATES, task, wave, lane); } \
            GRID_BAR(); \
            REPEAT(REP_ML, { PHASE_IDS; \
            if (bx < 128) { mlstm_prompt(lds, lds_base, QKV, GATES, OG, (float*)(ws + WS_SQ), outp, ib, bx, tid, wave, lane); if (REP_MR > 1) { __syncthreads(); mlstm_prompt(lds, lds_base, QKV, GATES, OG, (float*)(ws + WS_SQ), outp, ib, bx, tid, wave, lane); } } \
            else { if (bx < 192) mlstm_sample(lds, QKV, GATES, P.in[17] + (size_t)ib * DM, P.in[5], P.in[6], P.in[7], OC, outp, ib, bx - 128, tid, wave, lane); \
                   cache_shift(P, outp, (lp), (bx - 128) * NWAVES + wave, (G - 128) * NWAVES, lane); } }); \
            GRID_BAR(); \
            REPEAT(REP_FIN, { PHASE_IDS; for (int r = gw; r < MP; r += NGW) hn_row(OG, (const float*)(ws + WS_SQ), QKV, P.in[17] + (size_t)ib * DM, OC, r, lane); }); \
            GRID_BAR(); \
            GEMM_RESID(OC, ws + WS_WOUT + ib * SZ_WOUT, DM, false); \
            GRID_BAR(); \
            FFN(L, (L == DEPTH - 1)); \
            if ((lp) == 0) GRID_BAR(); \
        } \
    } while (0)
    LAYER_PAIR(0);
    LAYER_PAIR(1);
}

extern "C" void kernel_launch(void* const* d_in, const int* in_sizes, int n_in, void* d_out, int out_size, void* d_ws, size_t ws_size, hipStream_t stream) {
    static int grid = 0;
    if (grid == 0) {
        if (n_in != 23 || (size_t)out_size != O_END || ws_size < WS_END) {
            fprintf(stderr, "kernel_launch: built for 23 inputs, %zu outputs, >= %zu bytes of workspace; got n_in %d, out %d, ws %zu; nothing launched\n", (size_t)O_END, (size_t)WS_END, n_in, out_size, ws_size);
            grid = -1; return; }
        int dev = 0, cus = 0, per_cu = 0;
        if (hipGetDevice(&dev) != hipSuccess || hipDeviceGetAttribute(&cus, hipDeviceAttributeMultiprocessorCount, dev) != hipSuccess) { fprintf(stderr, "kernel_launch: device query failed\n"); grid = -1; return; }
        if (hipFuncSetAttribute((const void*)fwd_kernel, hipFuncAttributeMaxDynamicSharedMemorySize, LDS_BYTES) != hipSuccess) { fprintf(stderr, "kernel_launch: hipFuncSetAttribute failed\n"); grid = -1; return; }
        if (hipOccupancyMaxActiveBlocksPerMultiprocessor(&per_cu, (const void*)fwd_kernel, NTHR, LDS_BYTES) != hipSuccess || per_cu < 1)
            fprintf(stderr, "kernel_launch: occupancy query reports %d workgroups per CU\n", per_cu);
        (void)hipGetLastError();
        grid = cus;
    }
    if (grid < 0) return;
    (void)hipMemsetAsync((char*)d_ws + WS_CTL, 0, CTL_ZERO_BYTES, stream);
    Params p{};
    for (int i = 0; i < 23; ++i) p.in[i] = (const float*)d_in[i];
    p.out = (float*)d_out; p.ws = (unsigned char*)d_ws;
    hipLaunchKernelGGL(fwd_kernel, dim3(grid), dim3(NTHR), LDS_BYTES, stream, p);
    const hipError_t le = hipPeekAtLastError();
    if (le != hipSuccess) fprintf(stderr, "kernel_launch: launch failed: %s\n", hipGetErrorName(le));
}
```

```cpp
#include <hip/hip_runtime.h>
#include <cstdio>
#include <cstdint>

#define LAS __attribute__((address_space(3)))
typedef unsigned short bf16_t;
typedef short bf16x8 __attribute__((ext_vector_type(8)));
typedef float f32x4 __attribute__((ext_vector_type(4)));
typedef float f32x2 __attribute__((ext_vector_type(2)));
typedef unsigned u32x4 __attribute__((ext_vector_type(4)));
typedef unsigned u32x2 __attribute__((ext_vector_type(2)));
typedef unsigned short u16x4 __attribute__((ext_vector_type(4)));

constexpr int DM = 2048, SEQ = 2048, NBP = 4, NBS = 8, TSAMP = 4, PAST = 16384;
constexpr int MP = NBP * SEQ, MSAMP = NBS * TSAMP, MR = MP + MSAMP, MT = 8448;
constexpr int NQKV = 9216, NIN = 6144, NIN_SRC = 6160, DFF = 5632, NUP = 2 * DFF, DO = 1024;
constexpr int DEPTH = 4;
constexpr float EPS = 1e-6f;
constexpr int NWAVES = 8, NTHR = 512;

constexpr size_t O_YP = 0;
constexpr size_t O_YS = O_YP + (size_t)MP * DM;
constexpr size_t O_KV128P = O_YS + (size_t)MSAMP * DM;
constexpr size_t O_KV128S = O_KV128P + (size_t)2 * NBP * 128 * 2048;
constexpr size_t O_KV512P = O_KV128S + (size_t)2 * NBS * 128 * 2048;
constexpr size_t O_KV512S = O_KV512P + (size_t)2 * NBP * 512 * 2048;
constexpr size_t O_KV2048P = O_KV512S + (size_t)2 * NBS * 512 * 2048;
constexpr size_t O_KV2048S = O_KV2048P + (size_t)2 * NBP * 2048 * 2048;
constexpr size_t O_CP = O_KV2048S + (size_t)2 * NBS * 2048 * 2048;
constexpr size_t O_CS = O_CP + (size_t)2 * NBP * 8 * 256 * 128;
constexpr size_t O_NP = O_CS + (size_t)2 * NBS * 8 * 256 * 128;
constexpr size_t O_NS = O_NP + (size_t)2 * NBP * 8 * 128;
constexpr size_t O_MP = O_NS + (size_t)2 * NBS * 8 * 128;
constexpr size_t O_MS = O_MP + (size_t)2 * NBP * 8;
constexpr size_t O_CONVP = O_MS + (size_t)2 * NBS * 8;
constexpr size_t O_CONVS = O_CONVP + (size_t)DEPTH * NBP * 2 * NUP;
constexpr size_t O_END = O_CONVS + (size_t)DEPTH * NBS * 2 * NUP;

constexpr size_t al1m(size_t x) { return (x + 1048575) & ~(size_t)1048575; }
constexpr size_t WS_CTL = 0, CTL_ZERO_BYTES = 1048576;
constexpr size_t SZ_WQKV = (size_t)NQKV * DM * 2, SZ_WO = (size_t)DM * DO * 2, SZ_WIN = (size_t)NIN * DM * 2, SZ_WOUT = (size_t)DM * DM * 2, SZ_WUP = (size_t)NUP * DM * 2, SZ_WDOWN = (size_t)DM * DFF * 2;
constexpr size_t WS_WQKV = al1m(WS_CTL + CTL_ZERO_BYTES);
constexpr size_t WS_WO = al1m(WS_WQKV + 2 * SZ_WQKV);
constexpr size_t WS_WIN = al1m(WS_WO + 2 * SZ_WO);
constexpr size_t WS_WOUT = al1m(WS_WIN + 2 * SZ_WIN);
constexpr size_t WS_WUP = al1m(WS_WOUT + 2 * SZ_WOUT);
constexpr size_t WS_WDOWN = al1m(WS_WUP + 4 * SZ_WUP);
constexpr size_t WS_X = al1m(WS_WDOWN + 4 * SZ_WDOWN);
constexpr size_t WS_XB = al1m(WS_X + (size_t)MT * DM * 4);
constexpr size_t WS_SSQ = al1m(WS_XB + (size_t)MT * DM * 2);
constexpr size_t WS_SSQS = al1m(WS_SSQ + (size_t)MP * 32 * 4);
constexpr size_t WS_QKV = al1m(WS_SSQS + (size_t)MSAMP * 128 * 4);
constexpr size_t WS_OG = al1m(WS_QKV + (size_t)MT * NQKV * 2);
constexpr size_t WS_LSE = al1m(WS_OG + (size_t)MT * 3072 * 2);
constexpr size_t WS_OC = al1m(WS_LSE + (size_t)MT * 24 * 4);
constexpr size_t WS_GATES = al1m(WS_OC + (size_t)MT * DM * 2);
constexpr size_t WS_U = al1m(WS_GATES + (size_t)MT * 16 * 4);
constexpr size_t WS_Z = al1m(WS_U + (size_t)MT * NUP * 2);
constexpr size_t WS_SQ = al1m(WS_Z + (size_t)MT * DFF * 2);
constexpr size_t WS_ROPE = al1m(WS_SQ + (size_t)MP * 128 * 4);
constexpr size_t WS_WGP = al1m(WS_ROPE + (size_t)2052 * 128 * 4);
constexpr size_t WS_HALO = al1m(WS_WGP + (size_t)2 * 128 * 64 * 16);
constexpr size_t WS_END = al1m(WS_HALO + (size_t)64 * NUP * 4);
constexpr int CW_HCNT = 65536, CW_TMO = 65600, CW_CSQ = 65664;

constexpr int RING_BYTES = 131072;
constexpr int LDS_MISC_OFF = 150 * 1024;
constexpr int LDS_BYTES = 152 * 1024;

__device__ __forceinline__ unsigned pk2(float lo, float hi) { unsigned r; asm("v_cvt_pk_bf16_f32 %0, %1, %2" : "=v"(r) : "v"(lo), "v"(hi)); return r; }
__device__ __forceinline__ unsigned f2bf(float f) { return pk2(f, 0.f) & 0xffffu; }
__device__ __forceinline__ float bflo(unsigned w) { return __builtin_bit_cast(float, w << 16); }
__device__ __forceinline__ float bfhi(unsigned w) { return __builtin_bit_cast(float, w & 0xffff0000u); }
__device__ __forceinline__ float bf1(bf16_t b) { return __builtin_bit_cast(float, (unsigned)b << 16); }
__device__ __forceinline__ float fexp(float x) { return __builtin_amdgcn_exp2f(x * 1.4426950408889634f); }
template <int CTRL> __device__ __forceinline__ float dpp_mov(float src) { return __builtin_bit_cast(float, __builtin_amdgcn_mov_dpp(__builtin_bit_cast(int, src), CTRL, 0xf, 0xf, false)); }
__device__ __forceinline__ float row4_sum(float v) { v += dpp_mov<0xB1>(v); v += dpp_mov<0x4E>(v); return v; }
__device__ __forceinline__ float row8_sum(float v) { v = row4_sum(v); v += dpp_mov<0x141>(v); return v; }
__device__ __forceinline__ float row16_sum(float v) { v = row8_sum(v); v += dpp_mov<0x140>(v); return v; }
#define LDS_BARRIER() do { asm volatile("s_waitcnt lgkmcnt(0)" ::: "memory"); __builtin_amdgcn_s_barrier(); asm volatile("" ::: "memory"); } while (0)
__device__ __forceinline__ float wave_sum(float v) {
#pragma unroll
    for (int o = 1; o < 64; o <<= 1) v += __shfl_xor(v, o);
    return v;
}
__device__ __forceinline__ float wave_max(float v) {
#pragma unroll
    for (int o = 1; o < 64; o <<= 1) v = fmaxf(v, __shfl_xor(v, o));
    return v;
}
__device__ __forceinline__ f32x4 mma16(bf16x8 a, bf16x8 b, f32x4 c) { return __builtin_amdgcn_mfma_f32_16x16x32_bf16(a, b, c, 0, 0, 0); }
__device__ __forceinline__ bf16x8 tr_read2(unsigned base, int off0, int off1) {
    u16x4 r0, r1;
    asm volatile("ds_read_b64_tr_b16 %0, %2 offset:%c3\n\tds_read_b64_tr_b16 %1, %2 offset:%c4\n\ts_waitcnt lgkmcnt(0)" : "=&v"(r0), "=&v"(r1) : "v"(base), "i"(off0), "i"(off1) : "memory");
    bf16x8 o; o[0] = (short)r0[0]; o[1] = (short)r0[1]; o[2] = (short)r0[2]; o[3] = (short)r0[3]; o[4] = (short)r1[0]; o[5] = (short)r1[1]; o[6] = (short)r1[2]; o[7] = (short)r1[3];
    return o;
}

__device__ __forceinline__ bf16x8 tr_join(u16x4 r0, u16x4 r1) { bf16x8 o; o[0] = (short)r0[0]; o[1] = (short)r0[1]; o[2] = (short)r0[2]; o[3] = (short)r0[3]; o[4] = (short)r1[0]; o[5] = (short)r1[1]; o[6] = (short)r1[2]; o[7] = (short)r1[3]; return o; }
#define TR_RD "ds_read_b64_tr_b16 "
#define TR_READ4(F0, F1, F2, F3, base, a0, a1, b0, b1, c0, c1, d0, d1) do { u16x4 t0_, t1_, t2_, t3_, t4_, t5_, t6_, t7_; \
    asm volatile(TR_RD "%0, %8 offset:%c9\n\t" TR_RD "%1, %8 offset:%c10\n\t" TR_RD "%2, %8 offset:%c11\n\t" TR_RD "%3, %8 offset:%c12\n\t" TR_RD "%4, %8 offset:%c13\n\t" TR_RD "%5, %8 offset:%c14\n\t" TR_RD "%6, %8 offset:%c15\n\t" TR_RD "%7, %8 offset:%c16\n\ts_waitcnt lgkmcnt(0)" \
        : "=&v"(t0_), "=&v"(t1_), "=&v"(t2_), "=&v"(t3_), "=&v"(t4_), "=&v"(t5_), "=&v"(t6_), "=&v"(t7_) : "v"(base), "i"(a0), "i"(a1), "i"(b0), "i"(b1), "i"(c0), "i"(c1), "i"(d0), "i"(d1) : "memory"); \
    F0 = tr_join(t0_, t1_); F1 = tr_join(t2_, t3_); F2 = tr_join(t4_, t5_); F3 = tr_join(t6_, t7_); } while (0)
#define TR_READ5(F0, F1, F2, F3, F4, base, a0, a1, b0, b1, c0, c1, d0, d1, e0, e1) do { u16x4 t0_, t1_, t2_, t3_, t4_, t5_, t6_, t7_, t8_, t9_; \
    asm volatile(TR_RD "%0, %10 offset:%c11\n\t" TR_RD "%1, %10 offset:%c12\n\t" TR_RD "%2, %10 offset:%c13\n\t" TR_RD "%3, %10 offset:%c14\n\t" TR_RD "%4, %10 offset:%c15\n\t" TR_RD "%5, %10 offset:%c16\n\t" TR_RD "%6, %10 offset:%c17\n\t" TR_RD "%7, %10 offset:%c18\n\t" TR_RD "%8, %10 offset:%c19\n\t" TR_RD "%9, %10 offset:%c20\n\ts_waitcnt lgkmcnt(0)" \
        : "=&v"(t0_), "=&v"(t1_), "=&v"(t2_), "=&v"(t3_), "=&v"(t4_), "=&v"(t5_), "=&v"(t6_), "=&v"(t7_), "=&v"(t8_), "=&v"(t9_) : "v"(base), "i"(a0), "i"(a1), "i"(b0), "i"(b1), "i"(c0), "i"(c1), "i"(d0), "i"(d1), "i"(e0), "i"(e1) : "memory"); \
    F0 = tr_join(t0_, t1_); F1 = tr_join(t2_, t3_); F2 = tr_join(t4_, t5_); F3 = tr_join(t6_, t7_); F4 = tr_join(t8_, t9_); } while (0)
__device__ __forceinline__ bf16x8 pack8(f32x4 a, f32x4 b) {
    u32x4 w; w.x = pk2(a[0], a[1]); w.y = pk2(a[2], a[3]); w.z = pk2(b[0], b[1]); w.w = pk2(b[2], b[3]);
    return __builtin_bit_cast(bf16x8, w);
}

namespace pg8 {
#define PG8_LAS __attribute__((address_space(3)))
typedef unsigned short bf16_t;
typedef short bf16x8 __attribute__((ext_vector_type(8)));
typedef float f32x4 __attribute__((ext_vector_type(4)));
typedef unsigned u32x4 __attribute__((ext_vector_type(4)));
constexpr int BM = 256, BK = 64, HALF = 128, HTB = HALF * BK * 2  , STAGE_BYTES = 8 * HTB, NXCD = 8, WGM = 8;

__host__ __device__ __forceinline__ int lds_byte(int r, int c) { const int st = (r >> 4) * 2 + (c >> 5), rr = r & 15, cc = c & 31, ob = rr * 64 + cc * 2; return st * 1024 + (ob ^ (((ob >> 9) & 1) << 5)); }
__host__ __device__ __forceinline__ void stage_rc(int b, int& R, int& C) { const int st = b / 1024, sb = b % 1024, swz = sb ^ (((sb >> 9) & 1) << 5); R = (st >> 1) * 16 + swz / 64; C = (st & 1) * 32 + (swz % 64) / 2; }
__host__ __device__ __forceinline__ int perm32(int rho) { const int n = rho >> 4, i = rho & 15; return 8 * (i >> 2) + 4 * n + (i & 3); }

struct Unit { int pm, pn; };
struct Gemm { const bf16_t* A; const bf16_t* Bt; int M, N, K; };

struct StaticOrder {
    int nM, nN, nwg, G, c;
    __host__ __device__ void init(int M, int N, int G_, int c_) { nM = M / BM; nN = N / BM; nwg = nM * nN; G = G_; c = c_; }
    __host__ __device__ bool next(int i, Unit& u) const {
        const long L = (long)i * G + c; if (L >= nwg) return false;
        int wgid = (int)L; { const int q = nwg / NXCD, r = nwg % NXCD, xcd = wgid % NXCD, off = wgid / NXCD; wgid = (xcd < r ? xcd * (q + 1) : r * (q + 1) + (xcd - r) * q) + off; }
        const int nig = WGM * nN, gid = wgid / nig, fm = gid * WGM, gsz = (nM - fm) < WGM ? (nM - fm) : WGM;
        u.pm = fm + ((wgid % nig) % gsz); u.pn = (wgid % nig) / gsz; return true;
    }
    __device__ __forceinline__ void a_ready(const Unit&) const {}
    __device__ __forceinline__ void done(const Unit&) const {}
};
__device__ __forceinline__ unsigned cvt_pk_bf16(float lo, float hi) { unsigned r; asm volatile("v_cvt_pk_bf16_f32 %0, %1, %2" : "=v"(r) : "v"(lo), "v"(hi)); return r; }

struct EpiStore {
    static constexpr bool PERM = true, AFTER_DRAIN = false;
    bf16_t* O; int ldc;
    __device__ __forceinline__ void operator()(const f32x4 (&acc)[2][2][4][2], const Unit& u, int wr, int wc, int fr, int fq) const {
        const int row0 = u.pm * BM + wr * 64 + fr, col0 = u.pn * BM + wc * 32 + 8 * fq;
#pragma unroll
        for (int ai = 0; ai < 2; ++ai)
#pragma unroll
            for (int m = 0; m < 4; ++m) { bf16_t* rowp = O + (size_t)(row0 + ai * HALF + m * 16) * ldc + col0;
#pragma unroll
                for (int bj = 0; bj < 2; ++bj) { const f32x4 v0 = acc[ai][bj][m][0], v1 = acc[ai][bj][m][1];
                    u32x4 w; w.x = cvt_pk_bf16(v0[0], v0[1]); w.y = cvt_pk_bf16(v0[2], v0[3]); w.z = cvt_pk_bf16(v1[0], v1[1]); w.w = cvt_pk_bf16(v1[2], v1[3]);
                    *(u32x4*)(rowp + bj * HALF) = w; } }
    }
};
struct EpiResid {
    static constexpr bool PERM = false, AFTER_DRAIN = false;
    const float* xin; float* out; int ldc; int mrows;
    __device__ __forceinline__ void operator()(const f32x4 (&acc)[2][2][4][2], const Unit& u, int wr, int wc, int fr, int fq) const {
        const int row0 = u.pm * BM + wr * 64 + fr, col0 = u.pn * BM + wc * 32 + 4 * fq;
#pragma unroll
        for (int ai = 0; ai < 2; ++ai)
#pragma unroll
            for (int m = 0; m < 4; ++m) { const int r = row0 + ai * HALF + m * 16;
                if (r < mrows) { const size_t off = (size_t)r * ldc + col0;
#pragma unroll
                    for (int bj = 0; bj < 2; ++bj)
#pragma unroll
                        for (int n = 0; n < 2; ++n) { const f32x4 bs = *(const f32x4*)(xin + off + bj * HALF + n * 16); *(f32x4*)(out + off + bj * HALF + n * 16) = bs + acc[ai][bj][m][n]; } }
                asm volatile("" ::: "memory"); }
    }
};


struct EpiStoreN {
    static constexpr bool PERM = true, AFTER_DRAIN = false;
    bf16_t* O; int ldc; const float* ssq; float eps; const PG8_LAS float* rs_tab; int rs_pm;
    __device__ __forceinline__ void operator()(const f32x4 (&acc)[2][2][4][2], const Unit& u, int wr, int wc, int fr, int fq) const {
        const int row0 = u.pm * BM + wr * 64 + fr, col0 = u.pn * BM + wc * 32 + 8 * fq;
        const bool cached = (u.pm == rs_pm);
#pragma unroll
        for (int ai = 0; ai < 2; ++ai)
#pragma unroll
            for (int m = 0; m < 4; ++m) { const int r = row0 + ai * HALF + m * 16;
                float rs;
                if (cached) rs = rs_tab[wr * 64 + fr + ai * HALF + m * 16];
                else { const f32x4 p0 = *(const f32x4*)(ssq + (size_t)r * 32 + 8 * fq), p1 = *(const f32x4*)(ssq + (size_t)r * 32 + 8 * fq + 4);
                    float s = ((p0[0] + p0[1]) + (p0[2] + p0[3])) + ((p1[0] + p1[1]) + (p1[2] + p1[3]));
                    s += __shfl_xor(s, 16); s += __shfl_xor(s, 32);
                    rs = rsqrtf(s * (1.f / 2048.f) + eps); }
                bf16_t* rowp = O + (size_t)r * ldc + col0;
#pragma unroll
                for (int bj = 0; bj < 2; ++bj) { const f32x4 v0 = acc[ai][bj][m][0] * rs, v1 = acc[ai][bj][m][1] * rs;
                    u32x4 w; w.x = cvt_pk_bf16(v0[0], v0[1]); w.y = cvt_pk_bf16(v0[2], v0[3]); w.z = cvt_pk_bf16(v1[0], v1[1]); w.w = cvt_pk_bf16(v1[2], v1[3]);
                    *(u32x4*)(rowp + bj * HALF) = w; } }
    }
};
__device__ __forceinline__ int first_pm(const StaticOrder& S) { const int wg0 = S.c; const int q = S.nwg / NXCD, r = S.nwg % NXCD, xcd = wg0 % NXCD, off = wg0 / NXCD; const int wgid = (xcd < r ? xcd * (q + 1) : r * (q + 1) + (xcd - r) * q) + off;
    const int nig = WGM * S.nN, gid = wgid / nig, fm = gid * WGM, gsz = (S.nM - fm) < WGM ? (S.nM - fm) : WGM; return fm + ((wgid % nig) % gsz); }
__device__ __forceinline__ void rstd_panel(PG8_LAS float* tab, const float* ssq, int pm, float eps, int tid) {
    const int row = tid >> 1, hf = tid & 1; const float* q = ssq + (size_t)(pm * BM + row) * 32 + 16 * hf;
    const f32x4 a = *(const f32x4*)q, b = *(const f32x4*)(q + 4), c = *(const f32x4*)(q + 8), d = *(const f32x4*)(q + 12);
    float s = (((a[0] + a[1]) + (a[2] + a[3])) + ((b[0] + b[1]) + (b[2] + b[3]))) + (((c[0] + c[1]) + (c[2] + c[3])) + ((d[0] + d[1]) + (d[2] + d[3])));
    s += __shfl_xor(s, 1);
    if (hf == 0) tab[row] = rsqrtf(s * (1.f / 2048.f) + eps);
    __syncthreads();
}
struct EpiResidN {
    static constexpr bool PERM = true, AFTER_DRAIN = false;
    bf16_t* xb; float* fin; float* ssq; int ldc;
    __device__ __forceinline__ void operator()(const f32x4 (&acc)[2][2][4][2], const Unit& u, int wr, int wc, int fr, int fq) const {
        const int row0 = u.pm * BM + wr * 64 + fr, col0 = u.pn * BM + wc * 32 + 8 * fq;
#pragma unroll
        for (int ai = 0; ai < 2; ++ai)
#pragma unroll
            for (int m = 0; m < 4; ++m) { const int r = row0 + ai * HALF + m * 16; const size_t off = (size_t)r * ldc + col0; float sq = 0.f;
#pragma unroll
                for (int bj = 0; bj < 2; ++bj) { const u32x4 xw = *(const u32x4*)(xb + off + bj * HALF);
                    f32x4 v0 = acc[ai][bj][m][0], v1 = acc[ai][bj][m][1];
                    v0[0] += __builtin_bit_cast(float, xw.x << 16); v0[1] += __builtin_bit_cast(float, xw.x & 0xffff0000u); v0[2] += __builtin_bit_cast(float, xw.y << 16); v0[3] += __builtin_bit_cast(float, xw.y & 0xffff0000u);
                    v1[0] += __builtin_bit_cast(float, xw.z << 16); v1[1] += __builtin_bit_cast(float, xw.z & 0xffff0000u); v1[2] += __builtin_bit_cast(float, xw.w << 16); v1[3] += __builtin_bit_cast(float, xw.w & 0xffff0000u);
                    if (fin) { *(f32x4*)(fin + off + bj * HALF) = v0; *(f32x4*)(fin + off + bj * HALF + 4) = v1; }
                    else { u32x4 w; w.x = cvt_pk_bf16(v0[0], v0[1]); w.y = cvt_pk_bf16(v0[2], v0[3]); w.z = cvt_pk_bf16(v1[0], v1[1]); w.w = cvt_pk_bf16(v1[2], v1[3]); *(u32x4*)(xb + off + bj * HALF) = w; }
                    sq += ((v0[0] * v0[0] + v0[1] * v0[1]) + (v0[2] * v0[2] + v0[3] * v0[3])) + ((v1[0] * v1[0] + v1[1] * v1[1]) + (v1[2] * v1[2] + v1[3] * v1[3])); }
                if (ssq) { sq += __shfl_xor(sq, 16); sq += __shfl_xor(sq, 32); if (fq == 0) ssq[(size_t)r * 32 + u.pn * 4 + wc] = sq; }
                if (m == 3) asm volatile("" ::: "memory"); }
    }
};
template <int CTRL> __device__ __forceinline__ float dppf(float oldv, float src) {
    return __builtin_bit_cast(float, __builtin_amdgcn_update_dpp(__builtin_bit_cast(int, oldv), __builtin_bit_cast(int, src), CTRL, 0xf, 0xf, false)); }
template <int CTRL> __device__ __forceinline__ float dppr(float src) {
    return __builtin_bit_cast(float, __builtin_amdgcn_mov_dpp(__builtin_bit_cast(int, src), CTRL, 0xf, 0xf, false)); }
struct EpiConv {
    static constexpr bool PERM = true, AFTER_DRAIN = false;
    static constexpr size_t WS_Z_ = ::WS_Z, WS_SSQ_ = ::WS_SSQ, WS_HALO_ = ::WS_HALO; static constexpr int CW_HCNT_ = ::CW_HCNT, CW_TMO_ = ::CW_TMO;
    unsigned char* wsb; const float* cw; const float* cb; PG8_LAS unsigned char* ldsx; unsigned target; int rs_pm;
    __device__ __forceinline__ void operator()(f32x4 (&acc)[2][2][4][2], const Unit& u, int wr, int wc, int fr_in, int fq_in) const {
        int fr = fr_in, fq = fq_in; asm volatile("" : "+v"(fr), "+v"(fq));
        bf16_t* Z = (bf16_t*)(wsb + WS_Z_); const float* ssq = (const float*)(wsb + WS_SSQ_); const float* halo = (const float*)(wsb + WS_HALO_); const float eps = 1e-6f;
        unsigned* hcnt = (unsigned*)wsb + CW_HCNT_; unsigned* tmo = (unsigned*)wsb + CW_TMO_;
        const PG8_LAS float* rs_tab = (const PG8_LAS float*)ldsx; PG8_LAS f32x4* xch = (PG8_LAS f32x4*)(ldsx + 1024); volatile PG8_LAS unsigned* ready = (volatile PG8_LAS unsigned*)(ldsx + 1024 + 8192);
        const int row0 = u.pm * BM + wr * 64 + fr;
        const bool cached = (u.pm == rs_pm);
#pragma unroll
        for (int ai = 0; ai < 2; ++ai)
#pragma unroll
            for (int m = 0; m < 4; ++m) { const int r = row0 + ai * HALF + m * 16; float rs;
                if (cached) rs = rs_tab[wr * 64 + fr + ai * HALF + m * 16];
                else { const f32x4 p0 = *(const f32x4*)(ssq + (size_t)r * 32 + 8 * fq), p1 = *(const f32x4*)(ssq + (size_t)r * 32 + 8 * fq + 4);
                    float s = ((p0[0] + p0[1]) + (p0[2] + p0[3])) + ((p1[0] + p1[1]) + (p1[2] + p1[3]));
                    s += __shfl_xor(s, 16); s += __shfl_xor(s, 32); rs = rsqrtf(s * (1.f / 2048.f) + eps); }
#pragma unroll
                for (int bj = 0; bj < 2; ++bj) { acc[ai][bj][m][0] *= rs; acc[ai][bj][m][1] *= rs; } }
        f32x4 hal[2][2];
#pragma unroll
        for (int bj = 0; bj < 2; ++bj) { hal[bj][0] = (f32x4){0.f, 0.f, 0.f, 0.f}; hal[bj][1] = (f32x4){0.f, 0.f, 0.f, 0.f}; }
        if (wr == 0 && (u.pm & 7) != 0) {
            if (ready[0] == 0u) { unsigned spins = 0;
                while (__hip_atomic_load(hcnt, __ATOMIC_RELAXED, __HIP_MEMORY_SCOPE_AGENT) < target) { __builtin_amdgcn_s_sleep(2);
                    if (++spins > (1u << 20)) { __hip_atomic_store(tmo, 1u, __ATOMIC_RELAXED, __HIP_MEMORY_SCOPE_AGENT); break; } }
                ready[0] = 1u; }
            if (fr >= 14) { const unsigned long long* hp = (const unsigned long long*)(halo + (size_t)(2 * (u.pm - 1) + (fr - 14)) * 11264 + u.pn * 256 + wc * 32 + 8 * fq);
#pragma unroll
                for (int bj = 0; bj < 2; ++bj)
#pragma unroll
                    for (int n = 0; n < 2; ++n) { const unsigned long long lo = __hip_atomic_load(hp + bj * 64 + 2 * n, __ATOMIC_RELAXED, __HIP_MEMORY_SCOPE_AGENT), hi = __hip_atomic_load(hp + bj * 64 + 2 * n + 1, __ATOMIC_RELAXED, __HIP_MEMORY_SCOPE_AGENT);
                        hal[bj][n] = (f32x4){__builtin_bit_cast(float, (unsigned)lo), __builtin_bit_cast(float, (unsigned)(lo >> 32)), __builtin_bit_cast(float, (unsigned)hi), __builtin_bit_cast(float, (unsigned)(hi >> 32))}; } } }
        if (fr >= 14) {
#pragma unroll
            for (int ai = 0; ai < 2; ++ai)
#pragma unroll
                for (int bj = 0; bj < 2; ++bj)
#pragma unroll
                    for (int n = 0; n < 2; ++n) xch[(((((ai * 2 + wr) * 4 + wc) * 2 + (fr & 1)) * 4 + fq) * 4) + bj * 2 + n] = acc[ai][bj][3][n]; }
        asm volatile("s_waitcnt lgkmcnt(0)" ::: "memory"); __builtin_amdgcn_s_barrier(); asm volatile("" ::: "memory");
        const int jn0 = u.pn * 128 + wc * 32 + 8 * fq;
        u32x2 zk[2][4];
#pragma unroll
        for (int n = 0; n < 2; ++n) {
            const float* wp = cw + jn0 + 4 * n; const float* bp = cb + jn0 + 4 * n;
            const f32x4 wa0 = *(const f32x4*)wp, wa1 = *(const f32x4*)(wp + 11264), wa2 = *(const f32x4*)(wp + 2 * 11264), ba = *(const f32x4*)bp;
            const f32x4 wb0 = *(const f32x4*)(wp + 5632), wb1 = *(const f32x4*)(wp + 11264 + 5632), wb2 = *(const f32x4*)(wp + 2 * 11264 + 5632), bb = *(const f32x4*)(bp + 5632);
#pragma unroll
            for (int ai = 0; ai < 2; ++ai) {
                f32x4 pa, pb;
                if (ai == 0 && wr == 0) { pa = hal[0][n]; pb = hal[1][n]; }
                else { const int sai = wr ? ai : ai - 1, swr = wr ^ 1; const int xi = (((((sai * 2 + swr) * 4 + wc) * 2 + (fr & 1)) * 4 + fq) * 4) + n; pa = xch[xi]; pb = xch[xi + 2]; }
#pragma unroll
                for (int m = 0; m < 4; ++m) {
                    const f32x4 ca4 = acc[ai][0][m][n], cb4 = acc[ai][1][m][n]; float z[4];
#pragma unroll
                    for (int i = 0; i < 4; ++i) {
                        const float a1 = dppf<0x111>(dppr<0x121>(pa[i]), ca4[i]), a2 = dppf<0x112>(dppr<0x122>(pa[i]), ca4[i]);
                        const float b1 = dppf<0x111>(dppr<0x121>(pb[i]), cb4[i]), b2 = dppf<0x112>(dppr<0x122>(pb[i]), cb4[i]);
                        const float ca = ba[i] + wa0[i] * a2 + wa1[i] * a1 + wa2[i] * ca4[i];
                        const float cbv = bb[i] + wb0[i] * b2 + wb1[i] * b1 + wb2[i] * cb4[i];
                        z[i] = ca * __builtin_amdgcn_rcpf(1.f + __builtin_amdgcn_exp2f(ca * -1.4426950408889634f)) * cbv; }
                    u32x2 w; w.x = cvt_pk_bf16(z[0], z[1]); w.y = cvt_pk_bf16(z[2], z[3]);
                    if (n == 0) zk[ai][m] = w;
                    else { u32x4 w4; w4.x = zk[ai][m].x; w4.y = zk[ai][m].y; w4.z = w.x; w4.w = w.y; *(u32x4*)(Z + (size_t)(row0 + ai * HALF + m * 16) * 5632 + jn0) = w4; }
                    pa = ca4; pb = cb4; }
            }
        }
    }
};
template <class Epi, class Sched, bool ALIGN_EPI = false, bool SP2 = false>
__device__ __forceinline__ void gemm_phase(PG8_LAS unsigned char* lds, const Gemm g, const Sched& S, const Epi& E) {
    int tid = threadIdx.x; asm volatile("" : "+v"(tid));
    const int wid = __builtin_amdgcn_readfirstlane(tid >> 6), lane = tid & 63, wr = wid >> 2, wc = wid & 3, fr = lane & 15, fq = lane >> 4;
    const int K = g.K, nt = K / BK;
    unsigned voffA[2], voffB[2];
#pragma unroll
    for (int i = 0; i < 2; ++i) { int R, C; stage_rc(tid * 16 + i * 8192, R, C); const int Rb = Epi::PERM ? ((R & ~31) + perm32(R & 31)) : R;
        voffA[i] = (unsigned)(R * K + C) * 2u; voffB[i] = (unsigned)(Rb * K + C) * 2u; }
    const size_t kstep = (size_t)(BK * 2);
    const size_t hstep = (size_t)HALF * K * 2;
    const size_t tstep = 2 * hstep;
    const unsigned ldsw = (unsigned)wid * 1024u;
    const int aoff = lds_byte(wr * 64 + fr, fq * 8), boff = lds_byte(wc * 32 + fr, fq * 8);
#define PG8_SA(b, h) (((b) * 2 + (h)) * HTB)
#define PG8_SB(b, h) ((4 + (b) * 2 + (h)) * HTB)
#define PG8_STAGE(bufoff, gbase, voff) do { _Pragma("unroll") for (int _i = 0; _i < 2; ++_i) \
        __builtin_amdgcn_global_load_lds((const unsigned*)((const char*)(gbase) + (voff)[_i]), (PG8_LAS unsigned*)(lds + (bufoff) + ldsw + _i * 8192), 16, 0, 0); } while (0)
#define PG8_LDA(dst, b, h) do { _Pragma("unroll") for (int m = 0; m < 4; ++m) _Pragma("unroll") for (int k = 0; k < 2; ++k) dst[m][k] = *(const PG8_LAS bf16x8*)(lds + PG8_SA(b, h) + aoff + m * 2048 + k * 1024); } while (0)
#define PG8_LDB(dst, b, h) do { _Pragma("unroll") for (int n = 0; n < 2; ++n) _Pragma("unroll") for (int k = 0; k < 2; ++k) dst[n][k] = *(const PG8_LAS bf16x8*)(lds + PG8_SB(b, h) + boff + n * 2048 + k * 1024); } while (0)
#define PG8_MMA(ai, bj, At, Bt) do { __builtin_amdgcn_s_setprio(1); _Pragma("unroll") for (int m = 0; m < 4; ++m) _Pragma("unroll") for (int n = 0; n < 2; ++n) _Pragma("unroll") for (int k = 0; k < 2; ++k) \
        acc[ai][bj][m][n] = __builtin_amdgcn_mfma_f32_16x16x32_bf16(Bt[n][k], At[m][k], acc[ai][bj][m][n], 0, 0, 0); __builtin_amdgcn_s_setprio(0); } while (0)
#define PG8_WAIT_V(n) asm volatile("s_waitcnt vmcnt(" #n ")" ::: "memory")
#define PG8_WAIT_L(n) asm volatile("s_waitcnt lgkmcnt(" #n ")" ::: "memory")
#define PG8_BAR __builtin_amdgcn_s_barrier()
#define PG8_SCHED __builtin_amdgcn_sched_barrier(0)
    Unit cur, nxt; int ui = 0;
    if (!S.next(0, cur)) return;
    f32x4 acc[2][2][4][2];
#pragma unroll
    for (int a = 0; a < 2; ++a)
#pragma unroll
        for (int b = 0; b < 2; ++b)
#pragma unroll
            for (int m = 0; m < 4; ++m)
#pragma unroll
                for (int n = 0; n < 2; ++n) acc[a][b][m][n] = (f32x4){0.f, 0.f, 0.f, 0.f};
    bf16x8 At[4][2], B0[2][2], B1[2][2];
    const char* cA = (const char*)g.A + (size_t)cur.pm * tstep; const char* cB = (const char*)g.Bt + (size_t)cur.pn * tstep;
    S.a_ready(cur);
    if constexpr (SP2) {
        PG8_STAGE(PG8_SB(0, 0), cB, voffB); PG8_STAGE(PG8_SB(0, 1), cB + hstep, voffB); PG8_STAGE(PG8_SA(0, 0), cA, voffA); PG8_STAGE(PG8_SA(0, 1), cA + hstep, voffA);
        if (wr == 1) PG8_BAR;
        PG8_WAIT_V(2); PG8_BAR;
        PG8_STAGE(PG8_SB(1, 0), cB + kstep, voffB); PG8_STAGE(PG8_SA(1, 0), cA + kstep, voffA); PG8_STAGE(PG8_SB(1, 1), cB + hstep + kstep, voffB);
        PG8_WAIT_V(6); PG8_BAR;
    } else {
        PG8_STAGE(PG8_SB(0, 0), cB, voffB); PG8_STAGE(PG8_SA(0, 0), cA, voffA); PG8_STAGE(PG8_SB(0, 1), cB + hstep, voffB); PG8_STAGE(PG8_SA(0, 1), cA + hstep, voffA);
        if (wr == 1) PG8_BAR;
        PG8_WAIT_V(4); PG8_BAR;
        PG8_STAGE(PG8_SB(1, 0), cB + kstep, voffB); PG8_STAGE(PG8_SA(1, 0), cA + kstep, voffA); PG8_STAGE(PG8_SB(1, 1), cB + hstep + kstep, voffB);
        PG8_WAIT_V(6); PG8_BAR;
    }
    for (;;) {
        const bool has_next = S.next(ui + 1, nxt);
        const char* nA = has_next ? (const char*)g.A + (size_t)nxt.pm * tstep : cA; const char* nB = has_next ? (const char*)g.Bt + (size_t)nxt.pn * tstep : cB;
        for (int t = 0; t < nt; t += 2) {
            const bool last = (t == nt - 2);
            const char* a1 = cA + (size_t)(t + 1) * kstep;
            const char* a2 = last ? nA : cA + (size_t)(t + 2) * kstep; const char* b2 = last ? nB : cB + (size_t)(t + 2) * kstep;
            const char* a3 = a2 + kstep; const char* b3 = b2 + kstep;
            if (last && has_next) S.a_ready(nxt);
            if constexpr (SP2) {
            PG8_LDB(B0, 0, 0); PG8_LDB(B1, 0, 1); PG8_SCHED; PG8_LDA(At, 0, 0); PG8_STAGE(PG8_SA(1, 1), a1 + hstep, voffA);
            PG8_WAIT_V(8); PG8_WAIT_L(0); PG8_BAR; PG8_MMA(0, 0, At, B0); PG8_MMA(0, 1, At, B1); PG8_BAR; PG8_SCHED;
            PG8_LDA(At, 0, 1); PG8_STAGE(PG8_SB(0, 0), b2, voffB); PG8_STAGE(PG8_SB(0, 1), b2 + hstep, voffB); PG8_STAGE(PG8_SA(0, 0), a2, voffA);
            PG8_WAIT_V(8); PG8_WAIT_L(0); PG8_BAR; PG8_MMA(1, 0, At, B0); PG8_MMA(1, 1, At, B1); PG8_BAR; PG8_SCHED;
            PG8_LDB(B0, 1, 0); PG8_LDB(B1, 1, 1); PG8_SCHED; PG8_LDA(At, 1, 0); PG8_STAGE(PG8_SA(0, 1), a2 + hstep, voffA);
            PG8_WAIT_V(8); PG8_WAIT_L(0); PG8_BAR; PG8_MMA(0, 0, At, B0); PG8_MMA(0, 1, At, B1); PG8_BAR; PG8_SCHED;
            PG8_LDA(At, 1, 1); PG8_STAGE(PG8_SB(1, 0), b3, voffB); PG8_STAGE(PG8_SB(1, 1), b3 + hstep, voffB); PG8_STAGE(PG8_SA(1, 0), a3, voffA);
            PG8_WAIT_V(8); PG8_WAIT_L(0); PG8_BAR; PG8_MMA(1, 0, At, B0); PG8_MMA(1, 1, At, B1); PG8_BAR; PG8_SCHED;
            } else {
            PG8_LDB(B0, 0, 0); PG8_SCHED; PG8_LDA(At, 0, 0); PG8_STAGE(PG8_SA(1, 1), a1 + hstep, voffA);
            PG8_WAIT_L(8); PG8_BAR; PG8_WAIT_L(0); PG8_MMA(0, 0, At, B0); PG8_BAR; PG8_SCHED;
            PG8_LDB(B1, 0, 1); PG8_STAGE(PG8_SB(0, 0), b2, voffB);
            PG8_BAR; PG8_WAIT_L(0); PG8_MMA(0, 1, At, B1); PG8_BAR;
            PG8_LDA(At, 0, 1); PG8_STAGE(PG8_SA(0, 0), a2, voffA);
            PG8_BAR; PG8_WAIT_L(0); PG8_MMA(1, 0, At, B0); PG8_BAR; PG8_SCHED;
            PG8_STAGE(PG8_SB(0, 1), b2 + hstep, voffB);
            PG8_WAIT_V(6); PG8_BAR; PG8_MMA(1, 1, At, B1); PG8_BAR;
            PG8_LDB(B0, 1, 0); PG8_SCHED; PG8_LDA(At, 1, 0); PG8_STAGE(PG8_SA(0, 1), a2 + hstep, voffA);
            PG8_WAIT_L(8); PG8_BAR; PG8_WAIT_L(0); PG8_MMA(0, 0, At, B0); PG8_BAR; PG8_SCHED;
            PG8_LDB(B1, 1, 1); PG8_STAGE(PG8_SB(1, 0), b3, voffB);
            PG8_BAR; PG8_WAIT_L(0); PG8_MMA(0, 1, At, B1); PG8_BAR;
            PG8_LDA(At, 1, 1); PG8_STAGE(PG8_SA(1, 0), a3, voffA);
            PG8_BAR; PG8_WAIT_L(0); PG8_MMA(1, 0, At, B0); PG8_BAR; PG8_SCHED;
            PG8_STAGE(PG8_SB(1, 1), b3 + hstep, voffB);
            PG8_WAIT_V(6); PG8_BAR; PG8_MMA(1, 1, At, B1); PG8_BAR;
            }
        }
        if constexpr (ALIGN_EPI) { if (wr == 0) PG8_BAR; }
        if constexpr (!Epi::AFTER_DRAIN) { E(acc, cur, wr, wc, fr, fq); S.done(cur); }
        if (!has_next) break;
#pragma unroll
        for (int a = 0; a < 2; ++a)
#pragma unroll
            for (int b = 0; b < 2; ++b)
#pragma unroll
                for (int m = 0; m < 4; ++m)
#pragma unroll
                    for (int n = 0; n < 2; ++n) acc[a][b][m][n] = (f32x4){0.f, 0.f, 0.f, 0.f};
        cur = nxt; cA = nA; cB = nB; ++ui;
        if constexpr (ALIGN_EPI) { if (wr == 1) PG8_BAR; }
    }
    PG8_WAIT_V(0);
    if constexpr (!ALIGN_EPI) { if (wr == 0) PG8_BAR; }
    PG8_BAR;
    if constexpr (Epi::AFTER_DRAIN) { E.fused(acc, cur, wr, wc, fr, fq, lds, wid, lane); S.done(cur); }
#undef PG8_SA
#undef PG8_SB
#undef PG8_STAGE
#undef PG8_LDA
#undef PG8_LDB
#undef PG8_MMA
#undef PG8_WAIT_V
#undef PG8_WAIT_L
#undef PG8_BAR
#undef PG8_SCHED
}
}
#define XB_TMO      128
#define XB_XCNT(j)  (256  + 64 * (j))
#define XB_XSUB(j)  (1280 + 64 * (j))
#define XB_XGEN(j)  (2304 + 64 * (j))
#define XB_TOP      3328
#define XB_TOPGEN   3392
#define XCD_BAR_WORDS 3456
#define XB_SPIN_CAP (1u << 18)

__device__ __forceinline__ unsigned xb_ld(unsigned* p)              { return __hip_atomic_load(p, __ATOMIC_RELAXED, __HIP_MEMORY_SCOPE_AGENT); }
__device__ __forceinline__ unsigned xb_add(unsigned* p, unsigned v) { return __hip_atomic_fetch_add(p, v, __ATOMIC_RELAXED, __HIP_MEMORY_SCOPE_AGENT); }
__device__ __forceinline__ unsigned xb_xcc_id() { return (unsigned)__builtin_amdgcn_s_getreg((3 << 11) | 20) & 0xFu; }
#define XB_SPIN(cond, bar) do { unsigned _sp = 0; while (cond) { __builtin_amdgcn_s_sleep(1); \
    if ((++_sp & 255u) == 0u) { if (xb_ld(&(bar)[XB_TMO])) break; if (_sp > XB_SPIN_CAP) { atomicAdd(&(bar)[XB_TMO], 1u); break; } } } } while (0)

struct XcdBarrier {
    unsigned* bar; unsigned x;
    volatile LAS unsigned* st;
};

__device__ __forceinline__ XcdBarrier xcd_barrier_post(unsigned* bar, volatile LAS unsigned* st) {
    XcdBarrier b; b.bar = bar; b.x = xb_xcc_id(); b.st = st;
    if (threadIdx.x == 0) (void)xb_add(&bar[XB_XCNT(b.x)], 1u);
    return b;
}
__device__ __forceinline__ void xcd_barrier_complete(unsigned* bar, unsigned x, unsigned& nloc, unsigned& nx) {
    const unsigned G = gridDim.x * gridDim.y * gridDim.z;
    unsigned sum, cnt, mine, sp = 0u;
    for (;;) {
        sum = 0u; cnt = 0u; mine = 0u;
#pragma unroll
        for (unsigned j = 0; j < 16; ++j) { const unsigned c = xb_ld(&bar[XB_XCNT(j)]); sum += c; cnt += (c > 0u) ? 1u : 0u; mine = (j == x) ? c : mine; }
        if (sum == G) break;
        __builtin_amdgcn_s_sleep(1);
        if ((++sp & 255u) == 0u) { if (xb_ld(&bar[XB_TMO])) break; if (sp > XB_SPIN_CAP) { atomicAdd(&bar[XB_TMO], 1u); break; } }
    }
    nloc = mine > 0u ? mine : 1u; nx = cnt > 0u ? cnt : 1u;
}

__device__ __forceinline__ void xcd_barrier(const XcdBarrier& b) {
    asm volatile("s_waitcnt vmcnt(0)" ::: "memory");
    __syncthreads();
    if (threadIdx.x == 0) {
        unsigned* bar = b.bar;
        __builtin_amdgcn_s_waitcnt(0);
        unsigned nloc = b.st[0], nx = b.st[1];
        if (nloc == 0u) { xcd_barrier_complete(bar, b.x, nloc, nx); b.st[0] = nloc; b.st[1] = nx; }
        const unsigned old = xb_add(&bar[XB_XSUB(b.x)], 1u);
        const unsigned gen = old / nloc;
        if (old + 1u == (gen + 1u) * nloc) {
            __builtin_amdgcn_fence(__ATOMIC_RELEASE, "agent");
            asm volatile("s_waitcnt vmcnt(0)" ::: "memory");
            const unsigned og = xb_add(&bar[XB_TOP], 1u);
            const unsigned tg = og / nx;
            if (og + 1u == (tg + 1u) * nx) xb_add(&bar[XB_TOPGEN], 1u);
            else XB_SPIN(xb_ld(&bar[XB_TOPGEN]) == tg, bar);
            __builtin_amdgcn_fence(__ATOMIC_ACQUIRE, "agent");
            xb_add(&bar[XB_XGEN(b.x)], 1u);
            asm volatile("s_waitcnt vmcnt(0)" ::: "memory");
        } else {
            XB_SPIN(xb_ld(&bar[XB_XGEN(b.x)]) == gen, bar);
            __builtin_amdgcn_fence(__ATOMIC_ACQUIRE, "agent");
            asm volatile("s_waitcnt vmcnt(0)" ::: "memory");
        }
    }
    __syncthreads();
}

struct Params { const float* in[23]; float* out; unsigned char* ws; };

__device__ __forceinline__ void p0_transpose_item(const float* W, int ldw, int K, int N, bf16_t* WT, int item, int lane, float scale, const float* gk, bool pair_perm = false) {
    const int nblk = N / 64, kb = item / nblk, nb = item % nblk, i16 = lane & 15, q4 = lane >> 4;
    const int n0 = 64 * nb + 4 * i16;
    const int ns0 = (pair_perm ? ((nb >> 1) & 1) * DFF + 128 * (nb >> 2) + 64 * (nb & 1) : 64 * nb) + 4 * i16;
#pragma unroll
    for (int pass = 0; pass < 2; ++pass) {
        const int kk0 = 64 * kb + 32 * pass + 8 * q4;
        const float* src = W + (size_t)kk0 * ldw + ns0;
        f32x4 v[8];
#pragma unroll
        for (int i = 0; i < 8; ++i) v[i] = *(const f32x4*)(src + (size_t)i * ldw);
        f32x4 g0 = {scale, scale, scale, scale}, g1 = g0;
        if (gk) { g0 = *(const f32x4*)(gk + kk0) * scale; g1 = *(const f32x4*)(gk + kk0 + 4) * scale; }
#pragma unroll
        for (int j = 0; j < 4; ++j) { u32x4 o;
            o.x = pk2(v[0][j] * g0[0], v[1][j] * g0[1]); o.y = pk2(v[2][j] * g0[2], v[3][j] * g0[3]); o.z = pk2(v[4][j] * g1[0], v[5][j] * g1[1]); o.w = pk2(v[6][j] * g1[2], v[7][j] * g1[3]);
            *(u32x4*)(WT + (size_t)(n0 + j) * K + kk0) = o; }
    }
}

__device__ __forceinline__ void phase_prologue(const Params& P, LAS unsigned char* lds, int gw, int NGW, int wave, int lane) {
    constexpr int I_QKV = (DM / 64) * (NQKV / 64), I_WO = (DO / 64) * (DM / 64), I_WIN = (DM / 64) * (NIN / 64), I_WOUT = (DM / 64) * (DM / 64), I_WUP = (DM / 64) * (NUP / 64), I_WDN = (DFF / 64) * (DM / 64);
    constexpr int T0 = 2 * I_QKV, T1 = T0 + 2 * I_WO, T2 = T1 + 2 * I_WIN, T3 = T2 + 2 * I_WOUT, T4 = T3 + 4 * I_WUP, T5 = T4 + 4 * I_WDN;
    unsigned char* ws = P.ws;
    for (int it = gw; it < T5; it += NGW) {
        if (it < T0) { const int l = it / I_QKV, r = it % I_QKV; p0_transpose_item(P.in[11] + (size_t)l * DM * NQKV, NQKV, DM, NQKV, (bf16_t*)(ws + WS_WQKV + l * SZ_WQKV), r, lane, 1.f, P.in[9] + (size_t)(2 * l) * DM); }
        else if (it < T1) { const int q = it - T0, l = q / I_WO, r = q % I_WO; p0_transpose_item(P.in[14] + (size_t)l * DO * DM, DM, DO, DM, (bf16_t*)(ws + WS_WO + l * SZ_WO), r, lane, 1.f, nullptr); }
        else if (it < T2) { const int q = it - T1, l = q / I_WIN, r = q % I_WIN; const int nb = r % (NIN / 64);
            const float sc = (nb >= 16 && nb < 32) ? 0.08838834764831845f : 1.f;
            p0_transpose_item(P.in[15] + (size_t)l * DM * NIN_SRC, NIN_SRC, DM, NIN, (bf16_t*)(ws + WS_WIN + l * SZ_WIN), r, lane, sc, P.in[9] + (size_t)(2 * l + 1) * DM); }
        else if (it < T3) { const int q = it - T2, l = q / I_WOUT, r = q % I_WOUT; p0_transpose_item(P.in[18] + (size_t)l * DM * DM, DM, DM, DM, (bf16_t*)(ws + WS_WOUT + l * SZ_WOUT), r, lane, 1.f, nullptr); }
        else if (it < T4) { const int q = it - T3, l = q / I_WUP, r = q % I_WUP; p0_transpose_item(P.in[19] + (size_t)l * DM * NUP, NUP, DM, NUP, (bf16_t*)(ws + WS_WUP + l * SZ_WUP), r, lane, 1.f, P.in[10] + (size_t)l * DM, true); }
        else { const int q = it - T4, l = q / I_WDN, r = q % I_WDN; p0_transpose_item(P.in[22] + (size_t)l * DFF * DM, DM, DFF, DM, (bf16_t*)(ws + WS_WDOWN + l * SZ_WDOWN), r, lane, 1.f, nullptr); }
    }
    { const int gt = gw * 64 + lane, NT = NGW * 64;
      float* rope = (float*)(ws + WS_ROPE);
      for (int i = gt; i < 2052 * 64; i += NT) { const int pi = i >> 6, f = i & 63; const int pos = (pi < SEQ) ? pi : PAST + (pi - SEQ);
          const float invf = powf(10000.f, -(float)f * (1.f / 64.f)); const float ang = (float)pos * invf; float sn, cs; sincosf(ang, &sn, &cs); rope[2 * i] = cs; rope[2 * i + 1] = sn; }
      for (int i = gt; i < 3 * 64; i += NT) { const int g = i >> 6, f = i & 63; const float invf = powf(10000.f, -(float)f * (1.f / 64.f)); const float ang = (float)(32 << (2 * g)) * invf; float sn, cs; sincosf(ang, &sn, &cs);
          rope[(2052 * 64 + i) * 2] = cs; rope[(2052 * 64 + i) * 2 + 1] = sn; }
      f32x4* wgp = (f32x4*)(ws + WS_WGP);
      for (int i = gt; i < 2 * 128 * 64; i += NT) { const int l = i >> 13, kb = (i >> 6) & 127, ln = i & 63, col = ln & 15, kq = ln >> 4, k = 16 * kb + 4 * kq;
          const float* w = P.in[15] + (size_t)l * DM * NIN_SRC + (size_t)k * NIN_SRC + NIN + col; const float* g = P.in[9] + (size_t)(2 * l + 1) * DM + k;
          wgp[i] = (f32x4){g[0] * w[0], g[1] * w[NIN_SRC], g[2] * w[2 * NIN_SRC], g[3] * w[3 * NIN_SRC]}; } }
    for (int r = gw; r < MR; r += NGW) {
        const f32x4* xr = (const f32x4*)((r < MP) ? P.in[0] + (size_t)r * DM : P.in[1] + (size_t)(r - MP) * DM) + lane;
        u32x2* xb = (u32x2*)(ws + WS_XB) + (size_t)r * (DM / 4) + lane;
        float s = 0.f;
#pragma unroll
        for (int j = 0; j < 8; ++j) { const f32x4 v = xr[64 * j]; u32x2 w; w.x = pk2(v.x, v.y); w.y = pk2(v.z, v.w); xb[64 * j] = w; s += (v.x * v.x + v.y * v.y) + (v.z * v.z + v.w * v.w); }
        s = wave_sum(s);
        if (r < MP) { if (lane < 32) ((float*)(ws + WS_SSQ))[(size_t)r * 32 + lane] = (lane == 0) ? s : 0.f; }
        else { float* q = (float*)(ws + WS_SSQS) + (size_t)(r - MP) * 128; q[lane] = (lane == 0) ? s : 0.f; q[64 + lane] = 0.f; }
    }
}

__device__ __forceinline__ void gate_block(LAS unsigned char* lds, const bf16_t* X, const f32x4* WGP, const float* bg, float* GATES, int task, int wave, int lane) {
    const int r0 = task * 16, i16 = lane & 15, kq = lane >> 4;
    const bf16_t* xr = X + (size_t)(r0 + i16) * DM + 256 * wave + 4 * kq;
    const f32x4* wp = WGP + (size_t)(16 * wave) * 64 + lane;
    f32x4 acc = {0.f, 0.f, 0.f, 0.f}; float ss = 0.f;
#pragma unroll
    for (int j = 0; j < 16; ++j) {
        const u32x2 xw = *(const u32x2*)(xr + 16 * j); const f32x4 xv = {bflo(xw.x), bfhi(xw.x), bflo(xw.y), bfhi(xw.y)}, wv = wp[64 * j];
        ss += (xv.x * xv.x + xv.y * xv.y) + (xv.z * xv.z + xv.w * xv.w);
        acc = __builtin_amdgcn_mfma_f32_16x16x4f32(xv.x, wv.x, acc, 0, 0, 0);
        acc = __builtin_amdgcn_mfma_f32_16x16x4f32(xv.y, wv.y, acc, 0, 0, 0);
        acc = __builtin_amdgcn_mfma_f32_16x16x4f32(xv.z, wv.z, acc, 0, 0, 0);
        acc = __builtin_amdgcn_mfma_f32_16x16x4f32(xv.w, wv.w, acc, 0, 0, 0);
    }
    LAS f32x4* gp = (LAS f32x4*)lds; LAS float* sp = (LAS float*)(lds + 8192);
    __syncthreads();
    gp[wave * 64 + lane] = acc; sp[wave * 64 + lane] = ss;
    __syncthreads();
    if (wave == 0) {
        f32x4 a = gp[lane]; float s = sp[lane];
#pragma unroll
        for (int w = 1; w < 8; ++w) { a += gp[w * 64 + lane]; s += sp[w * 64 + lane]; }
        s += __shfl_xor(s, 16); s += __shfl_xor(s, 32);
        const float rstd = rsqrtf(s * (1.f / DM) + EPS);
        const float bias = bg[i16];
#pragma unroll
        for (int i = 0; i < 4; ++i) {
            const float rs = __shfl(rstd, 4 * kq + i);
            const float pre = a[i] * rs + bias;
            const float gc = 15.f * tanhf(pre * (1.f / 15.f));
            const float val = (i16 < 8) ? gc : (fminf(gc, 0.f) - log1pf(fexp(-fabsf(gc))));
            GATES[(size_t)(r0 + 4 * kq + i) * 16 + i16] = val;
        }
    }
}

constexpr int SK_PART = 0, SK_RSTD = 16384;
template <int MODE>
__device__ __forceinline__ void skinny_phase(LAS unsigned char* lds, const bf16_t* A, int K, const bf16_t* Bt, int N, bf16_t* Ob, int ldo, bf16_t* XBs, float* SSQS, float* Os, int c, int G, int nIdle, int tid, int wave, int lane) {
    const int i16 = lane & 15, q4 = lane >> 4;
    if (c < G - nIdle) return;
    LAS f32x4* part = (LAS f32x4*)(lds + SK_PART); LAS float* rstdS = (LAS float*)(lds + SK_RSTD);
    __syncthreads();
    if (MODE == 0) { const int row = tid >> 4, sub = tid & 15; const float* q = SSQS + row * 128 + 8 * sub;
        const f32x4 a = *(const f32x4*)q, b = *(const f32x4*)(q + 4); float s = ((a[0] + a[1]) + (a[2] + a[3])) + ((b[0] + b[1]) + (b[2] + b[3]));
        s = row16_sum(s);
        if (sub == 0) rstdS[row] = rsqrtf(s * (1.f / 2048.f) + EPS);
        __syncthreads(); }
    const int kper = K >> 3, nks = kper >> 5, k0 = wave * kper;
    for (int j = G - 1 - c; j < (N >> 4); j += nIdle) {
        f32x4 acc0 = {0.f, 0.f, 0.f, 0.f}, acc1 = {0.f, 0.f, 0.f, 0.f};
        const bf16_t* bp = Bt + (size_t)(16 * j + i16) * K + k0 + 8 * q4; const bf16_t* ap = A + (size_t)i16 * K + k0 + 8 * q4;
#pragma unroll 8
        for (int ks = 0; ks < nks; ++ks) { const bf16x8 bf = *(const bf16x8*)(bp + 32 * ks), a0 = *(const bf16x8*)(ap + 32 * ks), a1 = *(const bf16x8*)(ap + (size_t)16 * K + 32 * ks);
            acc0 = mma16(a0, bf, acc0); acc1 = mma16(a1, bf, acc1); }
        part[(wave * 2 + 0) * 64 + lane] = acc0; part[(wave * 2 + 1) * 64 + lane] = acc1;
        __syncthreads();
        if (wave < 2) {
            f32x4 s = part[wave * 64 + lane];
#pragma unroll
            for (int w = 1; w < 8; ++w) s += part[(w * 2 + wave) * 64 + lane];
            const int col = 16 * j + i16;
#pragma unroll
            for (int i = 0; i < 4; ++i) { const int r = 16 * wave + 4 * q4 + i;
                if (MODE == 0) Ob[(size_t)r * ldo + col] = (bf16_t)f2bf(s[i] * rstdS[r]);
                else if (MODE == 1) { const float xo = bf1(XBs[(size_t)r * DM + col]) + s[i]; XBs[(size_t)r * DM + col] = (bf16_t)f2bf(xo);
                    float sq = xo * xo; sq = row16_sum(sq);
                    if (i16 == 0) SSQS[r * 128 + j] = sq; }
                else Os[(size_t)r * DM + col] = bf1(XBs[(size_t)r * DM + col]) + s[i]; }
        }
        __syncthreads();
    }
}

constexpr int SU_PART = 0, SU_RSTD = 98304, SU_NITEMS = 352;
__device__ __forceinline__ void skinny_up(LAS unsigned char* lds, const float* st_in, const float* cw, const float* cb, const bf16_t* XB, const bf16_t* Bt, const float* SSQ, const float* SSQS, float* HALO, unsigned* hcnt,
                                          bf16_t* Z, float* outp, int layer, int c, int G, int nIdle, int tid, int wave, int lane) {
    if (c < G - nIdle) return;
    const int i16 = lane & 15, q4 = lane >> 4;
    LAS f32x4* part = (LAS f32x4*)(lds + SU_PART); LAS float* rstdS = (LAS float*)(lds + SU_RSTD);
    __syncthreads();
    { const int row = tid >> 2, pt = tid & 3; float s = 0.f;
      if (row < 32) { const float* q = SSQS + row * 128 + 32 * pt;
#pragma unroll
          for (int v = 0; v < 8; ++v) { const f32x4 a = *(const f32x4*)(q + 4 * v); s += (a[0] + a[1]) + (a[2] + a[3]); } }
      else if (row < 96) { const int hr = row - 32; const float* q = SSQ + (size_t)(256 * (hr >> 1) + 254 + (hr & 1)) * 32 + 8 * pt;
          const f32x4 a = *(const f32x4*)q, b = *(const f32x4*)(q + 4); s = ((a[0] + a[1]) + (a[2] + a[3])) + ((b[0] + b[1]) + (b[2] + b[3])); }
      s = row4_sum(s);
      if (pt == 0 && row < 96) rstdS[row] = rsqrtf(s * (1.f / 2048.f) + EPS); }
    __syncthreads();
    const int k0 = wave * 256;
    const bf16_t* ap[6];
#pragma unroll
    for (int rb = 0; rb < 6; ++rb) { const int grow = (rb < 2) ? MP + 16 * rb + i16 : 256 * ((16 * (rb - 2) + i16) >> 1) + 254 + (i16 & 1); ap[rb] = XB + (size_t)grow * DM + k0 + 8 * q4; }
    for (int j = G - 1 - c; j < SU_NITEMS; j += nIdle) {
        const int pn = j >> 3, sb = j & 7, na = 256 * pn + 16 * sb + i16;
        f32x4 acc[6][2];
#pragma unroll
        for (int rb = 0; rb < 6; ++rb) { acc[rb][0] = (f32x4){0.f, 0.f, 0.f, 0.f}; acc[rb][1] = (f32x4){0.f, 0.f, 0.f, 0.f}; }
        const bf16_t* bpa = Bt + (size_t)na * DM + k0 + 8 * q4; const bf16_t* bpb = bpa + (size_t)128 * DM;
#pragma unroll 2
        for (int ks = 0; ks < 8; ++ks) { const bf16x8 fa = *(const bf16x8*)(bpa + 32 * ks), fb = *(const bf16x8*)(bpb + 32 * ks);
#pragma unroll
            for (int rb = 0; rb < 6; ++rb) { const bf16x8 a = *(const bf16x8*)(ap[rb] + 32 * ks); acc[rb][0] = mma16(a, fa, acc[rb][0]); acc[rb][1] = mma16(a, fb, acc[rb][1]); } }
#pragma unroll
        for (int rb = 0; rb < 6; ++rb) { part[((wave * 6 + rb) * 2 + 0) * 64 + lane] = acc[rb][0]; part[((wave * 6 + rb) * 2 + 1) * 64 + lane] = acc[rb][1]; }
        __syncthreads();
        if (wave < 6) {
            const int rb = wave;
            f32x4 sa = part[((0 * 6 + rb) * 2 + 0) * 64 + lane], sbv = part[((0 * 6 + rb) * 2 + 1) * 64 + lane];
#pragma unroll
            for (int w = 1; w < 8; ++w) { sa += part[((w * 6 + rb) * 2 + 0) * 64 + lane]; sbv += part[((w * 6 + rb) * 2 + 1) * 64 + lane]; }
            const int jn = 128 * pn + 16 * sb + i16;
            if (rb < 2) {
                const int bs = 4 * rb + q4;
                float ua[4], ub[4];
#pragma unroll
                for (int i = 0; i < 4; ++i) { const float rs = rstdS[16 * rb + 4 * q4 + i]; ua[i] = sa[i] * rs; ub[i] = sbv[i] * rs; }
                const float wa0 = cw[jn], wa1 = cw[NUP + jn], wa2 = cw[2 * NUP + jn], ba = cb[jn], wb0 = cw[DFF + jn], wb1 = cw[NUP + DFF + jn], wb2 = cw[2 * NUP + DFF + jn], bb = cb[DFF + jn];
                const float* st = st_in + ((size_t)(layer * NBS + bs) * 2) * NUP;
                float a2 = st[jn], a1 = st[NUP + jn], b2 = st[DFF + jn], b1 = st[NUP + DFF + jn];
#pragma unroll
                for (int t = 0; t < 4; ++t) { const float ca = ba + wa0 * a2 + wa1 * a1 + wa2 * ua[t], cbv = bb + wb0 * b2 + wb1 * b1 + wb2 * ub[t];
                    Z[(size_t)(MP + bs * 4 + t) * DFF + jn] = (bf16_t)f2bf(ca / (1.f + fexp(-ca)) * cbv); a2 = a1; a1 = ua[t]; b2 = b1; b1 = ub[t]; }
                float* co = outp + O_CONVS + ((size_t)(layer * NBS + bs) * 2) * NUP;
                co[jn] = ua[2]; co[NUP + jn] = ua[3]; co[DFF + jn] = ub[2]; co[NUP + DFF + jn] = ub[3];
            } else {
#pragma unroll
                for (int i = 0; i < 4; ++i) { const int hr = 16 * (rb - 2) + 4 * q4 + i; const float rs = rstdS[32 + hr]; const float va = sa[i] * rs, vb = sbv[i] * rs;
                    __hip_atomic_store(HALO + (size_t)hr * NUP + na, va, __ATOMIC_RELAXED, __HIP_MEMORY_SCOPE_AGENT); __hip_atomic_store(HALO + (size_t)hr * NUP + na + 128, vb, __ATOMIC_RELAXED, __HIP_MEMORY_SCOPE_AGENT);
                    const int pmg = hr >> 1;
                    if ((pmg & 7) == 7) { float* co = outp + O_CONVP + ((size_t)(layer * NBP + (pmg >> 3)) * 2 + (hr & 1)) * NUP; co[jn] = va; co[DFF + jn] = vb; } }
                asm volatile("s_waitcnt vmcnt(0)" ::: "memory");
                if (lane == 0) __hip_atomic_fetch_add(hcnt, 1u, __ATOMIC_RELAXED, __HIP_MEMORY_SCOPE_AGENT);
            }
        }
        __syncthreads();
    }
}

__device__ __forceinline__ void unpack8(const u32x4 w, float (&x)[8]) { x[0] = bflo(w.x); x[1] = bfhi(w.x); x[2] = bflo(w.y); x[3] = bfhi(w.y); x[4] = bflo(w.z); x[5] = bfhi(w.z); x[6] = bflo(w.w); x[7] = bfhi(w.w); }
__device__ __forceinline__ void load8(const float* p, float (&x)[8]) { const f32x4 a = *(const f32x4*)p, b = *(const f32x4*)(p + 4); x[0] = a.x; x[1] = a.y; x[2] = a.z; x[3] = a.w; x[4] = b.x; x[5] = b.y; x[6] = b.z; x[7] = b.w; }
__device__ __forceinline__ void store8(float* p, const float (&x)[8]) { *(f32x4*)p = (f32x4){x[0], x[1], x[2], x[3]}; *(f32x4*)(p + 4) = (f32x4){x[4], x[5], x[6], x[7]}; }
constexpr int AT_PITCH = 272, AT_KOFF = 0, AT_VOFF = 256 * AT_PITCH;
struct AttnItem { int g, b, h, dil, r, qb; };
__device__ __forceinline__ AttnItem attn_decode(int item) {
    AttnItem a; a.g = item >> 9; const int rem = item & 511, idx = rem & 15; a.b = rem >> 7; a.h = (rem >> 4) & 7;
    a.dil = (a.g == 0) ? 1 : (a.g == 1) ? 4 : 16; a.r = (a.g == 0) ? 0 : (a.g == 1) ? (idx >> 2) : idx; a.qb = (a.g == 0) ? idx : (a.g == 1) ? (idx & 3) : 0; return a;
}
struct AttnPre { u32x4 kr[8]; };
__device__ __forceinline__ void attn_fetch(const bf16_t* QKV, const float* rope, const AttnItem& a, int tid, AttnPre& f) {
    const int ck = (a.g * 3 * 8 + a.h) * 128 + 1024, uk0 = 128 * (a.qb - 1); const size_t rowbase = (size_t)a.b * SEQ + a.r;
#pragma unroll
    for (int i = 0; i < 8; ++i) { const int id = tid + 512 * i, kk = id >> 4, ch = id & 15, u = uk0 + kk;
        f.kr[i] = (u32x4){0u, 0u, 0u, 0u};
        if (u >= 0) f.kr[i] = *(const u32x4*)(QKV + (rowbase + (size_t)u * a.dil) * NQKV + ck + 8 * ch); }
}
__device__ __forceinline__ void attn_phase(LAS unsigned char* lds, unsigned lds_base, const bf16_t* QKV, const float* rope, const float* qgain, const float* kgain, float* outp, int ia, bf16_t* OG, float* LSE,
                                           int first, int stride, int nitems, int tid, int wave, int lane) {
    const int i16 = lane & 15, q4 = lane >> 4, qq = i16 >> 2, p = lane & 3;
    const int ch = tid & 15; const float sgn = (ch >= 8) ? 1.f : -1.f;
    float kgn[8];
    load8(kgain + 8 * ch, kgn);
    AttnPre f;
    if (first < nitems) { const AttnItem a0 = attn_decode(first); attn_fetch(QKV, rope, a0, tid, f); }
    __syncthreads();
#pragma unroll 1
    for (int item = first; item < nitems; item += stride) {
        const AttnItem a = attn_decode(item);
        const int g = a.g, h = a.h, qb = a.qb;
        const int cq = (g * 3 * 8 + h) * 128;
        const size_t rowbase = (size_t)a.b * SEQ + a.r;
        const int win = 128 << (2 * g);
        float* kvo = outp + ((g == 0) ? O_KV128P : (g == 1) ? O_KV512P : O_KV2048P) + ((size_t)(ia * NBP + a.b) * win) * 2048 + h * 128 + 8 * ch;
        const int tqa = 16 * wave + i16;
        const int posq = a.r + a.dil * (128 * qb + tqa);
        const size_t grow = (size_t)a.b * SEQ + posq;
        { float c[8], sn[8], cd[8], sd[8];
          { const int u0 = (qb == 0) ? (tid >> 4) : 128 * (qb - 1) + (tid >> 4), pos0 = a.r + a.dil * u0;
            const f32x4* dp = (const f32x4*)(rope + ((size_t)(2052 + g) * 64 + 8 * (tid & 7)) * 2); const f32x4* rp = (const f32x4*)(rope + ((size_t)pos0 * 64 + 8 * (tid & 7)) * 2);
#pragma unroll
            for (int q = 0; q < 4; ++q) { const f32x4 t = dp[q], b0 = rp[q]; cd[2 * q] = t[0]; sd[2 * q] = t[1]; cd[2 * q + 1] = t[2]; sd[2 * q + 1] = t[3];
                c[2 * q] = b0[0]; sn[2 * q] = b0[1]; c[2 * q + 1] = b0[2]; sn[2 * q + 1] = b0[3]; } }
#pragma unroll
          for (int i = 0; i < 8; ++i) { const int id = tid + 512 * i, kk = id >> 4; const int u = 128 * (qb - 1) + kk;
            u32x4 kw = {0u, 0u, 0u, 0u};
            if (u >= 0) {
                float x[8]; unpack8(f.kr[i], x);
                float ss = 0.f;
#pragma unroll
                for (int j = 0; j < 8; ++j) ss += x[j] * x[j];
                ss = row16_sum(ss);
                const float rstd = rsqrtf(ss * (1.f / 128.f) + EPS);
                float o[8];
#pragma unroll
                for (int j = 0; j < 8; ++j) { const float y = x[j] * rstd * kgn[j]; const float pr = dpp_mov<0x128>(y); o[j] = y * c[j] + sgn * pr * sn[j];
                    const float cn = c[j] * cd[j] - sn[j] * sd[j]; sn[j] = sn[j] * cd[j] + c[j] * sd[j]; c[j] = cn; }
                kw.x = pk2(o[0], o[1]); kw.y = pk2(o[2], o[3]); kw.z = pk2(o[4], o[5]); kw.w = pk2(o[6], o[7]);
                const int jw = a.r + a.dil * u - (SEQ - win);
                if (kk >= 128 && jw >= 0) store8(kvo + (size_t)jw * 2048, o);
            }
            *(LAS u32x4*)(lds + AT_KOFF + kk * AT_PITCH + (id & 15) * 16) = kw; } }
        u32x4 vr[8];
        { const int cv = cq + 2048, uk0 = 128 * (qb - 1);
#pragma unroll
          for (int i = 0; i < 8; ++i) { const int id = tid + 512 * i, kk = id >> 4, u = uk0 + kk; vr[i] = (u32x4){0u, 0u, 0u, 0u};
              if (u >= 0) vr[i] = *(const u32x4*)(QKV + (rowbase + (size_t)u * a.dil) * NQKV + cv + 8 * (id & 15)); } }
        bf16x8 Qf[4];
        { float x[4][8];
#pragma unroll
          for (int ks = 0; ks < 4; ++ks) unpack8(*(const u32x4*)(QKV + grow * NQKV + cq + 32 * ks + 8 * q4), x[ks]);
          float ss = 0.f;
#pragma unroll
          for (int ks = 0; ks < 4; ++ks)
#pragma unroll
              for (int j = 0; j < 8; ++j) ss += x[ks][j] * x[ks][j];
          ss += __shfl_xor(ss, 16); ss += __shfl_xor(ss, 32);
          const float rstd = rsqrtf(ss * (1.f / 128.f) + EPS);
#pragma unroll
          for (int kp = 0; kp < 2; ++kp) { float g1[8], g2[8], cq_[8], sq_[8];
              load8(qgain + 32 * kp + 8 * q4, g1); load8(qgain + 64 + 32 * kp + 8 * q4, g2);
              const f32x4* rp = (const f32x4*)(rope + ((size_t)posq * 64 + 32 * kp + 8 * q4) * 2);
#pragma unroll
              for (int q = 0; q < 4; ++q) { const f32x4 t = rp[q]; cq_[2 * q] = t[0]; sq_[2 * q] = t[1]; cq_[2 * q + 1] = t[2]; sq_[2 * q + 1] = t[3]; }
              float o1[8], o2[8];
#pragma unroll
              for (int j = 0; j < 8; ++j) { const float y1 = x[kp][j] * rstd * g1[j], y2 = x[kp + 2][j] * rstd * g2[j]; o1[j] = y1 * cq_[j] - y2 * sq_[j]; o2[j] = y2 * cq_[j] + y1 * sq_[j]; }
              u32x4 w1, w2; w1.x = pk2(o1[0], o1[1]); w1.y = pk2(o1[2], o1[3]); w1.z = pk2(o1[4], o1[5]); w1.w = pk2(o1[6], o1[7]); w2.x = pk2(o2[0], o2[1]); w2.y = pk2(o2[2], o2[3]); w2.z = pk2(o2[4], o2[5]); w2.w = pk2(o2[6], o2[7]);
              Qf[kp] = __builtin_bit_cast(bf16x8, w1); Qf[kp + 2] = __builtin_bit_cast(bf16x8, w2); } }
        __syncthreads();
        if (item + stride < nitems) { const AttnItem an = attn_decode(item + stride); attn_fetch(QKV, rope, an, tid, f); }
        const int cb0 = wave & ~1;
        f32x4 S[10];
#pragma unroll
        for (int c = 0; c < 10; ++c) {
            f32x4 acc = {0.f, 0.f, 0.f, 0.f};
#pragma unroll
            for (int ks = 0; ks < 4; ++ks) { const bf16x8 kf = *(const LAS bf16x8*)(lds + AT_KOFF + (16 * (cb0 + c) + i16) * AT_PITCH + (32 * ks + 8 * q4) * 2); acc = mma16(kf, Qf[ks], acc); }
            S[c] = acc;
        }
        const float sc = 0.08838834764831845f * 1.4426950408889634f;
        float mx = -INFINITY;
#pragma unroll
        for (int c = 0; c < 10; ++c)
#pragma unroll
            for (int i = 0; i < 4; ++i) { const int kk = 16 * (cb0 + c) + 4 * q4 + i; const bool ok = (kk >= tqa) && (kk <= tqa + 128) && (qb > 0 || kk >= 128);
                const float s = ok ? S[c][i] * sc : -INFINITY; S[c][i] = s; mx = fmaxf(mx, s); }
        mx = fmaxf(mx, __shfl_xor(mx, 16)); mx = fmaxf(mx, __shfl_xor(mx, 32));
        float l = 0.f;
#pragma unroll
        for (int c = 0; c < 10; ++c)
#pragma unroll
            for (int i = 0; i < 4; ++i) { const float pv = __builtin_amdgcn_exp2f(S[c][i] - mx); S[c][i] = pv; l += pv; }
        l += __shfl_xor(l, 16); l += __shfl_xor(l, 32);
        bf16x8 Pf[5];
#pragma unroll
        for (int kst = 0; kst < 5; ++kst) Pf[kst] = pack8(S[2 * kst], S[2 * kst + 1]);
#pragma unroll
        for (int i = 0; i < 8; ++i) { const int id = tid + 512 * i, kk = id >> 4, u = 128 * (qb - 1) + kk;
            *(LAS u32x4*)(lds + AT_VOFF + kk * AT_PITCH + (id & 15) * 16) = vr[i];
            const int jw = a.r + a.dil * u - (SEQ - win);
            if (kk >= 128 && jw >= 0) { float vx[8]; unpack8(vr[i], vx); store8(kvo + (size_t)jw * 2048 + 1024, vx); } }
        __syncthreads();
        const float inv = 1.f / l;
        bf16_t* orow = OG + grow * 3072 + g * 1024 + h * 128 + 4 * q4;
        const unsigned vbase = lds_base + AT_VOFF + (16 * cb0 + 4 * q4 + qq) * AT_PITCH + 8 * p;
#pragma unroll
        for (int eb = 0; eb < 8; ++eb) {
            f32x4 acc = {0.f, 0.f, 0.f, 0.f};
            bf16x8 v0, v1, v2, v3, v4;
            TR_READ5(v0, v1, v2, v3, v4, vbase, 0 * AT_PITCH + 32 * eb, 16 * AT_PITCH + 32 * eb, 32 * AT_PITCH + 32 * eb, 48 * AT_PITCH + 32 * eb, 64 * AT_PITCH + 32 * eb, 80 * AT_PITCH + 32 * eb,
                     96 * AT_PITCH + 32 * eb, 112 * AT_PITCH + 32 * eb, 128 * AT_PITCH + 32 * eb, 144 * AT_PITCH + 32 * eb);
            acc = mma16(v0, Pf[0], acc); acc = mma16(v1, Pf[1], acc); acc = mma16(v2, Pf[2], acc); acc = mma16(v3, Pf[3], acc); acc = mma16(v4, Pf[4], acc);
            u32x2 w; w.x = pk2(acc[0] * inv, acc[1] * inv); w.y = pk2(acc[2] * inv, acc[3] * inv);
            *(u32x2*)(orow + 16 * eb) = w;
        }
        if (q4 == 0) LSE[grow * 24 + g * 8 + h] = (mx + log2f(l)) * 0.6931471805599453f;
    }
    __syncthreads();
}

__device__ __forceinline__ void sample_prep_vec(const bf16_t* src, const float* gain, const float* rope, int tt, LAS float* dst, int lane) {
    const float x1 = bf1(src[lane]), x2 = bf1(src[lane + 64]);
    const float rstd = rsqrtf(wave_sum(x1 * x1 + x2 * x2) * (1.f / 128.f) + EPS);
    const float y1 = x1 * rstd * gain[lane], y2 = x2 * rstd * gain[64 + lane];
    const f32x2 cs = *(const f32x2*)(rope + ((size_t)(SEQ + tt) * 64 + lane) * 2);
    dst[lane] = y1 * cs.x - y2 * cs.y; dst[lane + 64] = y2 * cs.x + y1 * cs.y;
}
__device__ __forceinline__ void attn_sample_task(LAS unsigned char* wl  , const bf16_t* QKV, const float* rope, const float* qgain, const float* kgain, float* outp,
                                                 const float* c128, const float* c512, const float* c2048, bf16_t* OG, float* LSE, int ia, int wt, int lane) {
    const int bs = wt / 96, rem = wt % 96, g = rem >> 5, h = (rem >> 2) & 7, t = rem & 3;
    const int win = 128 << (2 * g), dil = 1 << (2 * g);
    const float* cache = ((g == 0) ? c128 : (g == 1) ? c512 : c2048) + (size_t)(ia * NBS + bs) * win * 2048;
    const int cq = (g * 3 * 8 + h) * 128, ck = cq + 1024, cv = cq + 2048;
    const size_t rq = (size_t)MP + bs * 4 + t;
    LAS float* qs = (LAS float*)wl; LAS float* ps = (LAS float*)(wl + 512); LAS float* knew = (LAS float*)(wl + 1536);
    sample_prep_vec(QKV + rq * NQKV + cq, qgain, rope, t, qs, lane);
    for (int tn = (g == 0) ? 0 : t; tn <= t; ++tn) sample_prep_vec(QKV + ((size_t)MP + bs * 4 + tn) * NQKV + ck, kgain, rope, tn, knew + tn * 128, lane);
    asm volatile("s_waitcnt lgkmcnt(0)" ::: "memory");
    { float* kvo = outp + ((g == 0) ? O_KV128S : (g == 1) ? O_KV512S : O_KV2048S) + (((size_t)(ia * NBS + bs) * win + (win - TSAMP + t)) * 2) * 1024 + h * 128;
      kvo[lane] = knew[t * 128 + lane]; kvo[lane + 64] = knew[t * 128 + lane + 64];
      const bf16_t* vp = QKV + rq * NQKV + cv; kvo[1024 + lane] = bf1(vp[lane]); kvo[1024 + lane + 64] = bf1(vp[lane + 64]); }
    float sv[3];
#pragma unroll
    for (int pass = 0; pass < 3; ++pass) {
        const int j = pass * 64 + lane; float s = -INFINITY;
        if (j <= 128) {
            const int idx = win + t - dil * j; float acc = 0.f;
            if (idx >= win) { const LAS float* kp = knew + (idx - win) * 128;
                for (int d = 0; d < 128; d += 4) { const LAS float* q = qs + d; acc += q[0] * kp[d] + q[1] * kp[d + 1] + q[2] * kp[d + 2] + q[3] * kp[d + 3]; } }
            else { const float* kp = cache + ((size_t)idx * 2 + 0) * 1024 + h * 128;
                for (int d = 0; d < 128; d += 4) { const f32x4 kx = *(const f32x4*)(kp + d); const LAS float* q = qs + d; acc += q[0] * kx.x + q[1] * kx.y + q[2] * kx.z + q[3] * kx.w; } }
            s = acc * 0.08838834764831845f;
        }
        sv[pass] = s;
    }
    const float mx = wave_max(fmaxf(fmaxf(sv[0], sv[1]), sv[2]));
    float l = 0.f;
#pragma unroll
    for (int pass = 0; pass < 3; ++pass) { const float pv = fexp(sv[pass] - mx); l += pv; ps[pass * 64 + lane] = pv; }
    l = wave_sum(l);
    asm volatile("s_waitcnt lgkmcnt(0)" ::: "memory");
    { const int jg = lane >> 4, dd = lane & 15;
      float o[8];
#pragma unroll
      for (int q = 0; q < 8; ++q) o[q] = 0.f;
#pragma unroll 4
      for (int j = jg; j <= 128; j += 4) {
          const int idx = win + t - dil * j; const float pj = ps[j]; float v[8];
          if (idx >= win) { unpack8(*(const u32x4*)(QKV + ((size_t)MP + bs * 4 + (idx - win)) * NQKV + cv + 8 * dd), v); }
          else { load8(cache + ((size_t)idx * 2 + 1) * 1024 + h * 128 + 8 * dd, v); }
#pragma unroll
          for (int q = 0; q < 8; ++q) o[q] += pj * v[q];
      }
      const float inv = 1.f / l;
#pragma unroll
      for (int q = 0; q < 8; ++q) { o[q] += __shfl_xor(o[q], 16); o[q] += __shfl_xor(o[q], 32); o[q] *= inv; }
      if (jg == 0) { u32x4 w; w.x = pk2(o[0], o[1]); w.y = pk2(o[2], o[3]); w.z = pk2(o[4], o[5]); w.w = pk2(o[6], o[7]); *(u32x4*)(OG + rq * 3072 + g * 1024 + h * 128 + 8 * dd) = w; } }
    if (lane == 0) LSE[rq * 24 + g * 8 + h] = mx + logf(l);
}

__device__ __forceinline__ void combine_row(const bf16_t* OG, const float* LSE, bf16_t* OC, int r, int lane) {
    const int hh = lane >> 3;
    const float l0 = LSE[(size_t)r * 24 + hh], l1 = LSE[(size_t)r * 24 + 8 + hh], l2 = LSE[(size_t)r * 24 + 16 + hh];
    const float mx = fmaxf(l0, fmaxf(l1, l2));
    float e0 = fexp(l0 - mx), e1 = fexp(l1 - mx), e2 = fexp(l2 - mx);
    const float inv = 1.f / (e0 + e1 + e2); e0 *= inv; e1 *= inv; e2 *= inv;
    const bf16_t* src = OG + (size_t)r * 3072 + 16 * lane;
#pragma unroll
    for (int c = 0; c < 2; ++c) {
        const u32x4 a = *(const u32x4*)(src + 8 * c), bq = *(const u32x4*)(src + 1024 + 8 * c), cc = *(const u32x4*)(src + 2048 + 8 * c);
        u32x4 o;
        o.x = pk2(e0 * bflo(a.x) + e1 * bflo(bq.x) + e2 * bflo(cc.x), e0 * bfhi(a.x) + e1 * bfhi(bq.x) + e2 * bfhi(cc.x));
        o.y = pk2(e0 * bflo(a.y) + e1 * bflo(bq.y) + e2 * bflo(cc.y), e0 * bfhi(a.y) + e1 * bfhi(bq.y) + e2 * bfhi(cc.y));
        o.z = pk2(e0 * bflo(a.z) + e1 * bflo(bq.z) + e2 * bflo(cc.z), e0 * bfhi(a.z) + e1 * bfhi(bq.z) + e2 * bfhi(cc.z));
        o.w = pk2(e0 * bflo(a.w) + e1 * bflo(bq.w) + e2 * bflo(cc.w), e0 * bfhi(a.w) + e1 * bfhi(bq.w) + e2 * bfhi(cc.w));
        *(u32x4*)(OC + (size_t)r * DO + 16 * lane + 8 * c) = o;
    }
}

template <int CTRL, int RMASK> __device__ __forceinline__ float dpp_f(float oldv, float src) {
    return __builtin_bit_cast(float, __builtin_amdgcn_update_dpp(__builtin_bit_cast(int, oldv), __builtin_bit_cast(int, src), CTRL, RMASK, 0xf, false)); }
__device__ __forceinline__ float scan_sum(float v, int lane) {
    (void)lane;
    v += dpp_f<0x111, 0xf>(0.f, v); v += dpp_f<0x112, 0xf>(0.f, v); v += dpp_f<0x114, 0xf>(0.f, v); v += dpp_f<0x118, 0xf>(0.f, v);
    v += dpp_f<0x142, 0xa>(0.f, v); v += dpp_f<0x143, 0xc>(0.f, v);
    return v;
}
__device__ __forceinline__ float scan_max(float v, int lane) {
    (void)lane; const float ninf = -INFINITY;
    v = fmaxf(v, dpp_f<0x111, 0xf>(ninf, v)); v = fmaxf(v, dpp_f<0x112, 0xf>(ninf, v)); v = fmaxf(v, dpp_f<0x114, 0xf>(ninf, v)); v = fmaxf(v, dpp_f<0x118, 0xf>(ninf, v));
    v = fmaxf(v, dpp_f<0x142, 0xa>(ninf, v)); v = fmaxf(v, dpp_f<0x143, 0xc>(ninf, v));
    return v;
}
#ifndef ML_COPY
#define ML_COPY 0
#endif
constexpr int ML_QP = 272, ML_VP = 144, ML_PP = 144;
constexpr int ML_QSZ = 64 * ML_QP, ML_VSZ = 64 * ML_VP;
constexpr int ML_Q = 0, ML_K = ML_Q + 2 * ML_QSZ, ML_V = ML_K + 2 * ML_QSZ, ML_KW = ML_V + 2 * ML_VSZ, ML_P = ML_KW + ML_QSZ, ML_N = ML_P + 64 * ML_PP, ML_DEN = ML_N + 1024, ML_END = ML_DEN + 256;
__device__ __forceinline__ void mlstm_prompt(LAS unsigned char* lds, unsigned lds_base, const bf16_t* QKVO, const float* GATES, bf16_t* HRAW, float* SQ, float* out, int ib, int unit, int tid, int wave, int lane) {
    const int bh = unit >> 2, sl = unit & 3;
    const int b = bh >> 3, h = bh & 7;
    const int i16 = lane & 15, q4 = lane >> 4, qq = i16 >> 2, p = lane & 3;
    const int rb = wave >> 1, ea = wave & 1, e0 = 64 * sl + 32 * ea;
    f32x4 CT[2][8];
#pragma unroll
    for (int a = 0; a < 2; ++a)
#pragma unroll
        for (int d = 0; d < 8; ++d) CT[a][d] = (f32x4){0.f, 0.f, 0.f, 0.f};
    float m = 0.f;
    const unsigned vbase0 = lds_base + ML_V + (8 * q4 + qq) * ML_VP + (32 * ea + 4 * p) * 2, kwbase = lds_base + ML_KW + (8 * q4 + qq) * ML_QP + 8 * p;
    LAS float* nS = (LAS float*)(lds + ML_N); LAS float* denS = (LAS float*)(lds + ML_DEN);
    const size_t rbase = (size_t)b * SEQ;
    const int srow0 = tid >> 4, sch = tid & 15, vrow = tid >> 3, vch = tid & 7;
    u32x4 pq0, pq1, pk0, pk1, pv; float pig, plf;
    { const bf16_t* s0 = QKVO + (rbase + srow0) * NIN + h * 128 + 8 * sch; const bf16_t* s1 = s0 + (size_t)32 * NIN;
      pq0 = *(const u32x4*)s0; pk0 = *(const u32x4*)(s0 + 1024); pq1 = *(const u32x4*)s1; pk1 = *(const u32x4*)(s1 + 1024);
      pv = *(const u32x4*)(QKVO + (rbase + vrow) * NIN + 2048 + h * 256 + 64 * sl + 8 * vch);
      pig = GATES[(rbase + lane) * 16 + h]; plf = GATES[(rbase + lane) * 16 + 8 + h]; }
    __syncthreads();
    if (tid < 128) nS[tid] = 0.f;
    *(LAS u32x4*)(lds + ML_Q + srow0 * ML_QP + sch * 16) = pq0; *(LAS u32x4*)(lds + ML_Q + (srow0 + 32) * ML_QP + sch * 16) = pq1;
    *(LAS u32x4*)(lds + ML_K + srow0 * ML_QP + sch * 16) = pk0; *(LAS u32x4*)(lds + ML_K + (srow0 + 32) * ML_QP + sch * 16) = pk1;
    *(LAS u32x4*)(lds + ML_V + vrow * ML_VP + vch * 16) = pv;
    __syncthreads();
    float hv0[4] = {0.f, 0.f, 0.f, 0.f}, hv1[4] = {0.f, 0.f, 0.f, 0.f}, sv0[4] = {0.f, 0.f, 0.f, 0.f}, sv1[4] = {0.f, 0.f, 0.f, 0.f};
#define ML_FLUSH(rprev) do { _Pragma("unroll") for (int i = 0; i < 4; ++i) { const int t = 16 * rb + 4 * q4 + i; \
        bf16_t* hp = HRAW + ((rprev) + t) * DM + h * 256 + e0 + i16; hp[0] = (bf16_t)f2bf(hv0[i]); hp[16] = (bf16_t)f2bf(hv1[i]); \
        if (i16 == 0) { float* sp = SQ + ((rprev) + t) * 128 + h * 16 + 4 * sl + 2 * ea; sp[0] = sv0[i]; sp[1] = sv1[i]; } } } while (0)
#pragma unroll 1
    for (int c = 0; c < 32; ++c) {
        const int cur = c & 1, nxt = cur ^ 1;
        const size_t r0 = rbase + 64 * c;
        const LAS unsigned char* Qc = lds + ML_Q + cur * ML_QSZ; const LAS unsigned char* Kc = lds + ML_K + cur * ML_QSZ;
        const float ig = pig, lf = plf;
        asm volatile("" :: "v"(ig), "v"(lf));
        if (c > 0) ML_FLUSH(r0 - 64);
        { const size_t rn = rbase + 64 * ((c < 31) ? c + 1 : c);
          const bf16_t* s0 = QKVO + (rn + srow0) * NIN + h * 128 + 8 * sch; const bf16_t* s1 = s0 + (size_t)32 * NIN;
          pq0 = *(const u32x4*)s0; pk0 = *(const u32x4*)(s0 + 1024); pq1 = *(const u32x4*)s1; pk1 = *(const u32x4*)(s1 + 1024);
          pv = *(const u32x4*)(QKVO + (rn + vrow) * NIN + 2048 + h * 256 + 64 * sl + 8 * vch);
          pig = GATES[(rn + lane) * 16 + h]; plf = GATES[(rn + lane) * 16 + 8 + h]; }
        const float bcum = scan_sum(lf, lane);
        const float av = ig - bcum;
        const float Av = fmaxf(m, scan_max(av, lane));
        const float bL = __shfl(bcum, 63), A63 = __shfl(Av, 63);
        const float wsv = fexp(av - A63), wC = fexp(m - A63);
#pragma unroll
        for (int i = 0; i < 2; ++i) { const int id = lane + 64 * i, rr = 8 * wave + (id >> 4), ch = id & 15;
            const u32x4 kx = *(const LAS u32x4*)(Kc + rr * ML_QP + ch * 16); const float w = __shfl(wsv, rr);
            u32x4 o; o.x = pk2(bflo(kx.x) * w, bfhi(kx.x) * w); o.y = pk2(bflo(kx.y) * w, bfhi(kx.y) * w); o.z = pk2(bflo(kx.z) * w, bfhi(kx.z) * w); o.w = pk2(bflo(kx.w) * w, bfhi(kx.w) * w);
            *(LAS u32x4*)(lds + ML_KW + rr * ML_QP + ch * 16) = o; }
        {
#pragma unroll
          for (int cc = 0; cc < 2; ++cc) { const int cb = 2 * (wave & 1) + cc;
            f32x4 s = {0.f, 0.f, 0.f, 0.f};
            if (cb <= rb) {
#pragma unroll
                for (int ks = 0; ks < 4; ++ks) { const bf16x8 af = *(const LAS bf16x8*)(Qc + (16 * rb + i16) * ML_QP + (32 * ks + 8 * q4) * 2);
                    const bf16x8 bf = *(const LAS bf16x8*)(Kc + (16 * cb + i16) * ML_QP + (32 * ks + 8 * q4) * 2); s = mma16(af, bf, s); } }
            const int sidx = 16 * cb + i16; const float as = __shfl(av, sidx);
#pragma unroll
            for (int i = 0; i < 4; ++i) { const int t = 16 * rb + 4 * q4 + i; const float At = __shfl(Av, t);
                const float pv_ = (sidx <= t && cb <= rb) ? s[i] * fexp(as - At) : 0.f;
                *(LAS bf16_t*)(lds + ML_P + t * ML_PP + sidx * 2) = (bf16_t)f2bf(pv_); } } }
        LDS_BARRIER();
        { const int t = tid >> 3, part = tid & 7;
          const LAS unsigned char* qrow = Qc + t * ML_QP + part * 32;
          const u32x4 qa = *(const LAS u32x4*)(qrow), qb = *(const LAS u32x4*)(qrow + 16);
          const LAS float* nn = nS + cur * 128 + 16 * part;
          float a = nn[0] * bflo(qa.x) + nn[1] * bfhi(qa.x) + nn[2] * bflo(qa.y) + nn[3] * bfhi(qa.y) + nn[4] * bflo(qa.z) + nn[5] * bfhi(qa.z) + nn[6] * bflo(qa.w) + nn[7] * bfhi(qa.w)
                  + nn[8] * bflo(qb.x) + nn[9] * bfhi(qb.x) + nn[10] * bflo(qb.y) + nn[11] * bfhi(qb.y) + nn[12] * bflo(qb.z) + nn[13] * bfhi(qb.z) + nn[14] * bflo(qb.w) + nn[15] * bfhi(qb.w);
          const u32x4 pr = *(const LAS u32x4*)(lds + ML_P + t * ML_PP + part * 16);
          const float rsum = ((bflo(pr.x) + bfhi(pr.x)) + (bflo(pr.y) + bfhi(pr.y))) + ((bflo(pr.z) + bfhi(pr.z)) + (bflo(pr.w) + bfhi(pr.w)));
          const float At = __shfl(Av, t), bt = __shfl(bcum, t);
          float val = fexp(m - At) * a + rsum;
          val = row8_sum(val);
          if (part == 0) denS[t] = 1.f / fmaxf(fabsf(val), fexp(-(bt + At))); }
        if (tid < 128) { float acc = wC * nS[cur * 128 + tid];
#pragma unroll 8
            for (int s = 0; s < 64; ++s) acc += bf1(*(const LAS bf16_t*)(lds + ML_KW + s * ML_QP + tid * 2));
            nS[nxt * 128 + tid] = acc; }
        f32x4 num0 = {0.f, 0.f, 0.f, 0.f}, num1 = {0.f, 0.f, 0.f, 0.f};
#pragma unroll
        for (int ks = 0; ks < 4; ++ks) { const LAS unsigned char* qrow = Qc + (16 * rb + i16) * ML_QP;
            const u32x2 lo = *(const LAS u32x2*)(qrow + (32 * ks + 4 * q4) * 2), hi = *(const LAS u32x2*)(qrow + (32 * ks + 16 + 4 * q4) * 2);
            u32x4 w; w.x = lo.x; w.y = lo.y; w.z = hi.x; w.w = hi.y; const bf16x8 af = __builtin_bit_cast(bf16x8, w);
            num0 = mma16(af, pack8(CT[0][2 * ks], CT[0][2 * ks + 1]), num0); num1 = mma16(af, pack8(CT[1][2 * ks], CT[1][2 * ks + 1]), num1); }
#pragma unroll
        for (int i = 0; i < 4; ++i) { const float wi = fexp(m - __shfl(Av, 16 * rb + 4 * q4 + i)); num0[i] *= wi; num1[i] *= wi; }
        const unsigned vbase = vbase0 + cur * ML_VSZ;
        bf16x8 V00, V01, V10, V11;
        TR_READ4(V00, V01, V10, V11, vbase, 0, 4 * ML_VP, 32 * ML_VP, 36 * ML_VP, 32, 4 * ML_VP + 32, 32 * ML_VP + 32, 36 * ML_VP + 32);
        { const bf16x8 pf0 = *(const LAS bf16x8*)(lds + ML_P + (16 * rb + i16) * ML_PP + (8 * q4) * 2), pf1 = *(const LAS bf16x8*)(lds + ML_P + (16 * rb + i16) * ML_PP + (32 + 8 * q4) * 2);
          num0 = mma16(pf0, V00, num0); num0 = mma16(pf1, V01, num0); num1 = mma16(pf0, V10, num1); num1 = mma16(pf1, V11, num1); }
#pragma unroll
        for (int a = 0; a < 2; ++a)
#pragma unroll
            for (int d = 0; d < 8; ++d) CT[a][d] = CT[a][d] * wC;
#pragma unroll
        for (int ks = 0; ks < 2; ++ks)
#pragma unroll
            for (int dg = 0; dg < 2; ++dg) { bf16x8 k0, k1, k2, k3;
                TR_READ4(k0, k1, k2, k3, kwbase, 32 * ks * ML_QP + 32 * (4 * dg), (32 * ks + 4) * ML_QP + 32 * (4 * dg), 32 * ks * ML_QP + 32 * (4 * dg + 1), (32 * ks + 4) * ML_QP + 32 * (4 * dg + 1),
                         32 * ks * ML_QP + 32 * (4 * dg + 2), (32 * ks + 4) * ML_QP + 32 * (4 * dg + 2), 32 * ks * ML_QP + 32 * (4 * dg + 3), (32 * ks + 4) * ML_QP + 32 * (4 * dg + 3));
                const bf16x8 va = ks ? V01 : V00, vb = ks ? V11 : V10;
                CT[0][4 * dg] = mma16(k0, va, CT[0][4 * dg]); CT[0][4 * dg + 1] = mma16(k1, va, CT[0][4 * dg + 1]); CT[0][4 * dg + 2] = mma16(k2, va, CT[0][4 * dg + 2]); CT[0][4 * dg + 3] = mma16(k3, va, CT[0][4 * dg + 3]);
                CT[1][4 * dg] = mma16(k0, vb, CT[1][4 * dg]); CT[1][4 * dg + 1] = mma16(k1, vb, CT[1][4 * dg + 1]); CT[1][4 * dg + 2] = mma16(k2, vb, CT[1][4 * dg + 2]); CT[1][4 * dg + 3] = mma16(k3, vb, CT[1][4 * dg + 3]); }
        { LAS unsigned char* Qn = lds + ML_Q + nxt * ML_QSZ; LAS unsigned char* Kn = lds + ML_K + nxt * ML_QSZ;
          *(LAS u32x4*)(Qn + srow0 * ML_QP + sch * 16) = pq0; *(LAS u32x4*)(Qn + (srow0 + 32) * ML_QP + sch * 16) = pq1;
          *(LAS u32x4*)(Kn + srow0 * ML_QP + sch * 16) = pk0; *(LAS u32x4*)(Kn + (srow0 + 32) * ML_QP + sch * 16) = pk1;
          *(LAS u32x4*)(lds + ML_V + nxt * ML_VSZ + vrow * ML_VP + vch * 16) = pv; }
        LDS_BARRIER();
#pragma unroll
        for (int i = 0; i < 4; ++i) { const int t = 16 * rb + 4 * q4 + i; const float dinv = denS[t]; const float h0 = num0[i] * dinv, h1 = num1[i] * dinv;
            hv0[i] = h0; hv1[i] = h1;
            float s0 = h0 * h0, s1 = h1 * h1;
            s0 = row16_sum(s0);
            s1 = row16_sum(s1);
            sv0[i] = s0; sv1[i] = s1; }
        m = bL + A63;
    }
    ML_FLUSH(rbase + 64 * 31);
#undef ML_FLUSH
    const size_t sb = (size_t)(ib * NBP + b) * 8 + h;
    if (rb == 0) {
#pragma unroll
        for (int a = 0; a < 2; ++a)
#pragma unroll
            for (int d = 0; d < 8; ++d) *(f32x4*)(out + O_CP + (sb * 256 + e0 + 16 * a + i16) * 128 + 16 * d + 4 * q4) = CT[a][d]; }
    if (sl == 0) { if (tid < 128) out[O_NP + sb * 128 + tid] = nS[tid]; if (tid == 0) out[O_MP + sb] = m; }
}

__device__ __forceinline__ void hn_row(const bf16_t* HRAW, const float* SQ, const bf16_t* QKVO, const float* gh, bf16_t* HN, int r, int lane) {
    const int hh = lane >> 3;
    const f32x4 s0 = *(const f32x4*)(SQ + (size_t)r * 128 + hh * 16), s1 = *(const f32x4*)(SQ + (size_t)r * 128 + hh * 16 + 4), s2 = *(const f32x4*)(SQ + (size_t)r * 128 + hh * 16 + 8), s3 = *(const f32x4*)(SQ + (size_t)r * 128 + hh * 16 + 12);
    const float tot = (((s0[0] + s0[1]) + (s0[2] + s0[3])) + ((s1[0] + s1[1]) + (s1[2] + s1[3]))) + (((s2[0] + s2[1]) + (s2[2] + s2[3])) + ((s3[0] + s3[1]) + (s3[2] + s3[3])));
    const float rs = rsqrtf(tot * (1.f / 256.f) + EPS);
#pragma unroll
    for (int c = 0; c < 4; ++c) { const int col = 32 * lane + 8 * c;
        const u32x4 hx = *(const u32x4*)(HRAW + (size_t)r * DM + col), ox = *(const u32x4*)(QKVO + (size_t)r * NIN + 4096 + col);
        const f32x4 g0 = *(const f32x4*)(gh + col), g1 = *(const f32x4*)(gh + col + 4);
        u32x4 o;
        o.x = pk2(bflo(hx.x) * rs * g0[0] / (1.f + fexp(-bflo(ox.x))), bfhi(hx.x) * rs * g0[1] / (1.f + fexp(-bfhi(ox.x))));
        o.y = pk2(bflo(hx.y) * rs * g0[2] / (1.f + fexp(-bflo(ox.y))), bfhi(hx.y) * rs * g0[3] / (1.f + fexp(-bfhi(ox.y))));
        o.z = pk2(bflo(hx.z) * rs * g1[0] / (1.f + fexp(-bflo(ox.z))), bfhi(hx.z) * rs * g1[1] / (1.f + fexp(-bfhi(ox.z))));
        o.w = pk2(bflo(hx.w) * rs * g1[2] / (1.f + fexp(-bflo(ox.w))), bfhi(hx.w) * rs * g1[3] / (1.f + fexp(-bfhi(ox.w))));
        *(u32x4*)(HN + (size_t)r * DM + col) = o; }
}

__device__ __forceinline__ void mlstm_sample(LAS unsigned char* lds, const bf16_t* QKVO, const float* GATES, const float* gh, const float* C0all, const float* n0all, const float* m0all, bf16_t* HN, float* out, int ib, int bh, int tid, int wave, int lane) {
    const int bs = bh >> 3, h = bh & 7;
    const size_t sb = (size_t)(ib * NBS + bs) * 8 + h;
    LAS float* qs = (LAS float*)lds;
    LAS float* ks = qs + 512;
    LAS float* ns = ks + 512;
    LAS float* Ss = ns + 128;
    LAS float* nq = Ss + 16;
    LAS float* red = nq + 16;
    const size_t r0 = (size_t)MP + bs * 4;
    __syncthreads();
    { const int t = tid >> 7, d = tid & 127; qs[tid] = bf1(QKVO[(r0 + t) * NIN + h * 128 + d]); ks[tid] = bf1(QKVO[(r0 + t) * NIN + 1024 + h * 128 + d]); if (tid < 128) ns[tid] = n0all[sb * 128 + tid]; }
    __syncthreads();
    if (wave == 0) {
        if (lane < 16) { const int t = lane >> 2, s = lane & 3; float a = 0.f; for (int d = 0; d < 128; ++d) a += qs[t * 128 + d] * ks[s * 128 + d]; Ss[lane] = a; }
        else if (lane < 20) { const int t = lane - 16; float a = 0.f; for (int d = 0; d < 128; ++d) a += ns[d] * qs[t * 128 + d]; nq[t] = a; }
    }
    __syncthreads();
    const float m0 = m0all[sb];
    float bc[4], av[4], Av[4];
    { float run = 0.f, pm = -INFINITY;
#pragma unroll
      for (int t = 0; t < 4; ++t) { const float ig = GATES[(r0 + t) * 16 + h], lf = GATES[(r0 + t) * 16 + 8 + h]; run += lf; bc[t] = run; av[t] = ig - run; pm = fmaxf(pm, av[t]); Av[t] = fmaxf(m0, pm); } }
    const float A3 = Av[3], wC = fexp(m0 - A3);
    float Pm[4][4], den[4];
#pragma unroll
    for (int t = 0; t < 4; ++t) { float rs = 0.f;
#pragma unroll
        for (int s = 0; s < 4; ++s) { Pm[t][s] = (s <= t) ? Ss[t * 4 + s] * fexp(av[s] - Av[t]) : 0.f; rs += Pm[t][s]; }
        den[t] = fexp(m0 - Av[t]) * nq[t] + rs; }
    const int e = tid >> 1, hf = tid & 1;
    const float* Crow = C0all + (sb * 256 + e) * 128 + 64 * hf;
    f32x4 Cv[16];
#pragma unroll
    for (int j = 0; j < 16; ++j) Cv[j] = *(const f32x4*)(Crow + 4 * j);
    float inter[4];
#pragma unroll
    for (int t = 0; t < 4; ++t) { float a = 0.f; const LAS float* q = qs + t * 128 + 64 * hf;
#pragma unroll
        for (int j = 0; j < 16; ++j) a += Cv[j].x * q[4 * j] + Cv[j].y * q[4 * j + 1] + Cv[j].z * q[4 * j + 2] + Cv[j].w * q[4 * j + 3];
        a += __shfl_xor(a, 1); inter[t] = a; }
    float vv[4];
#pragma unroll
    for (int s = 0; s < 4; ++s) vv[s] = bf1(QKVO[(r0 + s) * NIN + 2048 + h * 256 + e]);
    float hv[4];
#pragma unroll
    for (int t = 0; t < 4; ++t) { float nu = fexp(m0 - Av[t]) * inter[t];
#pragma unroll
        for (int s = 0; s < 4; ++s) nu += Pm[t][s] * vv[s];
        hv[t] = nu / fmaxf(fabsf(den[t]), fexp(-(bc[t] + Av[t])));
        float sq = (hf == 0) ? hv[t] * hv[t] : 0.f; sq = wave_sum(sq); if (lane == 0) red[t * 8 + wave] = sq; }
    __syncthreads();
    if (hf == 0) {
#pragma unroll
        for (int t = 0; t < 4; ++t) { float tot = 0.f;
#pragma unroll
            for (int w = 0; w < 8; ++w) tot += red[t * 8 + w];
            const float rs = rsqrtf(tot * (1.f / 256.f) + EPS);
            const float og = bf1(QKVO[(r0 + t) * NIN + 4096 + h * 256 + e]);
            HN[(r0 + t) * DM + h * 256 + e] = (bf16_t)f2bf(hv[t] * rs * gh[h * 256 + e] / (1.f + fexp(-og))); } }
    float wv[4];
#pragma unroll
    for (int s = 0; s < 4; ++s) wv[s] = fexp(av[s] - A3) * vv[s];
    float* Cout = out + O_CS + (sb * 256 + e) * 128 + 64 * hf;
#pragma unroll
    for (int j = 0; j < 16; ++j) { f32x4 o = Cv[j] * wC;
#pragma unroll
        for (int s = 0; s < 4; ++s) { const LAS float* k = ks + s * 128 + 64 * hf + 4 * j; o.x += wv[s] * k[0]; o.y += wv[s] * k[1]; o.z += wv[s] * k[2]; o.w += wv[s] * k[3]; }
        *(f32x4*)(Cout + 4 * j) = o; }
    if (tid < 128) { float o = wC * ns[tid];
#pragma unroll
        for (int s = 0; s < 4; ++s) o += fexp(av[s] - A3) * ks[s * 128 + tid];
        out[O_NS + sb * 128 + tid] = o; }
    if (tid == 0) out[O_MS + sb] = bc[3] + A3;
}

__device__ __forceinline__ void cache_shift(const Params& P, float* outp, int ia, int w, int NW, int lane) {
    constexpr int N0 = NBS * 124, N1 = NBS * 508, N2 = NBS * 2044;
    for (int it = w; it < N0 + N1 + N2; it += NW) {
        int g, q; if (it < N0) { g = 0; q = it; } else if (it < N0 + N1) { g = 1; q = it - N0; } else { g = 2; q = it - N0 - N1; }
        const int win = 128 << (2 * g), per = win - 4, bs = q / per, j = q % per;
        const float* src = P.in[2 + g] + ((size_t)(ia * NBS + bs) * win + j + 4) * 2048;
        float* dst = outp + ((g == 0) ? O_KV128S : (g == 1) ? O_KV512S : O_KV2048S) + ((size_t)(ia * NBS + bs) * win + j) * 2048;
#pragma unroll
        for (int i = 0; i < 8; ++i) ((f32x4*)dst)[lane + 64 * i] = ((const f32x4*)src)[lane + 64 * i];
    }
}

__device__ __forceinline__ void phase_convgate(const Params& P, float* outp, const bf16_t* U, bf16_t* Z, int layer, int gtid, int NGT) {
    constexpr int NCG = DFF / 8, NRUN = MP / 64 + NBS;
    const float* cw = P.in[20] + (size_t)layer * 3 * NUP; const float* cbias = P.in[21] + (size_t)layer * NUP;
    for (int task = gtid; task < NCG * NRUN; task += NGT) {
        const int cg = task % NCG, run = task / NCG, j0 = 8 * cg;
        const int ua0 = 256 * (j0 >> 7) + (j0 & 127), ub0 = ua0 + 128;
        float wa[3][8], wb[3][8], ba[8], bb[8];
#pragma unroll
        for (int k = 0; k < 3; ++k) { load8(cw + (size_t)k * NUP + j0, wa[k]); load8(cw + (size_t)k * NUP + DFF + j0, wb[k]); }
        load8(cbias + j0, ba); load8(cbias + DFF + j0, bb);
        float a2[8], a1[8], b2[8], b1[8];
        size_t row0; int nrows; float* cout;
        if (run < MP / 64) { const int b = run >> 5, s0 = (run & 31) * 64; row0 = (size_t)b * SEQ + s0; nrows = 64;
            cout = (s0 == SEQ - 64) ? outp + O_CONVP + ((size_t)(layer * NBP + b) * 2) * NUP : nullptr;
            if (s0 == 0) {
#pragma unroll
                for (int j = 0; j < 8; ++j) { a2[j] = 0.f; a1[j] = 0.f; b2[j] = 0.f; b1[j] = 0.f; } }
            else { unpack8(*(const u32x4*)(U + (row0 - 2) * NUP + ua0), a2); unpack8(*(const u32x4*)(U + (row0 - 1) * NUP + ua0), a1);
                   unpack8(*(const u32x4*)(U + (row0 - 2) * NUP + ub0), b2); unpack8(*(const u32x4*)(U + (row0 - 1) * NUP + ub0), b1); } }
        else { const int bs = run - MP / 64; row0 = (size_t)MP + bs * 4; nrows = 4;
            cout = outp + O_CONVS + ((size_t)(layer * NBS + bs) * 2) * NUP;
            const float* st = P.in[8] + ((size_t)(layer * NBS + bs) * 2) * NUP;
            load8(st + j0, a2); load8(st + NUP + j0, a1); load8(st + DFF + j0, b2); load8(st + NUP + DFF + j0, b1); }
        for (int t = 0; t < nrows; t += 4) {
            u32x4 ua[4], ub[4];
#pragma unroll
            for (int q = 0; q < 4; ++q) { ua[q] = *(const u32x4*)(U + (row0 + t + q) * NUP + ua0); ub[q] = *(const u32x4*)(U + (row0 + t + q) * NUP + ub0); }
#pragma unroll
            for (int q = 0; q < 4; ++q) {
                float a0[8], b0[8];
                unpack8(ua[q], a0); unpack8(ub[q], b0);
                float z[8];
#pragma unroll
                for (int j = 0; j < 8; ++j) { const float ca = ba[j] + wa[0][j] * a2[j] + wa[1][j] * a1[j] + wa[2][j] * a0[j]; const float cb = bb[j] + wb[0][j] * b2[j] + wb[1][j] * b1[j] + wb[2][j] * b0[j];
                    z[j] = ca / (1.f + fexp(-ca)) * cb; a2[j] = a1[j]; a1[j] = a0[j]; b2[j] = b1[j]; b1[j] = b0[j]; }
                u32x4 o; o.x = pk2(z[0], z[1]); o.y = pk2(z[2], z[3]); o.z = pk2(z[4], z[5]); o.w = pk2(z[6], z[7]);
                *(u32x4*)(Z + (row0 + t + q) * DFF + j0) = o;
            }
        }
        if (cout) { store8(cout + j0, a2); store8(cout + NUP + j0, a1); store8(cout + DFF + j0, b2); store8(cout + NUP + DFF + j0, b1); }
    }
}

#ifndef REP_STORE
#define REP_STORE 1
#endif
#ifndef REP_CONV
#define REP_CONV 1
#endif
#ifndef REP_ML
#define REP_ML 1
#endif
#ifndef REP_ATT
#define REP_ATT 1
#endif
#ifndef REP_RESID
#define REP_RESID 1
#endif
#ifndef REP_FIN
#define REP_FIN 1
#endif
#ifndef REP_CS
#define REP_CS 1
#endif
#ifndef REP_MR
#define REP_MR 1
#endif
#ifndef REP_P0
#define REP_P0 1
#endif
#define REPEAT(n, body) do { body; if ((n) > 1) { body; } if ((n) > 2) { body; } } while (0)
__global__ void __launch_bounds__(NTHR, 2) fwd_kernel(Params P) {
    extern __shared__ __attribute__((aligned(16))) unsigned char lds_raw[];
    LAS unsigned char* lds = (LAS unsigned char*)lds_raw;
    const unsigned lds_base = (unsigned)(size_t)lds;
    const int tid0 = threadIdx.x;
    const int G0 = gridDim.x, bx0 = blockIdx.x;
#define PHASE_IDS int tid = tid0; asm volatile("" : "+v"(tid)); int zz_ = 0; asm volatile("" : "+v"(zz_)); zz_ = __builtin_amdgcn_readfirstlane(zz_); const int bx = bx0 + zz_, G = G0 + zz_; unsigned char* ws = P.ws + zz_; float* outp = P.out + zz_; \
    const int lane = tid & 63, wave = __builtin_amdgcn_readfirstlane(tid >> 6); const int gw = bx * NWAVES + wave, gtid = bx * NTHR + tid, NGW = G * NWAVES, NGT = G * NTHR; (void)gw; (void)gtid; (void)lane; (void)NGW; (void)NGT; (void)outp; \
    bf16_t* XB = (bf16_t*)(ws + WS_XB); float* SSQ = (float*)(ws + WS_SSQ); float* SSQS = (float*)(ws + WS_SSQS); bf16_t* QKV = (bf16_t*)(ws + WS_QKV); bf16_t* OG = (bf16_t*)(ws + WS_OG); float* LSE = (float*)(ws + WS_LSE); bf16_t* OC = (bf16_t*)(ws + WS_OC); \
    float* GATES = (float*)(ws + WS_GATES); bf16_t* U = (bf16_t*)(ws + WS_U); bf16_t* Z = (bf16_t*)(ws + WS_Z); (void)XB; (void)SSQ; (void)SSQS; (void)QKV; (void)OG; (void)LSE; (void)OC; (void)GATES; (void)U; (void)Z;
    volatile LAS unsigned* misc = (volatile LAS unsigned*)(lds + LDS_MISC_OFF);
    if (tid0 < 16) misc[tid0] = 0u;
    __syncthreads();
    { const XcdBarrier bar0 = xcd_barrier_post((unsigned*)(P.ws + WS_CTL) + 1024, misc + 8); if (tid0 == 0) misc[10] = bar0.x; }
    __syncthreads();
#define GRID_BAR() do { XcdBarrier bar_; bar_.bar = (unsigned*)(P.ws + WS_CTL) + 1024; bar_.x = (unsigned)__builtin_amdgcn_readfirstlane((int)misc[10]); bar_.st = misc + 8; xcd_barrier(bar_); } while (0)
#define GEMM_STORE(Abuf, Wt, NN, KK, Obuf) REPEAT(REP_STORE, GEMM_STORE1(Abuf, Wt, NN, KK, Obuf))
#define GEMM_STORE1(Abuf, Wt, NN, KK, Obuf) do { PHASE_IDS; \
        { pg8::Gemm g{Abuf, (const bf16_t*)(Wt), MP, NN, KK}; pg8::StaticOrder S; S.init(MP, NN, G, bx); const int pm0_ = pg8::first_pm(S); LAS float* rtab_ = (LAS float*)(lds + RING_BYTES); pg8::rstd_panel(rtab_, SSQ, pm0_, EPS, tid); pg8::EpiStoreN E{Obuf, NN, SSQ, EPS, rtab_, pm0_}; \
          pg8::gemm_phase<pg8::EpiStoreN, pg8::StaticOrder, true, true>(lds, g, S, E); } \
        skinny_phase<0>(lds, Abuf + (size_t)MP * KK, KK, (const bf16_t*)(Wt), NN, Obuf + (size_t)MP * NN, NN, nullptr, SSQS, nullptr, bx, G, (((MP / 256) * ((NN) / 256)) % G) ? G - (((MP / 256) * ((NN) / 256)) % G) : G, tid, wave, lane); } while (0)
#define GEMM_RESID(Abuf, Wt, KK, FIN) do { PHASE_IDS; \
        { pg8::Gemm g{Abuf, (const bf16_t*)(Wt), MP, DM, KK}; pg8::StaticOrder S; S.init(MP, DM, G, bx); pg8::EpiResidN E{XB, (FIN) ? outp : nullptr, (FIN) ? nullptr : SSQ, DM}; \
          pg8::gemm_phase<pg8::EpiResidN, pg8::StaticOrder, true, true>(lds, g, S, E); } \
        if (FIN) skinny_phase<2>(lds, Abuf + (size_t)MP * KK, KK, (const bf16_t*)(Wt), DM, nullptr, 0, XB + (size_t)MP * DM, nullptr, outp + (size_t)MP * DM, bx, G, G, tid, wave, lane); \
        else skinny_phase<1>(lds, Abuf + (size_t)MP * KK, KK, (const bf16_t*)(Wt), DM, nullptr, 0, XB + (size_t)MP * DM, SSQS, nullptr, bx, G, G, tid, wave, lane); } while (0)

    REPEAT(REP_P0, { PHASE_IDS; phase_prologue(P, lds, gw, NGW, wave, lane); });
    GRID_BAR();

#define FFN(L, FIN) do { \
        { PHASE_IDS; unsigned* ctl_ = (unsigned*)(ws + WS_CTL); \
          skinny_up(lds, P.in[8], P.in[20] + (size_t)(L) * 3 * NUP, P.in[21] + (size_t)(L) * NUP, XB, (const bf16_t*)(ws + WS_WUP + (L) * SZ_WUP), SSQ, SSQS, (float*)(ws + WS_HALO), ctl_ + CW_HCNT, Z, outp, (L), bx, G, 128, tid, wave, lane); \
          { pg8::Gemm g{XB, (const bf16_t*)(ws + WS_WUP + (L) * SZ_WUP), MP, NUP, DM}; pg8::StaticOrder S; S.init(MP, NUP, G, bx); const int pm0_ = pg8::first_pm(S); \
            LAS float* rtab_ = (LAS float*)(lds + RING_BYTES); volatile LAS unsigned* rdy_ = (volatile LAS unsigned*)(lds + RING_BYTES + 1024 + 8192); if (tid == 0) rdy_[0] = 0u; pg8::rstd_panel(rtab_, SSQ, pm0_, EPS, tid); \
            pg8::EpiConv E{ws, P.in[20] + (size_t)(L) * 3 * NUP, P.in[21] + (size_t)(L) * NUP, lds + RING_BYTES, (unsigned)((L) + 1) * (unsigned)(SU_NITEMS * 4), pm0_}; \
            pg8::gemm_phase<pg8::EpiConv, pg8::StaticOrder, true, true>(lds, g, S, E); } } \
        GRID_BAR(); \
        GEMM_RESID(Z, ws + WS_WDOWN + (L) * SZ_WDOWN, DFF, FIN); \
    } while (0)

#define LAYER_PAIR(lp) do { \
        { \
            const int ia = (lp); \
            GEMM_STORE(XB, ws + WS_WQKV + ia * SZ_WQKV, NQKV, DM, QKV); \
            GRID_BAR(); \
            REPEAT(REP_ATT, { PHASE_IDS; attn_phase(lds, lds_base, QKV, (const float*)(ws + WS_ROPE), P.in[12] + ia * 128, P.in[13] + ia * 128, outp, ia, OG, LSE, bx, G, 1536, tid, wave, lane); } \
            { PHASE_IDS; for (int wt = bx + G * wave; wt < NBS * 96; wt += G * NWAVES) attn_sample_task(lds + wave * 4096, QKV, (const float*)(ws + WS_ROPE), P.in[12] + ia * 128, P.in[13] + ia * 128, outp, P.in[2], P.in[3], P.in[4], OG, LSE, ia, wt, lane); __syncthreads(); }); \
            GRID_BAR(); \
            REPEAT(REP_ATT, { PHASE_IDS; for (int r = gw; r < MR; r += NGW) combine_row(OG, LSE, OC, r, lane); }); \
            GRID_BAR(); \
            GEMM_RESID(OC, ws + WS_WO + ia * SZ_WO, DO, false); \
            GRID_BAR(); \
            FFN(2 * (lp), false); \
            GRID_BAR(); \
        } \
        { \
            const int L = 2 * (lp) + 1, ib = (lp); \
            GEMM_STORE(XB, ws + WS_WIN + ib * SZ_WIN, NIN, DM, QKV); \
            { PHASE_IDS; for (int task = G - 1 - bx; task < MR / 16; task += G) gate_block(lds, XB, (const f32x4*)(ws + WS_WGP) + (size_t)ib * 128 * 64, P.in[16] + ib * 16, GATES, task, wave, lane); } \
            GRID_BAR(); \
            REPEAT(REP_ML, { PHASE_IDS; \
            if (bx < 128) { mlstm_prompt(lds, lds_base, QKV, GATES, OG, (float*)(ws + WS_SQ), outp, ib, bx, tid, wave, lane); if (REP_MR > 1) { __syncthreads(); mlstm_prompt(lds, lds_base, QKV, GATES, OG, (float*)(ws + WS_SQ), outp, ib, bx, tid, wave, lane); } } \
            else { if (bx < 192) mlstm_sample(lds, QKV, GATES, P.in[17] + (size_t)ib * DM, P.in[5], P.in[6], P.in[7], OC, outp, ib, bx - 128, tid, wave, lane); \
                   cache_shift(P, outp, (lp), (bx - 128) * NWAVES + wave, (G - 128) * NWAVES, lane); } }); \
            GRID_BAR(); \
            REPEAT(REP_FIN, { PHASE_IDS; for (int r = gw; r < MP; r += NGW) hn_row(OG, (const float*)(ws + WS_SQ), QKV, P.in[17] + (size_t)ib * DM, OC, r, lane); }); \
            GRID_BAR(); \
            GEMM_RESID(OC, ws + WS_WOUT + ib * SZ_WOUT, DM, false); \
            GRID_BAR(); \
            FFN(L, (L == DEPTH - 1)); \
            if ((lp) == 0) GRID_BAR(); \
        } \
    } while (0)
    LAYER_PAIR(0);
    LAYER_PAIR(1);
}

extern "C" void kernel_launch(void* const* d_in, const int* in_sizes, int n_in, void* d_out, int out_size, void* d_ws, size_t ws_size, hipStream_t stream) {
    static int grid = 0;
    if (grid == 0) {
        if (n_in != 23 || (size_t)out_size != O_END || ws_size < WS_END) {
            fprintf(stderr, "kernel_launch: built for 23 inputs, %zu outputs, >= %zu bytes of workspace; got n_in %d, out %d, ws %zu; nothing launched\n", (size_t)O_END, (size_t)WS_END, n_in, out_size, ws_size);
            grid = -1; return; }
        int dev = 0, cus = 0, per_cu = 0;
        if (hipGetDevice(&dev) != hipSuccess || hipDeviceGetAttribute(&cus, hipDeviceAttributeMultiprocessorCount, dev) != hipSuccess) { fprintf(stderr, "kernel_launch: device query failed\n"); grid = -1; return; }
        if (hipFuncSetAttribute((const void*)fwd_kernel, hipFuncAttributeMaxDynamicSharedMemorySize, LDS_BYTES) != hipSuccess) { fprintf(stderr, "kernel_launch: hipFuncSetAttribute failed\n"); grid = -1; return; }
        if (hipOccupancyMaxActiveBlocksPerMultiprocessor(&per_cu, (const void*)fwd_kernel, NTHR, LDS_BYTES) != hipSuccess || per_cu < 1)
            fprintf(stderr, "kernel_launch: occupancy query reports %d workgroups per CU\n", per_cu);
        (void)hipGetLastError();
        grid = cus;
    }
    if (grid < 0) return;
    (void)hipMemsetAsync((char*)d_ws + WS_CTL, 0, CTL_ZERO_BYTES, stream);
    Params p{};
    for (int i = 0; i < 23; ++i) p.in[i] = (const float*)d_in[i];
    p.out = (float*)d_out; p.ws = (unsigned char*)d_ws;
    hipLaunchKernelGGL(fwd_kernel, dim3(grid), dim3(NTHR), LDS_BYTES, stream, p);
    const hipError_t le = hipPeekAtLastError();
    if (le != hipSuccess) fprintf(stderr, "kernel_launch: launch failed: %s\n", hipGetErrorName(le));
}
```

```cpp
#include <hip/hip_runtime.h>
#include <cstdio>
#include <cstdint>

#define LAS __attribute__((address_space(3)))
typedef unsigned short bf16_t;
typedef short bf16x8 __attribute__((ext_vector_type(8)));
typedef float f32x4 __attribute__((ext_vector_type(4)));
typedef float f32x2 __attribute__((ext_vector_type(2)));
typedef unsigned u32x4 __attribute__((ext_vector_type(4)));
typedef unsigned u32x2 __attribute__((ext_vector_type(2)));
typedef unsigned short u16x4 __attribute__((ext_vector_type(4)));

constexpr int DM = 2048, SEQ = 2048, NBP = 4, NBS = 8, TSAMP = 4, PAST = 16384;
constexpr int MP = NBP * SEQ, MSAMP = NBS * TSAMP, MR = MP + MSAMP, MT = 8448;
constexpr int NQKV = 9216, NIN = 6144, NIN_SRC = 6160, DFF = 5632, NUP = 2 * DFF, DO = 1024;
constexpr int DEPTH = 4;
constexpr float EPS = 1e-6f;
constexpr int NWAVES = 8, NTHR = 512;

constexpr size_t O_YP = 0;
constexpr size_t O_YS = O_YP + (size_t)MP * DM;
constexpr size_t O_KV128P = O_YS + (size_t)MSAMP * DM;
constexpr size_t O_KV128S = O_KV128P + (size_t)2 * NBP * 128 * 2048;
constexpr size_t O_KV512P = O_KV128S + (size_t)2 * NBS * 128 * 2048;
constexpr size_t O_KV512S = O_KV512P + (size_t)2 * NBP * 512 * 2048;
constexpr size_t O_KV2048P = O_KV512S + (size_t)2 * NBS * 512 * 2048;
constexpr size_t O_KV2048S = O_KV2048P + (size_t)2 * NBP * 2048 * 2048;
constexpr size_t O_CP = O_KV2048S + (size_t)2 * NBS * 2048 * 2048;
constexpr size_t O_CS = O_CP + (size_t)2 * NBP * 8 * 256 * 128;
constexpr size_t O_NP = O_CS + (size_t)2 * NBS * 8 * 256 * 128;
constexpr size_t O_NS = O_NP + (size_t)2 * NBP * 8 * 128;
constexpr size_t O_MP = O_NS + (size_t)2 * NBS * 8 * 128;
constexpr size_t O_MS = O_MP + (size_t)2 * NBP * 8;
constexpr size_t O_CONVP = O_MS + (size_t)2 * NBS * 8;
constexpr size_t O_CONVS = O_CONVP + (size_t)DEPTH * NBP * 2 * NUP;
constexpr size_t O_END = O_CONVS + (size_t)DEPTH * NBS * 2 * NUP;

constexpr size_t al1m(size_t x) { return (x + 1048575) & ~(size_t)1048575; }
constexpr size_t WS_CTL = 0, CTL_ZERO_BYTES = 1048576;
constexpr size_t SZ_WQKV = (size_t)NQKV * DM * 2, SZ_WO = (size_t)DM * DO * 2, SZ_WIN = (size_t)NIN * DM * 2, SZ_WOUT = (size_t)DM * DM * 2, SZ_WUP = (size_t)NUP * DM * 2, SZ_WDOWN = (size_t)DM * DFF * 2;
constexpr size_t WS_WQKV = al1m(WS_CTL + CTL_ZERO_BYTES);
constexpr size_t WS_WO = al1m(WS_WQKV + 2 * SZ_WQKV);
constexpr size_t WS_WIN = al1m(WS_WO + 2 * SZ_WO);
constexpr size_t WS_WOUT = al1m(WS_WIN + 2 * SZ_WIN);
constexpr size_t WS_WUP = al1m(WS_WOUT + 2 * SZ_WOUT);
constexpr size_t WS_WDOWN = al1m(WS_WUP + 4 * SZ_WUP);
constexpr size_t WS_X = al1m(WS_WDOWN + 4 * SZ_WDOWN);
constexpr size_t WS_XB = al1m(WS_X + (size_t)MT * DM * 4);
constexpr size_t WS_SSQ = al1m(WS_XB + (size_t)MT * DM * 2);
constexpr size_t WS_SSQS = al1m(WS_SSQ + (size_t)MP * 32 * 4);
constexpr size_t WS_QKV = al1m(WS_SSQS + (size_t)MSAMP * 128 * 4);
constexpr size_t WS_OG = al1m(WS_QKV + (size_t)MT * NQKV * 2);
constexpr size_t WS_LSE = al1m(WS_OG + (size_t)MT * 3072 * 2);
constexpr size_t WS_OC = al1m(WS_LSE + (size_t)MT * 24 * 4);
constexpr size_t WS_GATES = al1m(WS_OC + (size_t)MT * DM * 2);
constexpr size_t WS_U = al1m(WS_GATES + (size_t)MT * 16 * 4);
constexpr size_t WS_Z = al1m(WS_U + (size_t)MT * NUP * 2);
constexpr size_t WS_SQ = al1m(WS_Z + (size_t)MT * DFF * 2);
constexpr size_t WS_ROPE = al1m(WS_SQ + (size_t)MP * 128 * 4);
constexpr size_t WS_WGP = al1m(WS_ROPE + (size_t)2052 * 128 * 4);
constexpr size_t WS_HALO = al1m(WS_WGP + (size_t)2 * 128 * 64 * 16);
constexpr size_t WS_END = al1m(WS_HALO + (size_t)64 * NUP * 4);
constexpr int CW_HCNT = 65536, CW_TMO = 65600, CW_CSQ = 65664;

constexpr int RING_BYTES = 131072;
constexpr int LDS_MISC_OFF = 150 * 1024;
constexpr int LDS_BYTES = 152 * 1024;

__device__ __forceinline__ unsigned pk2(float lo, float hi) { unsigned r; asm("v_cvt_pk_bf16_f32 %0, %1, %2" : "=v"(r) : "v"(lo), "v"(hi)); return r; }
__device__ __forceinline__ unsigned f2bf(float f) { return pk2(f, 0.f) & 0xffffu; }
__device__ __forceinline__ float bflo(unsigned w) { return __builtin_bit_cast(float, w << 16); }
__device__ __forceinline__ float bfhi(unsigned w) { return __builtin_bit_cast(float, w & 0xffff0000u); }
__device__ __forceinline__ float bf1(bf16_t b) { return __builtin_bit_cast(float, (unsigned)b << 16); }
__device__ __forceinline__ float fexp(float x) { return __builtin_amdgcn_exp2f(x * 1.4426950408889634f); }
template <int CTRL> __device__ __forceinline__ float dpp_mov(float src) { return __builtin_bit_cast(float, __builtin_amdgcn_mov_dpp(__builtin_bit_cast(int, src), CTRL, 0xf, 0xf, false)); }
__device__ __forceinline__ float row4_sum(float v) { v += dpp_mov<0xB1>(v); v += dpp_mov<0x4E>(v); return v; }
__device__ __forceinline__ float row8_sum(float v) { v = row4_sum(v); v += dpp_mov<0x141>(v); return v; }
__device__ __forceinline__ float row16_sum(float v) { v = row8_sum(v); v += dpp_mov<0x140>(v); return v; }
#define LDS_BARRIER() do { asm volatile("s_waitcnt lgkmcnt(0)" ::: "memory"); __builtin_amdgcn_s_barrier(); asm volatile("" ::: "memory"); } while (0)
__device__ __forceinline__ float wave_sum(float v) {
#pragma unroll
    for (int o = 1; o < 64; o <<= 1) v += __shfl_xor(v, o);
    return v;
}
__device__ __forceinline__ float wave_max(float v) {
#pragma unroll
    for (int o = 1; o < 64; o <<= 1) v = fmaxf(v, __shfl_xor(v, o));
    return v;
}
__device__ __forceinline__ f32x4 mma16(bf16x8 a, bf16x8 b, f32x4 c) { return __builtin_amdgcn_mfma_f32_16x16x32_bf16(a, b, c, 0, 0, 0); }
__device__ __forceinline__ bf16x8 tr_read2(unsigned base, int off0, int off1) {
    u16x4 r0, r1;
    asm volatile("ds_read_b64_tr_b16 %0, %2 offset:%c3\n\tds_read_b64_tr_b16 %1, %2 offset:%c4\n\ts_waitcnt lgkmcnt(0)" : "=&v"(r0), "=&v"(r1) : "v"(base), "i"(off0), "i"(off1) : "memory");
    bf16x8 o; o[0] = (short)r0[0]; o[1] = (short)r0[1]; o[2] = (short)r0[2]; o[3] = (short)r0[3]; o[4] = (short)r1[0]; o[5] = (short)r1[1]; o[6] = (short)r1[2]; o[7] = (short)r1[3];
    return o;
}

__device__ __forceinline__ bf16x8 tr_join(u16x4 r0, u16x4 r1) { bf16x8 o; o[0] = (short)r0[0]; o[1] = (short)r0[1]; o[2] = (short)r0[2]; o[3] = (short)r0[3]; o[4] = (short)r1[0]; o[5] = (short)r1[1]; o[6] = (short)r1[2]; o[7] = (short)r1[3]; return o; }
#define TR_RD "ds_read_b64_tr_b16 "
#define TR_READ4(F0, F1, F2, F3, base, a0, a1, b0, b1, c0, c1, d0, d1) do { u16x4 t0_, t1_, t2_, t3_, t4_, t5_, t6_, t7_; \
    asm volatile(TR_RD "%0, %8 offset:%c9\n\t" TR_RD "%1, %8 offset:%c10\n\t" TR_RD "%2, %8 offset:%c11\n\t" TR_RD "%3, %8 offset:%c12\n\t" TR_RD "%4, %8 offset:%c13\n\t" TR_RD "%5, %8 offset:%c14\n\t" TR_RD "%6, %8 offset:%c15\n\t" TR_RD "%7, %8 offset:%c16\n\ts_waitcnt lgkmcnt(0)" \
        : "=&v"(t0_), "=&v"(t1_), "=&v"(t2_), "=&v"(t3_), "=&v"(t4_), "=&v"(t5_), "=&v"(t6_), "=&v"(t7_) : "v"(base), "i"(a0), "i"(a1), "i"(b0), "i"(b1), "i"(c0), "i"(c1), "i"(d0), "i"(d1) : "memory"); \
    F0 = tr_join(t0_, t1_); F1 = tr_join(t2_, t3_); F2 = tr_join(t4_, t5_); F3 = tr_join(t6_, t7_); } while (0)
#define TR_READ5(F0, F1, F2, F3, F4, base, a0, a1, b0, b1, c0, c1, d0, d1, e0, e1) do { u16x4 t0_, t1_, t2_, t3_, t4_, t5_, t6_, t7_, t8_, t9_; \
    asm volatile(TR_RD "%0, %10 offset:%c11\n\t" TR_RD "%1, %10 offset:%c12\n\t" TR_RD "%2, %10 offset:%c13\n\t" TR_RD "%3, %10 offset:%c14\n\t" TR_RD "%4, %10 offset:%c15\n\t" TR_RD "%5, %10 offset:%c16\n\t" TR_RD "%6, %10 offset:%c17\n\t" TR_RD "%7, %10 offset:%c18\n\t" TR_RD "%8, %10 offset:%c19\n\t" TR_RD "%9, %10 offset:%c20\n\ts_waitcnt lgkmcnt(0)" \
        : "=&v"(t0_), "=&v"(t1_), "=&v"(t2_), "=&v"(t3_), "=&v"(t4_), "=&v"(t5_), "=&v"(t6_), "=&v"(t7_), "=&v"(t8_), "=&v"(t9_) : "v"(base), "i"(a0), "i"(a1), "i"(b0), "i"(b1), "i"(c0), "i"(c1), "i"(d0), "i"(d1), "i"(e0), "i"(e1) : "memory"); \
    F0 = tr_join(t0_, t1_); F1 = tr_join(t2_, t3_); F2 = tr_join(t4_, t5_); F3 = tr_join(t6_, t7_); F4 = tr_join(t8_, t9_); } while (0)
__device__ __forceinline__ bf16x8 pack8(f32x4 a, f32x4 b) {
    u32x4 w; w.x = pk2(a[0], a[1]); w.y = pk2(a[2], a[3]); w.z = pk2(b[0], b[1]); w.w = pk2(b[2], b[3]);
    return __builtin_bit_cast(bf16x8, w);
}

namespace pg8 {
#define PG8_LAS __attribute__((address_space(3)))
typedef unsigned short bf16_t;
typedef short bf16x8 __attribute__((ext_vector_type(8)));
typedef float f32x4 __attribute__((ext_vector_type(4)));
typedef unsigned u32x4 __attribute__((ext_vector_type(4)));
constexpr int BM = 256, BK = 64, HALF = 128, HTB = HALF * BK * 2  , STAGE_BYTES = 8 * HTB, NXCD = 8, WGM = 8;

__host__ __device__ __forceinline__ int lds_byte(int r, int c) { const int st = (r >> 4) * 2 + (c >> 5), rr = r & 15, cc = c & 31, ob = rr * 64 + cc * 2; return st * 1024 + (ob ^ (((ob >> 9) & 1) << 5)); }
__host__ __device__ __forceinline__ void stage_rc(int b, int& R, int& C) { const int st = b / 1024, sb = b % 1024, swz = sb ^ (((sb >> 9) & 1) << 5); R = (st >> 1) * 16 + swz / 64; C = (st & 1) * 32 + (swz % 64) / 2; }
__host__ __device__ __forceinline__ int perm32(int rho) { const int n = rho >> 4, i = rho & 15; return 8 * (i >> 2) + 4 * n + (i & 3); }

struct Unit { int pm, pn; };
struct Gemm { const bf16_t* A; const bf16_t* Bt; int M, N, K; };

struct StaticOrder {
    int nM, nN, nwg, G, c;
    __host__ __device__ void init(int M, int N, int G_, int c_) { nM = M / BM; nN = N / BM; nwg = nM * nN; G = G_; c = c_; }
    __host__ __device__ bool next(int i, Unit& u) const {
        const long L = (long)i * G + c; if (L >= nwg) return false;
        int wgid = (int)L; { const int q = nwg / NXCD, r = nwg % NXCD, xcd = wgid % NXCD, off = wgid / NXCD; wgid = (xcd < r ? xcd * (q + 1) : r * (q + 1) + (xcd - r) * q) + off; }
        const int nig = WGM * nN, gid = wgid / nig, fm = gid * WGM, gsz = (nM - fm) < WGM ? (nM - fm) : WGM;
        u.pm = fm + ((wgid % nig) % gsz); u.pn = (wgid % nig) / gsz; return true;
    }
    __device__ __forceinline__ void a_ready(const Unit&) const {}
    __device__ __forceinline__ void done(const Unit&) const {}
};
__device__ __forceinline__ unsigned cvt_pk_bf16(float lo, float hi) { unsigned r; asm volatile("v_cvt_pk_bf16_f32 %0, %1, %2" : "=v"(r) : "v"(lo), "v"(hi)); return r; }

struct EpiStore {
    static constexpr bool PERM = true, AFTER_DRAIN = false;
    bf16_t* O; int ldc;
    __device__ __forceinline__ void operator()(const f32x4 (&acc)[2][2][4][2], const Unit& u, int wr, int wc, int fr, int fq) const {
        const int row0 = u.pm * BM + wr * 64 + fr, col0 = u.pn * BM + wc * 32 + 8 * fq;
#pragma unroll
        for (int ai = 0; ai < 2; ++ai)
#pragma unroll
            for (int m = 0; m < 4; ++m) { bf16_t* rowp = O + (size_t)(row0 + ai * HALF + m * 16) * ldc + col0;
#pragma unroll
                for (int bj = 0; bj < 2; ++bj) { const f32x4 v0 = acc[ai][bj][m][0], v1 = acc[ai][bj][m][1];
                    u32x4 w; w.x = cvt_pk_bf16(v0[0], v0[1]); w.y = cvt_pk_bf16(v0[2], v0[3]); w.z = cvt_pk_bf16(v1[0], v1[1]); w.w = cvt_pk_bf16(v1[2], v1[3]);
                    *(u32x4*)(rowp + bj * HALF) = w; } }
    }
};
struct EpiResid {
    static constexpr bool PERM = false, AFTER_DRAIN = false;
    const float* xin; float* out; int ldc; int mrows;
    __device__ __forceinline__ void operator()(const f32x4 (&acc)[2][2][4][2], const Unit& u, int wr, int wc, int fr, int fq) const {
        const int row0 = u.pm * BM + wr * 64 + fr, col0 = u.pn * BM + wc * 32 + 4 * fq;
#pragma unroll
        for (int ai = 0; ai < 2; ++ai)
#pragma unroll
            for (int m = 0; m < 4; ++m) { const int r = row0 + ai * HALF + m * 16;
                if (r < mrows) { const size_t off = (size_t)r * ldc + col0;
#pragma unroll
                    for (int bj = 0; bj < 2; ++bj)
#pragma unroll
                        for (int n = 0; n < 2; ++n) { const f32x4 bs = *(const f32x4*)(xin + off + bj * HALF + n * 16); *(f32x4*)(out + off + bj * HALF + n * 16) = bs + acc[ai][bj][m][n]; } }
                asm volatile("" ::: "memory"); }
    }
};


struct EpiStoreN {
    static constexpr bool PERM = true, AFTER_DRAIN = false;
    bf16_t* O; int ldc; const float* ssq; float eps; const PG8_LAS float* rs_tab; int rs_pm;
    __device__ __forceinline__ void operator()(const f32x4 (&acc)[2][2][4][2], const Unit& u, int wr, int wc, int fr, int fq) const {
        const int row0 = u.pm * BM + wr * 64 + fr, col0 = u.pn * BM + wc * 32 + 8 * fq;
        const bool cached = (u.pm == rs_pm);
#pragma unroll
        for (int ai = 0; ai < 2; ++ai)
#pragma unroll
            for (int m = 0; m < 4; ++m) { const int r = row0 + ai * HALF + m * 16;
                float rs;
                if (cached) rs = rs_tab[wr * 64 + fr + ai * HALF + m * 16];
                else { const f32x4 p0 = *(const f32x4*)(ssq + (size_t)r * 32 + 8 * fq), p1 = *(const f32x4*)(ssq + (size_t)r * 32 + 8 * fq + 4);
                    float s = ((p0[0] + p0[1]) + (p0[2] + p0[3])) + ((p1[0] + p1[1]) + (p1[2] + p1[3]));
                    s += __shfl_xor(s, 16); s += __shfl_xor(s, 32);
                    rs = rsqrtf(s * (1.f / 2048.f) + eps); }
                bf16_t* rowp = O + (size_t)r * ldc + col0;
#pragma unroll
                for (int bj = 0; bj < 2; ++bj) { const f32x4 v0 = acc[ai][bj][m][0] * rs, v1 = acc[ai][bj][m][1] * rs;
                    u32x4 w; w.x = cvt_pk_bf16(v0[0], v0[1]); w.y = cvt_pk_bf16(v0[2], v0[3]); w.z = cvt_pk_bf16(v1[0], v1[1]); w.w = cvt_pk_bf16(v1[2], v1[3]);
                    *(u32x4*)(rowp + bj * HALF) = w; } }
    }
};
__device__ __forceinline__ int first_pm(const StaticOrder& S) { const int wg0 = S.c; const int q = S.nwg / NXCD, r = S.nwg % NXCD, xcd = wg0 % NXCD, off = wg0 / NXCD; const int wgid = (xcd < r ? xcd * (q + 1) : r * (q + 1) + (xcd - r) * q) + off;
    const int nig = WGM * S.nN, gid = wgid / nig, fm = gid * WGM, gsz = (S.nM - fm) < WGM ? (S.nM - fm) : WGM; return fm + ((wgid % nig) % gsz); }
__device__ __forceinline__ void rstd_panel(PG8_LAS float* tab, const float* ssq, int pm, float eps, int tid) {
    const int row = tid >> 1, hf = tid & 1; const float* q = ssq + (size_t)(pm * BM + row) * 32 + 16 * hf;
    const f32x4 a = *(const f32x4*)q, b = *(const f32x4*)(q + 4), c = *(const f32x4*)(q + 8), d = *(const f32x4*)(q + 12);
    float s = (((a[0] + a[1]) + (a[2] + a[3])) + ((b[0] + b[1]) + (b[2] + b[3]))) + (((c[0] + c[1]) + (c[2] + c[3])) + ((d[0] + d[1]) + (d[2] + d[3])));
    s += __shfl_xor(s, 1);
    if (hf == 0) tab[row] = rsqrtf(s * (1.f / 2048.f) + eps);
    __syncthreads();
}
struct EpiResidN {
    static constexpr bool PERM = true, AFTER_DRAIN = false;
    bf16_t* xb; float* fin; float* ssq; int ldc;
    __device__ __forceinline__ void operator()(const f32x4 (&acc)[2][2][4][2], const Unit& u, int wr, int wc, int fr, int fq) const {
        const int row0 = u.pm * BM + wr * 64 + fr, col0 = u.pn * BM + wc * 32 + 8 * fq;
#pragma unroll
        for (int ai = 0; ai < 2; ++ai)
#pragma unroll
            for (int m = 0; m < 4; ++m) { const int r = row0 + ai * HALF + m * 16; const size_t off = (size_t)r * ldc + col0; float sq = 0.f;
#pragma unroll
                for (int bj = 0; bj < 2; ++bj) { const u32x4 xw = *(const u32x4*)(xb + off + bj * HALF);
                    f32x4 v0 = acc[ai][bj][m][0], v1 = acc[ai][bj][m][1];
                    v0[0] += __builtin_bit_cast(float, xw.x << 16); v0[1] += __builtin_bit_cast(float, xw.x & 0xffff0000u); v0[2] += __builtin_bit_cast(float, xw.y << 16); v0[3] += __builtin_bit_cast(float, xw.y & 0xffff0000u);
                    v1[0] += __builtin_bit_cast(float, xw.z << 16); v1[1] += __builtin_bit_cast(float, xw.z & 0xffff0000u); v1[2] += __builtin_bit_cast(float, xw.w << 16); v1[3] += __builtin_bit_cast(float, xw.w & 0xffff0000u);
                    if (fin) { *(f32x4*)(fin + off + bj * HALF) = v0; *(f32x4*)(fin + off + bj * HALF + 4) = v1; }
                    else { u32x4 w; w.x = cvt_pk_bf16(v0[0], v0[1]); w.y = cvt_pk_bf16(v0[2], v0[3]); w.z = cvt_pk_bf16(v1[0], v1[1]); w.w = cvt_pk_bf16(v1[2], v1[3]); *(u32x4*)(xb + off + bj * HALF) = w; }
                    sq += ((v0[0] * v0[0] + v0[1] * v0[1]) + (v0[2] * v0[2] + v0[3] * v0[3])) + ((v1[0] * v1[0] + v1[1] * v1[1]) + (v1[2] * v1[2] + v1[3] * v1[3])); }
                if (ssq) { sq += __shfl_xor(sq, 16); sq += __shfl_xor(sq, 32); if (fq == 0) ssq[(size_t)r * 32 + u.pn * 4 + wc] = sq; }
                if (m == 3) asm volatile("" ::: "memory"); }
    }
};
template <int CTRL> __device__ __forceinline__ float dppf(float oldv, float src) {
    return __builtin_bit_cast(float, __builtin_amdgcn_update_dpp(__builtin_bit_cast(int, oldv), __builtin_bit_cast(int, src), CTRL, 0xf, 0xf, false)); }
template <int CTRL> __device__ __forceinline__ float dppr(float src) {
    return __builtin_bit_cast(float, __builtin_amdgcn_mov_dpp(__builtin_bit_cast(int, src), CTRL, 0xf, 0xf, false)); }
struct EpiConv {
    static constexpr bool PERM = true, AFTER_DRAIN = false;
    static constexpr size_t WS_Z_ = ::WS_Z, WS_SSQ_ = ::WS_SSQ, WS_HALO_ = ::WS_HALO; static constexpr int CW_HCNT_ = ::CW_HCNT, CW_TMO_ = ::CW_TMO;
    unsigned char* wsb; const float* cw; const float* cb; PG8_LAS unsigned char* ldsx; unsigned target; int rs_pm;
    __device__ __forceinline__ void operator()(f32x4 (&acc)[2][2][4][2], const Unit& u, int wr, int wc, int fr_in, int fq_in) const {
        int fr = fr_in, fq = fq_in; asm volatile("" : "+v"(fr), "+v"(fq));
        bf16_t* Z = (bf16_t*)(wsb + WS_Z_); const float* ssq = (const float*)(wsb + WS_SSQ_); const float* halo = (const float*)(wsb + WS_HALO_); const float eps = 1e-6f;
        unsigned* hcnt = (unsigned*)wsb + CW_HCNT_; unsigned* tmo = (unsigned*)wsb + CW_TMO_;
        const PG8_LAS float* rs_tab = (const PG8_LAS float*)ldsx; PG8_LAS f32x4* xch = (PG8_LAS f32x4*)(ldsx + 1024); volatile PG8_LAS unsigned* ready = (volatile PG8_LAS unsigned*)(ldsx + 1024 + 8192);
        const int row0 = u.pm * BM + wr * 64 + fr;
        const bool cached = (u.pm == rs_pm);
#pragma unroll
        for (int ai = 0; ai < 2; ++ai)
#pragma unroll
            for (int m = 0; m < 4; ++m) { const int r = row0 + ai * HALF + m * 16; float rs;
                if (cached) rs = rs_tab[wr * 64 + fr + ai * HALF + m * 16];
                else { const f32x4 p0 = *(const f32x4*)(ssq + (size_t)r * 32 + 8 * fq), p1 = *(const f32x4*)(ssq + (size_t)r * 32 + 8 * fq + 4);
                    float s = ((p0[0] + p0[1]) + (p0[2] + p0[3])) + ((p1[0] + p1[1]) + (p1[2] + p1[3]));
                    s += __shfl_xor(s, 16); s += __shfl_xor(s, 32); rs = rsqrtf(s * (1.f / 2048.f) + eps); }
#pragma unroll
                for (int bj = 0; bj < 2; ++bj) { acc[ai][bj][m][0] *= rs; acc[ai][bj][m][1] *= rs; } }
        f32x4 hal[2][2];
#pragma unroll
        for (int bj = 0; bj < 2; ++bj) { hal[bj][0] = (f32x4){0.f, 0.f, 0.f, 0.f}; hal[bj][1] = (f32x4){0.f, 0.f, 0.f, 0.f}; }
        if (wr == 0 && (u.pm & 7) != 0) {
            if (ready[0] == 0u) { unsigned spins = 0;
                while (__hip_atomic_load(hcnt, __ATOMIC_RELAXED, __HIP_MEMORY_SCOPE_AGENT) < target) { __builtin_amdgcn_s_sleep(2);
                    if (++spins > (1u << 20)) { __hip_atomic_store(tmo, 1u, __ATOMIC_RELAXED, __HIP_MEMORY_SCOPE_AGENT); break; } }
                ready[0] = 1u; }
            if (fr >= 14) { const unsigned long long* hp = (const unsigned long long*)(halo + (size_t)(2 * (u.pm - 1) + (fr - 14)) * 11264 + u.pn * 256 + wc * 32 + 8 * fq);
#pragma unroll
                for (int bj = 0; bj < 2; ++bj)
#pragma unroll
                    for (int n = 0; n < 2; ++n) { const unsigned long long lo = __hip_atomic_load(hp + bj * 64 + 2 * n, __ATOMIC_RELAXED, __HIP_MEMORY_SCOPE_AGENT), hi = __hip_atomic_load(hp + bj * 64 + 2 * n + 1, __ATOMIC_RELAXED, __HIP_MEMORY_SCOPE_AGENT);
                        hal[bj][n] = (f32x4){__builtin_bit_cast(float, (unsigned)lo), __builtin_bit_cast(float, (unsigned)(lo >> 32)), __builtin_bit_cast(float, (unsigned)hi), __builtin_bit_cast(float, (unsigned)(hi >> 32))}; } } }
        if (fr >= 14) {
#pragma unroll
            for (int ai = 0; ai < 2; ++ai)
#pragma unroll
                for (int bj = 0; bj < 2; ++bj)
#pragma unroll
                    for (int n = 0; n < 2; ++n) xch[(((((ai * 2 + wr) * 4 + wc) * 2 + (fr & 1)) * 4 + fq) * 4) + bj * 2 + n] = acc[ai][bj][3][n]; }
        asm volatile("s_waitcnt lgkmcnt(0)" ::: "memory"); __builtin_amdgcn_s_barrier(); asm volatile("" ::: "memory");
        const int jn0 = u.pn * 128 + wc * 32 + 8 * fq;
        u32x2 zk[2][4];
#pragma unroll
        for (int n = 0; n < 2; ++n) {
            const float* wp = cw + jn0 + 4 * n; const float* bp = cb + jn0 + 4 * n;
            const f32x4 wa0 = *(const f32x4*)wp, wa1 = *(const f32x4*)(wp + 11264), wa2 = *(const f32x4*)(wp + 2 * 11264), ba = *(const f32x4*)bp;
            const f32x4 wb0 = *(const f32x4*)(wp + 5632), wb1 = *(const f32x4*)(wp + 11264 + 5632), wb2 = *(const f32x4*)(wp + 2 * 11264 + 5632), bb = *(const f32x4*)(bp + 5632);
#pragma unroll
            for (int ai = 0; ai < 2; ++ai) {
                f32x4 pa, pb;
                if (ai == 0 && wr == 0) { pa = hal[0][n]; pb = hal[1][n]; }
                else { const int sai = wr ? ai : ai - 1, swr = wr ^ 1; const int xi = (((((sai * 2 + swr) * 4 + wc) * 2 + (fr & 1)) * 4 + fq) * 4) + n; pa = xch[xi]; pb = xch[xi + 2]; }
#pragma unroll
                for (int m = 0; m < 4; ++m) {
                    const f32x4 ca4 = acc[ai][0][m][n], cb4 = acc[ai][1][m][n]; float z[4];
#pragma unroll
                    for (int i = 0; i < 4; ++i) {
                        const float a1 = dppf<0x111>(dppr<0x121>(pa[i]), ca4[i]), a2 = dppf<0x112>(dppr<0x122>(pa[i]), ca4[i]);
                        const float b1 = dppf<0x111>(dppr<0x121>(pb[i]), cb4[i]), b2 = dppf<0x112>(dppr<0x122>(pb[i]), cb4[i]);
                        const float ca = ba[i] + wa0[i] * a2 + wa1[i] * a1 + wa2[i] * ca4[i];
                        const float cbv = bb[i] + wb0[i] * b2 + wb1[i] * b1 + wb2[i] * cb4[i];
                        z[i] = ca * __builtin_amdgcn_rcpf(1.f + __builtin_amdgcn_exp2f(ca * -1.4426950408889634f)) * cbv; }
                    u32x2 w; w.x = cvt_pk_bf16(z[0], z[1]); w.y = cvt_pk_bf16(z[2], z[3]);
                    if (n == 0) zk[ai][m] = w;
                    else { u32x4 w4; w4.x = zk[ai][m].x; w4.y = zk[ai][m].y; w4.z = w.x; w4.w = w.y; *(u32x4*)(Z + (size_t)(row0 + ai * HALF + m * 16) * 5632 + jn0) = w4; }
                    pa = ca4; pb = cb4; }
            }
        }
    }
};

struct EpiNull {
    static constexpr bool PERM = true, AFTER_DRAIN = false;
    float* sink;
    __device__ __forceinline__ void operator()(const f32x4 (&acc)[2][2][4][2], const Unit& u, int wr, int wc, int fr, int fq) const {
        f32x4 s = {0.f, 0.f, 0.f, 0.f};
#pragma unroll
        for (int a = 0; a < 2; ++a)
#pragma unroll
            for (int b = 0; b < 2; ++b)
#pragma unroll
                for (int m = 0; m < 4; ++m) { s += acc[a][b][m][0]; s += acc[a][b][m][1]; }
        const float t = (s[0] + s[1]) + (s[2] + s[3]);
        if (t == 1.2345678e33f) sink[fr] = t;
    }
};
template <class Epi, class Sched, bool ALIGN_EPI = false, bool SP2 = false>
__device__ __forceinline__ void gemm_phase(PG8_LAS unsigned char* lds, const Gemm g, const Sched& S, const Epi& E) {
    int tid = threadIdx.x; asm volatile("" : "+v"(tid));
    const int wid = __builtin_amdgcn_readfirstlane(tid >> 6), lane = tid & 63, wr = wid >> 2, wc = wid & 3, fr = lane & 15, fq = lane >> 4;
    const int K = g.K, nt = K / BK;
    unsigned voffA[2], voffB[2];
#pragma unroll
    for (int i = 0; i < 2; ++i) { int R, C; stage_rc(tid * 16 + i * 8192, R, C); const int Rb = Epi::PERM ? ((R & ~31) + perm32(R & 31)) : R;
        voffA[i] = (unsigned)(R * K + C) * 2u; voffB[i] = (unsigned)(Rb * K + C) * 2u; }
    const size_t kstep = (size_t)(BK * 2);
    const size_t hstep = (size_t)HALF * K * 2;
    const size_t tstep = 2 * hstep;
    const unsigned ldsw = (unsigned)wid * 1024u;
    const int aoff = lds_byte(wr * 64 + fr, fq * 8), boff = lds_byte(wc * 32 + fr, fq * 8);
#define PG8_SA(b, h) (((b) * 2 + (h)) * HTB)
#define PG8_SB(b, h) ((4 + (b) * 2 + (h)) * HTB)
#define PG8_STAGE(bufoff, gbase, voff) do { _Pragma("unroll") for (int _i = 0; _i < 2; ++_i) \
        __builtin_amdgcn_global_load_lds((const unsigned*)((const char*)(gbase) + (voff)[_i]), (PG8_LAS unsigned*)(lds + (bufoff) + ldsw + _i * 8192), 16, 0, 0); } while (0)
#define PG8_LDA(dst, b, h) do { _Pragma("unroll") for (int m = 0; m < 4; ++m) _Pragma("unroll") for (int k = 0; k < 2; ++k) dst[m][k] = *(const PG8_LAS bf16x8*)(lds + PG8_SA(b, h) + aoff + m * 2048 + k * 1024); } while (0)
#define PG8_LDB(dst, b, h) do { _Pragma("unroll") for (int n = 0; n < 2; ++n) _Pragma("unroll") for (int k = 0; k < 2; ++k) dst[n][k] = *(const PG8_LAS bf16x8*)(lds + PG8_SB(b, h) + boff + n * 2048 + k * 1024); } while (0)
#define PG8_MMA(ai, bj, At, Bt) do { __builtin_amdgcn_s_setprio(1); _Pragma("unroll") for (int m = 0; m < 4; ++m) _Pragma("unroll") for (int n = 0; n < 2; ++n) _Pragma("unroll") for (int k = 0; k < 2; ++k) \
        acc[ai][bj][m][n] = __builtin_amdgcn_mfma_f32_16x16x32_bf16(Bt[n][k], At[m][k], acc[ai][bj][m][n], 0, 0, 0); __builtin_amdgcn_s_setprio(0); } while (0)
#define PG8_WAIT_V(n) asm volatile("s_waitcnt vmcnt(" #n ")" ::: "memory")
#define PG8_WAIT_L(n) asm volatile("s_waitcnt lgkmcnt(" #n ")" ::: "memory")
#define PG8_BAR __builtin_amdgcn_s_barrier()
#define PG8_SCHED __builtin_amdgcn_sched_barrier(0)
    Unit cur, nxt; int ui = 0;
    if (!S.next(0, cur)) return;
    f32x4 acc[2][2][4][2];
#pragma unroll
    for (int a = 0; a < 2; ++a)
#pragma unroll
        for (int b = 0; b < 2; ++b)
#pragma unroll
            for (int m = 0; m < 4; ++m)
#pragma unroll
                for (int n = 0; n < 2; ++n) acc[a][b][m][n] = (f32x4){0.f, 0.f, 0.f, 0.f};
    bf16x8 At[4][2], B0[2][2], B1[2][2];
    const char* cA = (const char*)g.A + (size_t)cur.pm * tstep; const char* cB = (const char*)g.Bt + (size_t)cur.pn * tstep;
    S.a_ready(cur);
    if constexpr (SP2) {
        PG8_STAGE(PG8_SB(0, 0), cB, voffB); PG8_STAGE(PG8_SB(0, 1), cB + hstep, voffB); PG8_STAGE(PG8_SA(0, 0), cA, voffA); PG8_STAGE(PG8_SA(0, 1), cA + hstep, voffA);
        if (wr == 1) PG8_BAR;
        PG8_WAIT_V(2); PG8_BAR;
        PG8_STAGE(PG8_SB(1, 0), cB + kstep, voffB); PG8_STAGE(PG8_SA(1, 0), cA + kstep, voffA); PG8_STAGE(PG8_SB(1, 1), cB + hstep + kstep, voffB);
        PG8_WAIT_V(6); PG8_BAR;
    } else {
        PG8_STAGE(PG8_SB(0, 0), cB, voffB); PG8_STAGE(PG8_SA(0, 0), cA, voffA); PG8_STAGE(PG8_SB(0, 1), cB + hstep, voffB); PG8_STAGE(PG8_SA(0, 1), cA + hstep, voffA);
        if (wr == 1) PG8_BAR;
        PG8_WAIT_V(4); PG8_BAR;
        PG8_STAGE(PG8_SB(1, 0), cB + kstep, voffB); PG8_STAGE(PG8_SA(1, 0), cA + kstep, voffA); PG8_STAGE(PG8_SB(1, 1), cB + hstep + kstep, voffB);
        PG8_WAIT_V(6); PG8_BAR;
    }
    for (;;) {
        const bool has_next = S.next(ui + 1, nxt);
        const char* nA = has_next ? (const char*)g.A + (size_t)nxt.pm * tstep : cA; const char* nB = has_next ? (const char*)g.Bt + (size_t)nxt.pn * tstep : cB;
        for (int t = 0; t < nt; t += 2) {
            const bool last = (t == nt - 2);
            const char* a1 = cA + (size_t)(t + 1) * kstep;
            const char* a2 = last ? nA : cA + (size_t)(t + 2) * kstep; const char* b2 = last ? nB : cB + (size_t)(t + 2) * kstep;
            const char* a3 = a2 + kstep; const char* b3 = b2 + kstep;
            if (last && has_next) S.a_ready(nxt);
            if constexpr (SP2) {
            PG8_LDB(B0, 0, 0); PG8_LDB(B1, 0, 1); PG8_SCHED; PG8_LDA(At, 0, 0); PG8_STAGE(PG8_SA(1, 1), a1 + hstep, voffA);
            PG8_WAIT_V(8); PG8_WAIT_L(0); PG8_BAR; PG8_MMA(0, 0, At, B0); PG8_MMA(0, 1, At, B1); PG8_BAR; PG8_SCHED;
            PG8_LDA(At, 0, 1); PG8_STAGE(PG8_SB(0, 0), b2, voffB); PG8_STAGE(PG8_SB(0, 1), b2 + hstep, voffB); PG8_STAGE(PG8_SA(0, 0), a2, voffA);
            PG8_WAIT_V(8); PG8_WAIT_L(0); PG8_BAR; PG8_MMA(1, 0, At, B0); PG8_MMA(1, 1, At, B1); PG8_BAR; PG8_SCHED;
            PG8_LDB(B0, 1, 0); PG8_LDB(B1, 1, 1); PG8_SCHED; PG8_LDA(At, 1, 0); PG8_STAGE(PG8_SA(0, 1), a2 + hstep, voffA);
            PG8_WAIT_V(8); PG8_WAIT_L(0); PG8_BAR; PG8_MMA(0, 0, At, B0); PG8_MMA(0, 1, At, B1); PG8_BAR; PG8_SCHED;
            PG8_LDA(At, 1, 1); PG8_STAGE(PG8_SB(1, 0), b3, voffB); PG8_STAGE(PG8_SB(1, 1), b3 + hstep, voffB); PG8_STAGE(PG8_SA(1, 0), a3, voffA);
            PG8_WAIT_V(8); PG8_WAIT_L(0); PG8_BAR; PG8_MMA(1, 0, At, B0); PG8_MMA(1, 1, At, B1); PG8_BAR; PG8_SCHED;
            } else {
            PG8_LDB(B0, 0, 0); PG8_SCHED; PG8_LDA(At, 0, 0); PG8_STAGE(PG8_SA(1, 1), a1 + hstep, voffA);
            PG8_WAIT_L(8); PG8_BAR; PG8_WAIT_L(0); PG8_MMA(0, 0, At, B0); PG8_BAR; PG8_SCHED;
            PG8_LDB(B1, 0, 1); PG8_STAGE(PG8_SB(0, 0), b2, voffB);
            PG8_BAR; PG8_WAIT_L(0); PG8_MMA(0, 1, At, B1); PG8_BAR;
            PG8_LDA(At, 0, 1); PG8_STAGE(PG8_SA(0, 0), a2, voffA);
            PG8_BAR; PG8_WAIT_L(0); PG8_MMA(1, 0, At, B0); PG8_BAR; PG8_SCHED;
            PG8_STAGE(PG8_SB(0, 1), b2 + hstep, voffB);
            PG8_WAIT_V(6); PG8_BAR; PG8_MMA(1, 1, At, B1); PG8_BAR;
            PG8_LDB(B0, 1, 0); PG8_SCHED; PG8_LDA(At, 1, 0); PG8_STAGE(PG8_SA(0, 1), a2 + hstep, voffA);
            PG8_WAIT_L(8); PG8_BAR; PG8_WAIT_L(0); PG8_MMA(0, 0, At, B0); PG8_BAR; PG8_SCHED;
            PG8_LDB(B1, 1, 1); PG8_STAGE(PG8_SB(1, 0), b3, voffB);
            PG8_BAR; PG8_WAIT_L(0); PG8_MMA(0, 1, At, B1); PG8_BAR;
            PG8_LDA(At, 1, 1); PG8_STAGE(PG8_SA(1, 0), a3, voffA);
            PG8_BAR; PG8_WAIT_L(0); PG8_MMA(1, 0, At, B0); PG8_BAR; PG8_SCHED;
            PG8_STAGE(PG8_SB(1, 1), b3 + hstep, voffB);
            PG8_WAIT_V(6); PG8_BAR; PG8_MMA(1, 1, At, B1); PG8_BAR;
            }
        }
        if constexpr (ALIGN_EPI) { if (wr == 0) PG8_BAR; }
        if constexpr (!Epi::AFTER_DRAIN) { E(acc, cur, wr, wc, fr, fq); S.done(cur); }
        if (!has_next) break;
#pragma unroll
        for (int a = 0; a < 2; ++a)
#pragma unroll
            for (int b = 0; b < 2; ++b)
#pragma unroll
                for (int m = 0; m < 4; ++m)
#pragma unroll
                    for (int n = 0; n < 2; ++n) acc[a][b][m][n] = (f32x4){0.f, 0.f, 0.f, 0.f};
        cur = nxt; cA = nA; cB = nB; ++ui;
        if constexpr (ALIGN_EPI) { if (wr == 1) PG8_BAR; }
    }
    PG8_WAIT_V(0);
    if constexpr (!ALIGN_EPI) { if (wr == 0) PG8_BAR; }
    PG8_BAR;
    if constexpr (Epi::AFTER_DRAIN) { E.fused(acc, cur, wr, wc, fr, fq, lds, wid, lane); S.done(cur); }
#undef PG8_SA
#undef PG8_SB
#undef PG8_STAGE
#undef PG8_LDA
#undef PG8_LDB
#undef PG8_MMA
#undef PG8_WAIT_V
#undef PG8_WAIT_L
#undef PG8_BAR
#undef PG8_SCHED
}
}
#define XB_TMO      128
#define XB_XCNT(j)  (256  + 64 * (j))
#define XB_XSUB(j)  (1280 + 64 * (j))
#define XB_XGEN(j)  (2304 + 64 * (j))
#define XB_TOP      3328
#define XB_TOPGEN   3392
#define XCD_BAR_WORDS 3456
#define XB_SPIN_CAP (1u << 18)

__device__ __forceinline__ unsigned xb_ld(unsigned* p)              { return __hip_atomic_load(p, __ATOMIC_RELAXED, __HIP_MEMORY_SCOPE_AGENT); }
__device__ __forceinline__ unsigned xb_add(unsigned* p, unsigned v) { return __hip_atomic_fetch_add(p, v, __ATOMIC_RELAXED, __HIP_MEMORY_SCOPE_AGENT); }
__device__ __forceinline__ unsigned xb_xcc_id() { return (unsigned)__builtin_amdgcn_s_getreg((3 << 11) | 20) & 0xFu; }
#define XB_SPIN(cond, bar) do { unsigned _sp = 0; while (cond) { __builtin_amdgcn_s_sleep(1); \
    if ((++_sp & 255u) == 0u) { if (xb_ld(&(bar)[XB_TMO])) break; if (_sp > XB_SPIN_CAP) { atomicAdd(&(bar)[XB_TMO], 1u); break; } } } } while (0)

struct XcdBarrier {
    unsigned* bar; unsigned x;
    volatile LAS unsigned* st;
};

__device__ __forceinline__ XcdBarrier xcd_barrier_post(unsigned* bar, volatile LAS unsigned* st) {
    XcdBarrier b; b.bar = bar; b.x = xb_xcc_id(); b.st = st;
    if (threadIdx.x == 0) (void)xb_add(&bar[XB_XCNT(b.x)], 1u);
    return b;
}
__device__ __forceinline__ void xcd_barrier_complete(unsigned* bar, unsigned x, unsigned& nloc, unsigned& nx) {
    const unsigned G = gridDim.x * gridDim.y * gridDim.z;
    unsigned sum, cnt, mine, sp = 0u;
    for (;;) {
        sum = 0u; cnt = 0u; mine = 0u;
#pragma unroll
        for (unsigned j = 0; j < 16; ++j) { const unsigned c = xb_ld(&bar[XB_XCNT(j)]); sum += c; cnt += (c > 0u) ? 1u : 0u; mine = (j == x) ? c : mine; }
        if (sum == G) break;
        __builtin_amdgcn_s_sleep(1);
        if ((++sp & 255u) == 0u) { if (xb_ld(&bar[XB_TMO])) break; if (sp > XB_SPIN_CAP) { atomicAdd(&bar[XB_TMO], 1u); break; } }
    }
    nloc = mine > 0u ? mine : 1u; nx = cnt > 0u ? cnt : 1u;
}

__device__ __forceinline__ void xcd_barrier(const XcdBarrier& b) {
    asm volatile("s_waitcnt vmcnt(0)" ::: "memory");
    __syncthreads();
    if (threadIdx.x == 0) {
        unsigned* bar = b.bar;
        __builtin_amdgcn_s_waitcnt(0);
        unsigned nloc = b.st[0], nx = b.st[1];
        if (nloc == 0u) { xcd_barrier_complete(bar, b.x, nloc, nx); b.st[0] = nloc; b.st[1] = nx; }
        const unsigned old = xb_add(&bar[XB_XSUB(b.x)], 1u);
        const unsigned gen = old / nloc;
        if (old + 1u == (gen + 1u) * nloc) {
            __builtin_amdgcn_fence(__ATOMIC_RELEASE, "agent");
            asm volatile("s_waitcnt vmcnt(0)" ::: "memory");
            const unsigned og = xb_add(&bar[XB_TOP], 1u);
            const unsigned tg = og / nx;
            if (og + 1u == (tg + 1u) * nx) xb_add(&bar[XB_TOPGEN], 1u);
            else XB_SPIN(xb_ld(&bar[XB_TOPGEN]) == tg, bar);
            __builtin_amdgcn_fence(__ATOMIC_ACQUIRE, "agent");
            xb_add(&bar[XB_XGEN(b.x)], 1u);
            asm volatile("s_waitcnt vmcnt(0)" ::: "memory");
        } else {
            XB_SPIN(xb_ld(&bar[XB_XGEN(b.x)]) == gen, bar);
            __builtin_amdgcn_fence(__ATOMIC_ACQUIRE, "agent");
            asm volatile("s_waitcnt vmcnt(0)" ::: "memory");
        }
    }
    __syncthreads();
}

struct Params { const float* in[23]; float* out; unsigned char* ws; };

__device__ __forceinline__ void p0_transpose_item(const float* W, int ldw, int K, int N, bf16_t* WT, int item, int lane, float scale, const float* gk, bool pair_perm = false) {
    const int nblk = N / 64, kb = item / nblk, nb = item % nblk, i16 = lane & 15, q4 = lane >> 4;
    const int n0 = 64 * nb + 4 * i16;
    const int ns0 = (pair_perm ? ((nb >> 1) & 1) * DFF + 128 * (nb >> 2) + 64 * (nb & 1) : 64 * nb) + 4 * i16;
#pragma unroll
    for (int pass = 0; pass < 2; ++pass) {
        const int kk0 = 64 * kb + 32 * pass + 8 * q4;
        const float* src = W + (size_t)kk0 * ldw + ns0;
        f32x4 v[8];
#pragma unroll
        for (int i = 0; i < 8; ++i) v[i] = __builtin_nontemporal_load((const f32x4*)(src + (size_t)i * ldw));
        f32x4 g0 = {scale, scale, scale, scale}, g1 = g0;
        if (gk) { g0 = *(const f32x4*)(gk + kk0) * scale; g1 = *(const f32x4*)(gk + kk0 + 4) * scale; }
#pragma unroll
        for (int j = 0; j < 4; ++j) { u32x4 o;
            o.x = pk2(v[0][j] * g0[0], v[1][j] * g0[1]); o.y = pk2(v[2][j] * g0[2], v[3][j] * g0[3]); o.z = pk2(v[4][j] * g1[0], v[5][j] * g1[1]); o.w = pk2(v[6][j] * g1[2], v[7][j] * g1[3]);
            *(u32x4*)(WT + (size_t)(n0 + j) * K + kk0) = o; }
    }
}

__device__ __forceinline__ void phase_prologue(const Params& P, LAS unsigned char* lds, int gw, int NGW, int wave, int lane) {
    constexpr int I_QKV = (DM / 64) * (NQKV / 64), I_WO = (DO / 64) * (DM / 64), I_WIN = (DM / 64) * (NIN / 64), I_WOUT = (DM / 64) * (DM / 64), I_WUP = (DM / 64) * (NUP / 64), I_WDN = (DFF / 64) * (DM / 64);
    constexpr int T0 = 2 * I_QKV, T1 = T0 + 2 * I_WO, T2 = T1 + 2 * I_WIN, T3 = T2 + 2 * I_WOUT, T4 = T3 + 4 * I_WUP, T5 = T4 + 4 * I_WDN;
    unsigned char* ws = P.ws;
    for (int it = gw; it < T5; it += NGW) {
        if (it < T0) { const int l = it / I_QKV, r = it % I_QKV; p0_transpose_item(P.in[11] + (size_t)l * DM * NQKV, NQKV, DM, NQKV, (bf16_t*)(ws + WS_WQKV + l * SZ_WQKV), r, lane, 1.f, P.in[9] + (size_t)(2 * l) * DM); }
        else if (it < T1) { const int q = it - T0, l = q / I_WO, r = q % I_WO; p0_transpose_item(P.in[14] + (size_t)l * DO * DM, DM, DO, DM, (bf16_t*)(ws + WS_WO + l * SZ_WO), r, lane, 1.f, nullptr); }
        else if (it < T2) { const int q = it - T1, l = q / I_WIN, r = q % I_WIN; const int nb = r % (NIN / 64);
            const float sc = (nb >= 16 && nb < 32) ? 0.08838834764831845f : 1.f;
            p0_transpose_item(P.in[15] + (size_t)l * DM * NIN_SRC, NIN_SRC, DM, NIN, (bf16_t*)(ws + WS_WIN + l * SZ_WIN), r, lane, sc, P.in[9] + (size_t)(2 * l + 1) * DM); }
        else if (it < T3) { const int q = it - T2, l = q / I_WOUT, r = q % I_WOUT; p0_transpose_item(P.in[18] + (size_t)l * DM * DM, DM, DM, DM, (bf16_t*)(ws + WS_WOUT + l * SZ_WOUT), r, lane, 1.f, nullptr); }
        else if (it < T4) { const int q = it - T3, l = q / I_WUP, r = q % I_WUP; p0_transpose_item(P.in[19] + (size_t)l * DM * NUP, NUP, DM, NUP, (bf16_t*)(ws + WS_WUP + l * SZ_WUP), r, lane, 1.f, P.in[10] + (size_t)l * DM, true); }
        else { const int q = it - T4, l = q / I_WDN, r = q % I_WDN; p0_transpose_item(P.in[22] + (size_t)l * DFF * DM, DM, DFF, DM, (bf16_t*)(ws + WS_WDOWN + l * SZ_WDOWN), r, lane, 1.f, nullptr); }
    }
    { const int gt = gw * 64 + lane, NT = NGW * 64;
      float* rope = (float*)(ws + WS_ROPE);
      for (int i = gt; i < 2052 * 64; i += NT) { const int pi = i >> 6, f = i & 63; const int pos = (pi < SEQ) ? pi : PAST + (pi - SEQ);
          const float invf = powf(10000.f, -(float)f * (1.f / 64.f)); const float ang = (float)pos * invf; float sn, cs; sincosf(ang, &sn, &cs); rope[2 * i] = cs; rope[2 * i + 1] = sn; }
      for (int i = gt; i < 3 * 64; i += NT) { const int g = i >> 6, f = i & 63; const float invf = powf(10000.f, -(float)f * (1.f / 64.f)); const float ang = (float)(32 << (2 * g)) * invf; float sn, cs; sincosf(ang, &sn, &cs);
          rope[(2052 * 64 + i) * 2] = cs; rope[(2052 * 64 + i) * 2 + 1] = sn; }
      f32x4* wgp = (f32x4*)(ws + WS_WGP);
      for (int i = gt; i < 2 * 128 * 64; i += NT) { const int l = i >> 13, kb = (i >> 6) & 127, ln = i & 63, col = ln & 15, kq = ln >> 4, k = 16 * kb + 4 * kq;
          const float* w = P.in[15] + (size_t)l * DM * NIN_SRC + (size_t)k * NIN_SRC + NIN + col; const float* g = P.in[9] + (size_t)(2 * l + 1) * DM + k;
          wgp[i] = (f32x4){g[0] * w[0], g[1] * w[NIN_SRC], g[2] * w[2 * NIN_SRC], g[3] * w[3 * NIN_SRC]}; } }
    for (int r = gw; r < MR; r += NGW) {
        const f32x4* xr = (const f32x4*)((r < MP) ? P.in[0] + (size_t)r * DM : P.in[1] + (size_t)(r - MP) * DM) + lane;
        u32x2* xb = (u32x2*)(ws + WS_XB) + (size_t)r * (DM / 4) + lane;
        float s = 0.f;
#pragma unroll
        for (int j = 0; j < 8; ++j) { const f32x4 v = xr[64 * j]; u32x2 w; w.x = pk2(v.x, v.y); w.y = pk2(v.z, v.w); xb[64 * j] = w; s += (v.x * v.x + v.y * v.y) + (v.z * v.z + v.w * v.w); }
        s = wave_sum(s);
        if (r < MP) { if (lane < 32) ((float*)(ws + WS_SSQ))[(size_t)r * 32 + lane] = (lane == 0) ? s : 0.f; }
        else { float* q = (float*)(ws + WS_SSQS) + (size_t)(r - MP) * 128; q[lane] = (lane == 0) ? s : 0.f; q[64 + lane] = 0.f; }
    }
}

__device__ __forceinline__ void gate_block(LAS unsigned char* lds, const bf16_t* X, const f32x4* WGP, const float* bg, float* GATES, int task, int wave, int lane) {
    const int r0 = task * 16, i16 = lane & 15, kq = lane >> 4;
    const bf16_t* xr = X + (size_t)(r0 + i16) * DM + 256 * wave + 4 * kq;
    const f32x4* wp = WGP + (size_t)(16 * wave) * 64 + lane;
    f32x4 acc = {0.f, 0.f, 0.f, 0.f}; float ss = 0.f;
#pragma unroll
    for (int j = 0; j < 16; ++j) {
        const u32x2 xw = *(const u32x2*)(xr + 16 * j); const f32x4 xv = {bflo(xw.x), bfhi(xw.x), bflo(xw.y), bfhi(xw.y)}, wv = wp[64 * j];
        ss += (xv.x * xv.x + xv.y * xv.y) + (xv.z * xv.z + xv.w * xv.w);
        acc = __builtin_amdgcn_mfma_f32_16x16x4f32(xv.x, wv.x, acc, 0, 0, 0);
        acc = __builtin_amdgcn_mfma_f32_16x16x4f32(xv.y, wv.y, acc, 0, 0, 0);
        acc = __builtin_amdgcn_mfma_f32_16x16x4f32(xv.z, wv.z, acc, 0, 0, 0);
        acc = __builtin_amdgcn_mfma_f32_16x16x4f32(xv.w, wv.w, acc, 0, 0, 0);
    }
    LAS f32x4* gp = (LAS f32x4*)lds; LAS float* sp = (LAS float*)(lds + 8192);
    __syncthreads();
    gp[wave * 64 + lane] = acc; sp[wave * 64 + lane] = ss;
    __syncthreads();
    if (wave == 0) {
        f32x4 a = gp[lane]; float s = sp[lane];
#pragma unroll
        for (int w = 1; w < 8; ++w) { a += gp[w * 64 + lane]; s += sp[w * 64 + lane]; }
        s += __shfl_xor(s, 16); s += __shfl_xor(s, 32);
        const float rstd = rsqrtf(s * (1.f / DM) + EPS);
        const float bias = bg[i16];
#pragma unroll
        for (int i = 0; i < 4; ++i) {
            const float rs = __shfl(rstd, 4 * kq + i);
            const float pre = a[i] * rs + bias;
            const float gc = 15.f * tanhf(pre * (1.f / 15.f));
            const float val = (i16 < 8) ? gc : (fminf(gc, 0.f) - log1pf(fexp(-fabsf(gc))));
            GATES[(size_t)(r0 + 4 * kq + i) * 16 + i16] = val;
        }
    }
}

constexpr int SK_PART = 0, SK_RSTD = 16384;
template <int MODE>
__device__ __forceinline__ void skinny_phase(LAS unsigned char* lds, const bf16_t* A, int K, const bf16_t* Bt, int N, bf16_t* Ob, int ldo, bf16_t* XBs, float* SSQS, float* Os, int c, int G, int nIdle, int tid, int wave, int lane) {
    const int i16 = lane & 15, q4 = lane >> 4;
    if (c < G - nIdle) return;
    LAS f32x4* part = (LAS f32x4*)(lds + SK_PART); LAS float* rstdS = (LAS float*)(lds + SK_RSTD);
    __syncthreads();
    if (MODE == 0) { const int row = tid >> 4, sub = tid & 15; const float* q = SSQS + row * 128 + 8 * sub;
        const f32x4 a = *(const f32x4*)q, b = *(const f32x4*)(q + 4); float s = ((a[0] + a[1]) + (a[2] + a[3])) + ((b[0] + b[1]) + (b[2] + b[3]));
        s = row16_sum(s);
        if (sub == 0) rstdS[row] = rsqrtf(s * (1.f / 2048.f) + EPS);
        __syncthreads(); }
    const int kper = K >> 3, nks = kper >> 5, k0 = wave * kper;
    for (int j = G - 1 - c; j < (N >> 4); j += nIdle) {
        f32x4 acc0 = {0.f, 0.f, 0.f, 0.f}, acc1 = {0.f, 0.f, 0.f, 0.f};
        const bf16_t* bp = Bt + (size_t)(16 * j + i16) * K + k0 + 8 * q4; const bf16_t* ap = A + (size_t)i16 * K + k0 + 8 * q4;
#pragma unroll 8
        for (int ks = 0; ks < nks; ++ks) { const bf16x8 bf = *(const bf16x8*)(bp + 32 * ks), a0 = *(const bf16x8*)(ap + 32 * ks), a1 = *(const bf16x8*)(ap + (size_t)16 * K + 32 * ks);
            acc0 = mma16(a0, bf, acc0); acc1 = mma16(a1, bf, acc1); }
        part[(wave * 2 + 0) * 64 + lane] = acc0; part[(wave * 2 + 1) * 64 + lane] = acc1;
        __syncthreads();
        if (wave < 2) {
            f32x4 s = part[wave * 64 + lane];
#pragma unroll
            for (int w = 1; w < 8; ++w) s += part[(w * 2 + wave) * 64 + lane];
            const int col = 16 * j + i16;
#pragma unroll
            for (int i = 0; i < 4; ++i) { const int r = 16 * wave + 4 * q4 + i;
                if (MODE == 0) Ob[(size_t)r * ldo + col] = (bf16_t)f2bf(s[i] * rstdS[r]);
                else if (MODE == 1) { const float xo = bf1(XBs[(size_t)r * DM + col]) + s[i]; XBs[(size_t)r * DM + col] = (bf16_t)f2bf(xo);
                    float sq = xo * xo; sq = row16_sum(sq);
                    if (i16 == 0) SSQS[r * 128 + j] = sq; }
                else Os[(size_t)r * DM + col] = bf1(XBs[(size_t)r * DM + col]) + s[i]; }
        }
        __syncthreads();
    }
}

constexpr int SU_PART = 0, SU_RSTD = 98304, SU_NITEMS = 352;
__device__ __forceinline__ void skinny_up(LAS unsigned char* lds, const float* st_in, const float* cw, const float* cb, const bf16_t* XB, const bf16_t* Bt, const float* SSQ, const float* SSQS, float* HALO, unsigned* hcnt,
                                          bf16_t* Z, float* outp, int layer, int c, int G, int nIdle, int tid, int wave, int lane) {
    if (c < G - nIdle) return;
    const int i16 = lane & 15, q4 = lane >> 4;
    LAS f32x4* part = (LAS f32x4*)(lds + SU_PART); LAS float* rstdS = (LAS float*)(lds + SU_RSTD);
    __syncthreads();
    { const int row = tid >> 2, pt = tid & 3; float s = 0.f;
      if (row < 32) { const float* q = SSQS + row * 128 + 32 * pt;
#pragma unroll
          for (int v = 0; v < 8; ++v) { const f32x4 a = *(const f32x4*)(q + 4 * v); s += (a[0] + a[1]) + (a[2] + a[3]); } }
      else if (row < 96) { const int hr = row - 32; const float* q = SSQ + (size_t)(256 * (hr >> 1) + 254 + (hr & 1)) * 32 + 8 * pt;
          const f32x4 a = *(const f32x4*)q, b = *(const f32x4*)(q + 4); s = ((a[0] + a[1]) + (a[2] + a[3])) + ((b[0] + b[1]) + (b[2] + b[3])); }
      s = row4_sum(s);
      if (pt == 0 && row < 96) rstdS[row] = rsqrtf(s * (1.f / 2048.f) + EPS); }
    __syncthreads();
    const int k0 = wave * 256;
    const bf16_t* ap[6];
#pragma unroll
    for (int rb = 0; rb < 6; ++rb) { const int grow = (rb < 2) ? MP + 16 * rb + i16 : 256 * ((16 * (rb - 2) + i16) >> 1) + 254 + (i16 & 1); ap[rb] = XB + (size_t)grow * DM + k0 + 8 * q4; }
    for (int j = G - 1 - c; j < SU_NITEMS; j += nIdle) {
        const int pn = j >> 3, sb = j & 7, na = 256 * pn + 16 * sb + i16;
        f32x4 acc[6][2];
#pragma unroll
        for (int rb = 0; rb < 6; ++rb) { acc[rb][0] = (f32x4){0.f, 0.f, 0.f, 0.f}; acc[rb][1] = (f32x4){0.f, 0.f, 0.f, 0.f}; }
        const bf16_t* bpa = Bt + (size_t)na * DM + k0 + 8 * q4; const bf16_t* bpb = bpa + (size_t)128 * DM;
#pragma unroll 2
        for (int ks = 0; ks < 8; ++ks) { const bf16x8 fa = *(const bf16x8*)(bpa + 32 * ks), fb = *(const bf16x8*)(bpb + 32 * ks);
#pragma unroll
            for (int rb = 0; rb < 6; ++rb) { const bf16x8 a = *(const bf16x8*)(ap[rb] + 32 * ks); acc[rb][0] = mma16(a, fa, acc[rb][0]); acc[rb][1] = mma16(a, fb, acc[rb][1]); } }
#pragma unroll
        for (int rb = 0; rb < 6; ++rb) { part[((wave * 6 + rb) * 2 + 0) * 64 + lane] = acc[rb][0]; part[((wave * 6 + rb) * 2 + 1) * 64 + lane] = acc[rb][1]; }
        __syncthreads();
        if (wave < 6) {
            const int rb = wave;
            f32x4 sa = part[((0 * 6 + rb) * 2 + 0) * 64 + lane], sbv = part[((0 * 6 + rb) * 2 + 1) * 64 + lane];
#pragma unroll
            for (int w = 1; w < 8; ++w) { sa += part[((w * 6 + rb) * 2 + 0) * 64 + lane]; sbv += part[((w * 6 + rb) * 2 + 1) * 64 + lane]; }
            const int jn = 128 * pn + 16 * sb + i16;
            if (rb < 2) {
                const int bs = 4 * rb + q4;
                float ua[4], ub[4];
#pragma unroll
                for (int i = 0; i < 4; ++i) { const float rs = rstdS[16 * rb + 4 * q4 + i]; ua[i] = sa[i] * rs; ub[i] = sbv[i] * rs; }
                const float wa0 = cw[jn], wa1 = cw[NUP + jn], wa2 = cw[2 * NUP + jn], ba = cb[jn], wb0 = cw[DFF + jn], wb1 = cw[NUP + DFF + jn], wb2 = cw[2 * NUP + DFF + jn], bb = cb[DFF + jn];
                const float* st = st_in + ((size_t)(layer * NBS + bs) * 2) * NUP;
                float a2 = st[jn], a1 = st[NUP + jn], b2 = st[DFF + jn], b1 = st[NUP + DFF + jn];
#pragma unroll
                for (int t = 0; t < 4; ++t) { const float ca = ba + wa0 * a2 + wa1 * a1 + wa2 * ua[t], cbv = bb + wb0 * b2 + wb1 * b1 + wb2 * ub[t];
                    Z[(size_t)(MP + bs * 4 + t) * DFF + jn] = (bf16_t)f2bf(ca / (1.f + fexp(-ca)) * cbv); a2 = a1; a1 = ua[t]; b2 = b1; b1 = ub[t]; }
                float* co = outp + O_CONVS + ((size_t)(layer * NBS + bs) * 2) * NUP;
                co[jn] = ua[2]; co[NUP + jn] = ua[3]; co[DFF + jn] = ub[2]; co[NUP + DFF + jn] = ub[3];
            } else {
#pragma unroll
                for (int i = 0; i < 4; ++i) { const int hr = 16 * (rb - 2) + 4 * q4 + i; const float rs = rstdS[32 + hr]; const float va = sa[i] * rs, vb = sbv[i] * rs;
                    __hip_atomic_store(HALO + (size_t)hr * NUP + na, va, __ATOMIC_RELAXED, __HIP_MEMORY_SCOPE_AGENT); __hip_atomic_store(HALO + (size_t)hr * NUP + na + 128, vb, __ATOMIC_RELAXED, __HIP_MEMORY_SCOPE_AGENT);
                    const int pmg = hr >> 1;
                    if ((pmg & 7) == 7) { float* co = outp + O_CONVP + ((size_t)(layer * NBP + (pmg >> 3)) * 2 + (hr & 1)) * NUP; co[jn] = va; co[DFF + jn] = vb; } }
                asm volatile("s_waitcnt vmcnt(0)" ::: "memory");
                if (lane == 0) __hip_atomic_fetch_add(hcnt, 1u, __ATOMIC_RELAXED, __HIP_MEMORY_SCOPE_AGENT);
            }
        }
        __syncthreads();
    }
}

__device__ __forceinline__ void unpack8(const u32x4 w, float (&x)[8]) { x[0] = bflo(w.x); x[1] = bfhi(w.x); x[2] = bflo(w.y); x[3] = bfhi(w.y); x[4] = bflo(w.z); x[5] = bfhi(w.z); x[6] = bflo(w.w); x[7] = bfhi(w.w); }
__device__ __forceinline__ void load8(const float* p, float (&x)[8]) { const f32x4 a = *(const f32x4*)p, b = *(const f32x4*)(p + 4); x[0] = a.x; x[1] = a.y; x[2] = a.z; x[3] = a.w; x[4] = b.x; x[5] = b.y; x[6] = b.z; x[7] = b.w; }
__device__ __forceinline__ void store8(float* p, const float (&x)[8]) { *(f32x4*)p = (f32x4){x[0], x[1], x[2], x[3]}; *(f32x4*)(p + 4) = (f32x4){x[4], x[5], x[6], x[7]}; }
constexpr int AT_PITCH = 272, AT_KOFF = 0, AT_VOFF = 256 * AT_PITCH;
struct AttnItem { int g, b, h, dil, r, qb; };
__device__ __forceinline__ AttnItem attn_decode(int item) {
    AttnItem a; a.g = item >> 9; const int rem = item & 511, idx = rem & 15; a.b = rem >> 7; a.h = (rem >> 4) & 7;
    a.dil = (a.g == 0) ? 1 : (a.g == 1) ? 4 : 16; a.r = (a.g == 0) ? 0 : (a.g == 1) ? (idx >> 2) : idx; a.qb = (a.g == 0) ? idx : (a.g == 1) ? (idx & 3) : 0; return a;
}
struct AttnPre { u32x4 kr[8]; };
__device__ __forceinline__ void attn_fetch(const bf16_t* QKV, const float* rope, const AttnItem& a, int tid, AttnPre& f) {
    const int ck = (a.g * 3 * 8 + a.h) * 128 + 1024, uk0 = 128 * (a.qb - 1); const size_t rowbase = (size_t)a.b * SEQ + a.r;
#pragma unroll
    for (int i = 0; i < 8; ++i) { const int id = tid + 512 * i, kk = id >> 4, ch = id & 15, u = uk0 + kk;
        f.kr[i] = (u32x4){0u, 0u, 0u, 0u};
        if (u >= 0) f.kr[i] = *(const u32x4*)(QKV + (rowbase + (size_t)u * a.dil) * NQKV + ck + 8 * ch); }
}
__device__ __forceinline__ void attn_phase(LAS unsigned char* lds, unsigned lds_base, const bf16_t* QKV, const float* rope, const float* qgain, const float* kgain, float* outp, int ia, bf16_t* OG, float* LSE,
                                           int first, int stride, int nitems, int tid, int wave, int lane) {
    const int i16 = lane & 15, q4 = lane >> 4, qq = i16 >> 2, p = lane & 3;
    const int ch = tid & 15; const float sgn = (ch >= 8) ? 1.f : -1.f;
    float kgn[8];
    load8(kgain + 8 * ch, kgn);
    AttnPre f;
    if (first < nitems) { const AttnItem a0 = attn_decode(first); attn_fetch(QKV, rope, a0, tid, f); }
    __syncthreads();
#pragma unroll 1
    for (int item = first; item < nitems; item += stride) {
        const AttnItem a = attn_decode(item);
        const int g = a.g, h = a.h, qb = a.qb;
        const int cq = (g * 3 * 8 + h) * 128;
        const size_t rowbase = (size_t)a.b * SEQ + a.r;
        const int win = 128 << (2 * g);
        float* kvo = outp + ((g == 0) ? O_KV128P : (g == 1) ? O_KV512P : O_KV2048P) + ((size_t)(ia * NBP + a.b) * win) * 2048 + h * 128 + 8 * ch;
        const int tqa = 16 * wave + i16;
        const int posq = a.r + a.dil * (128 * qb + tqa);
        const size_t grow = (size_t)a.b * SEQ + posq;
        { float c[8], sn[8], cd[8], sd[8];
          { const int u0 = (qb == 0) ? (tid >> 4) : 128 * (qb - 1) + (tid >> 4), pos0 = a.r + a.dil * u0;
            const f32x4* dp = (const f32x4*)(rope + ((size_t)(2052 + g) * 64 + 8 * (tid & 7)) * 2); const f32x4* rp = (const f32x4*)(rope + ((size_t)pos0 * 64 + 8 * (tid & 7)) * 2);
#pragma unroll
            for (int q = 0; q < 4; ++q) { const f32x4 t = dp[q], b0 = rp[q]; cd[2 * q] = t[0]; sd[2 * q] = t[1]; cd[2 * q + 1] = t[2]; sd[2 * q + 1] = t[3];
                c[2 * q] = b0[0]; sn[2 * q] = b0[1]; c[2 * q + 1] = b0[2]; sn[2 * q + 1] = b0[3]; } }
#pragma unroll
          for (int i = 0; i < 8; ++i) { const int id = tid + 512 * i, kk = id >> 4; const int u = 128 * (qb - 1) + kk;
            u32x4 kw = {0u, 0u, 0u, 0u};
            if (u >= 0) {
                float x[8]; unpack8(f.kr[i], x);
                float ss = 0.f;
#pragma unroll
                for (int j = 0; j < 8; ++j) ss += x[j] * x[j];
                ss = row16_sum(ss);
                const float rstd = rsqrtf(ss * (1.f / 128.f) + EPS);
                float o[8];
#pragma unroll
                for (int j = 0; j < 8; ++j) { const float y = x[j] * rstd * kgn[j]; const float pr = dpp_mov<0x128>(y); o[j] = y * c[j] + sgn * pr * sn[j];
                    const float cn = c[j] * cd[j] - sn[j] * sd[j]; sn[j] = sn[j] * cd[j] + c[j] * sd[j]; c[j] = cn; }
                kw.x = pk2(o[0], o[1]); kw.y = pk2(o[2], o[3]); kw.z = pk2(o[4], o[5]); kw.w = pk2(o[6], o[7]);
                const int jw = a.r + a.dil * u - (SEQ - win);
                if (kk >= 128 && jw >= 0) store8(kvo + (size_t)jw * 2048, o);
            }
            *(LAS u32x4*)(lds + AT_KOFF + kk * AT_PITCH + (id & 15) * 16) = kw; } }
        u32x4 vr[8];
        { const int cv = cq + 2048, uk0 = 128 * (qb - 1);
#pragma unroll
          for (int i = 0; i < 8; ++i) { const int id = tid + 512 * i, kk = id >> 4, u = uk0 + kk; vr[i] = (u32x4){0u, 0u, 0u, 0u};
              if (u >= 0) vr[i] = *(const u32x4*)(QKV + (rowbase + (size_t)u * a.dil) * NQKV + cv + 8 * (id & 15)); } }
        bf16x8 Qf[4];
        { float x[4][8];
#pragma unroll
          for (int ks = 0; ks < 4; ++ks) unpack8(*(const u32x4*)(QKV + grow * NQKV + cq + 32 * ks + 8 * q4), x[ks]);
          float ss = 0.f;
#pragma unroll
          for (int ks = 0; ks < 4; ++ks)
#pragma unroll
              for (int j = 0; j < 8; ++j) ss += x[ks][j] * x[ks][j];
          ss += __shfl_xor(ss, 16); ss += __shfl_xor(ss, 32);
          const float rstd = rsqrtf(ss * (1.f / 128.f) + EPS);
#pragma unroll
          for (int kp = 0; kp < 2; ++kp) { float g1[8], g2[8], cq_[8], sq_[8];
              load8(qgain + 32 * kp + 8 * q4, g1); load8(qgain + 64 + 32 * kp + 8 * q4, g2);
              const f32x4* rp = (const f32x4*)(rope + ((size_t)posq * 64 + 32 * kp + 8 * q4) * 2);
#pragma unroll
              for (int q = 0; q < 4; ++q) { const f32x4 t = rp[q]; cq_[2 * q] = t[0]; sq_[2 * q] = t[1]; cq_[2 * q + 1] = t[2]; sq_[2 * q + 1] = t[3]; }
              float o1[8], o2[8];
#pragma unroll
              for (int j = 0; j < 8; ++j) { const float y1 = x[kp][j] * rstd * g1[j], y2 = x[kp + 2][j] * rstd * g2[j]; o1[j] = y1 * cq_[j] - y2 * sq_[j]; o2[j] = y2 * cq_[j] + y1 * sq_[j]; }
              u32x4 w1, w2; w1.x = pk2(o1[0], o1[1]); w1.y = pk2(o1[2], o1[3]); w1.z = pk2(o1[4], o1[5]); w1.w = pk2(o1[6], o1[7]); w2.x = pk2(o2[0], o2[1]); w2.y = pk2(o2[2], o2[3]); w2.z = pk2(o2[4], o2[5]); w2.w = pk2(o2[6], o2[7]);
              Qf[kp] = __builtin_bit_cast(bf16x8, w1); Qf[kp + 2] = __builtin_bit_cast(bf16x8, w2); } }
        __syncthreads();
        if (item + stride < nitems) { const AttnItem an = attn_decode(item + stride); attn_fetch(QKV, rope, an, tid, f); }
        const int cb0 = wave & ~1;
        f32x4 S[10];
#pragma unroll
        for (int c = 0; c < 10; ++c) {
            f32x4 acc = {0.f, 0.f, 0.f, 0.f};
#pragma unroll
            for (int ks = 0; ks < 4; ++ks) { const bf16x8 kf = *(const LAS bf16x8*)(lds + AT_KOFF + (16 * (cb0 + c) + i16) * AT_PITCH + (32 * ks + 8 * q4) * 2); acc = mma16(kf, Qf[ks], acc); }
            S[c] = acc;
        }
        const float sc = 0.08838834764831845f * 1.4426950408889634f;
        float mx = -INFINITY;
#pragma unroll
        for (int c = 0; c < 10; ++c)
#pragma unroll
            for (int i = 0; i < 4; ++i) { const int kk = 16 * (cb0 + c) + 4 * q4 + i; const bool ok = (kk >= tqa) && (kk <= tqa + 128) && (qb > 0 || kk >= 128);
                const float s = ok ? S[c][i] * sc : -INFINITY; S[c][i] = s; mx = fmaxf(mx, s); }
        mx = fmaxf(mx, __shfl_xor(mx, 16)); mx = fmaxf(mx, __shfl_xor(mx, 32));
        float l = 0.f;
#pragma unroll
        for (int c = 0; c < 10; ++c)
#pragma unroll
            for (int i = 0; i < 4; ++i) { const float pv = __builtin_amdgcn_exp2f(S[c][i] - mx); S[c][i] = pv; l += pv; }
        l += __shfl_xor(l, 16); l += __shfl_xor(l, 32);
        bf16x8 Pf[5];
#pragma unroll
        for (int kst = 0; kst < 5; ++kst) Pf[kst] = pack8(S[2 * kst], S[2 * kst + 1]);
#pragma unroll
        for (int i = 0; i < 8; ++i) { const int id = tid + 512 * i, kk = id >> 4, u = 128 * (qb - 1) + kk;
            *(LAS u32x4*)(lds + AT_VOFF + kk * AT_PITCH + (id & 15) * 16) = vr[i];
            const int jw = a.r + a.dil * u - (SEQ - win);
            if (kk >= 128 && jw >= 0) { float vx[8]; unpack8(vr[i], vx); store8(kvo + (size_t)jw * 2048 + 1024, vx); } }
        __syncthreads();
        const float inv = 1.f / l;
        bf16_t* orow = OG + grow * 3072 + g * 1024 + h * 128 + 4 * q4;
        const unsigned vbase = lds_base + AT_VOFF + (16 * cb0 + 4 * q4 + qq) * AT_PITCH + 8 * p;
#pragma unroll
        for (int eb = 0; eb < 8; ++eb) {
            f32x4 acc = {0.f, 0.f, 0.f, 0.f};
            bf16x8 v0, v1, v2, v3, v4;
            TR_READ5(v0, v1, v2, v3, v4, vbase, 0 * AT_PITCH + 32 * eb, 16 * AT_PITCH + 32 * eb, 32 * AT_PITCH + 32 * eb, 48 * AT_PITCH + 32 * eb, 64 * AT_PITCH + 32 * eb, 80 * AT_PITCH + 32 * eb,
                     96 * AT_PITCH + 32 * eb, 112 * AT_PITCH + 32 * eb, 128 * AT_PITCH + 32 * eb, 144 * AT_PITCH + 32 * eb);
            acc = mma16(v0, Pf[0], acc); acc = mma16(v1, Pf[1], acc); acc = mma16(v2, Pf[2], acc); acc = mma16(v3, Pf[3], acc); acc = mma16(v4, Pf[4], acc);
            u32x2 w; w.x = pk2(acc[0] * inv, acc[1] * inv); w.y = pk2(acc[2] * inv, acc[3] * inv);
            *(u32x2*)(orow + 16 * eb) = w;
        }
        if (q4 == 0) LSE[grow * 24 + g * 8 + h] = (mx + log2f(l)) * 0.6931471805599453f;
    }
    __syncthreads();
}

__device__ __forceinline__ void sample_prep_vec(const bf16_t* src, const float* gain, const float* rope, int tt, LAS float* dst, int lane) {
    const float x1 = bf1(src[lane]), x2 = bf1(src[lane + 64]);
    const float rstd = rsqrtf(wave_sum(x1 * x1 + x2 * x2) * (1.f / 128.f) + EPS);
    const float y1 = x1 * rstd * gain[lane], y2 = x2 * rstd * gain[64 + lane];
    const f32x2 cs = *(const f32x2*)(rope + ((size_t)(SEQ + tt) * 64 + lane) * 2);
    dst[lane] = y1 * cs.x - y2 * cs.y; dst[lane + 64] = y2 * cs.x + y1 * cs.y;
}
__device__ __forceinline__ void attn_sample_task(LAS unsigned char* wl  , const bf16_t* QKV, const float* rope, const float* qgain, const float* kgain, float* outp,
                                                 const float* c128, const float* c512, const float* c2048, bf16_t* OG, float* LSE, int ia, int wt, int lane) {
    const int bs = wt / 96, rem = wt % 96, g = rem >> 5, h = (rem >> 2) & 7, t = rem & 3;
    const int win = 128 << (2 * g), dil = 1 << (2 * g);
    const float* cache = ((g == 0) ? c128 : (g == 1) ? c512 : c2048) + (size_t)(ia * NBS + bs) * win * 2048;
    const int cq = (g * 3 * 8 + h) * 128, ck = cq + 1024, cv = cq + 2048;
    const size_t rq = (size_t)MP + bs * 4 + t;
    LAS float* qs = (LAS float*)wl; LAS float* ps = (LAS float*)(wl + 512); LAS float* knew = (LAS float*)(wl + 1536);
    sample_prep_vec(QKV + rq * NQKV + cq, qgain, rope, t, qs, lane);
    for (int tn = (g == 0) ? 0 : t; tn <= t; ++tn) sample_prep_vec(QKV + ((size_t)MP + bs * 4 + tn) * NQKV + ck, kgain, rope, tn, knew + tn * 128, lane);
    asm volatile("s_waitcnt lgkmcnt(0)" ::: "memory");
    { float* kvo = outp + ((g == 0) ? O_KV128S : (g == 1) ? O_KV512S : O_KV2048S) + (((size_t)(ia * NBS + bs) * win + (win - TSAMP + t)) * 2) * 1024 + h * 128;
      kvo[lane] = knew[t * 128 + lane]; kvo[lane + 64] = knew[t * 128 + lane + 64];
      const bf16_t* vp = QKV + rq * NQKV + cv; kvo[1024 + lane] = bf1(vp[lane]); kvo[1024 + lane + 64] = bf1(vp[lane + 64]); }
    float sv[3];
#pragma unroll
    for (int pass = 0; pass < 3; ++pass) {
        const int j = pass * 64 + lane; float s = -INFINITY;
        if (j <= 128) {
            const int idx = win + t - dil * j; float acc = 0.f;
            if (idx >= win) { const LAS float* kp = knew + (idx - win) * 128;
                for (int d = 0; d < 128; d += 4) { const LAS float* q = qs + d; acc += q[0] * kp[d] + q[1] * kp[d + 1] + q[2] * kp[d + 2] + q[3] * kp[d + 3]; } }
            else { const float* kp = cache + ((size_t)idx * 2 + 0) * 1024 + h * 128;
                for (int d = 0; d < 128; d += 4) { const f32x4 kx = *(const f32x4*)(kp + d); const LAS float* q = qs + d; acc += q[0] * kx.x + q[1] * kx.y + q[2] * kx.z + q[3] * kx.w; } }
            s = acc * 0.08838834764831845f;
        }
        sv[pass] = s;
    }
    const float mx = wave_max(fmaxf(fmaxf(sv[0], sv[1]), sv[2]));
    float l = 0.f;
#pragma unroll
    for (int pass = 0; pass < 3; ++pass) { const float pv = fexp(sv[pass] - mx); l += pv; ps[pass * 64 + lane] = pv; }
    l = wave_sum(l);
    asm volatile("s_waitcnt lgkmcnt(0)" ::: "memory");
    { const int jg = lane >> 4, dd = lane & 15;
      float o[8];
#pragma unroll
      for (int q = 0; q < 8; ++q) o[q] = 0.f;
#pragma unroll 4
      for (int j = jg; j <= 128; j += 4) {
          const int idx = win + t - dil * j; const float pj = ps[j]; float v[8];
          if (idx >= win) { unpack8(*(const u32x4*)(QKV + ((size_t)MP + bs * 4 + (idx - win)) * NQKV + cv + 8 * dd), v); }
          else { load8(cache + ((size_t)idx * 2 + 1) * 1024 + h * 128 + 8 * dd, v); }
#pragma unroll
          for (int q = 0; q < 8; ++q) o[q] += pj * v[q];
      }
      const float inv = 1.f / l;
#pragma unroll
      for (int q = 0; q < 8; ++q) { o[q] += __shfl_xor(o[q], 16); o[q] += __shfl_xor(o[q], 32); o[q] *= inv; }
      if (jg == 0) { u32x4 w; w.x = pk2(o[0], o[1]); w.y = pk2(o[2], o[3]); w.z = pk2(o[4], o[5]); w.w = pk2(o[6], o[7]); *(u32x4*)(OG + rq * 3072 + g * 1024 + h * 128 + 8 * dd) = w; } }
    if (lane == 0) LSE[rq * 24 + g * 8 + h] = mx + logf(l);
}

__device__ __forceinline__ void combine_row(const bf16_t* OG, const float* LSE, bf16_t* OC, int r, int lane) {
    const int hh = lane >> 3;
    const float l0 = LSE[(size_t)r * 24 + hh], l1 = LSE[(size_t)r * 24 + 8 + hh], l2 = LSE[(size_t)r * 24 + 16 + hh];
    const float mx = fmaxf(l0, fmaxf(l1, l2));
    float e0 = fexp(l0 - mx), e1 = fexp(l1 - mx), e2 = fexp(l2 - mx);
    const float inv = 1.f / (e0 + e1 + e2); e0 *= inv; e1 *= inv; e2 *= inv;
    const bf16_t* src = OG + (size_t)r * 3072 + 16 * lane;
#pragma unroll
    for (int c = 0; c < 2; ++c) {
        const u32x4 a = *(const u32x4*)(src + 8 * c), bq = *(const u32x4*)(src + 1024 + 8 * c), cc = *(const u32x4*)(src + 2048 + 8 * c);
        u32x4 o;
        o.x = pk2(e0 * bflo(a.x) + e1 * bflo(bq.x) + e2 * bflo(cc.x), e0 * bfhi(a.x) + e1 * bfhi(bq.x) + e2 * bfhi(cc.x));
        o.y = pk2(e0 * bflo(a.y) + e1 * bflo(bq.y) + e2 * bflo(cc.y), e0 * bfhi(a.y) + e1 * bfhi(bq.y) + e2 * bfhi(cc.y));
        o.z = pk2(e0 * bflo(a.z) + e1 * bflo(bq.z) + e2 * bflo(cc.z), e0 * bfhi(a.z) + e1 * bfhi(bq.z) + e2 * bfhi(cc.z));
        o.w = pk2(e0 * bflo(a.w) + e1 * bflo(bq.w) + e2 * bflo(cc.w), e0 * bfhi(a.w) + e1 * bfhi(bq.w) + e2 * bfhi(cc.w));
        *(u32x4*)(OC + (size_t)r * DO + 16 * lane + 8 * c) = o;
    }
}

template <int CTRL, int RMASK> __device__ __forceinline__ float dpp_f(float oldv, float src) {
    return __builtin_bit_cast(float, __builtin_amdgcn_update_dpp(__builtin_bit_cast(int, oldv), __builtin_bit_cast(int, src), CTRL, RMASK, 0xf, false)); }
__device__ __forceinline__ float scan_sum(float v, int lane) {
    (void)lane;
    v += dpp_f<0x111, 0xf>(0.f, v); v += dpp_f<0x112, 0xf>(0.f, v); v += dpp_f<0x114, 0xf>(0.f, v); v += dpp_f<0x118, 0xf>(0.f, v);
    v += dpp_f<0x142, 0xa>(0.f, v); v += dpp_f<0x143, 0xc>(0.f, v);
    return v;
}
__device__ __forceinline__ float scan_max(float v, int lane) {
    (void)lane; const float ninf = -INFINITY;
    v = fmaxf(v, dpp_f<0x111, 0xf>(ninf, v)); v = fmaxf(v, dpp_f<0x112, 0xf>(ninf, v)); v = fmaxf(v, dpp_f<0x114, 0xf>(ninf, v)); v = fmaxf(v, dpp_f<0x118, 0xf>(ninf, v));
    v = fmaxf(v, dpp_f<0x142, 0xa>(ninf, v)); v = fmaxf(v, dpp_f<0x143, 0xc>(ninf, v));
    return v;
}
#ifndef ML_COPY
#define ML_COPY 0
#endif
constexpr int ML_QP = 272, ML_VP = 144, ML_PP = 144;
constexpr int ML_QSZ = 64 * ML_QP, ML_VSZ = 64 * ML_VP;
constexpr int ML_Q = 0, ML_K = ML_Q + 2 * ML_QSZ, ML_V = ML_K + 2 * ML_QSZ, ML_KW = ML_V + 2 * ML_VSZ, ML_P = ML_KW + ML_QSZ, ML_N = ML_P + 64 * ML_PP, ML_DEN = ML_N + 1024, ML_END = ML_DEN + 256;
__device__ __forceinline__ void mlstm_prompt(LAS unsigned char* lds, unsigned lds_base, const bf16_t* QKVO, const float* GATES, bf16_t* HRAW, float* SQ, float* out, int ib, int unit, int tid, int wave, int lane) {
    const int bh = unit >> 2, sl = unit & 3;
    const int b = bh >> 3, h = bh & 7;
    const int i16 = lane & 15, q4 = lane >> 4, qq = i16 >> 2, p = lane & 3;
    const int rb = wave >> 1, ea = wave & 1, e0 = 64 * sl + 32 * ea;
    f32x4 CT[2][8];
#pragma unroll
    for (int a = 0; a < 2; ++a)
#pragma unroll
        for (int d = 0; d < 8; ++d) CT[a][d] = (f32x4){0.f, 0.f, 0.f, 0.f};
    float m = 0.f;
    const unsigned vbase0 = lds_base + ML_V + (8 * q4 + qq) * ML_VP + (32 * ea + 4 * p) * 2, kwbase = lds_base + ML_KW + (8 * q4 + qq) * ML_QP + 8 * p;
    LAS float* nS = (LAS float*)(lds + ML_N); LAS float* denS = (LAS float*)(lds + ML_DEN);
    const size_t rbase = (size_t)b * SEQ;
    const int srow0 = tid >> 4, sch = tid & 15, vrow = tid >> 3, vch = tid & 7;
    u32x4 pq0, pq1, pk0, pk1, pv; float pig, plf;
    { const bf16_t* s0 = QKVO + (rbase + srow0) * NIN + h * 128 + 8 * sch; const bf16_t* s1 = s0 + (size_t)32 * NIN;
      pq0 = *(const u32x4*)s0; pk0 = *(const u32x4*)(s0 + 1024); pq1 = *(const u32x4*)s1; pk1 = *(const u32x4*)(s1 + 1024);
      pv = *(const u32x4*)(QKVO + (rbase + vrow) * NIN + 2048 + h * 256 + 64 * sl + 8 * vch);
      pig = GATES[(rbase + lane) * 16 + h]; plf = GATES[(rbase + lane) * 16 + 8 + h]; }
    __syncthreads();
    if (tid < 128) nS[tid] = 0.f;
    *(LAS u32x4*)(lds + ML_Q + srow0 * ML_QP + sch * 16) = pq0; *(LAS u32x4*)(lds + ML_Q + (srow0 + 32) * ML_QP + sch * 16) = pq1;
    *(LAS u32x4*)(lds + ML_K + srow0 * ML_QP + sch * 16) = pk0; *(LAS u32x4*)(lds + ML_K + (srow0 + 32) * ML_QP + sch * 16) = pk1;
    *(LAS u32x4*)(lds + ML_V + vrow * ML_VP + vch * 16) = pv;
    __syncthreads();
    float hv0[4] = {0.f, 0.f, 0.f, 0.f}, hv1[4] = {0.f, 0.f, 0.f, 0.f}, sv0[4] = {0.f, 0.f, 0.f, 0.f}, sv1[4] = {0.f, 0.f, 0.f, 0.f};
#define ML_FLUSH(rprev) do { _Pragma("unroll") for (int i = 0; i < 4; ++i) { const int t = 16 * rb + 4 * q4 + i; \
        bf16_t* hp = HRAW + ((rprev) + t) * DM + h * 256 + e0 + i16; hp[0] = (bf16_t)f2bf(hv0[i]); hp[16] = (bf16_t)f2bf(hv1[i]); \
        if (i16 == 0) { float* sp = SQ + ((rprev) + t) * 128 + h * 16 + 4 * sl + 2 * ea; sp[0] = sv0[i]; sp[1] = sv1[i]; } } } while (0)
#pragma unroll 1
    for (int c = 0; c < 32; ++c) {
        const int cur = c & 1, nxt = cur ^ 1;
        const size_t r0 = rbase + 64 * c;
        const LAS unsigned char* Qc = lds + ML_Q + cur * ML_QSZ; const LAS unsigned char* Kc = lds + ML_K + cur * ML_QSZ;
        const float ig = pig, lf = plf;
        asm volatile("" :: "v"(ig), "v"(lf));
        if (c > 0) ML_FLUSH(r0 - 64);
        { const size_t rn = rbase + 64 * ((c < 31) ? c + 1 : c);
          const bf16_t* s0 = QKVO + (rn + srow0) * NIN + h * 128 + 8 * sch; const bf16_t* s1 = s0 + (size_t)32 * NIN;
          pq0 = *(const u32x4*)s0; pk0 = *(const u32x4*)(s0 + 1024); pq1 = *(const u32x4*)s1; pk1 = *(const u32x4*)(s1 + 1024);
          pv = *(const u32x4*)(QKVO + (rn + vrow) * NIN + 2048 + h * 256 + 64 * sl + 8 * vch);
          pig = GATES[(rn + lane) * 16 + h]; plf = GATES[(rn + lane) * 16 + 8 + h]; }
        const float bcum = scan_sum(lf, lane);
        const float av = ig - bcum;
        const float Av = fmaxf(m, scan_max(av, lane));
        const float bL = __shfl(bcum, 63), A63 = __shfl(Av, 63);
        const float wsv = fexp(av - A63), wC = fexp(m - A63);
#pragma unroll
        for (int i = 0; i < 2; ++i) { const int id = lane + 64 * i, rr = 8 * wave + (id >> 4), ch = id & 15;
            const u32x4 kx = *(const LAS u32x4*)(Kc + rr * ML_QP + ch * 16); const float w = __shfl(wsv, rr);
            u32x4 o; o.x = pk2(bflo(kx.x) * w, bfhi(kx.x) * w); o.y = pk2(bflo(kx.y) * w, bfhi(kx.y) * w); o.z = pk2(bflo(kx.z) * w, bfhi(kx.z) * w); o.w = pk2(bflo(kx.w) * w, bfhi(kx.w) * w);
            *(LAS u32x4*)(lds + ML_KW + rr * ML_QP + ch * 16) = o; }
        {
#pragma unroll
          for (int cc = 0; cc < 2; ++cc) { const int cb = 2 * (wave & 1) + cc;
            f32x4 s = {0.f, 0.f, 0.f, 0.f};
            if (cb <= rb) {
#pragma unroll
                for (int ks = 0; ks < 4; ++ks) { const bf16x8 af = *(const LAS bf16x8*)(Qc + (16 * rb + i16) * ML_QP + (32 * ks + 8 * q4) * 2);
                    const bf16x8 bf = *(const LAS bf16x8*)(Kc + (16 * cb + i16) * ML_QP + (32 * ks + 8 * q4) * 2); s = mma16(af, bf, s); } }
            const int sidx = 16 * cb + i16; const float as = __shfl(av, sidx);
#pragma unroll
            for (int i = 0; i < 4; ++i) { const int t = 16 * rb + 4 * q4 + i; const float At = __shfl(Av, t);
                const float pv_ = (sidx <= t && cb <= rb) ? s[i] * fexp(as - At) : 0.f;
                *(LAS bf16_t*)(lds + ML_P + t * ML_PP + sidx * 2) = (bf16_t)f2bf(pv_); } } }
        LDS_BARRIER();
        { const int t = tid >> 3, part = tid & 7;
          const LAS unsigned char* qrow = Qc + t * ML_QP + part * 32;
          const u32x4 qa = *(const LAS u32x4*)(qrow), qb = *(const LAS u32x4*)(qrow + 16);
          const LAS float* nn = nS + cur * 128 + 16 * part;
          float a = nn[0] * bflo(qa.x) + nn[1] * bfhi(qa.x) + nn[2] * bflo(qa.y) + nn[3] * bfhi(qa.y) + nn[4] * bflo(qa.z) + nn[5] * bfhi(qa.z) + nn[6] * bflo(qa.w) + nn[7] * bfhi(qa.w)
                  + nn[8] * bflo(qb.x) + nn[9] * bfhi(qb.x) + nn[10] * bflo(qb.y) + nn[11] * bfhi(qb.y) + nn[12] * bflo(qb.z) + nn[13] * bfhi(qb.z) + nn[14] * bflo(qb.w) + nn[15] * bfhi(qb.w);
          const u32x4 pr = *(const LAS u32x4*)(lds + ML_P + t * ML_PP + part * 16);
          const float rsum = ((bflo(pr.x) + bfhi(pr.x)) + (bflo(pr.y) + bfhi(pr.y))) + ((bflo(pr.z) + bfhi(pr.z)) + (bflo(pr.w) + bfhi(pr.w)));
          const float At = __shfl(Av, t), bt = __shfl(bcum, t);
          float val = fexp(m - At) * a + rsum;
          val = row8_sum(val);
          if (part == 0) denS[t] = 1.f / fmaxf(fabsf(val), fexp(-(bt + At))); }
        if (tid < 128) { float acc = wC * nS[cur * 128 + tid];
#pragma unroll 8
            for (int s = 0; s < 64; ++s) acc += bf1(*(const LAS bf16_t*)(lds + ML_KW + s * ML_QP + tid * 2));
            nS[nxt * 128 + tid] = acc; }
        f32x4 num0 = {0.f, 0.f, 0.f, 0.f}, num1 = {0.f, 0.f, 0.f, 0.f};
#pragma unroll
        for (int ks = 0; ks < 4; ++ks) { const LAS unsigned char* qrow = Qc + (16 * rb + i16) * ML_QP;
            const u32x2 lo = *(const LAS u32x2*)(qrow + (32 * ks + 4 * q4) * 2), hi = *(const LAS u32x2*)(qrow + (32 * ks + 16 + 4 * q4) * 2);
            u32x4 w; w.x = lo.x; w.y = lo.y; w.z = hi.x; w.w = hi.y; const bf16x8 af = __builtin_bit_cast(bf16x8, w);
            num0 = mma16(af, pack8(CT[0][2 * ks], CT[0][2 * ks + 1]), num0); num1 = mma16(af, pack8(CT[1][2 * ks], CT[1][2 * ks + 1]), num1); }
#pragma unroll
        for (int i = 0; i < 4; ++i) { const float wi = fexp(m - __shfl(Av, 16 * rb + 4 * q4 + i)); num0[i] *= wi; num1[i] *= wi; }
        const unsigned vbase = vbase0 + cur * ML_VSZ;
        bf16x8 V00, V01, V10, V11;
        TR_READ4(V00, V01, V10, V11, vbase, 0, 4 * ML_VP, 32 * ML_VP, 36 * ML_VP, 32, 4 * ML_VP + 32, 32 * ML_VP + 32, 36 * ML_VP + 32);
        { const bf16x8 pf0 = *(const LAS bf16x8*)(lds + ML_P + (16 * rb + i16) * ML_PP + (8 * q4) * 2), pf1 = *(const LAS bf16x8*)(lds + ML_P + (16 * rb + i16) * ML_PP + (32 + 8 * q4) * 2);
          num0 = mma16(pf0, V00, num0); num0 = mma16(pf1, V01, num0); num1 = mma16(pf0, V10, num1); num1 = mma16(pf1, V11, num1); }
#pragma unroll
        for (int a = 0; a < 2; ++a)
#pragma unroll
            for (int d = 0; d < 8; ++d) CT[a][d] = CT[a][d] * wC;
#pragma unroll
        for (int ks = 0; ks < 2; ++ks)
#pragma unroll
            for (int dg = 0; dg < 2; ++dg) { bf16x8 k0, k1, k2, k3;
                TR_READ4(k0, k1, k2, k3, kwbase, 32 * ks * ML_QP + 32 * (4 * dg), (32 * ks + 4) * ML_QP + 32 * (4 * dg), 32 * ks * ML_QP + 32 * (4 * dg + 1), (32 * ks + 4) * ML_QP + 32 * (4 * dg + 1),
                         32 * ks * ML_QP + 32 * (4 * dg + 2), (32 * ks + 4) * ML_QP + 32 * (4 * dg + 2), 32 * ks * ML_QP + 32 * (4 * dg + 3), (32 * ks + 4) * ML_QP + 32 * (4 * dg + 3));
                const bf16x8 va = ks ? V01 : V00, vb = ks ? V11 : V10;
                CT[0][4 * dg] = mma16(k0, va, CT[0][4 * dg]); CT[0][4 * dg + 1] = mma16(k1, va, CT[0][4 * dg + 1]); CT[0][4 * dg + 2] = mma16(k2, va, CT[0][4 * dg + 2]); CT[0][4 * dg + 3] = mma16(k3, va, CT[0][4 * dg + 3]);
                CT[1][4 * dg] = mma16(k0, vb, CT[1][4 * dg]); CT[1][4 * dg + 1] = mma16(k1, vb, CT[1][4 * dg + 1]); CT[1][4 * dg + 2] = mma16(k2, vb, CT[1][4 * dg + 2]); CT[1][4 * dg + 3] = mma16(k3, vb, CT[1][4 * dg + 3]); }
        { LAS unsigned char* Qn = lds + ML_Q + nxt * ML_QSZ; LAS unsigned char* Kn = lds + ML_K + nxt * ML_QSZ;
          *(LAS u32x4*)(Qn + srow0 * ML_QP + sch * 16) = pq0; *(LAS u32x4*)(Qn + (srow0 + 32) * ML_QP + sch * 16) = pq1;
          *(LAS u32x4*)(Kn + srow0 * ML_QP + sch * 16) = pk0; *(LAS u32x4*)(Kn + (srow0 + 32) * ML_QP + sch * 16) = pk1;
          *(LAS u32x4*)(lds + ML_V + nxt * ML_VSZ + vrow * ML_VP + vch * 16) = pv; }
        LDS_BARRIER();
#pragma unroll
        for (int i = 0; i < 4; ++i) { const int t = 16 * rb + 4 * q4 + i; const float dinv = denS[t]; const float h0 = num0[i] * dinv, h1 = num1[i] * dinv;
            hv0[i] = h0; hv1[i] = h1;
            float s0 = h0 * h0, s1 = h1 * h1;
            s0 = row16_sum(s0);
            s1 = row16_sum(s1);
            sv0[i] = s0; sv1[i] = s1; }
        m = bL + A63;
    }
    ML_FLUSH(rbase + 64 * 31);
#undef ML_FLUSH
    const size_t sb = (size_t)(ib * NBP + b) * 8 + h;
    if (rb == 0) {
#pragma unroll
        for (int a = 0; a < 2; ++a)
#pragma unroll
            for (int d = 0; d < 8; ++d) *(f32x4*)(out + O_CP + (sb * 256 + e0 + 16 * a + i16) * 128 + 16 * d + 4 * q4) = CT[a][d]; }
    if (sl == 0) { if (tid < 128) out[O_NP + sb * 128 + tid] = nS[tid]; if (tid == 0) out[O_MP + sb] = m; }
}

__device__ __forceinline__ void hn_row(const bf16_t* HRAW, const float* SQ, const bf16_t* QKVO, const float* gh, bf16_t* HN, int r, int lane) {
    const int hh = lane >> 3;
    const f32x4 s0 = *(const f32x4*)(SQ + (size_t)r * 128 + hh * 16), s1 = *(const f32x4*)(SQ + (size_t)r * 128 + hh * 16 + 4), s2 = *(const f32x4*)(SQ + (size_t)r * 128 + hh * 16 + 8), s3 = *(const f32x4*)(SQ + (size_t)r * 128 + hh * 16 + 12);
    const float tot = (((s0[0] + s0[1]) + (s0[2] + s0[3])) + ((s1[0] + s1[1]) + (s1[2] + s1[3]))) + (((s2[0] + s2[1]) + (s2[2] + s2[3])) + ((s3[0] + s3[1]) + (s3[2] + s3[3])));
    const float rs = rsqrtf(tot * (1.f / 256.f) + EPS);
#pragma unroll
    for (int c = 0; c < 4; ++c) { const int col = 32 * lane + 8 * c;
        const u32x4 hx = *(const u32x4*)(HRAW + (size_t)r * DM + col), ox = *(const u32x4*)(QKVO + (size_t)r * NIN + 4096 + col);
        const f32x4 g0 = *(const f32x4*)(gh + col), g1 = *(const f32x4*)(gh + col + 4);
        u32x4 o;
        o.x = pk2(bflo(hx.x) * rs * g0[0] / (1.f + fexp(-bflo(ox.x))), bfhi(hx.x) * rs * g0[1] / (1.f + fexp(-bfhi(ox.x))));
        o.y = pk2(bflo(hx.y) * rs * g0[2] / (1.f + fexp(-bflo(ox.y))), bfhi(hx.y) * rs * g0[3] / (1.f + fexp(-bfhi(ox.y))));
        o.z = pk2(bflo(hx.z) * rs * g1[0] / (1.f + fexp(-bflo(ox.z))), bfhi(hx.z) * rs * g1[1] / (1.f + fexp(-bfhi(ox.z))));
        o.w = pk2(bflo(hx.w) * rs * g1[2] / (1.f + fexp(-bflo(ox.w))), bfhi(hx.w) * rs * g1[3] / (1.f + fexp(-bfhi(ox.w))));
        *(u32x4*)(HN + (size_t)r * DM + col) = o; }
}

__device__ __forceinline__ void mlstm_sample(LAS unsigned char* lds, const bf16_t* QKVO, const float* GATES, const float* gh, const float* C0all, const float* n0all, const float* m0all, bf16_t* HN, float* out, int ib, int bh, int tid, int wave, int lane) {
    const int bs = bh >> 3, h = bh & 7;
    const size_t sb = (size_t)(ib * NBS + bs) * 8 + h;
    LAS float* qs = (LAS float*)lds;
    LAS float* ks = qs + 512;
    LAS float* ns = ks + 512;
    LAS float* Ss = ns + 128;
    LAS float* nq = Ss + 16;
    LAS float* red = nq + 16;
    const size_t r0 = (size_t)MP + bs * 4;
    __syncthreads();
    { const int t = tid >> 7, d = tid & 127; qs[tid] = bf1(QKVO[(r0 + t) * NIN + h * 128 + d]); ks[tid] = bf1(QKVO[(r0 + t) * NIN + 1024 + h * 128 + d]); if (tid < 128) ns[tid] = n0all[sb * 128 + tid]; }
    __syncthreads();
    if (wave == 0) {
        if (lane < 16) { const int t = lane >> 2, s = lane & 3; float a = 0.f; for (int d = 0; d < 128; ++d) a += qs[t * 128 + d] * ks[s * 128 + d]; Ss[lane] = a; }
        else if (lane < 20) { const int t = lane - 16; float a = 0.f; for (int d = 0; d < 128; ++d) a += ns[d] * qs[t * 128 + d]; nq[t] = a; }
    }
    __syncthreads();
    const float m0 = m0all[sb];
    float bc[4], av[4], Av[4];
    { float run = 0.f, pm = -INFINITY;
#pragma unroll
      for (int t = 0; t < 4; ++t) { const float ig = GATES[(r0 + t) * 16 + h], lf = GATES[(r0 + t) * 16 + 8 + h]; run += lf; bc[t] = run; av[t] = ig - run; pm = fmaxf(pm, av[t]); Av[t] = fmaxf(m0, pm); } }
    const float A3 = Av[3], wC = fexp(m0 - A3);
    float Pm[4][4], den[4];
#pragma unroll
    for (int t = 0; t < 4; ++t) { float rs = 0.f;
#pragma unroll
        for (int s = 0; s < 4; ++s) { Pm[t][s] = (s <= t) ? Ss[t * 4 + s] * fexp(av[s] - Av[t]) : 0.f; rs += Pm[t][s]; }
        den[t] = fexp(m0 - Av[t]) * nq[t] + rs; }
    const int e = tid >> 1, hf = tid & 1;
    const float* Crow = C0all + (sb * 256 + e) * 128 + 64 * hf;
    f32x4 Cv[16];
#pragma unroll
    for (int j = 0; j < 16; ++j) Cv[j] = *(const f32x4*)(Crow + 4 * j);
    float inter[4];
#pragma unroll
    for (int t = 0; t < 4; ++t) { float a = 0.f; const LAS float* q = qs + t * 128 + 64 * hf;
#pragma unroll
        for (int j = 0; j < 16; ++j) a += Cv[j].x * q[4 * j] + Cv[j].y * q[4 * j + 1] + Cv[j].z * q[4 * j + 2] + Cv[j].w * q[4 * j + 3];
        a += __shfl_xor(a, 1); inter[t] = a; }
    float vv[4];
#pragma unroll
    for (int s = 0; s < 4; ++s) vv[s] = bf1(QKVO[(r0 + s) * NIN + 2048 + h * 256 + e]);
    float hv[4];
#pragma unroll
    for (int t = 0; t < 4; ++t) { float nu = fexp(m0 - Av[t]) * inter[t];
#pragma unroll
        for (int s = 0; s < 4; ++s) nu += Pm[t][s] * vv[s];
        hv[t] = nu / fmaxf(fabsf(den[t]), fexp(-(bc[t] + Av[t])));
        float sq = (hf == 0) ? hv[t] * hv[t] : 0.f; sq = wave_sum(sq); if (lane == 0) red[t * 8 + wave] = sq; }
    __syncthreads();
    if (hf == 0) {
#pragma unroll
        for (int t = 0; t < 4; ++t) { float tot = 0.f;
#pragma unroll
            for (int w = 0; w < 8; ++w) tot += red[t * 8 + w];
            const float rs = rsqrtf(tot * (1.f / 256.f) + EPS);
            const float og = bf1(QKVO[(r0 + t) * NIN + 4096 + h * 256 + e]);
            HN[(r0 + t) * DM + h * 256 + e] = (bf16_t)f2bf(hv[t] * rs * gh[h * 256 + e] / (1.f + fexp(-og))); } }
    float wv[4];
#pragma unroll
    for (int s = 0; s < 4; ++s) wv[s] = fexp(av[s] - A3) * vv[s];
    float* Cout = out + O_CS + (sb * 256 + e) * 128 + 64 * hf;
#pragma unroll
    for (int j = 0; j < 16; ++j) { f32x4 o = Cv[j] * wC;
#pragma unroll
        for (int s = 0; s < 4; ++s) { const LAS float* k = ks + s * 128 + 64 * hf + 4 * j; o.x += wv[s] * k[0]; o.y += wv[s] * k[1]; o.z += wv[s] * k[2]; o.w += wv[s] * k[3]; }
        *(f32x4*)(Cout + 4 * j) = o; }
    if (tid < 128) { float o = wC * ns[tid];
#pragma unroll
        for (int s = 0; s < 4; ++s) o += fexp(av[s] - A3) * ks[s * 128 + tid];
        out[O_NS + sb * 128 + tid] = o; }
    if (tid == 0) out[O_MS + sb] = bc[3] + A3;
}

__device__ __forceinline__ void cache_shift(const Params& P, float* outp, int ia, int w, int NW, int lane) {
    constexpr int N0 = NBS * 124, N1 = NBS * 508, N2 = NBS * 2044;
    for (int it = w; it < N0 + N1 + N2; it += NW) {
        int g, q; if (it < N0) { g = 0; q = it; } else if (it < N0 + N1) { g = 1; q = it - N0; } else { g = 2; q = it - N0 - N1; }
        const int win = 128 << (2 * g), per = win - 4, bs = q / per, j = q % per;
        const float* src = P.in[2 + g] + ((size_t)(ia * NBS + bs) * win + j + 4) * 2048;
        float* dst = outp + ((g == 0) ? O_KV128S : (g == 1) ? O_KV512S : O_KV2048S) + ((size_t)(ia * NBS + bs) * win + j) * 2048;
#pragma unroll
        for (int i = 0; i < 8; ++i) ((f32x4*)dst)[lane + 64 * i] = ((const f32x4*)src)[lane + 64 * i];
    }
}

__device__ __forceinline__ void phase_convgate(const Params& P, float* outp, const bf16_t* U, bf16_t* Z, int layer, int gtid, int NGT) {
    constexpr int NCG = DFF / 8, NRUN = MP / 64 + NBS;
    const float* cw = P.in[20] + (size_t)layer * 3 * NUP; const float* cbias = P.in[21] + (size_t)layer * NUP;
    for (int task = gtid; task < NCG * NRUN; task += NGT) {
        const int cg = task % NCG, run = task / NCG, j0 = 8 * cg;
        const int ua0 = 256 * (j0 >> 7) + (j0 & 127), ub0 = ua0 + 128;
        float wa[3][8], wb[3][8], ba[8], bb[8];
#pragma unroll
        for (int k = 0; k < 3; ++k) { load8(cw + (size_t)k * NUP + j0, wa[k]); load8(cw + (size_t)k * NUP + DFF + j0, wb[k]); }
        load8(cbias + j0, ba); load8(cbias + DFF + j0, bb);
        float a2[8], a1[8], b2[8], b1[8];
        size_t row0; int nrows; float* cout;
        if (run < MP / 64) { const int b = run >> 5, s0 = (run & 31) * 64; row0 = (size_t)b * SEQ + s0; nrows = 64;
            cout = (s0 == SEQ - 64) ? outp + O_CONVP + ((size_t)(layer * NBP + b) * 2) * NUP : nullptr;
            if (s0 == 0) {
#pragma unroll
                for (int j = 0; j < 8; ++j) { a2[j] = 0.f; a1[j] = 0.f; b2[j] = 0.f; b1[j] = 0.f; } }
            else { unpack8(*(const u32x4*)(U + (row0 - 2) * NUP + ua0), a2); unpack8(*(const u32x4*)(U + (row0 - 1) * NUP + ua0), a1);
                   unpack8(*(const u32x4*)(U + (row0 - 2) * NUP + ub0), b2); unpack8(*(const u32x4*)(U + (row0 - 1) * NUP + ub0), b1); } }
        else { const int bs = run - MP / 64; row0 = (size_t)MP + bs * 4; nrows = 4;
            cout = outp + O_CONVS + ((size_t)(layer * NBS + bs) * 2) * NUP;
            const float* st = P.in[8] + ((size_t)(layer * NBS + bs) * 2) * NUP;
            load8(st + j0, a2); load8(st + NUP + j0, a1); load8(st + DFF + j0, b2); load8(st + NUP + DFF + j0, b1); }
        for (int t = 0; t < nrows; t += 4) {
            u32x4 ua[4], ub[4];
#pragma unroll
            for (int q = 0; q < 4; ++q) { ua[q] = *(const u32x4*)(U + (row0 + t + q) * NUP + ua0); ub[q] = *(const u32x4*)(U + (row0 + t + q) * NUP + ub0); }
#pragma unroll
            for (int q = 0; q < 4; ++q) {
                float a0[8], b0[8];
                unpack8(ua[q], a0); unpack8(ub[q], b0);
                float z[8];
#pragma unroll
                for (int j = 0; j < 8; ++j) { const float ca = ba[j] + wa[0][j] * a2[j] + wa[1][j] * a1[j] + wa[2][j] * a0[j]; const float cb = bb[j] + wb[0][j] * b2[j] + wb[1][j] * b1[j] + wb[2][j] * b0[j];
                    z[j] = ca / (1.f + fexp(-ca)) * cb; a2[j] = a1[j]; a1[j] = a0[j]; b2[j] = b1[j]; b1[j] = b0[j]; }
                u32x4 o; o.x = pk2(z[0], z[1]); o.y = pk2(z[2], z[3]); o.z = pk2(z[4], z[5]); o.w = pk2(z[6], z[7]);
                *(u32x4*)(Z + (row0 + t + q) * DFF + j0) = o;
            }
        }
        if (cout) { store8(cout + j0, a2); store8(cout + NUP + j0, a1); store8(cout + DFF + j0, b2); store8(cout + NUP + DFF + j0, b1); }
    }
}

#ifndef REP_STORE
#define REP_STORE 1
#endif
#ifndef REP_CONV
#define REP_CONV 1
#endif
#ifndef REP_ML
#define REP_ML 1
#endif
#ifndef REP_ATT
#define REP_ATT 1
#endif
#ifndef REP_RESID
#define REP_RESID 1
#endif
#ifndef REP_FIN
#define REP_FIN 1
#endif
#ifndef REP_CS
#define REP_CS 1
#endif
#ifndef REP_MR
#define REP_MR 1
#endif
#ifndef REP_UP
#define REP_UP 0
#endif
#ifndef REP_BAR
#define REP_BAR 1
#endif
#ifndef REP_P0
#define REP_P0 1
#endif
#define REPEAT(n, body) do { body; if ((n) > 1) { body; } if ((n) > 2) { body; } } while (0)
__global__ void __launch_bounds__(NTHR, 2) fwd_kernel(Params P) {
    extern __shared__ __attribute__((aligned(16))) unsigned char lds_raw[];
    LAS unsigned char* lds = (LAS unsigned char*)lds_raw;
    const unsigned lds_base = (unsigned)(size_t)lds;
    const int tid0 = threadIdx.x;
    const int G0 = gridDim.x, bx0 = blockIdx.x;
#define PHASE_IDS int tid = tid0; asm volatile("" : "+v"(tid)); int zz_ = 0; asm volatile("" : "+v"(zz_)); zz_ = __builtin_amdgcn_readfirstlane(zz_); const int bx = bx0 + zz_, G = G0 + zz_; unsigned char* ws = P.ws + zz_; float* outp = P.out + zz_; \
    const int lane = tid & 63, wave = __builtin_amdgcn_readfirstlane(tid >> 6); const int gw = bx * NWAVES + wave, gtid = bx * NTHR + tid, NGW = G * NWAVES, NGT = G * NTHR; (void)gw; (void)gtid; (void)lane; (void)NGW; (void)NGT; (void)outp; \
    bf16_t* XB = (bf16_t*)(ws + WS_XB); float* SSQ = (float*)(ws + WS_SSQ); float* SSQS = (float*)(ws + WS_SSQS); bf16_t* QKV = (bf16_t*)(ws + WS_QKV); bf16_t* OG = (bf16_t*)(ws + WS_OG); float* LSE = (float*)(ws + WS_LSE); bf16_t* OC = (bf16_t*)(ws + WS_OC); \
    float* GATES = (float*)(ws + WS_GATES); bf16_t* U = (bf16_t*)(ws + WS_U); bf16_t* Z = (bf16_t*)(ws + WS_Z); (void)XB; (void)SSQ; (void)SSQS; (void)QKV; (void)OG; (void)LSE; (void)OC; (void)GATES; (void)U; (void)Z;
    volatile LAS unsigned* misc = (volatile LAS unsigned*)(lds + LDS_MISC_OFF);
    if (tid0 < 16) misc[tid0] = 0u;
    __syncthreads();
    { const XcdBarrier bar0 = xcd_barrier_post((unsigned*)(P.ws + WS_CTL) + 1024, misc + 8); if (tid0 == 0) misc[10] = bar0.x; }
    __syncthreads();
#define GRID_BAR() do { XcdBarrier bar_; bar_.bar = (unsigned*)(P.ws + WS_CTL) + 1024; bar_.x = (unsigned)__builtin_amdgcn_readfirstlane((int)misc[10]); bar_.st = misc + 8; xcd_barrier(bar_); if (REP_BAR > 1) xcd_barrier(bar_); } while (0)
#define GEMM_STORE(Abuf, Wt, NN, KK, Obuf) REPEAT(REP_STORE, GEMM_STORE1(Abuf, Wt, NN, KK, Obuf))
#define GEMM_STORE1(Abuf, Wt, NN, KK, Obuf) do { PHASE_IDS; \
        { pg8::Gemm g{Abuf, (const bf16_t*)(Wt), MP, NN, KK}; pg8::StaticOrder S; S.init(MP, NN, G, bx); const int pm0_ = pg8::first_pm(S); LAS float* rtab_ = (LAS float*)(lds + RING_BYTES); pg8::rstd_panel(rtab_, SSQ, pm0_, EPS, tid); pg8::EpiStoreN E{Obuf, NN, SSQ, EPS, rtab_, pm0_}; \
          pg8::gemm_phase<pg8::EpiStoreN, pg8::StaticOrder, true, true>(lds, g, S, E); } \
        skinny_phase<0>(lds, Abuf + (size_t)MP * KK, KK, (const bf16_t*)(Wt), NN, Obuf + (size_t)MP * NN, NN, nullptr, SSQS, nullptr, bx, G, (((MP / 256) * ((NN) / 256)) % G) ? G - (((MP / 256) * ((NN) / 256)) % G) : G, tid, wave, lane); } while (0)
#define GEMM_RESID(Abuf, Wt, KK, FIN) do { PHASE_IDS; \
        { pg8::Gemm g{Abuf, (const bf16_t*)(Wt), MP, DM, KK}; pg8::StaticOrder S; S.init(MP, DM, G, bx); pg8::EpiResidN E{XB, (FIN) ? outp : nullptr, (FIN) ? nullptr : SSQ, DM}; \
          pg8::gemm_phase<pg8::EpiResidN, pg8::StaticOrder, true, true>(lds, g, S, E); } \
        if (FIN) skinny_phase<2>(lds, Abuf + (size_t)MP * KK, KK, (const bf16_t*)(Wt), DM, nullptr, 0, XB + (size_t)MP * DM, nullptr, outp + (size_t)MP * DM, bx, G, G, tid, wave, lane); \
        else skinny_phase<1>(lds, Abuf + (size_t)MP * KK, KK, (const bf16_t*)(Wt), DM, nullptr, 0, XB + (size_t)MP * DM, SSQS, nullptr, bx, G, G, tid, wave, lane); } while (0)

    REPEAT(REP_P0, { PHASE_IDS; phase_prologue(P, lds, gw, NGW, wave, lane); });
    GRID_BAR();

#define FFN(L, FIN) do { \
        { PHASE_IDS; unsigned* ctl_ = (unsigned*)(ws + WS_CTL); \
          skinny_up(lds, P.in[8], P.in[20] + (size_t)(L) * 3 * NUP, P.in[21] + (size_t)(L) * NUP, XB, (const bf16_t*)(ws + WS_WUP + (L) * SZ_WUP), SSQ, SSQS, (float*)(ws + WS_HALO), ctl_ + CW_HCNT, Z, outp, (L), bx, G, 128, tid, wave, lane); \
          { pg8::Gemm g{XB, (const bf16_t*)(ws + WS_WUP + (L) * SZ_WUP), MP, NUP, DM}; pg8::StaticOrder S; S.init(MP, NUP, G, bx); const int pm0_ = pg8::first_pm(S); \
            LAS float* rtab_ = (LAS float*)(lds + RING_BYTES); volatile LAS unsigned* rdy_ = (volatile LAS unsigned*)(lds + RING_BYTES + 1024 + 8192); if (tid == 0) rdy_[0] = 0u; pg8::rstd_panel(rtab_, SSQ, pm0_, EPS, tid); \
            pg8::EpiConv E{ws, P.in[20] + (size_t)(L) * 3 * NUP, P.in[21] + (size_t)(L) * NUP, lds + RING_BYTES, (unsigned)((L) + 1) * (unsigned)(SU_NITEMS * 4), pm0_}; \
            pg8::gemm_phase<pg8::EpiConv, pg8::StaticOrder, true, true>(lds, g, S, E); \
            if (REP_UP == 1) pg8::gemm_phase<pg8::EpiConv, pg8::StaticOrder, true, true>(lds, g, S, E); \
            if (REP_UP == 2) { pg8::EpiNull EN{(float*)(ws + WS_U)}; pg8::gemm_phase<pg8::EpiNull, pg8::StaticOrder, true, true>(lds, g, S, EN); } } } \
        GRID_BAR(); \
        GEMM_RESID(Z, ws + WS_WDOWN + (L) * SZ_WDOWN, DFF, FIN); \
    } while (0)

#define LAYER_PAIR(lp) do { \
        { \
            const int ia = (lp); \
            GEMM_STORE(XB, ws + WS_WQKV + ia * SZ_WQKV, NQKV, DM, QKV); \
            GRID_BAR(); \
            REPEAT(REP_ATT, { PHASE_IDS; attn_phase(lds, lds_base, QKV, (const float*)(ws + WS_ROPE), P.in[12] + ia * 128, P.in[13] + ia * 128, outp, ia, OG, LSE, bx, G, 1536, tid, wave, lane); } \
            { PHASE_IDS; for (int wt = bx + G * wave; wt < NBS * 96; wt += G * NWAVES) attn_sample_task(lds + wave * 4096, QKV, (const float*)(ws + WS_ROPE), P.in[12] + ia * 128, P.in[13] + ia * 128, outp, P.in[2], P.in[3], P.in[4], OG, LSE, ia, wt, lane); __syncthreads(); }); \
            GRID_BAR(); \
            REPEAT(REP_ATT, { PHASE_IDS; for (int r = gw; r < MR; r += NGW) combine_row(OG, LSE, OC, r, lane); }); \
            GRID_BAR(); \
            GEMM_RESID(OC, ws + WS_WO + ia * SZ_WO, DO, false); \
            GRID_BAR(); \
            FFN(2 * (lp), false); \
            GRID_BAR(); \
        } \
        { \
            const int L = 2 * (lp) + 1, ib = (lp); \
            GEMM_STORE(XB, ws + WS_WIN + ib * SZ_WIN, NIN, DM, QKV); \
            { PHASE_IDS; for (int task = G - 1 - bx; task < MR / 16; task += G) gate_block(lds, XB, (const f32x4*)(ws + WS_WGP) + (size_t)ib * 128 * 64, P.in[16] + ib * 16, GATES, task, wave, lane); } \
            GRID_BAR(); \
            REPEAT(REP_ML, { PHASE_IDS; \
            if (bx < 128) { mlstm_prompt(lds, lds_base, QKV, GATES, OG, (float*)(ws + WS_SQ), outp, ib, bx, tid, wave, lane); if (REP_MR > 1) { __syncthreads(); mlstm_prompt(lds, lds_base, QKV, GATES, OG, (float*)(ws + WS_SQ), outp, ib, bx, tid, wave, lane); } } \
            else { if (bx < 192) mlstm_sample(lds, QKV, GATES, P.in[17] + (size_t)ib * DM, P.in[5], P.in[6], P.in[7], OC, outp, ib, bx - 128, tid, wave, lane); \
                   cache_shift(P, outp, (lp), (bx - 128) * NWAVES + wave, (G - 128) * NWAVES, lane); } }); \
            GRID_BAR(); \
            REPEAT(REP_FIN, { PHASE_IDS; for (int r = gw; r < MP; r += NGW) hn_row(OG, (const float*)(ws + WS_SQ), QKV, P.in[17] + (size_t)ib * DM, OC, r, lane); }); \
            GRID_BAR(); \
            GEMM_RESID(OC, ws + WS_WOUT + ib * SZ_WOUT, DM, false); \
            GRID_BAR(); \
            FFN(L, (L == DEPTH - 1)); \
            if ((lp) == 0) GRID_BAR(); \
        } \
    } while (0)
    LAYER_PAIR(0);
    LAYER_PAIR(1);
}

extern "C" void kernel_launch(void* const* d_in, const int* in_sizes, int n_in, void* d_out, int out_size, void* d_ws, size_t ws_size, hipStream_t stream) {
    static int grid = 0;
    if (grid == 0) {
        if (n_in != 23 || (size_t)out_size != O_END || ws_size < WS_END) {
            fprintf(stderr, "kernel_launch: built for 23 inputs, %zu outputs, >= %zu bytes of workspace; got n_in %d, out %d, ws %zu; nothing launched\n", (size_t)O_END, (size_t)WS_END, n_in, out_size, ws_size);
            grid = -1; return; }
        int dev = 0, cus = 0, per_cu = 0;
        if (hipGetDevice(&dev) != hipSuccess || hipDeviceGetAttribute(&cus, hipDeviceAttributeMultiprocessorCount, dev) != hipSuccess) { fprintf(stderr, "kernel_launch: device query failed\n"); grid = -1; return; }
        if (hipFuncSetAttribute((const void*)fwd_kernel, hipFuncAttributeMaxDynamicSharedMemorySize, LDS_BYTES) != hipSuccess) { fprintf(stderr, "kernel_launch: hipFuncSetAttribute failed\n"); grid = -1; return; }
        if (hipOccupancyMaxActiveBlocksPerMultiprocessor(&per_cu, (const void*)fwd_kernel, NTHR, LDS_BYTES) != hipSuccess || per_cu < 1)
            fprintf(stderr, "kernel_launch: occupancy query reports %d workgroups per CU\n", per_cu);
        (void)hipGetLastError();
        grid = cus;
    }
    if (grid < 0) return;
    (void)hipMemsetAsync((char*)d_ws + WS_CTL, 0, CTL_ZERO_BYTES, stream);
    Params p{};
    for (int i = 0; i < 23; ++i) p.in[i] = (const float*)d_in[i];
    p.out = (float*)d_out; p.ws = (unsigned char*)d_ws;
    hipLaunchKernelGGL(fwd_kernel, dim3(grid), dim3(NTHR), LDS_BYTES, stream, p);
    const hipError_t le = hipPeekAtLastError();
    if (le != hipSuccess) fprintf(stderr, "kernel_launch: launch failed: %s\n", hipGetErrorName(le));
}
```

```cpp
#include <hip/hip_runtime.h>
#include <cstdio>
#include <cstdint>

#define LAS __attribute__((address_space(3)))
typedef unsigned short bf16_t;
typedef short bf16x8 __attribute__((ext_vector_type(8)));
typedef float f32x4 __attribute__((ext_vector_type(4)));
typedef float f32x2 __attribute__((ext_vector_type(2)));
typedef unsigned u32x4 __attribute__((ext_vector_type(4)));
typedef unsigned u32x2 __attribute__((ext_vector_type(2)));
typedef unsigned short u16x4 __attribute__((ext_vector_type(4)));

constexpr int DM = 2048, SEQ = 2048, NBP = 4, NBS = 8, TSAMP = 4, PAST = 16384;
constexpr int MP = NBP * SEQ, MSAMP = NBS * TSAMP, MR = MP + MSAMP, MT = 8448;
constexpr int NQKV = 9216, NIN = 6144, NIN_SRC = 6160, DFF = 5632, NUP = 2 * DFF, DO = 1024;
constexpr int DEPTH = 4;
constexpr float EPS = 1e-6f;
constexpr int NWAVES = 8, NTHR = 512;

constexpr size_t O_YP = 0;
constexpr size_t O_YS = O_YP + (size_t)MP * DM;
constexpr size_t O_KV128P = O_YS + (size_t)MSAMP * DM;
constexpr size_t O_KV128S = O_KV128P + (size_t)2 * NBP * 128 * 2048;
constexpr size_t O_KV512P = O_KV128S + (size_t)2 * NBS * 128 * 2048;
constexpr size_t O_KV512S = O_KV512P + (size_t)2 * NBP * 512 * 2048;
constexpr size_t O_KV2048P = O_KV512S + (size_t)2 * NBS * 512 * 2048;
constexpr size_t O_KV2048S = O_KV2048P + (size_t)2 * NBP * 2048 * 2048;
constexpr size_t O_CP = O_KV2048S + (size_t)2 * NBS * 2048 * 2048;
constexpr size_t O_CS = O_CP + (size_t)2 * NBP * 8 * 256 * 128;
constexpr size_t O_NP = O_CS + (size_t)2 * NBS * 8 * 256 * 128;
constexpr size_t O_NS = O_NP + (size_t)2 * NBP * 8 * 128;
constexpr size_t O_MP = O_NS + (size_t)2 * NBS * 8 * 128;
constexpr size_t O_MS = O_MP + (size_t)2 * NBP * 8;
constexpr size_t O_CONVP = O_MS + (size_t)2 * NBS * 8;
constexpr size_t O_CONVS = O_CONVP + (size_t)DEPTH * NBP * 2 * NUP;
constexpr size_t O_END = O_CONVS + (size_t)DEPTH * NBS * 2 * NUP;

constexpr size_t al1m(size_t x) { return (x + 1048575) & ~(size_t)1048575; }
constexpr size_t WS_CTL = 0, CTL_ZERO_BYTES = 1048576;
constexpr size_t SZ_WQKV = (size_t)NQKV * DM * 2, SZ_WO = (size_t)DM * DO * 2, SZ_WIN = (size_t)NIN * DM * 2, SZ_WOUT = (size_t)DM * DM * 2, SZ_WUP = (size_t)NUP * DM * 2, SZ_WDOWN = (size_t)DM * DFF * 2;
constexpr size_t WS_WQKV = al1m(WS_CTL + CTL_ZERO_BYTES);
constexpr size_t WS_WO = al1m(WS_WQKV + 2 * SZ_WQKV);
constexpr size_t WS_WIN = al1m(WS_WO + 2 * SZ_WO);
constexpr size_t WS_WOUT = al1m(WS_WIN + 2 * SZ_WIN);
constexpr size_t WS_WUP = al1m(WS_WOUT + 2 * SZ_WOUT);
constexpr size_t WS_WDOWN = al1m(WS_WUP + 4 * SZ_WUP);
constexpr size_t WS_X = al1m(WS_WDOWN + 4 * SZ_WDOWN);
constexpr size_t WS_XB = al1m(WS_X + (size_t)MT * DM * 4);
constexpr size_t WS_SSQ = al1m(WS_XB + (size_t)MT * DM * 2);
constexpr size_t WS_SSQS = al1m(WS_SSQ + (size_t)MP * 32 * 4);
constexpr size_t WS_QKV = al1m(WS_SSQS + (size_t)MSAMP * 128 * 4);
constexpr size_t WS_OG = al1m(WS_QKV + (size_t)MT * NQKV * 2);
constexpr size_t WS_LSE = al1m(WS_OG + (size_t)MT * 3072 * 2);
constexpr size_t WS_OC = al1m(WS_LSE + (size_t)MT * 24 * 4);
constexpr size_t WS_GATES = al1m(WS_OC + (size_t)MT * DM * 2);
constexpr size_t WS_U = al1m(WS_GATES + (size_t)MT * 16 * 4);
constexpr size_t WS_Z = al1m(WS_U + (size_t)MT * NUP * 2);
constexpr size_t WS_SQ = al1m(WS_Z + (size_t)MT * DFF * 2);
constexpr size_t WS_ROPE = al1m(WS_SQ + (size_t)MP * 128 * 4);
constexpr size_t WS_WGP = al1m(WS_ROPE + (size_t)2052 * 128 * 4);
constexpr size_t WS_HALO = al1m(WS_WGP + (size_t)2 * 128 * 64 * 16);
constexpr size_t WS_END = al1m(WS_HALO + (size_t)64 * NUP * 4);
constexpr int CW_HCNT = 65536, CW_TMO = 65600, CW_CSQ = 65664, CW_PRG = 66560;

constexpr int RING_BYTES = 131072;
constexpr int LDS_MISC_OFF = 150 * 1024;
constexpr int LDS_BYTES = 152 * 1024;

__device__ __forceinline__ unsigned pk2(float lo, float hi) { unsigned r; asm("v_cvt_pk_bf16_f32 %0, %1, %2" : "=v"(r) : "v"(lo), "v"(hi)); return r; }
__device__ __forceinline__ unsigned f2bf(float f) { return pk2(f, 0.f) & 0xffffu; }
__device__ __forceinline__ float bflo(unsigned w) { return __builtin_bit_cast(float, w << 16); }
__device__ __forceinline__ float bfhi(unsigned w) { return __builtin_bit_cast(float, w & 0xffff0000u); }
__device__ __forceinline__ float bf1(bf16_t b) { return __builtin_bit_cast(float, (unsigned)b << 16); }
__device__ __forceinline__ float fexp(float x) { return __builtin_amdgcn_exp2f(x * 1.4426950408889634f); }
template <int CTRL> __device__ __forceinline__ float dpp_mov(float src) { return __builtin_bit_cast(float, __builtin_amdgcn_mov_dpp(__builtin_bit_cast(int, src), CTRL, 0xf, 0xf, false)); }
__device__ __forceinline__ float row4_sum(float v) { v += dpp_mov<0xB1>(v); v += dpp_mov<0x4E>(v); return v; }
__device__ __forceinline__ float row8_sum(float v) { v = row4_sum(v); v += dpp_mov<0x141>(v); return v; }
__device__ __forceinline__ float row16_sum(float v) { v = row8_sum(v); v += dpp_mov<0x140>(v); return v; }
#define LDS_BARRIER() do { asm volatile("s_waitcnt lgkmcnt(0)" ::: "memory"); __builtin_amdgcn_s_barrier(); asm volatile("" ::: "memory"); } while (0)
__device__ __forceinline__ float wave_sum(float v) {
#pragma unroll
    for (int o = 1; o < 64; o <<= 1) v += __shfl_xor(v, o);
    return v;
}
__device__ __forceinline__ float wave_max(float v) {
#pragma unroll
    for (int o = 1; o < 64; o <<= 1) v = fmaxf(v, __shfl_xor(v, o));
    return v;
}
__device__ __forceinline__ f32x4 mma16(bf16x8 a, bf16x8 b, f32x4 c) { return __builtin_amdgcn_mfma_f32_16x16x32_bf16(a, b, c, 0, 0, 0); }
__device__ __forceinline__ bf16x8 tr_read2(unsigned base, int off0, int off1) {
    u16x4 r0, r1;
    asm volatile("ds_read_b64_tr_b16 %0, %2 offset:%c3\n\tds_read_b64_tr_b16 %1, %2 offset:%c4\n\ts_waitcnt lgkmcnt(0)" : "=&v"(r0), "=&v"(r1) : "v"(base), "i"(off0), "i"(off1) : "memory");
    bf16x8 o; o[0] = (short)r0[0]; o[1] = (short)r0[1]; o[2] = (short)r0[2]; o[3] = (short)r0[3]; o[4] = (short)r1[0]; o[5] = (short)r1[1]; o[6] = (short)r1[2]; o[7] = (short)r1[3];
    return o;
}

__device__ __forceinline__ bf16x8 tr_join(u16x4 r0, u16x4 r1) { bf16x8 o; o[0] = (short)r0[0]; o[1] = (short)r0[1]; o[2] = (short)r0[2]; o[3] = (short)r0[3]; o[4] = (short)r1[0]; o[5] = (short)r1[1]; o[6] = (short)r1[2]; o[7] = (short)r1[3]; return o; }
#define TR_RD "ds_read_b64_tr_b16 "
#define TR_READ4(F0, F1, F2, F3, base, a0, a1, b0, b1, c0, c1, d0, d1) do { u16x4 t0_, t1_, t2_, t3_, t4_, t5_, t6_, t7_; \
    asm volatile(TR_RD "%0, %8 offset:%c9\n\t" TR_RD "%1, %8 offset:%c10\n\t" TR_RD "%2, %8 offset:%c11\n\t" TR_RD "%3, %8 offset:%c12\n\t" TR_RD "%4, %8 offset:%c13\n\t" TR_RD "%5, %8 offset:%c14\n\t" TR_RD "%6, %8 offset:%c15\n\t" TR_RD "%7, %8 offset:%c16\n\ts_waitcnt lgkmcnt(0)" \
        : "=&v"(t0_), "=&v"(t1_), "=&v"(t2_), "=&v"(t3_), "=&v"(t4_), "=&v"(t5_), "=&v"(t6_), "=&v"(t7_) : "v"(base), "i"(a0), "i"(a1), "i"(b0), "i"(b1), "i"(c0), "i"(c1), "i"(d0), "i"(d1) : "memory"); \
    F0 = tr_join(t0_, t1_); F1 = tr_join(t2_, t3_); F2 = tr_join(t4_, t5_); F3 = tr_join(t6_, t7_); } while (0)
#define TR_READ5(F0, F1, F2, F3, F4, base, a0, a1, b0, b1, c0, c1, d0, d1, e0, e1) do { u16x4 t0_, t1_, t2_, t3_, t4_, t5_, t6_, t7_, t8_, t9_; \
    asm volatile(TR_RD "%0, %10 offset:%c11\n\t" TR_RD "%1, %10 offset:%c12\n\t" TR_RD "%2, %10 offset:%c13\n\t" TR_RD "%3, %10 offset:%c14\n\t" TR_RD "%4, %10 offset:%c15\n\t" TR_RD "%5, %10 offset:%c16\n\t" TR_RD "%6, %10 offset:%c17\n\t" TR_RD "%7, %10 offset:%c18\n\t" TR_RD "%8, %10 offset:%c19\n\t" TR_RD "%9, %10 offset:%c20\n\ts_waitcnt lgkmcnt(0)" \
        : "=&v"(t0_), "=&v"(t1_), "=&v"(t2_), "=&v"(t3_), "=&v"(t4_), "=&v"(t5_), "=&v"(t6_), "=&v"(t7_), "=&v"(t8_), "=&v"(t9_) : "v"(base), "i"(a0), "i"(a1), "i"(b0), "i"(b1), "i"(c0), "i"(c1), "i"(d0), "i"(d1), "i"(e0), "i"(e1) : "memory"); \
    F0 = tr_join(t0_, t1_); F1 = tr_join(t2_, t3_); F2 = tr_join(t4_, t5_); F3 = tr_join(t6_, t7_); F4 = tr_join(t8_, t9_); } while (0)
__device__ __forceinline__ bf16x8 pack8(f32x4 a, f32x4 b) {
    u32x4 w; w.x = pk2(a[0], a[1]); w.y = pk2(a[2], a[3]); w.z = pk2(b[0], b[1]); w.w = pk2(b[2], b[3]);
    return __builtin_bit_cast(bf16x8, w);
}

namespace pg8 {
#define PG8_LAS __attribute__((address_space(3)))
typedef unsigned short bf16_t;
typedef short bf16x8 __attribute__((ext_vector_type(8)));
typedef float f32x4 __attribute__((ext_vector_type(4)));
typedef unsigned u32x4 __attribute__((ext_vector_type(4)));
constexpr int BM = 256, BK = 64, HALF = 128, HTB = HALF * BK * 2  , STAGE_BYTES = 8 * HTB, NXCD = 8, WGM = 8;

__host__ __device__ __forceinline__ int lds_byte(int r, int c) { const int st = (r >> 4) * 2 + (c >> 5), rr = r & 15, cc = c & 31, ob = rr * 64 + cc * 2; return st * 1024 + (ob ^ (((ob >> 9) & 1) << 5)); }
__host__ __device__ __forceinline__ void stage_rc(int b, int& R, int& C) { const int st = b / 1024, sb = b % 1024, swz = sb ^ (((sb >> 9) & 1) << 5); R = (st >> 1) * 16 + swz / 64; C = (st & 1) * 32 + (swz % 64) / 2; }
__host__ __device__ __forceinline__ int perm32(int rho) { const int n = rho >> 4, i = rho & 15; return 8 * (i >> 2) + 4 * n + (i & 3); }

struct Unit { int pm, pn; };
struct Gemm { const bf16_t* A; const bf16_t* Bt; int M, N, K; };

struct StaticOrder {
    int nM, nN, nwg, G, c;
    __host__ __device__ void init(int M, int N, int G_, int c_) { nM = M / BM; nN = N / BM; nwg = nM * nN; G = G_; c = c_; }
    __host__ __device__ bool next(int i, Unit& u) const {
        const long L = (long)i * G + c; if (L >= nwg) return false;
        int wgid = (int)L; { const int q = nwg / NXCD, r = nwg % NXCD, xcd = wgid % NXCD, off = wgid / NXCD; wgid = (xcd < r ? xcd * (q + 1) : r * (q + 1) + (xcd - r) * q) + off; }
        const int nig = WGM * nN, gid = wgid / nig, fm = gid * WGM, gsz = (nM - fm) < WGM ? (nM - fm) : WGM;
        u.pm = fm + ((wgid % nig) % gsz); u.pn = (wgid % nig) / gsz; return true;
    }
    __device__ __forceinline__ void a_ready(const Unit&) const {}
    __device__ __forceinline__ void done(const Unit&) const {}
};
__device__ __forceinline__ unsigned cvt_pk_bf16(float lo, float hi) { unsigned r; asm volatile("v_cvt_pk_bf16_f32 %0, %1, %2" : "=v"(r) : "v"(lo), "v"(hi)); return r; }

struct EpiStore {
    static constexpr bool PERM = true, AFTER_DRAIN = false;
    bf16_t* O; int ldc;
    __device__ __forceinline__ void operator()(const f32x4 (&acc)[2][2][4][2], const Unit& u, int wr, int wc, int fr, int fq) const {
        const int row0 = u.pm * BM + wr * 64 + fr, col0 = u.pn * BM + wc * 32 + 8 * fq;
#pragma unroll
        for (int ai = 0; ai < 2; ++ai)
#pragma unroll
            for (int m = 0; m < 4; ++m) { bf16_t* rowp = O + (size_t)(row0 + ai * HALF + m * 16) * ldc + col0;
#pragma unroll
                for (int bj = 0; bj < 2; ++bj) { const f32x4 v0 = acc[ai][bj][m][0], v1 = acc[ai][bj][m][1];
                    u32x4 w; w.x = cvt_pk_bf16(v0[0], v0[1]); w.y = cvt_pk_bf16(v0[2], v0[3]); w.z = cvt_pk_bf16(v1[0], v1[1]); w.w = cvt_pk_bf16(v1[2], v1[3]);
                    *(u32x4*)(rowp + bj * HALF) = w; } }
    }
};
struct EpiResid {
    static constexpr bool PERM = false, AFTER_DRAIN = false;
    const float* xin; float* out; int ldc; int mrows;
    __device__ __forceinline__ void operator()(const f32x4 (&acc)[2][2][4][2], const Unit& u, int wr, int wc, int fr, int fq) const {
        const int row0 = u.pm * BM + wr * 64 + fr, col0 = u.pn * BM + wc * 32 + 4 * fq;
#pragma unroll
        for (int ai = 0; ai < 2; ++ai)
#pragma unroll
            for (int m = 0; m < 4; ++m) { const int r = row0 + ai * HALF + m * 16;
                if (r < mrows) { const size_t off = (size_t)r * ldc + col0;
#pragma unroll
                    for (int bj = 0; bj < 2; ++bj)
#pragma unroll
                        for (int n = 0; n < 2; ++n) { const f32x4 bs = *(const f32x4*)(xin + off + bj * HALF + n * 16); *(f32x4*)(out + off + bj * HALF + n * 16) = bs + acc[ai][bj][m][n]; } }
                asm volatile("" ::: "memory"); }
    }
};


struct EpiStoreN {
    static constexpr bool PERM = true, AFTER_DRAIN = false;
    bf16_t* O; int ldc; const float* ssq; float eps; const PG8_LAS float* rs_tab; int rs_pm;
    __device__ __forceinline__ void operator()(const f32x4 (&acc)[2][2][4][2], const Unit& u, int wr, int wc, int fr, int fq) const {
        const int row0 = u.pm * BM + wr * 64 + fr, col0 = u.pn * BM + wc * 32 + 8 * fq;
        const bool cached = (u.pm == rs_pm);
#pragma unroll
        for (int ai = 0; ai < 2; ++ai)
#pragma unroll
            for (int m = 0; m < 4; ++m) { const int r = row0 + ai * HALF + m * 16;
                float rs;
                if (cached) rs = rs_tab[wr * 64 + fr + ai * HALF + m * 16];
                else { const f32x4 p0 = *(const f32x4*)(ssq + (size_t)r * 32 + 8 * fq), p1 = *(const f32x4*)(ssq + (size_t)r * 32 + 8 * fq + 4);
                    float s = ((p0[0] + p0[1]) + (p0[2] + p0[3])) + ((p1[0] + p1[1]) + (p1[2] + p1[3]));
                    s += __shfl_xor(s, 16); s += __shfl_xor(s, 32);
                    rs = rsqrtf(s * (1.f / 2048.f) + eps); }
                bf16_t* rowp = O + (size_t)r * ldc + col0;
#pragma unroll
                for (int bj = 0; bj < 2; ++bj) { const f32x4 v0 = acc[ai][bj][m][0] * rs, v1 = acc[ai][bj][m][1] * rs;
                    u32x4 w; w.x = cvt_pk_bf16(v0[0], v0[1]); w.y = cvt_pk_bf16(v0[2], v0[3]); w.z = cvt_pk_bf16(v1[0], v1[1]); w.w = cvt_pk_bf16(v1[2], v1[3]);
                    *(u32x4*)(rowp + bj * HALF) = w; } }
    }
};
__device__ __forceinline__ int first_pm(const StaticOrder& S) { const int wg0 = S.c; const int q = S.nwg / NXCD, r = S.nwg % NXCD, xcd = wg0 % NXCD, off = wg0 / NXCD; const int wgid = (xcd < r ? xcd * (q + 1) : r * (q + 1) + (xcd - r) * q) + off;
    const int nig = WGM * S.nN, gid = wgid / nig, fm = gid * WGM, gsz = (S.nM - fm) < WGM ? (S.nM - fm) : WGM; return fm + ((wgid % nig) % gsz); }
__device__ __forceinline__ void rstd_panel(PG8_LAS float* tab, const float* ssq, int pm, float eps, int tid) {
    const int row = tid >> 1, hf = tid & 1; const float* q = ssq + (size_t)(pm * BM + row) * 32 + 16 * hf;
    const f32x4 a = *(const f32x4*)q, b = *(const f32x4*)(q + 4), c = *(const f32x4*)(q + 8), d = *(const f32x4*)(q + 12);
    float s = (((a[0] + a[1]) + (a[2] + a[3])) + ((b[0] + b[1]) + (b[2] + b[3]))) + (((c[0] + c[1]) + (c[2] + c[3])) + ((d[0] + d[1]) + (d[2] + d[3])));
    s += __shfl_xor(s, 1);
    if (hf == 0) tab[row] = rsqrtf(s * (1.f / 2048.f) + eps);
    __syncthreads();
}
struct EpiResidN {
    static constexpr bool PERM = true, AFTER_DRAIN = false;
    bf16_t* xb; float* fin; float* ssq; int ldc;
    __device__ __forceinline__ void operator()(const f32x4 (&acc)[2][2][4][2], const Unit& u, int wr, int wc, int fr, int fq) const {
        const int row0 = u.pm * BM + wr * 64 + fr, col0 = u.pn * BM + wc * 32 + 8 * fq;
#pragma unroll
        for (int ai = 0; ai < 2; ++ai)
#pragma unroll
            for (int m = 0; m < 4; ++m) { const int r = row0 + ai * HALF + m * 16; const size_t off = (size_t)r * ldc + col0; float sq = 0.f;
#pragma unroll
                for (int bj = 0; bj < 2; ++bj) { const u32x4 xw = *(const u32x4*)(xb + off + bj * HALF);
                    f32x4 v0 = acc[ai][bj][m][0], v1 = acc[ai][bj][m][1];
                    v0[0] += __builtin_bit_cast(float, xw.x << 16); v0[1] += __builtin_bit_cast(float, xw.x & 0xffff0000u); v0[2] += __builtin_bit_cast(float, xw.y << 16); v0[3] += __builtin_bit_cast(float, xw.y & 0xffff0000u);
                    v1[0] += __builtin_bit_cast(float, xw.z << 16); v1[1] += __builtin_bit_cast(float, xw.z & 0xffff0000u); v1[2] += __builtin_bit_cast(float, xw.w << 16); v1[3] += __builtin_bit_cast(float, xw.w & 0xffff0000u);
                    if (fin) { *(f32x4*)(fin + off + bj * HALF) = v0; *(f32x4*)(fin + off + bj * HALF + 4) = v1; }
                    else { u32x4 w; w.x = cvt_pk_bf16(v0[0], v0[1]); w.y = cvt_pk_bf16(v0[2], v0[3]); w.z = cvt_pk_bf16(v1[0], v1[1]); w.w = cvt_pk_bf16(v1[2], v1[3]); *(u32x4*)(xb + off + bj * HALF) = w; }
                    sq += ((v0[0] * v0[0] + v0[1] * v0[1]) + (v0[2] * v0[2] + v0[3] * v0[3])) + ((v1[0] * v1[0] + v1[1] * v1[1]) + (v1[2] * v1[2] + v1[3] * v1[3])); }
                if (ssq) { sq += __shfl_xor(sq, 16); sq += __shfl_xor(sq, 32); if (fq == 0) ssq[(size_t)r * 32 + u.pn * 4 + wc] = sq; }
                if (m == 3) asm volatile("" ::: "memory"); }
    }
};
template <int CTRL> __device__ __forceinline__ float dppf(float oldv, float src) {
    return __builtin_bit_cast(float, __builtin_amdgcn_update_dpp(__builtin_bit_cast(int, oldv), __builtin_bit_cast(int, src), CTRL, 0xf, 0xf, false)); }
template <int CTRL> __device__ __forceinline__ float dppr(float src) {
    return __builtin_bit_cast(float, __builtin_amdgcn_mov_dpp(__builtin_bit_cast(int, src), CTRL, 0xf, 0xf, false)); }
struct EpiConv {
    static constexpr bool PERM = true, AFTER_DRAIN = false;
    static constexpr size_t WS_Z_ = ::WS_Z, WS_SSQ_ = ::WS_SSQ, WS_HALO_ = ::WS_HALO; static constexpr int CW_HCNT_ = ::CW_HCNT, CW_TMO_ = ::CW_TMO;
    unsigned char* wsb; const float* cw; const float* cb; PG8_LAS unsigned char* ldsx; unsigned target; int rs_pm;
    __device__ __forceinline__ void operator()(f32x4 (&acc)[2][2][4][2], const Unit& u, int wr, int wc, int fr_in, int fq_in) const {
        int fr = fr_in, fq = fq_in; asm volatile("" : "+v"(fr), "+v"(fq));
        bf16_t* Z = (bf16_t*)(wsb + WS_Z_); const float* ssq = (const float*)(wsb + WS_SSQ_); const float* halo = (const float*)(wsb + WS_HALO_); const float eps = 1e-6f;
        unsigned* hcnt = (unsigned*)wsb + CW_HCNT_; unsigned* tmo = (unsigned*)wsb + CW_TMO_;
        const PG8_LAS float* rs_tab = (const PG8_LAS float*)ldsx; PG8_LAS f32x4* xch = (PG8_LAS f32x4*)(ldsx + 1024); volatile PG8_LAS unsigned* ready = (volatile PG8_LAS unsigned*)(ldsx + 1024 + 8192);
        const int row0 = u.pm * BM + wr * 64 + fr;
        const bool cached = (u.pm == rs_pm);
#pragma unroll
        for (int ai = 0; ai < 2; ++ai)
#pragma unroll
            for (int m = 0; m < 4; ++m) { const int r = row0 + ai * HALF + m * 16; float rs;
                if (cached) rs = rs_tab[wr * 64 + fr + ai * HALF + m * 16];
                else { const f32x4 p0 = *(const f32x4*)(ssq + (size_t)r * 32 + 8 * fq), p1 = *(const f32x4*)(ssq + (size_t)r * 32 + 8 * fq + 4);
                    float s = ((p0[0] + p0[1]) + (p0[2] + p0[3])) + ((p1[0] + p1[1]) + (p1[2] + p1[3]));
                    s += __shfl_xor(s, 16); s += __shfl_xor(s, 32); rs = rsqrtf(s * (1.f / 2048.f) + eps); }
#pragma unroll
                for (int bj = 0; bj < 2; ++bj) { acc[ai][bj][m][0] *= rs; acc[ai][bj][m][1] *= rs; } }
        f32x4 hal[2][2];
#pragma unroll
        for (int bj = 0; bj < 2; ++bj) { hal[bj][0] = (f32x4){0.f, 0.f, 0.f, 0.f}; hal[bj][1] = (f32x4){0.f, 0.f, 0.f, 0.f}; }
        if (wr == 0 && (u.pm & 7) != 0) {
            if (ready[0] == 0u) { unsigned spins = 0;
                while (__hip_atomic_load(hcnt, __ATOMIC_RELAXED, __HIP_MEMORY_SCOPE_AGENT) < target) { __builtin_amdgcn_s_sleep(2);
                    if (++spins > (1u << 20)) { __hip_atomic_store(tmo, 1u, __ATOMIC_RELAXED, __HIP_MEMORY_SCOPE_AGENT); break; } }
                ready[0] = 1u; }
            if (fr >= 14) { const unsigned long long* hp = (const unsigned long long*)(halo + (size_t)(2 * (u.pm - 1) + (fr - 14)) * 11264 + u.pn * 256 + wc * 32 + 8 * fq);
#pragma unroll
                for (int bj = 0; bj < 2; ++bj)
#pragma unroll
                    for (int n = 0; n < 2; ++n) { const unsigned long long lo = __hip_atomic_load(hp + bj * 64 + 2 * n, __ATOMIC_RELAXED, __HIP_MEMORY_SCOPE_AGENT), hi = __hip_atomic_load(hp + bj * 64 + 2 * n + 1, __ATOMIC_RELAXED, __HIP_MEMORY_SCOPE_AGENT);
                        hal[bj][n] = (f32x4){__builtin_bit_cast(float, (unsigned)lo), __builtin_bit_cast(float, (unsigned)(lo >> 32)), __builtin_bit_cast(float, (unsigned)hi), __builtin_bit_cast(float, (unsigned)(hi >> 32))}; } } }
        if (fr >= 14) {
#pragma unroll
            for (int ai = 0; ai < 2; ++ai)
#pragma unroll
                for (int bj = 0; bj < 2; ++bj)
#pragma unroll
                    for (int n = 0; n < 2; ++n) xch[(((((ai * 2 + wr) * 4 + wc) * 2 + (fr & 1)) * 4 + fq) * 4) + bj * 2 + n] = acc[ai][bj][3][n]; }
        asm volatile("s_waitcnt lgkmcnt(0)" ::: "memory"); __builtin_amdgcn_s_barrier(); asm volatile("" ::: "memory");
        const int jn0 = u.pn * 128 + wc * 32 + 8 * fq;
        u32x2 zk[2][4];
#pragma unroll
        for (int n = 0; n < 2; ++n) {
            const float* wp = cw + jn0 + 4 * n; const float* bp = cb + jn0 + 4 * n;
            const f32x4 wa0 = *(const f32x4*)wp, wa1 = *(const f32x4*)(wp + 11264), wa2 = *(const f32x4*)(wp + 2 * 11264), ba = *(const f32x4*)bp;
            const f32x4 wb0 = *(const f32x4*)(wp + 5632), wb1 = *(const f32x4*)(wp + 11264 + 5632), wb2 = *(const f32x4*)(wp + 2 * 11264 + 5632), bb = *(const f32x4*)(bp + 5632);
#pragma unroll
            for (int ai = 0; ai < 2; ++ai) {
                f32x4 pa, pb;
                if (ai == 0 && wr == 0) { pa = hal[0][n]; pb = hal[1][n]; }
                else { const int sai = wr ? ai : ai - 1, swr = wr ^ 1; const int xi = (((((sai * 2 + swr) * 4 + wc) * 2 + (fr & 1)) * 4 + fq) * 4) + n; pa = xch[xi]; pb = xch[xi + 2]; }
#pragma unroll
                for (int m = 0; m < 4; ++m) {
                    const f32x4 ca4 = acc[ai][0][m][n], cb4 = acc[ai][1][m][n]; float z[4];
#pragma unroll
                    for (int i = 0; i < 4; ++i) {
                        const float a1 = dppf<0x111>(dppr<0x121>(pa[i]), ca4[i]), a2 = dppf<0x112>(dppr<0x122>(pa[i]), ca4[i]);
                        const float b1 = dppf<0x111>(dppr<0x121>(pb[i]), cb4[i]), b2 = dppf<0x112>(dppr<0x122>(pb[i]), cb4[i]);
                        const float ca = ba[i] + wa0[i] * a2 + wa1[i] * a1 + wa2[i] * ca4[i];
                        const float cbv = bb[i] + wb0[i] * b2 + wb1[i] * b1 + wb2[i] * cb4[i];
                        z[i] = ca * __builtin_amdgcn_rcpf(1.f + __builtin_amdgcn_exp2f(ca * -1.4426950408889634f)) * cbv; }
                    u32x2 w; w.x = cvt_pk_bf16(z[0], z[1]); w.y = cvt_pk_bf16(z[2], z[3]);
                    if (n == 0) zk[ai][m] = w;
                    else { u32x4 w4; w4.x = zk[ai][m].x; w4.y = zk[ai][m].y; w4.z = w.x; w4.w = w.y; *(u32x4*)(Z + (size_t)(row0 + ai * HALF + m * 16) * 5632 + jn0) = w4; }
                    pa = ca4; pb = cb4; }
            }
        }
    }
};

struct EpiNull {
    static constexpr bool PERM = true, AFTER_DRAIN = false;
    float* sink;
    __device__ __forceinline__ void operator()(const f32x4 (&acc)[2][2][4][2], const Unit& u, int wr, int wc, int fr, int fq) const {
        f32x4 s = {0.f, 0.f, 0.f, 0.f};
#pragma unroll
        for (int a = 0; a < 2; ++a)
#pragma unroll
            for (int b = 0; b < 2; ++b)
#pragma unroll
                for (int m = 0; m < 4; ++m) { s += acc[a][b][m][0]; s += acc[a][b][m][1]; }
        const float t = (s[0] + s[1]) + (s[2] + s[3]);
        if (t == 1.2345678e33f) sink[fr] = t;
    }
};
template <class Epi, class Sched, bool ALIGN_EPI = false, bool SP2 = false>
__device__ __forceinline__ void gemm_phase(PG8_LAS unsigned char* lds, const Gemm g, const Sched& S, const Epi& E) {
    int tid = threadIdx.x; asm volatile("" : "+v"(tid));
    const int wid = __builtin_amdgcn_readfirstlane(tid >> 6), lane = tid & 63, wr = wid >> 2, wc = wid & 3, fr = lane & 15, fq = lane >> 4;
    const int K = g.K, nt = K / BK;
    unsigned voffA[2], voffB[2];
#pragma unroll
    for (int i = 0; i < 2; ++i) { int R, C; stage_rc(tid * 16 + i * 8192, R, C); const int Rb = Epi::PERM ? ((R & ~31) + perm32(R & 31)) : R;
        voffA[i] = (unsigned)(R * K + C) * 2u; voffB[i] = (unsigned)(Rb * K + C) * 2u; }
    const size_t kstep = (size_t)(BK * 2);
    const size_t hstep = (size_t)HALF * K * 2;
    const size_t tstep = 2 * hstep;
    const unsigned ldsw = (unsigned)wid * 1024u;
    const int aoff = lds_byte(wr * 64 + fr, fq * 8), boff = lds_byte(wc * 32 + fr, fq * 8);
#define PG8_SA(b, h) (((b) * 2 + (h)) * HTB)
#define PG8_SB(b, h) ((4 + (b) * 2 + (h)) * HTB)
#define PG8_STAGE(bufoff, gbase, voff) do { _Pragma("unroll") for (int _i = 0; _i < 2; ++_i) \
        __builtin_amdgcn_global_load_lds((const unsigned*)((const char*)(gbase) + (voff)[_i]), (PG8_LAS unsigned*)(lds + (bufoff) + ldsw + _i * 8192), 16, 0, 0); } while (0)
#define PG8_LDA(dst, b, h) do { _Pragma("unroll") for (int m = 0; m < 4; ++m) _Pragma("unroll") for (int k = 0; k < 2; ++k) dst[m][k] = *(const PG8_LAS bf16x8*)(lds + PG8_SA(b, h) + aoff + m * 2048 + k * 1024); } while (0)
#define PG8_LDB(dst, b, h) do { _Pragma("unroll") for (int n = 0; n < 2; ++n) _Pragma("unroll") for (int k = 0; k < 2; ++k) dst[n][k] = *(const PG8_LAS bf16x8*)(lds + PG8_SB(b, h) + boff + n * 2048 + k * 1024); } while (0)
#define PG8_MMA(ai, bj, At, Bt) do { __builtin_amdgcn_s_setprio(1); _Pragma("unroll") for (int m = 0; m < 4; ++m) _Pragma("unroll") for (int n = 0; n < 2; ++n) _Pragma("unroll") for (int k = 0; k < 2; ++k) \
        acc[ai][bj][m][n] = __builtin_amdgcn_mfma_f32_16x16x32_bf16(Bt[n][k], At[m][k], acc[ai][bj][m][n], 0, 0, 0); __builtin_amdgcn_s_setprio(0); } while (0)
#define PG8_WAIT_V(n) asm volatile("s_waitcnt vmcnt(" #n ")" ::: "memory")
#define PG8_WAIT_L(n) asm volatile("s_waitcnt lgkmcnt(" #n ")" ::: "memory")
#define PG8_BAR __builtin_amdgcn_s_barrier()
#define PG8_SCHED __builtin_amdgcn_sched_barrier(0)
    Unit cur, nxt; int ui = 0;
    if (!S.next(0, cur)) return;
    f32x4 acc[2][2][4][2];
#pragma unroll
    for (int a = 0; a < 2; ++a)
#pragma unroll
        for (int b = 0; b < 2; ++b)
#pragma unroll
            for (int m = 0; m < 4; ++m)
#pragma unroll
                for (int n = 0; n < 2; ++n) acc[a][b][m][n] = (f32x4){0.f, 0.f, 0.f, 0.f};
    bf16x8 At[4][2], B0[2][2], B1[2][2];
    const char* cA = (const char*)g.A + (size_t)cur.pm * tstep; const char* cB = (const char*)g.Bt + (size_t)cur.pn * tstep;
    S.a_ready(cur);
    if constexpr (SP2) {
        PG8_STAGE(PG8_SB(0, 0), cB, voffB); PG8_STAGE(PG8_SB(0, 1), cB + hstep, voffB); PG8_STAGE(PG8_SA(0, 0), cA, voffA); PG8_STAGE(PG8_SA(0, 1), cA + hstep, voffA);
        if (wr == 1) PG8_BAR;
        PG8_WAIT_V(2); PG8_BAR;
        PG8_STAGE(PG8_SB(1, 0), cB + kstep, voffB); PG8_STAGE(PG8_SA(1, 0), cA + kstep, voffA); PG8_STAGE(PG8_SB(1, 1), cB + hstep + kstep, voffB);
        PG8_WAIT_V(6); PG8_BAR;
    } else {
        PG8_STAGE(PG8_SB(0, 0), cB, voffB); PG8_STAGE(PG8_SA(0, 0), cA, voffA); PG8_STAGE(PG8_SB(0, 1), cB + hstep, voffB); PG8_STAGE(PG8_SA(0, 1), cA + hstep, voffA);
        if (wr == 1) PG8_BAR;
        PG8_WAIT_V(4); PG8_BAR;
        PG8_STAGE(PG8_SB(1, 0), cB + kstep, voffB); PG8_STAGE(PG8_SA(1, 0), cA + kstep, voffA); PG8_STAGE(PG8_SB(1, 1), cB + hstep + kstep, voffB);
        PG8_WAIT_V(6); PG8_BAR;
    }
    for (;;) {
        const bool has_next = S.next(ui + 1, nxt);
        const char* nA = has_next ? (const char*)g.A + (size_t)nxt.pm * tstep : cA; const char* nB = has_next ? (const char*)g.Bt + (size_t)nxt.pn * tstep : cB;
        for (int t = 0; t < nt; t += 2) {
            const bool last = (t == nt - 2);
            const char* a1 = cA + (size_t)(t + 1) * kstep;
            const char* a2 = last ? nA : cA + (size_t)(t + 2) * kstep; const char* b2 = last ? nB : cB + (size_t)(t + 2) * kstep;
            const char* a3 = a2 + kstep; const char* b3 = b2 + kstep;
            if (last && has_next) S.a_ready(nxt);
            if constexpr (SP2) {
            PG8_LDB(B0, 0, 0); PG8_LDB(B1, 0, 1); PG8_SCHED; PG8_LDA(At, 0, 0); PG8_STAGE(PG8_SA(1, 1), a1 + hstep, voffA);
            PG8_WAIT_V(8); PG8_WAIT_L(0); PG8_BAR; PG8_MMA(0, 0, At, B0); PG8_MMA(0, 1, At, B1); PG8_BAR; PG8_SCHED;
            PG8_LDA(At, 0, 1); PG8_STAGE(PG8_SB(0, 0), b2, voffB); PG8_STAGE(PG8_SB(0, 1), b2 + hstep, voffB); PG8_STAGE(PG8_SA(0, 0), a2, voffA);
            PG8_WAIT_V(8); PG8_WAIT_L(0); PG8_BAR; PG8_MMA(1, 0, At, B0); PG8_MMA(1, 1, At, B1); PG8_BAR; PG8_SCHED;
            PG8_LDB(B0, 1, 0); PG8_LDB(B1, 1, 1); PG8_SCHED; PG8_LDA(At, 1, 0); PG8_STAGE(PG8_SA(0, 1), a2 + hstep, voffA);
            PG8_WAIT_V(8); PG8_WAIT_L(0); PG8_BAR; PG8_MMA(0, 0, At, B0); PG8_MMA(0, 1, At, B1); PG8_BAR; PG8_SCHED;
            PG8_LDA(At, 1, 1); PG8_STAGE(PG8_SB(1, 0), b3, voffB); PG8_STAGE(PG8_SB(1, 1), b3 + hstep, voffB); PG8_STAGE(PG8_SA(1, 0), a3, voffA);
            PG8_WAIT_V(8); PG8_WAIT_L(0); PG8_BAR; PG8_MMA(1, 0, At, B0); PG8_MMA(1, 1, At, B1); PG8_BAR; PG8_SCHED;
            } else {
            PG8_LDB(B0, 0, 0); PG8_SCHED; PG8_LDA(At, 0, 0); PG8_STAGE(PG8_SA(1, 1), a1 + hstep, voffA);
            PG8_WAIT_L(8); PG8_BAR; PG8_WAIT_L(0); PG8_MMA(0, 0, At, B0); PG8_BAR; PG8_SCHED;
            PG8_LDB(B1, 0, 1); PG8_STAGE(PG8_SB(0, 0), b2, voffB);
            PG8_BAR; PG8_WAIT_L(0); PG8_MMA(0, 1, At, B1); PG8_BAR;
            PG8_LDA(At, 0, 1); PG8_STAGE(PG8_SA(0, 0), a2, voffA);
            PG8_BAR; PG8_WAIT_L(0); PG8_MMA(1, 0, At, B0); PG8_BAR; PG8_SCHED;
            PG8_STAGE(PG8_SB(0, 1), b2 + hstep, voffB);
            PG8_WAIT_V(6); PG8_BAR; PG8_MMA(1, 1, At, B1); PG8_BAR;
            PG8_LDB(B0, 1, 0); PG8_SCHED; PG8_LDA(At, 1, 0); PG8_STAGE(PG8_SA(0, 1), a2 + hstep, voffA);
            PG8_WAIT_L(8); PG8_BAR; PG8_WAIT_L(0); PG8_MMA(0, 0, At, B0); PG8_BAR; PG8_SCHED;
            PG8_LDB(B1, 1, 1); PG8_STAGE(PG8_SB(1, 0), b3, voffB);
            PG8_BAR; PG8_WAIT_L(0); PG8_MMA(0, 1, At, B1); PG8_BAR;
            PG8_LDA(At, 1, 1); PG8_STAGE(PG8_SA(1, 0), a3, voffA);
            PG8_BAR; PG8_WAIT_L(0); PG8_MMA(1, 0, At, B0); PG8_BAR; PG8_SCHED;
            PG8_STAGE(PG8_SB(1, 1), b3 + hstep, voffB);
            PG8_WAIT_V(6); PG8_BAR; PG8_MMA(1, 1, At, B1); PG8_BAR;
            }
        }
        if constexpr (ALIGN_EPI) { if (wr == 0) PG8_BAR; }
        if constexpr (!Epi::AFTER_DRAIN) { E(acc, cur, wr, wc, fr, fq); S.done(cur); }
        if (!has_next) break;
#pragma unroll
        for (int a = 0; a < 2; ++a)
#pragma unroll
            for (int b = 0; b < 2; ++b)
#pragma unroll
                for (int m = 0; m < 4; ++m)
#pragma unroll
                    for (int n = 0; n < 2; ++n) acc[a][b][m][n] = (f32x4){0.f, 0.f, 0.f, 0.f};
        cur = nxt; cA = nA; cB = nB; ++ui;
        if constexpr (ALIGN_EPI) { if (wr == 1) PG8_BAR; }
    }
    PG8_WAIT_V(0);
    if constexpr (!ALIGN_EPI) { if (wr == 0) PG8_BAR; }
    PG8_BAR;
    if constexpr (Epi::AFTER_DRAIN) { E.fused(acc, cur, wr, wc, fr, fq, lds, wid, lane); S.done(cur); }
#undef PG8_SA
#undef PG8_SB
#undef PG8_STAGE
#undef PG8_LDA
#undef PG8_LDB
#undef PG8_MMA
#undef PG8_WAIT_V
#undef PG8_WAIT_L
#undef PG8_BAR
#undef PG8_SCHED
}
}
#define XB_TMO      128
#define XB_XCNT(j)  (256  + 64 * (j))
#define XB_XSUB(j)  (1280 + 64 * (j))
#define XB_XGEN(j)  (2304 + 64 * (j))
#define XB_TOP      3328
#define XB_TOPGEN   3392
#define XCD_BAR_WORDS 3456
#define XB_SPIN_CAP (1u << 18)

__device__ __forceinline__ unsigned xb_ld(unsigned* p)              { return __hip_atomic_load(p, __ATOMIC_RELAXED, __HIP_MEMORY_SCOPE_AGENT); }
__device__ __forceinline__ unsigned xb_add(unsigned* p, unsigned v) { return __hip_atomic_fetch_add(p, v, __ATOMIC_RELAXED, __HIP_MEMORY_SCOPE_AGENT); }
__device__ __forceinline__ unsigned xb_xcc_id() { return (unsigned)__builtin_amdgcn_s_getreg((3 << 11) | 20) & 0xFu; }
#define XB_SPIN(cond, bar) do { unsigned _sp = 0; while (cond) { __builtin_amdgcn_s_sleep(1); \
    if ((++_sp & 255u) == 0u) { if (xb_ld(&(bar)[XB_TMO])) break; if (_sp > XB_SPIN_CAP) { atomicAdd(&(bar)[XB_TMO], 1u); break; } } } } while (0)

struct XcdBarrier {
    unsigned* bar; unsigned x;
    volatile LAS unsigned* st;
};

__device__ __forceinline__ XcdBarrier xcd_barrier_post(unsigned* bar, volatile LAS unsigned* st) {
    XcdBarrier b; b.bar = bar; b.x = xb_xcc_id(); b.st = st;
    if (threadIdx.x == 0) (void)xb_add(&bar[XB_XCNT(b.x)], 1u);
    return b;
}
__device__ __forceinline__ void xcd_barrier_complete(unsigned* bar, unsigned x, unsigned& nloc, unsigned& nx) {
    const unsigned G = gridDim.x * gridDim.y * gridDim.z;
    unsigned sum, cnt, mine, sp = 0u;
    for (;;) {
        sum = 0u; cnt = 0u; mine = 0u;
#pragma unroll
        for (unsigned j = 0; j < 16; ++j) { const unsigned c = xb_ld(&bar[XB_XCNT(j)]); sum += c; cnt += (c > 0u) ? 1u : 0u; mine = (j == x) ? c : mine; }
        if (sum == G) break;
        __builtin_amdgcn_s_sleep(1);
        if ((++sp & 255u) == 0u) { if (xb_ld(&bar[XB_TMO])) break; if (sp > XB_SPIN_CAP) { atomicAdd(&bar[XB_TMO], 1u); break; } }
    }
    nloc = mine > 0u ? mine : 1u; nx = cnt > 0u ? cnt : 1u;
}

__device__ __forceinline__ void xcd_barrier(const XcdBarrier& b) {
    asm volatile("s_waitcnt vmcnt(0)" ::: "memory");
    __syncthreads();
    if (threadIdx.x == 0) {
        unsigned* bar = b.bar;
        __builtin_amdgcn_s_waitcnt(0);
        unsigned nloc = b.st[0], nx = b.st[1];
        if (nloc == 0u) { xcd_barrier_complete(bar, b.x, nloc, nx); b.st[0] = nloc; b.st[1] = nx; }
        const unsigned old = xb_add(&bar[XB_XSUB(b.x)], 1u);
        const unsigned gen = old / nloc;
        if (old + 1u == (gen + 1u) * nloc) {
            __builtin_amdgcn_fence(__ATOMIC_RELEASE, "agent");
            asm volatile("s_waitcnt vmcnt(0)" ::: "memory");
            const unsigned og = xb_add(&bar[XB_TOP], 1u);
            const unsigned tg = og / nx;
            if (og + 1u == (tg + 1u) * nx) xb_add(&bar[XB_TOPGEN], 1u);
            else XB_SPIN(xb_ld(&bar[XB_TOPGEN]) == tg, bar);
            __builtin_amdgcn_fence(__ATOMIC_ACQUIRE, "agent");
            xb_add(&bar[XB_XGEN(b.x)], 1u);
            asm volatile("s_waitcnt vmcnt(0)" ::: "memory");
        } else {
            XB_SPIN(xb_ld(&bar[XB_XGEN(b.x)]) == gen, bar);
            __builtin_amdgcn_fence(__ATOMIC_ACQUIRE, "agent");
            asm volatile("s_waitcnt vmcnt(0)" ::: "memory");
        }
    }
    __syncthreads();
}

struct Params { const float* in[23]; float* out; unsigned char* ws; };

__device__ __forceinline__ void p0_transpose_item(const float* W, int ldw, int K, int N, bf16_t* WT, int item, int lane, float scale, const float* gk, bool pair_perm = false, bool deep = false) {
    const int nblk = N / 64, kb = item / nblk, nb = item % nblk, i16 = lane & 15, q4 = lane >> 4;
    const int n0 = 64 * nb + 4 * i16;
    const int ns0 = (pair_perm ? ((nb >> 1) & 1) * DFF + 128 * (nb >> 2) + 64 * (nb & 1) : 64 * nb) + 4 * i16;
#ifndef P0_NTST
#define P0_NTST 0
#endif
#ifndef P0_DEEP
#define P0_DEEP 1
#endif
#ifndef P0_ASM
#define P0_ASM 1
#endif
    if (P0_ASM && deep) {
        const int kk0 = 64 * kb + 8 * q4;
        const float* src = W + (size_t)kk0 * ldw + ns0;
        const float* ra[16];
#pragma unroll
        for (int i = 0; i < 16; ++i) ra[i] = src + (size_t)((i >> 3) * 32 + (i & 7)) * ldw;
        f32x4 v[16];
#define P0_GL "global_load_dwordx4 "
#define P0_CP ", off sc0 sc1 nt\n\t"
        asm volatile(P0_GL "%0, %8" P0_CP P0_GL "%1, %9" P0_CP P0_GL "%2, %10" P0_CP P0_GL "%3, %11" P0_CP P0_GL "%4, %12" P0_CP P0_GL "%5, %13" P0_CP P0_GL "%6, %14" P0_CP P0_GL "%7, %15, off sc0 sc1 nt"
                     : "=&v"(v[0]), "=&v"(v[1]), "=&v"(v[2]), "=&v"(v[3]), "=&v"(v[4]), "=&v"(v[5]), "=&v"(v[6]), "=&v"(v[7]) : "v"(ra[0]), "v"(ra[1]), "v"(ra[2]), "v"(ra[3]), "v"(ra[4]), "v"(ra[5]), "v"(ra[6]), "v"(ra[7]) : "memory");
        asm volatile(P0_GL "%0, %8" P0_CP P0_GL "%1, %9" P0_CP P0_GL "%2, %10" P0_CP P0_GL "%3, %11" P0_CP P0_GL "%4, %12" P0_CP P0_GL "%5, %13" P0_CP P0_GL "%6, %14" P0_CP P0_GL "%7, %15, off sc0 sc1 nt\n\ts_waitcnt vmcnt(0)"
                     : "=&v"(v[8]), "=&v"(v[9]), "=&v"(v[10]), "=&v"(v[11]), "=&v"(v[12]), "=&v"(v[13]), "=&v"(v[14]), "=&v"(v[15]) : "v"(ra[8]), "v"(ra[9]), "v"(ra[10]), "v"(ra[11]), "v"(ra[12]), "v"(ra[13]), "v"(ra[14]), "v"(ra[15]) : "memory");
        asm volatile("" : "+v"(v[0]), "+v"(v[1]), "+v"(v[2]), "+v"(v[3]), "+v"(v[4]), "+v"(v[5]), "+v"(v[6]), "+v"(v[7]));
#undef P0_GL
#undef P0_CP
        u32x4 o[2][4];
#pragma unroll
        for (int pass = 0; pass < 2; ++pass) {
            f32x4 g0 = {scale, scale, scale, scale}, g1 = g0;
            if (gk) { g0 = *(const f32x4*)(gk + kk0 + 32 * pass) * scale; g1 = *(const f32x4*)(gk + kk0 + 32 * pass + 4) * scale; }
#pragma unroll
            for (int j = 0; j < 4; ++j) { const int b = 8 * pass;
                o[pass][j].x = pk2(v[b + 0][j] * g0[0], v[b + 1][j] * g0[1]); o[pass][j].y = pk2(v[b + 2][j] * g0[2], v[b + 3][j] * g0[3]); o[pass][j].z = pk2(v[b + 4][j] * g1[0], v[b + 5][j] * g1[1]); o[pass][j].w = pk2(v[b + 6][j] * g1[2], v[b + 7][j] * g1[3]); }
        }
        if (P0_ASM == 2) {
#pragma unroll
            for (int pass = 0; pass < 2; ++pass)
#pragma unroll
                for (int j = 0; j < 4; ++j) *(u32x4*)(WT + (size_t)(n0 + j) * K + kk0 + 32 * pass) = o[pass][j];
            return; }
        bf16_t* q0 = WT + (size_t)(n0 + 0) * K + kk0; bf16_t* q1 = WT + (size_t)(n0 + 1) * K + kk0; bf16_t* q2 = WT + (size_t)(n0 + 2) * K + kk0; bf16_t* q3 = WT + (size_t)(n0 + 3) * K + kk0;
        asm volatile("global_store_dwordx4 %8, %0, off sc0 sc1 nt\n\tglobal_store_dwordx4 %9, %1, off sc0 sc1 nt\n\tglobal_store_dwordx4 %10, %2, off sc0 sc1 nt\n\tglobal_store_dwordx4 %11, %3, off sc0 sc1 nt\n\t"
                     "global_store_dwordx4 %8, %4, off offset:64 sc0 sc1 nt\n\tglobal_store_dwordx4 %9, %5, off offset:64 sc0 sc1 nt\n\tglobal_store_dwordx4 %10, %6, off offset:64 sc0 sc1 nt\n\tglobal_store_dwordx4 %11, %7, off offset:64 sc0 sc1 nt"
                     :: "v"(o[0][0]), "v"(o[0][1]), "v"(o[0][2]), "v"(o[0][3]), "v"(o[1][0]), "v"(o[1][1]), "v"(o[1][2]), "v"(o[1][3]), "v"(q0), "v"(q1), "v"(q2), "v"(q3) : "memory");
        return;
    }
    if (P0_DEEP && deep) {
        const int kk0 = 64 * kb + 8 * q4;
        const float* src = W + (size_t)kk0 * ldw + ns0;
        f32x4 v[16];
#pragma unroll
        for (int i = 0; i < 16; ++i) v[i] = __builtin_nontemporal_load((const f32x4*)(src + (size_t)((i >> 3) * 32 + (i & 7)) * ldw));
#pragma unroll
        for (int pass = 0; pass < 2; ++pass) {
            f32x4 g0 = {scale, scale, scale, scale}, g1 = g0;
            if (gk) { g0 = *(const f32x4*)(gk + kk0 + 32 * pass) * scale; g1 = *(const f32x4*)(gk + kk0 + 32 * pass + 4) * scale; }
#pragma unroll
            for (int j = 0; j < 4; ++j) { u32x4 o; const int b = 8 * pass;
                o.x = pk2(v[b + 0][j] * g0[0], v[b + 1][j] * g0[1]); o.y = pk2(v[b + 2][j] * g0[2], v[b + 3][j] * g0[3]); o.z = pk2(v[b + 4][j] * g1[0], v[b + 5][j] * g1[1]); o.w = pk2(v[b + 6][j] * g1[2], v[b + 7][j] * g1[3]);
                if (P0_NTST) __builtin_nontemporal_store(o, (u32x4*)(WT + (size_t)(n0 + j) * K + kk0 + 32 * pass)); else *(u32x4*)(WT + (size_t)(n0 + j) * K + kk0 + 32 * pass) = o; }
        }
        return;
    }
#pragma unroll
    for (int pass = 0; pass < 2; ++pass) {
        const int kk0 = 64 * kb + 32 * pass + 8 * q4;
        const float* src = W + (size_t)kk0 * ldw + ns0;
        f32x4 v[8];
#pragma unroll
        for (int i = 0; i < 8; ++i) v[i] = __builtin_nontemporal_load((const f32x4*)(src + (size_t)i * ldw));
        f32x4 g0 = {scale, scale, scale, scale}, g1 = g0;
        if (gk) { g0 = *(const f32x4*)(gk + kk0) * scale; g1 = *(const f32x4*)(gk + kk0 + 4) * scale; }
#pragma unroll
        for (int j = 0; j < 4; ++j) { u32x4 o;
            o.x = pk2(v[0][j] * g0[0], v[1][j] * g0[1]); o.y = pk2(v[2][j] * g0[2], v[3][j] * g0[3]); o.z = pk2(v[4][j] * g1[0], v[5][j] * g1[1]); o.w = pk2(v[6][j] * g1[2], v[7][j] * g1[3]);
            *(u32x4*)(WT + (size_t)(n0 + j) * K + kk0) = o; }
    }
}

constexpr int I_QKV = (DM / 64) * (NQKV / 64), I_WO = (DO / 64) * (DM / 64), I_WIN = (DM / 64) * (NIN / 64), I_WOUT = (DM / 64) * (DM / 64), I_WUP = (DM / 64) * (NUP / 64), I_WDN = (DFF / 64) * (DM / 64);
constexpr int P0_T0 = 2 * I_QKV, P0_T1 = P0_T0 + 2 * I_WO, P0_T2 = P0_T1 + 2 * I_WIN, P0_T3 = P0_T2 + 2 * I_WOUT, P0_T4 = P0_T3 + 4 * I_WUP, P0_TOTAL = P0_T4 + 4 * I_WDN;
constexpr int P0_G1 = I_QKV + I_WO + I_WUP + I_WDN + I_WIN, P0_G2 = P0_G1 + I_WOUT + 2 * (I_WUP + I_WDN) + I_QKV + I_WO + I_WIN;
#ifndef P0_PRO_DEEP
#define P0_PRO_DEEP 0
#endif
#ifndef P0_C1
#define P0_C1 P0_G1
#endif
#ifndef P0_C2
#define P0_C2 P0_G2
#endif
static_assert(P0_C1 >= P0_G1 && P0_C2 >= P0_G2 && P0_C2 >= P0_C1 && P0_C2 <= P0_TOTAL, "a weight must be transposed before the phase that reads it");
__device__ __forceinline__ void p0_item(const Params& P, int v, int lane, bool deep = false) {
    unsigned char* ws = P.ws;
    int it = v, vs = 0;
#define P0_SEG(CNT, RSTART) if (vs >= 0) { if (v < vs + (CNT)) { it = (RSTART) + (v - vs); vs = -1; } else vs += (CNT); }
    P0_SEG(I_QKV, 0) P0_SEG(I_WO, P0_T0) P0_SEG(I_WUP, P0_T3) P0_SEG(I_WDN, P0_T4) P0_SEG(I_WIN, P0_T1)
    P0_SEG(I_WOUT, P0_T2) P0_SEG(I_WUP, P0_T3 + I_WUP) P0_SEG(I_WDN, P0_T4 + I_WDN) P0_SEG(I_QKV, I_QKV) P0_SEG(I_WO, P0_T0 + I_WO) P0_SEG(I_WUP, P0_T3 + 2 * I_WUP) P0_SEG(I_WDN, P0_T4 + 2 * I_WDN) P0_SEG(I_WIN, P0_T1 + I_WIN)
    P0_SEG(I_WOUT, P0_T2 + I_WOUT) P0_SEG(I_WUP, P0_T3 + 3 * I_WUP) P0_SEG(I_WDN, P0_T4 + 3 * I_WDN)
#undef P0_SEG
    if (it < P0_T0) { const int l = it / I_QKV, r = it % I_QKV; p0_transpose_item(P.in[11] + (size_t)l * DM * NQKV, NQKV, DM, NQKV, (bf16_t*)(ws + WS_WQKV + l * SZ_WQKV), r, lane, 1.f, P.in[9] + (size_t)(2 * l) * DM, false, deep); }
    else if (it < P0_T1) { const int q = it - P0_T0, l = q / I_WO, r = q % I_WO; p0_transpose_item(P.in[14] + (size_t)l * DO * DM, DM, DO, DM, (bf16_t*)(ws + WS_WO + l * SZ_WO), r, lane, 1.f, nullptr, false, deep); }
    else if (it < P0_T2) { const int q = it - P0_T1, l = q / I_WIN, r = q % I_WIN; const int nb = r % (NIN / 64);
        const float sc = (nb >= 16 && nb < 32) ? 0.08838834764831845f : 1.f;
        p0_transpose_item(P.in[15] + (size_t)l * DM * NIN_SRC, NIN_SRC, DM, NIN, (bf16_t*)(ws + WS_WIN + l * SZ_WIN), r, lane, sc, P.in[9] + (size_t)(2 * l + 1) * DM, false, deep); }
    else if (it < P0_T3) { const int q = it - P0_T2, l = q / I_WOUT, r = q % I_WOUT; p0_transpose_item(P.in[18] + (size_t)l * DM * DM, DM, DM, DM, (bf16_t*)(ws + WS_WOUT + l * SZ_WOUT), r, lane, 1.f, nullptr, false, deep); }
    else if (it < P0_T4) { const int q = it - P0_T3, l = q / I_WUP, r = q % I_WUP; p0_transpose_item(P.in[19] + (size_t)l * DM * NUP, NUP, DM, NUP, (bf16_t*)(ws + WS_WUP + l * SZ_WUP), r, lane, 1.f, P.in[10] + (size_t)l * DM, true, deep); }
    else { const int q = it - P0_T4, l = q / I_WDN, r = q % I_WDN; p0_transpose_item(P.in[22] + (size_t)l * DFF * DM, DM, DFF, DM, (bf16_t*)(ws + WS_WDOWN + l * SZ_WDOWN), r, lane, 1.f, nullptr, false, deep); }
}

__device__ __forceinline__ void phase_prologue(const Params& P, LAS unsigned char* lds, int gw, int NGW, int wave, int lane) {
    unsigned char* ws = P.ws;
    for (int v = gw; v < (P0_C1); v += NGW) p0_item(P, v, lane, P0_PRO_DEEP);
    { const int gt = gw * 64 + lane, NT = NGW * 64;
      float* rope = (float*)(ws + WS_ROPE);
      for (int i = gt; i < 2052 * 64; i += NT) { const int pi = i >> 6, f = i & 63; const int pos = (pi < SEQ) ? pi : PAST + (pi - SEQ);
          const float invf = powf(10000.f, -(float)f * (1.f / 64.f)); const float ang = (float)pos * invf; float sn, cs; sincosf(ang, &sn, &cs); rope[2 * i] = cs; rope[2 * i + 1] = sn; }
      for (int i = gt; i < 3 * 64; i += NT) { const int g = i >> 6, f = i & 63; const float invf = powf(10000.f, -(float)f * (1.f / 64.f)); const float ang = (float)(32 << (2 * g)) * invf; float sn, cs; sincosf(ang, &sn, &cs);
          rope[(2052 * 64 + i) * 2] = cs; rope[(2052 * 64 + i) * 2 + 1] = sn; }
      f32x4* wgp = (f32x4*)(ws + WS_WGP);
      for (int i = gt; i < 2 * 128 * 64; i += NT) { const int l = i >> 13, kb = (i >> 6) & 127, ln = i & 63, col = ln & 15, kq = ln >> 4, k = 16 * kb + 4 * kq;
          const float* w = P.in[15] + (size_t)l * DM * NIN_SRC + (size_t)k * NIN_SRC + NIN + col; const float* g = P.in[9] + (size_t)(2 * l + 1) * DM + k;
          wgp[i] = (f32x4){g[0] * w[0], g[1] * w[NIN_SRC], g[2] * w[2 * NIN_SRC], g[3] * w[3 * NIN_SRC]}; } }
    for (int r = gw; r < MR; r += NGW) {
        const f32x4* xr = (const f32x4*)((r < MP) ? P.in[0] + (size_t)r * DM : P.in[1] + (size_t)(r - MP) * DM) + lane;
        u32x2* xb = (u32x2*)(ws + WS_XB) + (size_t)r * (DM / 4) + lane;
        float s = 0.f;
#pragma unroll
        for (int j = 0; j < 8; ++j) { const f32x4 v = xr[64 * j]; u32x2 w; w.x = pk2(v.x, v.y); w.y = pk2(v.z, v.w); xb[64 * j] = w; s += (v.x * v.x + v.y * v.y) + (v.z * v.z + v.w * v.w); }
        s = wave_sum(s);
        if (r < MP) { if (lane < 32) ((float*)(ws + WS_SSQ))[(size_t)r * 32 + lane] = (lane == 0) ? s : 0.f; }
        else { float* q = (float*)(ws + WS_SSQS) + (size_t)(r - MP) * 128; q[lane] = (lane == 0) ? s : 0.f; q[64 + lane] = 0.f; }
    }
}

constexpr int CS_PER_LAYER = NBS * (124 + 508 + 2044);
#ifndef CS_D
#define CS_D 0
#endif
#ifndef UPCOPY
#define UPCOPY 6000
#endif
#ifndef UPT
#define UPT 0
#endif
constexpr int CS_NUP = (UPT > 0) ? 2 : 4;
#ifndef CS_ATTQ
#define CS_ATTQ 0
#endif
constexpr int CS_ATTQN = (CS_ATTQ > 0) ? CS_ATTQ : 1, CS_ATT_PER = (CS_ATTQ > 0) ? 1536 * NWAVES / 2 : 0;
constexpr int CS_QKV = (NQKV / 16) * NWAVES * CS_D, CS_UP = 352 * NWAVES * CS_D, CS_ATT0 = 2 * CS_QKV + 4 * CS_UP, CS_UPC0 = CS_ATT0 + 2 * CS_ATT_PER, CS_TAILS = CS_UPC0 + CS_NUP * (UPCOPY),     CS_DN = (CS_D > 0) ? CS_D : 1;
static_assert(CS_TAILS <= 2 * CS_PER_LAYER, "more side-stream slots than positions");
#ifndef CS_SPLIT
#define CS_SPLIT CS_TAILS
#endif
#ifndef CS_DEPTH
#define CS_DEPTH 2
#endif
__device__ __forceinline__ void cs_addr(const Params& P, float* outp, int t, const f32x4*& src, f32x4*& dst) {
    constexpr int N0 = NBS * 124, N1 = NBS * 508;
    const int ia = (t >= CS_PER_LAYER) ? 1 : 0, it = t - ia * CS_PER_LAYER;
    int g, q; if (it < N0) { g = 0; q = it; } else if (it < N0 + N1) { g = 1; q = it - N0; } else { g = 2; q = it - N0 - N1; }
    const int win = 128 << (2 * g), per = win - 4, bs = q / per, j = q % per;
    src = (const f32x4*)(P.in[2 + g] + ((size_t)(ia * NBS + bs) * win + j + 4) * 2048);
    dst = (f32x4*)(outp + ((g == 0) ? O_KV128S : (g == 1) ? O_KV512S : O_KV2048S) + ((size_t)(ia * NBS + bs) * win + j) * 2048);
}

__device__ __forceinline__ void gate_block(LAS unsigned char* lds, const bf16_t* X, const f32x4* WGP, const float* bg, float* GATES, int task, int wave, int lane) {
    const int r0 = task * 16, i16 = lane & 15, kq = lane >> 4;
    const bf16_t* xr = X + (size_t)(r0 + i16) * DM + 256 * wave + 4 * kq;
    const f32x4* wp = WGP + (size_t)(16 * wave) * 64 + lane;
    f32x4 acc = {0.f, 0.f, 0.f, 0.f}; float ss = 0.f;
#pragma unroll
    for (int j = 0; j < 16; ++j) {
        const u32x2 xw = *(const u32x2*)(xr + 16 * j); const f32x4 xv = {bflo(xw.x), bfhi(xw.x), bflo(xw.y), bfhi(xw.y)}, wv = wp[64 * j];
        ss += (xv.x * xv.x + xv.y * xv.y) + (xv.z * xv.z + xv.w * xv.w);
        acc = __builtin_amdgcn_mfma_f32_16x16x4f32(xv.x, wv.x, acc, 0, 0, 0);
        acc = __builtin_amdgcn_mfma_f32_16x16x4f32(xv.y, wv.y, acc, 0, 0, 0);
        acc = __builtin_amdgcn_mfma_f32_16x16x4f32(xv.z, wv.z, acc, 0, 0, 0);
        acc = __builtin_amdgcn_mfma_f32_16x16x4f32(xv.w, wv.w, acc, 0, 0, 0);
    }
    LAS f32x4* gp = (LAS f32x4*)lds; LAS float* sp = (LAS float*)(lds + 8192);
    __syncthreads();
    gp[wave * 64 + lane] = acc; sp[wave * 64 + lane] = ss;
    __syncthreads();
    if (wave == 0) {
        f32x4 a = gp[lane]; float s = sp[lane];
#pragma unroll
        for (int w = 1; w < 8; ++w) { a += gp[w * 64 + lane]; s += sp[w * 64 + lane]; }
        s += __shfl_xor(s, 16); s += __shfl_xor(s, 32);
        const float rstd = rsqrtf(s * (1.f / DM) + EPS);
        const float bias = bg[i16];
#pragma unroll
        for (int i = 0; i < 4; ++i) {
            const float rs = __shfl(rstd, 4 * kq + i);
            const float pre = a[i] * rs + bias;
            const float gc = 15.f * tanhf(pre * (1.f / 15.f));
            const float val = (i16 < 8) ? gc : (fminf(gc, 0.f) - log1pf(fexp(-fabsf(gc))));
            GATES[(size_t)(r0 + 4 * kq + i) * 16 + i16] = val;
        }
    }
}

constexpr int SK_PART = 0, SK_RSTD = 16384;
template <int MODE>
__device__ __forceinline__ void skinny_phase(LAS unsigned char* lds, const bf16_t* A, int K, const bf16_t* Bt, int N, bf16_t* Ob, int ldo, bf16_t* XBs, float* SSQS, float* Os, int c, int G, int nIdle, int tid, int wave, int lane, const Params& SP, int cs_base) {
    const int i16 = lane & 15, q4 = lane >> 4;
    if (c < G - nIdle) return;
    LAS f32x4* part = (LAS f32x4*)(lds + SK_PART); LAS float* rstdS = (LAS float*)(lds + SK_RSTD);
    __syncthreads();
    if (MODE == 0) { const int row = tid >> 4, sub = tid & 15; const float* q = SSQS + row * 128 + 8 * sub;
        const f32x4 a = *(const f32x4*)q, b = *(const f32x4*)(q + 4); float s = ((a[0] + a[1]) + (a[2] + a[3])) + ((b[0] + b[1]) + (b[2] + b[3]));
        s = row16_sum(s);
        if (sub == 0) rstdS[row] = rsqrtf(s * (1.f / 2048.f) + EPS);
        __syncthreads(); }
    const int kper = K >> 3, nks = kper >> 5, k0 = wave * kper;
    for (int j = G - 1 - c; j < (N >> 4); j += nIdle) {
        f32x4 acc0 = {0.f, 0.f, 0.f, 0.f}, acc1 = {0.f, 0.f, 0.f, 0.f};
        f32x4 sd[CS_DN][8]; f32x4* sdst[CS_DN];
        if (CS_D > 0 && MODE == 0 && cs_base >= 0) {
#pragma unroll
            for (int d = 0; d < CS_D; ++d) { const f32x4* ssrc; cs_addr(SP, SP.out, cs_base + (j * NWAVES + wave) * CS_D + d, ssrc, sdst[d]);
#pragma unroll
                for (int i = 0; i < 8; ++i) sd[d][i] = __builtin_nontemporal_load(ssrc + lane + 64 * i); } }
        const bf16_t* bp = Bt + (size_t)(16 * j + i16) * K + k0 + 8 * q4; const bf16_t* ap = A + (size_t)i16 * K + k0 + 8 * q4;
#pragma unroll 11
        for (int ks = 0; ks < nks; ++ks) { const bf16x8 bf = *(const bf16x8*)(bp + 32 * ks), a0 = *(const bf16x8*)(ap + 32 * ks), a1 = *(const bf16x8*)(ap + (size_t)16 * K + 32 * ks);
            acc0 = mma16(a0, bf, acc0); acc1 = mma16(a1, bf, acc1); }
        part[(wave * 2 + 0) * 64 + lane] = acc0; part[(wave * 2 + 1) * 64 + lane] = acc1;
        __syncthreads();
        if (CS_D > 0 && MODE == 0 && cs_base >= 0) {
#pragma unroll
            for (int d = 0; d < CS_D; ++d)
#pragma unroll
                for (int i = 0; i < 8; ++i) __builtin_nontemporal_store(sd[d][i], sdst[d] + lane + 64 * i); }
        if (wave < 2) {
            f32x4 s = part[wave * 64 + lane];
#pragma unroll
            for (int w = 1; w < 8; ++w) s += part[(w * 2 + wave) * 64 + lane];
            const int col = 16 * j + i16;
#pragma unroll
            for (int i = 0; i < 4; ++i) { const int r = 16 * wave + 4 * q4 + i;
                if (MODE == 0) Ob[(size_t)r * ldo + col] = (bf16_t)f2bf(s[i] * rstdS[r]);
                else if (MODE == 1) { const float xo = bf1(XBs[(size_t)r * DM + col]) + s[i]; XBs[(size_t)r * DM + col] = (bf16_t)f2bf(xo);
                    float sq = xo * xo; sq = row16_sum(sq);
                    if (i16 == 0) SSQS[r * 128 + j] = sq; }
                else Os[(size_t)r * DM + col] = bf1(XBs[(size_t)r * DM + col]) + s[i]; }
        }
        __syncthreads();
    }
}

constexpr int SU_PART = 0, SU_RSTD = 98304, SU_NITEMS = 352;
__device__ __forceinline__ void skinny_up(LAS unsigned char* lds, const float* st_in, const float* cw, const float* cb, const bf16_t* XB, const bf16_t* Bt, const float* SSQ, const float* SSQS, float* HALO, unsigned* hcnt,
                                          bf16_t* Z, float* outp, int layer, int c, int G, int nIdle, int tid, int wave, int lane, const Params& SP, int cs_base) {
    if (c < G - nIdle) return;
    const int i16 = lane & 15, q4 = lane >> 4;
    LAS f32x4* part = (LAS f32x4*)(lds + SU_PART); LAS float* rstdS = (LAS float*)(lds + SU_RSTD);
    __syncthreads();
    { const int row = tid >> 2, pt = tid & 3; float s = 0.f;
      if (row < 32) { const float* q = SSQS + row * 128 + 32 * pt;
#pragma unroll
          for (int v = 0; v < 8; ++v) { const f32x4 a = *(const f32x4*)(q + 4 * v); s += (a[0] + a[1]) + (a[2] + a[3]); } }
      else if (row < 96) { const int hr = row - 32; const float* q = SSQ + (size_t)(256 * (hr >> 1) + 254 + (hr & 1)) * 32 + 8 * pt;
          const f32x4 a = *(const f32x4*)q, b = *(const f32x4*)(q + 4); s = ((a[0] + a[1]) + (a[2] + a[3])) + ((b[0] + b[1]) + (b[2] + b[3])); }
      s = row4_sum(s);
      if (pt == 0 && row < 96) rstdS[row] = rsqrtf(s * (1.f / 2048.f) + EPS); }
    __syncthreads();
    const int k0 = wave * 256;
    const bf16_t* ap[6];
#pragma unroll
    for (int rb = 0; rb < 6; ++rb) { const int grow = (rb < 2) ? MP + 16 * rb + i16 : 256 * ((16 * (rb - 2) + i16) >> 1) + 254 + (i16 & 1); ap[rb] = XB + (size_t)grow * DM + k0 + 8 * q4; }
    for (int j = G - 1 - c; j < SU_NITEMS; j += nIdle) {
        const int pn = j >> 3, sb = j & 7, na = 256 * pn + 16 * sb + i16;
        f32x4 acc[6][2];
#pragma unroll
        for (int rb = 0; rb < 6; ++rb) { acc[rb][0] = (f32x4){0.f, 0.f, 0.f, 0.f}; acc[rb][1] = (f32x4){0.f, 0.f, 0.f, 0.f}; }
        f32x4 sd[CS_DN][8]; f32x4* sdst[CS_DN];
        if (CS_D > 0 && cs_base >= 0) {
#pragma unroll
            for (int d = 0; d < CS_D; ++d) { const f32x4* ssrc; cs_addr(SP, outp, cs_base + (j * NWAVES + wave) * CS_D + d, ssrc, sdst[d]);
#pragma unroll
                for (int i = 0; i < 8; ++i) sd[d][i] = __builtin_nontemporal_load(ssrc + lane + 64 * i); } }
        const bf16_t* bpa = Bt + (size_t)na * DM + k0 + 8 * q4; const bf16_t* bpb = bpa + (size_t)128 * DM;
#pragma unroll 2
        for (int ks = 0; ks < 8; ++ks) { const bf16x8 fa = *(const bf16x8*)(bpa + 32 * ks), fb = *(const bf16x8*)(bpb + 32 * ks);
#pragma unroll
            for (int rb = 0; rb < 6; ++rb) { const bf16x8 a = *(const bf16x8*)(ap[rb] + 32 * ks); acc[rb][0] = mma16(a, fa, acc[rb][0]); acc[rb][1] = mma16(a, fb, acc[rb][1]); } }
#pragma unroll
        for (int rb = 0; rb < 6; ++rb) { part[((wave * 6 + rb) * 2 + 0) * 64 + lane] = acc[rb][0]; part[((wave * 6 + rb) * 2 + 1) * 64 + lane] = acc[rb][1]; }
        __syncthreads();
        if (CS_D > 0 && cs_base >= 0) {
#pragma unroll
            for (int d = 0; d < CS_D; ++d)
#pragma unroll
                for (int i = 0; i < 8; ++i) __builtin_nontemporal_store(sd[d][i], sdst[d] + lane + 64 * i); }
        if (wave < 6) {
            const int rb = wave;
            f32x4 sa = part[((0 * 6 + rb) * 2 + 0) * 64 + lane], sbv = part[((0 * 6 + rb) * 2 + 1) * 64 + lane];
#pragma unroll
            for (int w = 1; w < 8; ++w) { sa += part[((w * 6 + rb) * 2 + 0) * 64 + lane]; sbv += part[((w * 6 + rb) * 2 + 1) * 64 + lane]; }
            const int jn = 128 * pn + 16 * sb + i16;
            if (rb < 2) {
                const int bs = 4 * rb + q4;
                float ua[4], ub[4];
#pragma unroll
                for (int i = 0; i < 4; ++i) { const float rs = rstdS[16 * rb + 4 * q4 + i]; ua[i] = sa[i] * rs; ub[i] = sbv[i] * rs; }
                const float wa0 = cw[jn], wa1 = cw[NUP + jn], wa2 = cw[2 * NUP + jn], ba = cb[jn], wb0 = cw[DFF + jn], wb1 = cw[NUP + DFF + jn], wb2 = cw[2 * NUP + DFF + jn], bb = cb[DFF + jn];
                const float* st = st_in + ((size_t)(layer * NBS + bs) * 2) * NUP;
                float a2 = st[jn], a1 = st[NUP + jn], b2 = st[DFF + jn], b1 = st[NUP + DFF + jn];
#pragma unroll
                for (int t = 0; t < 4; ++t) { const float ca = ba + wa0 * a2 + wa1 * a1 + wa2 * ua[t], cbv = bb + wb0 * b2 + wb1 * b1 + wb2 * ub[t];
                    Z[(size_t)(MP + bs * 4 + t) * DFF + jn] = (bf16_t)f2bf(ca / (1.f + fexp(-ca)) * cbv); a2 = a1; a1 = ua[t]; b2 = b1; b1 = ub[t]; }
                float* co = outp + O_CONVS + ((size_t)(layer * NBS + bs) * 2) * NUP;
                co[jn] = ua[2]; co[NUP + jn] = ua[3]; co[DFF + jn] = ub[2]; co[NUP + DFF + jn] = ub[3];
            } else {
#pragma unroll
                for (int i = 0; i < 4; ++i) { const int hr = 16 * (rb - 2) + 4 * q4 + i; const float rs = rstdS[32 + hr]; const float va = sa[i] * rs, vb = sbv[i] * rs;
                    __hip_atomic_store(HALO + (size_t)hr * NUP + na, va, __ATOMIC_RELAXED, __HIP_MEMORY_SCOPE_AGENT); __hip_atomic_store(HALO + (size_t)hr * NUP + na + 128, vb, __ATOMIC_RELAXED, __HIP_MEMORY_SCOPE_AGENT);
                    const int pmg = hr >> 1;
                    if ((pmg & 7) == 7) { float* co = outp + O_CONVP + ((size_t)(layer * NBP + (pmg >> 3)) * 2 + (hr & 1)) * NUP; co[jn] = va; co[DFF + jn] = vb; } }
                asm volatile("s_waitcnt vmcnt(0)" ::: "memory");
                if (lane == 0) __hip_atomic_fetch_add(hcnt, 1u, __ATOMIC_RELAXED, __HIP_MEMORY_SCOPE_AGENT);
            }
        }
        __syncthreads();
    }
}

__device__ __forceinline__ void unpack8(const u32x4 w, float (&x)[8]) { x[0] = bflo(w.x); x[1] = bfhi(w.x); x[2] = bflo(w.y); x[3] = bfhi(w.y); x[4] = bflo(w.z); x[5] = bfhi(w.z); x[6] = bflo(w.w); x[7] = bfhi(w.w); }
__device__ __forceinline__ void load8(const float* p, float (&x)[8]) { const f32x4 a = *(const f32x4*)p, b = *(const f32x4*)(p + 4); x[0] = a.x; x[1] = a.y; x[2] = a.z; x[3] = a.w; x[4] = b.x; x[5] = b.y; x[6] = b.z; x[7] = b.w; }
#ifndef KV_NT
#define KV_NT 0
#endif
__device__ __forceinline__ void store8_nt(float* p, const float (&x)[8]) { __builtin_nontemporal_store((f32x4){x[0], x[1], x[2], x[3]}, (f32x4*)p); __builtin_nontemporal_store((f32x4){x[4], x[5], x[6], x[7]}, (f32x4*)(p + 4)); }
__device__ __forceinline__ void store8(float* p, const float (&x)[8]) { *(f32x4*)p = (f32x4){x[0], x[1], x[2], x[3]}; *(f32x4*)(p + 4) = (f32x4){x[4], x[5], x[6], x[7]}; }
constexpr int AT_PITCH = 272, AT_KOFF = 0, AT_VOFF = 256 * AT_PITCH;
struct AttnItem { int g, b, h, dil, r, qb; };
__device__ __forceinline__ AttnItem attn_decode(int item) {
    AttnItem a; a.g = item >> 9; const int rem = item & 511, idx = rem & 15; a.b = rem >> 7; a.h = (rem >> 4) & 7;
    a.dil = (a.g == 0) ? 1 : (a.g == 1) ? 4 : 16; a.r = (a.g == 0) ? 0 : (a.g == 1) ? (idx >> 2) : idx; a.qb = (a.g == 0) ? idx : (a.g == 1) ? (idx & 3) : 0; return a;
}
struct AttnPre { u32x4 kr[8]; };
__device__ __forceinline__ void attn_fetch(const bf16_t* QKV, const float* rope, const AttnItem& a, int tid, AttnPre& f) {
    const int ck = (a.g * 3 * 8 + a.h) * 128 + 1024, uk0 = 128 * (a.qb - 1); const size_t rowbase = (size_t)a.b * SEQ + a.r;
#pragma unroll
    for (int i = 0; i < 8; ++i) { const int id = tid + 512 * i, kk = id >> 4, ch = id & 15, u = uk0 + kk;
        f.kr[i] = (u32x4){0u, 0u, 0u, 0u};
        if (u >= 0) f.kr[i] = *(const u32x4*)(QKV + (rowbase + (size_t)u * a.dil) * NQKV + ck + 8 * ch); }
}
__device__ __forceinline__ void attn_phase(const Params& P, LAS unsigned char* lds, unsigned lds_base, const bf16_t* QKV, const float* rope, const float* qgain, const float* kgain, float* outp, int ia, bf16_t* OG, float* LSE,
                                           int first, int stride, int nitems, int tid, int wave, int lane) {
    const int i16 = lane & 15, q4 = lane >> 4, qq = i16 >> 2, p = lane & 3;
    const int ch = tid & 15; const float sgn = (ch >= 8) ? 1.f : -1.f;
    float kgn[8];
    load8(kgain + 8 * ch, kgn);
    AttnPre f;
    if (first < nitems) { const AttnItem a0 = attn_decode(first); attn_fetch(QKV, rope, a0, tid, f); }
    __syncthreads();
#pragma unroll 1
    for (int item = first; item < nitems; item += stride) {
        const AttnItem a = attn_decode(item);
        const int g = a.g, h = a.h, qb = a.qb;
        const int cq = (g * 3 * 8 + h) * 128;
        const size_t rowbase = (size_t)a.b * SEQ + a.r;
        const int win = 128 << (2 * g);
        float* kvo = outp + ((g == 0) ? O_KV128P : (g == 1) ? O_KV512P : O_KV2048P) + ((size_t)(ia * NBP + a.b) * win) * 2048 + h * 128 + 8 * ch;
        const int tqa = 16 * wave + i16;
        const int posq = a.r + a.dil * (128 * qb + tqa);
        const size_t grow = (size_t)a.b * SEQ + posq;
        { float c[8], sn[8], cd[8], sd[8];
          { const int u0 = (qb == 0) ? (tid >> 4) : 128 * (qb - 1) + (tid >> 4), pos0 = a.r + a.dil * u0;
            const f32x4* dp = (const f32x4*)(rope + ((size_t)(2052 + g) * 64 + 8 * (tid & 7)) * 2); const f32x4* rp = (const f32x4*)(rope + ((size_t)pos0 * 64 + 8 * (tid & 7)) * 2);
#pragma unroll
            for (int q = 0; q < 4; ++q) { const f32x4 t = dp[q], b0 = rp[q]; cd[2 * q] = t[0]; sd[2 * q] = t[1]; cd[2 * q + 1] = t[2]; sd[2 * q + 1] = t[3];
                c[2 * q] = b0[0]; sn[2 * q] = b0[1]; c[2 * q + 1] = b0[2]; sn[2 * q + 1] = b0[3]; } }
#pragma unroll
          for (int i = 0; i < 8; ++i) { const int id = tid + 512 * i, kk = id >> 4; const int u = 128 * (qb - 1) + kk;
            u32x4 kw = {0u, 0u, 0u, 0u};
            if (u >= 0) {
                float x[8]; unpack8(f.kr[i], x);
                float ss = 0.f;
#pragma unroll
                for (int j = 0; j < 8; ++j) ss += x[j] * x[j];
                ss = row16_sum(ss);
                const float rstd = rsqrtf(ss * (1.f / 128.f) + EPS);
                float o[8];
#pragma unroll
                for (int j = 0; j < 8; ++j) { const float y = x[j] * rstd * kgn[j]; const float pr = dpp_mov<0x128>(y); o[j] = y * c[j] + sgn * pr * sn[j];
                    const float cn = c[j] * cd[j] - sn[j] * sd[j]; sn[j] = sn[j] * cd[j] + c[j] * sd[j]; c[j] = cn; }
                kw.x = pk2(o[0], o[1]); kw.y = pk2(o[2], o[3]); kw.z = pk2(o[4], o[5]); kw.w = pk2(o[6], o[7]);
                const int jw = a.r + a.dil * u - (SEQ - win);
                if (kk >= 128 && jw >= 0) { if (KV_NT) store8_nt(kvo + (size_t)jw * 2048, o); else store8(kvo + (size_t)jw * 2048, o); }
            }
            *(LAS u32x4*)(lds + AT_KOFF + kk * AT_PITCH + (id & 15) * 16) = kw; } }
        u32x4 vr[8];
        { const int cv = cq + 2048, uk0 = 128 * (qb - 1);
#pragma unroll
          for (int i = 0; i < 8; ++i) { const int id = tid + 512 * i, kk = id >> 4, u = uk0 + kk; vr[i] = (u32x4){0u, 0u, 0u, 0u};
              if (u >= 0) vr[i] = *(const u32x4*)(QKV + (rowbase + (size_t)u * a.dil) * NQKV + cv + 8 * (id & 15)); } }
        bf16x8 Qf[4];
        { float x[4][8];
#pragma unroll
          for (int ks = 0; ks < 4; ++ks) unpack8(*(const u32x4*)(QKV + grow * NQKV + cq + 32 * ks + 8 * q4), x[ks]);
          float ss = 0.f;
#pragma unroll
          for (int ks = 0; ks < 4; ++ks)
#pragma unroll
              for (int j = 0; j < 8; ++j) ss += x[ks][j] * x[ks][j];
          ss += __shfl_xor(ss, 16); ss += __shfl_xor(ss, 32);
          const float rstd = rsqrtf(ss * (1.f / 128.f) + EPS);
#pragma unroll
          for (int kp = 0; kp < 2; ++kp) { float g1[8], g2[8], cq_[8], sq_[8];
              load8(qgain + 32 * kp + 8 * q4, g1); load8(qgain + 64 + 32 * kp + 8 * q4, g2);
              const f32x4* rp = (const f32x4*)(rope + ((size_t)posq * 64 + 32 * kp + 8 * q4) * 2);
#pragma unroll
              for (int q = 0; q < 4; ++q) { const f32x4 t = rp[q]; cq_[2 * q] = t[0]; sq_[2 * q] = t[1]; cq_[2 * q + 1] = t[2]; sq_[2 * q + 1] = t[3]; }
              float o1[8], o2[8];
#pragma unroll
              for (int j = 0; j < 8; ++j) { const float y1 = x[kp][j] * rstd * g1[j], y2 = x[kp + 2][j] * rstd * g2[j]; o1[j] = y1 * cq_[j] - y2 * sq_[j]; o2[j] = y2 * cq_[j] + y1 * sq_[j]; }
              u32x4 w1, w2; w1.x = pk2(o1[0], o1[1]); w1.y = pk2(o1[2], o1[3]); w1.z = pk2(o1[4], o1[5]); w1.w = pk2(o1[6], o1[7]); w2.x = pk2(o2[0], o2[1]); w2.y = pk2(o2[2], o2[3]); w2.z = pk2(o2[4], o2[5]); w2.w = pk2(o2[6], o2[7]);
              Qf[kp] = __builtin_bit_cast(bf16x8, w1); Qf[kp + 2] = __builtin_bit_cast(bf16x8, w2); } }
        __syncthreads();
        if (item + stride < nitems) { const AttnItem an = attn_decode(item + stride); attn_fetch(QKV, rope, an, tid, f); }
        f32x4 cl[CS_ATTQN]; const f32x4* csrc = nullptr; f32x4* cdst = nullptr;
        if (CS_ATTQ > 0) { const int cst = item * NWAVES + wave; cs_addr(P, outp, CS_ATT0 + ia * (CS_ATT_PER) + (cst >> 1), csrc, cdst); csrc += (cst & 1) * 256 + lane; cdst += (cst & 1) * 256 + lane;
#pragma unroll
            for (int i = 0; i < CS_ATTQ; ++i) cl[i] = __builtin_nontemporal_load(csrc + 64 * i); }
        const int cb0 = wave & ~1;
        f32x4 S[10];
#pragma unroll
        for (int c = 0; c < 10; ++c) {
            f32x4 acc = {0.f, 0.f, 0.f, 0.f};
#pragma unroll
            for (int ks = 0; ks < 4; ++ks) { const bf16x8 kf = *(const LAS bf16x8*)(lds + AT_KOFF + (16 * (cb0 + c) + i16) * AT_PITCH + (32 * ks + 8 * q4) * 2); acc = mma16(kf, Qf[ks], acc); }
            S[c] = acc;
        }
        const float sc = 0.08838834764831845f * 1.4426950408889634f;
        float mx = -INFINITY;
#pragma unroll
        for (int c = 0; c < 10; ++c)
#pragma unroll
            for (int i = 0; i < 4; ++i) { const int kk = 16 * (cb0 + c) + 4 * q4 + i; const bool ok = (kk >= tqa) && (kk <= tqa + 128) && (qb > 0 || kk >= 128);
                const float s = ok ? S[c][i] * sc : -INFINITY; S[c][i] = s; mx = fmaxf(mx, s); }
        mx = fmaxf(mx, __shfl_xor(mx, 16)); mx = fmaxf(mx, __shfl_xor(mx, 32));
        float l = 0.f;
#pragma unroll
        for (int c = 0; c < 10; ++c)
#pragma unroll
            for (int i = 0; i < 4; ++i) { const float pv = __builtin_amdgcn_exp2f(S[c][i] - mx); S[c][i] = pv; l += pv; }
        l += __shfl_xor(l, 16); l += __shfl_xor(l, 32);
        bf16x8 Pf[5];
#pragma unroll
        for (int kst = 0; kst < 5; ++kst) Pf[kst] = pack8(S[2 * kst], S[2 * kst + 1]);
#pragma unroll
        for (int i = 0; i < 8; ++i) { const int id = tid + 512 * i, kk = id >> 4, u = 128 * (qb - 1) + kk;
            *(LAS u32x4*)(lds + AT_VOFF + kk * AT_PITCH + (id & 15) * 16) = vr[i];
            const int jw = a.r + a.dil * u - (SEQ - win);
            if (kk >= 128 && jw >= 0) { float vx[8]; unpack8(vr[i], vx); if (KV_NT) store8_nt(kvo + (size_t)jw * 2048 + 1024, vx); else store8(kvo + (size_t)jw * 2048 + 1024, vx); } }
        __syncthreads();
        if (CS_ATTQ > 0) {
#pragma unroll
            for (int i = 0; i < CS_ATTQ; ++i) __builtin_nontemporal_store(cl[i], cdst + 64 * i);
#pragma unroll
            for (int i = 0; i < CS_ATTQ; ++i) cl[i] = __builtin_nontemporal_load(csrc + 64 * (CS_ATTQ + i)); }
        const float inv = 1.f / l;
        bf16_t* orow = OG + grow * 3072 + g * 1024 + h * 128 + 4 * q4;
        const unsigned vbase = lds_base + AT_VOFF + (16 * cb0 + 4 * q4 + qq) * AT_PITCH + 8 * p;
#pragma unroll
        for (int eb = 0; eb < 8; ++eb) {
            f32x4 acc = {0.f, 0.f, 0.f, 0.f};
            bf16x8 v0, v1, v2, v3, v4;
            TR_READ5(v0, v1, v2, v3, v4, vbase, 0 * AT_PITCH + 32 * eb, 16 * AT_PITCH + 32 * eb, 32 * AT_PITCH + 32 * eb, 48 * AT_PITCH + 32 * eb, 64 * AT_PITCH + 32 * eb, 80 * AT_PITCH + 32 * eb,
                     96 * AT_PITCH + 32 * eb, 112 * AT_PITCH + 32 * eb, 128 * AT_PITCH + 32 * eb, 144 * AT_PITCH + 32 * eb);
            acc = mma16(v0, Pf[0], acc); acc = mma16(v1, Pf[1], acc); acc = mma16(v2, Pf[2], acc); acc = mma16(v3, Pf[3], acc); acc = mma16(v4, Pf[4], acc);
            u32x2 w; w.x = pk2(acc[0] * inv, acc[1] * inv); w.y = pk2(acc[2] * inv, acc[3] * inv);
            *(u32x2*)(orow + 16 * eb) = w;
        }
        if (q4 == 0) LSE[grow * 24 + g * 8 + h] = (mx + log2f(l)) * 0.6931471805599453f;
        if (CS_ATTQ > 0) {
#pragma unroll
            for (int i = 0; i < CS_ATTQ; ++i) __builtin_nontemporal_store(cl[i], cdst + 64 * (CS_ATTQ + i)); }
    }
    __syncthreads();
}

__device__ __forceinline__ void sample_prep_vec(const bf16_t* src, const float* gain, const float* rope, int tt, LAS float* dst, int lane) {
    const float x1 = bf1(src[lane]), x2 = bf1(src[lane + 64]);
    const float rstd = rsqrtf(wave_sum(x1 * x1 + x2 * x2) * (1.f / 128.f) + EPS);
    const float y1 = x1 * rstd * gain[lane], y2 = x2 * rstd * gain[64 + lane];
    const f32x2 cs = *(const f32x2*)(rope + ((size_t)(SEQ + tt) * 64 + lane) * 2);
    dst[lane] = y1 * cs.x - y2 * cs.y; dst[lane + 64] = y2 * cs.x + y1 * cs.y;
}
__device__ __forceinline__ void attn_sample_task(LAS unsigned char* wl  , const bf16_t* QKV, const float* rope, const float* qgain, const float* kgain, float* outp,
                                                 const float* c128, const float* c512, const float* c2048, bf16_t* OG, float* LSE, int ia, int wt, int lane) {
    const int bs = wt / 96, rem = wt % 96, g = rem >> 5, h = (rem >> 2) & 7, t = rem & 3;
    const int win = 128 << (2 * g), dil = 1 << (2 * g);
    const float* cache = ((g == 0) ? c128 : (g == 1) ? c512 : c2048) + (size_t)(ia * NBS + bs) * win * 2048;
    const int cq = (g * 3 * 8 + h) * 128, ck = cq + 1024, cv = cq + 2048;
    const size_t rq = (size_t)MP + bs * 4 + t;
    LAS float* qs = (LAS float*)wl; LAS float* ps = (LAS float*)(wl + 512); LAS float* knew = (LAS float*)(wl + 1536);
    sample_prep_vec(QKV + rq * NQKV + cq, qgain, rope, t, qs, lane);
    for (int tn = (g == 0) ? 0 : t; tn <= t; ++tn) sample_prep_vec(QKV + ((size_t)MP + bs * 4 + tn) * NQKV + ck, kgain, rope, tn, knew + tn * 128, lane);
    asm volatile("s_waitcnt lgkmcnt(0)" ::: "memory");
    { float* kvo = outp + ((g == 0) ? O_KV128S : (g == 1) ? O_KV512S : O_KV2048S) + (((size_t)(ia * NBS + bs) * win + (win - TSAMP + t)) * 2) * 1024 + h * 128;
      kvo[lane] = knew[t * 128 + lane]; kvo[lane + 64] = knew[t * 128 + lane + 64];
      const bf16_t* vp = QKV + rq * NQKV + cv; kvo[1024 + lane] = bf1(vp[lane]); kvo[1024 + lane + 64] = bf1(vp[lane + 64]); }
    float sv[3];
#pragma unroll
    for (int pass = 0; pass < 3; ++pass) {
        const int j = pass * 64 + lane; float s = -INFINITY;
        if (j <= 128) {
            const int idx = win + t - dil * j; float acc = 0.f;
            if (idx >= win) { const LAS float* kp = knew + (idx - win) * 128;
                for (int d = 0; d < 128; d += 4) { const LAS float* q = qs + d; acc += q[0] * kp[d] + q[1] * kp[d + 1] + q[2] * kp[d + 2] + q[3] * kp[d + 3]; } }
            else { const float* kp = cache + ((size_t)idx * 2 + 0) * 1024 + h * 128;
                for (int d = 0; d < 128; d += 4) { const f32x4 kx = *(const f32x4*)(kp + d); const LAS float* q = qs + d; acc += q[0] * kx.x + q[1] * kx.y + q[2] * kx.z + q[3] * kx.w; } }
            s = acc * 0.08838834764831845f;
        }
        sv[pass] = s;
    }
    const float mx = wave_max(fmaxf(fmaxf(sv[0], sv[1]), sv[2]));
    float l = 0.f;
#pragma unroll
    for (int pass = 0; pass < 3; ++pass) { const float pv = fexp(sv[pass] - mx); l += pv; ps[pass * 64 + lane] = pv; }
    l = wave_sum(l);
    asm volatile("s_waitcnt lgkmcnt(0)" ::: "memory");
    { const int jg = lane >> 4, dd = lane & 15;
      float o[8];
#pragma unroll
      for (int q = 0; q < 8; ++q) o[q] = 0.f;
#pragma unroll 4
      for (int j = jg; j <= 128; j += 4) {
          const int idx = win + t - dil * j; const float pj = ps[j]; float v[8];
          if (idx >= win) { unpack8(*(const u32x4*)(QKV + ((size_t)MP + bs * 4 + (idx - win)) * NQKV + cv + 8 * dd), v); }
          else { load8(cache + ((size_t)idx * 2 + 1) * 1024 + h * 128 + 8 * dd, v); }
#pragma unroll
          for (int q = 0; q < 8; ++q) o[q] += pj * v[q];
      }
      const float inv = 1.f / l;
#pragma unroll
      for (int q = 0; q < 8; ++q) { o[q] += __shfl_xor(o[q], 16); o[q] += __shfl_xor(o[q], 32); o[q] *= inv; }
      if (jg == 0) { u32x4 w; w.x = pk2(o[0], o[1]); w.y = pk2(o[2], o[3]); w.z = pk2(o[4], o[5]); w.w = pk2(o[6], o[7]); *(u32x4*)(OG + rq * 3072 + g * 1024 + h * 128 + 8 * dd) = w; } }
    if (lane == 0) LSE[rq * 24 + g * 8 + h] = mx + logf(l);
}

__device__ __forceinline__ void combine_row(const bf16_t* OG, const float* LSE, bf16_t* OC, int r, int lane) {
    const int hh = lane >> 3;
    const float l0 = LSE[(size_t)r * 24 + hh], l1 = LSE[(size_t)r * 24 + 8 + hh], l2 = LSE[(size_t)r * 24 + 16 + hh];
    const float mx = fmaxf(l0, fmaxf(l1, l2));
    float e0 = fexp(l0 - mx), e1 = fexp(l1 - mx), e2 = fexp(l2 - mx);
    const float inv = 1.f / (e0 + e1 + e2); e0 *= inv; e1 *= inv; e2 *= inv;
    const bf16_t* src = OG + (size_t)r * 3072 + 16 * lane;
#pragma unroll
    for (int c = 0; c < 2; ++c) {
        const u32x4 a = *(const u32x4*)(src + 8 * c), bq = *(const u32x4*)(src + 1024 + 8 * c), cc = *(const u32x4*)(src + 2048 + 8 * c);
        u32x4 o;
        o.x = pk2(e0 * bflo(a.x) + e1 * bflo(bq.x) + e2 * bflo(cc.x), e0 * bfhi(a.x) + e1 * bfhi(bq.x) + e2 * bfhi(cc.x));
        o.y = pk2(e0 * bflo(a.y) + e1 * bflo(bq.y) + e2 * bflo(cc.y), e0 * bfhi(a.y) + e1 * bfhi(bq.y) + e2 * bfhi(cc.y));
        o.z = pk2(e0 * bflo(a.z) + e1 * bflo(bq.z) + e2 * bflo(cc.z), e0 * bfhi(a.z) + e1 * bfhi(bq.z) + e2 * bfhi(cc.z));
        o.w = pk2(e0 * bflo(a.w) + e1 * bflo(bq.w) + e2 * bflo(cc.w), e0 * bfhi(a.w) + e1 * bfhi(bq.w) + e2 * bfhi(cc.w));
        *(u32x4*)(OC + (size_t)r * DO + 16 * lane + 8 * c) = o;
    }
}

template <int NR> __device__ __forceinline__ void combine_rows(const bf16_t* OG, const float* LSE, bf16_t* OC, int r0, int rstride, int rmax, int lane) {
    const int hh = lane >> 3;
    u32x4 a[NR][2], bq[NR][2], cc[NR][2]; float l0[NR], l1[NR], l2[NR];
#pragma unroll
    for (int k = 0; k < NR; ++k) { const int r = r0 + k * rstride;
        if (r < rmax) { l0[k] = LSE[(size_t)r * 24 + hh]; l1[k] = LSE[(size_t)r * 24 + 8 + hh]; l2[k] = LSE[(size_t)r * 24 + 16 + hh];
            const bf16_t* src = OG + (size_t)r * 3072 + 16 * lane;
#pragma unroll
            for (int c = 0; c < 2; ++c) { a[k][c] = *(const u32x4*)(src + 8 * c); bq[k][c] = *(const u32x4*)(src + 1024 + 8 * c); cc[k][c] = *(const u32x4*)(src + 2048 + 8 * c); } } }
#pragma unroll
    for (int k = 0; k < NR; ++k) { const int r = r0 + k * rstride;
        if (r < rmax) {
            const float mx = fmaxf(l0[k], fmaxf(l1[k], l2[k]));
            float e0 = fexp(l0[k] - mx), e1 = fexp(l1[k] - mx), e2 = fexp(l2[k] - mx);
            const float inv = 1.f / (e0 + e1 + e2); e0 *= inv; e1 *= inv; e2 *= inv;
#pragma unroll
            for (int c = 0; c < 2; ++c) { const u32x4 A = a[k][c], B = bq[k][c], C = cc[k][c]; u32x4 o;
                o.x = pk2(e0 * bflo(A.x) + e1 * bflo(B.x) + e2 * bflo(C.x), e0 * bfhi(A.x) + e1 * bfhi(B.x) + e2 * bfhi(C.x));
                o.y = pk2(e0 * bflo(A.y) + e1 * bflo(B.y) + e2 * bflo(C.y), e0 * bfhi(A.y) + e1 * bfhi(B.y) + e2 * bfhi(C.y));
                o.z = pk2(e0 * bflo(A.z) + e1 * bflo(B.z) + e2 * bflo(C.z), e0 * bfhi(A.z) + e1 * bfhi(B.z) + e2 * bfhi(C.z));
                o.w = pk2(e0 * bflo(A.w) + e1 * bflo(B.w) + e2 * bflo(C.w), e0 * bfhi(A.w) + e1 * bfhi(B.w) + e2 * bfhi(C.w));
                *(u32x4*)(OC + (size_t)r * DO + 16 * lane + 8 * c) = o; } } }
}

template <int CTRL, int RMASK> __device__ __forceinline__ float dpp_f(float oldv, float src) {
    return __builtin_bit_cast(float, __builtin_amdgcn_update_dpp(__builtin_bit_cast(int, oldv), __builtin_bit_cast(int, src), CTRL, RMASK, 0xf, false)); }
__device__ __forceinline__ float scan_sum(float v, int lane) {
    (void)lane;
    v += dpp_f<0x111, 0xf>(0.f, v); v += dpp_f<0x112, 0xf>(0.f, v); v += dpp_f<0x114, 0xf>(0.f, v); v += dpp_f<0x118, 0xf>(0.f, v);
    v += dpp_f<0x142, 0xa>(0.f, v); v += dpp_f<0x143, 0xc>(0.f, v);
    return v;
}
__device__ __forceinline__ float scan_max(float v, int lane) {
    (void)lane; const float ninf = -INFINITY;
    v = fmaxf(v, dpp_f<0x111, 0xf>(ninf, v)); v = fmaxf(v, dpp_f<0x112, 0xf>(ninf, v)); v = fmaxf(v, dpp_f<0x114, 0xf>(ninf, v)); v = fmaxf(v, dpp_f<0x118, 0xf>(ninf, v));
    v = fmaxf(v, dpp_f<0x142, 0xa>(ninf, v)); v = fmaxf(v, dpp_f<0x143, 0xc>(ninf, v));
    return v;
}
#ifndef ML_COPY
#define ML_COPY 0
#endif
constexpr int ML_QP = 272, ML_VP = 144, ML_PP = 144;
constexpr int ML_QSZ = 64 * ML_QP, ML_VSZ = 64 * ML_VP;
constexpr int ML_Q = 0, ML_K = ML_Q + 2 * ML_QSZ, ML_V = ML_K + 2 * ML_QSZ, ML_KW = ML_V + 2 * ML_VSZ, ML_P = ML_KW + ML_QSZ, ML_N = ML_P + 64 * ML_PP, ML_DEN = ML_N + 1024, ML_END = ML_DEN + 256;
__device__ __forceinline__ void mlstm_prompt(LAS unsigned char* lds, unsigned lds_base, const bf16_t* QKVO, const float* GATES, bf16_t* HRAW, float* SQ, float* out, int ib, int unit, int tid, int wave, int lane) {
    const int bh = unit >> 2, sl = unit & 3;
    const int b = bh >> 3, h = bh & 7;
    const int i16 = lane & 15, q4 = lane >> 4, qq = i16 >> 2, p = lane & 3;
    const int rb = wave >> 1, ea = wave & 1, e0 = 64 * sl + 32 * ea;
    f32x4 CT[2][8];
#pragma unroll
    for (int a = 0; a < 2; ++a)
#pragma unroll
        for (int d = 0; d < 8; ++d) CT[a][d] = (f32x4){0.f, 0.f, 0.f, 0.f};
    float m = 0.f;
    const unsigned vbase0 = lds_base + ML_V + (8 * q4 + qq) * ML_VP + (32 * ea + 4 * p) * 2, kwbase = lds_base + ML_KW + (8 * q4 + qq) * ML_QP + 8 * p;
    LAS float* nS = (LAS float*)(lds + ML_N); LAS float* denS = (LAS float*)(lds + ML_DEN);
    const size_t rbase = (size_t)b * SEQ;
    const int srow0 = tid >> 4, sch = tid & 15, vrow = tid >> 3, vch = tid & 7;
    u32x4 pq0, pq1, pk0, pk1, pv; float pig, plf;
    { const bf16_t* s0 = QKVO + (rbase + srow0) * NIN + h * 128 + 8 * sch; const bf16_t* s1 = s0 + (size_t)32 * NIN;
      pq0 = *(const u32x4*)s0; pk0 = *(const u32x4*)(s0 + 1024); pq1 = *(const u32x4*)s1; pk1 = *(const u32x4*)(s1 + 1024);
      pv = *(const u32x4*)(QKVO + (rbase + vrow) * NIN + 2048 + h * 256 + 64 * sl + 8 * vch);
      pig = GATES[(rbase + lane) * 16 + h]; plf = GATES[(rbase + lane) * 16 + 8 + h]; }
    __syncthreads();
    if (tid < 128) nS[tid] = 0.f;
    *(LAS u32x4*)(lds + ML_Q + srow0 * ML_QP + sch * 16) = pq0; *(LAS u32x4*)(lds + ML_Q + (srow0 + 32) * ML_QP + sch * 16) = pq1;
    *(LAS u32x4*)(lds + ML_K + srow0 * ML_QP + sch * 16) = pk0; *(LAS u32x4*)(lds + ML_K + (srow0 + 32) * ML_QP + sch * 16) = pk1;
    *(LAS u32x4*)(lds + ML_V + vrow * ML_VP + vch * 16) = pv;
    __syncthreads();
    float hv0[4] = {0.f, 0.f, 0.f, 0.f}, hv1[4] = {0.f, 0.f, 0.f, 0.f}, sv0[4] = {0.f, 0.f, 0.f, 0.f}, sv1[4] = {0.f, 0.f, 0.f, 0.f};
#define ML_FLUSH(rprev) do { _Pragma("unroll") for (int i = 0; i < 4; ++i) { const int t = 16 * rb + 4 * q4 + i; \
        bf16_t* hp = HRAW + ((rprev) + t) * DM + h * 256 + e0 + i16; hp[0] = (bf16_t)f2bf(hv0[i]); hp[16] = (bf16_t)f2bf(hv1[i]); \
        if (i16 == 0) { float* sp = SQ + ((rprev) + t) * 128 + h * 16 + 4 * sl + 2 * ea; sp[0] = sv0[i]; sp[1] = sv1[i]; } } } while (0)
#pragma unroll 1
    for (int c = 0; c < 32; ++c) {
        const int cur = c & 1, nxt = cur ^ 1;
        const size_t r0 = rbase + 64 * c;
        const LAS unsigned char* Qc = lds + ML_Q + cur * ML_QSZ; const LAS unsigned char* Kc = lds + ML_K + cur * ML_QSZ;
        const float ig = pig, lf = plf;
        asm volatile("" :: "v"(ig), "v"(lf));
        if (c > 0) ML_FLUSH(r0 - 64);
        { const size_t rn = rbase + 64 * ((c < 31) ? c + 1 : c);
          const bf16_t* s0 = QKVO + (rn + srow0) * NIN + h * 128 + 8 * sch; const bf16_t* s1 = s0 + (size_t)32 * NIN;
          pq0 = *(const u32x4*)s0; pk0 = *(const u32x4*)(s0 + 1024); pq1 = *(const u32x4*)s1; pk1 = *(const u32x4*)(s1 + 1024);
          pv = *(const u32x4*)(QKVO + (rn + vrow) * NIN + 2048 + h * 256 + 64 * sl + 8 * vch);
          pig = GATES[(rn + lane) * 16 + h]; plf = GATES[(rn + lane) * 16 + 8 + h]; }
        const float bcum = scan_sum(lf, lane);
        const float av = ig - bcum;
        const float Av = fmaxf(m, scan_max(av, lane));
        const float bL = __shfl(bcum, 63), A63 = __shfl(Av, 63);
        const float wsv = fexp(av - A63), wC = fexp(m - A63);
#pragma unroll
        for (int i = 0; i < 2; ++i) { const int id = lane + 64 * i, rr = 8 * wave + (id >> 4), ch = id & 15;
            const u32x4 kx = *(const LAS u32x4*)(Kc + rr * ML_QP + ch * 16); const float w = __shfl(wsv, rr);
            u32x4 o; o.x = pk2(bflo(kx.x) * w, bfhi(kx.x) * w); o.y = pk2(bflo(kx.y) * w, bfhi(kx.y) * w); o.z = pk2(bflo(kx.z) * w, bfhi(kx.z) * w); o.w = pk2(bflo(kx.w) * w, bfhi(kx.w) * w);
            *(LAS u32x4*)(lds + ML_KW + rr * ML_QP + ch * 16) = o; }
        {
#pragma unroll
          for (int cc = 0; cc < 2; ++cc) { const int cb = 2 * (wave & 1) + cc;
            f32x4 s = {0.f, 0.f, 0.f, 0.f};
            if (cb <= rb) {
#pragma unroll
                for (int ks = 0; ks < 4; ++ks) { const bf16x8 af = *(const LAS bf16x8*)(Qc + (16 * rb + i16) * ML_QP + (32 * ks + 8 * q4) * 2);
                    const bf16x8 bf = *(const LAS bf16x8*)(Kc + (16 * cb + i16) * ML_QP + (32 * ks + 8 * q4) * 2); s = mma16(af, bf, s); } }
            const int sidx = 16 * cb + i16; const float as = __shfl(av, sidx);
#pragma unroll
            for (int i = 0; i < 4; ++i) { const int t = 16 * rb + 4 * q4 + i; const float At = __shfl(Av, t);
                const float pv_ = (sidx <= t && cb <= rb) ? s[i] * fexp(as - At) : 0.f;
                *(LAS bf16_t*)(lds + ML_P + t * ML_PP + sidx * 2) = (bf16_t)f2bf(pv_); } } }
        LDS_BARRIER();
        { const int t = tid >> 3, part = tid & 7;
          const LAS unsigned char* qrow = Qc + t * ML_QP + part * 32;
          const u32x4 qa = *(const LAS u32x4*)(qrow), qb = *(const LAS u32x4*)(qrow + 16);
          const LAS float* nn = nS + cur * 128 + 16 * part;
          float a = nn[0] * bflo(qa.x) + nn[1] * bfhi(qa.x) + nn[2] * bflo(qa.y) + nn[3] * bfhi(qa.y) + nn[4] * bflo(qa.z) + nn[5] * bfhi(qa.z) + nn[6] * bflo(qa.w) + nn[7] * bfhi(qa.w)
                  + nn[8] * bflo(qb.x) + nn[9] * bfhi(qb.x) + nn[10] * bflo(qb.y) + nn[11] * bfhi(qb.y) + nn[12] * bflo(qb.z) + nn[13] * bfhi(qb.z) + nn[14] * bflo(qb.w) + nn[15] * bfhi(qb.w);
          const u32x4 pr = *(const LAS u32x4*)(lds + ML_P + t * ML_PP + part * 16);
          const float rsum = ((bflo(pr.x) + bfhi(pr.x)) + (bflo(pr.y) + bfhi(pr.y))) + ((bflo(pr.z) + bfhi(pr.z)) + (bflo(pr.w) + bfhi(pr.w)));
          const float At = __shfl(Av, t), bt = __shfl(bcum, t);
          float val = fexp(m - At) * a + rsum;
          val = row8_sum(val);
          if (part == 0) denS[t] = 1.f / fmaxf(fabsf(val), fexp(-(bt + At))); }
        if (tid < 128) { float acc = wC * nS[cur * 128 + tid];
#pragma unroll 8
            for (int s = 0; s < 64; ++s) acc += bf1(*(const LAS bf16_t*)(lds + ML_KW + s * ML_QP + tid * 2));
            nS[nxt * 128 + tid] = acc; }
        f32x4 num0 = {0.f, 0.f, 0.f, 0.f}, num1 = {0.f, 0.f, 0.f, 0.f};
#pragma unroll
        for (int ks = 0; ks < 4; ++ks) { const LAS unsigned char* qrow = Qc + (16 * rb + i16) * ML_QP;
            const u32x2 lo = *(const LAS u32x2*)(qrow + (32 * ks + 4 * q4) * 2), hi = *(const LAS u32x2*)(qrow + (32 * ks + 16 + 4 * q4) * 2);
            u32x4 w; w.x = lo.x; w.y = lo.y; w.z = hi.x; w.w = hi.y; const bf16x8 af = __builtin_bit_cast(bf16x8, w);
            num0 = mma16(af, pack8(CT[0][2 * ks], CT[0][2 * ks + 1]), num0); num1 = mma16(af, pack8(CT[1][2 * ks], CT[1][2 * ks + 1]), num1); }
#pragma unroll
        for (int i = 0; i < 4; ++i) { const float wi = fexp(m - __shfl(Av, 16 * rb + 4 * q4 + i)); num0[i] *= wi; num1[i] *= wi; }
        const unsigned vbase = vbase0 + cur * ML_VSZ;
        bf16x8 V00, V01, V10, V11;
        TR_READ4(V00, V01, V10, V11, vbase, 0, 4 * ML_VP, 32 * ML_VP, 36 * ML_VP, 32, 4 * ML_VP + 32, 32 * ML_VP + 32, 36 * ML_VP + 32);
        { const bf16x8 pf0 = *(const LAS bf16x8*)(lds + ML_P + (16 * rb + i16) * ML_PP + (8 * q4) * 2), pf1 = *(const LAS bf16x8*)(lds + ML_P + (16 * rb + i16) * ML_PP + (32 + 8 * q4) * 2);
          num0 = mma16(pf0, V00, num0); num0 = mma16(pf1, V01, num0); num1 = mma16(pf0, V10, num1); num1 = mma16(pf1, V11, num1); }
#pragma unroll
        for (int a = 0; a < 2; ++a)
#pragma unroll
            for (int d = 0; d < 8; ++d) CT[a][d] = CT[a][d] * wC;
#pragma unroll
        for (int ks = 0; ks < 2; ++ks)
#pragma unroll
            for (int dg = 0; dg < 2; ++dg) { bf16x8 k0, k1, k2, k3;
                TR_READ4(k0, k1, k2, k3, kwbase, 32 * ks * ML_QP + 32 * (4 * dg), (32 * ks + 4) * ML_QP + 32 * (4 * dg), 32 * ks * ML_QP + 32 * (4 * dg + 1), (32 * ks + 4) * ML_QP + 32 * (4 * dg + 1),
                         32 * ks * ML_QP + 32 * (4 * dg + 2), (32 * ks + 4) * ML_QP + 32 * (4 * dg + 2), 32 * ks * ML_QP + 32 * (4 * dg + 3), (32 * ks + 4) * ML_QP + 32 * (4 * dg + 3));
                const bf16x8 va = ks ? V01 : V00, vb = ks ? V11 : V10;
                CT[0][4 * dg] = mma16(k0, va, CT[0][4 * dg]); CT[0][4 * dg + 1] = mma16(k1, va, CT[0][4 * dg + 1]); CT[0][4 * dg + 2] = mma16(k2, va, CT[0][4 * dg + 2]); CT[0][4 * dg + 3] = mma16(k3, va, CT[0][4 * dg + 3]);
                CT[1][4 * dg] = mma16(k0, vb, CT[1][4 * dg]); CT[1][4 * dg + 1] = mma16(k1, vb, CT[1][4 * dg + 1]); CT[1][4 * dg + 2] = mma16(k2, vb, CT[1][4 * dg + 2]); CT[1][4 * dg + 3] = mma16(k3, vb, CT[1][4 * dg + 3]); }
        { LAS unsigned char* Qn = lds + ML_Q + nxt * ML_QSZ; LAS unsigned char* Kn = lds + ML_K + nxt * ML_QSZ;
          *(LAS u32x4*)(Qn + srow0 * ML_QP + sch * 16) = pq0; *(LAS u32x4*)(Qn + (srow0 + 32) * ML_QP + sch * 16) = pq1;
          *(LAS u32x4*)(Kn + srow0 * ML_QP + sch * 16) = pk0; *(LAS u32x4*)(Kn + (srow0 + 32) * ML_QP + sch * 16) = pk1;
          *(LAS u32x4*)(lds + ML_V + nxt * ML_VSZ + vrow * ML_VP + vch * 16) = pv; }
        LDS_BARRIER();
#pragma unroll
        for (int i = 0; i < 4; ++i) { const int t = 16 * rb + 4 * q4 + i; const float dinv = denS[t]; const float h0 = num0[i] * dinv, h1 = num1[i] * dinv;
            hv0[i] = h0; hv1[i] = h1;
            float s0 = h0 * h0, s1 = h1 * h1;
            s0 = row16_sum(s0);
            s1 = row16_sum(s1);
            sv0[i] = s0; sv1[i] = s1; }
        m = bL + A63;
    }
    ML_FLUSH(rbase + 64 * 31);
#undef ML_FLUSH
    const size_t sb = (size_t)(ib * NBP + b) * 8 + h;
    if (rb == 0) {
#pragma unroll
        for (int a = 0; a < 2; ++a)
#pragma unroll
            for (int d = 0; d < 8; ++d) *(f32x4*)(out + O_CP + (sb * 256 + e0 + 16 * a + i16) * 128 + 16 * d + 4 * q4) = CT[a][d]; }
    if (sl == 0) { if (tid < 128) out[O_NP + sb * 128 + tid] = nS[tid]; if (tid == 0) out[O_MP + sb] = m; }
}

__device__ __forceinline__ void hn_row(const bf16_t* HRAW, const float* SQ, const bf16_t* QKVO, const float* gh, bf16_t* HN, int r, int lane) {
    const int hh = lane >> 3;
    const f32x4 s0 = *(const f32x4*)(SQ + (size_t)r * 128 + hh * 16), s1 = *(const f32x4*)(SQ + (size_t)r * 128 + hh * 16 + 4), s2 = *(const f32x4*)(SQ + (size_t)r * 128 + hh * 16 + 8), s3 = *(const f32x4*)(SQ + (size_t)r * 128 + hh * 16 + 12);
    const float tot = (((s0[0] + s0[1]) + (s0[2] + s0[3])) + ((s1[0] + s1[1]) + (s1[2] + s1[3]))) + (((s2[0] + s2[1]) + (s2[2] + s2[3])) + ((s3[0] + s3[1]) + (s3[2] + s3[3])));
    const float rs = rsqrtf(tot * (1.f / 256.f) + EPS);
#pragma unroll
    for (int c = 0; c < 4; ++c) { const int col = 32 * lane + 8 * c;
        const u32x4 hx = *(const u32x4*)(HRAW + (size_t)r * DM + col), ox = *(const u32x4*)(QKVO + (size_t)r * NIN + 4096 + col);
        const f32x4 g0 = *(const f32x4*)(gh + col), g1 = *(const f32x4*)(gh + col + 4);
        u32x4 o;
        o.x = pk2(bflo(hx.x) * rs * g0[0] / (1.f + fexp(-bflo(ox.x))), bfhi(hx.x) * rs * g0[1] / (1.f + fexp(-bfhi(ox.x))));
        o.y = pk2(bflo(hx.y) * rs * g0[2] / (1.f + fexp(-bflo(ox.y))), bfhi(hx.y) * rs * g0[3] / (1.f + fexp(-bfhi(ox.y))));
        o.z = pk2(bflo(hx.z) * rs * g1[0] / (1.f + fexp(-bflo(ox.z))), bfhi(hx.z) * rs * g1[1] / (1.f + fexp(-bfhi(ox.z))));
        o.w = pk2(bflo(hx.w) * rs * g1[2] / (1.f + fexp(-bflo(ox.w))), bfhi(hx.w) * rs * g1[3] / (1.f + fexp(-bfhi(ox.w))));
        *(u32x4*)(HN + (size_t)r * DM + col) = o; }
}

__device__ __forceinline__ void hn_rows2(const bf16_t* HRAW, const float* SQ, const bf16_t* QKVO, const float* gh, bf16_t* HN, int r0, int rstride, int lane) {
    const int hh = lane >> 3;
    f32x4 sq[2][4]; u32x4 hx[2][4], ox[2][4];
#pragma unroll
    for (int k = 0; k < 2; ++k) { const int r = r0 + k * rstride;
#pragma unroll
        for (int q = 0; q < 4; ++q) sq[k][q] = *(const f32x4*)(SQ + (size_t)r * 128 + hh * 16 + 4 * q);
#pragma unroll
        for (int c = 0; c < 4; ++c) { const int col = 32 * lane + 8 * c; hx[k][c] = *(const u32x4*)(HRAW + (size_t)r * DM + col); ox[k][c] = *(const u32x4*)(QKVO + (size_t)r * NIN + 4096 + col); } }
#pragma unroll
    for (int k = 0; k < 2; ++k) { const int r = r0 + k * rstride;
        const f32x4 s0 = sq[k][0], s1 = sq[k][1], s2 = sq[k][2], s3 = sq[k][3];
        const float tot = (((s0[0] + s0[1]) + (s0[2] + s0[3])) + ((s1[0] + s1[1]) + (s1[2] + s1[3]))) + (((s2[0] + s2[1]) + (s2[2] + s2[3])) + ((s3[0] + s3[1]) + (s3[2] + s3[3])));
        const float rs = rsqrtf(tot * (1.f / 256.f) + EPS);
#pragma unroll
        for (int c = 0; c < 4; ++c) { const int col = 32 * lane + 8 * c; const u32x4 H = hx[k][c], O = ox[k][c];
            const f32x4 g0 = *(const f32x4*)(gh + col), g1 = *(const f32x4*)(gh + col + 4);
            u32x4 o;
            o.x = pk2(bflo(H.x) * rs * g0[0] / (1.f + fexp(-bflo(O.x))), bfhi(H.x) * rs * g0[1] / (1.f + fexp(-bfhi(O.x))));
            o.y = pk2(bflo(H.y) * rs * g0[2] / (1.f + fexp(-bflo(O.y))), bfhi(H.y) * rs * g0[3] / (1.f + fexp(-bfhi(O.y))));
            o.z = pk2(bflo(H.z) * rs * g1[0] / (1.f + fexp(-bflo(O.z))), bfhi(H.z) * rs * g1[1] / (1.f + fexp(-bfhi(O.z))));
            o.w = pk2(bflo(H.w) * rs * g1[2] / (1.f + fexp(-bflo(O.w))), bfhi(H.w) * rs * g1[3] / (1.f + fexp(-bfhi(O.w))));
            *(u32x4*)(HN + (size_t)r * DM + col) = o; } }
}

#ifndef HN_TAIL
#define HN_TAIL 0
#endif
__device__ __forceinline__ void hn_tail(unsigned* ctl, const bf16_t* HRAW, const float* SQ, const bf16_t* QKVO, const float* gh, bf16_t* HN, int ib, int unit, int tid, int wave, int lane) {
    const int b = unit >> 5;
    unsigned* cnt = ctl + CW_PRG + (ib * 4 + b) * 64;
    asm volatile("s_waitcnt vmcnt(0)" ::: "memory");
    __syncthreads();
    if (tid == 0) {
        __builtin_amdgcn_fence(__ATOMIC_RELEASE, "agent");
        __hip_atomic_fetch_add(cnt, 1u, __ATOMIC_RELAXED, __HIP_MEMORY_SCOPE_AGENT);
        unsigned spins = 0;
        while (__hip_atomic_load(cnt, __ATOMIC_RELAXED, __HIP_MEMORY_SCOPE_AGENT) < 32u) { __builtin_amdgcn_s_sleep(8);
            if (++spins > (1u << 20)) { __hip_atomic_store(ctl + CW_TMO, 1u, __ATOMIC_RELAXED, __HIP_MEMORY_SCOPE_AGENT); break; } }
    }
    __syncthreads();
    __builtin_amdgcn_fence(__ATOMIC_ACQUIRE, "agent");
    for (int r = b * SEQ + (unit & 31) * NWAVES + wave; r < (b + 1) * SEQ; r += 32 * NWAVES) hn_row(HRAW, SQ, QKVO, gh, HN, r, lane);
}

__device__ __forceinline__ void mlstm_sample(LAS unsigned char* lds, const bf16_t* QKVO, const float* GATES, const float* gh, const float* C0all, const float* n0all, const float* m0all, bf16_t* HN, float* out, int ib, int bh, int tid, int wave, int lane) {
    const int bs = bh >> 3, h = bh & 7;
    const size_t sb = (size_t)(ib * NBS + bs) * 8 + h;
    LAS float* qs = (LAS float*)lds;
    LAS float* ks = qs + 512;
    LAS float* ns = ks + 512;
    LAS float* Ss = ns + 128;
    LAS float* nq = Ss + 16;
    LAS float* red = nq + 16;
    const size_t r0 = (size_t)MP + bs * 4;
    __syncthreads();
    { const int t = tid >> 7, d = tid & 127; qs[tid] = bf1(QKVO[(r0 + t) * NIN + h * 128 + d]); ks[tid] = bf1(QKVO[(r0 + t) * NIN + 1024 + h * 128 + d]); if (tid < 128) ns[tid] = n0all[sb * 128 + tid]; }
    __syncthreads();
    if (wave == 0) {
        if (lane < 16) { const int t = lane >> 2, s = lane & 3; float a = 0.f; for (int d = 0; d < 128; ++d) a += qs[t * 128 + d] * ks[s * 128 + d]; Ss[lane] = a; }
        else if (lane < 20) { const int t = lane - 16; float a = 0.f; for (int d = 0; d < 128; ++d) a += ns[d] * qs[t * 128 + d]; nq[t] = a; }
    }
    __syncthreads();
    const float m0 = m0all[sb];
    float bc[4], av[4], Av[4];
    { float run = 0.f, pm = -INFINITY;
#pragma unroll
      for (int t = 0; t < 4; ++t) { const float ig = GATES[(r0 + t) * 16 + h], lf = GATES[(r0 + t) * 16 + 8 + h]; run += lf; bc[t] = run; av[t] = ig - run; pm = fmaxf(pm, av[t]); Av[t] = fmaxf(m0, pm); } }
    const float A3 = Av[3], wC = fexp(m0 - A3);
    float Pm[4][4], den[4];
#pragma unroll
    for (int t = 0; t < 4; ++t) { float rs = 0.f;
#pragma unroll
        for (int s = 0; s < 4; ++s) { Pm[t][s] = (s <= t) ? Ss[t * 4 + s] * fexp(av[s] - Av[t]) : 0.f; rs += Pm[t][s]; }
        den[t] = fexp(m0 - Av[t]) * nq[t] + rs; }
    const int e = tid >> 1, hf = tid & 1;
    const float* Crow = C0all + (sb * 256 + e) * 128 + 64 * hf;
    f32x4 Cv[16];
#pragma unroll
    for (int j = 0; j < 16; ++j) Cv[j] = *(const f32x4*)(Crow + 4 * j);
    float inter[4];
#pragma unroll
    for (int t = 0; t < 4; ++t) { float a = 0.f; const LAS float* q = qs + t * 128 + 64 * hf;
#pragma unroll
        for (int j = 0; j < 16; ++j) a += Cv[j].x * q[4 * j] + Cv[j].y * q[4 * j + 1] + Cv[j].z * q[4 * j + 2] + Cv[j].w * q[4 * j + 3];
        a += __shfl_xor(a, 1); inter[t] = a; }
    float vv[4];
#pragma unroll
    for (int s = 0; s < 4; ++s) vv[s] = bf1(QKVO[(r0 + s) * NIN + 2048 + h * 256 + e]);
    float hv[4];
#pragma unroll
    for (int t = 0; t < 4; ++t) { float nu = fexp(m0 - Av[t]) * inter[t];
#pragma unroll
        for (int s = 0; s < 4; ++s) nu += Pm[t][s] * vv[s];
        hv[t] = nu / fmaxf(fabsf(den[t]), fexp(-(bc[t] + Av[t])));
        float sq = (hf == 0) ? hv[t] * hv[t] : 0.f; sq = wave_sum(sq); if (lane == 0) red[t * 8 + wave] = sq; }
    __syncthreads();
    if (hf == 0) {
#pragma unroll
        for (int t = 0; t < 4; ++t) { float tot = 0.f;
#pragma unroll
            for (int w = 0; w < 8; ++w) tot += red[t * 8 + w];
            const float rs = rsqrtf(tot * (1.f / 256.f) + EPS);
            const float og = bf1(QKVO[(r0 + t) * NIN + 4096 + h * 256 + e]);
            HN[(r0 + t) * DM + h * 256 + e] = (bf16_t)f2bf(hv[t] * rs * gh[h * 256 + e] / (1.f + fexp(-og))); } }
    float wv[4];
#pragma unroll
    for (int s = 0; s < 4; ++s) wv[s] = fexp(av[s] - A3) * vv[s];
    float* Cout = out + O_CS + (sb * 256 + e) * 128 + 64 * hf;
#pragma unroll
    for (int j = 0; j < 16; ++j) { f32x4 o = Cv[j] * wC;
#pragma unroll
        for (int s = 0; s < 4; ++s) { const LAS float* k = ks + s * 128 + 64 * hf + 4 * j; o.x += wv[s] * k[0]; o.y += wv[s] * k[1]; o.z += wv[s] * k[2]; o.w += wv[s] * k[3]; }
        *(f32x4*)(Cout + 4 * j) = o; }
    if (tid < 128) { float o = wC * ns[tid];
#pragma unroll
        for (int s = 0; s < 4; ++s) o += fexp(av[s] - A3) * ks[s * 128 + tid];
        out[O_NS + sb * 128 + tid] = o; }
    if (tid == 0) out[O_MS + sb] = bc[3] + A3;
}

#ifndef CS_ASM
#define CS_ASM 1
#endif
__device__ __forceinline__ void cs_copy2_asm(const f32x4* s0, const f32x4* s1, f32x4* d0, f32x4* d1, int lane) {
    const f32x4 *pa = s0 + lane, *pb = s0 + lane + 256, *pc = s1 + lane, *pd = s1 + lane + 256;
    f32x4 *qa = d0 + lane, *qb = d0 + lane + 256, *qc = d1 + lane, *qd = d1 + lane + 256;
    f32x4 r0, r1, r2, r3, r4, r5, r6, r7, r8, r9, r10, r11, r12, r13, r14, r15;
    asm volatile("global_load_dwordx4 %0, %16, off sc0 sc1 nt\n\tglobal_load_dwordx4 %1, %16, off offset:1024 sc0 sc1 nt\n\tglobal_load_dwordx4 %2, %16, off offset:2048 sc0 sc1 nt\n\tglobal_load_dwordx4 %3, %16, off offset:3072 sc0 sc1 nt\n\t"
                 "global_load_dwordx4 %4, %17, off sc0 sc1 nt\n\tglobal_load_dwordx4 %5, %17, off offset:1024 sc0 sc1 nt\n\tglobal_load_dwordx4 %6, %17, off offset:2048 sc0 sc1 nt\n\tglobal_load_dwordx4 %7, %17, off offset:3072 sc0 sc1 nt\n\t"
                 "global_load_dwordx4 %8, %18, off sc0 sc1 nt\n\tglobal_load_dwordx4 %9, %18, off offset:1024 sc0 sc1 nt\n\tglobal_load_dwordx4 %10, %18, off offset:2048 sc0 sc1 nt\n\tglobal_load_dwordx4 %11, %18, off offset:3072 sc0 sc1 nt\n\t"
                 "global_load_dwordx4 %12, %19, off sc0 sc1 nt\n\tglobal_load_dwordx4 %13, %19, off offset:1024 sc0 sc1 nt\n\tglobal_load_dwordx4 %14, %19, off offset:2048 sc0 sc1 nt\n\tglobal_load_dwordx4 %15, %19, off offset:3072 sc0 sc1 nt\n\t"
                 "s_waitcnt vmcnt(0)"
                 : "=&v"(r0), "=&v"(r1), "=&v"(r2), "=&v"(r3), "=&v"(r4), "=&v"(r5), "=&v"(r6), "=&v"(r7), "=&v"(r8), "=&v"(r9), "=&v"(r10), "=&v"(r11), "=&v"(r12), "=&v"(r13), "=&v"(r14), "=&v"(r15)
                 : "v"(pa), "v"(pb), "v"(pc), "v"(pd) : "memory");
    asm volatile("global_store_dwordx4 %16, %0, off sc0 sc1 nt\n\tglobal_store_dwordx4 %16, %1, off offset:1024 sc0 sc1 nt\n\tglobal_store_dwordx4 %16, %2, off offset:2048 sc0 sc1 nt\n\tglobal_store_dwordx4 %16, %3, off offset:3072 sc0 sc1 nt\n\t"
                 "global_store_dwordx4 %17, %4, off sc0 sc1 nt\n\tglobal_store_dwordx4 %17, %5, off offset:1024 sc0 sc1 nt\n\tglobal_store_dwordx4 %17, %6, off offset:2048 sc0 sc1 nt\n\tglobal_store_dwordx4 %17, %7, off offset:3072 sc0 sc1 nt\n\t"
                 "global_store_dwordx4 %18, %8, off sc0 sc1 nt\n\tglobal_store_dwordx4 %18, %9, off offset:1024 sc0 sc1 nt\n\tglobal_store_dwordx4 %18, %10, off offset:2048 sc0 sc1 nt\n\tglobal_store_dwordx4 %18, %11, off offset:3072 sc0 sc1 nt\n\t"
                 "global_store_dwordx4 %19, %12, off sc0 sc1 nt\n\tglobal_store_dwordx4 %19, %13, off offset:1024 sc0 sc1 nt\n\tglobal_store_dwordx4 %19, %14, off offset:2048 sc0 sc1 nt\n\tglobal_store_dwordx4 %19, %15, off offset:3072 sc0 sc1 nt"
                 :: "v"(r0), "v"(r1), "v"(r2), "v"(r3), "v"(r4), "v"(r5), "v"(r6), "v"(r7), "v"(r8), "v"(r9), "v"(r10), "v"(r11), "v"(r12), "v"(r13), "v"(r14), "v"(r15), "v"(qa), "v"(qb), "v"(qc), "v"(qd) : "memory");
}
#ifndef CS_NT
#define CS_NT 0
#endif
__device__ __forceinline__ void cache_shift(const Params& P, float* outp, int lo, int hi, int w, int NW, int lane) {
    int t = lo + w;
    if (CS_ASM) {
        for (; t + NW < hi; t += 2 * NW) { const f32x4 *s0, *s1; f32x4 *d0, *d1; cs_addr(P, outp, t, s0, d0); cs_addr(P, outp, t + NW, s1, d1); cs_copy2_asm(s0, s1, d0, d1, lane); }
        if (t < hi) { const f32x4* s0; f32x4* d0; cs_addr(P, outp, t, s0, d0); cs_copy2_asm(s0, s0, d0, d0, lane); }
        return;
    }
    if (CS_DEPTH > 1) {
        for (; t + (CS_DEPTH - 1) * NW < hi; t += CS_DEPTH * NW) {
            const f32x4* sp[CS_DEPTH]; f32x4* dp[CS_DEPTH]; f32x4 a[CS_DEPTH][8];
#pragma unroll
            for (int d = 0; d < CS_DEPTH; ++d) cs_addr(P, outp, t + d * NW, sp[d], dp[d]);
#pragma unroll
            for (int d = 0; d < CS_DEPTH; ++d)
#pragma unroll
                for (int i = 0; i < 8; ++i) a[d][i] = CS_NT ? __builtin_nontemporal_load(sp[d] + lane + 64 * i) : sp[d][lane + 64 * i];
#pragma unroll
            for (int d = 0; d < CS_DEPTH; ++d)
#pragma unroll
                for (int i = 0; i < 8; ++i) { if (CS_NT) __builtin_nontemporal_store(a[d][i], dp[d] + lane + 64 * i); else dp[d][lane + 64 * i] = a[d][i]; }
        }
    }
    for (; t < hi; t += NW) {
        const f32x4* src; f32x4* dst; cs_addr(P, outp, t, src, dst);
#pragma unroll
        for (int i = 0; i < 8; ++i) { if (CS_NT) __builtin_nontemporal_store(__builtin_nontemporal_load(src + lane + 64 * i), dst + lane + 64 * i); else dst[lane + 64 * i] = src[lane + 64 * i]; }
    }
}

__device__ __forceinline__ void phase_convgate(const Params& P, float* outp, const bf16_t* U, bf16_t* Z, int layer, int gtid, int NGT) {
    constexpr int NCG = DFF / 8, NRUN = MP / 64 + NBS;
    const float* cw = P.in[20] + (size_t)layer * 3 * NUP; const float* cbias = P.in[21] + (size_t)layer * NUP;
    for (int task = gtid; task < NCG * NRUN; task += NGT) {
        const int cg = task % NCG, run = task / NCG, j0 = 8 * cg;
        const int ua0 = 256 * (j0 >> 7) + (j0 & 127), ub0 = ua0 + 128;
        float wa[3][8], wb[3][8], ba[8], bb[8];
#pragma unroll
        for (int k = 0; k < 3; ++k) { load8(cw + (size_t)k * NUP + j0, wa[k]); load8(cw + (size_t)k * NUP + DFF + j0, wb[k]); }
        load8(cbias + j0, ba); load8(cbias + DFF + j0, bb);
        float a2[8], a1[8], b2[8], b1[8];
        size_t row0; int nrows; float* cout;
        if (run < MP / 64) { const int b = run >> 5, s0 = (run & 31) * 64; row0 = (size_t)b * SEQ + s0; nrows = 64;
            cout = (s0 == SEQ - 64) ? outp + O_CONVP + ((size_t)(layer * NBP + b) * 2) * NUP : nullptr;
            if (s0 == 0) {
#pragma unroll
                for (int j = 0; j < 8; ++j) { a2[j] = 0.f; a1[j] = 0.f; b2[j] = 0.f; b1[j] = 0.f; } }
            else { unpack8(*(const u32x4*)(U + (row0 - 2) * NUP + ua0), a2); unpack8(*(const u32x4*)(U + (row0 - 1) * NUP + ua0), a1);
                   unpack8(*(const u32x4*)(U + (row0 - 2) * NUP + ub0), b2); unpack8(*(const u32x4*)(U + (row0 - 1) * NUP + ub0), b1); } }
        else { const int bs = run - MP / 64; row0 = (size_t)MP + bs * 4; nrows = 4;
            cout = outp + O_CONVS + ((size_t)(layer * NBS + bs) * 2) * NUP;
            const float* st = P.in[8] + ((size_t)(layer * NBS + bs) * 2) * NUP;
            load8(st + j0, a2); load8(st + NUP + j0, a1); load8(st + DFF + j0, b2); load8(st + NUP + DFF + j0, b1); }
        for (int t = 0; t < nrows; t += 4) {
            u32x4 ua[4], ub[4];
#pragma unroll
            for (int q = 0; q < 4; ++q) { ua[q] = *(const u32x4*)(U + (row0 + t + q) * NUP + ua0); ub[q] = *(const u32x4*)(U + (row0 + t + q) * NUP + ub0); }
#pragma unroll
            for (int q = 0; q < 4; ++q) {
                float a0[8], b0[8];
                unpack8(ua[q], a0); unpack8(ub[q], b0);
                float z[8];
#pragma unroll
                for (int j = 0; j < 8; ++j) { const float ca = ba[j] + wa[0][j] * a2[j] + wa[1][j] * a1[j] + wa[2][j] * a0[j]; const float cb = bb[j] + wb[0][j] * b2[j] + wb[1][j] * b1[j] + wb[2][j] * b0[j];
                    z[j] = ca / (1.f + fexp(-ca)) * cb; a2[j] = a1[j]; a1[j] = a0[j]; b2[j] = b1[j]; b1[j] = b0[j]; }
                u32x4 o; o.x = pk2(z[0], z[1]); o.y = pk2(z[2], z[3]); o.z = pk2(z[4], z[5]); o.w = pk2(z[6], z[7]);
                *(u32x4*)(Z + (row0 + t + q) * DFF + j0) = o;
            }
        }
        if (cout) { store8(cout + j0, a2); store8(cout + NUP + j0, a1); store8(cout + DFF + j0, b2); store8(cout + NUP + DFF + j0, b1); }
    }
}

#ifndef REP_STORE
#define REP_STORE 1
#endif
#ifndef REP_CONV
#define REP_CONV 1
#endif
#ifndef REP_ML
#define REP_ML 1
#endif
#ifndef REP_ATT
#define REP_ATT 1
#endif
#ifndef REP_RESID
#define REP_RESID 1
#endif
#ifndef REP_FIN
#define REP_FIN 1
#endif
#ifndef COMB_NR
#define COMB_NR 1
#endif
#ifndef HN2
#define HN2 0
#endif
#ifndef REP_SIDE
#define REP_SIDE 1
#endif
#ifndef MLX
#define MLX 3
#endif
#ifndef REP_CS
#define REP_CS 1
#endif
#ifndef REP_MR
#define REP_MR 1
#endif
#ifndef REP_UP
#define REP_UP 0
#endif
#ifndef REP_BAR
#define REP_BAR 1
#endif
#ifndef REP_TAIL
#define REP_TAIL 1
#endif
#ifndef REP_P0
#define REP_P0 1
#endif
#define REPEAT(n, body) do { body; if ((n) > 1) { body; } if ((n) > 2) { body; } } while (0)
__global__ void __launch_bounds__(NTHR, 2) fwd_kernel(Params P) {
    extern __shared__ __attribute__((aligned(16))) unsigned char lds_raw[];
    LAS unsigned char* lds = (LAS unsigned char*)lds_raw;
    const unsigned lds_base = (unsigned)(size_t)lds;
    const int tid0 = threadIdx.x;
    const int G0 = gridDim.x, bx0 = blockIdx.x;
#define PHASE_IDS int tid = tid0; asm volatile("" : "+v"(tid)); int zz_ = 0; asm volatile("" : "+v"(zz_)); zz_ = __builtin_amdgcn_readfirstlane(zz_); const int bx = bx0 + zz_, G = G0 + zz_; unsigned char* ws = P.ws + zz_; float* outp = P.out + zz_; \
    const int lane = tid & 63, wave = __builtin_amdgcn_readfirstlane(tid >> 6); const int gw = bx * NWAVES + wave, gtid = bx * NTHR + tid, NGW = G * NWAVES, NGT = G * NTHR; (void)gw; (void)gtid; (void)lane; (void)NGW; (void)NGT; (void)outp; \
    bf16_t* XB = (bf16_t*)(ws + WS_XB); float* SSQ = (float*)(ws + WS_SSQ); float* SSQS = (float*)(ws + WS_SSQS); bf16_t* QKV = (bf16_t*)(ws + WS_QKV); bf16_t* OG = (bf16_t*)(ws + WS_OG); float* LSE = (float*)(ws + WS_LSE); bf16_t* OC = (bf16_t*)(ws + WS_OC); \
    float* GATES = (float*)(ws + WS_GATES); bf16_t* U = (bf16_t*)(ws + WS_U); bf16_t* Z = (bf16_t*)(ws + WS_Z); (void)XB; (void)SSQ; (void)SSQS; (void)QKV; (void)OG; (void)LSE; (void)OC; (void)GATES; (void)U; (void)Z;
    volatile LAS unsigned* misc = (volatile LAS unsigned*)(lds + LDS_MISC_OFF);
    if (tid0 < 16) misc[tid0] = 0u;
    __syncthreads();
    { const XcdBarrier bar0 = xcd_barrier_post((unsigned*)(P.ws + WS_CTL) + 1024, misc + 8); if (tid0 == 0) misc[10] = bar0.x; }
    __syncthreads();
#define GRID_BAR() do { XcdBarrier bar_; bar_.bar = (unsigned*)(P.ws + WS_CTL) + 1024; bar_.x = (unsigned)__builtin_amdgcn_readfirstlane((int)misc[10]); bar_.st = misc + 8; xcd_barrier(bar_); if (REP_BAR > 1) xcd_barrier(bar_); } while (0)
#define GEMM_STORE(Abuf, Wt, NN, KK, Obuf, CSB) REPEAT(REP_STORE, GEMM_STORE1(Abuf, Wt, NN, KK, Obuf, CSB))
#define GEMM_STORE1(Abuf, Wt, NN, KK, Obuf, CSB) do { PHASE_IDS; \
        { pg8::Gemm g{Abuf, (const bf16_t*)(Wt), MP, NN, KK}; pg8::StaticOrder S; S.init(MP, NN, G, bx); const int pm0_ = pg8::first_pm(S); LAS float* rtab_ = (LAS float*)(lds + RING_BYTES); pg8::rstd_panel(rtab_, SSQ, pm0_, EPS, tid); pg8::EpiStoreN E{Obuf, NN, SSQ, EPS, rtab_, pm0_}; \
          pg8::gemm_phase<pg8::EpiStoreN, pg8::StaticOrder, true, true>(lds, g, S, E); } \
        REPEAT(REP_TAIL, skinny_phase<0>(lds, Abuf + (size_t)MP * KK, KK, (const bf16_t*)(Wt), NN, Obuf + (size_t)MP * NN, NN, nullptr, SSQS, nullptr, bx, G, (((MP / 256) * ((NN) / 256)) % G) ? G - (((MP / 256) * ((NN) / 256)) % G) : G, tid, wave, lane, P, (CSB))); } while (0)
#define GEMM_RESID(Abuf, Wt, KK, FIN) do { PHASE_IDS; \
        { pg8::Gemm g{Abuf, (const bf16_t*)(Wt), MP, DM, KK}; pg8::StaticOrder S; S.init(MP, DM, G, bx); pg8::EpiResidN E{XB, (FIN) ? outp : nullptr, (FIN) ? nullptr : SSQ, DM}; \
          pg8::gemm_phase<pg8::EpiResidN, pg8::StaticOrder, true, true>(lds, g, S, E); } \
        if (FIN) skinny_phase<2>(lds, Abuf + (size_t)MP * KK, KK, (const bf16_t*)(Wt), DM, nullptr, 0, XB + (size_t)MP * DM, nullptr, outp + (size_t)MP * DM, bx, G, G, tid, wave, lane, P, -1); \
        else skinny_phase<1>(lds, Abuf + (size_t)MP * KK, KK, (const bf16_t*)(Wt), DM, nullptr, 0, XB + (size_t)MP * DM, SSQS, nullptr, bx, G, G, tid, wave, lane, P, -1); } while (0)

    REPEAT(REP_P0, { PHASE_IDS; phase_prologue(P, lds, gw, NGW, wave, lane); });
    GRID_BAR();

#define FFN(L, FIN) do { \
        { PHASE_IDS; unsigned* ctl_ = (unsigned*)(ws + WS_CTL); \
          skinny_up(lds, P.in[8], P.in[20] + (size_t)(L) * 3 * NUP, P.in[21] + (size_t)(L) * NUP, XB, (const bf16_t*)(ws + WS_WUP + (L) * SZ_WUP), SSQ, SSQS, (float*)(ws + WS_HALO), ctl_ + CW_HCNT, Z, outp, (L), bx, G, 128, tid, wave, lane, P, 2 * CS_QKV + (L) * CS_UP); \
          if (bx >= G - 128) {   \
              if (UPT > 0 && (L) == 0) for (int v = (P0_C1) + (bx - (G - 128)) * NWAVES + wave; v < (P0_C1) + (UPT); v += 128 * NWAVES) p0_item(P, v, lane, true); \
              else if (UPT > 0 && (L) == 1) for (int v = (P0_C2) - (UPT) + (bx - (G - 128)) * NWAVES + wave; v < (P0_C2); v += 128 * NWAVES) p0_item(P, v, lane, true); \
              else if (UPCOPY > 0) cache_shift(P, outp, CS_UPC0 + ((L) - (4 - CS_NUP)) * (UPCOPY), CS_UPC0 + ((L) - (4 - CS_NUP) + 1) * (UPCOPY), (bx - (G - 128)) * NWAVES + wave, 128 * NWAVES, lane); } \
          { pg8::Gemm g{XB, (const bf16_t*)(ws + WS_WUP + (L) * SZ_WUP), MP, NUP, DM}; pg8::StaticOrder S; S.init(MP, NUP, G, bx); const int pm0_ = pg8::first_pm(S); \
            LAS float* rtab_ = (LAS float*)(lds + RING_BYTES); volatile LAS unsigned* rdy_ = (volatile LAS unsigned*)(lds + RING_BYTES + 1024 + 8192); if (tid == 0) rdy_[0] = 0u; pg8::rstd_panel(rtab_, SSQ, pm0_, EPS, tid); \
            pg8::EpiConv E{ws, P.in[20] + (size_t)(L) * 3 * NUP, P.in[21] + (size_t)(L) * NUP, lds + RING_BYTES, (unsigned)((L) + 1) * (unsigned)(SU_NITEMS * 4), pm0_}; \
            pg8::gemm_phase<pg8::EpiConv, pg8::StaticOrder, true, true>(lds, g, S, E); \
            if (REP_UP == 1) pg8::gemm_phase<pg8::EpiConv, pg8::StaticOrder, true, true>(lds, g, S, E); \
            if (REP_UP == 2) { pg8::EpiNull EN{(float*)(ws + WS_U)}; pg8::gemm_phase<pg8::EpiNull, pg8::StaticOrder, true, true>(lds, g, S, EN); } } } \
        GRID_BAR(); \
        GEMM_RESID(Z, ws + WS_WDOWN + (L) * SZ_WDOWN, DFF, FIN); \
    } while (0)

#define LAYER_PAIR(lp) do { \
        { \
            const int ia = (lp); \
            GEMM_STORE(XB, ws + WS_WQKV + ia * SZ_WQKV, NQKV, DM, QKV, ia * CS_QKV); \
            GRID_BAR(); \
            REPEAT(REP_ATT, { PHASE_IDS; attn_phase(P, lds, lds_base, QKV, (const float*)(ws + WS_ROPE), P.in[12] + ia * 128, P.in[13] + ia * 128, outp, ia, OG, LSE, bx, G, 1536, tid, wave, lane); } \
            { PHASE_IDS; for (int wt = bx + G * wave; wt < NBS * 96; wt += G * NWAVES) attn_sample_task(lds + wave * 4096, QKV, (const float*)(ws + WS_ROPE), P.in[12] + ia * 128, P.in[13] + ia * 128, outp, P.in[2], P.in[3], P.in[4], OG, LSE, ia, wt, lane); __syncthreads(); }); \
            GRID_BAR(); \
            REPEAT(REP_ATT, { PHASE_IDS; if (COMB_NR > 1) { for (int r = gw; r < MR; r += COMB_NR * NGW) combine_rows<COMB_NR>(OG, LSE, OC, r, NGW, MR, lane); } else { for (int r = gw; r < MR; r += NGW) combine_row(OG, LSE, OC, r, lane); } }); \
            GRID_BAR(); \
            GEMM_RESID(OC, ws + WS_WO + ia * SZ_WO, DO, false); \
            GRID_BAR(); \
            FFN(2 * (lp), false); \
            GRID_BAR(); \
        } \
        { \
            const int L = 2 * (lp) + 1, ib = (lp); \
            GEMM_STORE(XB, ws + WS_WIN + ib * SZ_WIN, NIN, DM, QKV, -1); \
            REPEAT(REP_TAIL, { PHASE_IDS; for (int task = G - 1 - bx; task < MP / 16; task += G) gate_block(lds, XB, (const f32x4*)(ws + WS_WGP) + (size_t)ib * 128 * 64, P.in[16] + ib * 16, GATES, task, wave, lane); \
              if (bx < MSAMP / 16) gate_block(lds, XB, (const f32x4*)(ws + WS_WGP) + (size_t)ib * 128 * 64, P.in[16] + ib * 16, GATES, MP / 16 + bx, wave, lane); });   \
            GRID_BAR(); \
            REPEAT(REP_ML, { PHASE_IDS; \
              \
            const int xq_ = (MLX ? (bx & 7) : (bx >> 5)); const int xi_ = (MLX ? (bx >> 3) : (bx & 31)); const int mu_ = (MLX == 3) ? xq_ * 16 + (xi_ >> 1) : (MLX == 2) ? xq_ * 16 + (xi_ & 15) : (xq_ & 3) * 32 + xi_; \
            if ((MLX == 3) ? ((xi_ & 1) == 0) : (MLX == 2) ? (xi_ < 16) : (xq_ < 4)) { mlstm_prompt(lds, lds_base, QKV, GATES, OG, (float*)(ws + WS_SQ), outp, ib, mu_, tid, wave, lane); if (REP_MR > 1) { __syncthreads(); mlstm_prompt(lds, lds_base, QKV, GATES, OG, (float*)(ws + WS_SQ), outp, ib, mu_, tid, wave, lane); } \
              if (HN_TAIL) hn_tail((unsigned*)(ws + WS_CTL), OG, (const float*)(ws + WS_SQ), QKV, P.in[17] + (size_t)ib * DM, OC, ib, mu_, tid, wave, lane); } \
            else { if (mu_ < 64) mlstm_sample(lds, QKV, GATES, P.in[17] + (size_t)ib * DM, P.in[5], P.in[6], P.in[7], OC, outp, ib, mu_, tid, wave, lane); \
                   for (int rs_ = 0; rs_ < REP_SIDE; ++rs_) { cache_shift(P, outp, (lp) == 0 ? CS_TAILS : (CS_SPLIT), (lp) == 0 ? (CS_SPLIT) : 2 * CS_PER_LAYER, mu_ * NWAVES + wave, 128 * NWAVES, lane); \
                   for (int v = ((lp) == 0 ? (P0_C1) + (UPT) : (P0_C2)) + mu_ * NWAVES + wave; v < ((lp) == 0 ? (P0_C2) - (UPT) : P0_TOTAL); v += 128 * NWAVES) p0_item(P, v, lane, true); } \
                   if (REP_CS > 1 && (lp) == 1) { __syncthreads(); cache_shift(P, outp, (CS_SPLIT), 2 * CS_PER_LAYER, mu_ * NWAVES + wave, 128 * NWAVES, lane); } \
                   if (REP_CS > 2 && (lp) == 0) { __syncthreads(); for (int v = (P0_C1) + mu_ * NWAVES + wave; v < (P0_C2); v += 128 * NWAVES) p0_item(P, v, lane, true); } } }); \
            GRID_BAR(); \
            if (!HN_TAIL) { REPEAT(REP_FIN, { PHASE_IDS; if (HN2) { for (int r = gw; r < MP; r += 2 * NGW) hn_rows2(OG, (const float*)(ws + WS_SQ), QKV, P.in[17] + (size_t)ib * DM, OC, r, NGW, lane); } else { for (int r = gw; r < MP; r += NGW) hn_row(OG, (const float*)(ws + WS_SQ), QKV, P.in[17] + (size_t)ib * DM, OC, r, lane); } }); GRID_BAR(); } \
            GEMM_RESID(OC, ws + WS_WOUT + ib * SZ_WOUT, DM, false); \
            GRID_BAR(); \
            FFN(L, (L == DEPTH - 1)); \
            if ((lp) == 0) GRID_BAR(); \
        } \
    } while (0)
    LAYER_PAIR(0);
    LAYER_PAIR(1);
}

extern "C" void kernel_launch(void* const* d_in, const int* in_sizes, int n_in, void* d_out, int out_size, void* d_ws, size_t ws_size, hipStream_t stream) {
    static int grid = 0;
    if (grid == 0) {
        if (n_in != 23 || (size_t)out_size != O_END || ws_size < WS_END) {
            fprintf(stderr, "kernel_launch: built for 23 inputs, %zu outputs, >= %zu bytes of workspace; got n_in %d, out %d, ws %zu; nothing launched\n", (size_t)O_END, (size_t)WS_END, n_in, out_size, ws_size);
            grid = -1; return; }
        int dev = 0, cus = 0, per_cu = 0;
        if (hipGetDevice(&dev) != hipSuccess || hipDeviceGetAttribute(&cus, hipDeviceAttributeMultiprocessorCount, dev) != hipSuccess) { fprintf(stderr, "kernel_launch: device query failed\n"); grid = -1; return; }
        if (hipFuncSetAttribute((const void*)fwd_kernel, hipFuncAttributeMaxDynamicSharedMemorySize, LDS_BYTES) != hipSuccess) { fprintf(stderr, "kernel_launch: hipFuncSetAttribute failed\n"); grid = -1; return; }
        if (hipOccupancyMaxActiveBlocksPerMultiprocessor(&per_cu, (const void*)fwd_kernel, NTHR, LDS_BYTES) != hipSuccess || per_cu < 1)
            fprintf(stderr, "kernel_launch: occupancy query reports %d workgroups per CU\n", per_cu);
        (void)hipGetLastError();
        grid = cus;
    }
    if (grid < 0) return;
    (void)hipMemsetAsync((char*)d_ws + WS_CTL, 0, CTL_ZERO_BYTES, stream);
    Params p{};
    for (int i = 0; i < 23; ++i) p.in[i] = (const float*)d_in[i];
    p.out = (float*)d_out; p.ws = (unsigned char*)d_ws;
    hipLaunchKernelGGL(fwd_kernel, dim3(grid), dim3(NTHR), LDS_BYTES, stream, p);
    const hipError_t le = hipPeekAtLastError();
    if (le != hipSuccess) fprintf(stderr, "kernel_launch: launch failed: %s\n", hipGetErrorName(le));
}
```

```cpp
#include <hip/hip_runtime.h>
#include <cstdio>
#include <cstdint>

#define LAS __attribute__((address_space(3)))
typedef unsigned short bf16_t;
typedef short bf16x8 __attribute__((ext_vector_type(8)));
typedef float f32x4 __attribute__((ext_vector_type(4)));
typedef float f32x2 __attribute__((ext_vector_type(2)));
typedef unsigned u32x4 __attribute__((ext_vector_type(4)));
typedef unsigned u32x2 __attribute__((ext_vector_type(2)));
typedef unsigned short u16x4 __attribute__((ext_vector_type(4)));

constexpr int DM = 2048, SEQ = 2048, NBP = 4, NBS = 8, TSAMP = 4, PAST = 16384;
constexpr int MP = NBP * SEQ, MSAMP = NBS * TSAMP, MR = MP + MSAMP, MT = 8448;
constexpr int NQKV = 9216, NIN = 6144, NIN_SRC = 6160, DFF = 5632, NUP = 2 * DFF, DO = 1024;
constexpr int DEPTH = 4;
constexpr float EPS = 1e-6f;
constexpr int NWAVES = 8, NTHR = 512;

constexpr size_t O_YP = 0;
constexpr size_t O_YS = O_YP + (size_t)MP * DM;
constexpr size_t O_KV128P = O_YS + (size_t)MSAMP * DM;
constexpr size_t O_KV128S = O_KV128P + (size_t)2 * NBP * 128 * 2048;
constexpr size_t O_KV512P = O_KV128S + (size_t)2 * NBS * 128 * 2048;
constexpr size_t O_KV512S = O_KV512P + (size_t)2 * NBP * 512 * 2048;
constexpr size_t O_KV2048P = O_KV512S + (size_t)2 * NBS * 512 * 2048;
constexpr size_t O_KV2048S = O_KV2048P + (size_t)2 * NBP * 2048 * 2048;
constexpr size_t O_CP = O_KV2048S + (size_t)2 * NBS * 2048 * 2048;
constexpr size_t O_CS = O_CP + (size_t)2 * NBP * 8 * 256 * 128;
constexpr size_t O_NP = O_CS + (size_t)2 * NBS * 8 * 256 * 128;
constexpr size_t O_NS = O_NP + (size_t)2 * NBP * 8 * 128;
constexpr size_t O_MP = O_NS + (size_t)2 * NBS * 8 * 128;
constexpr size_t O_MS = O_MP + (size_t)2 * NBP * 8;
constexpr size_t O_CONVP = O_MS + (size_t)2 * NBS * 8;
constexpr size_t O_CONVS = O_CONVP + (size_t)DEPTH * NBP * 2 * NUP;
constexpr size_t O_END = O_CONVS + (size_t)DEPTH * NBS * 2 * NUP;

constexpr size_t al1m(size_t x) { return (x + 1048575) & ~(size_t)1048575; }
constexpr size_t WS_CTL = 0, CTL_ZERO_BYTES = 1048576;
constexpr size_t SZ_WQKV = (size_t)NQKV * DM * 2, SZ_WO = (size_t)DM * DO * 2, SZ_WIN = (size_t)NIN * DM * 2, SZ_WOUT = (size_t)DM * DM * 2, SZ_WUP = (size_t)NUP * DM * 2, SZ_WDOWN = (size_t)DM * DFF * 2;
constexpr size_t WS_WQKV = al1m(WS_CTL + CTL_ZERO_BYTES);
constexpr size_t WS_WO = al1m(WS_WQKV + 2 * SZ_WQKV);
constexpr size_t WS_WIN = al1m(WS_WO + 2 * SZ_WO);
constexpr size_t WS_WOUT = al1m(WS_WIN + 2 * SZ_WIN);
constexpr size_t WS_WUP = al1m(WS_WOUT + 2 * SZ_WOUT);
constexpr size_t WS_WDOWN = al1m(WS_WUP + 4 * SZ_WUP);
constexpr size_t WS_X = al1m(WS_WDOWN + 4 * SZ_WDOWN);
constexpr size_t WS_XB = al1m(WS_X + (size_t)MT * DM * 4);
constexpr size_t WS_SSQ = al1m(WS_XB + (size_t)MT * DM * 2);
constexpr size_t WS_SSQS = al1m(WS_SSQ + (size_t)MP * 32 * 4);
constexpr size_t WS_QKV = al1m(WS_SSQS + (size_t)MSAMP * 128 * 4);
constexpr size_t WS_OG = al1m(WS_QKV + (size_t)MT * NQKV * 2);
constexpr size_t WS_LSE = al1m(WS_OG + (size_t)MT * 3072 * 2);
constexpr size_t WS_OC = al1m(WS_LSE + (size_t)MT * 24 * 4);
constexpr size_t WS_GATES = al1m(WS_OC + (size_t)MT * DM * 2);
constexpr size_t WS_U = al1m(WS_GATES + (size_t)MT * 16 * 4);
constexpr size_t WS_Z = al1m(WS_U + (size_t)MT * NUP * 2);
constexpr size_t WS_SQ = al1m(WS_Z + (size_t)MT * DFF * 2);
constexpr size_t WS_ROPE = al1m(WS_SQ + (size_t)MP * 128 * 4);
constexpr size_t WS_WGP = al1m(WS_ROPE + (size_t)2052 * 128 * 4);
constexpr size_t WS_HALO = al1m(WS_WGP + (size_t)2 * 128 * 64 * 16);
constexpr size_t WS_END = al1m(WS_HALO + (size_t)64 * NUP * 4);
constexpr int CW_HCNT = 65536, CW_TMO = 65600, CW_CSQ = 65664, CW_PRG = 66560;

constexpr int RING_BYTES = 131072;
constexpr int LDS_MISC_OFF = 150 * 1024;
constexpr int LDS_BYTES = 152 * 1024;

__device__ __forceinline__ unsigned pk2(float lo, float hi) { unsigned r; asm("v_cvt_pk_bf16_f32 %0, %1, %2" : "=v"(r) : "v"(lo), "v"(hi)); return r; }
__device__ __forceinline__ unsigned f2bf(float f) { return pk2(f, 0.f) & 0xffffu; }
__device__ __forceinline__ float bflo(unsigned w) { return __builtin_bit_cast(float, w << 16); }
__device__ __forceinline__ float bfhi(unsigned w) { return __builtin_bit_cast(float, w & 0xffff0000u); }
__device__ __forceinline__ float bf1(bf16_t b) { return __builtin_bit_cast(float, (unsigned)b << 16); }
__device__ __forceinline__ float fexp(float x) { return __builtin_amdgcn_exp2f(x * 1.4426950408889634f); }
template <int CTRL> __device__ __forceinline__ float dpp_mov(float src) { return __builtin_bit_cast(float, __builtin_amdgcn_mov_dpp(__builtin_bit_cast(int, src), CTRL, 0xf, 0xf, false)); }
__device__ __forceinline__ float row4_sum(float v) { v += dpp_mov<0xB1>(v); v += dpp_mov<0x4E>(v); return v; }
__device__ __forceinline__ float row8_sum(float v) { v = row4_sum(v); v += dpp_mov<0x141>(v); return v; }
__device__ __forceinline__ float row16_sum(float v) { v = row8_sum(v); v += dpp_mov<0x140>(v); return v; }
#define LDS_BARRIER() do { asm volatile("s_waitcnt lgkmcnt(0)" ::: "memory"); __builtin_amdgcn_s_barrier(); asm volatile("" ::: "memory"); } while (0)
__device__ __forceinline__ float wave_sum(float v) {
#pragma unroll
    for (int o = 1; o < 64; o <<= 1) v += __shfl_xor(v, o);
    return v;
}
__device__ __forceinline__ float wave_max(float v) {
#pragma unroll
    for (int o = 1; o < 64; o <<= 1) v = fmaxf(v, __shfl_xor(v, o));
    return v;
}
__device__ __forceinline__ f32x4 mma16(bf16x8 a, bf16x8 b, f32x4 c) { return __builtin_amdgcn_mfma_f32_16x16x32_bf16(a, b, c, 0, 0, 0); }
__device__ __forceinline__ bf16x8 tr_read2(unsigned base, int off0, int off1) {
    u16x4 r0, r1;
    asm volatile("ds_read_b64_tr_b16 %0, %2 offset:%c3\n\tds_read_b64_tr_b16 %1, %2 offset:%c4\n\ts_waitcnt lgkmcnt(0)" : "=&v"(r0), "=&v"(r1) : "v"(base), "i"(off0), "i"(off1) : "memory");
    bf16x8 o; o[0] = (short)r0[0]; o[1] = (short)r0[1]; o[2] = (short)r0[2]; o[3] = (short)r0[3]; o[4] = (short)r1[0]; o[5] = (short)r1[1]; o[6] = (short)r1[2]; o[7] = (short)r1[3];
    return o;
}

__device__ __forceinline__ bf16x8 tr_join(u16x4 r0, u16x4 r1) { bf16x8 o; o[0] = (short)r0[0]; o[1] = (short)r0[1]; o[2] = (short)r0[2]; o[3] = (short)r0[3]; o[4] = (short)r1[0]; o[5] = (short)r1[1]; o[6] = (short)r1[2]; o[7] = (short)r1[3]; return o; }
#define TR_RD "ds_read_b64_tr_b16 "
#define TR_READ4(F0, F1, F2, F3, base, a0, a1, b0, b1, c0, c1, d0, d1) do { u16x4 t0_, t1_, t2_, t3_, t4_, t5_, t6_, t7_; \
    asm volatile(TR_RD "%0, %8 offset:%c9\n\t" TR_RD "%1, %8 offset:%c10\n\t" TR_RD "%2, %8 offset:%c11\n\t" TR_RD "%3, %8 offset:%c12\n\t" TR_RD "%4, %8 offset:%c13\n\t" TR_RD "%5, %8 offset:%c14\n\t" TR_RD "%6, %8 offset:%c15\n\t" TR_RD "%7, %8 offset:%c16\n\ts_waitcnt lgkmcnt(0)" \
        : "=&v"(t0_), "=&v"(t1_), "=&v"(t2_), "=&v"(t3_), "=&v"(t4_), "=&v"(t5_), "=&v"(t6_), "=&v"(t7_) : "v"(base), "i"(a0), "i"(a1), "i"(b0), "i"(b1), "i"(c0), "i"(c1), "i"(d0), "i"(d1) : "memory"); \
    F0 = tr_join(t0_, t1_); F1 = tr_join(t2_, t3_); F2 = tr_join(t4_, t5_); F3 = tr_join(t6_, t7_); } while (0)
#define TR_READ5(F0, F1, F2, F3, F4, base, a0, a1, b0, b1, c0, c1, d0, d1, e0, e1) do { u16x4 t0_, t1_, t2_, t3_, t4_, t5_, t6_, t7_, t8_, t9_; \
    asm volatile(TR_RD "%0, %10 offset:%c11\n\t" TR_RD "%1, %10 offset:%c12\n\t" TR_RD "%2, %10 offset:%c13\n\t" TR_RD "%3, %10 offset:%c14\n\t" TR_RD "%4, %10 offset:%c15\n\t" TR_RD "%5, %10 offset:%c16\n\t" TR_RD "%6, %10 offset:%c17\n\t" TR_RD "%7, %10 offset:%c18\n\t" TR_RD "%8, %10 offset:%c19\n\t" TR_RD "%9, %10 offset:%c20\n\ts_waitcnt lgkmcnt(0)" \
        : "=&v"(t0_), "=&v"(t1_), "=&v"(t2_), "=&v"(t3_), "=&v"(t4_), "=&v"(t5_), "=&v"(t6_), "=&v"(t7_), "=&v"(t8_), "=&v"(t9_) : "v"(base), "i"(a0), "i"(a1), "i"(b0), "i"(b1), "i"(c0), "i"(c1), "i"(d0), "i"(d1), "i"(e0), "i"(e1) : "memory"); \
    F0 = tr_join(t0_, t1_); F1 = tr_join(t2_, t3_); F2 = tr_join(t4_, t5_); F3 = tr_join(t6_, t7_); F4 = tr_join(t8_, t9_); } while (0)
__device__ __forceinline__ bf16x8 pack8(f32x4 a, f32x4 b) {
    u32x4 w; w.x = pk2(a[0], a[1]); w.y = pk2(a[2], a[3]); w.z = pk2(b[0], b[1]); w.w = pk2(b[2], b[3]);
    return __builtin_bit_cast(bf16x8, w);
}

namespace pg8 {
#define PG8_LAS __attribute__((address_space(3)))
typedef unsigned short bf16_t;
typedef short bf16x8 __attribute__((ext_vector_type(8)));
typedef float f32x4 __attribute__((ext_vector_type(4)));
typedef unsigned u32x4 __attribute__((ext_vector_type(4)));
constexpr int BM = 256, BK = 64, HALF = 128, HTB = HALF * BK * 2  , STAGE_BYTES = 8 * HTB, NXCD = 8, WGM = 8;

__host__ __device__ __forceinline__ int lds_byte(int r, int c) { const int st = (r >> 4) * 2 + (c >> 5), rr = r & 15, cc = c & 31, ob = rr * 64 + cc * 2; return st * 1024 + (ob ^ (((ob >> 9) & 1) << 5)); }
__host__ __device__ __forceinline__ void stage_rc(int b, int& R, int& C) { const int st = b / 1024, sb = b % 1024, swz = sb ^ (((sb >> 9) & 1) << 5); R = (st >> 1) * 16 + swz / 64; C = (st & 1) * 32 + (swz % 64) / 2; }
__host__ __device__ __forceinline__ int perm32(int rho) { const int n = rho >> 4, i = rho & 15; return 8 * (i >> 2) + 4 * n + (i & 3); }

struct Unit { int pm, pn; };
struct Gemm { const bf16_t* A; const bf16_t* Bt; int M, N, K; };

struct StaticOrder {
    int nM, nN, nwg, G, c;
    __host__ __device__ void init(int M, int N, int G_, int c_) { nM = M / BM; nN = N / BM; nwg = nM * nN; G = G_; c = c_; }
    __host__ __device__ bool next(int i, Unit& u) const {
        const long L = (long)i * G + c; if (L >= nwg) return false;
        int wgid = (int)L; { const int q = nwg / NXCD, r = nwg % NXCD, xcd = wgid % NXCD, off = wgid / NXCD; wgid = (xcd < r ? xcd * (q + 1) : r * (q + 1) + (xcd - r) * q) + off; }
        const int nig = WGM * nN, gid = wgid / nig, fm = gid * WGM, gsz = (nM - fm) < WGM ? (nM - fm) : WGM;
        u.pm = fm + ((wgid % nig) % gsz); u.pn = (wgid % nig) / gsz; return true;
    }
    __device__ __forceinline__ void a_ready(const Unit&) const {}
    __device__ __forceinline__ void done(const Unit&) const {}
};
__device__ __forceinline__ unsigned cvt_pk_bf16(float lo, float hi) { unsigned r; asm volatile("v_cvt_pk_bf16_f32 %0, %1, %2" : "=v"(r) : "v"(lo), "v"(hi)); return r; }

struct EpiStore {
    static constexpr bool PERM = true, AFTER_DRAIN = false;
    bf16_t* O; int ldc;
    __device__ __forceinline__ void operator()(const f32x4 (&acc)[2][2][4][2], const Unit& u, int wr, int wc, int fr, int fq) const {
        const int row0 = u.pm * BM + wr * 64 + fr, col0 = u.pn * BM + wc * 32 + 8 * fq;
#pragma unroll
        for (int ai = 0; ai < 2; ++ai)
#pragma unroll
            for (int m = 0; m < 4; ++m) { bf16_t* rowp = O + (size_t)(row0 + ai * HALF + m * 16) * ldc + col0;
#pragma unroll
                for (int bj = 0; bj < 2; ++bj) { const f32x4 v0 = acc[ai][bj][m][0], v1 = acc[ai][bj][m][1];
                    u32x4 w; w.x = cvt_pk_bf16(v0[0], v0[1]); w.y = cvt_pk_bf16(v0[2], v0[3]); w.z = cvt_pk_bf16(v1[0], v1[1]); w.w = cvt_pk_bf16(v1[2], v1[3]);
                    *(u32x4*)(rowp + bj * HALF) = w; } }
    }
};
struct EpiResid {
    static constexpr bool PERM = false, AFTER_DRAIN = false;
    const float* xin; float* out; int ldc; int mrows;
    __device__ __forceinline__ void operator()(const f32x4 (&acc)[2][2][4][2], const Unit& u, int wr, int wc, int fr, int fq) const {
        const int row0 = u.pm * BM + wr * 64 + fr, col0 = u.pn * BM + wc * 32 + 4 * fq;
#pragma unroll
        for (int ai = 0; ai < 2; ++ai)
#pragma unroll
            for (int m = 0; m < 4; ++m) { const int r = row0 + ai * HALF + m * 16;
                if (r < mrows) { const size_t off = (size_t)r * ldc + col0;
#pragma unroll
                    for (int bj = 0; bj < 2; ++bj)
#pragma unroll
                        for (int n = 0; n < 2; ++n) { const f32x4 bs = *(const f32x4*)(xin + off + bj * HALF + n * 16); *(f32x4*)(out + off + bj * HALF + n * 16) = bs + acc[ai][bj][m][n]; } }
                asm volatile("" ::: "memory"); }
    }
};


struct EpiStoreN {
    static constexpr bool PERM = true, AFTER_DRAIN = false;
    bf16_t* O; int ldc; const float* ssq; float eps; const PG8_LAS float* rs_tab; int rs_pm;
    __device__ __forceinline__ void operator()(const f32x4 (&acc)[2][2][4][2], const Unit& u, int wr, int wc, int fr, int fq) const {
        const int row0 = u.pm * BM + wr * 64 + fr, col0 = u.pn * BM + wc * 32 + 8 * fq;
        const bool cached = (u.pm == rs_pm);
#pragma unroll
        for (int ai = 0; ai < 2; ++ai)
#pragma unroll
            for (int m = 0; m < 4; ++m) { const int r = row0 + ai * HALF + m * 16;
                float rs;
                if (cached) rs = rs_tab[wr * 64 + fr + ai * HALF + m * 16];
                else { const f32x4 p0 = *(const f32x4*)(ssq + (size_t)r * 32 + 8 * fq), p1 = *(const f32x4*)(ssq + (size_t)r * 32 + 8 * fq + 4);
                    float s = ((p0[0] + p0[1]) + (p0[2] + p0[3])) + ((p1[0] + p1[1]) + (p1[2] + p1[3]));
                    s += __shfl_xor(s, 16); s += __shfl_xor(s, 32);
                    rs = rsqrtf(s * (1.f / 2048.f) + eps); }
                bf16_t* rowp = O + (size_t)r * ldc + col0;
#pragma unroll
                for (int bj = 0; bj < 2; ++bj) { const f32x4 v0 = acc[ai][bj][m][0] * rs, v1 = acc[ai][bj][m][1] * rs;
                    u32x4 w; w.x = cvt_pk_bf16(v0[0], v0[1]); w.y = cvt_pk_bf16(v0[2], v0[3]); w.z = cvt_pk_bf16(v1[0], v1[1]); w.w = cvt_pk_bf16(v1[2], v1[3]);
                    *(u32x4*)(rowp + bj * HALF) = w; } }
    }
};
__device__ __forceinline__ int first_pm(const StaticOrder& S) { const int wg0 = S.c; const int q = S.nwg / NXCD, r = S.nwg % NXCD, xcd = wg0 % NXCD, off = wg0 / NXCD; const int wgid = (xcd < r ? xcd * (q + 1) : r * (q + 1) + (xcd - r) * q) + off;
    const int nig = WGM * S.nN, gid = wgid / nig, fm = gid * WGM, gsz = (S.nM - fm) < WGM ? (S.nM - fm) : WGM; return fm + ((wgid % nig) % gsz); }
__device__ __forceinline__ void rstd_panel(PG8_LAS float* tab, const float* ssq, int pm, float eps, int tid) {
    const int row = tid >> 1, hf = tid & 1; const float* q = ssq + (size_t)(pm * BM + row) * 32 + 16 * hf;
    const f32x4 a = *(const f32x4*)q, b = *(const f32x4*)(q + 4), c = *(const f32x4*)(q + 8), d = *(const f32x4*)(q + 12);
    float s = (((a[0] + a[1]) + (a[2] + a[3])) + ((b[0] + b[1]) + (b[2] + b[3]))) + (((c[0] + c[1]) + (c[2] + c[3])) + ((d[0] + d[1]) + (d[2] + d[3])));
    s += __shfl_xor(s, 1);
    if (hf == 0) tab[row] = rsqrtf(s * (1.f / 2048.f) + eps);
    __syncthreads();
}
struct EpiResidN {
    static constexpr bool PERM = true, AFTER_DRAIN = false;
    bf16_t* xb; float* fin; float* ssq; int ldc;
    __device__ __forceinline__ void operator()(const f32x4 (&acc)[2][2][4][2], const Unit& u, int wr, int wc, int fr, int fq) const {
        const int row0 = u.pm * BM + wr * 64 + fr, col0 = u.pn * BM + wc * 32 + 8 * fq;
#pragma unroll
        for (int ai = 0; ai < 2; ++ai)
#pragma unroll
            for (int m = 0; m < 4; ++m) { const int r = row0 + ai * HALF + m * 16; const size_t off = (size_t)r * ldc + col0; float sq = 0.f;
#pragma unroll
                for (int bj = 0; bj < 2; ++bj) { const u32x4 xw = *(const u32x4*)(xb + off + bj * HALF);
                    f32x4 v0 = acc[ai][bj][m][0], v1 = acc[ai][bj][m][1];
                    v0[0] += __builtin_bit_cast(float, xw.x << 16); v0[1] += __builtin_bit_cast(float, xw.x & 0xffff0000u); v0[2] += __builtin_bit_cast(float, xw.y << 16); v0[3] += __builtin_bit_cast(float, xw.y & 0xffff0000u);
                    v1[0] += __builtin_bit_cast(float, xw.z << 16); v1[1] += __builtin_bit_cast(float, xw.z & 0xffff0000u); v1[2] += __builtin_bit_cast(float, xw.w << 16); v1[3] += __builtin_bit_cast(float, xw.w & 0xffff0000u);
                    if (fin) { *(f32x4*)(fin + off + bj * HALF) = v0; *(f32x4*)(fin + off + bj * HALF + 4) = v1; }
                    else { u32x4 w; w.x = cvt_pk_bf16(v0[0], v0[1]); w.y = cvt_pk_bf16(v0[2], v0[3]); w.z = cvt_pk_bf16(v1[0], v1[1]); w.w = cvt_pk_bf16(v1[2], v1[3]); *(u32x4*)(xb + off + bj * HALF) = w; }
                    sq += ((v0[0] * v0[0] + v0[1] * v0[1]) + (v0[2] * v0[2] + v0[3] * v0[3])) + ((v1[0] * v1[0] + v1[1] * v1[1]) + (v1[2] * v1[2] + v1[3] * v1[3])); }
                if (ssq) { sq += __shfl_xor(sq, 16); sq += __shfl_xor(sq, 32); if (fq == 0) ssq[(size_t)r * 32 + u.pn * 4 + wc] = sq; }
                if (m == 3) asm volatile("" ::: "memory"); }
    }
};
template <int CTRL> __device__ __forceinline__ float dppf(float oldv, float src) {
    return __builtin_bit_cast(float, __builtin_amdgcn_update_dpp(__builtin_bit_cast(int, oldv), __builtin_bit_cast(int, src), CTRL, 0xf, 0xf, false)); }
template <int CTRL> __device__ __forceinline__ float dppr(float src) {
    return __builtin_bit_cast(float, __builtin_amdgcn_mov_dpp(__builtin_bit_cast(int, src), CTRL, 0xf, 0xf, false)); }
struct EpiConv {
    static constexpr bool PERM = true, AFTER_DRAIN = false;
    static constexpr size_t WS_Z_ = ::WS_Z, WS_SSQ_ = ::WS_SSQ, WS_HALO_ = ::WS_HALO; static constexpr int CW_HCNT_ = ::CW_HCNT, CW_TMO_ = ::CW_TMO;
    unsigned char* wsb; const float* cw; const float* cb; PG8_LAS unsigned char* ldsx; unsigned target; int rs_pm;
    __device__ __forceinline__ void operator()(f32x4 (&acc)[2][2][4][2], const Unit& u, int wr, int wc, int fr_in, int fq_in) const {
        int fr = fr_in, fq = fq_in; asm volatile("" : "+v"(fr), "+v"(fq));
        bf16_t* Z = (bf16_t*)(wsb + WS_Z_); const float* ssq = (const float*)(wsb + WS_SSQ_); const float* halo = (const float*)(wsb + WS_HALO_); const float eps = 1e-6f;
        unsigned* hcnt = (unsigned*)wsb + CW_HCNT_; unsigned* tmo = (unsigned*)wsb + CW_TMO_;
        const PG8_LAS float* rs_tab = (const PG8_LAS float*)ldsx; PG8_LAS f32x4* xch = (PG8_LAS f32x4*)(ldsx + 1024); volatile PG8_LAS unsigned* ready = (volatile PG8_LAS unsigned*)(ldsx + 1024 + 8192);
        const int row0 = u.pm * BM + wr * 64 + fr;
        const bool cached = (u.pm == rs_pm);
#pragma unroll
        for (int ai = 0; ai < 2; ++ai)
#pragma unroll
            for (int m = 0; m < 4; ++m) { const int r = row0 + ai * HALF + m * 16; float rs;
                if (cached) rs = rs_tab[wr * 64 + fr + ai * HALF + m * 16];
                else { const f32x4 p0 = *(const f32x4*)(ssq + (size_t)r * 32 + 8 * fq), p1 = *(const f32x4*)(ssq + (size_t)r * 32 + 8 * fq + 4);
                    float s = ((p0[0] + p0[1]) + (p0[2] + p0[3])) + ((p1[0] + p1[1]) + (p1[2] + p1[3]));
                    s += __shfl_xor(s, 16); s += __shfl_xor(s, 32); rs = rsqrtf(s * (1.f / 2048.f) + eps); }
#pragma unroll
                for (int bj = 0; bj < 2; ++bj) { acc[ai][bj][m][0] *= rs; acc[ai][bj][m][1] *= rs; } }
        f32x4 hal[2][2];
#pragma unroll
        for (int bj = 0; bj < 2; ++bj) { hal[bj][0] = (f32x4){0.f, 0.f, 0.f, 0.f}; hal[bj][1] = (f32x4){0.f, 0.f, 0.f, 0.f}; }
        if (wr == 0 && (u.pm & 7) != 0) {
            if (ready[0] == 0u) { unsigned spins = 0;
                while (__hip_atomic_load(hcnt, __ATOMIC_RELAXED, __HIP_MEMORY_SCOPE_AGENT) < target) { __builtin_amdgcn_s_sleep(2);
                    if (++spins > (1u << 20)) { __hip_atomic_store(tmo, 1u, __ATOMIC_RELAXED, __HIP_MEMORY_SCOPE_AGENT); break; } }
                ready[0] = 1u; }
            if (fr >= 14) { const unsigned long long* hp = (const unsigned long long*)(halo + (size_t)(2 * (u.pm - 1) + (fr - 14)) * 11264 + u.pn * 256 + wc * 32 + 8 * fq);
#pragma unroll
                for (int bj = 0; bj < 2; ++bj)
#pragma unroll
                    for (int n = 0; n < 2; ++n) { const unsigned long long lo = __hip_atomic_load(hp + bj * 64 + 2 * n, __ATOMIC_RELAXED, __HIP_MEMORY_SCOPE_AGENT), hi = __hip_atomic_load(hp + bj * 64 + 2 * n + 1, __ATOMIC_RELAXED, __HIP_MEMORY_SCOPE_AGENT);
                        hal[bj][n] = (f32x4){__builtin_bit_cast(float, (unsigned)lo), __builtin_bit_cast(float, (unsigned)(lo >> 32)), __builtin_bit_cast(float, (unsigned)hi), __builtin_bit_cast(float, (unsigned)(hi >> 32))}; } } }
        if (fr >= 14) {
#pragma unroll
            for (int ai = 0; ai < 2; ++ai)
#pragma unroll
                for (int bj = 0; bj < 2; ++bj)
#pragma unroll
                    for (int n = 0; n < 2; ++n) xch[(((((ai * 2 + wr) * 4 + wc) * 2 + (fr & 1)) * 4 + fq) * 4) + bj * 2 + n] = acc[ai][bj][3][n]; }
        asm volatile("s_waitcnt lgkmcnt(0)" ::: "memory"); __builtin_amdgcn_s_barrier(); asm volatile("" ::: "memory");
        const int jn0 = u.pn * 128 + wc * 32 + 8 * fq;
        u32x2 zk[2][4];
#pragma unroll
        for (int n = 0; n < 2; ++n) {
            const float* wp = cw + jn0 + 4 * n; const float* bp = cb + jn0 + 4 * n;
            const f32x4 wa0 = *(const f32x4*)wp, wa1 = *(const f32x4*)(wp + 11264), wa2 = *(const f32x4*)(wp + 2 * 11264), ba = *(const f32x4*)bp;
            const f32x4 wb0 = *(const f32x4*)(wp + 5632), wb1 = *(const f32x4*)(wp + 11264 + 5632), wb2 = *(const f32x4*)(wp + 2 * 11264 + 5632), bb = *(const f32x4*)(bp + 5632);
#pragma unroll
            for (int ai = 0; ai < 2; ++ai) {
                f32x4 pa, pb;
                if (ai == 0 && wr == 0) { pa = hal[0][n]; pb = hal[1][n]; }
                else { const int sai = wr ? ai : ai - 1, swr = wr ^ 1; const int xi = (((((sai * 2 + swr) * 4 + wc) * 2 + (fr & 1)) * 4 + fq) * 4) + n; pa = xch[xi]; pb = xch[xi + 2]; }
#pragma unroll
                for (int m = 0; m < 4; ++m) {
                    const f32x4 ca4 = acc[ai][0][m][n], cb4 = acc[ai][1][m][n]; float z[4];
#pragma unroll
                    for (int i = 0; i < 4; ++i) {
                        const float a1 = dppf<0x111>(dppr<0x121>(pa[i]), ca4[i]), a2 = dppf<0x112>(dppr<0x122>(pa[i]), ca4[i]);
                        const float b1 = dppf<0x111>(dppr<0x121>(pb[i]), cb4[i]), b2 = dppf<0x112>(dppr<0x122>(pb[i]), cb4[i]);
                        const float ca = ba[i] + wa0[i] * a2 + wa1[i] * a1 + wa2[i] * ca4[i];
                        const float cbv = bb[i] + wb0[i] * b2 + wb1[i] * b1 + wb2[i] * cb4[i];
                        z[i] = ca * __builtin_amdgcn_rcpf(1.f + __builtin_amdgcn_exp2f(ca * -1.4426950408889634f)) * cbv; }
                    u32x2 w; w.x = cvt_pk_bf16(z[0], z[1]); w.y = cvt_pk_bf16(z[2], z[3]);
                    if (n == 0) zk[ai][m] = w;
                    else { u32x4 w4; w4.x = zk[ai][m].x; w4.y = zk[ai][m].y; w4.z = w.x; w4.w = w.y; *(u32x4*)(Z + (size_t)(row0 + ai * HALF + m * 16) * 5632 + jn0) = w4; }
                    pa = ca4; pb = cb4; }
            }
        }
    }
};

struct EpiNull {
    static constexpr bool PERM = true, AFTER_DRAIN = false;
    float* sink;
    __device__ __forceinline__ void operator()(const f32x4 (&acc)[2][2][4][2], const Unit& u, int wr, int wc, int fr, int fq) const {
        f32x4 s = {0.f, 0.f, 0.f, 0.f};
#pragma unroll
        for (int a = 0; a < 2; ++a)
#pragma unroll
            for (int b = 0; b < 2; ++b)
#pragma unroll
                for (int m = 0; m < 4; ++m) { s += acc[a][b][m][0]; s += acc[a][b][m][1]; }
        const float t = (s[0] + s[1]) + (s[2] + s[3]);
        if (t == 1.2345678e33f) sink[fr] = t;
    }
};
template <class Epi, class Sched, bool ALIGN_EPI = false, bool SP2 = false>
__device__ __forceinline__ void gemm_phase(PG8_LAS unsigned char* lds, const Gemm g, const Sched& S, const Epi& E) {
    int tid = threadIdx.x; asm volatile("" : "+v"(tid));
    const int wid = __builtin_amdgcn_readfirstlane(tid >> 6), lane = tid & 63, wr = wid >> 2, wc = wid & 3, fr = lane & 15, fq = lane >> 4;
    const int K = g.K, nt = K / BK;
    unsigned voffA[2], voffB[2];
#pragma unroll
    for (int i = 0; i < 2; ++i) { int R, C; stage_rc(tid * 16 + i * 8192, R, C); const int Rb = Epi::PERM ? ((R & ~31) + perm32(R & 31)) : R;
        voffA[i] = (unsigned)(R * K + C) * 2u; voffB[i] = (unsigned)(Rb * K + C) * 2u; }
    const size_t kstep = (size_t)(BK * 2);
    const size_t hstep = (size_t)HALF * K * 2;
    const size_t tstep = 2 * hstep;
    const unsigned ldsw = (unsigned)wid * 1024u;
    const int aoff = lds_byte(wr * 64 + fr, fq * 8), boff = lds_byte(wc * 32 + fr, fq * 8);
#define PG8_SA(b, h) (((b) * 2 + (h)) * HTB)
#define PG8_SB(b, h) ((4 + (b) * 2 + (h)) * HTB)
#define PG8_STAGE(bufoff, gbase, voff) do { _Pragma("unroll") for (int _i = 0; _i < 2; ++_i) \
        __builtin_amdgcn_global_load_lds((const unsigned*)((const char*)(gbase) + (voff)[_i]), (PG8_LAS unsigned*)(lds + (bufoff) + ldsw + _i * 8192), 16, 0, 0); } while (0)
#define PG8_LDA(dst, b, h) do { _Pragma("unroll") for (int m = 0; m < 4; ++m) _Pragma("unroll") for (int k = 0; k < 2; ++k) dst[m][k] = *(const PG8_LAS bf16x8*)(lds + PG8_SA(b, h) + aoff + m * 2048 + k * 1024); } while (0)
#define PG8_LDB(dst, b, h) do { _Pragma("unroll") for (int n = 0; n < 2; ++n) _Pragma("unroll") for (int k = 0; k < 2; ++k) dst[n][k] = *(const PG8_LAS bf16x8*)(lds + PG8_SB(b, h) + boff + n * 2048 + k * 1024); } while (0)
#define PG8_MMA(ai, bj, At, Bt) do { __builtin_amdgcn_s_setprio(1); _Pragma("unroll") for (int m = 0; m < 4; ++m) _Pragma("unroll") for (int n = 0; n < 2; ++n) _Pragma("unroll") for (int k = 0; k < 2; ++k) \
        acc[ai][bj][m][n] = __builtin_amdgcn_mfma_f32_16x16x32_bf16(Bt[n][k], At[m][k], acc[ai][bj][m][n], 0, 0, 0); __builtin_amdgcn_s_setprio(0); } while (0)
#define PG8_WAIT_V(n) asm volatile("s_waitcnt vmcnt(" #n ")" ::: "memory")
#define PG8_WAIT_L(n) asm volatile("s_waitcnt lgkmcnt(" #n ")" ::: "memory")
#define PG8_BAR __builtin_amdgcn_s_barrier()
#define PG8_SCHED __builtin_amdgcn_sched_barrier(0)
    Unit cur, nxt; int ui = 0;
    if (!S.next(0, cur)) return;
    f32x4 acc[2][2][4][2];
#pragma unroll
    for (int a = 0; a < 2; ++a)
#pragma unroll
        for (int b = 0; b < 2; ++b)
#pragma unroll
            for (int m = 0; m < 4; ++m)
#pragma unroll
                for (int n = 0; n < 2; ++n) acc[a][b][m][n] = (f32x4){0.f, 0.f, 0.f, 0.f};
    bf16x8 At[4][2], B0[2][2], B1[2][2];
    const char* cA = (const char*)g.A + (size_t)cur.pm * tstep; const char* cB = (const char*)g.Bt + (size_t)cur.pn * tstep;
    S.a_ready(cur);
    if constexpr (SP2) {
        PG8_STAGE(PG8_SB(0, 0), cB, voffB); PG8_STAGE(PG8_SB(0, 1), cB + hstep, voffB); PG8_STAGE(PG8_SA(0, 0), cA, voffA); PG8_STAGE(PG8_SA(0, 1), cA + hstep, voffA);
        if (wr == 1) PG8_BAR;
        PG8_WAIT_V(2); PG8_BAR;
        PG8_STAGE(PG8_SB(1, 0), cB + kstep, voffB); PG8_STAGE(PG8_SA(1, 0), cA + kstep, voffA); PG8_STAGE(PG8_SB(1, 1), cB + hstep + kstep, voffB);
        PG8_WAIT_V(6); PG8_BAR;
    } else {
        PG8_STAGE(PG8_SB(0, 0), cB, voffB); PG8_STAGE(PG8_SA(0, 0), cA, voffA); PG8_STAGE(PG8_SB(0, 1), cB + hstep, voffB); PG8_STAGE(PG8_SA(0, 1), cA + hstep, voffA);
        if (wr == 1) PG8_BAR;
        PG8_WAIT_V(4); PG8_BAR;
        PG8_STAGE(PG8_SB(1, 0), cB + kstep, voffB); PG8_STAGE(PG8_SA(1, 0), cA + kstep, voffA); PG8_STAGE(PG8_SB(1, 1), cB + hstep + kstep, voffB);
        PG8_WAIT_V(6); PG8_BAR;
    }
    for (;;) {
        const bool has_next = S.next(ui + 1, nxt);
        const char* nA = has_next ? (const char*)g.A + (size_t)nxt.pm * tstep : cA; const char* nB = has_next ? (const char*)g.Bt + (size_t)nxt.pn * tstep : cB;
        for (int t = 0; t < nt; t += 2) {
            const bool last = (t == nt - 2);
            const char* a1 = cA + (size_t)(t + 1) * kstep;
            const char* a2 = last ? nA : cA + (size_t)(t + 2) * kstep; const char* b2 = last ? nB : cB + (size_t)(t + 2) * kstep;
            const char* a3 = a2 + kstep; const char* b3 = b2 + kstep;
            if (last && has_next) S.a_ready(nxt);
            if constexpr (SP2) {
            PG8_LDB(B0, 0, 0); PG8_LDB(B1, 0, 1); PG8_SCHED; PG8_LDA(At, 0, 0); PG8_STAGE(PG8_SA(1, 1), a1 + hstep, voffA);
            PG8_WAIT_V(8); PG8_WAIT_L(0); PG8_BAR; PG8_MMA(0, 0, At, B0); PG8_MMA(0, 1, At, B1); PG8_BAR; PG8_SCHED;
            PG8_LDA(At, 0, 1); PG8_STAGE(PG8_SB(0, 0), b2, voffB); PG8_STAGE(PG8_SB(0, 1), b2 + hstep, voffB); PG8_STAGE(PG8_SA(0, 0), a2, voffA);
            PG8_WAIT_V(8); PG8_WAIT_L(0); PG8_BAR; PG8_MMA(1, 0, At, B0); PG8_MMA(1, 1, At, B1); PG8_BAR; PG8_SCHED;
            PG8_LDB(B0, 1, 0); PG8_LDB(B1, 1, 1); PG8_SCHED; PG8_LDA(At, 1, 0); PG8_STAGE(PG8_SA(0, 1), a2 + hstep, voffA);
            PG8_WAIT_V(8); PG8_WAIT_L(0); PG8_BAR; PG8_MMA(0, 0, At, B0); PG8_MMA(0, 1, At, B1); PG8_BAR; PG8_SCHED;
            PG8_LDA(At, 1, 1); PG8_STAGE(PG8_SB(1, 0), b3, voffB); PG8_STAGE(PG8_SB(1, 1), b3 + hstep, voffB); PG8_STAGE(PG8_SA(1, 0), a3, voffA);
            PG8_WAIT_V(8); PG8_WAIT_L(0); PG8_BAR; PG8_MMA(1, 0, At, B0); PG8_MMA(1, 1, At, B1); PG8_BAR; PG8_SCHED;
            } else {
            PG8_LDB(B0, 0, 0); PG8_SCHED; PG8_LDA(At, 0, 0); PG8_STAGE(PG8_SA(1, 1), a1 + hstep, voffA);
            PG8_WAIT_L(8); PG8_BAR; PG8_WAIT_L(0); PG8_MMA(0, 0, At, B0); PG8_BAR; PG8_SCHED;
            PG8_LDB(B1, 0, 1); PG8_STAGE(PG8_SB(0, 0), b2, voffB);
            PG8_BAR; PG8_WAIT_L(0); PG8_MMA(0, 1, At, B1); PG8_BAR;
            PG8_LDA(At, 0, 1); PG8_STAGE(PG8_SA(0, 0), a2, voffA);
            PG8_BAR; PG8_WAIT_L(0); PG8_MMA(1, 0, At, B0); PG8_BAR; PG8_SCHED;
            PG8_STAGE(PG8_SB(0, 1), b2 + hstep, voffB);
            PG8_WAIT_V(6); PG8_BAR; PG8_MMA(1, 1, At, B1); PG8_BAR;
            PG8_LDB(B0, 1, 0); PG8_SCHED; PG8_LDA(At, 1, 0); PG8_STAGE(PG8_SA(0, 1), a2 + hstep, voffA);
            PG8_WAIT_L(8); PG8_BAR; PG8_WAIT_L(0); PG8_MMA(0, 0, At, B0); PG8_BAR; PG8_SCHED;
            PG8_LDB(B1, 1, 1); PG8_STAGE(PG8_SB(1, 0), b3, voffB);
            PG8_BAR; PG8_WAIT_L(0); PG8_MMA(0, 1, At, B1); PG8_BAR;
            PG8_LDA(At, 1, 1); PG8_STAGE(PG8_SA(1, 0), a3, voffA);
            PG8_BAR; PG8_WAIT_L(0); PG8_MMA(1, 0, At, B0); PG8_BAR; PG8_SCHED;
            PG8_STAGE(PG8_SB(1, 1), b3 + hstep, voffB);
            PG8_WAIT_V(6); PG8_BAR; PG8_MMA(1, 1, At, B1); PG8_BAR;
            }
        }
        if constexpr (ALIGN_EPI) { if (wr == 0) PG8_BAR; }
        if constexpr (!Epi::AFTER_DRAIN) { E(acc, cur, wr, wc, fr, fq); S.done(cur); }
        if (!has_next) break;
#pragma unroll
        for (int a = 0; a < 2; ++a)
#pragma unroll
            for (int b = 0; b < 2; ++b)
#pragma unroll
                for (int m = 0; m < 4; ++m)
#pragma unroll
                    for (int n = 0; n < 2; ++n) acc[a][b][m][n] = (f32x4){0.f, 0.f, 0.f, 0.f};
        cur = nxt; cA = nA; cB = nB; ++ui;
        if constexpr (ALIGN_EPI) { if (wr == 1) PG8_BAR; }
    }
    PG8_WAIT_V(0);
    if constexpr (!ALIGN_EPI) { if (wr == 0) PG8_BAR; }
    PG8_BAR;
    if constexpr (Epi::AFTER_DRAIN) { E.fused(acc, cur, wr, wc, fr, fq, lds, wid, lane); S.done(cur); }
#undef PG8_SA
#undef PG8_SB
#undef PG8_STAGE
#undef PG8_LDA
#undef PG8_LDB
#undef PG8_MMA
#undef PG8_WAIT_V
#undef PG8_WAIT_L
#undef PG8_BAR
#undef PG8_SCHED
}
}
#define XB_TMO      128
#define XB_XCNT(j)  (256  + 64 * (j))
#define XB_XSUB(j)  (1280 + 64 * (j))
#define XB_XGEN(j)  (2304 + 64 * (j))
#define XB_TOP      3328
#define XB_TOPGEN   3392
#define XCD_BAR_WORDS 3456
#define XB_SPIN_CAP (1u << 18)

__device__ __forceinline__ unsigned xb_ld(unsigned* p)              { return __hip_atomic_load(p, __ATOMIC_RELAXED, __HIP_MEMORY_SCOPE_AGENT); }
__device__ __forceinline__ unsigned xb_add(unsigned* p, unsigned v) { return __hip_atomic_fetch_add(p, v, __ATOMIC_RELAXED, __HIP_MEMORY_SCOPE_AGENT); }
__device__ __forceinline__ unsigned xb_xcc_id() { return (unsigned)__builtin_amdgcn_s_getreg((3 << 11) | 20) & 0xFu; }
#define XB_SPIN(cond, bar) do { unsigned _sp = 0; while (cond) { __builtin_amdgcn_s_sleep(1); \
    if ((++_sp & 255u) == 0u) { if (xb_ld(&(bar)[XB_TMO])) break; if (_sp > XB_SPIN_CAP) { atomicAdd(&(bar)[XB_TMO], 1u); break; } } } } while (0)

struct XcdBarrier {
    unsigned* bar; unsigned x;
    volatile LAS unsigned* st;
};

__device__ __forceinline__ XcdBarrier xcd_barrier_post(unsigned* bar, volatile LAS unsigned* st) {
    XcdBarrier b; b.bar = bar; b.x = xb_xcc_id(); b.st = st;
    if (threadIdx.x == 0) (void)xb_add(&bar[XB_XCNT(b.x)], 1u);
    return b;
}
__device__ __forceinline__ void xcd_barrier_complete(unsigned* bar, unsigned x, unsigned& nloc, unsigned& nx) {
    const unsigned G = gridDim.x * gridDim.y * gridDim.z;
    unsigned sum, cnt, mine, sp = 0u;
    for (;;) {
        sum = 0u; cnt = 0u; mine = 0u;
#pragma unroll
        for (unsigned j = 0; j < 16; ++j) { const unsigned c = xb_ld(&bar[XB_XCNT(j)]); sum += c; cnt += (c > 0u) ? 1u : 0u; mine = (j == x) ? c : mine; }
        if (sum == G) break;
        __builtin_amdgcn_s_sleep(1);
        if ((++sp & 255u) == 0u) { if (xb_ld(&bar[XB_TMO])) break; if (sp > XB_SPIN_CAP) { atomicAdd(&bar[XB_TMO], 1u); break; } }
    }
    nloc = mine > 0u ? mine : 1u; nx = cnt > 0u ? cnt : 1u;
}

__device__ __forceinline__ void xcd_barrier(const XcdBarrier& b) {
    asm volatile("s_waitcnt vmcnt(0)" ::: "memory");
    __syncthreads();
    if (threadIdx.x == 0) {
        unsigned* bar = b.bar;
        __builtin_amdgcn_s_waitcnt(0);
        unsigned nloc = b.st[0], nx = b.st[1];
        if (nloc == 0u) { xcd_barrier_complete(bar, b.x, nloc, nx); b.st[0] = nloc; b.st[1] = nx; }
        const unsigned old = xb_add(&bar[XB_XSUB(b.x)], 1u);
        const unsigned gen = old / nloc;
        if (old + 1u == (gen + 1u) * nloc) {
            __builtin_amdgcn_fence(__ATOMIC_RELEASE, "agent");
            asm volatile("s_waitcnt vmcnt(0)" ::: "memory");
            const unsigned og = xb_add(&bar[XB_TOP], 1u);
            const unsigned tg = og / nx;
            if (og + 1u == (tg + 1u) * nx) xb_add(&bar[XB_TOPGEN], 1u);
            else XB_SPIN(xb_ld(&bar[XB_TOPGEN]) == tg, bar);
            __builtin_amdgcn_fence(__ATOMIC_ACQUIRE, "agent");
            xb_add(&bar[XB_XGEN(b.x)], 1u);
            asm volatile("s_waitcnt vmcnt(0)" ::: "memory");
        } else {
            XB_SPIN(xb_ld(&bar[XB_XGEN(b.x)]) == gen, bar);
            __builtin_amdgcn_fence(__ATOMIC_ACQUIRE, "agent");
            asm volatile("s_waitcnt vmcnt(0)" ::: "memory");
        }
    }
    __syncthreads();
}

struct Params { const float* in[23]; float* out; unsigned char* ws; };

__device__ __forceinline__ void p0_transpose_item(const float* W, int ldw, int K, int N, bf16_t* WT, int item, int lane, float scale, const float* gk, bool pair_perm = false, bool deep = false) {
    const int nblk = N / 64, kb = item / nblk, nb = item % nblk, i16 = lane & 15, q4 = lane >> 4;
    const int n0 = 64 * nb + 4 * i16;
    const int ns0 = (pair_perm ? ((nb >> 1) & 1) * DFF + 128 * (nb >> 2) + 64 * (nb & 1) : 64 * nb) + 4 * i16;
#ifndef P0_NTST
#define P0_NTST 0
#endif
#ifndef P0_DEEP
#define P0_DEEP 1
#endif
#ifndef P0_ASM
#define P0_ASM 1
#endif
    if (P0_ASM && deep) {
        const int kk0 = 64 * kb + 8 * q4;
        const float* src = W + (size_t)kk0 * ldw + ns0;
        const float* ra[16];
#pragma unroll
        for (int i = 0; i < 16; ++i) ra[i] = src + (size_t)((i >> 3) * 32 + (i & 7)) * ldw;
        f32x4 v[16];
#define P0_GL "global_load_dwordx4 "
#define P0_CP ", off sc0 sc1 nt\n\t"
        asm volatile(P0_GL "%0, %8" P0_CP P0_GL "%1, %9" P0_CP P0_GL "%2, %10" P0_CP P0_GL "%3, %11" P0_CP P0_GL "%4, %12" P0_CP P0_GL "%5, %13" P0_CP P0_GL "%6, %14" P0_CP P0_GL "%7, %15, off sc0 sc1 nt"
                     : "=&v"(v[0]), "=&v"(v[1]), "=&v"(v[2]), "=&v"(v[3]), "=&v"(v[4]), "=&v"(v[5]), "=&v"(v[6]), "=&v"(v[7]) : "v"(ra[0]), "v"(ra[1]), "v"(ra[2]), "v"(ra[3]), "v"(ra[4]), "v"(ra[5]), "v"(ra[6]), "v"(ra[7]) : "memory");
        asm volatile(P0_GL "%0, %8" P0_CP P0_GL "%1, %9" P0_CP P0_GL "%2, %10" P0_CP P0_GL "%3, %11" P0_CP P0_GL "%4, %12" P0_CP P0_GL "%5, %13" P0_CP P0_GL "%6, %14" P0_CP P0_GL "%7, %15, off sc0 sc1 nt\n\ts_waitcnt vmcnt(0)"
                     : "=&v"(v[8]), "=&v"(v[9]), "=&v"(v[10]), "=&v"(v[11]), "=&v"(v[12]), "=&v"(v[13]), "=&v"(v[14]), "=&v"(v[15]) : "v"(ra[8]), "v"(ra[9]), "v"(ra[10]), "v"(ra[11]), "v"(ra[12]), "v"(ra[13]), "v"(ra[14]), "v"(ra[15]) : "memory");
        asm volatile("" : "+v"(v[0]), "+v"(v[1]), "+v"(v[2]), "+v"(v[3]), "+v"(v[4]), "+v"(v[5]), "+v"(v[6]), "+v"(v[7]));
#undef P0_GL
#undef P0_CP
        u32x4 o[2][4];
#pragma unroll
        for (int pass = 0; pass < 2; ++pass) {
            f32x4 g0 = {scale, scale, scale, scale}, g1 = g0;
            if (gk) { g0 = *(const f32x4*)(gk + kk0 + 32 * pass) * scale; g1 = *(const f32x4*)(gk + kk0 + 32 * pass + 4) * scale; }
#pragma unroll
            for (int j = 0; j < 4; ++j) { const int b = 8 * pass;
                o[pass][j].x = pk2(v[b + 0][j] * g0[0], v[b + 1][j] * g0[1]); o[pass][j].y = pk2(v[b + 2][j] * g0[2], v[b + 3][j] * g0[3]); o[pass][j].z = pk2(v[b + 4][j] * g1[0], v[b + 5][j] * g1[1]); o[pass][j].w = pk2(v[b + 6][j] * g1[2], v[b + 7][j] * g1[3]); }
        }
        if (P0_ASM == 2) {
#pragma unroll
            for (int pass = 0; pass < 2; ++pass)
#pragma unroll
                for (int j = 0; j < 4; ++j) *(u32x4*)(WT + (size_t)(n0 + j) * K + kk0 + 32 * pass) = o[pass][j];
            return; }
        bf16_t* q0 = WT + (size_t)(n0 + 0) * K + kk0; bf16_t* q1 = WT + (size_t)(n0 + 1) * K + kk0; bf16_t* q2 = WT + (size_t)(n0 + 2) * K + kk0; bf16_t* q3 = WT + (size_t)(n0 + 3) * K + kk0;
        asm volatile("global_store_dwordx4 %8, %0, off sc0 sc1 nt\n\tglobal_store_dwordx4 %9, %1, off sc0 sc1 nt\n\tglobal_store_dwordx4 %10, %2, off sc0 sc1 nt\n\tglobal_store_dwordx4 %11, %3, off sc0 sc1 nt\n\t"
                     "global_store_dwordx4 %8, %4, off offset:64 sc0 sc1 nt\n\tglobal_store_dwordx4 %9, %5, off offset:64 sc0 sc1 nt\n\tglobal_store_dwordx4 %10, %6, off offset:64 sc0 sc1 nt\n\tglobal_store_dwordx4 %11, %7, off offset:64 sc0 sc1 nt"
                     :: "v"(o[0][0]), "v"(o[0][1]), "v"(o[0][2]), "v"(o[0][3]), "v"(o[1][0]), "v"(o[1][1]), "v"(o[1][2]), "v"(o[1][3]), "v"(q0), "v"(q1), "v"(q2), "v"(q3) : "memory");
        return;
    }
    if (P0_DEEP && deep) {
        const int kk0 = 64 * kb + 8 * q4;
        const float* src = W + (size_t)kk0 * ldw + ns0;
        f32x4 v[16];
#pragma unroll
        for (int i = 0; i < 16; ++i) v[i] = __builtin_nontemporal_load((const f32x4*)(src + (size_t)((i >> 3) * 32 + (i & 7)) * ldw));
#pragma unroll
        for (int pass = 0; pass < 2; ++pass) {
            f32x4 g0 = {scale, scale, scale, scale}, g1 = g0;
            if (gk) { g0 = *(const f32x4*)(gk + kk0 + 32 * pass) * scale; g1 = *(const f32x4*)(gk + kk0 + 32 * pass + 4) * scale; }
#pragma unroll
            for (int j = 0; j < 4; ++j) { u32x4 o; const int b = 8 * pass;
                o.x = pk2(v[b + 0][j] * g0[0], v[b + 1][j] * g0[1]); o.y = pk2(v[b + 2][j] * g0[2], v[b + 3][j] * g0[3]); o.z = pk2(v[b + 4][j] * g1[0], v[b + 5][j] * g1[1]); o.w = pk2(v[b + 6][j] * g1[2], v[b + 7][j] * g1[3]);
                if (P0_NTST) __builtin_nontemporal_store(o, (u32x4*)(WT + (size_t)(n0 + j) * K + kk0 + 32 * pass)); else *(u32x4*)(WT + (size_t)(n0 + j) * K + kk0 + 32 * pass) = o; }
        }
        return;
    }
#pragma unroll
    for (int pass = 0; pass < 2; ++pass) {
        const int kk0 = 64 * kb + 32 * pass + 8 * q4;
        const float* src = W + (size_t)kk0 * ldw + ns0;
        f32x4 v[8];
#pragma unroll
        for (int i = 0; i < 8; ++i) v[i] = __builtin_nontemporal_load((const f32x4*)(src + (size_t)i * ldw));
        f32x4 g0 = {scale, scale, scale, scale}, g1 = g0;
        if (gk) { g0 = *(const f32x4*)(gk + kk0) * scale; g1 = *(const f32x4*)(gk + kk0 + 4) * scale; }
#pragma unroll
        for (int j = 0; j < 4; ++j) { u32x4 o;
            o.x = pk2(v[0][j] * g0[0], v[1][j] * g0[1]); o.y = pk2(v[2][j] * g0[2], v[3][j] * g0[3]); o.z = pk2(v[4][j] * g1[0], v[5][j] * g1[1]); o.w = pk2(v[6][j] * g1[2], v[7][j] * g1[3]);
            *(u32x4*)(WT + (size_t)(n0 + j) * K + kk0) = o; }
    }
}

constexpr int I_QKV = (DM / 64) * (NQKV / 64), I_WO = (DO / 64) * (DM / 64), I_WIN = (DM / 64) * (NIN / 64), I_WOUT = (DM / 64) * (DM / 64), I_WUP = (DM / 64) * (NUP / 64), I_WDN = (DFF / 64) * (DM / 64);
constexpr int P0_T0 = 2 * I_QKV, P0_T1 = P0_T0 + 2 * I_WO, P0_T2 = P0_T1 + 2 * I_WIN, P0_T3 = P0_T2 + 2 * I_WOUT, P0_T4 = P0_T3 + 4 * I_WUP, P0_TOTAL = P0_T4 + 4 * I_WDN;
constexpr int P0_G1 = I_QKV + I_WO + I_WUP + I_WDN + I_WIN, P0_G2 = P0_G1 + I_WOUT + 2 * (I_WUP + I_WDN) + I_QKV + I_WO + I_WIN;
#ifndef P0_PRO_DEEP
#define P0_PRO_DEEP 0
#endif
#ifndef P0_C1
#define P0_C1 P0_G1
#endif
#ifndef P0_C2
#define P0_C2 P0_G2
#endif
#ifndef UPW0
#define UPW0 4096
#endif
static_assert(UPW0 >= 0 && UPW0 <= I_WIN + I_WDN, "only weights first read after the layer-0 up phase may wait for it");
static_assert(P0_C1 >= P0_G1 && P0_C2 >= P0_G2 && P0_C2 >= P0_C1 && P0_C2 <= P0_TOTAL, "a weight must be transposed before the phase that reads it");
__device__ __forceinline__ void p0_item(const Params& P, int v, int lane, bool deep = false) {
    unsigned char* ws = P.ws;
    int it = v, vs = 0;
#define P0_SEG(CNT, RSTART) if (vs >= 0) { if (v < vs + (CNT)) { it = (RSTART) + (v - vs); vs = -1; } else vs += (CNT); }
    P0_SEG(I_QKV, 0) P0_SEG(I_WO, P0_T0) P0_SEG(I_WUP, P0_T3) P0_SEG(I_WDN, P0_T4) P0_SEG(I_WIN, P0_T1)
    P0_SEG(I_WOUT, P0_T2) P0_SEG(I_WUP, P0_T3 + I_WUP) P0_SEG(I_WDN, P0_T4 + I_WDN) P0_SEG(I_QKV, I_QKV) P0_SEG(I_WO, P0_T0 + I_WO) P0_SEG(I_WUP, P0_T3 + 2 * I_WUP) P0_SEG(I_WDN, P0_T4 + 2 * I_WDN) P0_SEG(I_WIN, P0_T1 + I_WIN)
    P0_SEG(I_WOUT, P0_T2 + I_WOUT) P0_SEG(I_WUP, P0_T3 + 3 * I_WUP) P0_SEG(I_WDN, P0_T4 + 3 * I_WDN)
#undef P0_SEG
    if (it < P0_T0) { const int l = it / I_QKV, r = it % I_QKV; p0_transpose_item(P.in[11] + (size_t)l * DM * NQKV, NQKV, DM, NQKV, (bf16_t*)(ws + WS_WQKV + l * SZ_WQKV), r, lane, 1.f, P.in[9] + (size_t)(2 * l) * DM, false, deep); }
    else if (it < P0_T1) { const int q = it - P0_T0, l = q / I_WO, r = q % I_WO; p0_transpose_item(P.in[14] + (size_t)l * DO * DM, DM, DO, DM, (bf16_t*)(ws + WS_WO + l * SZ_WO), r, lane, 1.f, nullptr, false, deep); }
    else if (it < P0_T2) { const int q = it - P0_T1, l = q / I_WIN, r = q % I_WIN; const int nb = r % (NIN / 64);
        const float sc = (nb >= 16 && nb < 32) ? 0.08838834764831845f : 1.f;
        p0_transpose_item(P.in[15] + (size_t)l * DM * NIN_SRC, NIN_SRC, DM, NIN, (bf16_t*)(ws + WS_WIN + l * SZ_WIN), r, lane, sc, P.in[9] + (size_t)(2 * l + 1) * DM, false, deep); }
    else if (it < P0_T3) { const int q = it - P0_T2, l = q / I_WOUT, r = q % I_WOUT; p0_transpose_item(P.in[18] + (size_t)l * DM * DM, DM, DM, DM, (bf16_t*)(ws + WS_WOUT + l * SZ_WOUT), r, lane, 1.f, nullptr, false, deep); }
    else if (it < P0_T4) { const int q = it - P0_T3, l = q / I_WUP, r = q % I_WUP; p0_transpose_item(P.in[19] + (size_t)l * DM * NUP, NUP, DM, NUP, (bf16_t*)(ws + WS_WUP + l * SZ_WUP), r, lane, 1.f, P.in[10] + (size_t)l * DM, true, deep); }
    else { const int q = it - P0_T4, l = q / I_WDN, r = q % I_WDN; p0_transpose_item(P.in[22] + (size_t)l * DFF * DM, DM, DFF, DM, (bf16_t*)(ws + WS_WDOWN + l * SZ_WDOWN), r, lane, 1.f, nullptr, false, deep); }
}

__device__ __forceinline__ void phase_prologue(const Params& P, LAS unsigned char* lds, int gw, int NGW, int wave, int lane) {
    unsigned char* ws = P.ws;
    for (int v = gw; v < (P0_C1); v += NGW) { if (UPW0 > 0 && v >= P0_G1 - (UPW0) && v < P0_G1) continue; p0_item(P, v, lane, P0_PRO_DEEP); }
    { const int gt = gw * 64 + lane, NT = NGW * 64;
      float* rope = (float*)(ws + WS_ROPE);
      for (int i = gt; i < 2052 * 64; i += NT) { const int pi = i >> 6, f = i & 63; const int pos = (pi < SEQ) ? pi : PAST + (pi - SEQ);
          const float invf = powf(10000.f, -(float)f * (1.f / 64.f)); const float ang = (float)pos * invf; float sn, cs; sincosf(ang, &sn, &cs); rope[2 * i] = cs; rope[2 * i + 1] = sn; }
      for (int i = gt; i < 3 * 64; i += NT) { const int g = i >> 6, f = i & 63; const float invf = powf(10000.f, -(float)f * (1.f / 64.f)); const float ang = (float)(32 << (2 * g)) * invf; float sn, cs; sincosf(ang, &sn, &cs);
          rope[(2052 * 64 + i) * 2] = cs; rope[(2052 * 64 + i) * 2 + 1] = sn; }
      f32x4* wgp = (f32x4*)(ws + WS_WGP);
      for (int i = gt; i < 2 * 128 * 64; i += NT) { const int l = i >> 13, kb = (i >> 6) & 127, ln = i & 63, col = ln & 15, kq = ln >> 4, k = 16 * kb + 4 * kq;
          const float* w = P.in[15] + (size_t)l * DM * NIN_SRC + (size_t)k * NIN_SRC + NIN + col; const float* g = P.in[9] + (size_t)(2 * l + 1) * DM + k;
          wgp[i] = (f32x4){g[0] * w[0], g[1] * w[NIN_SRC], g[2] * w[2 * NIN_SRC], g[3] * w[3 * NIN_SRC]}; } }
    for (int r = gw; r < MR; r += NGW) {
        const f32x4* xr = (const f32x4*)((r < MP) ? P.in[0] + (size_t)r * DM : P.in[1] + (size_t)(r - MP) * DM) + lane;
        u32x2* xb = (u32x2*)(ws + WS_XB) + (size_t)r * (DM / 4) + lane;
        float s = 0.f;
#pragma unroll
        for (int j = 0; j < 8; ++j) { const f32x4 v = xr[64 * j]; u32x2 w; w.x = pk2(v.x, v.y); w.y = pk2(v.z, v.w); xb[64 * j] = w; s += (v.x * v.x + v.y * v.y) + (v.z * v.z + v.w * v.w); }
        s = wave_sum(s);
        if (r < MP) { if (lane < 32) ((float*)(ws + WS_SSQ))[(size_t)r * 32 + lane] = (lane == 0) ? s : 0.f; }
        else { float* q = (float*)(ws + WS_SSQS) + (size_t)(r - MP) * 128; q[lane] = (lane == 0) ? s : 0.f; q[64 + lane] = 0.f; }
    }
}

constexpr int CS_PER_LAYER = NBS * (124 + 508 + 2044);
#ifndef CS_D
#define CS_D 0
#endif
#ifndef UPCOPY
#define UPCOPY 6000
#endif
#ifndef UPT
#define UPT 0
#endif
#ifndef UPW0
#define UPW0 0
#endif
constexpr int CS_NUP = (UPT > 0) ? 2 : (UPW0 > 0) ? 3 : 4;
#ifndef CS_ATTQ
#define CS_ATTQ 0
#endif
constexpr int CS_ATTQN = (CS_ATTQ > 0) ? CS_ATTQ : 1, CS_ATT_PER = (CS_ATTQ > 0) ? 1536 * NWAVES / 2 : 0;
constexpr int CS_QKV = (NQKV / 16) * NWAVES * CS_D, CS_UP = 352 * NWAVES * CS_D, CS_ATT0 = 2 * CS_QKV + 4 * CS_UP, CS_UPC0 = CS_ATT0 + 2 * CS_ATT_PER, CS_TAILS = CS_UPC0 + CS_NUP * (UPCOPY),     CS_DN = (CS_D > 0) ? CS_D : 1;
static_assert(CS_TAILS <= 2 * CS_PER_LAYER, "more side-stream slots than positions");
#ifndef CS_SPLIT
#define CS_SPLIT CS_TAILS
#endif
#ifndef CS_DEPTH
#define CS_DEPTH 2
#endif
__device__ __forceinline__ void cs_addr(const Params& P, float* outp, int t, const f32x4*& src, f32x4*& dst) {
    constexpr int N0 = NBS * 124, N1 = NBS * 508;
    const int ia = (t >= CS_PER_LAYER) ? 1 : 0, it = t - ia * CS_PER_LAYER;
    int g, q; if (it < N0) { g = 0; q = it; } else if (it < N0 + N1) { g = 1; q = it - N0; } else { g = 2; q = it - N0 - N1; }
    const int win = 128 << (2 * g), per = win - 4, bs = q / per, j = q % per;
    src = (const f32x4*)(P.in[2 + g] + ((size_t)(ia * NBS + bs) * win + j + 4) * 2048);
    dst = (f32x4*)(outp + ((g == 0) ? O_KV128S : (g == 1) ? O_KV512S : O_KV2048S) + ((size_t)(ia * NBS + bs) * win + j) * 2048);
}

__device__ __forceinline__ void gate_block(LAS unsigned char* lds, const bf16_t* X, const f32x4* WGP, const float* bg, float* GATES, int task, int wave, int lane) {
    const int r0 = task * 16, i16 = lane & 15, kq = lane >> 4;
    const bf16_t* xr = X + (size_t)(r0 + i16) * DM + 256 * wave + 4 * kq;
    const f32x4* wp = WGP + (size_t)(16 * wave) * 64 + lane;
    f32x4 acc = {0.f, 0.f, 0.f, 0.f}; float ss = 0.f;
#pragma unroll
    for (int j = 0; j < 16; ++j) {
        const u32x2 xw = *(const u32x2*)(xr + 16 * j); const f32x4 xv = {bflo(xw.x), bfhi(xw.x), bflo(xw.y), bfhi(xw.y)}, wv = wp[64 * j];
        ss += (xv.x * xv.x + xv.y * xv.y) + (xv.z * xv.z + xv.w * xv.w);
        acc = __builtin_amdgcn_mfma_f32_16x16x4f32(xv.x, wv.x, acc, 0, 0, 0);
        acc = __builtin_amdgcn_mfma_f32_16x16x4f32(xv.y, wv.y, acc, 0, 0, 0);
        acc = __builtin_amdgcn_mfma_f32_16x16x4f32(xv.z, wv.z, acc, 0, 0, 0);
        acc = __builtin_amdgcn_mfma_f32_16x16x4f32(xv.w, wv.w, acc, 0, 0, 0);
    }
    LAS f32x4* gp = (LAS f32x4*)lds; LAS float* sp = (LAS float*)(lds + 8192);
    __syncthreads();
    gp[wave * 64 + lane] = acc; sp[wave * 64 + lane] = ss;
    __syncthreads();
    if (wave == 0) {
        f32x4 a = gp[lane]; float s = sp[lane];
#pragma unroll
        for (int w = 1; w < 8; ++w) { a += gp[w * 64 + lane]; s += sp[w * 64 + lane]; }
        s += __shfl_xor(s, 16); s += __shfl_xor(s, 32);
        const float rstd = rsqrtf(s * (1.f / DM) + EPS);
        const float bias = bg[i16];
#pragma unroll
        for (int i = 0; i < 4; ++i) {
            const float rs = __shfl(rstd, 4 * kq + i);
            const float pre = a[i] * rs + bias;
            const float gc = 15.f * tanhf(pre * (1.f / 15.f));
            const float val = (i16 < 8) ? gc : (fminf(gc, 0.f) - log1pf(fexp(-fabsf(gc))));
            GATES[(size_t)(r0 + 4 * kq + i) * 16 + i16] = val;
        }
    }
}

constexpr int SK_PART = 0, SK_RSTD = 16384;
template <int MODE>
__device__ __forceinline__ void skinny_phase(LAS unsigned char* lds, const bf16_t* A, int K, const bf16_t* Bt, int N, bf16_t* Ob, int ldo, bf16_t* XBs, float* SSQS, float* Os, int c, int G, int nIdle, int tid, int wave, int lane, const Params& SP, int cs_base) {
    const int i16 = lane & 15, q4 = lane >> 4;
    if (c < G - nIdle) return;
    LAS f32x4* part = (LAS f32x4*)(lds + SK_PART); LAS float* rstdS = (LAS float*)(lds + SK_RSTD);
    __syncthreads();
    if (MODE == 0) { const int row = tid >> 4, sub = tid & 15; const float* q = SSQS + row * 128 + 8 * sub;
        const f32x4 a = *(const f32x4*)q, b = *(const f32x4*)(q + 4); float s = ((a[0] + a[1]) + (a[2] + a[3])) + ((b[0] + b[1]) + (b[2] + b[3]));
        s = row16_sum(s);
        if (sub == 0) rstdS[row] = rsqrtf(s * (1.f / 2048.f) + EPS);
        __syncthreads(); }
    const int kper = K >> 3, nks = kper >> 5, k0 = wave * kper;
    for (int j = G - 1 - c; j < (N >> 4); j += nIdle) {
        f32x4 acc0 = {0.f, 0.f, 0.f, 0.f}, acc1 = {0.f, 0.f, 0.f, 0.f};
        f32x4 sd[CS_DN][8]; f32x4* sdst[CS_DN];
        if (CS_D > 0 && MODE == 0 && cs_base >= 0) {
#pragma unroll
            for (int d = 0; d < CS_D; ++d) { const f32x4* ssrc; cs_addr(SP, SP.out, cs_base + (j * NWAVES + wave) * CS_D + d, ssrc, sdst[d]);
#pragma unroll
                for (int i = 0; i < 8; ++i) sd[d][i] = __builtin_nontemporal_load(ssrc + lane + 64 * i); } }
        const bf16_t* bp = Bt + (size_t)(16 * j + i16) * K + k0 + 8 * q4; const bf16_t* ap = A + (size_t)i16 * K + k0 + 8 * q4;
#pragma unroll 11
        for (int ks = 0; ks < nks; ++ks) { const bf16x8 bf = *(const bf16x8*)(bp + 32 * ks), a0 = *(const bf16x8*)(ap + 32 * ks), a1 = *(const bf16x8*)(ap + (size_t)16 * K + 32 * ks);
            acc0 = mma16(a0, bf, acc0); acc1 = mma16(a1, bf, acc1); }
        part[(wave * 2 + 0) * 64 + lane] = acc0; part[(wave * 2 + 1) * 64 + lane] = acc1;
        __syncthreads();
        if (CS_D > 0 && MODE == 0 && cs_base >= 0) {
#pragma unroll
            for (int d = 0; d < CS_D; ++d)
#pragma unroll
                for (int i = 0; i < 8; ++i) __builtin_nontemporal_store(sd[d][i], sdst[d] + lane + 64 * i); }
        if (wave < 2) {
            f32x4 s = part[wave * 64 + lane];
#pragma unroll
            for (int w = 1; w < 8; ++w) s += part[(w * 2 + wave) * 64 + lane];
            const int col = 16 * j + i16;
#pragma unroll
            for (int i = 0; i < 4; ++i) { const int r = 16 * wave + 4 * q4 + i;
                if (MODE == 0) Ob[(size_t)r * ldo + col] = (bf16_t)f2bf(s[i] * rstdS[r]);
                else if (MODE == 1) { const float xo = bf1(XBs[(size_t)r * DM + col]) + s[i]; XBs[(size_t)r * DM + col] = (bf16_t)f2bf(xo);
                    float sq = xo * xo; sq = row16_sum(sq);
                    if (i16 == 0) SSQS[r * 128 + j] = sq; }
                else Os[(size_t)r * DM + col] = bf1(XBs[(size_t)r * DM + col]) + s[i]; }
        }
        __syncthreads();
    }
}

constexpr int SU_PART = 0, SU_RSTD = 98304, SU_NITEMS = 352;
__device__ __forceinline__ void skinny_up(LAS unsigned char* lds, const float* st_in, const float* cw, const float* cb, const bf16_t* XB, const bf16_t* Bt, const float* SSQ, const float* SSQS, float* HALO, unsigned* hcnt,
                                          bf16_t* Z, float* outp, int layer, int c, int G, int nIdle, int tid, int wave, int lane, const Params& SP, int cs_base) {
    if (c < G - nIdle) return;
    const int i16 = lane & 15, q4 = lane >> 4;
    LAS f32x4* part = (LAS f32x4*)(lds + SU_PART); LAS float* rstdS = (LAS float*)(lds + SU_RSTD);
    __syncthreads();
    { const int row = tid >> 2, pt = tid & 3; float s = 0.f;
      if (row < 32) { const float* q = SSQS + row * 128 + 32 * pt;
#pragma unroll
          for (int v = 0; v < 8; ++v) { const f32x4 a = *(const f32x4*)(q + 4 * v); s += (a[0] + a[1]) + (a[2] + a[3]); } }
      else if (row < 96) { const int hr = row - 32; const float* q = SSQ + (size_t)(256 * (hr >> 1) + 254 + (hr & 1)) * 32 + 8 * pt;
          const f32x4 a = *(const f32x4*)q, b = *(const f32x4*)(q + 4); s = ((a[0] + a[1]) + (a[2] + a[3])) + ((b[0] + b[1]) + (b[2] + b[3])); }
      s = row4_sum(s);
      if (pt == 0 && row < 96) rstdS[row] = rsqrtf(s * (1.f / 2048.f) + EPS); }
    __syncthreads();
    const int k0 = wave * 256;
    const bf16_t* ap[6];
#pragma unroll
    for (int rb = 0; rb < 6; ++rb) { const int grow = (rb < 2) ? MP + 16 * rb + i16 : 256 * ((16 * (rb - 2) + i16) >> 1) + 254 + (i16 & 1); ap[rb] = XB + (size_t)grow * DM + k0 + 8 * q4; }
    for (int j = G - 1 - c; j < SU_NITEMS; j += nIdle) {
        const int pn = j >> 3, sb = j & 7, na = 256 * pn + 16 * sb + i16;
        f32x4 acc[6][2];
#pragma unroll
        for (int rb = 0; rb < 6; ++rb) { acc[rb][0] = (f32x4){0.f, 0.f, 0.f, 0.f}; acc[rb][1] = (f32x4){0.f, 0.f, 0.f, 0.f}; }
        f32x4 sd[CS_DN][8]; f32x4* sdst[CS_DN];
        if (CS_D > 0 && cs_base >= 0) {
#pragma unroll
            for (int d = 0; d < CS_D; ++d) { const f32x4* ssrc; cs_addr(SP, outp, cs_base + (j * NWAVES + wave) * CS_D + d, ssrc, sdst[d]);
#pragma unroll
                for (int i = 0; i < 8; ++i) sd[d][i] = __builtin_nontemporal_load(ssrc + lane + 64 * i); } }
        const bf16_t* bpa = Bt + (size_t)na * DM + k0 + 8 * q4; const bf16_t* bpb = bpa + (size_t)128 * DM;
#pragma unroll 2
        for (int ks = 0; ks < 8; ++ks) { const bf16x8 fa = *(const bf16x8*)(bpa + 32 * ks), fb = *(const bf16x8*)(bpb + 32 * ks);
#pragma unroll
            for (int rb = 0; rb < 6; ++rb) { const bf16x8 a = *(const bf16x8*)(ap[rb] + 32 * ks); acc[rb][0] = mma16(a, fa, acc[rb][0]); acc[rb][1] = mma16(a, fb, acc[rb][1]); } }
#pragma unroll
        for (int rb = 0; rb < 6; ++rb) { part[((wave * 6 + rb) * 2 + 0) * 64 + lane] = acc[rb][0]; part[((wave * 6 + rb) * 2 + 1) * 64 + lane] = acc[rb][1]; }
        __syncthreads();
        if (CS_D > 0 && cs_base >= 0) {
#pragma unroll
            for (int d = 0; d < CS_D; ++d)
#pragma unroll
                for (int i = 0; i < 8; ++i) __builtin_nontemporal_store(sd[d][i], sdst[d] + lane + 64 * i); }
        if (wave < 6) {
            const int rb = wave;
            f32x4 sa = part[((0 * 6 + rb) * 2 + 0) * 64 + lane], sbv = part[((0 * 6 + rb) * 2 + 1) * 64 + lane];
#pragma unroll
            for (int w = 1; w < 8; ++w) { sa += part[((w * 6 + rb) * 2 + 0) * 64 + lane]; sbv += part[((w * 6 + rb) * 2 + 1) * 64 + lane]; }
            const int jn = 128 * pn + 16 * sb + i16;
            if (rb < 2) {
                const int bs = 4 * rb + q4;
                float ua[4], ub[4];
#pragma unroll
                for (int i = 0; i < 4; ++i) { const float rs = rstdS[16 * rb + 4 * q4 + i]; ua[i] = sa[i] * rs; ub[i] = sbv[i] * rs; }
                const float wa0 = cw[jn], wa1 = cw[NUP + jn], wa2 = cw[2 * NUP + jn], ba = cb[jn], wb0 = cw[DFF + jn], wb1 = cw[NUP + DFF + jn], wb2 = cw[2 * NUP + DFF + jn], bb = cb[DFF + jn];
                const float* st = st_in + ((size_t)(layer * NBS + bs) * 2) * NUP;
                float a2 = st[jn], a1 = st[NUP + jn], b2 = st[DFF + jn], b1 = st[NUP + DFF + jn];
#pragma unroll
                for (int t = 0; t < 4; ++t) { const float ca = ba + wa0 * a2 + wa1 * a1 + wa2 * ua[t], cbv = bb + wb0 * b2 + wb1 * b1 + wb2 * ub[t];
                    Z[(size_t)(MP + bs * 4 + t) * DFF + jn] = (bf16_t)f2bf(ca / (1.f + fexp(-ca)) * cbv); a2 = a1; a1 = ua[t]; b2 = b1; b1 = ub[t]; }
                float* co = outp + O_CONVS + ((size_t)(layer * NBS + bs) * 2) * NUP;
                co[jn] = ua[2]; co[NUP + jn] = ua[3]; co[DFF + jn] = ub[2]; co[NUP + DFF + jn] = ub[3];
            } else {
#pragma unroll
                for (int i = 0; i < 4; ++i) { const int hr = 16 * (rb - 2) + 4 * q4 + i; const float rs = rstdS[32 + hr]; const float va = sa[i] * rs, vb = sbv[i] * rs;
                    __hip_atomic_store(HALO + (size_t)hr * NUP + na, va, __ATOMIC_RELAXED, __HIP_MEMORY_SCOPE_AGENT); __hip_atomic_store(HALO + (size_t)hr * NUP + na + 128, vb, __ATOMIC_RELAXED, __HIP_MEMORY_SCOPE_AGENT);
                    const int pmg = hr >> 1;
                    if ((pmg & 7) == 7) { float* co = outp + O_CONVP + ((size_t)(layer * NBP + (pmg >> 3)) * 2 + (hr & 1)) * NUP; co[jn] = va; co[DFF + jn] = vb; } }
                asm volatile("s_waitcnt vmcnt(0)" ::: "memory");
                if (lane == 0) __hip_atomic_fetch_add(hcnt, 1u, __ATOMIC_RELAXED, __HIP_MEMORY_SCOPE_AGENT);
            }
        }
        __syncthreads();
    }
}

__device__ __forceinline__ void unpack8(const u32x4 w, float (&x)[8]) { x[0] = bflo(w.x); x[1] = bfhi(w.x); x[2] = bflo(w.y); x[3] = bfhi(w.y); x[4] = bflo(w.z); x[5] = bfhi(w.z); x[6] = bflo(w.w); x[7] = bfhi(w.w); }
__device__ __forceinline__ void load8(const float* p, float (&x)[8]) { const f32x4 a = *(const f32x4*)p, b = *(const f32x4*)(p + 4); x[0] = a.x; x[1] = a.y; x[2] = a.z; x[3] = a.w; x[4] = b.x; x[5] = b.y; x[6] = b.z; x[7] = b.w; }
#ifndef KV_NT
#define KV_NT 0
#endif
__device__ __forceinline__ void store8_nt(float* p, const float (&x)[8]) { __builtin_nontemporal_store((f32x4){x[0], x[1], x[2], x[3]}, (f32x4*)p); __builtin_nontemporal_store((f32x4){x[4], x[5], x[6], x[7]}, (f32x4*)(p + 4)); }
__device__ __forceinline__ void store8(float* p, const float (&x)[8]) { *(f32x4*)p = (f32x4){x[0], x[1], x[2], x[3]}; *(f32x4*)(p + 4) = (f32x4){x[4], x[5], x[6], x[7]}; }
constexpr int AT_PITCH = 272, AT_KOFF = 0, AT_VOFF = 256 * AT_PITCH;
struct AttnItem { int g, b, h, dil, r, qb; };
__device__ __forceinline__ AttnItem attn_decode(int item) {
    AttnItem a; a.g = item >> 9; const int rem = item & 511, idx = rem & 15; a.b = rem >> 7; a.h = (rem >> 4) & 7;
    a.dil = (a.g == 0) ? 1 : (a.g == 1) ? 4 : 16; a.r = (a.g == 0) ? 0 : (a.g == 1) ? (idx >> 2) : idx; a.qb = (a.g == 0) ? idx : (a.g == 1) ? (idx & 3) : 0; return a;
}
struct AttnPre { u32x4 kr[8]; };
__device__ __forceinline__ void attn_fetch(const bf16_t* QKV, const float* rope, const AttnItem& a, int tid, AttnPre& f) {
    const int ck = (a.g * 3 * 8 + a.h) * 128 + 1024, uk0 = 128 * (a.qb - 1); const size_t rowbase = (size_t)a.b * SEQ + a.r;
#pragma unroll
    for (int i = 0; i < 8; ++i) { const int id = tid + 512 * i, kk = id >> 4, ch = id & 15, u = uk0 + kk;
        f.kr[i] = (u32x4){0u, 0u, 0u, 0u};
        if (u >= 0) f.kr[i] = *(const u32x4*)(QKV + (rowbase + (size_t)u * a.dil) * NQKV + ck + 8 * ch); }
}
__device__ __forceinline__ void attn_phase(const Params& P, LAS unsigned char* lds, unsigned lds_base, const bf16_t* QKV, const float* rope, const float* qgain, const float* kgain, float* outp, int ia, bf16_t* OG, float* LSE,
                                           int first, int stride, int nitems, int tid, int wave, int lane) {
    const int i16 = lane & 15, q4 = lane >> 4, qq = i16 >> 2, p = lane & 3;
    const int ch = tid & 15; const float sgn = (ch >= 8) ? 1.f : -1.f;
    float kgn[8];
    load8(kgain + 8 * ch, kgn);
    AttnPre f;
    if (first < nitems) { const AttnItem a0 = attn_decode(first); attn_fetch(QKV, rope, a0, tid, f); }
    __syncthreads();
#pragma unroll 1
    for (int item = first; item < nitems; item += stride) {
        const AttnItem a = attn_decode(item);
        const int g = a.g, h = a.h, qb = a.qb;
        const int cq = (g * 3 * 8 + h) * 128;
        const size_t rowbase = (size_t)a.b * SEQ + a.r;
        const int win = 128 << (2 * g);
        float* kvo = outp + ((g == 0) ? O_KV128P : (g == 1) ? O_KV512P : O_KV2048P) + ((size_t)(ia * NBP + a.b) * win) * 2048 + h * 128 + 8 * ch;
        const int tqa = 16 * wave + i16;
        const int posq = a.r + a.dil * (128 * qb + tqa);
        const size_t grow = (size_t)a.b * SEQ + posq;
        { float c[8], sn[8], cd[8], sd[8];
          { const int u0 = (qb == 0) ? (tid >> 4) : 128 * (qb - 1) + (tid >> 4), pos0 = a.r + a.dil * u0;
            const f32x4* dp = (const f32x4*)(rope + ((size_t)(2052 + g) * 64 + 8 * (tid & 7)) * 2); const f32x4* rp = (const f32x4*)(rope + ((size_t)pos0 * 64 + 8 * (tid & 7)) * 2);
#pragma unroll
            for (int q = 0; q < 4; ++q) { const f32x4 t = dp[q], b0 = rp[q]; cd[2 * q] = t[0]; sd[2 * q] = t[1]; cd[2 * q + 1] = t[2]; sd[2 * q + 1] = t[3];
                c[2 * q] = b0[0]; sn[2 * q] = b0[1]; c[2 * q + 1] = b0[2]; sn[2 * q + 1] = b0[3]; } }
#pragma unroll
          for (int i = 0; i < 8; ++i) { const int id = tid + 512 * i, kk = id >> 4; const int u = 128 * (qb - 1) + kk;
            u32x4 kw = {0u, 0u, 0u, 0u};
            if (u >= 0) {
                float x[8]; unpack8(f.kr[i], x);
                float ss = 0.f;
#pragma unroll
                for (int j = 0; j < 8; ++j) ss += x[j] * x[j];
                ss = row16_sum(ss);
                const float rstd = rsqrtf(ss * (1.f / 128.f) + EPS);
                float o[8];
#pragma unroll
                for (int j = 0; j < 8; ++j) { const float y = x[j] * rstd * kgn[j]; const float pr = dpp_mov<0x128>(y); o[j] = y * c[j] + sgn * pr * sn[j];
                    const float cn = c[j] * cd[j] - sn[j] * sd[j]; sn[j] = sn[j] * cd[j] + c[j] * sd[j]; c[j] = cn; }
                kw.x = pk2(o[0], o[1]); kw.y = pk2(o[2], o[3]); kw.z = pk2(o[4], o[5]); kw.w = pk2(o[6], o[7]);
                const int jw = a.r + a.dil * u - (SEQ - win);
                if (kk >= 128 && jw >= 0) { if (KV_NT) store8_nt(kvo + (size_t)jw * 2048, o); else store8(kvo + (size_t)jw * 2048, o); }
            }
            *(LAS u32x4*)(lds + AT_KOFF + kk * AT_PITCH + (id & 15) * 16) = kw; } }
        u32x4 vr[8];
        { const int cv = cq + 2048, uk0 = 128 * (qb - 1);
#pragma unroll
          for (int i = 0; i < 8; ++i) { const int id = tid + 512 * i, kk = id >> 4, u = uk0 + kk; vr[i] = (u32x4){0u, 0u, 0u, 0u};
              if (u >= 0) vr[i] = *(const u32x4*)(QKV + (rowbase + (size_t)u * a.dil) * NQKV + cv + 8 * (id & 15)); } }
        bf16x8 Qf[4];
        { float x[4][8];
#pragma unroll
          for (int ks = 0; ks < 4; ++ks) unpack8(*(const u32x4*)(QKV + grow * NQKV + cq + 32 * ks + 8 * q4), x[ks]);
          float ss = 0.f;
#pragma unroll
          for (int ks = 0; ks < 4; ++ks)
#pragma unroll
              for (int j = 0; j < 8; ++j) ss += x[ks][j] * x[ks][j];
          ss += __shfl_xor(ss, 16); ss += __shfl_xor(ss, 32);
          const float rstd = rsqrtf(ss * (1.f / 128.f) + EPS);
#pragma unroll
          for (int kp = 0; kp < 2; ++kp) { float g1[8], g2[8], cq_[8], sq_[8];
              load8(qgain + 32 * kp + 8 * q4, g1); load8(qgain + 64 + 32 * kp + 8 * q4, g2);
              const f32x4* rp = (const f32x4*)(rope + ((size_t)posq * 64 + 32 * kp + 8 * q4) * 2);
#pragma unroll
              for (int q = 0; q < 4; ++q) { const f32x4 t = rp[q]; cq_[2 * q] = t[0]; sq_[2 * q] = t[1]; cq_[2 * q + 1] = t[2]; sq_[2 * q + 1] = t[3]; }
              float o1[8], o2[8];
#pragma unroll
              for (int j = 0; j < 8; ++j) { const float y1 = x[kp][j] * rstd * g1[j], y2 = x[kp + 2][j] * rstd * g2[j]; o1[j] = y1 * cq_[j] - y2 * sq_[j]; o2[j] = y2 * cq_[j] + y1 * sq_[j]; }
              u32x4 w1, w2; w1.x = pk2(o1[0], o1[1]); w1.y = pk2(o1[2], o1[3]); w1.z = pk2(o1[4], o1[5]); w1.w = pk2(o1[6], o1[7]); w2.x = pk2(o2[0], o2[1]); w2.y = pk2(o2[2], o2[3]); w2.z = pk2(o2[4], o2[5]); w2.w = pk2(o2[6], o2[7]);
              Qf[kp] = __builtin_bit_cast(bf16x8, w1); Qf[kp + 2] = __builtin_bit_cast(bf16x8, w2); } }
        __syncthreads();
        if (item + stride < nitems) { const AttnItem an = attn_decode(item + stride); attn_fetch(QKV, rope, an, tid, f); }
        f32x4 cl[CS_ATTQN]; const f32x4* csrc = nullptr; f32x4* cdst = nullptr;
        if (CS_ATTQ > 0) { const int cst = item * NWAVES + wave; cs_addr(P, outp, CS_ATT0 + ia * (CS_ATT_PER) + (cst >> 1), csrc, cdst); csrc += (cst & 1) * 256 + lane; cdst += (cst & 1) * 256 + lane;
#pragma unroll
            for (int i = 0; i < CS_ATTQ; ++i) cl[i] = __builtin_nontemporal_load(csrc + 64 * i); }
        const int cb0 = wave & ~1;
        f32x4 S[10];
#pragma unroll
        for (int c = 0; c < 10; ++c) {
            f32x4 acc = {0.f, 0.f, 0.f, 0.f};
#pragma unroll
            for (int ks = 0; ks < 4; ++ks) { const bf16x8 kf = *(const LAS bf16x8*)(lds + AT_KOFF + (16 * (cb0 + c) + i16) * AT_PITCH + (32 * ks + 8 * q4) * 2); acc = mma16(kf, Qf[ks], acc); }
            S[c] = acc;
        }
        const float sc = 0.08838834764831845f * 1.4426950408889634f;
        float mx = -INFINITY;
#pragma unroll
        for (int c = 0; c < 10; ++c)
#pragma unroll
            for (int i = 0; i < 4; ++i) { const int kk = 16 * (cb0 + c) + 4 * q4 + i; const bool ok = (kk >= tqa) && (kk <= tqa + 128) && (qb > 0 || kk >= 128);
                const float s = ok ? S[c][i] * sc : -INFINITY; S[c][i] = s; mx = fmaxf(mx, s); }
        mx = fmaxf(mx, __shfl_xor(mx, 16)); mx = fmaxf(mx, __shfl_xor(mx, 32));
        float l = 0.f;
#pragma unroll
        for (int c = 0; c < 10; ++c)
#pragma unroll
            for (int i = 0; i < 4; ++i) { const float pv = __builtin_amdgcn_exp2f(S[c][i] - mx); S[c][i] = pv; l += pv; }
        l += __shfl_xor(l, 16); l += __shfl_xor(l, 32);
        bf16x8 Pf[5];
#pragma unroll
        for (int kst = 0; kst < 5; ++kst) Pf[kst] = pack8(S[2 * kst], S[2 * kst + 1]);
#pragma unroll
        for (int i = 0; i < 8; ++i) { const int id = tid + 512 * i, kk = id >> 4, u = 128 * (qb - 1) + kk;
            *(LAS u32x4*)(lds + AT_VOFF + kk * AT_PITCH + (id & 15) * 16) = vr[i];
            const int jw = a.r + a.dil * u - (SEQ - win);
            if (kk >= 128 && jw >= 0) { float vx[8]; unpack8(vr[i], vx); if (KV_NT) store8_nt(kvo + (size_t)jw * 2048 + 1024, vx); else store8(kvo + (size_t)jw * 2048 + 1024, vx); } }
        __syncthreads();
        if (CS_ATTQ > 0) {
#pragma unroll
            for (int i = 0; i < CS_ATTQ; ++i) __builtin_nontemporal_store(cl[i], cdst + 64 * i);
#pragma unroll
            for (int i = 0; i < CS_ATTQ; ++i) cl[i] = __builtin_nontemporal_load(csrc + 64 * (CS_ATTQ + i)); }
        const float inv = 1.f / l;
        bf16_t* orow = OG + grow * 3072 + g * 1024 + h * 128 + 4 * q4;
        const unsigned vbase = lds_base + AT_VOFF + (16 * cb0 + 4 * q4 + qq) * AT_PITCH + 8 * p;
#pragma unroll
        for (int eb = 0; eb < 8; ++eb) {
            f32x4 acc = {0.f, 0.f, 0.f, 0.f};
            bf16x8 v0, v1, v2, v3, v4;
            TR_READ5(v0, v1, v2, v3, v4, vbase, 0 * AT_PITCH + 32 * eb, 16 * AT_PITCH + 32 * eb, 32 * AT_PITCH + 32 * eb, 48 * AT_PITCH + 32 * eb, 64 * AT_PITCH + 32 * eb, 80 * AT_PITCH + 32 * eb,
                     96 * AT_PITCH + 32 * eb, 112 * AT_PITCH + 32 * eb, 128 * AT_PITCH + 32 * eb, 144 * AT_PITCH + 32 * eb);
            acc = mma16(v0, Pf[0], acc); acc = mma16(v1, Pf[1], acc); acc = mma16(v2, Pf[2], acc); acc = mma16(v3, Pf[3], acc); acc = mma16(v4, Pf[4], acc);
            u32x2 w; w.x = pk2(acc[0] * inv, acc[1] * inv); w.y = pk2(acc[2] * inv, acc[3] * inv);
            *(u32x2*)(orow + 16 * eb) = w;
        }
        if (q4 == 0) LSE[grow * 24 + g * 8 + h] = (mx + log2f(l)) * 0.6931471805599453f;
        if (CS_ATTQ > 0) {
#pragma unroll
            for (int i = 0; i < CS_ATTQ; ++i) __builtin_nontemporal_store(cl[i], cdst + 64 * (CS_ATTQ + i)); }
    }
    __syncthreads();
}

__device__ __forceinline__ void sample_prep_vec(const bf16_t* src, const float* gain, const float* rope, int tt, LAS float* dst, int lane) {
    const float x1 = bf1(src[lane]), x2 = bf1(src[lane + 64]);
    const float rstd = rsqrtf(wave_sum(x1 * x1 + x2 * x2) * (1.f / 128.f) + EPS);
    const float y1 = x1 * rstd * gain[lane], y2 = x2 * rstd * gain[64 + lane];
    const f32x2 cs = *(const f32x2*)(rope + ((size_t)(SEQ + tt) * 64 + lane) * 2);
    dst[lane] = y1 * cs.x - y2 * cs.y; dst[lane + 64] = y2 * cs.x + y1 * cs.y;
}
__device__ __forceinline__ void attn_sample_task(LAS unsigned char* wl  , const bf16_t* QKV, const float* rope, const float* qgain, const float* kgain, float* outp,
                                                 const float* c128, const float* c512, const float* c2048, bf16_t* OG, float* LSE, int ia, int wt, int lane) {
    const int bs = wt / 96, rem = wt % 96, g = rem >> 5, h = (rem >> 2) & 7, t = rem & 3;
    const int win = 128 << (2 * g), dil = 1 << (2 * g);
    const float* cache = ((g == 0) ? c128 : (g == 1) ? c512 : c2048) + (size_t)(ia * NBS + bs) * win * 2048;
    const int cq = (g * 3 * 8 + h) * 128, ck = cq + 1024, cv = cq + 2048;
    const size_t rq = (size_t)MP + bs * 4 + t;
    LAS float* qs = (LAS float*)wl; LAS float* ps = (LAS float*)(wl + 512); LAS float* knew = (LAS float*)(wl + 1536);
    sample_prep_vec(QKV + rq * NQKV + cq, qgain, rope, t, qs, lane);
    for (int tn = (g == 0) ? 0 : t; tn <= t; ++tn) sample_prep_vec(QKV + ((size_t)MP + bs * 4 + tn) * NQKV + ck, kgain, rope, tn, knew + tn * 128, lane);
    asm volatile("s_waitcnt lgkmcnt(0)" ::: "memory");
    { float* kvo = outp + ((g == 0) ? O_KV128S : (g == 1) ? O_KV512S : O_KV2048S) + (((size_t)(ia * NBS + bs) * win + (win - TSAMP + t)) * 2) * 1024 + h * 128;
      kvo[lane] = knew[t * 128 + lane]; kvo[lane + 64] = knew[t * 128 + lane + 64];
      const bf16_t* vp = QKV + rq * NQKV + cv; kvo[1024 + lane] = bf1(vp[lane]); kvo[1024 + lane + 64] = bf1(vp[lane + 64]); }
    float sv[3];
#pragma unroll
    for (int pass = 0; pass < 3; ++pass) {
        const int j = pass * 64 + lane; float s = -INFINITY;
        if (j <= 128) {
            const int idx = win + t - dil * j; float acc = 0.f;
            if (idx >= win) { const LAS float* kp = knew + (idx - win) * 128;
                for (int d = 0; d < 128; d += 4) { const LAS float* q = qs + d; acc += q[0] * kp[d] + q[1] * kp[d + 1] + q[2] * kp[d + 2] + q[3] * kp[d + 3]; } }
            else { const float* kp = cache + ((size_t)idx * 2 + 0) * 1024 + h * 128;
                for (int d = 0; d < 128; d += 4) { const f32x4 kx = *(const f32x4*)(kp + d); const LAS float* q = qs + d; acc += q[0] * kx.x + q[1] * kx.y + q[2] * kx.z + q[3] * kx.w; } }
            s = acc * 0.08838834764831845f;
        }
        sv[pass] = s;
    }
    const float mx = wave_max(fmaxf(fmaxf(sv[0], sv[1]), sv[2]));
    float l = 0.f;
#pragma unroll
    for (int pass = 0; pass < 3; ++pass) { const float pv = fexp(sv[pass] - mx); l += pv; ps[pass * 64 + lane] = pv; }
    l = wave_sum(l);
    asm volatile("s_waitcnt lgkmcnt(0)" ::: "memory");
    { const int jg = lane >> 4, dd = lane & 15;
      float o[8];
#pragma unroll
      for (int q = 0; q < 8; ++q) o[q] = 0.f;
#pragma unroll 4
      for (int j = jg; j <= 128; j += 4) {
          const int idx = win + t - dil * j; const float pj = ps[j]; float v[8];
          if (idx >= win) { unpack8(*(const u32x4*)(QKV + ((size_t)MP + bs * 4 + (idx - win)) * NQKV + cv + 8 * dd), v); }
          else { load8(cache + ((size_t)idx * 2 + 1) * 1024 + h * 128 + 8 * dd, v); }
#pragma unroll
          for (int q = 0; q < 8; ++q) o[q] += pj * v[q];
      }
      const float inv = 1.f / l;
#pragma unroll
      for (int q = 0; q < 8; ++q) { o[q] += __shfl_xor(o[q], 16); o[q] += __shfl_xor(o[q], 32); o[q] *= inv; }
      if (jg == 0) { u32x4 w; w.x = pk2(o[0], o[1]); w.y = pk2(o[2], o[3]); w.z = pk2(o[4], o[5]); w.w = pk2(o[6], o[7]); *(u32x4*)(OG + rq * 3072 + g * 1024 + h * 128 + 8 * dd) = w; } }
    if (lane == 0) LSE[rq * 24 + g * 8 + h] = mx + logf(l);
}

__device__ __forceinline__ void combine_row(const bf16_t* OG, const float* LSE, bf16_t* OC, int r, int lane) {
    const int hh = lane >> 3;
    const float l0 = LSE[(size_t)r * 24 + hh], l1 = LSE[(size_t)r * 24 + 8 + hh], l2 = LSE[(size_t)r * 24 + 16 + hh];
    const float mx = fmaxf(l0, fmaxf(l1, l2));
    float e0 = fexp(l0 - mx), e1 = fexp(l1 - mx), e2 = fexp(l2 - mx);
    const float inv = 1.f / (e0 + e1 + e2); e0 *= inv; e1 *= inv; e2 *= inv;
    const bf16_t* src = OG + (size_t)r * 3072 + 16 * lane;
#pragma unroll
    for (int c = 0; c < 2; ++c) {
        const u32x4 a = *(const u32x4*)(src + 8 * c), bq = *(const u32x4*)(src + 1024 + 8 * c), cc = *(const u32x4*)(src + 2048 + 8 * c);
        u32x4 o;
        o.x = pk2(e0 * bflo(a.x) + e1 * bflo(bq.x) + e2 * bflo(cc.x), e0 * bfhi(a.x) + e1 * bfhi(bq.x) + e2 * bfhi(cc.x));
        o.y = pk2(e0 * bflo(a.y) + e1 * bflo(bq.y) + e2 * bflo(cc.y), e0 * bfhi(a.y) + e1 * bfhi(bq.y) + e2 * bfhi(cc.y));
        o.z = pk2(e0 * bflo(a.z) + e1 * bflo(bq.z) + e2 * bflo(cc.z), e0 * bfhi(a.z) + e1 * bfhi(bq.z) + e2 * bfhi(cc.z));
        o.w = pk2(e0 * bflo(a.w) + e1 * bflo(bq.w) + e2 * bflo(cc.w), e0 * bfhi(a.w) + e1 * bfhi(bq.w) + e2 * bfhi(cc.w));
        *(u32x4*)(OC + (size_t)r * DO + 16 * lane + 8 * c) = o;
    }
}

template <int NR> __device__ __forceinline__ void combine_rows(const bf16_t* OG, const float* LSE, bf16_t* OC, int r0, int rstride, int rmax, int lane) {
    const int hh = lane >> 3;
    u32x4 a[NR][2], bq[NR][2], cc[NR][2]; float l0[NR], l1[NR], l2[NR];
#pragma unroll
    for (int k = 0; k < NR; ++k) { const int r = r0 + k * rstride;
        if (r < rmax) { l0[k] = LSE[(size_t)r * 24 + hh]; l1[k] = LSE[(size_t)r * 24 + 8 + hh]; l2[k] = LSE[(size_t)r * 24 + 16 + hh];
            const bf16_t* src = OG + (size_t)r * 3072 + 16 * lane;
#pragma unroll
            for (int c = 0; c < 2; ++c) { a[k][c] = *(const u32x4*)(src + 8 * c); bq[k][c] = *(const u32x4*)(src + 1024 + 8 * c); cc[k][c] = *(const u32x4*)(src + 2048 + 8 * c); } } }
#pragma unroll
    for (int k = 0; k < NR; ++k) { const int r = r0 + k * rstride;
        if (r < rmax) {
            const float mx = fmaxf(l0[k], fmaxf(l1[k], l2[k]));
            float e0 = fexp(l0[k] - mx), e1 = fexp(l1[k] - mx), e2 = fexp(l2[k] - mx);
            const float inv = 1.f / (e0 + e1 + e2); e0 *= inv; e1 *= inv; e2 *= inv;
#pragma unroll
            for (int c = 0; c < 2; ++c) { const u32x4 A = a[k][c], B = bq[k][c], C = cc[k][c]; u32x4 o;
                o.x = pk2(e0 * bflo(A.x) + e1 * bflo(B.x) + e2 * bflo(C.x), e0 * bfhi(A.x) + e1 * bfhi(B.x) + e2 * bfhi(C.x));
                o.y = pk2(e0 * bflo(A.y) + e1 * bflo(B.y) + e2 * bflo(C.y), e0 * bfhi(A.y) + e1 * bfhi(B.y) + e2 * bfhi(C.y));
                o.z = pk2(e0 * bflo(A.z) + e1 * bflo(B.z) + e2 * bflo(C.z), e0 * bfhi(A.z) + e1 * bfhi(B.z) + e2 * bfhi(C.z));
                o.w = pk2(e0 * bflo(A.w) + e1 * bflo(B.w) + e2 * bflo(C.w), e0 * bfhi(A.w) + e1 * bfhi(B.w) + e2 * bfhi(C.w));
                *(u32x4*)(OC + (size_t)r * DO + 16 * lane + 8 * c) = o; } } }
}

template <int CTRL, int RMASK> __device__ __forceinline__ float dpp_f(float oldv, float src) {
    return __builtin_bit_cast(float, __builtin_amdgcn_update_dpp(__builtin_bit_cast(int, oldv), __builtin_bit_cast(int, src), CTRL, RMASK, 0xf, false)); }
__device__ __forceinline__ float scan_sum(float v, int lane) {
    (void)lane;
    v += dpp_f<0x111, 0xf>(0.f, v); v += dpp_f<0x112, 0xf>(0.f, v); v += dpp_f<0x114, 0xf>(0.f, v); v += dpp_f<0x118, 0xf>(0.f, v);
    v += dpp_f<0x142, 0xa>(0.f, v); v += dpp_f<0x143, 0xc>(0.f, v);
    return v;
}
__device__ __forceinline__ float scan_max(float v, int lane) {
    (void)lane; const float ninf = -INFINITY;
    v = fmaxf(v, dpp_f<0x111, 0xf>(ninf, v)); v = fmaxf(v, dpp_f<0x112, 0xf>(ninf, v)); v = fmaxf(v, dpp_f<0x114, 0xf>(ninf, v)); v = fmaxf(v, dpp_f<0x118, 0xf>(ninf, v));
    v = fmaxf(v, dpp_f<0x142, 0xa>(ninf, v)); v = fmaxf(v, dpp_f<0x143, 0xc>(ninf, v));
    return v;
}
#ifndef ML_COPY
#define ML_COPY 0
#endif
constexpr int ML_QP = 272, ML_VP = 144, ML_PP = 144;
constexpr int ML_QSZ = 64 * ML_QP, ML_VSZ = 64 * ML_VP;
constexpr int ML_Q = 0, ML_K = ML_Q + 2 * ML_QSZ, ML_V = ML_K + 2 * ML_QSZ, ML_KW = ML_V + 2 * ML_VSZ, ML_P = ML_KW + ML_QSZ, ML_N = ML_P + 64 * ML_PP, ML_DEN = ML_N + 1024, ML_END = ML_DEN + 256;
__device__ __forceinline__ void mlstm_prompt(LAS unsigned char* lds, unsigned lds_base, const bf16_t* QKVO, const float* GATES, bf16_t* HRAW, float* SQ, float* out, int ib, int unit, int tid, int wave, int lane) {
    const int bh = unit >> 2, sl = unit & 3;
    const int b = bh >> 3, h = bh & 7;
    const int i16 = lane & 15, q4 = lane >> 4, qq = i16 >> 2, p = lane & 3;
    const int rb = wave >> 1, ea = wave & 1, e0 = 64 * sl + 32 * ea;
    f32x4 CT[2][8];
#pragma unroll
    for (int a = 0; a < 2; ++a)
#pragma unroll
        for (int d = 0; d < 8; ++d) CT[a][d] = (f32x4){0.f, 0.f, 0.f, 0.f};
    float m = 0.f;
    const unsigned vbase0 = lds_base + ML_V + (8 * q4 + qq) * ML_VP + (32 * ea + 4 * p) * 2, kwbase = lds_base + ML_KW + (8 * q4 + qq) * ML_QP + 8 * p;
    LAS float* nS = (LAS float*)(lds + ML_N); LAS float* denS = (LAS float*)(lds + ML_DEN);
    const size_t rbase = (size_t)b * SEQ;
    const int srow0 = tid >> 4, sch = tid & 15, vrow = tid >> 3, vch = tid & 7;
    u32x4 pq0, pq1, pk0, pk1, pv; float pig, plf;
    { const bf16_t* s0 = QKVO + (rbase + srow0) * NIN + h * 128 + 8 * sch; const bf16_t* s1 = s0 + (size_t)32 * NIN;
      pq0 = *(const u32x4*)s0; pk0 = *(const u32x4*)(s0 + 1024); pq1 = *(const u32x4*)s1; pk1 = *(const u32x4*)(s1 + 1024);
      pv = *(const u32x4*)(QKVO + (rbase + vrow) * NIN + 2048 + h * 256 + 64 * sl + 8 * vch);
      pig = GATES[(rbase + lane) * 16 + h]; plf = GATES[(rbase + lane) * 16 + 8 + h]; }
    __syncthreads();
    if (tid < 128) nS[tid] = 0.f;
    *(LAS u32x4*)(lds + ML_Q + srow0 * ML_QP + sch * 16) = pq0; *(LAS u32x4*)(lds + ML_Q + (srow0 + 32) * ML_QP + sch * 16) = pq1;
    *(LAS u32x4*)(lds + ML_K + srow0 * ML_QP + sch * 16) = pk0; *(LAS u32x4*)(lds + ML_K + (srow0 + 32) * ML_QP + sch * 16) = pk1;
    *(LAS u32x4*)(lds + ML_V + vrow * ML_VP + vch * 16) = pv;
    __syncthreads();
    float hv0[4] = {0.f, 0.f, 0.f, 0.f}, hv1[4] = {0.f, 0.f, 0.f, 0.f}, sv0[4] = {0.f, 0.f, 0.f, 0.f}, sv1[4] = {0.f, 0.f, 0.f, 0.f};
#define ML_FLUSH(rprev) do { _Pragma("unroll") for (int i = 0; i < 4; ++i) { const int t = 16 * rb + 4 * q4 + i; \
        bf16_t* hp = HRAW + ((rprev) + t) * DM + h * 256 + e0 + i16; hp[0] = (bf16_t)f2bf(hv0[i]); hp[16] = (bf16_t)f2bf(hv1[i]); \
        if (i16 == 0) { float* sp = SQ + ((rprev) + t) * 128 + h * 16 + 4 * sl + 2 * ea; sp[0] = sv0[i]; sp[1] = sv1[i]; } } } while (0)
#pragma unroll 1
    for (int c = 0; c < 32; ++c) {
        const int cur = c & 1, nxt = cur ^ 1;
        const size_t r0 = rbase + 64 * c;
        const LAS unsigned char* Qc = lds + ML_Q + cur * ML_QSZ; const LAS unsigned char* Kc = lds + ML_K + cur * ML_QSZ;
        const float ig = pig, lf = plf;
        asm volatile("" :: "v"(ig), "v"(lf));
        if (c > 0) ML_FLUSH(r0 - 64);
        { const size_t rn = rbase + 64 * ((c < 31) ? c + 1 : c);
          const bf16_t* s0 = QKVO + (rn + srow0) * NIN + h * 128 + 8 * sch; const bf16_t* s1 = s0 + (size_t)32 * NIN;
          pq0 = *(const u32x4*)s0; pk0 = *(const u32x4*)(s0 + 1024); pq1 = *(const u32x4*)s1; pk1 = *(const u32x4*)(s1 + 1024);
          pv = *(const u32x4*)(QKVO + (rn + vrow) * NIN + 2048 + h * 256 + 64 * sl + 8 * vch);
          pig = GATES[(rn + lane) * 16 + h]; plf = GATES[(rn + lane) * 16 + 8 + h]; }
        const float bcum = scan_sum(lf, lane);
        const float av = ig - bcum;
        const float Av = fmaxf(m, scan_max(av, lane));
        const float bL = __shfl(bcum, 63), A63 = __shfl(Av, 63);
        const float wsv = fexp(av - A63), wC = fexp(m - A63);
#pragma unroll
        for (int i = 0; i < 2; ++i) { const int id = lane + 64 * i, rr = 8 * wave + (id >> 4), ch = id & 15;
            const u32x4 kx = *(const LAS u32x4*)(Kc + rr * ML_QP + ch * 16); const float w = __shfl(wsv, rr);
            u32x4 o; o.x = pk2(bflo(kx.x) * w, bfhi(kx.x) * w); o.y = pk2(bflo(kx.y) * w, bfhi(kx.y) * w); o.z = pk2(bflo(kx.z) * w, bfhi(kx.z) * w); o.w = pk2(bflo(kx.w) * w, bfhi(kx.w) * w);
            *(LAS u32x4*)(lds + ML_KW + rr * ML_QP + ch * 16) = o; }
        {
#pragma unroll
          for (int cc = 0; cc < 2; ++cc) { const int cb = 2 * (wave & 1) + cc;
            f32x4 s = {0.f, 0.f, 0.f, 0.f};
            if (cb <= rb) {
#pragma unroll
                for (int ks = 0; ks < 4; ++ks) { const bf16x8 af = *(const LAS bf16x8*)(Qc + (16 * rb + i16) * ML_QP + (32 * ks + 8 * q4) * 2);
                    const bf16x8 bf = *(const LAS bf16x8*)(Kc + (16 * cb + i16) * ML_QP + (32 * ks + 8 * q4) * 2); s = mma16(af, bf, s); } }
            const int sidx = 16 * cb + i16; const float as = __shfl(av, sidx);
#pragma unroll
            for (int i = 0; i < 4; ++i) { const int t = 16 * rb + 4 * q4 + i; const float At = __shfl(Av, t);
                const float pv_ = (sidx <= t && cb <= rb) ? s[i] * fexp(as - At) : 0.f;
                *(LAS bf16_t*)(lds + ML_P + t * ML_PP + sidx * 2) = (bf16_t)f2bf(pv_); } } }
        LDS_BARRIER();
        { const int t = tid >> 3, part = tid & 7;
          const LAS unsigned char* qrow = Qc + t * ML_QP + part * 32;
          const u32x4 qa = *(const LAS u32x4*)(qrow), qb = *(const LAS u32x4*)(qrow + 16);
          const LAS float* nn = nS + cur * 128 + 16 * part;
          float a = nn[0] * bflo(qa.x) + nn[1] * bfhi(qa.x) + nn[2] * bflo(qa.y) + nn[3] * bfhi(qa.y) + nn[4] * bflo(qa.z) + nn[5] * bfhi(qa.z) + nn[6] * bflo(qa.w) + nn[7] * bfhi(qa.w)
                  + nn[8] * bflo(qb.x) + nn[9] * bfhi(qb.x) + nn[10] * bflo(qb.y) + nn[11] * bfhi(qb.y) + nn[12] * bflo(qb.z) + nn[13] * bfhi(qb.z) + nn[14] * bflo(qb.w) + nn[15] * bfhi(qb.w);
          const u32x4 pr = *(const LAS u32x4*)(lds + ML_P + t * ML_PP + part * 16);
          const float rsum = ((bflo(pr.x) + bfhi(pr.x)) + (bflo(pr.y) + bfhi(pr.y))) + ((bflo(pr.z) + bfhi(pr.z)) + (bflo(pr.w) + bfhi(pr.w)));
          const float At = __shfl(Av, t), bt = __shfl(bcum, t);
          float val = fexp(m - At) * a + rsum;
          val = row8_sum(val);
          if (part == 0) denS[t] = 1.f / fmaxf(fabsf(val), fexp(-(bt + At))); }
        if (tid < 128) { float acc = wC * nS[cur * 128 + tid];
#pragma unroll 8
            for (int s = 0; s < 64; ++s) acc += bf1(*(const LAS bf16_t*)(lds + ML_KW + s * ML_QP + tid * 2));
            nS[nxt * 128 + tid] = acc; }
        f32x4 num0 = {0.f, 0.f, 0.f, 0.f}, num1 = {0.f, 0.f, 0.f, 0.f};
#pragma unroll
        for (int ks = 0; ks < 4; ++ks) { const LAS unsigned char* qrow = Qc + (16 * rb + i16) * ML_QP;
            const u32x2 lo = *(const LAS u32x2*)(qrow + (32 * ks + 4 * q4) * 2), hi = *(const LAS u32x2*)(qrow + (32 * ks + 16 + 4 * q4) * 2);
            u32x4 w; w.x = lo.x; w.y = lo.y; w.z = hi.x; w.w = hi.y; const bf16x8 af = __builtin_bit_cast(bf16x8, w);
            num0 = mma16(af, pack8(CT[0][2 * ks], CT[0][2 * ks + 1]), num0); num1 = mma16(af, pack8(CT[1][2 * ks], CT[1][2 * ks + 1]), num1); }
#pragma unroll
        for (int i = 0; i < 4; ++i) { const float wi = fexp(m - __shfl(Av, 16 * rb + 4 * q4 + i)); num0[i] *= wi; num1[i] *= wi; }
        const unsigned vbase = vbase0 + cur * ML_VSZ;
        bf16x8 V00, V01, V10, V11;
        TR_READ4(V00, V01, V10, V11, vbase, 0, 4 * ML_VP, 32 * ML_VP, 36 * ML_VP, 32, 4 * ML_VP + 32, 32 * ML_VP + 32, 36 * ML_VP + 32);
        { const bf16x8 pf0 = *(const LAS bf16x8*)(lds + ML_P + (16 * rb + i16) * ML_PP + (8 * q4) * 2), pf1 = *(const LAS bf16x8*)(lds + ML_P + (16 * rb + i16) * ML_PP + (32 + 8 * q4) * 2);
          num0 = mma16(pf0, V00, num0); num0 = mma16(pf1, V01, num0); num1 = mma16(pf0, V10, num1); num1 = mma16(pf1, V11, num1); }
#pragma unroll
        for (int a = 0; a < 2; ++a)
#pragma unroll
            for (int d = 0; d < 8; ++d) CT[a][d] = CT[a][d] * wC;
#pragma unroll
        for (int ks = 0; ks < 2; ++ks)
#pragma unroll
            for (int dg = 0; dg < 2; ++dg) { bf16x8 k0, k1, k2, k3;
                TR_READ4(k0, k1, k2, k3, kwbase, 32 * ks * ML_QP + 32 * (4 * dg), (32 * ks + 4) * ML_QP + 32 * (4 * dg), 32 * ks * ML_QP + 32 * (4 * dg + 1), (32 * ks + 4) * ML_QP + 32 * (4 * dg + 1),
                         32 * ks * ML_QP + 32 * (4 * dg + 2), (32 * ks + 4) * ML_QP + 32 * (4 * dg + 2), 32 * ks * ML_QP + 32 * (4 * dg + 3), (32 * ks + 4) * ML_QP + 32 * (4 * dg + 3));
                const bf16x8 va = ks ? V01 : V00, vb = ks ? V11 : V10;
                CT[0][4 * dg] = mma16(k0, va, CT[0][4 * dg]); CT[0][4 * dg + 1] = mma16(k1, va, CT[0][4 * dg + 1]); CT[0][4 * dg + 2] = mma16(k2, va, CT[0][4 * dg + 2]); CT[0][4 * dg + 3] = mma16(k3, va, CT[0][4 * dg + 3]);
                CT[1][4 * dg] = mma16(k0, vb, CT[1][4 * dg]); CT[1][4 * dg + 1] = mma16(k1, vb, CT[1][4 * dg + 1]); CT[1][4 * dg + 2] = mma16(k2, vb, CT[1][4 * dg + 2]); CT[1][4 * dg + 3] = mma16(k3, vb, CT[1][4 * dg + 3]); }
        { LAS unsigned char* Qn = lds + ML_Q + nxt * ML_QSZ; LAS unsigned char* Kn = lds + ML_K + nxt * ML_QSZ;
          *(LAS u32x4*)(Qn + srow0 * ML_QP + sch * 16) = pq0; *(LAS u32x4*)(Qn + (srow0 + 32) * ML_QP + sch * 16) = pq1;
          *(LAS u32x4*)(Kn + srow0 * ML_QP + sch * 16) = pk0; *(LAS u32x4*)(Kn + (srow0 + 32) * ML_QP + sch * 16) = pk1;
          *(LAS u32x4*)(lds + ML_V + nxt * ML_VSZ + vrow * ML_VP + vch * 16) = pv; }
        LDS_BARRIER();
#pragma unroll
        for (int i = 0; i < 4; ++i) { const int t = 16 * rb + 4 * q4 + i; const float dinv = denS[t]; const float h0 = num0[i] * dinv, h1 = num1[i] * dinv;
            hv0[i] = h0; hv1[i] = h1;
            float s0 = h0 * h0, s1 = h1 * h1;
            s0 = row16_sum(s0);
            s1 = row16_sum(s1);
            sv0[i] = s0; sv1[i] = s1; }
        m = bL + A63;
    }
    ML_FLUSH(rbase + 64 * 31);
#undef ML_FLUSH
    const size_t sb = (size_t)(ib * NBP + b) * 8 + h;
    if (rb == 0) {
#pragma unroll
        for (int a = 0; a < 2; ++a)
#pragma unroll
            for (int d = 0; d < 8; ++d) *(f32x4*)(out + O_CP + (sb * 256 + e0 + 16 * a + i16) * 128 + 16 * d + 4 * q4) = CT[a][d]; }
    if (sl == 0) { if (tid < 128) out[O_NP + sb * 128 + tid] = nS[tid]; if (tid == 0) out[O_MP + sb] = m; }
}

__device__ __forceinline__ void hn_row(const bf16_t* HRAW, const float* SQ, const bf16_t* QKVO, const float* gh, bf16_t* HN, int r, int lane) {
    const int hh = lane >> 3;
    const f32x4 s0 = *(const f32x4*)(SQ + (size_t)r * 128 + hh * 16), s1 = *(const f32x4*)(SQ + (size_t)r * 128 + hh * 16 + 4), s2 = *(const f32x4*)(SQ + (size_t)r * 128 + hh * 16 + 8), s3 = *(const f32x4*)(SQ + (size_t)r * 128 + hh * 16 + 12);
    const float tot = (((s0[0] + s0[1]) + (s0[2] + s0[3])) + ((s1[0] + s1[1]) + (s1[2] + s1[3]))) + (((s2[0] + s2[1]) + (s2[2] + s2[3])) + ((s3[0] + s3[1]) + (s3[2] + s3[3])));
    const float rs = rsqrtf(tot * (1.f / 256.f) + EPS);
#pragma unroll
    for (int c = 0; c < 4; ++c) { const int col = 32 * lane + 8 * c;
        const u32x4 hx = *(const u32x4*)(HRAW + (size_t)r * DM + col), ox = *(const u32x4*)(QKVO + (size_t)r * NIN + 4096 + col);
        const f32x4 g0 = *(const f32x4*)(gh + col), g1 = *(const f32x4*)(gh + col + 4);
        u32x4 o;
        o.x = pk2(bflo(hx.x) * rs * g0[0] / (1.f + fexp(-bflo(ox.x))), bfhi(hx.x) * rs * g0[1] / (1.f + fexp(-bfhi(ox.x))));
        o.y = pk2(bflo(hx.y) * rs * g0[2] / (1.f + fexp(-bflo(ox.y))), bfhi(hx.y) * rs * g0[3] / (1.f + fexp(-bfhi(ox.y))));
        o.z = pk2(bflo(hx.z) * rs * g1[0] / (1.f + fexp(-bflo(ox.z))), bfhi(hx.z) * rs * g1[1] / (1.f + fexp(-bfhi(ox.z))));
        o.w = pk2(bflo(hx.w) * rs * g1[2] / (1.f + fexp(-bflo(ox.w))), bfhi(hx.w) * rs * g1[3] / (1.f + fexp(-bfhi(ox.w))));
        *(u32x4*)(HN + (size_t)r * DM + col) = o; }
}

__device__ __forceinline__ void hn_rows2(const bf16_t* HRAW, const float* SQ, const bf16_t* QKVO, const float* gh, bf16_t* HN, int r0, int rstride, int lane) {
    const int hh = lane >> 3;
    f32x4 sq[2][4]; u32x4 hx[2][4], ox[2][4];
#pragma unroll
    for (int k = 0; k < 2; ++k) { const int r = r0 + k * rstride;
#pragma unroll
        for (int q = 0; q < 4; ++q) sq[k][q] = *(const f32x4*)(SQ + (size_t)r * 128 + hh * 16 + 4 * q);
#pragma unroll
        for (int c = 0; c < 4; ++c) { const int col = 32 * lane + 8 * c; hx[k][c] = *(const u32x4*)(HRAW + (size_t)r * DM + col); ox[k][c] = *(const u32x4*)(QKVO + (size_t)r * NIN + 4096 + col); } }
#pragma unroll
    for (int k = 0; k < 2; ++k) { const int r = r0 + k * rstride;
        const f32x4 s0 = sq[k][0], s1 = sq[k][1], s2 = sq[k][2], s3 = sq[k][3];
        const float tot = (((s0[0] + s0[1]) + (s0[2] + s0[3])) + ((s1[0] + s1[1]) + (s1[2] + s1[3]))) + (((s2[0] + s2[1]) + (s2[2] + s2[3])) + ((s3[0] + s3[1]) + (s3[2] + s3[3])));
        const float rs = rsqrtf(tot * (1.f / 256.f) + EPS);
#pragma unroll
        for (int c = 0; c < 4; ++c) { const int col = 32 * lane + 8 * c; const u32x4 H = hx[k][c], O = ox[k][c];
            const f32x4 g0 = *(const f32x4*)(gh + col), g1 = *(const f32x4*)(gh + col + 4);
            u32x4 o;
            o.x = pk2(bflo(H.x) * rs * g0[0] / (1.f + fexp(-bflo(O.x))), bfhi(H.x) * rs * g0[1] / (1.f + fexp(-bfhi(O.x))));
            o.y = pk2(bflo(H.y) * rs * g0[2] / (1.f + fexp(-bflo(O.y))), bfhi(H.y) * rs * g0[3] / (1.f + fexp(-bfhi(O.y))));
            o.z = pk2(bflo(H.z) * rs * g1[0] / (1.f + fexp(-bflo(O.z))), bfhi(H.z) * rs * g1[1] / (1.f + fexp(-bfhi(O.z))));
            o.w = pk2(bflo(H.w) * rs * g1[2] / (1.f + fexp(-bflo(O.w))), bfhi(H.w) * rs * g1[3] / (1.f + fexp(-bfhi(O.w))));
            *(u32x4*)(HN + (size_t)r * DM + col) = o; } }
}

#ifndef HN_TAIL
#define HN_TAIL 0
#endif
__device__ __forceinline__ void hn_tail(unsigned* ctl, const bf16_t* HRAW, const float* SQ, const bf16_t* QKVO, const float* gh, bf16_t* HN, int ib, int unit, int tid, int wave, int lane) {
    const int b = unit >> 5;
    unsigned* cnt = ctl + CW_PRG + (ib * 4 + b) * 64;
    asm volatile("s_waitcnt vmcnt(0)" ::: "memory");
    __syncthreads();
    if (tid == 0) {
        __builtin_amdgcn_fence(__ATOMIC_RELEASE, "agent");
        __hip_atomic_fetch_add(cnt, 1u, __ATOMIC_RELAXED, __HIP_MEMORY_SCOPE_AGENT);
        unsigned spins = 0;
        while (__hip_atomic_load(cnt, __ATOMIC_RELAXED, __HIP_MEMORY_SCOPE_AGENT) < 32u) { __builtin_amdgcn_s_sleep(8);
            if (++spins > (1u << 20)) { __hip_atomic_store(ctl + CW_TMO, 1u, __ATOMIC_RELAXED, __HIP_MEMORY_SCOPE_AGENT); break; } }
    }
    __syncthreads();
    __builtin_amdgcn_fence(__ATOMIC_ACQUIRE, "agent");
    for (int r = b * SEQ + (unit & 31) * NWAVES + wave; r < (b + 1) * SEQ; r += 32 * NWAVES) hn_row(HRAW, SQ, QKVO, gh, HN, r, lane);
}

__device__ __forceinline__ void mlstm_sample(LAS unsigned char* lds, const bf16_t* QKVO, const float* GATES, const float* gh, const float* C0all, const float* n0all, const float* m0all, bf16_t* HN, float* out, int ib, int bh, int tid, int wave, int lane) {
    const int bs = bh >> 3, h = bh & 7;
    const size_t sb = (size_t)(ib * NBS + bs) * 8 + h;
    LAS float* qs = (LAS float*)lds;
    LAS float* ks = qs + 512;
    LAS float* ns = ks + 512;
    LAS float* Ss = ns + 128;
    LAS float* nq = Ss + 16;
    LAS float* red = nq + 16;
    const size_t r0 = (size_t)MP + bs * 4;
    __syncthreads();
    { const int t = tid >> 7, d = tid & 127; qs[tid] = bf1(QKVO[(r0 + t) * NIN + h * 128 + d]); ks[tid] = bf1(QKVO[(r0 + t) * NIN + 1024 + h * 128 + d]); if (tid < 128) ns[tid] = n0all[sb * 128 + tid]; }
    __syncthreads();
    if (wave == 0) {
        if (lane < 16) { const int t = lane >> 2, s = lane & 3; float a = 0.f; for (int d = 0; d < 128; ++d) a += qs[t * 128 + d] * ks[s * 128 + d]; Ss[lane] = a; }
        else if (lane < 20) { const int t = lane - 16; float a = 0.f; for (int d = 0; d < 128; ++d) a += ns[d] * qs[t * 128 + d]; nq[t] = a; }
    }
    __syncthreads();
    const float m0 = m0all[sb];
    float bc[4], av[4], Av[4];
    { float run = 0.f, pm = -INFINITY;
#pragma unroll
      for (int t = 0; t < 4; ++t) { const float ig = GATES[(r0 + t) * 16 + h], lf = GATES[(r0 + t) * 16 + 8 + h]; run += lf; bc[t] = run; av[t] = ig - run; pm = fmaxf(pm, av[t]); Av[t] = fmaxf(m0, pm); } }
    const float A3 = Av[3], wC = fexp(m0 - A3);
    float Pm[4][4], den[4];
#pragma unroll
    for (int t = 0; t < 4; ++t) { float rs = 0.f;
#pragma unroll
        for (int s = 0; s < 4; ++s) { Pm[t][s] = (s <= t) ? Ss[t * 4 + s] * fexp(av[s] - Av[t]) : 0.f; rs += Pm[t][s]; }
        den[t] = fexp(m0 - Av[t]) * nq[t] + rs; }
    const int e = tid >> 1, hf = tid & 1;
    const float* Crow = C0all + (sb * 256 + e) * 128 + 64 * hf;
    f32x4 Cv[16];
#pragma unroll
    for (int j = 0; j < 16; ++j) Cv[j] = *(const f32x4*)(Crow + 4 * j);
    float inter[4];
#pragma unroll
    for (int t = 0; t < 4; ++t) { float a = 0.f; const LAS float* q = qs + t * 128 + 64 * hf;
#pragma unroll
        for (int j = 0; j < 16; ++j) a += Cv[j].x * q[4 * j] + Cv[j].y * q[4 * j + 1] + Cv[j].z * q[4 * j + 2] + Cv[j].w * q[4 * j + 3];
        a += __shfl_xor(a, 1); inter[t] = a; }
    float vv[4];
#pragma unroll
    for (int s = 0; s < 4; ++s) vv[s] = bf1(QKVO[(r0 + s) * NIN + 2048 + h * 256 + e]);
    float hv[4];
#pragma unroll
    for (int t = 0; t < 4; ++t) { float nu = fexp(m0 - Av[t]) * inter[t];
#pragma unroll
        for (int s = 0; s < 4; ++s) nu += Pm[t][s] * vv[s];
        hv[t] = nu / fmaxf(fabsf(den[t]), fexp(-(bc[t] + Av[t])));
        float sq = (hf == 0) ? hv[t] * hv[t] : 0.f; sq = wave_sum(sq); if (lane == 0) red[t * 8 + wave] = sq; }
    __syncthreads();
    if (hf == 0) {
#pragma unroll
        for (int t = 0; t < 4; ++t) { float tot = 0.f;
#pragma unroll
            for (int w = 0; w < 8; ++w) tot += red[t * 8 + w];
            const float rs = rsqrtf(tot * (1.f / 256.f) + EPS);
            const float og = bf1(QKVO[(r0 + t) * NIN + 4096 + h * 256 + e]);
            HN[(r0 + t) * DM + h * 256 + e] = (bf16_t)f2bf(hv[t] * rs * gh[h * 256 + e] / (1.f + fexp(-og))); } }
    float wv[4];
#pragma unroll
    for (int s = 0; s < 4; ++s) wv[s] = fexp(av[s] - A3) * vv[s];
    float* Cout = out + O_CS + (sb * 256 + e) * 128 + 64 * hf;
#pragma unroll
    for (int j = 0; j < 16; ++j) { f32x4 o = Cv[j] * wC;
#pragma unroll
        for (int s = 0; s < 4; ++s) { const LAS float* k = ks + s * 128 + 64 * hf + 4 * j; o.x += wv[s] * k[0]; o.y += wv[s] * k[1]; o.z += wv[s] * k[2]; o.w += wv[s] * k[3]; }
        *(f32x4*)(Cout + 4 * j) = o; }
    if (tid < 128) { float o = wC * ns[tid];
#pragma unroll
        for (int s = 0; s < 4; ++s) o += fexp(av[s] - A3) * ks[s * 128 + tid];
        out[O_NS + sb * 128 + tid] = o; }
    if (tid == 0) out[O_MS + sb] = bc[3] + A3;
}

#ifndef CS_ASM
#define CS_ASM 1
#endif
__device__ __forceinline__ void cs_copy2_asm(const f32x4* s0, const f32x4* s1, f32x4* d0, f32x4* d1, int lane) {
    const f32x4 *pa = s0 + lane, *pb = s0 + lane + 256, *pc = s1 + lane, *pd = s1 + lane + 256;
    f32x4 *qa = d0 + lane, *qb = d0 + lane + 256, *qc = d1 + lane, *qd = d1 + lane + 256;
    f32x4 r0, r1, r2, r3, r4, r5, r6, r7, r8, r9, r10, r11, r12, r13, r14, r15;
    asm volatile("global_load_dwordx4 %0, %16, off sc0 sc1 nt\n\tglobal_load_dwordx4 %1, %16, off offset:1024 sc0 sc1 nt\n\tglobal_load_dwordx4 %2, %16, off offset:2048 sc0 sc1 nt\n\tglobal_load_dwordx4 %3, %16, off offset:3072 sc0 sc1 nt\n\t"
                 "global_load_dwordx4 %4, %17, off sc0 sc1 nt\n\tglobal_load_dwordx4 %5, %17, off offset:1024 sc0 sc1 nt\n\tglobal_load_dwordx4 %6, %17, off offset:2048 sc0 sc1 nt\n\tglobal_load_dwordx4 %7, %17, off offset:3072 sc0 sc1 nt\n\t"
                 "global_load_dwordx4 %8, %18, off sc0 sc1 nt\n\tglobal_load_dwordx4 %9, %18, off offset:1024 sc0 sc1 nt\n\tglobal_load_dwordx4 %10, %18, off offset:2048 sc0 sc1 nt\n\tglobal_load_dwordx4 %11, %18, off offset:3072 sc0 sc1 nt\n\t"
                 "global_load_dwordx4 %12, %19, off sc0 sc1 nt\n\tglobal_load_dwordx4 %13, %19, off offset:1024 sc0 sc1 nt\n\tglobal_load_dwordx4 %14, %19, off offset:2048 sc0 sc1 nt\n\tglobal_load_dwordx4 %15, %19, off offset:3072 sc0 sc1 nt\n\t"
                 "s_waitcnt vmcnt(0)"
                 : "=&v"(r0), "=&v"(r1), "=&v"(r2), "=&v"(r3), "=&v"(r4), "=&v"(r5), "=&v"(r6), "=&v"(r7), "=&v"(r8), "=&v"(r9), "=&v"(r10), "=&v"(r11), "=&v"(r12), "=&v"(r13), "=&v"(r14), "=&v"(r15)
                 : "v"(pa), "v"(pb), "v"(pc), "v"(pd) : "memory");
    asm volatile("global_store_dwordx4 %16, %0, off sc0 sc1 nt\n\tglobal_store_dwordx4 %16, %1, off offset:1024 sc0 sc1 nt\n\tglobal_store_dwordx4 %16, %2, off offset:2048 sc0 sc1 nt\n\tglobal_store_dwordx4 %16, %3, off offset:3072 sc0 sc1 nt\n\t"
                 "global_store_dwordx4 %17, %4, off sc0 sc1 nt\n\tglobal_store_dwordx4 %17, %5, off offset:1024 sc0 sc1 nt\n\tglobal_store_dwordx4 %17, %6, off offset:2048 sc0 sc1 nt\n\tglobal_store_dwordx4 %17, %7, off offset:3072 sc0 sc1 nt\n\t"
                 "global_store_dwordx4 %18, %8, off sc0 sc1 nt\n\tglobal_store_dwordx4 %18, %9, off offset:1024 sc0 sc1 nt\n\tglobal_store_dwordx4 %18, %10, off offset:2048 sc0 sc1 nt\n\tglobal_store_dwordx4 %18, %11, off offset:3072 sc0 sc1 nt\n\t"
                 "global_store_dwordx4 %19, %12, off sc0 sc1 nt\n\tglobal_store_dwordx4 %19, %13, off offset:1024 sc0 sc1 nt\n\tglobal_store_dwordx4 %19, %14, off offset:2048 sc0 sc1 nt\n\tglobal_store_dwordx4 %19, %15, off offset:3072 sc0 sc1 nt"
                 :: "v"(r0), "v"(r1), "v"(r2), "v"(r3), "v"(r4), "v"(r5), "v"(r6), "v"(r7), "v"(r8), "v"(r9), "v"(r10), "v"(r11), "v"(r12), "v"(r13), "v"(r14), "v"(r15), "v"(qa), "v"(qb), "v"(qc), "v"(qd) : "memory");
}
#ifndef CS_NT
#define CS_NT 0
#endif
__device__ __forceinline__ void cache_shift(const Params& P, float* outp, int lo, int hi, int w, int NW, int lane) {
    int t = lo + w;
    if (CS_ASM) {
        for (; t + NW < hi; t += 2 * NW) { const f32x4 *s0, *s1; f32x4 *d0, *d1; cs_addr(P, outp, t, s0, d0); cs_addr(P, outp, t + NW, s1, d1); cs_copy2_asm(s0, s1, d0, d1, lane); }
        if (t < hi) { const f32x4* s0; f32x4* d0; cs_addr(P, outp, t, s0, d0); cs_copy2_asm(s0, s0, d0, d0, lane); }
        return;
    }
    if (CS_DEPTH > 1) {
        for (; t + (CS_DEPTH - 1) * NW < hi; t += CS_DEPTH * NW) {
            const f32x4* sp[CS_DEPTH]; f32x4* dp[CS_DEPTH]; f32x4 a[CS_DEPTH][8];
#pragma unroll
            for (int d = 0; d < CS_DEPTH; ++d) cs_addr(P, outp, t + d * NW, sp[d], dp[d]);
#pragma unroll
            for (int d = 0; d < CS_DEPTH; ++d)
#pragma unroll
                for (int i = 0; i < 8; ++i) a[d][i] = CS_NT ? __builtin_nontemporal_load(sp[d] + lane + 64 * i) : sp[d][lane + 64 * i];
#pragma unroll
            for (int d = 0; d < CS_DEPTH; ++d)
#pragma unroll
                for (int i = 0; i < 8; ++i) { if (CS_NT) __builtin_nontemporal_store(a[d][i], dp[d] + lane + 64 * i); else dp[d][lane + 64 * i] = a[d][i]; }
        }
    }
    for (; t < hi; t += NW) {
        const f32x4* src; f32x4* dst; cs_addr(P, outp, t, src, dst);
#pragma unroll
        for (int i = 0; i < 8; ++i) { if (CS_NT) __builtin_nontemporal_store(__builtin_nontemporal_load(src + lane + 64 * i), dst + lane + 64 * i); else dst[lane + 64 * i] = src[lane + 64 * i]; }
    }
}

__device__ __forceinline__ void phase_convgate(const Params& P, float* outp, const bf16_t* U, bf16_t* Z, int layer, int gtid, int NGT) {
    constexpr int NCG = DFF / 8, NRUN = MP / 64 + NBS;
    const float* cw = P.in[20] + (size_t)layer * 3 * NUP; const float* cbias = P.in[21] + (size_t)layer * NUP;
    for (int task = gtid; task < NCG * NRUN; task += NGT) {
        const int cg = task % NCG, run = task / NCG, j0 = 8 * cg;
        const int ua0 = 256 * (j0 >> 7) + (j0 & 127), ub0 = ua0 + 128;
        float wa[3][8], wb[3][8], ba[8], bb[8];
#pragma unroll
        for (int k = 0; k < 3; ++k) { load8(cw + (size_t)k * NUP + j0, wa[k]); load8(cw + (size_t)k * NUP + DFF + j0, wb[k]); }
        load8(cbias + j0, ba); load8(cbias + DFF + j0, bb);
        float a2[8], a1[8], b2[8], b1[8];
        size_t row0; int nrows; float* cout;
        if (run < MP / 64) { const int b = run >> 5, s0 = (run & 31) * 64; row0 = (size_t)b * SEQ + s0; nrows = 64;
            cout = (s0 == SEQ - 64) ? outp + O_CONVP + ((size_t)(layer * NBP + b) * 2) * NUP : nullptr;
            if (s0 == 0) {
#pragma unroll
                for (int j = 0; j < 8; ++j) { a2[j] = 0.f; a1[j] = 0.f; b2[j] = 0.f; b1[j] = 0.f; } }
            else { unpack8(*(const u32x4*)(U + (row0 - 2) * NUP + ua0), a2); unpack8(*(const u32x4*)(U + (row0 - 1) * NUP + ua0), a1);
                   unpack8(*(const u32x4*)(U + (row0 - 2) * NUP + ub0), b2); unpack8(*(const u32x4*)(U + (row0 - 1) * NUP + ub0), b1); } }
        else { const int bs = run - MP / 64; row0 = (size_t)MP + bs * 4; nrows = 4;
            cout = outp + O_CONVS + ((size_t)(layer * NBS + bs) * 2) * NUP;
            const float* st = P.in[8] + ((size_t)(layer * NBS + bs) * 2) * NUP;
            load8(st + j0, a2); load8(st + NUP + j0, a1); load8(st + DFF + j0, b2); load8(st + NUP + DFF + j0, b1); }
        for (int t = 0; t < nrows; t += 4) {
            u32x4 ua[4], ub[4];
#pragma unroll
            for (int q = 0; q < 4; ++q) { ua[q] = *(const u32x4*)(U + (row0 + t + q) * NUP + ua0); ub[q] = *(const u32x4*)(U + (row0 + t + q) * NUP + ub0); }
#pragma unroll
            for (int q = 0; q < 4; ++q) {
                float a0[8], b0[8];
                unpack8(ua[q], a0); unpack8(ub[q], b0);
                float z[8];
#pragma unroll
                for (int j = 0; j < 8; ++j) { const float ca = ba[j] + wa[0][j] * a2[j] + wa[1][j] * a1[j] + wa[2][j] * a0[j]; const float cb = bb[j] + wb[0][j] * b2[j] + wb[1][j] * b1[j] + wb[2][j] * b0[j];
                    z[j] = ca / (1.f + fexp(-ca)) * cb; a2[j] = a1[j]; a1[j] = a0[j]; b2[j] = b1[j]; b1[j] = b0[j]; }
                u32x4 o; o.x = pk2(z[0], z[1]); o.y = pk2(z[2], z[3]); o.z = pk2(z[4], z[5]); o.w = pk2(z[6], z[7]);
                *(u32x4*)(Z + (row0 + t + q) * DFF + j0) = o;
            }
        }
        if (cout) { store8(cout + j0, a2); store8(cout + NUP + j0, a1); store8(cout + DFF + j0, b2); store8(cout + NUP + DFF + j0, b1); }
    }
}

#ifndef REP_STORE
#define REP_STORE 1
#endif
#ifndef REP_CONV
#define REP_CONV 1
#endif
#ifndef REP_ML
#define REP_ML 1
#endif
#ifndef REP_ATT
#define REP_ATT 1
#endif
#ifndef REP_RESID
#define REP_RESID 1
#endif
#ifndef REP_FIN
#define REP_FIN 1
#endif
#ifndef COMB_NR
#define COMB_NR 1
#endif
#ifndef HN2
#define HN2 0
#endif
#ifndef REP_SIDE
#define REP_SIDE 1
#endif
#ifndef MLX
#define MLX 3
#endif
#ifndef REP_CS
#define REP_CS 1
#endif
#ifndef REP_MR
#define REP_MR 1
#endif
#ifndef REP_UP
#define REP_UP 0
#endif
#ifndef REP_BAR
#define REP_BAR 1
#endif
#ifndef REP_TAIL
#define REP_TAIL 1
#endif
#ifndef REP_P0
#define REP_P0 1
#endif
#define REPEAT(n, body) do { body; if ((n) > 1) { body; } if ((n) > 2) { body; } } while (0)
__global__ void __launch_bounds__(NTHR, 2) fwd_kernel(Params P) {
    extern __shared__ __attribute__((aligned(16))) unsigned char lds_raw[];
    LAS unsigned char* lds = (LAS unsigned char*)lds_raw;
    const unsigned lds_base = (unsigned)(size_t)lds;
    const int tid0 = threadIdx.x;
    const int G0 = gridDim.x, bx0 = blockIdx.x;
#define PHASE_IDS int tid = tid0; asm volatile("" : "+v"(tid)); int zz_ = 0; asm volatile("" : "+v"(zz_)); zz_ = __builtin_amdgcn_readfirstlane(zz_); const int bx = bx0 + zz_, G = G0 + zz_; unsigned char* ws = P.ws + zz_; float* outp = P.out + zz_; \
    const int lane = tid & 63, wave = __builtin_amdgcn_readfirstlane(tid >> 6); const int gw = bx * NWAVES + wave, gtid = bx * NTHR + tid, NGW = G * NWAVES, NGT = G * NTHR; (void)gw; (void)gtid; (void)lane; (void)NGW; (void)NGT; (void)outp; \
    bf16_t* XB = (bf16_t*)(ws + WS_XB); float* SSQ = (float*)(ws + WS_SSQ); float* SSQS = (float*)(ws + WS_SSQS); bf16_t* QKV = (bf16_t*)(ws + WS_QKV); bf16_t* OG = (bf16_t*)(ws + WS_OG); float* LSE = (float*)(ws + WS_LSE); bf16_t* OC = (bf16_t*)(ws + WS_OC); \
    float* GATES = (float*)(ws + WS_GATES); bf16_t* U = (bf16_t*)(ws + WS_U); bf16_t* Z = (bf16_t*)(ws + WS_Z); (void)XB; (void)SSQ; (void)SSQS; (void)QKV; (void)OG; (void)LSE; (void)OC; (void)GATES; (void)U; (void)Z;
    volatile LAS unsigned* misc = (volatile LAS unsigned*)(lds + LDS_MISC_OFF);
    if (tid0 < 16) misc[tid0] = 0u;
    __syncthreads();
    { const XcdBarrier bar0 = xcd_barrier_post((unsigned*)(P.ws + WS_CTL) + 1024, misc + 8); if (tid0 == 0) misc[10] = bar0.x; }
    __syncthreads();
#define GRID_BAR() do { XcdBarrier bar_; bar_.bar = (unsigned*)(P.ws + WS_CTL) + 1024; bar_.x = (unsigned)__builtin_amdgcn_readfirstlane((int)misc[10]); bar_.st = misc + 8; xcd_barrier(bar_); if (REP_BAR > 1) xcd_barrier(bar_); } while (0)
#define GEMM_STORE(Abuf, Wt, NN, KK, Obuf, CSB) REPEAT(REP_STORE, GEMM_STORE1(Abuf, Wt, NN, KK, Obuf, CSB))
#define GEMM_STORE1(Abuf, Wt, NN, KK, Obuf, CSB) do { PHASE_IDS; \
        { pg8::Gemm g{Abuf, (const bf16_t*)(Wt), MP, NN, KK}; pg8::StaticOrder S; S.init(MP, NN, G, bx); const int pm0_ = pg8::first_pm(S); LAS float* rtab_ = (LAS float*)(lds + RING_BYTES); pg8::rstd_panel(rtab_, SSQ, pm0_, EPS, tid); pg8::EpiStoreN E{Obuf, NN, SSQ, EPS, rtab_, pm0_}; \
          pg8::gemm_phase<pg8::EpiStoreN, pg8::StaticOrder, true, true>(lds, g, S, E); } \
        REPEAT(REP_TAIL, skinny_phase<0>(lds, Abuf + (size_t)MP * KK, KK, (const bf16_t*)(Wt), NN, Obuf + (size_t)MP * NN, NN, nullptr, SSQS, nullptr, bx, G, (((MP / 256) * ((NN) / 256)) % G) ? G - (((MP / 256) * ((NN) / 256)) % G) : G, tid, wave, lane, P, (CSB))); } while (0)
#define GEMM_RESID(Abuf, Wt, KK, FIN) do { PHASE_IDS; \
        { pg8::Gemm g{Abuf, (const bf16_t*)(Wt), MP, DM, KK}; pg8::StaticOrder S; S.init(MP, DM, G, bx); pg8::EpiResidN E{XB, (FIN) ? outp : nullptr, (FIN) ? nullptr : SSQ, DM}; \
          pg8::gemm_phase<pg8::EpiResidN, pg8::StaticOrder, true, true>(lds, g, S, E); } \
        if (FIN) skinny_phase<2>(lds, Abuf + (size_t)MP * KK, KK, (const bf16_t*)(Wt), DM, nullptr, 0, XB + (size_t)MP * DM, nullptr, outp + (size_t)MP * DM, bx, G, G, tid, wave, lane, P, -1); \
        else skinny_phase<1>(lds, Abuf + (size_t)MP * KK, KK, (const bf16_t*)(Wt), DM, nullptr, 0, XB + (size_t)MP * DM, SSQS, nullptr, bx, G, G, tid, wave, lane, P, -1); } while (0)

    REPEAT(REP_P0, { PHASE_IDS; phase_prologue(P, lds, gw, NGW, wave, lane); });
    GRID_BAR();

#define FFN(L, FIN) do { \
        { PHASE_IDS; unsigned* ctl_ = (unsigned*)(ws + WS_CTL); \
          skinny_up(lds, P.in[8], P.in[20] + (size_t)(L) * 3 * NUP, P.in[21] + (size_t)(L) * NUP, XB, (const bf16_t*)(ws + WS_WUP + (L) * SZ_WUP), SSQ, SSQS, (float*)(ws + WS_HALO), ctl_ + CW_HCNT, Z, outp, (L), bx, G, 128, tid, wave, lane, P, 2 * CS_QKV + (L) * CS_UP); \
          if (bx >= G - 128) {   \
              if (UPW0 > 0 && (L) == 0) { for (int v = P0_G1 - (UPW0) + (bx - (G - 128)) * NWAVES + wave; v < P0_G1; v += 128 * NWAVES) p0_item(P, v, lane, true); } \
              else if (UPT > 0 && (L) == 0) for (int v = (P0_C1) + (bx - (G - 128)) * NWAVES + wave; v < (P0_C1) + (UPT); v += 128 * NWAVES) p0_item(P, v, lane, true); \
              else if (UPT > 0 && (L) == 1) for (int v = (P0_C2) - (UPT) + (bx - (G - 128)) * NWAVES + wave; v < (P0_C2); v += 128 * NWAVES) p0_item(P, v, lane, true); \
              else if (UPCOPY > 0) cache_shift(P, outp, CS_UPC0 + ((L) - (4 - CS_NUP)) * (UPCOPY), CS_UPC0 + ((L) - (4 - CS_NUP) + 1) * (UPCOPY), (bx - (G - 128)) * NWAVES + wave, 128 * NWAVES, lane); } \
          { pg8::Gemm g{XB, (const bf16_t*)(ws + WS_WUP + (L) * SZ_WUP), MP, NUP, DM}; pg8::StaticOrder S; S.init(MP, NUP, G, bx); const int pm0_ = pg8::first_pm(S); \
            LAS float* rtab_ = (LAS float*)(lds + RING_BYTES); volatile LAS unsigned* rdy_ = (volatile LAS unsigned*)(lds + RING_BYTES + 1024 + 8192); if (tid == 0) rdy_[0] = 0u; pg8::rstd_panel(rtab_, SSQ, pm0_, EPS, tid); \
            pg8::EpiConv E{ws, P.in[20] + (size_t)(L) * 3 * NUP, P.in[21] + (size_t)(L) * NUP, lds + RING_BYTES, (unsigned)((L) + 1) * (unsigned)(SU_NITEMS * 4), pm0_}; \
            pg8::gemm_phase<pg8::EpiConv, pg8::StaticOrder, true, true>(lds, g, S, E); \
            if (REP_UP == 1) pg8::gemm_phase<pg8::EpiConv, pg8::StaticOrder, true, true>(lds, g, S, E); \
            if (REP_UP == 2) { pg8::EpiNull EN{(float*)(ws + WS_U)}; pg8::gemm_phase<pg8::EpiNull, pg8::StaticOrder, true, true>(lds, g, S, EN); } } } \
        GRID_BAR(); \
        GEMM_RESID(Z, ws + WS_WDOWN + (L) * SZ_WDOWN, DFF, FIN); \
    } while (0)

#define LAYER_PAIR(lp) do { \
        { \
            const int ia = (lp); \
            GEMM_STORE(XB, ws + WS_WQKV + ia * SZ_WQKV, NQKV, DM, QKV, ia * CS_QKV); \
            GRID_BAR(); \
            REPEAT(REP_ATT, { PHASE_IDS; attn_phase(P, lds, lds_base, QKV, (const float*)(ws + WS_ROPE), P.in[12] + ia * 128, P.in[13] + ia * 128, outp, ia, OG, LSE, bx, G, 1536, tid, wave, lane); } \
            { PHASE_IDS; for (int wt = bx + G * wave; wt < NBS * 96; wt += G * NWAVES) attn_sample_task(lds + wave * 4096, QKV, (const float*)(ws + WS_ROPE), P.in[12] + ia * 128, P.in[13] + ia * 128, outp, P.in[2], P.in[3], P.in[4], OG, LSE, ia, wt, lane); __syncthreads(); }); \
            GRID_BAR(); \
            REPEAT(REP_ATT, { PHASE_IDS; if (COMB_NR > 1) { for (int r = gw; r < MR; r += COMB_NR * NGW) combine_rows<COMB_NR>(OG, LSE, OC, r, NGW, MR, lane); } else { for (int r = gw; r < MR; r += NGW) combine_row(OG, LSE, OC, r, lane); } }); \
            GRID_BAR(); \
            GEMM_RESID(OC, ws + WS_WO + ia * SZ_WO, DO, false); \
            GRID_BAR(); \
            FFN(2 * (lp), false); \
            GRID_BAR(); \
        } \
        { \
            const int L = 2 * (lp) + 1, ib = (lp); \
            GEMM_STORE(XB, ws + WS_WIN + ib * SZ_WIN, NIN, DM, QKV, -1); \
            REPEAT(REP_TAIL, { PHASE_IDS; for (int task = G - 1 - bx; task < MP / 16; task += G) gate_block(lds, XB, (const f32x4*)(ws + WS_WGP) + (size_t)ib * 128 * 64, P.in[16] + ib * 16, GATES, task, wave, lane); \
              if (bx < MSAMP / 16) gate_block(lds, XB, (const f32x4*)(ws + WS_WGP) + (size_t)ib * 128 * 64, P.in[16] + ib * 16, GATES, MP / 16 + bx, wave, lane); });   \
            GRID_BAR(); \
            REPEAT(REP_ML, { PHASE_IDS; \
              \
            const int xq_ = (MLX ? (bx & 7) : (bx >> 5)); const int xi_ = (MLX ? (bx >> 3) : (bx & 31)); const int mu_ = (MLX == 3) ? xq_ * 16 + (xi_ >> 1) : (MLX == 2) ? xq_ * 16 + (xi_ & 15) : (xq_ & 3) * 32 + xi_; \
            if ((MLX == 3) ? ((xi_ & 1) == 0) : (MLX == 2) ? (xi_ < 16) : (xq_ < 4)) { mlstm_prompt(lds, lds_base, QKV, GATES, OG, (float*)(ws + WS_SQ), outp, ib, mu_, tid, wave, lane); if (REP_MR > 1) { __syncthreads(); mlstm_prompt(lds, lds_base, QKV, GATES, OG, (float*)(ws + WS_SQ), outp, ib, mu_, tid, wave, lane); } \
              if (HN_TAIL) hn_tail((unsigned*)(ws + WS_CTL), OG, (const float*)(ws + WS_SQ), QKV, P.in[17] + (size_t)ib * DM, OC, ib, mu_, tid, wave, lane); } \
            else { if (mu_ < 64) mlstm_sample(lds, QKV, GATES, P.in[17] + (size_t)ib * DM, P.in[5], P.in[6], P.in[7], OC, outp, ib, mu_, tid, wave, lane); \
                   for (int rs_ = 0; rs_ < REP_SIDE; ++rs_) { cache_shift(P, outp, (lp) == 0 ? CS_TAILS : (CS_SPLIT), (lp) == 0 ? (CS_SPLIT) : 2 * CS_PER_LAYER, mu_ * NWAVES + wave, 128 * NWAVES, lane); \
                   for (int v = ((lp) == 0 ? (P0_C1) + (UPT) : (P0_C2)) + mu_ * NWAVES + wave; v < ((lp) == 0 ? (P0_C2) - (UPT) : P0_TOTAL); v += 128 * NWAVES) p0_item(P, v, lane, true); } \
                   if (REP_CS > 1 && (lp) == 1) { __syncthreads(); cache_shift(P, outp, (CS_SPLIT), 2 * CS_PER_LAYER, mu_ * NWAVES + wave, 128 * NWAVES, lane); } \
                   if (REP_CS > 2 && (lp) == 0) { __syncthreads(); for (int v = (P0_C1) + mu_ * NWAVES + wave; v < (P0_C2); v += 128 * NWAVES) p0_item(P, v, lane, true); } } }); \
            GRID_BAR(); \
            if (!HN_TAIL) { REPEAT(REP_FIN, { PHASE_IDS; if (HN2) { for (int r = gw; r < MP; r += 2 * NGW) hn_rows2(OG, (const float*)(ws + WS_SQ), QKV, P.in[17] + (size_t)ib * DM, OC, r, NGW, lane); } else { for (int r = gw; r < MP; r += NGW) hn_row(OG, (const float*)(ws + WS_SQ), QKV, P.in[17] + (size_t)ib * DM, OC, r, lane); } }); GRID_BAR(); } \
            GEMM_RESID(OC, ws + WS_WOUT + ib * SZ_WOUT, DM, false); \
            GRID_BAR(); \
            FFN(L, (L == DEPTH - 1)); \
            if ((lp) == 0) GRID_BAR(); \
        } \
    } while (0)
    LAYER_PAIR(0);
    LAYER_PAIR(1);
}

extern "C" void kernel_launch(void* const* d_in, const int* in_sizes, int n_in, void* d_out, int out_size, void* d_ws, size_t ws_size, hipStream_t stream) {
    static int grid = 0;
    if (grid == 0) {
        if (n_in != 23 || (size_t)out_size != O_END || ws_size < WS_END) {
            fprintf(stderr, "kernel_launch: built for 23 inputs, %zu outputs, >= %zu bytes of workspace; got n_in %d, out %d, ws %zu; nothing launched\n", (size_t)O_END, (size_t)WS_END, n_in, out_size, ws_size);
            grid = -1; return; }
        int dev = 0, cus = 0, per_cu = 0;
        if (hipGetDevice(&dev) != hipSuccess || hipDeviceGetAttribute(&cus, hipDeviceAttributeMultiprocessorCount, dev) != hipSuccess) { fprintf(stderr, "kernel_launch: device query failed\n"); grid = -1; return; }
        if (hipFuncSetAttribute((const void*)fwd_kernel, hipFuncAttributeMaxDynamicSharedMemorySize, LDS_BYTES) != hipSuccess) { fprintf(stderr, "kernel_launch: hipFuncSetAttribute failed\n"); grid = -1; return; }
        if (hipOccupancyMaxActiveBlocksPerMultiprocessor(&per_cu, (const void*)fwd_kernel, NTHR, LDS_BYTES) != hipSuccess || per_cu < 1)
            fprintf(stderr, "kernel_launch: occupancy query reports %d workgroups per CU\n", per_cu);
        (void)hipGetLastError();
        grid = cus;
    }
    if (grid < 0) return;
    (void)hipMemsetAsync((char*)d_ws + WS_CTL, 0, CTL_ZERO_BYTES, stream);
    Params p{};
    for (int i = 0; i < 23; ++i) p.in[i] = (const float*)d_in[i];
    p.out = (float*)d_out; p.ws = (unsigned char*)d_ws;
    hipLaunchKernelGGL(fwd_kernel, dim3(grid), dim3(NTHR), LDS_BYTES, stream, p);
    const hipError_t le = hipPeekAtLastError();
    if (le != hipSuccess) fprintf(stderr, "kernel_launch: launch failed: %s\n", hipGetErrorName(le));
}
```
